# Optimizing an MI355X kernel written in HIP

```python
import math
import jax
import jax.numpy as jnp
from jax import lax
import numpy as np


D_MODEL = 1024
BATCH = 2
SEQ = 8192
DEPTH = 2

CHUNK = 64
Q_BLOCK = 128
NORM_EPS = 1e-6

MLA_HEADS = 4
MLA_Q_RANK = 256
MLA_KV_RANK = 128
MLA_NOPE = 128
MLA_ROPE = 64
MLA_V = 128
MLA_WIDTH = MLA_HEADS * MLA_V
ROPE_THETA = 10000.0

SSD_HEADS = 8
SSD_HEAD_DIM = 64
SSD_WIDTH = SSD_HEADS * SSD_HEAD_DIM
SSD_GROUPS = 2
SSD_STATE = 128
SSD_CONV = 4
SSD_XBC = SSD_WIDTH + 2 * SSD_GROUPS * SSD_STATE

RWKV_HEADS = 8
RWKV_HEAD_DIM = 64
RWKV_WIDTH = RWKV_HEADS * RWKV_HEAD_DIM
DECAY_LORA = 64
ICLR_LORA = 64
DECAY_SCALE = 0.606531
GN_EPS = 64e-5

D_MIX = MLA_WIDTH + SSD_WIDTH + RWKV_WIDTH
IN_SPLIT_SIZES = (MLA_Q_RANK, MLA_KV_RANK, MLA_ROPE, MLA_WIDTH,
                  SSD_WIDTH, SSD_XBC, SSD_HEADS,
                  RWKV_WIDTH, RWKV_WIDTH, RWKV_WIDTH, DECAY_LORA, ICLR_LORA, RWKV_WIDTH)
D_IN = (MLA_Q_RANK + MLA_KV_RANK + MLA_ROPE + MLA_WIDTH + SSD_WIDTH + SSD_XBC + SSD_HEADS
        + 3 * RWKV_WIDTH + DECAY_LORA + ICLR_LORA + RWKV_WIDTH)

kernel_name = 'hybrid_mla_ssd_rwkv7_adaln_chunk_causal'


def rms_norm(x, w):
    xf = x.astype(jnp.float32)
    y = xf * lax.rsqrt(jnp.mean(xf * xf, axis=-1, keepdims=True) + NORM_EPS)
    return (y * w.astype(jnp.float32)).astype(x.dtype)


def split_cols(t, sizes):
    idx = np.cumsum(np.array(sizes))[:-1].tolist()
    return jnp.split(t, idx, axis=-1)


def rope_angles(positions, dim):
    half = dim // 2
    inv_freq = ROPE_THETA ** (-jnp.arange(half, dtype=jnp.float32) / half)
    ang = positions.astype(jnp.float32)[..., None] * inv_freq
    return jnp.cos(ang), jnp.sin(ang)


def apply_rope(x, cos, sin):
    x1, x2 = jnp.split(x, 2, axis=-1)
    cos = cos.astype(x.dtype)
    sin = sin.astype(x.dtype)
    return jnp.concatenate([x1 * cos - x2 * sin, x1 * sin + x2 * cos], axis=-1)


def chunk_causal_attention(q, k, v):
    b, s, h, dqk = q.shape
    n_blk = s // Q_BLOCK
    scale = dqk ** -0.5
    q_blocks = jnp.moveaxis(q.reshape(b, n_blk, Q_BLOCK, h, dqk), 1, 0)
    key_chunk = jnp.arange(s) // CHUNK

    def one_block(args):
        q_blk, blk = args
        scores = jnp.einsum('bqhd,bkhd->bhqk', q_blk, k).astype(jnp.float32) * scale
        query_chunk = (blk * Q_BLOCK + jnp.arange(Q_BLOCK)) // CHUNK
        mask = key_chunk[None, :] <= query_chunk[:, None]
        probs = jax.nn.softmax(jnp.where(mask, scores, -jnp.inf), axis=-1)
        return jnp.einsum('bhqk,bkhd->bqhd', probs.astype(v.dtype), v)

    out = lax.map(one_block, (q_blocks, jnp.arange(n_blk)))
    return jnp.moveaxis(out, 0, 1).reshape(b, s, h, v.shape[-1])


def mla_branch(q_lat, kv_lat, k_pe, cos, sin, q_norm_w, w_uq, kv_norm_w, w_ukv):
    b, s, _ = q_lat.shape
    q = (rms_norm(q_lat, q_norm_w) @ w_uq).reshape(b, s, MLA_HEADS, MLA_NOPE + MLA_ROPE)
    q_nope, q_pe = jnp.split(q, [MLA_NOPE], axis=-1)
    q_pe = apply_rope(q_pe, cos[:, :, None, :], sin[:, :, None, :])
    kv = (rms_norm(kv_lat, kv_norm_w) @ w_ukv).reshape(b, s, MLA_HEADS, MLA_NOPE + MLA_V)
    k_nope, v = jnp.split(kv, [MLA_NOPE], axis=-1)
    k_pe = apply_rope(k_pe, cos, sin)
    k_pe = jnp.broadcast_to(k_pe[:, :, None, :], (b, s, MLA_HEADS, MLA_ROPE))
    q = jnp.concatenate([q_nope, q_pe], axis=-1)
    k = jnp.concatenate([k_nope, k_pe], axis=-1)
    o = chunk_causal_attention(q, k, v)
    return o.reshape(b, s, MLA_WIDTH)


def causal_depthwise_conv(u, w, bias):
    out = lax.conv_general_dilated(
        u, w[:, None, :], window_strides=(1,), padding=[(w.shape[0] - 1, 0)],
        dimension_numbers=('NWC', 'WIO', 'NWC'), feature_group_count=u.shape[-1])
    return out + bias


def ssd_chunked(xs, dt, a, bm, cm):
    b, s, h, p = xs.shape
    g, n = bm.shape[2], bm.shape[3]
    r = h // g
    nc, L = s // CHUNK, CHUNK
    xdt = (xs * dt[..., None]).reshape(b, nc, L, g, r, p)
    a_cum = jnp.cumsum((dt * a).reshape(b, nc, L, g, r), axis=2)
    bg = bm.reshape(b, nc, L, g, n)
    cg = cm.reshape(b, nc, L, g, n)
    causal = jnp.tril(jnp.ones((L, L), dtype=bool))[None, None, :, :, None, None]
    seg = a_cum[:, :, :, None] - a_cum[:, :, None, :]
    decay = jnp.exp(jnp.where(causal, seg, -jnp.inf))
    cb = jnp.einsum('bctgn,bcsgn->bctsg', cg, bg)
    y_diag = jnp.einsum('bctsg,bctsgr,bcsgrp->bctgrp', cb, decay, xdt)
    decay_to_end = jnp.exp(a_cum[:, :, -1:] - a_cum)
    states = jnp.einsum('bcsgn,bcsgr,bcsgrp->bcgrpn', bg, decay_to_end, xdt)
    chunk_decay = jnp.exp(a_cum[:, :, -1])

    def carry_state(state, inp):
        st, dec = inp
        return state * dec[..., None, None] + st, state

    init = jnp.zeros((b, g, r, p, n), jnp.float32)
    _, prev = lax.scan(carry_state, init, (jnp.moveaxis(states, 1, 0), jnp.moveaxis(chunk_decay, 1, 0)))
    prev = jnp.moveaxis(prev, 0, 1)
    y_off = jnp.einsum('bctgn,bcgrpn,bctgr->bctgrp', cg, prev, jnp.exp(a_cum))
    return (y_diag + y_off).reshape(b, s, h, p)


def ssd_branch(z, xbc, dt_raw, conv_w, conv_b, dt_bias, a_log, d_skip, ssd_norm_w):
    f32 = jnp.float32
    b, s, _ = z.shape
    xbc = jax.nn.silu(causal_depthwise_conv(xbc, conv_w, conv_b))
    xs, bm, cm = split_cols(xbc, (SSD_WIDTH, SSD_GROUPS * SSD_STATE, SSD_GROUPS * SSD_STATE))
    xs = xs.reshape(b, s, SSD_HEADS, SSD_HEAD_DIM).astype(f32)
    bm = bm.reshape(b, s, SSD_GROUPS, SSD_STATE).astype(f32)
    cm = cm.reshape(b, s, SSD_GROUPS, SSD_STATE).astype(f32)
    dt = jax.nn.softplus((dt_raw + dt_bias).astype(f32))
    a = -jnp.exp(a_log.astype(f32))
    y = ssd_chunked(xs, dt, a, bm, cm) + d_skip.astype(f32)[:, None] * xs
    y = y.reshape(b, s, SSD_WIDTH).astype(z.dtype) * jax.nn.silu(z)
    return rms_norm(y, ssd_norm_w)


def token_shift(f, mu):
    prev = jnp.pad(f, ((0, 0), (1, 0), (0, 0)))[:, :-1]
    return f + (prev - f) * mu


def wkv7_scan(r, w, k, v, a, bb):
    def step(state, inp):
        r_t, w_t, k_t, v_t, a_t, b_t = inp
        sa = jnp.einsum('bhij,bhj->bhi', state, a_t)
        state = (state * w_t[:, :, None, :] + sa[..., None] * b_t[:, :, None, :]
                 + v_t[..., None] * k_t[:, :, None, :])
        return state, jnp.einsum('bhij,bhj->bhi', state, r_t)

    bsz, s, h, n = r.shape
    init = jnp.zeros((bsz, h, n, n), jnp.float32)
    xs = tuple(jnp.moveaxis(t, 1, 0) for t in (r, w, k, v, a, bb))
    _, y = lax.scan(step, init, xs)
    return jnp.moveaxis(y, 0, 1)


def rwkv7_branch(r, k, v, w_lo, a_lo, mu_rkv, mu_w, mu_a, w0, w_lora_b, a0, a_lora_b,
                 k_k, k_a, r_k, lnx_w, lnx_b):
    f32 = jnp.float32
    b, s, _ = r.shape
    out_dtype = r.dtype
    r = token_shift(r, mu_rkv[0])
    k = token_shift(k, mu_rkv[1])
    v = token_shift(v, mu_rkv[2])
    w_lo = token_shift(w_lo, mu_w)
    a_lo = token_shift(a_lo, mu_a)
    w = jnp.exp(-DECAY_SCALE * jax.nn.sigmoid((w0 + jnp.tanh(w_lo) @ w_lora_b).astype(f32)))
    a = jax.nn.sigmoid((a0 + a_lo @ a_lora_b).astype(f32))

    def heads(t):
        return t.astype(f32).reshape(t.shape[:-1] + (RWKV_HEADS, RWKV_HEAD_DIM))

    r, k, v, w, a = heads(r), heads(k), heads(v), heads(w), heads(a)
    kk = k * heads(k_k)
    kk = kk / jnp.maximum(jnp.sqrt(jnp.sum(kk * kk, axis=-1, keepdims=True)), 1e-12)
    k = k * (1.0 + (a - 1.0) * heads(k_a))
    y = wkv7_scan(r, w, k, v, -kk, kk * a)
    mean = jnp.mean(y, axis=-1, keepdims=True)
    var = jnp.mean(jnp.square(y - mean), axis=-1, keepdims=True)
    y = (y - mean) * lax.rsqrt(var + GN_EPS) * heads(lnx_w) + heads(lnx_b)
    y = y + jnp.sum(r * k * r_k.astype(f32), axis=-1, keepdims=True) * v
    return y.reshape(b, s, RWKV_WIDTH).astype(out_dtype)


def setup_inputs(seed: int = 0) -> dict:
    key = jax.random.key(seed)
    ks = list(jax.random.split(key, 40))
    f32 = jnp.float32

    def normal(shape, scale):
        return scale * jax.random.normal(ks.pop(), shape, f32)

    def gain(shape):
        return 1.0 + 0.02 * jax.random.normal(ks.pop(), shape, f32)

    def uniform(shape, lo, hi):
        return jax.random.uniform(ks.pop(), shape, f32, lo, hi)

    x = normal((BATCH, SEQ, D_MODEL), 1.0)
    c = normal((BATCH, D_MODEL), 1.0)
    offsets = jax.random.randint(ks.pop(), (BATCH, 1), 0, 4096, dtype=jnp.int32)
    positions = jnp.arange(SEQ, dtype=jnp.int32)[None, :] + offsets
    dt0 = jnp.exp(uniform((DEPTH, SSD_HEADS), math.log(1e-3), math.log(1e-1)))
    return {
        'x': x,
        'c': c,
        'positions': positions,
        'ada_w': normal((DEPTH, D_MODEL, 3 * D_MODEL), 0.5 * D_MODEL ** -0.5),
        'ada_b': normal((DEPTH, 3 * D_MODEL), 0.02),
        'norm_w': gain((DEPTH, D_MODEL)),
        'w_in': normal((DEPTH, D_MODEL, D_IN), D_MODEL ** -0.5),
        'q_norm_w': gain((DEPTH, MLA_Q_RANK)),
        'w_uq': normal((DEPTH, MLA_Q_RANK, MLA_HEADS * (MLA_NOPE + MLA_ROPE)), MLA_Q_RANK ** -0.5),
        'kv_norm_w': gain((DEPTH, MLA_KV_RANK)),
        'w_ukv': normal((DEPTH, MLA_KV_RANK, MLA_HEADS * (MLA_NOPE + MLA_V)), MLA_KV_RANK ** -0.5),
        'conv_w': normal((DEPTH, SSD_CONV, SSD_XBC), SSD_CONV ** -0.5),
        'conv_b': normal((DEPTH, SSD_XBC), 0.02),
        'dt_bias': dt0 + jnp.log(-jnp.expm1(-dt0)),
        'a_log': jnp.log(uniform((DEPTH, SSD_HEADS), 1.0, 16.0)),
        'd_skip': 1.0 + normal((DEPTH, SSD_HEADS), 0.1),
        'ssd_norm_w': gain((DEPTH, SSD_WIDTH)),
        'mu_rkv': uniform((DEPTH, 3, RWKV_WIDTH), 0.0, 1.0),
        'mu_w': uniform((DEPTH, DECAY_LORA), 0.0, 1.0),
        'mu_a': uniform((DEPTH, ICLR_LORA), 0.0, 1.0),
        'w0': uniform((DEPTH, RWKV_WIDTH), -4.0, 1.0),
        'w_lora_b': normal((DEPTH, DECAY_LORA, RWKV_WIDTH), 0.1),
        'a0': normal((DEPTH, RWKV_WIDTH), 0.5),
        'a_lora_b': normal((DEPTH, ICLR_LORA, RWKV_WIDTH), 0.5 * ICLR_LORA ** -0.5),
        'k_k': 0.85 + normal((DEPTH, RWKV_WIDTH), 0.05),
        'k_a': 1.0 + normal((DEPTH, RWKV_WIDTH), 0.05),
        'r_k': normal((DEPTH, RWKV_HEADS, RWKV_HEAD_DIM), 0.1),
        'lnx_w': gain((DEPTH, RWKV_WIDTH)),
        'lnx_b': normal((DEPTH, RWKV_WIDTH), 0.02),
        'w_out': normal((DEPTH, D_MIX, D_MODEL), D_MIX ** -0.5),
        'final_norm_w': gain((D_MODEL,)),
    }


def reference(x, c, positions, ada_w, ada_b, norm_w, w_in, q_norm_w, w_uq, kv_norm_w, w_ukv,
              conv_w, conv_b, dt_bias, a_log, d_skip, ssd_norm_w, mu_rkv, mu_w, mu_a, w0,
              w_lora_b, a0, a_lora_b, k_k, k_a, r_k, lnx_w, lnx_b, w_out, final_norm_w):
    cos, sin = rope_angles(positions, MLA_ROPE)
    c_act = jax.nn.silu(c)
    for l in range(DEPTH):
        mod = c_act @ ada_w[l] + ada_b[l]
        shift, scale, gate = jnp.split(mod[:, None, :], 3, axis=-1)
        h = rms_norm(x, norm_w[l]) * (1.0 + scale) + shift
        (q_lat, kv_lat, k_pe, g_mla, z, xbc, dt_raw,
         r, k, v, w_lo, a_lo, g_rwkv) = split_cols(h @ w_in[l], IN_SPLIT_SIZES)
        y_mla = mla_branch(q_lat, kv_lat, k_pe, cos, sin, q_norm_w[l], w_uq[l],
                           kv_norm_w[l], w_ukv[l]) * jax.nn.silu(g_mla)
        y_ssd = ssd_branch(z, xbc, dt_raw, conv_w[l], conv_b[l], dt_bias[l], a_log[l],
                           d_skip[l], ssd_norm_w[l])
        y_rwkv = rwkv7_branch(r, k, v, w_lo, a_lo, mu_rkv[l], mu_w[l], mu_a[l], w0[l],
                              w_lora_b[l], a0[l], a_lora_b[l], k_k[l], k_a[l], r_k[l],
                              lnx_w[l], lnx_b[l]) * jax.nn.silu(g_rwkv)
        y = jnp.concatenate([y_mla, y_ssd, y_rwkv], axis=-1)
        x = x + gate * (y @ w_out[l])
    return rms_norm(x, final_norm_w)
```

```cpp
#include <hip/hip_runtime.h>
#include <hip/hip_cooperative_groups.h>
#include <cstdio>
#include <cstdint>
namespace cg = cooperative_groups;

#define LAS __attribute__((address_space(3)))
#define GAS __attribute__((address_space(1)))
typedef unsigned short bf16_t;
typedef short bf16x8 __attribute__((ext_vector_type(8)));
typedef float f32x4 __attribute__((ext_vector_type(4)));
typedef float f32x2 __attribute__((ext_vector_type(2)));
typedef float f32x16 __attribute__((ext_vector_type(16)));
typedef unsigned u32x4 __attribute__((ext_vector_type(4)));
typedef unsigned u32x2 __attribute__((ext_vector_type(2)));
typedef short v4i16_t __attribute__((ext_vector_type(4)));

#ifndef MK_PER_PHASE
#define MK_PER_PHASE 0
#endif

namespace pg8 {
constexpr int BM = 256, BK = 64, HALF = 128, HTB = HALF * BK * 2, STAGE_BYTES = 8 * HTB, NXCD = 8, WGM = 8;
__host__ __device__ __forceinline__ int lds_byte(int r, int c) { const int st = (r >> 4) * 2 + (c >> 5), rr = r & 15, cc = c & 31, ob = rr * 64 + cc * 2; return st * 1024 + (ob ^ (((ob >> 9) & 1) << 5)); }
__host__ __device__ __forceinline__ void stage_rc(int b, int& R, int& C) { const int st = b / 1024, sb = b % 1024, swz = sb ^ (((sb >> 9) & 1) << 5); R = (st >> 1) * 16 + swz / 64; C = (st & 1) * 32 + (swz % 64) / 2; }
__host__ __device__ __forceinline__ int perm32(int rho) { const int n = rho >> 4, i = rho & 15; return 8 * (i >> 2) + 4 * n + (i & 3); }
struct Unit { int pm, pn; };
struct Gemm { const bf16_t* A; const bf16_t* Bt; int M, N, K, lda, ldb; };
struct StaticOrder {
    int nM, nN, nwg, G, c;
    __host__ __device__ void init(int M, int N, int G_, int c_) { nM = M / BM; nN = N / BM; nwg = nM * nN; G = G_; c = c_; }
    __host__ __device__ bool next(int i, Unit& u) const {
        const long L = (long)i * G + c; if (L >= nwg) return false;
        int wgid = (int)L; { const int q = nwg / NXCD, r = nwg % NXCD, xcd = wgid % NXCD, off = wgid / NXCD; wgid = (xcd < r ? xcd * (q + 1) : r * (q + 1) + (xcd - r) * q) + off; }
        const int nig = WGM * nN, gid = wgid / nig, fm = gid * WGM, gsz = (nM - fm) < WGM ? (nM - fm) : WGM;
        u.pm = fm + ((wgid % nig) % gsz); u.pn = (wgid % nig) / gsz; return true;
    }
};
template <class Epi, class Sched, bool ALIGN_EPI, bool SP2>
__device__ __forceinline__ void gemm_phase(LAS unsigned char* lds, int wave_id, const Gemm g, const Sched& S, const Epi& E) {
    int lane = (int)__builtin_amdgcn_mbcnt_hi(~0u, __builtin_amdgcn_mbcnt_lo(~0u, 0u)); asm volatile("" : "+v"(lane));
    const int wid = wave_id, tid = wid * 64 + lane, wr = wid >> 2, wc = wid & 3, fr = lane & 15, fq = lane >> 4;
    const int K = g.K, nt = K / BK;
    unsigned voffA[2], voffB[2];
#pragma unroll
    for (int i = 0; i < 2; ++i) { int R, C; stage_rc(tid * 16 + i * 8192, R, C); const int Rb = (R & ~31) + perm32(R & 31);
        voffA[i] = (unsigned)(R * g.lda + C) * 2u; voffB[i] = (unsigned)(Rb * g.ldb + C) * 2u; }
    const size_t kstep = (size_t)(BK * 2);
    const size_t hstepA = (size_t)HALF * g.lda * 2, hstepB = (size_t)HALF * g.ldb * 2;
    const size_t tstepA = 2 * hstepA, tstepB = 2 * hstepB;
    const unsigned ldsw = (unsigned)wid * 1024u, lds0 = (unsigned)(uintptr_t)lds;
    const int aoff = lds_byte(wr * 64 + fr, fq * 8), boff = lds_byte(wc * 32 + fr, fq * 8);
#define PG8_SA(b, h) (((b) * 2 + (h)) * HTB)
#define PG8_SB(b, h) ((4 + (b) * 2 + (h)) * HTB)
#define PG8_STAGE(bufoff, gbase, voff) do { _Pragma("unroll") for (int _i = 0; _i < 2; ++_i) { unsigned keep_; \
        asm volatile("s_mov_b32 %0, m0\n\ts_mov_b32 m0, %3\n\ts_nop 0\n\tglobal_load_lds_dwordx4 %1, %2\n\ts_mov_b32 m0, %0" : "=&s"(keep_) : "v"((voff)[_i]), "s"((const char*)(gbase)), "s"(lds0 + (unsigned)(bufoff) + ldsw + (unsigned)(_i * 8192)) : "memory"); } } while (0)
#define PG8_LDA(dst, b, h) do { _Pragma("unroll") for (int m = 0; m < 4; ++m) _Pragma("unroll") for (int k = 0; k < 2; ++k) dst[m][k] = *(const LAS bf16x8*)(lds + PG8_SA(b, h) + aoff + m * 2048 + k * 1024); } while (0)
#define PG8_LDB(dst, b, h) do { _Pragma("unroll") for (int n = 0; n < 2; ++n) _Pragma("unroll") for (int k = 0; k < 2; ++k) dst[n][k] = *(const LAS bf16x8*)(lds + PG8_SB(b, h) + boff + n * 2048 + k * 1024); } while (0)
#define PG8_MMA(ai, bj, At, Bt) do { __builtin_amdgcn_s_setprio(1); _Pragma("unroll") for (int m = 0; m < 4; ++m) _Pragma("unroll") for (int n = 0; n < 2; ++n) _Pragma("unroll") for (int k = 0; k < 2; ++k) \
        acc[ai][bj][m][n] = __builtin_amdgcn_mfma_f32_16x16x32_bf16(Bt[n][k], At[m][k], acc[ai][bj][m][n], 0, 0, 0); __builtin_amdgcn_s_setprio(0); } while (0)
#define PG8_WAIT_V(n) asm volatile("s_waitcnt vmcnt(" #n ")" ::: "memory")
#define PG8_WAIT_L(n) asm volatile("s_waitcnt lgkmcnt(" #n ")" ::: "memory")
#define PG8_BAR __builtin_amdgcn_s_barrier()
#define PG8_SCHED __builtin_amdgcn_sched_barrier(0)
    Unit cur, nxt; int ui = 0;
    if (!S.next(0, cur)) return;
    f32x4 acc[2][2][4][2];
#pragma unroll
    for (int a = 0; a < 2; ++a)
#pragma unroll
        for (int b = 0; b < 2; ++b)
#pragma unroll
            for (int m = 0; m < 4; ++m)
#pragma unroll
                for (int n = 0; n < 2; ++n) acc[a][b][m][n] = (f32x4){0.f, 0.f, 0.f, 0.f};
    bf16x8 At[4][2], B0[2][2], B1[2][2];
    const char* cA = (const char*)g.A + (size_t)cur.pm * tstepA; const char* cB = (const char*)g.Bt + (size_t)cur.pn * tstepB;
    if constexpr (SP2) {
        PG8_STAGE(PG8_SB(0, 0), cB, voffB); PG8_STAGE(PG8_SB(0, 1), cB + hstepB, voffB); PG8_STAGE(PG8_SA(0, 0), cA, voffA); PG8_STAGE(PG8_SA(0, 1), cA + hstepA, voffA);
        if (wr == 1) PG8_BAR;
        PG8_WAIT_V(2); PG8_BAR;
        PG8_STAGE(PG8_SB(1, 0), cB + kstep, voffB); PG8_STAGE(PG8_SA(1, 0), cA + kstep, voffA); PG8_STAGE(PG8_SB(1, 1), cB + hstepB + kstep, voffB);
        PG8_WAIT_V(6); PG8_BAR;
    } else {
        PG8_STAGE(PG8_SB(0, 0), cB, voffB); PG8_STAGE(PG8_SA(0, 0), cA, voffA); PG8_STAGE(PG8_SB(0, 1), cB + hstepB, voffB); PG8_STAGE(PG8_SA(0, 1), cA + hstepA, voffA);
        if (wr == 1) PG8_BAR;
        PG8_WAIT_V(4); PG8_BAR;
        PG8_STAGE(PG8_SB(1, 0), cB + kstep, voffB); PG8_STAGE(PG8_SA(1, 0), cA + kstep, voffA); PG8_STAGE(PG8_SB(1, 1), cB + hstepB + kstep, voffB);
        PG8_WAIT_V(6); PG8_BAR;
    }
    for (;;) {
        const bool has_next = S.next(ui + 1, nxt);
        const char* nA = has_next ? (const char*)g.A + (size_t)nxt.pm * tstepA : cA; const char* nB = has_next ? (const char*)g.Bt + (size_t)nxt.pn * tstepB : cB;
        for (int t = 0; t < nt; t += 2) {
            const bool last = (t == nt - 2);
            const char* a1 = cA + (size_t)(t + 1) * kstep;
            const char* a2 = last ? nA : cA + (size_t)(t + 2) * kstep; const char* b2 = last ? nB : cB + (size_t)(t + 2) * kstep;
            const char* a3 = a2 + kstep; const char* b3 = b2 + kstep;
            if constexpr (SP2) {
            PG8_LDB(B0, 0, 0); PG8_LDB(B1, 0, 1); PG8_SCHED; PG8_LDA(At, 0, 0); PG8_STAGE(PG8_SA(1, 1), a1 + hstepA, voffA);
            PG8_WAIT_V(8); PG8_WAIT_L(0); PG8_BAR; PG8_MMA(0, 0, At, B0); PG8_MMA(0, 1, At, B1); PG8_BAR; PG8_SCHED;
            PG8_LDA(At, 0, 1); PG8_STAGE(PG8_SB(0, 0), b2, voffB); PG8_STAGE(PG8_SB(0, 1), b2 + hstepB, voffB); PG8_STAGE(PG8_SA(0, 0), a2, voffA);
            PG8_WAIT_V(8); PG8_WAIT_L(0); PG8_BAR; PG8_MMA(1, 0, At, B0); PG8_MMA(1, 1, At, B1); PG8_BAR; PG8_SCHED;
            PG8_LDB(B0, 1, 0); PG8_LDB(B1, 1, 1); PG8_SCHED; PG8_LDA(At, 1, 0); PG8_STAGE(PG8_SA(0, 1), a2 + hstepA, voffA);
            PG8_WAIT_V(8); PG8_WAIT_L(0); PG8_BAR; PG8_MMA(0, 0, At, B0); PG8_MMA(0, 1, At, B1); PG8_BAR; PG8_SCHED;
            PG8_LDA(At, 1, 1); PG8_STAGE(PG8_SB(1, 0), b3, voffB); PG8_STAGE(PG8_SB(1, 1), b3 + hstepB, voffB); PG8_STAGE(PG8_SA(1, 0), a3, voffA);
            PG8_WAIT_V(8); PG8_WAIT_L(0); PG8_BAR; PG8_MMA(1, 0, At, B0); PG8_MMA(1, 1, At, B1); PG8_BAR; PG8_SCHED;
            } else {
            PG8_LDB(B0, 0, 0); PG8_SCHED; PG8_LDA(At, 0, 0); PG8_STAGE(PG8_SA(1, 1), a1 + hstepA, voffA);
            PG8_WAIT_L(8); PG8_BAR; PG8_WAIT_L(0); PG8_MMA(0, 0, At, B0); PG8_BAR; PG8_SCHED;
            PG8_LDB(B1, 0, 1); PG8_STAGE(PG8_SB(0, 0), b2, voffB);
            PG8_BAR; PG8_WAIT_L(0); PG8_MMA(0, 1, At, B1); PG8_BAR;
            PG8_LDA(At, 0, 1); PG8_STAGE(PG8_SA(0, 0), a2, voffA);
            PG8_BAR; PG8_WAIT_L(0); PG8_MMA(1, 0, At, B0); PG8_BAR; PG8_SCHED;
            PG8_STAGE(PG8_SB(0, 1), b2 + hstepB, voffB);
            PG8_WAIT_V(6); PG8_BAR; PG8_MMA(1, 1, At, B1); PG8_BAR;
            PG8_LDB(B0, 1, 0); PG8_SCHED; PG8_LDA(At, 1, 0); PG8_STAGE(PG8_SA(0, 1), a2 + hstepA, voffA);
            PG8_WAIT_L(8); PG8_BAR; PG8_WAIT_L(0); PG8_MMA(0, 0, At, B0); PG8_BAR; PG8_SCHED;
            PG8_LDB(B1, 1, 1); PG8_STAGE(PG8_SB(1, 0), b3, voffB);
            PG8_BAR; PG8_WAIT_L(0); PG8_MMA(0, 1, At, B1); PG8_BAR;
            PG8_LDA(At, 1, 1); PG8_STAGE(PG8_SA(1, 0), a3, voffA);
            PG8_BAR; PG8_WAIT_L(0); PG8_MMA(1, 0, At, B0); PG8_BAR; PG8_SCHED;
            PG8_STAGE(PG8_SB(1, 1), b3 + hstepB, voffB);
            PG8_WAIT_V(6); PG8_BAR; PG8_MMA(1, 1, At, B1); PG8_BAR;
            }
        }
        if constexpr (ALIGN_EPI) { if (wr == 0) PG8_BAR; }
        E(acc, cur, wr, wc, fr, fq);
        if (!has_next) break;
#pragma unroll
        for (int a = 0; a < 2; ++a)
#pragma unroll
            for (int b = 0; b < 2; ++b)
#pragma unroll
                for (int m = 0; m < 4; ++m)
#pragma unroll
                    for (int n = 0; n < 2; ++n) acc[a][b][m][n] = (f32x4){0.f, 0.f, 0.f, 0.f};
        cur = nxt; cA = nA; cB = nB; ++ui;
        if constexpr (ALIGN_EPI) { if (wr == 1) PG8_BAR; }
    }
    PG8_WAIT_V(0);
    if constexpr (!ALIGN_EPI) { if (wr == 0) PG8_BAR; }
    PG8_BAR;
#undef PG8_SA
#undef PG8_SB
#undef PG8_STAGE
#undef PG8_LDA
#undef PG8_LDB
#undef PG8_MMA
#undef PG8_WAIT_V
#undef PG8_WAIT_L
#undef PG8_BAR
#undef PG8_SCHED
}
}

constexpr int NT = 16384, SEQ = 8192, DM = 1024, DIN = 4680, NIN = 4864, NCHK = 256, NWAVES = 8, NTHR = 512;
constexpr float EPS = 1e-6f, GN_EPS = 64e-5f, DECAY_SCALE = 0.606531f;
constexpr float QSCALE = 0.07216878364870322f * 1.4426950408889634f;
constexpr size_t MiB = 1u << 20;
constexpr size_t WS_CTL = 0, CTL_BYTES = 1 * MiB;
constexpr size_t CTL_MOD = 65536;
constexpr size_t CTL_SSQ = 131072;
constexpr size_t WS_WIN = 1 * MiB;
constexpr size_t WS_CB = WS_WIN, WS_ECUM = WS_WIN + 8 * MiB, WS_CDEC = WS_ECUM + 512 * 1024;
constexpr size_t WS_WQ = 10 * MiB + 512 * 1024;
constexpr size_t WS_WUV = 11 * MiB;
constexpr size_t WS_WLW = 11 * MiB + 512 * 1024;
constexpr size_t WS_WLA = WS_WLW + 65536;
constexpr size_t WS_WOUT = 12 * MiB;
constexpr size_t WS_XN = 15 * MiB;
constexpr size_t WS_TT = WS_XN, WS_QE = WS_XN + 16 * MiB;
constexpr size_t WS_QLAT = 47 * MiB, WS_KVL = 55 * MiB;
constexpr size_t WS_OL = WS_QLAT;
constexpr size_t WS_GATES = 63 * MiB;
constexpr size_t WS_XBC = 111 * MiB;
constexpr size_t WS_R = 143 * MiB, WS_K = 159 * MiB, WS_V = 175 * MiB;
constexpr size_t WS_F = 191 * MiB;
constexpr size_t WS_Q = 200 * MiB;
constexpr size_t WS_KVB = 224 * MiB;
constexpr size_t WS_YD = 230 * MiB;
constexpr size_t WS_ROPE = 246 * MiB;
constexpr size_t WS_HX = 250 * MiB;
constexpr size_t WS_HRKV = WS_HX + 1536 * 1024;
constexpr size_t WS_HF = WS_HRKV + 768 * 1024;
constexpr size_t WS_END = 253 * MiB;
constexpr int LDS_BYTES = 152 * 1024;

#define LDS_WAIT() asm volatile("s_waitcnt lgkmcnt(0)" ::: "memory")
__device__ __forceinline__ unsigned f2bf(float f) { unsigned u = __builtin_bit_cast(unsigned, f); return (u + 0x7fffu + ((u >> 16) & 1u)) >> 16; }
__device__ __forceinline__ unsigned pk2(float lo, float hi) { return f2bf(lo) | (f2bf(hi) << 16); }
__device__ __forceinline__ float bf2f(unsigned short b) { return __builtin_bit_cast(float, (unsigned)b << 16); }
__device__ __forceinline__ float bflo(unsigned w) { return __builtin_bit_cast(float, w << 16); }
__device__ __forceinline__ float bfhi(unsigned w) { return __builtin_bit_cast(float, w & 0xffff0000u); }
__device__ __forceinline__ float wave_sum(float v) {
#pragma unroll
    for (int o = 1; o < 64; o <<= 1) v += __shfl_xor(v, o);
    return v;
}
__device__ __forceinline__ float sigmoidf_(float x) { return 1.f / (1.f + __expf(-x)); }
__device__ __forceinline__ float siluf_(float x) { return x / (1.f + __expf(-x)); }
__device__ __forceinline__ int pi16(int n) { const int x = n & 15; return (n & ~15) | ((x >= 4 && x < 8) ? x + 4 : (x >= 8 && x < 12) ? x - 4 : x); }
__device__ __forceinline__ int sg32(int x) { return (x & ~31) | (16 * ((x >> 2) & 1) + 4 * ((x & 31) >> 3) + (x & 3)); }
__device__ __forceinline__ int crow(int r, int hi) { return (r & 3) + 8 * (r >> 2) + 4 * hi; }

template <int K> __device__ __forceinline__ f32x4 mma_tile(const LAS bf16_t* A, int lda, const LAS bf16_t* Bt, int ldb, int lane) {
    f32x4 acc = {0.f, 0.f, 0.f, 0.f};
    const LAS bf16_t* ap = A + (lane & 15) * lda + (lane >> 4) * 8;
    const LAS bf16_t* bp = Bt + (lane & 15) * ldb + (lane >> 4) * 8;
#pragma unroll
    for (int k = 0; k < K; k += 32) {
        const bf16x8 a = *(const LAS bf16x8*)(ap + k), b = *(const LAS bf16x8*)(bp + k);
        acc = __builtin_amdgcn_mfma_f32_16x16x32_bf16(a, b, acc, 0, 0, 0);
    }
    return acc;
}

struct Args {
    const float* in[31]; float* out; unsigned char* ws; int ph_lo, ph_hi;
};
struct Ctx {
    LAS unsigned char* lds; int tid, lane, wave, G, bid;
    unsigned char* ws; float* out;
    const float* const* in;
};
__device__ __forceinline__ const float* ldin(const float* const* in, int i) { asm volatile("" : "+s"(i)); return in[i]; }
#define INP(i) ldin(F.in, i)
__device__ __forceinline__ int fresh_lane() { int l_ = (int)__builtin_amdgcn_mbcnt_hi(~0u, __builtin_amdgcn_mbcnt_lo(~0u, 0u)); asm volatile("" : "+v"(l_)); return l_; }
enum { I_X = 0, I_C, I_POS, I_ADAW, I_ADAB, I_NORMW, I_WIN, I_QNW, I_WUQ, I_KVNW, I_WUKV, I_CONVW, I_CONVB, I_DTB, I_ALOG, I_DSKIP, I_SSDNW,
       I_MURKV, I_MUW, I_MUA, I_W0, I_WLB, I_A0, I_ALB, I_KK, I_KA, I_RK, I_LNXW, I_LNXB, I_WOUT, I_FNW };

__device__ __forceinline__ int win_src_col(int n) {
    if (n < 448) return n;
    if (n < 512) return -1;
    if (n < 1024) return 448 + (n - 512);
    if (n < 1536) return 960 + (n - 1024);
    if (n < 2560) return 1472 + (n - 1536);
    if (n < 3072) return 2504 + (n - 2560);
    if (n < 3584) return 3016 + (n - 3072);
    if (n < 4096) return 3528 + (n - 3584);
    if (n < 4608) return 4168 + (n - 4096);
    if (n < 4672) return 4040 + (n - 4608);
    if (n < 4736) return 4104 + (n - 4672);
    if (n < 4744) return 2496 + (n - 4736);
    return -1;
}
template <class Src> __device__ __forceinline__ void transpose_item(const Src& src, bf16_t* WT, int ldw, LAS float* scr, int kb, int nb, int lane) {
    const int k0 = 64 * kb, n0 = 32 * nb;
#pragma unroll 8
    for (int i = 0; i < 32; ++i) { const int kk = 2 * i + (lane >> 5); scr[kk * 33 + (lane & 31)] = src(k0 + kk, n0 + (lane & 31)); }
    LDS_WAIT();
    const int c = lane & 7;
#pragma unroll
    for (int j = 0; j < 4; ++j) { const int n = (lane >> 3) + 8 * j; const LAS float* s = scr + (8 * c) * 33 + n;
        u32x4 o; o.x = pk2(s[0 * 33], s[1 * 33]); o.y = pk2(s[2 * 33], s[3 * 33]); o.z = pk2(s[4 * 33], s[5 * 33]); o.w = pk2(s[6 * 33], s[7 * 33]);
        *(u32x4*)(WT + (size_t)(n0 + n) * ldw + k0 + 8 * c) = o; }
    LDS_WAIT();
}
__device__ __forceinline__ void prep_weights(const Ctx& F, int l) {
    LAS float* scr = (LAS float*)(F.lds + F.wave * 8448);
    const int gw = F.bid * NWAVES + F.wave, NGW = F.G * NWAVES;
    const float* w_in = INP(I_WIN) + (size_t)l * DM * DIN;
    const float* w_out = INP(I_WOUT) + (size_t)l * 1536 * 1024;
    const float* wlb = INP(I_WLB) + (size_t)l * 64 * 512;
    const float* alb = INP(I_ALB) + (size_t)l * 64 * 512;
    bf16_t* WIN = (bf16_t*)(F.ws + WS_WIN); bf16_t* WOUT = (bf16_t*)(F.ws + WS_WOUT); bf16_t* WLW = (bf16_t*)(F.ws + WS_WLW); bf16_t* WLA = (bf16_t*)(F.ws + WS_WLA);
    constexpr int I_IN = 16 * (NIN / 32), I_OUT = 24 * 32, I_LW = 16, I_LA = 16, NITEMS = I_IN + I_OUT + I_LW + I_LA;
    for (int it = gw; it < NITEMS; it += NGW) {
        int r = it;
        if (r < I_IN) { const int kb = r / (NIN / 32), nb = r % (NIN / 32);
            transpose_item([&](int k, int n) { const int sc = win_src_col(n); return sc >= 0 ? w_in[(size_t)k * DIN + sc] : 0.f; }, WIN, 1024, scr, kb, nb, F.lane); continue; }
        r -= I_IN;
        if (r < I_OUT) { const int kb = r / 32, nb = r % 32;
            transpose_item([&](int k, int n) { return w_out[(size_t)k * 1024 + n]; }, WOUT, 1536, scr, kb, nb, F.lane); continue; }
        r -= I_OUT;
        if (r < I_LW) { transpose_item([&](int k, int n) { return wlb[k * 512 + n]; }, WLW, 64, scr, 0, r, F.lane); continue; }
        r -= I_LW;
        transpose_item([&](int k, int n) { return alb[k * 512 + n]; }, WLA, 64, scr, 0, r, F.lane);
    }
    const float* wuq = INP(I_WUQ) + (size_t)l * 256 * 768; const float* wukv = INP(I_WUKV) + (size_t)l * 128 * 1024; const float* qnw = INP(I_QNW) + l * 256;
    bf16_t* WQ = (bf16_t*)(F.ws + WS_WQ); bf16_t* WUV = (bf16_t*)(F.ws + WS_WUV);
    const int gt = F.bid * NTHR + F.tid, NGT = F.G * NTHR;
    for (int e = gt; e < 768 * 256; e += NGT) {
        const int n = e >> 8, k = e & 255, h = n / 192, idx = n % 192; float v;
        if (idx < 128) {
            const f32x4* a = (const f32x4*)(wuq + (size_t)k * 768 + h * 192); const f32x4* b = (const f32x4*)(wukv + (size_t)idx * 1024 + h * 256);
            float s = 0.f;
#pragma unroll 8
            for (int d = 0; d < 32; ++d) { const f32x4 x = a[d], y = b[d]; s += x.x * y.x + x.y * y.y + x.z * y.z + x.w * y.w; }
            v = s;
        } else v = wuq[(size_t)k * 768 + n];
        WQ[e] = (bf16_t)f2bf(v * qnw[k]);
    }
    for (int e = gt; e < 512 * 512; e += NGT) {
        const int n = e >> 9, k = e & 511, h = n >> 7, d = n & 127, h2 = k >> 7, c = k & 127;
        WUV[e] = (h == h2) ? (bf16_t)f2bf(wukv[(size_t)c * 1024 + h * 256 + 128 + d]) : (bf16_t)0;
    }
}
__device__ __forceinline__ void p0_prologue(const Ctx& F) {
    prep_weights(F, 0);
    const int gw = F.bid * NWAVES + F.wave, NGW = F.G * NWAVES;
    float* MOD = (float*)(F.ws + WS_CTL + CTL_MOD);
    for (int it = gw; it < 2 * 12 * 32; it += NGW) {
        const int l = it / 384, r = it % 384, cb = r / 32, ks = r % 32;
        const float* aw = INP(I_ADAW) + (size_t)l * DM * 3072 + (size_t)(ks * 32) * 3072 + cb * 256 + F.lane * 4;
        const float* cc = INP(I_C);
        f32x4 a0 = {0.f, 0.f, 0.f, 0.f}, a1 = a0;
#pragma unroll 8
        for (int k = 0; k < 32; ++k) { const f32x4 w = *(const f32x4*)(aw + (size_t)k * 3072); const float s0 = siluf_(cc[ks * 32 + k]), s1 = siluf_(cc[DM + ks * 32 + k]); a0 += w * s0; a1 += w * s1; }
        if (ks == 0) { const f32x4 bb = *(const f32x4*)(INP(I_ADAB) + l * 3072 + cb * 256 + F.lane * 4); a0 += bb; a1 += bb; }
        float* m0 = MOD + (size_t)(l * 2 + 0) * 3072 + cb * 256 + F.lane * 4; float* m1 = m0 + 3072;
#pragma unroll
        for (int j = 0; j < 4; ++j) { atomicAdd(m0 + j, a0[j]); atomicAdd(m1 + j, a1[j]); }
    }
    float* ROPE = (float*)(F.ws + WS_ROPE); const int* pos = (const int*)INP(I_POS);
    for (int e = F.bid * NTHR + F.tid; e < NT * 32; e += F.G * NTHR) {
        const int m = e >> 5, i = e & 31;
        const float invf = powf(10000.f, -(float)i / 32.f); const float ang = (float)pos[m] * invf;
        const double a = (double)ang; const double kq = __builtin_rint(a * 0.15915494309189535); const float rr = (float)(a - kq * 6.283185307179586);
        ROPE[(size_t)m * 64 + i] = cosf(rr); ROPE[(size_t)m * 64 + 32 + i] = sinf(rr);
    }
}
__device__ __forceinline__ void p1_norm(const Ctx& F, int l) {
    const float* xin = (l == 0) ? INP(I_X) : F.out;
    const float* nw = INP(I_NORMW) + l * DM; const float* MOD = (const float*)(F.ws + WS_CTL + CTL_MOD);
    bf16_t* XN = (bf16_t*)(F.ws + WS_XN);
    const int gw = F.bid * NWAVES + F.wave, NGW = F.G * NWAVES;
    for (int m = gw; m < NT; m += NGW) {
        const int b = m >> 13; const float* md = MOD + (size_t)(l * 2 + b) * 3072;
        const f32x4* xr = (const f32x4*)(xin + (size_t)m * DM) + F.lane;
        f32x4 v[4]; float s = 0.f;
#pragma unroll
        for (int j = 0; j < 4; ++j) { v[j] = xr[64 * j]; s += v[j].x * v[j].x + v[j].y * v[j].y + v[j].z * v[j].z + v[j].w * v[j].w; }
        const float rstd = 1.f / sqrtf(wave_sum(s) * (1.f / DM) + EPS);
        unsigned long long* o8 = (unsigned long long*)(XN + (size_t)m * DM) + F.lane;
#pragma unroll
        for (int j = 0; j < 4; ++j) { const int c0 = 4 * F.lane + 256 * j;
            const f32x4 w = *(const f32x4*)(nw + c0), sh = *(const f32x4*)(md + c0), sc = *(const f32x4*)(md + 1024 + c0);
            const f32x4 y = v[j] * rstd * w * (sc + 1.f) + sh;
            o8[64 * j] = (unsigned long long)pk2(y.x, y.y) | ((unsigned long long)pk2(y.z, y.w) << 32); }
    }
}
__device__ __forceinline__ u32x4 pack8(f32x4 a, f32x4 b) { u32x4 w; w.x = pk2(a[0], a[1]); w.y = pk2(a[2], a[3]); w.z = pk2(b[0], b[1]); w.w = pk2(b[2], b[3]); return w; }
struct EpiIn {
    unsigned char* ws; int l;
    __device__ __forceinline__ void operator()(const f32x4 (&acc)[2][2][4][2], const pg8::Unit& u, int wr, int wc, int fr, int fq) const {
        { int ln_ = (int)__builtin_amdgcn_mbcnt_hi(~0u, __builtin_amdgcn_mbcnt_lo(~0u, 0u)); asm volatile("" : "+v"(ln_)); fr = ln_ & 15; fq = ln_ >> 4; }
        const int pn = u.pn; size_t bo; int ld, c0;
        if (pn == 0) { bo = WS_QLAT; ld = 256; c0 = 0; } else if (pn == 1) { bo = WS_KVL; ld = 256; c0 = 0; }
        else if (pn < 4) { bo = WS_GATES; ld = 1536; c0 = (pn - 2) * 256; } else if (pn < 6) { bo = WS_GATES; ld = 1536; c0 = 512 + (pn - 4) * 256; }
        else if (pn < 10) { bo = WS_XBC; ld = 1024; c0 = (pn - 6) * 256; } else if (pn < 12) { bo = WS_R; ld = 512; c0 = (pn - 10) * 256; }
        else if (pn < 14) { bo = WS_K; ld = 512; c0 = (pn - 12) * 256; } else if (pn < 16) { bo = WS_V; ld = 512; c0 = (pn - 14) * 256; }
        else if (pn < 18) { bo = WS_GATES; ld = 1536; c0 = 1024 + (pn - 16) * 256; } else { bo = WS_F; ld = 144; c0 = 0; }
        bf16_t* base = (bf16_t*)(ws + bo); float* F = (float*)(ws + WS_F);
        float* ssq_q = (float*)(ws + WS_CTL + CTL_SSQ) + (size_t)(l * 2) * NT; float* ssq_kv = ssq_q + NT;
        const int row0 = u.pm * 256 + wr * 64 + fr, col0 = wc * 32 + 8 * fq;
        if (pn < 18) {
#pragma unroll
            for (int ai = 0; ai < 2; ++ai)
#pragma unroll
                for (int m = 0; m < 4; ++m) { const int row = row0 + ai * 128 + m * 16; bf16_t* rp = base + (size_t)row * ld + c0 + col0;
#pragma unroll
                    for (int bj = 0; bj < 2; ++bj) *(u32x4*)(rp + bj * 128) = pack8(acc[ai][bj][m][0], acc[ai][bj][m][1]);
                    if (pn < 2) { float s = 0.f;
#pragma unroll
                        for (int bj = 0; bj < 2; ++bj) if (pn == 0 || bj == 0) {
#pragma unroll
                            for (int n = 0; n < 2; ++n) { const f32x4 x = acc[ai][bj][m][n]; s += x[0] * x[0] + x[1] * x[1] + x[2] * x[2] + x[3] * x[3]; } }
                        s += __shfl_xor(s, 16); s += __shfl_xor(s, 32);
                        if (fq == 0) atomicAdd((pn == 0 ? ssq_q : ssq_kv) + row, s); } }
        } else {
#pragma unroll
            for (int ai = 0; ai < 2; ++ai)
#pragma unroll
                for (int m = 0; m < 4; ++m) { const int row = row0 + ai * 128 + m * 16;
#pragma unroll
                    for (int bj = 0; bj < 2; ++bj) { const int c = bj * 128 + col0; if (c < 136) { float* fp = F + (size_t)row * 144 + c; *(f32x4*)fp = acc[ai][bj][m][0]; *(f32x4*)(fp + 4) = acc[ai][bj][m][1]; } } }
        }
    }
};
struct EpiQ {
    unsigned char* ws; int l;
    __device__ __forceinline__ void operator()(const f32x4 (&acc)[2][2][4][2], const pg8::Unit& u, int wr, int wc, int fr, int fq) const {
        { int ln_ = (int)__builtin_amdgcn_mbcnt_hi(~0u, __builtin_amdgcn_mbcnt_lo(~0u, 0u)); asm volatile("" : "+v"(ln_)); fr = ln_ & 15; fq = ln_ >> 4; }
        bf16_t* Q = (bf16_t*)(ws + WS_Q); const float* ssq = (const float*)(ws + WS_CTL + CTL_SSQ) + (size_t)(l * 2) * NT;
        const int row0 = u.pm * 256 + wr * 64 + fr, c0 = u.pn * 256 + wc * 32 + 8 * fq;
#pragma unroll
        for (int ai = 0; ai < 2; ++ai)
#pragma unroll
            for (int m = 0; m < 4; ++m) { const int row = row0 + ai * 128 + m * 16; const float sc = QSCALE / sqrtf(ssq[row] * (1.f / 256.f) + EPS); bf16_t* qp = Q + (size_t)row * 768 + c0;
#pragma unroll
                for (int bj = 0; bj < 2; ++bj) *(u32x4*)(qp + bj * 128) = pack8(acc[ai][bj][m][0] * sc, acc[ai][bj][m][1] * sc); }
    }
};
struct EpiUV {
    bf16_t* gates;
    __device__ __forceinline__ void operator()(const f32x4 (&acc)[2][2][4][2], const pg8::Unit& u, int wr, int wc, int fr, int fq) const {
        { int ln_ = (int)__builtin_amdgcn_mbcnt_hi(~0u, __builtin_amdgcn_mbcnt_lo(~0u, 0u)); asm volatile("" : "+v"(ln_)); fr = ln_ & 15; fq = ln_ >> 4; }
        const int row0 = u.pm * 256 + wr * 64 + fr;
#pragma unroll
        for (int ai = 0; ai < 2; ++ai)
#pragma unroll
            for (int m = 0; m < 4; ++m) { asm volatile("" ::: "memory"); const int row = row0 + ai * 128 + m * 16;
#pragma unroll
                for (int bj = 0; bj < 2; ++bj) { const int c = u.pn * 256 + bj * 128 + wc * 32 + 8 * fq; u32x4* gp = (u32x4*)(gates + (size_t)row * 1536 + c); const u32x4 gw = *gp;
                    f32x4 v0 = acc[ai][bj][m][0], v1 = acc[ai][bj][m][1];
                    v0[0] *= siluf_(bflo(gw.x)); v0[1] *= siluf_(bfhi(gw.x)); v0[2] *= siluf_(bflo(gw.y)); v0[3] *= siluf_(bfhi(gw.y));
                    v1[0] *= siluf_(bflo(gw.z)); v1[1] *= siluf_(bfhi(gw.z)); v1[2] *= siluf_(bflo(gw.w)); v1[3] *= siluf_(bfhi(gw.w));
                    *gp = pack8(v0, v1); } }
    }
};
struct EpiOut {
    const float* xin; float* xout; const float* gate;
    __device__ __forceinline__ void operator()(const f32x4 (&acc)[2][2][4][2], const pg8::Unit& u, int wr, int wc, int fr, int fq) const {
        { int ln_ = (int)__builtin_amdgcn_mbcnt_hi(~0u, __builtin_amdgcn_mbcnt_lo(~0u, 0u)); asm volatile("" : "+v"(ln_)); fr = ln_ & 15; fq = ln_ >> 4; }
        const int row0 = u.pm * 256 + wr * 64 + fr;
#pragma unroll
        for (int bj = 0; bj < 2; ++bj) { const int c = u.pn * 256 + bj * 128 + wc * 32 + 8 * fq;
#pragma unroll
            for (int ai = 0; ai < 2; ++ai)
#pragma unroll
                for (int m = 0; m < 4; ++m) { const int row = row0 + ai * 128 + m * 16; const float* gp = gate + (size_t)(row >> 13) * 3072 + c;
                    const f32x4 g0 = *(const f32x4*)gp, g1 = *(const f32x4*)(gp + 4);
                    const size_t off = (size_t)row * DM + c; const f32x4 x0 = *(const f32x4*)(xin + off), x1 = *(const f32x4*)(xin + off + 4);
                    *(f32x4*)(xout + off) = x0 + g0 * acc[ai][bj][m][0]; *(f32x4*)(xout + off + 4) = x1 + g1 * acc[ai][bj][m][1]; } }
    }
};

__device__ __forceinline__ void p3a_extras(const Ctx& F, int l) {
    const int tid_ = F.wave * 64 + fresh_lane();
    const int gt = F.bid * NTHR + tid_, NGT = F.G * NTHR;
    const bf16_t* KVL = (const bf16_t*)(F.ws + WS_KVL); bf16_t* KVB = (bf16_t*)(F.ws + WS_KVB);
    const float* ssq = (const float*)(F.ws + WS_CTL + CTL_SSQ) + (size_t)(l * 2 + 1) * NT; const float* kvnw = INP(I_KVNW) + l * 128;
    const float* ROPE = (const float*)(F.ws + WS_ROPE);
    for (int e = gt; e < NT * 24; e += NGT) {
        const int m = e / 24, g = e % 24;
        if (g < 16) {
            const u32x4 w = *(const u32x4*)(KVL + (size_t)m * 256 + 8 * g); const float rs = 1.f / sqrtf(ssq[m] * (1.f / 128.f) + EPS);
            const f32x4 n0 = *(const f32x4*)(kvnw + 8 * g), n1 = *(const f32x4*)(kvnw + 8 * g + 4);
            u32x4 o; o.x = pk2(bflo(w.x) * rs * n0[0], bfhi(w.x) * rs * n0[1]); o.y = pk2(bflo(w.y) * rs * n0[2], bfhi(w.y) * rs * n0[3]);
            o.z = pk2(bflo(w.z) * rs * n1[0], bfhi(w.z) * rs * n1[1]); o.w = pk2(bflo(w.w) * rs * n1[2], bfhi(w.w) * rs * n1[3]);
            *(u32x4*)(KVB + (size_t)m * 192 + 8 * g) = o;
        } else {
            const int i0 = 4 * (g - 16);
            const u32x2 a = *(const u32x2*)(KVL + (size_t)m * 256 + 128 + i0), b = *(const u32x2*)(KVL + (size_t)m * 256 + 160 + i0);
            const f32x4 cs = *(const f32x4*)(ROPE + (size_t)m * 64 + i0), sn = *(const f32x4*)(ROPE + (size_t)m * 64 + 32 + i0);
            const f32x4 x1 = {bflo(a.x), bfhi(a.x), bflo(a.y), bfhi(a.y)}, x2 = {bflo(b.x), bfhi(b.x), bflo(b.y), bfhi(b.y)};
            const f32x4 o1 = x1 * cs - x2 * sn, o2 = x1 * sn + x2 * cs;
            u32x2 w1, w2; w1.x = pk2(o1[0], o1[1]); w1.y = pk2(o1[2], o1[3]); w2.x = pk2(o2[0], o2[1]); w2.y = pk2(o2[2], o2[3]);
            *(u32x2*)(KVB + (size_t)m * 192 + 128 + i0) = w1; *(u32x2*)(KVB + (size_t)m * 192 + 160 + i0) = w2;
        }
    }
    const u32x4* XBC = (const u32x4*)(F.ws + WS_XBC); u32x4* HX = (u32x4*)(F.ws + WS_HX);
    for (int e = gt; e < NCHK * 3 * 128; e += NGT) { const int c = e / 384, r = e % 384, j = r >> 7, p = r & 127; HX[e] = XBC[(size_t)(64 * c + 61 + j) * 128 + p]; }
    u32x4* HR = (u32x4*)(F.ws + WS_HRKV);
    for (int e = gt; e < 3 * NCHK * 64; e += NGT) { const int w = e / (NCHK * 64), r = e % (NCHK * 64), c = r >> 6, p = r & 63;
        const u32x4* src = (const u32x4*)(F.ws + (w == 0 ? WS_R : w == 1 ? WS_K : WS_V)); HR[e] = src[(size_t)(64 * c + 63) * 64 + p]; }
    const f32x4* FF = (const f32x4*)(F.ws + WS_F); f32x4* HF = (f32x4*)(F.ws + WS_HF);
    for (int e = gt; e < NCHK * 32; e += NGT) { const int c = e >> 5, p = e & 31; HF[e] = FF[(size_t)(64 * c + 63) * 36 + p]; }
}

__device__ __forceinline__ int ssd_win_col(int g, int o) { return o < 256 ? 256 * g + o : o < 384 ? 512 + 128 * g + (o - 256) : 768 + 128 * g + (o - 384); }
__device__ __forceinline__ void p3b_ssd(const Ctx& F, int l) {
    constexpr int SC_C = 0, SC_B = 17408, SC_BT = 34816, SC_XST = 53248, SC_CB = 90112, SC_G = 106752, SC_XSD = 115968, SC_DT = 125184, SC_AC = 127232;
    LAS bf16_t* Cg = (LAS bf16_t*)(F.lds + SC_C); LAS bf16_t* Bg = (LAS bf16_t*)(F.lds + SC_B); LAS bf16_t* BT = (LAS bf16_t*)(F.lds + SC_BT);
    LAS bf16_t* XST = (LAS bf16_t*)(F.lds + SC_XST); LAS float* CB = (LAS float*)(F.lds + SC_CB); LAS bf16_t* Gh = (LAS bf16_t*)(F.lds + SC_G);
    LAS bf16_t* XSD = (LAS bf16_t*)(F.lds + SC_XSD); LAS float* DT = (LAS float*)(F.lds + SC_DT); LAS float* AC = (LAS float*)(F.lds + SC_AC);
    bf16_t* XBC = (bf16_t*)(F.ws + WS_XBC); const bf16_t* HX = (const bf16_t*)(F.ws + WS_HX); const float* Ff = (const float*)(F.ws + WS_F);
    bf16_t* Cbuf = (bf16_t*)(F.ws + WS_CB); float* ECUM = (float*)(F.ws + WS_ECUM); float* CDEC = (float*)(F.ws + WS_CDEC); bf16_t* YD = (bf16_t*)(F.ws + WS_YD);
    const float* convw = INP(I_CONVW) + (size_t)l * 4 * 1024; const float* convb = INP(I_CONVB) + l * 1024;
    const float* dtb = INP(I_DTB) + l * 8; const float* alog = INP(I_ALOG) + l * 8; const float* dskip = INP(I_DSKIP) + l * 8;
    const int tid = F.tid, lane = F.lane, wave = F.wave;
    for (int c = F.bid; c < NCHK; c += F.G) {
        const int m0 = 64 * c; const bool first = (c & 127) == 0;
        if (wave == 0) {
            const int t = lane;
#pragma unroll
            for (int h = 0; h < 8; ++h) {
                const float raw = Ff[(size_t)(m0 + t) * 144 + 128 + h] + dtb[h];
                const float dt = raw > 20.f ? raw : log1pf(expf(raw));
                float v = dt * (-expf(alog[h]));
#pragma unroll
                for (int o = 1; o < 64; o <<= 1) { const float y = __shfl_up(v, o); if (lane >= o) v += y; }
                DT[t * 8 + h] = dt; AC[t * 8 + h] = v;
                const float ev = expf(v); ECUM[(size_t)(c * 8 + h) * 64 + sg32(t)] = ev; if (t == 63) CDEC[c * 8 + h] = ev;
            }
        }
        for (int g = 0; g < 2; ++g) {
            {
                const int col = ssd_win_col(g, tid);
                const float w0 = convw[col], w1 = convw[1024 + col], w2 = convw[2048 + col], w3 = convw[3072 + col], cb = convb[col];
                float h0 = 0.f, h1 = 0.f, h2 = 0.f;
                if (!first) { h0 = bf2f(HX[(size_t)((c - 1) * 3 + 0) * 1024 + col]); h1 = bf2f(HX[(size_t)((c - 1) * 3 + 1) * 1024 + col]); h2 = bf2f(HX[(size_t)((c - 1) * 3 + 2) * 1024 + col]); }
#pragma unroll 8
                for (int t = 0; t < 64; ++t) {
                    const float x = bf2f(XBC[(size_t)(m0 + t) * 1024 + col]);
                    const float u = w0 * h0 + w1 * h1 + w2 * h2 + w3 * x + cb; h0 = h1; h1 = h2; h2 = x;
                    const bf16_t bv = (bf16_t)f2bf(siluf_(u));
                    if (tid < 256) XST[tid * 72 + t] = bv;
                    else if (tid < 384) { const int n = tid - 256; Bg[t * 136 + n] = bv; BT[n * 72 + t] = bv; }
                    else { const int n = tid - 384; Cg[t * 136 + n] = bv; Cbuf[(size_t)(m0 + t) * 256 + g * 128 + pi16(n)] = bv; }
                }
            }
            __syncthreads();
#pragma unroll
            for (int i = 0; i < 2; ++i) { const int idx = 2 * wave + i, ti = idx >> 2, si = idx & 3;
                const f32x4 acc = mma_tile<128>(Cg + ti * 16 * 136, 136, Bg + si * 16 * 136, 136, lane);
#pragma unroll
                for (int r = 0; r < 4; ++r) CB[(ti * 16 + 4 * (lane >> 4) + r) * 65 + si * 16 + (lane & 15)] = acc[r]; }
            __syncthreads();
            for (int hl = 0; hl < 4; ++hl) {
                const int h = 4 * g + hl;
                {   const int t = tid >> 3, s0 = (tid & 7) * 8; const float at = AC[t * 8 + h], a63 = AC[63 * 8 + h];
                    float gv[8], xv[8]; const u32x4 xw = *(const LAS u32x4*)(XST + (64 * hl + t) * 72 + s0);
                    const float xf[8] = {bflo(xw.x), bfhi(xw.x), bflo(xw.y), bfhi(xw.y), bflo(xw.z), bfhi(xw.z), bflo(xw.w), bfhi(xw.w)};
#pragma unroll
                    for (int j = 0; j < 8; ++j) { const int s = s0 + j; const float as = AC[s * 8 + h], ds = DT[s * 8 + h];
                        gv[j] = (s <= t) ? CB[t * 65 + s] * expf(at - as) * ds : 0.f; xv[j] = xf[j] * ds * expf(a63 - as); }
                    u32x4 o; o.x = pk2(gv[0], gv[1]); o.y = pk2(gv[2], gv[3]); o.z = pk2(gv[4], gv[5]); o.w = pk2(gv[6], gv[7]); *(LAS u32x4*)(Gh + t * 72 + s0) = o;
                    o.x = pk2(xv[0], xv[1]); o.y = pk2(xv[2], xv[3]); o.z = pk2(xv[4], xv[5]); o.w = pk2(xv[6], xv[7]); *(LAS u32x4*)(XSD + t * 72 + s0) = o; }
                __syncthreads();
                const float dsk = dskip[h];
#pragma unroll
                for (int i = 0; i < 2; ++i) { const int idx = 2 * wave + i, ti = idx >> 2, pi = idx & 3;
                    const f32x4 acc = mma_tile<64>(Gh + ti * 16 * 72, 72, XST + (64 * hl + 16 * pi) * 72, 72, lane);
#pragma unroll
                    for (int r = 0; r < 4; ++r) { const int t = ti * 16 + 4 * (lane >> 4) + r, p = pi * 16 + (lane & 15);
                        const float y = acc[r] + dsk * bf2f(XST[(64 * hl + p) * 72 + t]); YD[(size_t)(m0 + t) * 512 + 64 * h + p] = (bf16_t)f2bf(y); } }
#pragma unroll
                for (int i = 0; i < 4; ++i) { const int idx = 4 * wave + i, pi = idx >> 3, ni = idx & 7;
                    const f32x4 acc = mma_tile<64>(XSD + pi * 16 * 72, 72, BT + ni * 16 * 72, 72, lane);
#pragma unroll
                    for (int r = 0; r < 4; ++r) { const int p = pi * 16 + 4 * (lane >> 4) + r, n = ni * 16 + (lane & 15);
                        const int f = hl * 8192 + p * 128 + sg32(n), row = f >> 9, col = ssd_win_col(g, f & 511);
                        XBC[(size_t)(m0 + row) * 1024 + col] = (bf16_t)f2bf(acc[r]); } }
                __syncthreads();
            }
        }
    }
}

__device__ __forceinline__ void p3c_rwkv(const Ctx& F, int l) {
    constexpr int M9 = 9216, O_TW = 0, O_AL = 9216, O_SL = 18432, O_MAB = O_SL + 12 * M9  , O_LWF = O_SL + 10 * M9  , O_ICF = O_LWF + 16640, O_WL = O_MAB + 16640  , O_SCR = O_WL + 256;
    static_assert(O_ICF + 16640 <= O_MAB + 16640 && O_SCR + 4224 <= LDS_BYTES, "rwkv lds map");
#define LB() ({ LAS unsigned char* p_ = F.lds; asm volatile("" : "+s"(p_)); p_; })
#define SLOT(i) ((LAS bf16_t*)(L + O_SL + (i) * M9))
#define TW ((LAS bf16_t*)(L + O_TW))
#define AL ((LAS bf16_t*)(L + O_AL))
#define AT SLOT(0)
#define ATt SLOT(1)
#define BTl SLOT(2)
#define KTl SLOT(3)
#define RT SLOT(4)
#define BHt SLOT(5)
#define KH SLOT(6)
#define VT SLOT(7)
#define MI SLOT(8)
#define MakT SLOT(9)
#define Rb SLOT(10)
#define Rk SLOT(11)
#define Attn SLOT(0)
#define KEt SLOT(1)
#define X1t SLOT(2)
#define X2t SLOT(3)
#define S8 SLOT(8)
#define S9 SLOT(9)
#define MAB ((LAS float*)(L + O_MAB))
#define LWf ((LAS float*)(L + O_LWF))
#define ICf ((LAS float*)(L + O_ICF))
#define WL ((LAS float*)(L + O_WL))
#define SCR ((LAS float*)(L + O_SCR))
    const int tid = F.tid, lane = F.lane, wave = F.wave;
    for (int c = F.bid; c < NCHK; c += F.G) {
        const int m0 = 64 * c; const bool first = (c & 127) == 0;
        {
            LAS unsigned char* L = LB();
            const int t = tid >> 3, q0 = (tid & 7) * 8;
            const float* Ff = (const float*)(F.ws + WS_F); const float* HF = (const float*)(F.ws + WS_HF); const float* mu_w = INP(I_MUW) + l * 64; const float* mu_a = INP(I_MUA) + l * 64;
            float cw[8], pw[8], ca[8], pa[8];
            const float* cur = Ff + (size_t)(m0 + t) * 144; const float* prv = (t > 0) ? cur - 144 : HF + (size_t)(c - 1) * 128;
#pragma unroll
            for (int j = 0; j < 8; ++j) { cw[j] = cur[q0 + j]; ca[j] = cur[64 + q0 + j]; }
            if (t > 0) {
#pragma unroll
                for (int j = 0; j < 8; ++j) { pw[j] = prv[q0 + j]; pa[j] = prv[64 + q0 + j]; }
            } else if (!first) {
#pragma unroll
                for (int j = 0; j < 8; ++j) { pw[j] = prv[q0 + j]; pa[j] = prv[64 + q0 + j]; }
            } else {
#pragma unroll
                for (int j = 0; j < 8; ++j) { pw[j] = 0.f; pa[j] = 0.f; }
            }
            float ow[8], oa[8];
#pragma unroll
            for (int j = 0; j < 8; ++j) { ow[j] = tanhf(cw[j] + (pw[j] - cw[j]) * mu_w[q0 + j]); oa[j] = ca[j] + (pa[j] - ca[j]) * mu_a[q0 + j]; }
            u32x4 o; o.x = pk2(ow[0], ow[1]); o.y = pk2(ow[2], ow[3]); o.z = pk2(ow[4], ow[5]); o.w = pk2(ow[6], ow[7]); *(LAS u32x4*)(TW + t * 72 + q0) = o;
            o.x = pk2(oa[0], oa[1]); o.y = pk2(oa[2], oa[3]); o.z = pk2(oa[4], oa[5]); o.w = pk2(oa[6], oa[7]); *(LAS u32x4*)(AL + t * 72 + q0) = o;
        }
        for (int h = 0; h < 8; ++h) {
            int tid = F.tid, lane = F.lane; asm volatile("" : "+v"(tid), "+v"(lane));
            {   LAS unsigned char* L = LB(); const int row = tid >> 3, c8 = tid & 7; const bf16_t* WLW = (const bf16_t*)(F.ws + WS_WLW); const bf16_t* WLA = (const bf16_t*)(F.ws + WS_WLA);
                *(LAS u32x4*)(S8 + row * 72 + c8 * 8) = *(const u32x4*)(WLW + (size_t)(h * 64 + row) * 64 + c8 * 8);
                *(LAS u32x4*)(S9 + row * 72 + c8 * 8) = *(const u32x4*)(WLA + (size_t)(h * 64 + row) * 64 + c8 * 8); }
            __syncthreads();
            { LAS unsigned char* L = LB(); const float* w0 = INP(I_W0) + l * 512; const float* a0 = INP(I_A0) + l * 512;
#pragma unroll
            for (int i = 0; i < 4; ++i) { const int idx = 4 * wave + i, which = idx >> 4, ti = (idx >> 2) & 3, ci = idx & 3;
                const f32x4 acc = mma_tile<64>((which ? AL : TW) + ti * 16 * 72, 72, (which ? S9 : S8) + ci * 16 * 72, 72, lane);
#pragma unroll
                for (int r = 0; r < 4; ++r) { const int t = ti * 16 + 4 * (lane >> 4) + r, ch = ci * 16 + (lane & 15);
                    if (which == 0) LWf[t * 65 + ch] = -DECAY_SCALE * sigmoidf_(acc[r] + w0[h * 64 + ch]); else ICf[t * 65 + ch] = sigmoidf_(acc[r] + a0[h * 64 + ch]); } } }
            __syncthreads();
            if (wave == 0) { LAS unsigned char* L = LB(); float run = 0.f;
#pragma unroll 8
                for (int t = 0; t < 64; ++t) { run += LWf[t * 65 + lane]; LWf[t * 65 + lane] = run; }
                WL[lane] = expf(run); }
            __syncthreads();
            float bonv[8]; const int t1 = tid >> 3, ch0 = (tid & 7) * 8, col1 = h * 64 + ch0;
            {   LAS unsigned char* L = LB(); const int t = t1;
                const bf16_t* Rg = (const bf16_t*)(F.ws + WS_R); const bf16_t* Kg = (const bf16_t*)(F.ws + WS_K); const bf16_t* Vg = (const bf16_t*)(F.ws + WS_V); const bf16_t* HR = (const bf16_t*)(F.ws + WS_HRKV);
                const float* mu_r = INP(I_MURKV) + (size_t)l * 1536; const float* mu_k = mu_r + 512; const float* mu_v = mu_r + 1024;
                const float* kkp = INP(I_KK) + l * 512; const float* kap = INP(I_KA) + l * 512; const float* rkp = INP(I_RK) + l * 512;
                const size_t off = (size_t)(m0 + t) * 512 + col1;
                const u32x4 rw = *(const u32x4*)(Rg + off), kw = *(const u32x4*)(Kg + off), vw = *(const u32x4*)(Vg + off);
                u32x4 rp = {0u, 0u, 0u, 0u}, kp = rp, vp = rp;
                if (t > 0) { rp = *(const u32x4*)(Rg + off - 512); kp = *(const u32x4*)(Kg + off - 512); vp = *(const u32x4*)(Vg + off - 512); }
                else if (!first) { const size_t ho = (size_t)(c - 1) * 512 + col1; rp = *(const u32x4*)(HR + ho); kp = *(const u32x4*)(HR + (size_t)NCHK * 512 + ho); vp = *(const u32x4*)(HR + (size_t)2 * NCHK * 512 + ho); }
                const unsigned rwa[4] = {rw.x, rw.y, rw.z, rw.w}, kwa[4] = {kw.x, kw.y, kw.z, kw.w}, vwa[4] = {vw.x, vw.y, vw.z, vw.w};
                const unsigned rpa[4] = {rp.x, rp.y, rp.z, rp.w}, kpa[4] = {kp.x, kp.y, kp.z, kp.w}, vpa[4] = {vp.x, vp.y, vp.z, vp.w};
                float rs[8], ks[8], vs[8], kkv[8], k2[8], ic[8]; float ss = 0.f, bs = 0.f;
#pragma unroll
                for (int j = 0; j < 8; ++j) { const int gch = col1 + j; const int q = j >> 1;
                    const float r_ = (j & 1) ? bfhi(rwa[q]) : bflo(rwa[q]), rq = (j & 1) ? bfhi(rpa[q]) : bflo(rpa[q]);
                    const float k_ = (j & 1) ? bfhi(kwa[q]) : bflo(kwa[q]), kq = (j & 1) ? bfhi(kpa[q]) : bflo(kpa[q]);
                    const float v_ = (j & 1) ? bfhi(vwa[q]) : bflo(vwa[q]), vq = (j & 1) ? bfhi(vpa[q]) : bflo(vpa[q]);
                    rs[j] = r_ + (rq - r_) * mu_r[gch]; ks[j] = k_ + (kq - k_) * mu_k[gch]; vs[j] = v_ + (vq - v_) * mu_v[gch];
                    ic[j] = ICf[t * 65 + ch0 + j];
                    kkv[j] = ks[j] * kkp[gch]; ss += kkv[j] * kkv[j];
                    k2[j] = ks[j] * (1.f + (ic[j] - 1.f) * kap[gch]); bs += rs[j] * k2[j] * rkp[gch]; }
                ss += __shfl_xor(ss, 1); ss += __shfl_xor(ss, 2); ss += __shfl_xor(ss, 4);
                bs += __shfl_xor(bs, 1); bs += __shfl_xor(bs, 2); bs += __shfl_xor(bs, 4);
                const float inv = 1.f / fmaxf(sqrtf(ss), 1e-12f);
                float vAT[8], vB[8], vK[8], vR[8], vBH[8], vKH[8];
#pragma unroll
                for (int j = 0; j < 8; ++j) { const int ch = ch0 + j;
                    const float LWt = LWf[t * 65 + ch], LWp = (t > 0) ? LWf[(t - 1) * 65 + ch] : 0.f, L63 = LWf[63 * 65 + ch];
                    const float kk = kkv[j] * inv, a = -kk, b = kk * ic[j];
                    const float e1 = expf(LWt), e2 = expf(-LWt), e3 = expf(LWp), e4 = expf(L63 - LWt);
                    vAT[j] = a * e3; vB[j] = b * e2; vK[j] = k2[j] * e2; vR[j] = rs[j] * e1; vBH[j] = b * e4; vKH[j] = k2[j] * e4; bonv[j] = bs * vs[j];
                    ATt[ch * 72 + t] = (bf16_t)f2bf(vAT[j]); BHt[ch * 72 + t] = (bf16_t)f2bf(vBH[j]); VT[ch * 72 + t] = (bf16_t)f2bf(vs[j]); }
                u32x4 o;
#define PK8(A_) (o[0] = pk2(A_[0], A_[1]), o[1] = pk2(A_[2], A_[3]), o[2] = pk2(A_[4], A_[5]), o[3] = pk2(A_[6], A_[7]), o)
                *(LAS u32x4*)(AT + t * 72 + ch0) = PK8(vAT); *(LAS u32x4*)(BTl + t * 72 + ch0) = PK8(vB); *(LAS u32x4*)(KTl + t * 72 + ch0) = PK8(vK);
                *(LAS u32x4*)(RT + t * 72 + ch0) = PK8(vR); *(LAS u32x4*)(KH + t * 72 + ch0) = PK8(vKH);
            }
            __syncthreads();
            { u32x4 o; *(u32x4*)((bf16_t*)(F.ws + WS_V) + (size_t)(m0 + t1) * 512 + col1) = PK8(bonv); }
            { LAS unsigned char* L = LB();
#pragma unroll
            for (int i = 0; i < 8; ++i) { const int p = wave >> 1, idx = 8 * (wave & 1) + i, ti = idx >> 2, si = idx & 3;
                const f32x4 acc = mma_tile<64>(((p < 2) ? AT : RT) + ti * 16 * 72, 72, ((p & 1) ? KTl : BTl) + si * 16 * 72, 72, lane);
#pragma unroll
                for (int r = 0; r < 4; ++r) { const int t = ti * 16 + 4 * (lane >> 4) + r, s = si * 16 + (lane & 15);
                    if (p == 0) MAB[t * 65 + s] = (s < t) ? acc[r] : 0.f;
                    else if (p == 1) MakT[s * 72 + t] = (bf16_t)f2bf((s < t) ? acc[r] : 0.f);
                    else if (p == 2) Rb[t * 72 + s] = (bf16_t)f2bf((s <= t) ? acc[r] : 0.f);
                    else Rk[t * 72 + s] = (bf16_t)f2bf((s <= t) ? acc[r] : 0.f); } } }
            __syncthreads();
            if (wave < 4 && lane < 16) { LAS unsigned char* L = LB(); const int b0 = 16 * wave; float x[16];
#pragma unroll
                for (int t = 0; t < 16; ++t) { float v = (t == lane) ? 1.f : 0.f;
#pragma unroll
                    for (int s = 0; s < 16; ++s) if (s < t) v += MAB[(b0 + t) * 65 + b0 + s] * x[s];
                    x[t] = v; }
#pragma unroll
                for (int t = 0; t < 16; ++t) MAB[(b0 + t) * 65 + b0 + lane] = x[t]; }
            __syncthreads();
            {   LAS unsigned char* L = LB(); const int pr = tid >> 8, e = tid & 255, rr = e >> 4, cc = e & 15, rb = pr ? 48 : 16, cb = pr ? 32 : 0; float v = 0.f;
#pragma unroll
                for (int s = 0; s < 16; ++s) v += MAB[(rb + rr) * 65 + cb + s] * MAB[(cb + s) * 65 + cb + cc];
                SCR[(pr * 16 + rr) * 33 + cc] = v; }
            __syncthreads();
            {   LAS unsigned char* L = LB(); const int pr = tid >> 8, e = tid & 255, rr = e >> 4, cc = e & 15, rb = pr ? 48 : 16, cb = pr ? 32 : 0; float v = 0.f;
#pragma unroll
                for (int s = 0; s < 16; ++s) v += MAB[(rb + rr) * 65 + rb + s] * SCR[(pr * 16 + s) * 33 + cc];
                MAB[(rb + rr) * 65 + cb + cc] = v; }
            __syncthreads();
            {   LAS unsigned char* L = LB(); float v2[2];
#pragma unroll
                for (int i = 0; i < 2; ++i) { const int e = tid * 2 + i, rr = e >> 5, cc = e & 31; float v = 0.f;
#pragma unroll 8
                    for (int s = 0; s < 32; ++s) v += MAB[(32 + rr) * 65 + s] * MAB[s * 65 + cc];
                    v2[i] = v; }
                SCR[((tid * 2) >> 5) * 33 + ((tid * 2) & 31)] = v2[0]; SCR[((tid * 2 + 1) >> 5) * 33 + ((tid * 2 + 1) & 31)] = v2[1]; }
            __syncthreads();
            {   LAS unsigned char* L = LB();
#pragma unroll
                for (int i = 0; i < 2; ++i) { const int e = tid * 2 + i, rr = e >> 5, cc = e & 31; float v = 0.f;
#pragma unroll 8
                    for (int s = 0; s < 32; ++s) v += MAB[(32 + rr) * 65 + 32 + s] * SCR[s * 33 + cc];
                    MAB[(32 + rr) * 65 + cc] = v; } }
            __syncthreads();
            {   LAS unsigned char* L = LB(); const int t = tid >> 3, s0 = (tid & 7) * 8; float x[8];
#pragma unroll
                for (int j = 0; j < 8; ++j) x[j] = MAB[t * 65 + s0 + j];
                u32x4 o; *(LAS u32x4*)(MI + t * 72 + s0) = PK8(x); }
            __syncthreads();
            { LAS unsigned char* L = LB();
#pragma unroll
            for (int i = 0; i < 4; ++i) { const int idx = 4 * wave + i, which = idx >> 4, ti = (idx >> 2) & 3, ci = idx & 3;
                const f32x4 acc = mma_tile<64>(MI + ti * 16 * 72, 72, (which ? MakT : ATt) + ci * 16 * 72, 72, lane);
#pragma unroll
                for (int r = 0; r < 4; ++r) { const int t = ti * 16 + 4 * (lane >> 4) + r, j = ci * 16 + (lane & 15); (which ? X2t : X1t)[j * 72 + t] = (bf16_t)f2bf(acc[r]); } } }
            __syncthreads();
            { LAS unsigned char* L = LB();
            bf16_t* QEw = (bf16_t*)(F.ws + WS_QE) + (size_t)(c * 8 + h) * 4096; bf16_t* TTw = (bf16_t*)(F.ws + WS_TT) + (size_t)(c * 8 + h) * 4096;
#pragma unroll
            for (int i = 0; i < 8; ++i) { const int p = wave >> 1, idx = 8 * (wave & 1) + i, ti = idx >> 2, si = idx & 3;
                const f32x4 acc = mma_tile<64>(((p == 0 || p == 1) ? Rb : (p == 2) ? X1t : X2t) + ti * 16 * 72, 72, ((p == 0) ? X1t : (p == 1) ? X2t : BHt) + si * 16 * 72, 72, lane);
#pragma unroll
                for (int r = 0; r < 4; ++r) { const int rw = ti * 16 + 4 * (lane >> 4) + r, cl = si * 16 + (lane & 15);
                    if (p == 0) QEw[rw * 64 + pi16(cl)] = (bf16_t)f2bf(acc[r] + bf2f(RT[rw * 72 + cl]));
                    else if (p == 1) Attn[rw * 72 + cl] = (bf16_t)f2bf(acc[r] + bf2f(Rk[rw * 72 + cl]));
                    else if (p == 2) TTw[cl * 64 + pi16(rw)] = (bf16_t)f2bf(acc[r] + ((rw == cl) ? WL[rw] : 0.f));
                    else KEt[cl * 72 + rw] = (bf16_t)f2bf(acc[r] + bf2f(KH[rw * 72 + cl])); } } }
            __syncthreads();
            bf16_t* Rg = (bf16_t*)(F.ws + WS_R); bf16_t* Kg = (bf16_t*)(F.ws + WS_K); LAS unsigned char* L = LB();
#pragma unroll
            for (int i = 0; i < 4; ++i) { const int idx = 4 * wave + i, which = idx >> 4, ti = (idx >> 2) & 3, ci = idx & 3;
                const f32x4 acc = mma_tile<64>((which ? VT : Attn) + ti * 16 * 72, 72, (which ? KEt : VT) + ci * 16 * 72, 72, lane);
#pragma unroll
                for (int r = 0; r < 4; ++r) { const int rw = ti * 16 + 4 * (lane >> 4) + r, cl = ci * 16 + (lane & 15);
                    if (which == 0) Kg[(size_t)(m0 + cl) * 512 + h * 64 + sg32(rw)] = (bf16_t)f2bf(acc[r]);
                    else Rg[(size_t)(m0 + rw) * 512 + h * 64 + sg32(cl)] = (bf16_t)f2bf(acc[r]); } }
        }
        __syncthreads();
    }
#undef SLOT
#undef PK8
#undef LB
#undef TW
#undef AL
#undef AT
#undef ATt
#undef BTl
#undef KTl
#undef RT
#undef BHt
#undef KH
#undef VT
#undef MI
#undef MakT
#undef Rb
#undef Rk
#undef Attn
#undef KEt
#undef X1t
#undef X2t
#undef S8
#undef S9
#undef MAB
#undef LWf
#undef ICf
#undef WL
#undef SCR
}

__device__ __forceinline__ bf16x8 cvt8(const f32x16& x, int s) {
    u32x4 w; w.x = pk2(x[8 * s + 0], x[8 * s + 1]); w.y = pk2(x[8 * s + 2], x[8 * s + 3]); w.z = pk2(x[8 * s + 4], x[8 * s + 5]); w.w = pk2(x[8 * s + 6], x[8 * s + 7]);
    return __builtin_bit_cast(bf16x8, w);
}
__device__ __forceinline__ f32x16 ld16bf(const bf16_t* p) {
    const u32x4 a = *(const u32x4*)p, b = *(const u32x4*)(p + 8); f32x16 r;
    r[0] = bflo(a.x); r[1] = bfhi(a.x); r[2] = bflo(a.y); r[3] = bfhi(a.y); r[4] = bflo(a.z); r[5] = bfhi(a.z); r[6] = bflo(a.w); r[7] = bfhi(a.w);
    r[8] = bflo(b.x); r[9] = bfhi(b.x); r[10] = bflo(b.y); r[11] = bfhi(b.y); r[12] = bflo(b.z); r[13] = bfhi(b.z); r[14] = bflo(b.w); r[15] = bfhi(b.w); return r;
}
__device__ __forceinline__ void st16bf(bf16_t* p, const f32x16& x) {
    u32x4 a, b; a.x = pk2(x[0], x[1]); a.y = pk2(x[2], x[3]); a.z = pk2(x[4], x[5]); a.w = pk2(x[6], x[7]); b.x = pk2(x[8], x[9]); b.y = pk2(x[10], x[11]); b.z = pk2(x[12], x[13]); b.w = pk2(x[14], x[15]);
    *(u32x4*)p = a; *(u32x4*)(p + 8) = b;
}
constexpr int KROW = 400;
__device__ __forceinline__ void attn_unit(const Ctx& F, int b, int c) {
    const int tid = F.tid, lane = F.lane, wave = F.wave, r32 = lane & 31, hi = lane >> 5, head = wave >> 1;
    const bf16_t* Q = (const bf16_t*)(F.ws + WS_Q); const bf16_t* KV = (const bf16_t*)(F.ws + WS_KVB) + (size_t)b * SEQ * 192; bf16_t* OL = (bf16_t*)(F.ws + WS_OL);
    const size_t mq = (size_t)b * SEQ + 64 * c + 32 * (wave & 1) + r32;
    bf16x8 qr[12];
#pragma unroll
    for (int d0 = 0; d0 < 12; ++d0) qr[d0] = *(const bf16x8*)(Q + mq * 768 + head * 192 + 16 * d0 + 8 * hi);
    {
        const float* rp = (const float*)(F.ws + WS_ROPE) + mq * 64;
#pragma unroll
        for (int d0 = 8; d0 < 10; ++d0) { const int j0 = 16 * (d0 - 8) + 8 * hi;
            const f32x4 c0 = *(const f32x4*)(rp + j0), c1 = *(const f32x4*)(rp + j0 + 4), s0 = *(const f32x4*)(rp + 32 + j0), s1 = *(const f32x4*)(rp + 32 + j0 + 4);
            const u32x4 a = __builtin_bit_cast(u32x4, qr[d0]), b = __builtin_bit_cast(u32x4, qr[d0 + 2]);
            const float x1[8] = {bflo(a.x), bfhi(a.x), bflo(a.y), bfhi(a.y), bflo(a.z), bfhi(a.z), bflo(a.w), bfhi(a.w)}, x2[8] = {bflo(b.x), bfhi(b.x), bflo(b.y), bfhi(b.y), bflo(b.z), bfhi(b.z), bflo(b.w), bfhi(b.w)};
            const float cs[8] = {c0[0], c0[1], c0[2], c0[3], c1[0], c1[1], c1[2], c1[3]}, sn[8] = {s0[0], s0[1], s0[2], s0[3], s1[0], s1[1], s1[2], s1[3]};
            float o1[8], o2[8];
#pragma unroll
            for (int e = 0; e < 8; ++e) { o1[e] = x1[e] * cs[e] - x2[e] * sn[e]; o2[e] = x1[e] * sn[e] + x2[e] * cs[e]; }
            u32x4 w1, w2; w1.x = pk2(o1[0], o1[1]); w1.y = pk2(o1[2], o1[3]); w1.z = pk2(o1[4], o1[5]); w1.w = pk2(o1[6], o1[7]); w2.x = pk2(o2[0], o2[1]); w2.y = pk2(o2[2], o2[3]); w2.z = pk2(o2[4], o2[5]); w2.w = pk2(o2[6], o2[7]);
            qr[d0] = __builtin_bit_cast(bf16x8, w1); qr[d0 + 2] = __builtin_bit_cast(bf16x8, w2); }
    }
    int prow[3], pcol[3];
#pragma unroll
    for (int i = 0; i < 3; ++i) { const int idx = tid + 512 * i; prow[i] = idx / 24; pcol[i] = idx % 24; }
    const int nt = c + 1;
    u32x4 st[3];
#pragma unroll
    for (int i = 0; i < 3; ++i) st[i] = *(const u32x4*)(KV + (size_t)prow[i] * 192 + pcol[i] * 8);
#pragma unroll
    for (int i = 0; i < 3; ++i) *(LAS u32x4*)(F.lds + prow[i] * KROW + pcol[i] * 16) = st[i];
    __syncthreads();
    f32x16 o[4];
#pragma unroll
    for (int d = 0; d < 4; ++d)
#pragma unroll
        for (int r = 0; r < 16; ++r) o[d][r] = 0.f;
    float mrun = -1e30f, lrun = 0.f;
    const int troff = (4 * hi + ((lane & 15) >> 2)) * KROW + (((lane >> 4) & 1) * 16 + (lane & 3) * 4) * 2;
    for (int kt = 0; kt < nt; ++kt) {
        LAS unsigned char* buf = F.lds + (kt & 1) * (64 * KROW);
        if (kt + 1 < nt) {
#pragma unroll
            for (int i = 0; i < 3; ++i) st[i] = *(const u32x4*)(KV + (size_t)((kt + 1) * 64 + prow[i]) * 192 + pcol[i] * 8);
        }
        f32x16 p0, p1;
#pragma unroll
        for (int r = 0; r < 16; ++r) { p0[r] = 0.f; p1[r] = 0.f; }
#pragma unroll
        for (int d0 = 0; d0 < 12; ++d0) {
            const bf16x8 a0 = *(const LAS bf16x8*)(buf + r32 * KROW + d0 * 32 + hi * 16), a1 = *(const LAS bf16x8*)(buf + (32 + r32) * KROW + d0 * 32 + hi * 16);
            p0 = __builtin_amdgcn_mfma_f32_32x32x16_bf16(a0, qr[d0], p0, 0, 0, 0); p1 = __builtin_amdgcn_mfma_f32_32x32x16_bf16(a1, qr[d0], p1, 0, 0, 0);
        }
        float mx = p0[0];
#pragma unroll
        for (int r = 0; r < 16; ++r) { mx = fmaxf(mx, p0[r]); mx = fmaxf(mx, p1[r]); }
        mx = fmaxf(mx, __shfl_xor(mx, 32));
        const float mnew = fmaxf(mrun, mx), alpha = exp2f(mrun - mnew); mrun = mnew;
        float ls = 0.f;
#pragma unroll
        for (int r = 0; r < 16; ++r) { p0[r] = exp2f(p0[r] - mnew); p1[r] = exp2f(p1[r] - mnew); ls += p0[r] + p1[r]; }
        lrun = lrun * alpha + ls;
#pragma unroll
        for (int d = 0; d < 4; ++d)
#pragma unroll
            for (int r = 0; r < 16; ++r) o[d][r] *= alpha;
#pragma unroll
        for (int s = 0; s < 4; ++s) {
            const bf16x8 pb = (s < 2) ? cvt8(p0, s & 1) : cvt8(p1, s & 1);
#pragma unroll
            for (int db = 0; db < 4; ++db) {
                const LAS unsigned char* vp = buf + troff + (16 * s) * KROW + db * 64;
                const v4i16_t lo = __builtin_amdgcn_ds_read_tr16_b64_v4i16((LAS v4i16_t*)vp), hh = __builtin_amdgcn_ds_read_tr16_b64_v4i16((LAS v4i16_t*)(vp + 8 * KROW));
                const bf16x8 va = {lo[0], lo[1], lo[2], lo[3], hh[0], hh[1], hh[2], hh[3]};
                o[db] = __builtin_amdgcn_mfma_f32_32x32x16_bf16(va, pb, o[db], 0, 0, 0);
            }
        }
        if (kt + 1 < nt) {
            LAS unsigned char* nb = F.lds + ((kt + 1) & 1) * (64 * KROW);
#pragma unroll
            for (int i = 0; i < 3; ++i) *(LAS u32x4*)(nb + prow[i] * KROW + pcol[i] * 16) = st[i];
        }
        __syncthreads();
    }
    lrun += __shfl_xor(lrun, 32);
    const float inv = 1.f / lrun;
#pragma unroll
    for (int db = 0; db < 4; ++db)
#pragma unroll
        for (int g = 0; g < 4; ++g) { u32x2 w; w.x = pk2(o[db][4 * g] * inv, o[db][4 * g + 1] * inv); w.y = pk2(o[db][4 * g + 2] * inv, o[db][4 * g + 3] * inv);
            *(u32x2*)(OL + mq * 512 + head * 128 + 32 * db + 8 * g + 4 * hi) = w; }
}
__device__ __forceinline__ void rwkv_scan(const Ctx& F, int b, int h, int half) {
    const int lane = F.lane, r32 = lane & 31, hi = lane >> 5, i = 32 * half + r32;
    const bf16_t* TTg = (const bf16_t*)(F.ws + WS_TT); const bf16_t* QEg = (const bf16_t*)(F.ws + WS_QE); const bf16_t* Rg = (const bf16_t*)(F.ws + WS_R); bf16_t* Kg = (bf16_t*)(F.ws + WS_K);
    f32x16 X0, X1;
#pragma unroll
    for (int r = 0; r < 16; ++r) { X0[r] = 0.f; X1[r] = 0.f; }
    for (int c = 0; c < 128; ++c) {
        const int cg_ = b * 128 + c; const size_t m0 = (size_t)64 * cg_;
        const bf16_t* TTw = TTg + (size_t)(cg_ * 8 + h) * 4096; const bf16_t* QEw = QEg + (size_t)(cg_ * 8 + h) * 4096;
        const bf16_t* Dw = Rg + (m0 + i) * 512 + h * 64; bf16_t* Yw = Kg + (m0 + i) * 512 + h * 64;
        bf16x8 ta[2][4], qa[2][4];
#pragma unroll
        for (int a = 0; a < 2; ++a)
#pragma unroll
            for (int s2 = 0; s2 < 4; ++s2) { ta[a][s2] = *(const bf16x8*)(TTw + (32 * a + r32) * 64 + 16 * s2 + 8 * hi); qa[a][s2] = *(const bf16x8*)(QEw + (32 * a + r32) * 64 + 16 * s2 + 8 * hi); }
        f32x16 n0 = ld16bf(Dw + 16 * hi), n1 = ld16bf(Dw + 32 + 16 * hi), y0 = ld16bf(Yw + 16 * hi), y1 = ld16bf(Yw + 32 + 16 * hi);
        const bf16x8 bf[4] = {cvt8(X0, 0), cvt8(X0, 1), cvt8(X1, 0), cvt8(X1, 1)};
#pragma unroll
        for (int s2 = 0; s2 < 4; ++s2) {
            n0 = __builtin_amdgcn_mfma_f32_32x32x16_bf16(ta[0][s2], bf[s2], n0, 0, 0, 0); n1 = __builtin_amdgcn_mfma_f32_32x32x16_bf16(ta[1][s2], bf[s2], n1, 0, 0, 0);
            y0 = __builtin_amdgcn_mfma_f32_32x32x16_bf16(qa[0][s2], bf[s2], y0, 0, 0, 0); y1 = __builtin_amdgcn_mfma_f32_32x32x16_bf16(qa[1][s2], bf[s2], y1, 0, 0, 0);
        }
        st16bf(Yw + 16 * hi, y0); st16bf(Yw + 32 + 16 * hi, y1);
        X0 = n0; X1 = n1;
    }
}
__device__ __forceinline__ void ssd_scan(const Ctx& F, int b, int h, int half) {
    const int lane = F.lane, r32 = lane & 31, hi = lane >> 5, p = 32 * half + r32, g = h >> 2, hl = h & 3;
    const bf16_t* Cb = (const bf16_t*)(F.ws + WS_CB); const float* ECUM = (const float*)(F.ws + WS_ECUM); const float* CDEC = (const float*)(F.ws + WS_CDEC);
    bf16_t* YD = (bf16_t*)(F.ws + WS_YD); const bf16_t* ST = (const bf16_t*)(F.ws + WS_XBC);
    f32x16 X[4];
#pragma unroll
    for (int a = 0; a < 4; ++a)
#pragma unroll
        for (int r = 0; r < 16; ++r) X[a][r] = 0.f;
    for (int c = 0; c < 128; ++c) {
        const int cg_ = b * 128 + c; const size_t m0 = (size_t)64 * cg_;
        f32x16 stv[4];
#pragma unroll
        for (int a = 0; a < 4; ++a) { const int f = hl * 8192 + p * 128 + 32 * a + 16 * hi, row = f >> 9, col = ssd_win_col(g, f & 511); stv[a] = ld16bf(ST + (m0 + row) * 1024 + col); }
        const float cd = CDEC[cg_ * 8 + h];
        bf16x8 bf[8];
#pragma unroll
        for (int s2 = 0; s2 < 8; ++s2) bf[s2] = cvt8(X[s2 >> 1], s2 & 1);
#pragma unroll
        for (int tb = 0; tb < 2; ++tb) {
            f32x16 acc;
#pragma unroll
            for (int r = 0; r < 16; ++r) acc[r] = 0.f;
#pragma unroll
            for (int s2 = 0; s2 < 8; ++s2) { const bf16x8 ca = *(const bf16x8*)(Cb + (m0 + 32 * tb + r32) * 256 + g * 128 + 16 * s2 + 8 * hi); acc = __builtin_amdgcn_mfma_f32_32x32x16_bf16(ca, bf[s2], acc, 0, 0, 0); }
            const float* ep = ECUM + (size_t)(cg_ * 8 + h) * 64 + 32 * tb + 16 * hi;
#pragma unroll
            for (int r = 0; r < 16; ++r) { bf16_t* yp = YD + (m0 + 32 * tb + crow(r, hi)) * 512 + 64 * h + p; *yp = (bf16_t)f2bf(bf2f(*yp) + acc[r] * ep[r]); }
        }
#pragma unroll
        for (int a = 0; a < 4; ++a)
#pragma unroll
            for (int r = 0; r < 16; ++r) X[a][r] = X[a][r] * cd + stv[a][r];
    }
}
__device__ __forceinline__ void p4_mix(const Ctx& F) {
    if (F.bid < 128) {
        const int b = F.bid >> 6, c = F.bid & 63;
        attn_unit(F, b, 127 - c); __syncthreads(); attn_unit(F, b, c);
    } else if (F.bid < 136) {
        const int task = (F.bid - 128) * 8 + F.wave;
        if (task < 32) rwkv_scan(F, task >> 4, (task >> 1) & 7, task & 1); else { const int t2 = task - 32; ssd_scan(F, t2 >> 4, (t2 >> 1) & 7, t2 & 1); }
    }
}
__device__ __forceinline__ void p5_assemble(const Ctx& F, int l) {
    bf16_t* GT = (bf16_t*)(F.ws + WS_GATES);
    {   pg8::Gemm g{(const bf16_t*)(F.ws + WS_OL), (const bf16_t*)(F.ws + WS_WUV), NT, 512, 512, 512, 512}; pg8::StaticOrder S; S.init(NT, 512, F.G, F.bid); EpiUV E{GT};
        pg8::gemm_phase<EpiUV, pg8::StaticOrder, true, true>(F.lds, F.wave, g, S, E); }
    __syncthreads();
    int lane = fresh_lane();
    const int gw = F.bid * NWAVES + F.wave, NGW = F.G * NWAVES;
    const bf16_t* YD = (const bf16_t*)(F.ws + WS_YD); const float* snw = INP(I_SSDNW) + l * 512;
    for (int m = gw; m < NT; m += NGW) {
        const u32x4 yw = *(const u32x4*)(YD + (size_t)m * 512 + 8 * lane); u32x4* zp = (u32x4*)(GT + (size_t)m * 1536 + 512 + 8 * lane); const u32x4 zw = *zp;
        float v[8] = {bflo(yw.x) * siluf_(bflo(zw.x)), bfhi(yw.x) * siluf_(bfhi(zw.x)), bflo(yw.y) * siluf_(bflo(zw.y)), bfhi(yw.y) * siluf_(bfhi(zw.y)),
                      bflo(yw.z) * siluf_(bflo(zw.z)), bfhi(yw.z) * siluf_(bfhi(zw.z)), bflo(yw.w) * siluf_(bflo(zw.w)), bfhi(yw.w) * siluf_(bfhi(zw.w))};
        float s = 0.f;
#pragma unroll
        for (int j = 0; j < 8; ++j) s += v[j] * v[j];
        const float rs = 1.f / sqrtf(wave_sum(s) * (1.f / 512.f) + EPS);
        const f32x4 w0 = *(const f32x4*)(snw + 8 * lane), w1 = *(const f32x4*)(snw + 8 * lane + 4);
        u32x4 o; o.x = pk2(v[0] * rs * w0[0], v[1] * rs * w0[1]); o.y = pk2(v[2] * rs * w0[2], v[3] * rs * w0[3]); o.z = pk2(v[4] * rs * w1[0], v[5] * rs * w1[1]); o.w = pk2(v[6] * rs * w1[2], v[7] * rs * w1[3]);
        *zp = o;
    }
    LAS float* SW = (LAS float*)(F.lds + F.wave * 16640);
    const bf16_t* Yt = (const bf16_t*)(F.ws + WS_K); const bf16_t* BON = (const bf16_t*)(F.ws + WS_V); const float* lw = INP(I_LNXW) + l * 512; const float* lb = INP(I_LNXB) + l * 512;
    for (int w = gw; w < NCHK * 8; w += NGW) {
        asm volatile("" : "+v"(lane));
        const int cg_ = w >> 3, h = w & 7; const size_t m0 = (size_t)64 * cg_; const int pos = sg32(lane);
        float y[64]; float s = 0.f;
#pragma unroll
        for (int i = 0; i < 64; ++i) { y[i] = bf2f(Yt[(m0 + i) * 512 + h * 64 + pos]); s += y[i]; }
        const float mean = s * (1.f / 64.f); float q = 0.f;
#pragma unroll
        for (int i = 0; i < 64; ++i) { y[i] -= mean; q += y[i] * y[i]; }
        const float rs = 1.f / sqrtf(q * (1.f / 64.f) + GN_EPS);
#pragma unroll
        for (int i = 0; i < 64; ++i) SW[lane * 65 + i] = y[i] * rs;
        LDS_WAIT();
#pragma unroll
        for (int it = 0; it < 8; ++it) { const int t = it * 8 + (lane >> 3), i0 = (lane & 7) * 8; const size_t row = m0 + t;
            const u32x4 bw = *(const u32x4*)(BON + row * 512 + h * 64 + i0); u32x4* gp = (u32x4*)(GT + row * 1536 + 1024 + h * 64 + i0); const u32x4 gv = *gp;
            const float bo[8] = {bflo(bw.x), bfhi(bw.x), bflo(bw.y), bfhi(bw.y), bflo(bw.z), bfhi(bw.z), bflo(bw.w), bfhi(bw.w)};
            const float gg[8] = {bflo(gv.x), bfhi(gv.x), bflo(gv.y), bfhi(gv.y), bflo(gv.z), bfhi(gv.z), bflo(gv.w), bfhi(gv.w)};
            float ov[8];
#pragma unroll
            for (int j = 0; j < 8; ++j) ov[j] = (SW[t * 65 + i0 + j] * lw[h * 64 + i0 + j] + lb[h * 64 + i0 + j] + bo[j]) * siluf_(gg[j]);
            u32x4 o; o.x = pk2(ov[0], ov[1]); o.y = pk2(ov[2], ov[3]); o.z = pk2(ov[4], ov[5]); o.w = pk2(ov[6], ov[7]); *gp = o; }
        LDS_WAIT();
    }
}
__device__ __forceinline__ void p7_final(const Ctx& F) {
    const int gw = F.bid * NWAVES + F.wave, NGW = F.G * NWAVES; const float* fw = INP(I_FNW);
    for (int m = gw; m < NT; m += NGW) {
        f32x4* xr = (f32x4*)(F.out + (size_t)m * DM) + F.lane; f32x4 v[4]; float s = 0.f;
#pragma unroll
        for (int j = 0; j < 4; ++j) { v[j] = xr[64 * j]; s += v[j].x * v[j].x + v[j].y * v[j].y + v[j].z * v[j].z + v[j].w * v[j].w; }
        const float rstd = 1.f / sqrtf(wave_sum(s) * (1.f / DM) + EPS);
#pragma unroll
        for (int j = 0; j < 4; ++j) xr[64 * j] = v[j] * rstd * *(const f32x4*)(fw + 4 * F.lane + 256 * j);
    }
}

#define LAYER(l) do { \
        const int pb = 1 + 8 * l; \
        if (IN(pb + 0)) { PHB(); if (l == 1) prep_weights(F, 1); p1_norm(F, l); SEAM(pb + 0); } \
        if (IN(pb + 1)) { PHB(); \
            pg8::Gemm g{(const bf16_t*)(F.ws + WS_XN), (const bf16_t*)(F.ws + WS_WIN), NT, NIN, DM, DM, DM}; pg8::StaticOrder S; S.init(NT, NIN, F.G, F.bid); \
            EpiIn E{F.ws, l}; \
            pg8::gemm_phase<EpiIn, pg8::StaticOrder, true, true>(F.lds, F.wave, g, S, E); \
            SEAM(pb + 1); \
        } \
        if (IN(pb + 2)) { PHB(); \
            pg8::Gemm g{(const bf16_t*)(F.ws + WS_QLAT), (const bf16_t*)(F.ws + WS_WQ), NT, 768, 256, 256, 256}; pg8::StaticOrder S; S.init(NT, 768, F.G, F.bid); \
            EpiQ E{F.ws, l}; \
            pg8::gemm_phase<EpiQ, pg8::StaticOrder, true, true>(F.lds, F.wave, g, S, E); \
            p3a_extras(F, l); \
            SEAM(pb + 2); \
        } \
        if (IN(pb + 3)) { PHB(); p3b_ssd(F, l); SEAM(pb + 3); } \
        if (IN(pb + 4)) { PHB(); p3c_rwkv(F, l); SEAM(pb + 4); } \
        if (IN(pb + 5)) { PHB(); p4_mix(F); SEAM(pb + 5); } \
        if (IN(pb + 6)) { PHB(); p5_assemble(F, l); SEAM(pb + 6); } \
        if (IN(pb + 7)) { PHB(); \
            pg8::Gemm g{(const bf16_t*)(F.ws + WS_GATES), (const bf16_t*)(F.ws + WS_WOUT), NT, DM, 1536, 1536, 1536}; pg8::StaticOrder S; S.init(NT, DM, F.G, F.bid); \
            EpiOut E{(l == 0) ? INP(I_X) : F.out, F.out, (const float*)(F.ws + WS_CTL + CTL_MOD) + (size_t)(l * 2) * 3072 + 2048}; \
            pg8::gemm_phase<EpiOut, pg8::StaticOrder, true, true>(F.lds, F.wave, g, S, E); \
            SEAM(pb + 7); \
        } \
    } while (0)
__global__ void __launch_bounds__(NTHR, 2) mk_fwd(Args args) {
    extern __shared__ __attribute__((aligned(16))) unsigned char lds_raw[];
    Ctx F; F.lds = (LAS unsigned char*)lds_raw; F.tid = threadIdx.x; F.lane = F.tid & 63; F.wave = __builtin_amdgcn_readfirstlane(F.tid >> 6);
    F.G = gridDim.x; F.bid = blockIdx.x; F.ws = args.ws; F.out = args.out; F.in = args.in;
    const int wave0 = F.wave;
    cg::grid_group grid = cg::this_grid();
#if MK_PER_PHASE
    const int lo = args.ph_lo, hi = args.ph_hi;
#else
    constexpr int lo = 0, hi = 18;
#endif
#ifndef MK_ONLY
#define MK_ONLY -1
#endif
#define IN(k) (lo <= (k) && (k) < hi && (MK_ONLY < 0 || MK_ONLY == ((k) == 0 ? 0 : (k) == 17 ? 17 : 1 + ((k) - 1) % 8)))
#define SEAM(k) do { if (IN((k) + 1)) grid.sync(); } while (0)
#define PHB() do { int b_ = blockIdx.x, g_ = gridDim.x, v_ = wave0; asm volatile("" : "+s"(b_), "+s"(g_), "+s"(v_)); F.bid = b_; F.G = g_; F.wave = v_; int t_ = v_ * 64 + (int)__builtin_amdgcn_mbcnt_hi(~0u, __builtin_amdgcn_mbcnt_lo(~0u, 0u)); asm volatile("; PHASE_MARK %0" : "+v"(t_)); F.tid = t_; F.lane = t_ & 63; unsigned char* w_ = args.ws; float* o_ = args.out; asm volatile("" : "+s"(w_), "+s"(o_)); F.ws = w_; F.out = o_; } while (0)
    if (IN(0)) { PHB(); p0_prologue(F); SEAM(0); }
    LAYER(0);
    LAYER(1);
    if (IN(17)) { PHB(); p7_final(F); }
#undef IN
#undef SEAM
}
constexpr int N_PHASES = 18;

extern "C" void kernel_launch(void* const* d_in, const int* in_sizes, int n_in, void* d_out, int out_size, void* d_ws, size_t ws_size, hipStream_t stream) {
    static int grid = 0;
    if (grid == 0) {
        if (n_in != 31 || out_size != NT * DM || ws_size < WS_END) { fprintf(stderr, "kernel_launch: unexpected shapes (n_in %d, out %d, ws %zu)\n", n_in, out_size, ws_size); grid = -1; return; }
        int dev = 0, cus = 0, per_cu = 0;
        hipGetDevice(&dev); hipDeviceGetAttribute(&cus, hipDeviceAttributeMultiprocessorCount, dev);
        if (hipFuncSetAttribute((const void*)mk_fwd, hipFuncAttributeMaxDynamicSharedMemorySize, LDS_BYTES) != hipSuccess) { fprintf(stderr, "kernel_launch: hipFuncSetAttribute failed\n"); grid = -1; return; }
        hipOccupancyMaxActiveBlocksPerMultiprocessor(&per_cu, (const void*)mk_fwd, NTHR, LDS_BYTES);
        (void)hipGetLastError();
        if (per_cu < 1) per_cu = 1;
        grid = cus;
        fprintf(stderr, "kernel_launch: cus %d, occupancy query %d block(s)/CU, grid %d\n", cus, per_cu, grid);
    }
    if (grid < 0) return;
    hipMemsetAsync((char*)d_ws + WS_CTL, 0, CTL_BYTES, stream);
    Args a{};
    for (int i = 0; i < 31; ++i) a.in[i] = (const float*)d_in[i];
    a.out = (float*)d_out; a.ws = (unsigned char*)d_ws;
#if MK_PER_PHASE
    for (int p = 0; p < N_PHASES; ++p) { a.ph_lo = p; a.ph_hi = p + 1; hipLaunchKernelGGL(mk_fwd, dim3(grid), dim3(NTHR), LDS_BYTES, stream, a); }
#else
    a.ph_lo = 0; a.ph_hi = N_PHASES;
    void* params[] = {&a};
    hipError_t e = hipLaunchCooperativeKernel((const void*)mk_fwd, dim3(grid), dim3(NTHR), params, LDS_BYTES, stream);
    if (e != hipSuccess) fprintf(stderr, "kernel_launch: cooperative launch failed: %s\n", hipGetErrorString(e));
#endif
}
```

```cpp
#include <hip/hip_runtime.h>
#include <hip/hip_cooperative_groups.h>
#include <cstdio>
#include <cstdint>
namespace cg = cooperative_groups;

#define LAS __attribute__((address_space(3)))
#define GAS __attribute__((address_space(1)))
typedef unsigned short bf16_t;
typedef short bf16x8 __attribute__((ext_vector_type(8)));
typedef float f32x4 __attribute__((ext_vector_type(4)));
typedef float f32x2 __attribute__((ext_vector_type(2)));
typedef float f32x16 __attribute__((ext_vector_type(16)));
typedef unsigned u32x4 __attribute__((ext_vector_type(4)));
typedef unsigned u32x2 __attribute__((ext_vector_type(2)));
typedef short v4i16_t __attribute__((ext_vector_type(4)));

#ifndef MK_PER_PHASE
#define MK_PER_PHASE 0
#endif

namespace pg8 {
constexpr int BM = 256, BK = 64, HALF = 128, HTB = HALF * BK * 2, STAGE_BYTES = 8 * HTB, NXCD = 8, WGM = 8;
__host__ __device__ __forceinline__ int lds_byte(int r, int c) { const int st = (r >> 4) * 2 + (c >> 5), rr = r & 15, cc = c & 31, ob = rr * 64 + cc * 2; return st * 1024 + (ob ^ (((ob >> 9) & 1) << 5)); }
__host__ __device__ __forceinline__ void stage_rc(int b, int& R, int& C) { const int st = b / 1024, sb = b % 1024, swz = sb ^ (((sb >> 9) & 1) << 5); R = (st >> 1) * 16 + swz / 64; C = (st & 1) * 32 + (swz % 64) / 2; }
__host__ __device__ __forceinline__ int perm32(int rho) { const int n = rho >> 4, i = rho & 15; return 8 * (i >> 2) + 4 * n + (i & 3); }
struct Unit { int pm, pn; };
struct Gemm { const bf16_t* A; const bf16_t* Bt; int M, N, K, lda, ldb; };
struct StaticOrder {
    int nM, nN, nwg, G, c;
    __host__ __device__ void init(int M, int N, int G_, int c_) { nM = M / BM; nN = N / BM; nwg = nM * nN; G = G_; c = c_; }
    __host__ __device__ bool next(int i, Unit& u) const {
        const long L = (long)i * G + c; if (L >= nwg) return false;
        int wgid = (int)L; { const int q = nwg / NXCD, r = nwg % NXCD, xcd = wgid % NXCD, off = wgid / NXCD; wgid = (xcd < r ? xcd * (q + 1) : r * (q + 1) + (xcd - r) * q) + off; }
        const int nig = WGM * nN, gid = wgid / nig, fm = gid * WGM, gsz = (nM - fm) < WGM ? (nM - fm) : WGM;
        u.pm = fm + ((wgid % nig) % gsz); u.pn = (wgid % nig) / gsz; return true;
    }
};
template <class Epi, class Sched, bool ALIGN_EPI, bool SP2>
__device__ __forceinline__ void gemm_phase(LAS unsigned char* lds, int wave_id, const Gemm g, const Sched& S, const Epi& E) {
    int lane = (int)__builtin_amdgcn_mbcnt_hi(~0u, __builtin_amdgcn_mbcnt_lo(~0u, 0u)); asm volatile("" : "+v"(lane));
    const int wid = wave_id, tid = wid * 64 + lane, wr = wid >> 2, wc = wid & 3, fr = lane & 15, fq = lane >> 4;
    const int K = g.K, nt = K / BK;
    unsigned voffA[2], voffB[2];
#pragma unroll
    for (int i = 0; i < 2; ++i) { int R, C; stage_rc(tid * 16 + i * 8192, R, C); const int Rb = (R & ~31) + perm32(R & 31);
        voffA[i] = (unsigned)(R * g.lda + C) * 2u; voffB[i] = (unsigned)(Rb * g.ldb + C) * 2u; }
    const size_t kstep = (size_t)(BK * 2);
    const size_t hstepA = (size_t)HALF * g.lda * 2, hstepB = (size_t)HALF * g.ldb * 2;
    const size_t tstepA = 2 * hstepA, tstepB = 2 * hstepB;
    const unsigned ldsw = (unsigned)wid * 1024u, lds0 = (unsigned)(uintptr_t)lds;
    const int aoff = lds_byte(wr * 64 + fr, fq * 8), boff = lds_byte(wc * 32 + fr, fq * 8);
#define PG8_SA(b, h) (((b) * 2 + (h)) * HTB)
#define PG8_SB(b, h) ((4 + (b) * 2 + (h)) * HTB)
#define PG8_STAGE(bufoff, gbase, voff) do { _Pragma("unroll") for (int _i = 0; _i < 2; ++_i) { unsigned keep_; \
        asm volatile("s_mov_b32 %0, m0\n\ts_mov_b32 m0, %3\n\ts_nop 0\n\tglobal_load_lds_dwordx4 %1, %2\n\ts_mov_b32 m0, %0" : "=&s"(keep_) : "v"((voff)[_i]), "s"((const char*)(gbase)), "s"(lds0 + (unsigned)(bufoff) + ldsw + (unsigned)(_i * 8192)) : "memory"); } } while (0)
#define PG8_LDA(dst, b, h) do { _Pragma("unroll") for (int m = 0; m < 4; ++m) _Pragma("unroll") for (int k = 0; k < 2; ++k) dst[m][k] = *(const LAS bf16x8*)(lds + PG8_SA(b, h) + aoff + m * 2048 + k * 1024); } while (0)
#define PG8_LDB(dst, b, h) do { _Pragma("unroll") for (int n = 0; n < 2; ++n) _Pragma("unroll") for (int k = 0; k < 2; ++k) dst[n][k] = *(const LAS bf16x8*)(lds + PG8_SB(b, h) + boff + n * 2048 + k * 1024); } while (0)
#define PG8_MMA(ai, bj, At, Bt) do { __builtin_amdgcn_s_setprio(1); _Pragma("unroll") for (int m = 0; m < 4; ++m) _Pragma("unroll") for (int n = 0; n < 2; ++n) _Pragma("unroll") for (int k = 0; k < 2; ++k) \
        acc[ai][bj][m][n] = __builtin_amdgcn_mfma_f32_16x16x32_bf16(Bt[n][k], At[m][k], acc[ai][bj][m][n], 0, 0, 0); __builtin_amdgcn_s_setprio(0); } while (0)
#define PG8_WAIT_V(n) asm volatile("s_waitcnt vmcnt(" #n ")" ::: "memory")
#define PG8_WAIT_L(n) asm volatile("s_waitcnt lgkmcnt(" #n ")" ::: "memory")
#define PG8_BAR __builtin_amdgcn_s_barrier()
#define PG8_SCHED __builtin_amdgcn_sched_barrier(0)
    Unit cur, nxt; int ui = 0;
    if (!S.next(0, cur)) return;
    f32x4 acc[2][2][4][2];
#pragma unroll
    for (int a = 0; a < 2; ++a)
#pragma unroll
        for (int b = 0; b < 2; ++b)
#pragma unroll
            for (int m = 0; m < 4; ++m)
#pragma unroll
                for (int n = 0; n < 2; ++n) acc[a][b][m][n] = (f32x4){0.f, 0.f, 0.f, 0.f};
    bf16x8 At[4][2], B0[2][2], B1[2][2];
    const char* cA = (const char*)g.A + (size_t)cur.pm * tstepA; const char* cB = (const char*)g.Bt + (size_t)cur.pn * tstepB;
    if constexpr (SP2) {
        PG8_STAGE(PG8_SB(0, 0), cB, voffB); PG8_STAGE(PG8_SB(0, 1), cB + hstepB, voffB); PG8_STAGE(PG8_SA(0, 0), cA, voffA); PG8_STAGE(PG8_SA(0, 1), cA + hstepA, voffA);
        if (wr == 1) PG8_BAR;
        PG8_WAIT_V(2); PG8_BAR;
        PG8_STAGE(PG8_SB(1, 0), cB + kstep, voffB); PG8_STAGE(PG8_SA(1, 0), cA + kstep, voffA); PG8_STAGE(PG8_SB(1, 1), cB + hstepB + kstep, voffB);
        PG8_WAIT_V(6); PG8_BAR;
    } else {
        PG8_STAGE(PG8_SB(0, 0), cB, voffB); PG8_STAGE(PG8_SA(0, 0), cA, voffA); PG8_STAGE(PG8_SB(0, 1), cB + hstepB, voffB); PG8_STAGE(PG8_SA(0, 1), cA + hstepA, voffA);
        if (wr == 1) PG8_BAR;
        PG8_WAIT_V(4); PG8_BAR;
        PG8_STAGE(PG8_SB(1, 0), cB + kstep, voffB); PG8_STAGE(PG8_SA(1, 0), cA + kstep, voffA); PG8_STAGE(PG8_SB(1, 1), cB + hstepB + kstep, voffB);
        PG8_WAIT_V(6); PG8_BAR;
    }
    for (;;) {
        const bool has_next = S.next(ui + 1, nxt);
        const char* nA = has_next ? (const char*)g.A + (size_t)nxt.pm * tstepA : cA; const char* nB = has_next ? (const char*)g.Bt + (size_t)nxt.pn * tstepB : cB;
        for (int t = 0; t < nt; t += 2) {
            const bool last = (t == nt - 2);
            const char* a1 = cA + (size_t)(t + 1) * kstep;
            const char* a2 = last ? nA : cA + (size_t)(t + 2) * kstep; const char* b2 = last ? nB : cB + (size_t)(t + 2) * kstep;
            const char* a3 = a2 + kstep; const char* b3 = b2 + kstep;
            if constexpr (SP2) {
            PG8_LDB(B0, 0, 0); PG8_LDB(B1, 0, 1); PG8_SCHED; PG8_LDA(At, 0, 0); PG8_STAGE(PG8_SA(1, 1), a1 + hstepA, voffA);
            PG8_WAIT_V(8); PG8_WAIT_L(0); PG8_BAR; PG8_MMA(0, 0, At, B0); PG8_MMA(0, 1, At, B1); PG8_BAR; PG8_SCHED;
            PG8_LDA(At, 0, 1); PG8_STAGE(PG8_SB(0, 0), b2, voffB); PG8_STAGE(PG8_SB(0, 1), b2 + hstepB, voffB); PG8_STAGE(PG8_SA(0, 0), a2, voffA);
            PG8_WAIT_V(8); PG8_WAIT_L(0); PG8_BAR; PG8_MMA(1, 0, At, B0); PG8_MMA(1, 1, At, B1); PG8_BAR; PG8_SCHED;
            PG8_LDB(B0, 1, 0); PG8_LDB(B1, 1, 1); PG8_SCHED; PG8_LDA(At, 1, 0); PG8_STAGE(PG8_SA(0, 1), a2 + hstepA, voffA);
            PG8_WAIT_V(8); PG8_WAIT_L(0); PG8_BAR; PG8_MMA(0, 0, At, B0); PG8_MMA(0, 1, At, B1); PG8_BAR; PG8_SCHED;
            PG8_LDA(At, 1, 1); PG8_STAGE(PG8_SB(1, 0), b3, voffB); PG8_STAGE(PG8_SB(1, 1), b3 + hstepB, voffB); PG8_STAGE(PG8_SA(1, 0), a3, voffA);
            PG8_WAIT_V(8); PG8_WAIT_L(0); PG8_BAR; PG8_MMA(1, 0, At, B0); PG8_MMA(1, 1, At, B1); PG8_BAR; PG8_SCHED;
            } else {
            PG8_LDB(B0, 0, 0); PG8_SCHED; PG8_LDA(At, 0, 0); PG8_STAGE(PG8_SA(1, 1), a1 + hstepA, voffA);
            PG8_WAIT_L(8); PG8_BAR; PG8_WAIT_L(0); PG8_MMA(0, 0, At, B0); PG8_BAR; PG8_SCHED;
            PG8_LDB(B1, 0, 1); PG8_STAGE(PG8_SB(0, 0), b2, voffB);
            PG8_BAR; PG8_WAIT_L(0); PG8_MMA(0, 1, At, B1); PG8_BAR;
            PG8_LDA(At, 0, 1); PG8_STAGE(PG8_SA(0, 0), a2, voffA);
            PG8_BAR; PG8_WAIT_L(0); PG8_MMA(1, 0, At, B0); PG8_BAR; PG8_SCHED;
            PG8_STAGE(PG8_SB(0, 1), b2 + hstepB, voffB);
            PG8_WAIT_V(6); PG8_BAR; PG8_MMA(1, 1, At, B1); PG8_BAR;
            PG8_LDB(B0, 1, 0); PG8_SCHED; PG8_LDA(At, 1, 0); PG8_STAGE(PG8_SA(0, 1), a2 + hstepA, voffA);
            PG8_WAIT_L(8); PG8_BAR; PG8_WAIT_L(0); PG8_MMA(0, 0, At, B0); PG8_BAR; PG8_SCHED;
            PG8_LDB(B1, 1, 1); PG8_STAGE(PG8_SB(1, 0), b3, voffB);
            PG8_BAR; PG8_WAIT_L(0); PG8_MMA(0, 1, At, B1); PG8_BAR;
            PG8_LDA(At, 1, 1); PG8_STAGE(PG8_SA(1, 0), a3, voffA);
            PG8_BAR; PG8_WAIT_L(0); PG8_MMA(1, 0, At, B0); PG8_BAR; PG8_SCHED;
            PG8_STAGE(PG8_SB(1, 1), b3 + hstepB, voffB);
            PG8_WAIT_V(6); PG8_BAR; PG8_MMA(1, 1, At, B1); PG8_BAR;
            }
        }
        if constexpr (ALIGN_EPI) { if (wr == 0) PG8_BAR; }
        E(acc, cur, wr, wc, fr, fq);
        if (!has_next) break;
#pragma unroll
        for (int a = 0; a < 2; ++a)
#pragma unroll
            for (int b = 0; b < 2; ++b)
#pragma unroll
                for (int m = 0; m < 4; ++m)
#pragma unroll
                    for (int n = 0; n < 2; ++n) acc[a][b][m][n] = (f32x4){0.f, 0.f, 0.f, 0.f};
        cur = nxt; cA = nA; cB = nB; ++ui;
        if constexpr (ALIGN_EPI) { if (wr == 1) PG8_BAR; }
    }
    PG8_WAIT_V(0);
    if constexpr (!ALIGN_EPI) { if (wr == 0) PG8_BAR; }
    PG8_BAR;
#undef PG8_SA
#undef PG8_SB
#undef PG8_STAGE
#undef PG8_LDA
#undef PG8_LDB
#undef PG8_MMA
#undef PG8_WAIT_V
#undef PG8_WAIT_L
#undef PG8_BAR
#undef PG8_SCHED
}
}

constexpr int NT = 16384, SEQ = 8192, DM = 1024, DIN = 4680, NIN = 4864, NCHK = 256, NWAVES = 8, NTHR = 512;
constexpr float EPS = 1e-6f, GN_EPS = 64e-5f, DECAY_SCALE = 0.606531f;
constexpr float QSCALE = 0.07216878364870322f * 1.4426950408889634f;
constexpr size_t MiB = 1u << 20;
constexpr size_t WS_CTL = 0, CTL_BYTES = 1 * MiB;
constexpr size_t CTL_MOD = 65536;
constexpr size_t CTL_SSQ = 131072;
constexpr size_t WS_WIN = 1 * MiB;
constexpr size_t WS_CB = WS_WIN, WS_ECUM = WS_WIN + 8 * MiB, WS_CDEC = WS_ECUM + 512 * 1024;
constexpr size_t WS_WQ = 10 * MiB + 512 * 1024;
constexpr size_t WS_WUV = 11 * MiB;
constexpr size_t WS_WLW = 11 * MiB + 512 * 1024;
constexpr size_t WS_WLA = WS_WLW + 65536;
constexpr size_t WS_WOUT = 12 * MiB;
constexpr size_t WS_XN = 15 * MiB;
constexpr size_t WS_TT = WS_XN, WS_QE = WS_XN + 16 * MiB;
constexpr size_t WS_QLAT = 47 * MiB, WS_KVL = 55 * MiB;
constexpr size_t WS_OL = WS_QLAT;
constexpr size_t WS_GATES = 63 * MiB;
constexpr size_t WS_XBC = 111 * MiB;
constexpr size_t WS_R = 143 * MiB, WS_K = 159 * MiB, WS_V = 175 * MiB;
constexpr size_t WS_F = 191 * MiB;
constexpr size_t WS_Q = 200 * MiB;
constexpr size_t WS_KVB = 224 * MiB;
constexpr size_t WS_YD = 230 * MiB;
constexpr size_t WS_ROPE = 246 * MiB;
constexpr size_t WS_HX = 250 * MiB;
constexpr size_t WS_HRKV = WS_HX + 1536 * 1024;
constexpr size_t WS_HF = WS_HRKV + 768 * 1024;
constexpr size_t WS_END = 253 * MiB;
constexpr int LDS_BYTES = 152 * 1024;

#define LDS_WAIT() asm volatile("s_waitcnt lgkmcnt(0)" ::: "memory")
__device__ __forceinline__ unsigned f2bf(float f) { unsigned u = __builtin_bit_cast(unsigned, f); return (u + 0x7fffu + ((u >> 16) & 1u)) >> 16; }
__device__ __forceinline__ unsigned pk2(float lo, float hi) { return f2bf(lo) | (f2bf(hi) << 16); }
__device__ __forceinline__ float bf2f(unsigned short b) { return __builtin_bit_cast(float, (unsigned)b << 16); }
__device__ __forceinline__ float bflo(unsigned w) { return __builtin_bit_cast(float, w << 16); }
__device__ __forceinline__ float bfhi(unsigned w) { return __builtin_bit_cast(float, w & 0xffff0000u); }
__device__ __forceinline__ float wave_sum(float v) {
#pragma unroll
    for (int o = 1; o < 64; o <<= 1) v += __shfl_xor(v, o);
    return v;
}
__device__ __forceinline__ float sigmoidf_(float x) { return 1.f / (1.f + __expf(-x)); }
__device__ __forceinline__ float siluf_(float x) { return x / (1.f + __expf(-x)); }
__device__ __forceinline__ int pi16(int n) { const int x = n & 15; return (n & ~15) | ((x >= 4 && x < 8) ? x + 4 : (x >= 8 && x < 12) ? x - 4 : x); }
__device__ __forceinline__ int sg32(int x) { return (x & ~31) | (16 * ((x >> 2) & 1) + 4 * ((x & 31) >> 3) + (x & 3)); }
__device__ __forceinline__ int crow(int r, int hi) { return (r & 3) + 8 * (r >> 2) + 4 * hi; }

template <int K> __device__ __forceinline__ f32x4 mma_tile(const LAS bf16_t* A, int lda, const LAS bf16_t* Bt, int ldb, int lane) {
    f32x4 acc = {0.f, 0.f, 0.f, 0.f};
    const LAS bf16_t* ap = A + (lane & 15) * lda + (lane >> 4) * 8;
    const LAS bf16_t* bp = Bt + (lane & 15) * ldb + (lane >> 4) * 8;
#pragma unroll
    for (int k = 0; k < K; k += 32) {
        const bf16x8 a = *(const LAS bf16x8*)(ap + k), b = *(const LAS bf16x8*)(bp + k);
        acc = __builtin_amdgcn_mfma_f32_16x16x32_bf16(a, b, acc, 0, 0, 0);
    }
    return acc;
}

struct Args {
    const float* in[31]; float* out; unsigned char* ws; int ph_lo, ph_hi;
};
struct Ctx {
    LAS unsigned char* lds; int tid, lane, wave, G, bid;
    unsigned char* ws; float* out;
    const float* const* in;
};
__device__ __forceinline__ const float* ldin(const float* const* in, int i) { asm volatile("" : "+s"(i)); return in[i]; }
#define INP(i) ldin(F.in, i)
__device__ __forceinline__ int fresh_lane() { int l_ = (int)__builtin_amdgcn_mbcnt_hi(~0u, __builtin_amdgcn_mbcnt_lo(~0u, 0u)); asm volatile("" : "+v"(l_)); return l_; }
enum { I_X = 0, I_C, I_POS, I_ADAW, I_ADAB, I_NORMW, I_WIN, I_QNW, I_WUQ, I_KVNW, I_WUKV, I_CONVW, I_CONVB, I_DTB, I_ALOG, I_DSKIP, I_SSDNW,
       I_MURKV, I_MUW, I_MUA, I_W0, I_WLB, I_A0, I_ALB, I_KK, I_KA, I_RK, I_LNXW, I_LNXB, I_WOUT, I_FNW };

__device__ __forceinline__ int win_src_col(int n) {
    if (n < 448) return n;
    if (n < 512) return -1;
    if (n < 1024) return 448 + (n - 512);
    if (n < 1536) return 960 + (n - 1024);
    if (n < 2560) return 1472 + (n - 1536);
    if (n < 3072) return 2504 + (n - 2560);
    if (n < 3584) return 3016 + (n - 3072);
    if (n < 4096) return 3528 + (n - 3584);
    if (n < 4608) return 4168 + (n - 4096);
    if (n < 4672) return 4040 + (n - 4608);
    if (n < 4736) return 4104 + (n - 4672);
    if (n < 4744) return 2496 + (n - 4736);
    return -1;
}
template <class Src> __device__ __forceinline__ void transpose_item(const Src& src, bf16_t* WT, int ldw, LAS float* scr, int kb, int nb, int lane) {
    const int k0 = 64 * kb, n0 = 32 * nb;
#pragma unroll 8
    for (int i = 0; i < 32; ++i) { const int kk = 2 * i + (lane >> 5); scr[kk * 33 + (lane & 31)] = src(k0 + kk, n0 + (lane & 31)); }
    LDS_WAIT();
    const int c = lane & 7;
#pragma unroll
    for (int j = 0; j < 4; ++j) { const int n = (lane >> 3) + 8 * j; const LAS float* s = scr + (8 * c) * 33 + n;
        u32x4 o; o.x = pk2(s[0 * 33], s[1 * 33]); o.y = pk2(s[2 * 33], s[3 * 33]); o.z = pk2(s[4 * 33], s[5 * 33]); o.w = pk2(s[6 * 33], s[7 * 33]);
        *(u32x4*)(WT + (size_t)(n0 + n) * ldw + k0 + 8 * c) = o; }
    LDS_WAIT();
}
__device__ __forceinline__ void prep_weights(const Ctx& F, int l) {
    LAS float* scr = (LAS float*)(F.lds + F.wave * 8448);
    const int gw = F.bid * NWAVES + F.wave, NGW = F.G * NWAVES;
    const float* w_in = INP(I_WIN) + (size_t)l * DM * DIN;
    const float* w_out = INP(I_WOUT) + (size_t)l * 1536 * 1024;
    const float* wlb = INP(I_WLB) + (size_t)l * 64 * 512;
    const float* alb = INP(I_ALB) + (size_t)l * 64 * 512;
    bf16_t* WIN = (bf16_t*)(F.ws + WS_WIN); bf16_t* WOUT = (bf16_t*)(F.ws + WS_WOUT); bf16_t* WLW = (bf16_t*)(F.ws + WS_WLW); bf16_t* WLA = (bf16_t*)(F.ws + WS_WLA);
    constexpr int I_IN = 16 * (NIN / 32), I_OUT = 24 * 32, I_LW = 16, I_LA = 16, NITEMS = I_IN + I_OUT + I_LW + I_LA;
    for (int it = gw; it < NITEMS; it += NGW) {
        int r = it;
        if (r < I_IN) { const int kb = r / (NIN / 32), nb = r % (NIN / 32);
            transpose_item([&](int k, int n) { const int sc = win_src_col(n); return sc >= 0 ? w_in[(size_t)k * DIN + sc] : 0.f; }, WIN, 1024, scr, kb, nb, F.lane); continue; }
        r -= I_IN;
        if (r < I_OUT) { const int kb = r / 32, nb = r % 32;
            transpose_item([&](int k, int n) { return w_out[(size_t)k * 1024 + n]; }, WOUT, 1536, scr, kb, nb, F.lane); continue; }
        r -= I_OUT;
        if (r < I_LW) { transpose_item([&](int k, int n) { return wlb[k * 512 + n]; }, WLW, 64, scr, 0, r, F.lane); continue; }
        r -= I_LW;
        transpose_item([&](int k, int n) { return alb[k * 512 + n]; }, WLA, 64, scr, 0, r, F.lane);
    }
    const float* wuq = INP(I_WUQ) + (size_t)l * 256 * 768; const float* wukv = INP(I_WUKV) + (size_t)l * 128 * 1024; const float* qnw = INP(I_QNW) + l * 256;
    bf16_t* WQ = (bf16_t*)(F.ws + WS_WQ); bf16_t* WUV = (bf16_t*)(F.ws + WS_WUV);
    const int gt = F.bid * NTHR + F.tid, NGT = F.G * NTHR;
    for (int e = gt; e < 768 * 256; e += NGT) {
        const int n = e >> 8, k = e & 255, h = n / 192, idx = n % 192; float v;
        if (idx < 128) {
            const f32x4* a = (const f32x4*)(wuq + (size_t)k * 768 + h * 192); const f32x4* b = (const f32x4*)(wukv + (size_t)idx * 1024 + h * 256);
            float s = 0.f;
#pragma unroll 8
            for (int d = 0; d < 32; ++d) { const f32x4 x = a[d], y = b[d]; s += x.x * y.x + x.y * y.y + x.z * y.z + x.w * y.w; }
            v = s;
        } else v = wuq[(size_t)k * 768 + n];
        WQ[e] = (bf16_t)f2bf(v * qnw[k]);
    }
    for (int e = gt; e < 512 * 512; e += NGT) {
        const int n = e >> 9, k = e & 511, h = n >> 7, d = n & 127, h2 = k >> 7, c = k & 127;
        WUV[e] = (h == h2) ? (bf16_t)f2bf(wukv[(size_t)c * 1024 + h * 256 + 128 + d]) : (bf16_t)0;
    }
}
__device__ __forceinline__ void p0_prologue(const Ctx& F) {
    prep_weights(F, 0);
    const int gw = F.bid * NWAVES + F.wave, NGW = F.G * NWAVES;
    float* MOD = (float*)(F.ws + WS_CTL + CTL_MOD);
    for (int it = gw; it < 2 * 12 * 32; it += NGW) {
        const int l = it / 384, r = it % 384, cb = r / 32, ks = r % 32;
        const float* aw = INP(I_ADAW) + (size_t)l * DM * 3072 + (size_t)(ks * 32) * 3072 + cb * 256 + F.lane * 4;
        const float* cc = INP(I_C);
        f32x4 a0 = {0.f, 0.f, 0.f, 0.f}, a1 = a0;
#pragma unroll 8
        for (int k = 0; k < 32; ++k) { const f32x4 w = *(const f32x4*)(aw + (size_t)k * 3072); const float s0 = siluf_(cc[ks * 32 + k]), s1 = siluf_(cc[DM + ks * 32 + k]); a0 += w * s0; a1 += w * s1; }
        if (ks == 0) { const f32x4 bb = *(const f32x4*)(INP(I_ADAB) + l * 3072 + cb * 256 + F.lane * 4); a0 += bb; a1 += bb; }
        float* m0 = MOD + (size_t)(l * 2 + 0) * 3072 + cb * 256 + F.lane * 4; float* m1 = m0 + 3072;
#pragma unroll
        for (int j = 0; j < 4; ++j) { atomicAdd(m0 + j, a0[j]); atomicAdd(m1 + j, a1[j]); }
    }
    float* ROPE = (float*)(F.ws + WS_ROPE); const int* pos = (const int*)INP(I_POS);
    for (int e = F.bid * NTHR + F.tid; e < NT * 32; e += F.G * NTHR) {
        const int m = e >> 5, i = e & 31;
        const float invf = powf(10000.f, -(float)i / 32.f); const float ang = (float)pos[m] * invf;
        const double a = (double)ang; const double kq = __builtin_rint(a * 0.15915494309189535); const float rr = (float)(a - kq * 6.283185307179586);
        ROPE[(size_t)m * 64 + i] = cosf(rr); ROPE[(size_t)m * 64 + 32 + i] = sinf(rr);
    }
}
__device__ __forceinline__ void p1_norm(const Ctx& F, int l) {
    const float* xin = (l == 0) ? INP(I_X) : F.out;
    const float* nw = INP(I_NORMW) + l * DM; const float* MOD = (const float*)(F.ws + WS_CTL + CTL_MOD);
    bf16_t* XN = (bf16_t*)(F.ws + WS_XN);
    const int gw = F.bid * NWAVES + F.wave, NGW = F.G * NWAVES;
    for (int m = gw; m < NT; m += NGW) {
        const int b = m >> 13; const float* md = MOD + (size_t)(l * 2 + b) * 3072;
        const f32x4* xr = (const f32x4*)(xin + (size_t)m * DM) + F.lane;
        f32x4 v[4]; float s = 0.f;
#pragma unroll
        for (int j = 0; j < 4; ++j) { v[j] = xr[64 * j]; s += v[j].x * v[j].x + v[j].y * v[j].y + v[j].z * v[j].z + v[j].w * v[j].w; }
        const float rstd = 1.f / sqrtf(wave_sum(s) * (1.f / DM) + EPS);
        unsigned long long* o8 = (unsigned long long*)(XN + (size_t)m * DM) + F.lane;
#pragma unroll
        for (int j = 0; j < 4; ++j) { const int c0 = 4 * F.lane + 256 * j;
            const f32x4 w = *(const f32x4*)(nw + c0), sh = *(const f32x4*)(md + c0), sc = *(const f32x4*)(md + 1024 + c0);
            const f32x4 y = v[j] * rstd * w * (sc + 1.f) + sh;
            o8[64 * j] = (unsigned long long)pk2(y.x, y.y) | ((unsigned long long)pk2(y.z, y.w) << 32); }
    }
}
__device__ __forceinline__ u32x4 pack8(f32x4 a, f32x4 b) { u32x4 w; w.x = pk2(a[0], a[1]); w.y = pk2(a[2], a[3]); w.z = pk2(b[0], b[1]); w.w = pk2(b[2], b[3]); return w; }
struct EpiIn {
    unsigned char* ws; int l;
    __device__ __forceinline__ void operator()(const f32x4 (&acc)[2][2][4][2], const pg8::Unit& u, int wr, int wc, int fr, int fq) const {
        { int ln_ = (int)__builtin_amdgcn_mbcnt_hi(~0u, __builtin_amdgcn_mbcnt_lo(~0u, 0u)); asm volatile("" : "+v"(ln_)); fr = ln_ & 15; fq = ln_ >> 4; }
        const int pn = u.pn; size_t bo; int ld, c0;
        if (pn == 0) { bo = WS_QLAT; ld = 256; c0 = 0; } else if (pn == 1) { bo = WS_KVL; ld = 256; c0 = 0; }
        else if (pn < 4) { bo = WS_GATES; ld = 1536; c0 = (pn - 2) * 256; } else if (pn < 6) { bo = WS_GATES; ld = 1536; c0 = 512 + (pn - 4) * 256; }
        else if (pn < 10) { bo = WS_XBC; ld = 1024; c0 = (pn - 6) * 256; } else if (pn < 12) { bo = WS_R; ld = 512; c0 = (pn - 10) * 256; }
        else if (pn < 14) { bo = WS_K; ld = 512; c0 = (pn - 12) * 256; } else if (pn < 16) { bo = WS_V; ld = 512; c0 = (pn - 14) * 256; }
        else if (pn < 18) { bo = WS_GATES; ld = 1536; c0 = 1024 + (pn - 16) * 256; } else { bo = WS_F; ld = 144; c0 = 0; }
        bf16_t* base = (bf16_t*)(ws + bo); float* F = (float*)(ws + WS_F);
        float* ssq_q = (float*)(ws + WS_CTL + CTL_SSQ) + (size_t)(l * 2) * NT; float* ssq_kv = ssq_q + NT;
        const int row0 = u.pm * 256 + wr * 64 + fr, col0 = wc * 32 + 8 * fq;
        if (pn < 18) {
#pragma unroll
            for (int ai = 0; ai < 2; ++ai)
#pragma unroll
                for (int m = 0; m < 4; ++m) { const int row = row0 + ai * 128 + m * 16; bf16_t* rp = base + (size_t)row * ld + c0 + col0;
#pragma unroll
                    for (int bj = 0; bj < 2; ++bj) *(u32x4*)(rp + bj * 128) = pack8(acc[ai][bj][m][0], acc[ai][bj][m][1]);
                    if (pn < 2) { float s = 0.f;
#pragma unroll
                        for (int bj = 0; bj < 2; ++bj) if (pn == 0 || bj == 0) {
#pragma unroll
                            for (int n = 0; n < 2; ++n) { const f32x4 x = acc[ai][bj][m][n]; s += x[0] * x[0] + x[1] * x[1] + x[2] * x[2] + x[3] * x[3]; } }
                        s += __shfl_xor(s, 16); s += __shfl_xor(s, 32);
                        if (fq == 0) atomicAdd((pn == 0 ? ssq_q : ssq_kv) + row, s); } }
        } else {
#pragma unroll
            for (int ai = 0; ai < 2; ++ai)
#pragma unroll
                for (int m = 0; m < 4; ++m) { const int row = row0 + ai * 128 + m * 16;
#pragma unroll
                    for (int bj = 0; bj < 2; ++bj) { const int c = bj * 128 + col0; if (c < 136) { float* fp = F + (size_t)row * 144 + c; *(f32x4*)fp = acc[ai][bj][m][0]; *(f32x4*)(fp + 4) = acc[ai][bj][m][1]; } } }
        }
    }
};
struct EpiQ {
    unsigned char* ws; int l;
    __device__ __forceinline__ void operator()(const f32x4 (&acc)[2][2][4][2], const pg8::Unit& u, int wr, int wc, int fr, int fq) const {
        { int ln_ = (int)__builtin_amdgcn_mbcnt_hi(~0u, __builtin_amdgcn_mbcnt_lo(~0u, 0u)); asm volatile("" : "+v"(ln_)); fr = ln_ & 15; fq = ln_ >> 4; }
        bf16_t* Q = (bf16_t*)(ws + WS_Q); const float* ssq = (const float*)(ws + WS_CTL + CTL_SSQ) + (size_t)(l * 2) * NT;
        const int row0 = u.pm * 256 + wr * 64 + fr, c0 = u.pn * 256 + wc * 32 + 8 * fq;
#pragma unroll
        for (int ai = 0; ai < 2; ++ai)
#pragma unroll
            for (int m = 0; m < 4; ++m) { const int row = row0 + ai * 128 + m * 16; const float sc = QSCALE / sqrtf(ssq[row] * (1.f / 256.f) + EPS); bf16_t* qp = Q + (size_t)row * 768 + c0;
#pragma unroll
                for (int bj = 0; bj < 2; ++bj) *(u32x4*)(qp + bj * 128) = pack8(acc[ai][bj][m][0] * sc, acc[ai][bj][m][1] * sc); }
    }
};
struct EpiUV {
    bf16_t* gates;
    __device__ __forceinline__ void operator()(const f32x4 (&acc)[2][2][4][2], const pg8::Unit& u, int wr, int wc, int fr, int fq) const {
        { int ln_ = (int)__builtin_amdgcn_mbcnt_hi(~0u, __builtin_amdgcn_mbcnt_lo(~0u, 0u)); asm volatile("" : "+v"(ln_)); fr = ln_ & 15; fq = ln_ >> 4; }
        const int row0 = u.pm * 256 + wr * 64 + fr;
#pragma unroll
        for (int ai = 0; ai < 2; ++ai)
#pragma unroll
            for (int m = 0; m < 4; ++m) { asm volatile("" ::: "memory"); const int row = row0 + ai * 128 + m * 16;
#pragma unroll
                for (int bj = 0; bj < 2; ++bj) { const int c = u.pn * 256 + bj * 128 + wc * 32 + 8 * fq; u32x4* gp = (u32x4*)(gates + (size_t)row * 1536 + c); const u32x4 gw = *gp;
                    f32x4 v0 = acc[ai][bj][m][0], v1 = acc[ai][bj][m][1];
                    v0[0] *= siluf_(bflo(gw.x)); v0[1] *= siluf_(bfhi(gw.x)); v0[2] *= siluf_(bflo(gw.y)); v0[3] *= siluf_(bfhi(gw.y));
                    v1[0] *= siluf_(bflo(gw.z)); v1[1] *= siluf_(bfhi(gw.z)); v1[2] *= siluf_(bflo(gw.w)); v1[3] *= siluf_(bfhi(gw.w));
                    *gp = pack8(v0, v1); } }
    }
};
struct EpiOut {
    const float* xin; float* xout; const float* gate;
    __device__ __forceinline__ void operator()(const f32x4 (&acc)[2][2][4][2], const pg8::Unit& u, int wr, int wc, int fr, int fq) const {
        { int ln_ = (int)__builtin_amdgcn_mbcnt_hi(~0u, __builtin_amdgcn_mbcnt_lo(~0u, 0u)); asm volatile("" : "+v"(ln_)); fr = ln_ & 15; fq = ln_ >> 4; }
        const int row0 = u.pm * 256 + wr * 64 + fr;
#pragma unroll
        for (int bj = 0; bj < 2; ++bj) { const int c = u.pn * 256 + bj * 128 + wc * 32 + 8 * fq;
#pragma unroll
            for (int ai = 0; ai < 2; ++ai)
#pragma unroll
                for (int m = 0; m < 4; ++m) { const int row = row0 + ai * 128 + m * 16; const float* gp = gate + (size_t)(row >> 13) * 3072 + c;
                    const f32x4 g0 = *(const f32x4*)gp, g1 = *(const f32x4*)(gp + 4);
                    const size_t off = (size_t)row * DM + c; const f32x4 x0 = *(const f32x4*)(xin + off), x1 = *(const f32x4*)(xin + off + 4);
                    *(f32x4*)(xout + off) = x0 + g0 * acc[ai][bj][m][0]; *(f32x4*)(xout + off + 4) = x1 + g1 * acc[ai][bj][m][1]; } }
    }
};

__device__ __forceinline__ void p3a_extras(const Ctx& F, int l) {
    const int tid_ = F.wave * 64 + fresh_lane();
    const int gt = F.bid * NTHR + tid_, NGT = F.G * NTHR;
    const bf16_t* KVL = (const bf16_t*)(F.ws + WS_KVL); bf16_t* KVB = (bf16_t*)(F.ws + WS_KVB);
    const float* ssq = (const float*)(F.ws + WS_CTL + CTL_SSQ) + (size_t)(l * 2 + 1) * NT; const float* kvnw = INP(I_KVNW) + l * 128;
    const float* ROPE = (const float*)(F.ws + WS_ROPE);
    for (int e = gt; e < NT * 24; e += NGT) {
        const int m = e / 24, g = e % 24;
        if (g < 16) {
            const u32x4 w = *(const u32x4*)(KVL + (size_t)m * 256 + 8 * g); const float rs = 1.f / sqrtf(ssq[m] * (1.f / 128.f) + EPS);
            const f32x4 n0 = *(const f32x4*)(kvnw + 8 * g), n1 = *(const f32x4*)(kvnw + 8 * g + 4);
            u32x4 o; o.x = pk2(bflo(w.x) * rs * n0[0], bfhi(w.x) * rs * n0[1]); o.y = pk2(bflo(w.y) * rs * n0[2], bfhi(w.y) * rs * n0[3]);
            o.z = pk2(bflo(w.z) * rs * n1[0], bfhi(w.z) * rs * n1[1]); o.w = pk2(bflo(w.w) * rs * n1[2], bfhi(w.w) * rs * n1[3]);
            *(u32x4*)(KVB + (size_t)m * 192 + 8 * g) = o;
        } else {
            const int i0 = 4 * (g - 16);
            const u32x2 a = *(const u32x2*)(KVL + (size_t)m * 256 + 128 + i0), b = *(const u32x2*)(KVL + (size_t)m * 256 + 160 + i0);
            const f32x4 cs = *(const f32x4*)(ROPE + (size_t)m * 64 + i0), sn = *(const f32x4*)(ROPE + (size_t)m * 64 + 32 + i0);
            const f32x4 x1 = {bflo(a.x), bfhi(a.x), bflo(a.y), bfhi(a.y)}, x2 = {bflo(b.x), bfhi(b.x), bflo(b.y), bfhi(b.y)};
            const f32x4 o1 = x1 * cs - x2 * sn, o2 = x1 * sn + x2 * cs;
            u32x2 w1, w2; w1.x = pk2(o1[0], o1[1]); w1.y = pk2(o1[2], o1[3]); w2.x = pk2(o2[0], o2[1]); w2.y = pk2(o2[2], o2[3]);
            *(u32x2*)(KVB + (size_t)m * 192 + 128 + i0) = w1; *(u32x2*)(KVB + (size_t)m * 192 + 160 + i0) = w2;
        }
    }
    const u32x4* XBC = (const u32x4*)(F.ws + WS_XBC); u32x4* HX = (u32x4*)(F.ws + WS_HX);
    for (int e = gt; e < NCHK * 3 * 128; e += NGT) { const int c = e / 384, r = e % 384, j = r >> 7, p = r & 127; HX[e] = XBC[(size_t)(64 * c + 61 + j) * 128 + p]; }
    u32x4* HR = (u32x4*)(F.ws + WS_HRKV);
    for (int e = gt; e < 3 * NCHK * 64; e += NGT) { const int w = e / (NCHK * 64), r = e % (NCHK * 64), c = r >> 6, p = r & 63;
        const u32x4* src = (const u32x4*)(F.ws + (w == 0 ? WS_R : w == 1 ? WS_K : WS_V)); HR[e] = src[(size_t)(64 * c + 63) * 64 + p]; }
    const f32x4* FF = (const f32x4*)(F.ws + WS_F); f32x4* HF = (f32x4*)(F.ws + WS_HF);
    for (int e = gt; e < NCHK * 32; e += NGT) { const int c = e >> 5, p = e & 31; HF[e] = FF[(size_t)(64 * c + 63) * 36 + p]; }
}

__device__ __forceinline__ int ssd_win_col(int g, int o) { return o < 256 ? 256 * g + o : o < 384 ? 512 + 128 * g + (o - 256) : 768 + 128 * g + (o - 384); }
__device__ __forceinline__ void p3b_ssd(const Ctx& F, int l) {
    constexpr int SC_C = 0, SC_B = 17408, SC_BT = 34816, SC_XST = 53248, SC_CB = 90112, SC_G = 106752, SC_XSD = 115968, SC_DT = 125184, SC_AC = 127232;
    LAS bf16_t* Cg = (LAS bf16_t*)(F.lds + SC_C); LAS bf16_t* Bg = (LAS bf16_t*)(F.lds + SC_B); LAS bf16_t* BT = (LAS bf16_t*)(F.lds + SC_BT);
    LAS bf16_t* XST = (LAS bf16_t*)(F.lds + SC_XST); LAS float* CB = (LAS float*)(F.lds + SC_CB); LAS bf16_t* Gh = (LAS bf16_t*)(F.lds + SC_G);
    LAS bf16_t* XSD = (LAS bf16_t*)(F.lds + SC_XSD); LAS float* DT = (LAS float*)(F.lds + SC_DT); LAS float* AC = (LAS float*)(F.lds + SC_AC);
    bf16_t* XBC = (bf16_t*)(F.ws + WS_XBC); const bf16_t* HX = (const bf16_t*)(F.ws + WS_HX); const float* Ff = (const float*)(F.ws + WS_F);
    bf16_t* Cbuf = (bf16_t*)(F.ws + WS_CB); float* ECUM = (float*)(F.ws + WS_ECUM); float* CDEC = (float*)(F.ws + WS_CDEC); bf16_t* YD = (bf16_t*)(F.ws + WS_YD);
    const float* convw = INP(I_CONVW) + (size_t)l * 4 * 1024; const float* convb = INP(I_CONVB) + l * 1024;
    const float* dtb = INP(I_DTB) + l * 8; const float* alog = INP(I_ALOG) + l * 8; const float* dskip = INP(I_DSKIP) + l * 8;
    const int tid = F.tid, lane = F.lane, wave = F.wave;
    for (int c = F.bid; c < NCHK; c += F.G) {
        const int m0 = 64 * c; const bool first = (c & 127) == 0;
        if (wave == 0) {
            const int t = lane;
#pragma unroll
            for (int h = 0; h < 8; ++h) {
                const float raw = Ff[(size_t)(m0 + t) * 144 + 128 + h] + dtb[h];
                const float dt = raw > 20.f ? raw : log1pf(expf(raw));
                float v = dt * (-expf(alog[h]));
#pragma unroll
                for (int o = 1; o < 64; o <<= 1) { const float y = __shfl_up(v, o); if (lane >= o) v += y; }
                DT[t * 8 + h] = dt; AC[t * 8 + h] = v;
                const float ev = expf(v); ECUM[(size_t)(c * 8 + h) * 64 + t] = ev; if (t == 63) CDEC[c * 8 + h] = ev;
            }
        }
        for (int g = 0; g < 2; ++g) {
            {
                const int col = ssd_win_col(g, tid);
                const float w0 = convw[col], w1 = convw[1024 + col], w2 = convw[2048 + col], w3 = convw[3072 + col], cb = convb[col];
                float h0 = 0.f, h1 = 0.f, h2 = 0.f;
                if (!first) { h0 = bf2f(HX[(size_t)((c - 1) * 3 + 0) * 1024 + col]); h1 = bf2f(HX[(size_t)((c - 1) * 3 + 1) * 1024 + col]); h2 = bf2f(HX[(size_t)((c - 1) * 3 + 2) * 1024 + col]); }
#pragma unroll 8
                for (int t = 0; t < 64; ++t) {
                    const float x = bf2f(XBC[(size_t)(m0 + t) * 1024 + col]);
                    const float u = w0 * h0 + w1 * h1 + w2 * h2 + w3 * x + cb; h0 = h1; h1 = h2; h2 = x;
                    const bf16_t bv = (bf16_t)f2bf(siluf_(u));
                    if (tid < 256) XST[tid * 72 + t] = bv;
                    else if (tid < 384) { const int n = tid - 256; Bg[t * 136 + n] = bv; BT[n * 72 + t] = bv; }
                    else { const int n = tid - 384; Cg[t * 136 + n] = bv; Cbuf[(size_t)(m0 + t) * 256 + g * 128 + n] = bv; }
                }
            }
            __syncthreads();
#pragma unroll
            for (int i = 0; i < 2; ++i) { const int idx = 2 * wave + i, ti = idx >> 2, si = idx & 3;
                const f32x4 acc = mma_tile<128>(Cg + ti * 16 * 136, 136, Bg + si * 16 * 136, 136, lane);
#pragma unroll
                for (int r = 0; r < 4; ++r) CB[(ti * 16 + 4 * (lane >> 4) + r) * 65 + si * 16 + (lane & 15)] = acc[r]; }
            __syncthreads();
            for (int hl = 0; hl < 4; ++hl) {
                const int h = 4 * g + hl;
                {   const int t = tid >> 3, s0 = (tid & 7) * 8; const float at = AC[t * 8 + h], a63 = AC[63 * 8 + h];
                    float gv[8], xv[8]; const u32x4 xw = *(const LAS u32x4*)(XST + (64 * hl + t) * 72 + s0);
                    const float xf[8] = {bflo(xw.x), bfhi(xw.x), bflo(xw.y), bfhi(xw.y), bflo(xw.z), bfhi(xw.z), bflo(xw.w), bfhi(xw.w)};
#pragma unroll
                    for (int j = 0; j < 8; ++j) { const int s = s0 + j; const float as = AC[s * 8 + h], ds = DT[s * 8 + h];
                        gv[j] = (s <= t) ? CB[t * 65 + s] * expf(at - as) * ds : 0.f; xv[j] = xf[j] * ds * expf(a63 - as); }
                    u32x4 o; o.x = pk2(gv[0], gv[1]); o.y = pk2(gv[2], gv[3]); o.z = pk2(gv[4], gv[5]); o.w = pk2(gv[6], gv[7]); *(LAS u32x4*)(Gh + t * 72 + s0) = o;
                    o.x = pk2(xv[0], xv[1]); o.y = pk2(xv[2], xv[3]); o.z = pk2(xv[4], xv[5]); o.w = pk2(xv[6], xv[7]); *(LAS u32x4*)(XSD + t * 72 + s0) = o; }
                __syncthreads();
                const float dsk = dskip[h];
#pragma unroll
                for (int i = 0; i < 2; ++i) { const int idx = 2 * wave + i, ti = idx >> 2, pi = idx & 3;
                    const f32x4 acc = mma_tile<64>(Gh + ti * 16 * 72, 72, XST + (64 * hl + 16 * pi) * 72, 72, lane);
#pragma unroll
                    for (int r = 0; r < 4; ++r) { const int t = ti * 16 + 4 * (lane >> 4) + r, p = pi * 16 + (lane & 15);
                        const float y = acc[r] + dsk * bf2f(XST[(64 * hl + p) * 72 + t]); YD[(size_t)(m0 + t) * 512 + 64 * h + p] = (bf16_t)f2bf(y); } }
#pragma unroll
                for (int i = 0; i < 4; ++i) { const int idx = 4 * wave + i, pi = idx >> 3, ni = idx & 7;
                    const f32x4 acc = mma_tile<64>(XSD + pi * 16 * 72, 72, BT + ni * 16 * 72, 72, lane);
#pragma unroll
                    for (int r = 0; r < 4; ++r) { const int p = pi * 16 + 4 * (lane >> 4) + r, n = ni * 16 + (lane & 15);
                        const int f = hl * 8192 + p * 128 + n, row = f >> 9, col = ssd_win_col(g, f & 511);
                        XBC[(size_t)(m0 + row) * 1024 + col] = (bf16_t)f2bf(acc[r]); } }
                __syncthreads();
            }
        }
    }
}

__device__ __forceinline__ void p3c_rwkv(const Ctx& F, int l) {
    constexpr int M9 = 9216, O_TW = 0, O_AL = 9216, O_SL = 18432, O_MAB = O_SL + 12 * M9  , O_LWF = O_SL + 10 * M9  , O_ICF = O_LWF + 16640, O_WL = O_MAB + 16640  , O_SCR = O_WL + 256;
    static_assert(O_ICF + 16640 <= O_MAB + 16640 && O_SCR + 4224 <= LDS_BYTES, "rwkv lds map");
#define LB() ({ LAS unsigned char* p_ = F.lds; asm volatile("" : "+s"(p_)); p_; })
#define SLOT(i) ((LAS bf16_t*)(L + O_SL + (i) * M9))
#define TW ((LAS bf16_t*)(L + O_TW))
#define AL ((LAS bf16_t*)(L + O_AL))
#define AT SLOT(0)
#define ATt SLOT(1)
#define BTl SLOT(2)
#define KTl SLOT(3)
#define RT SLOT(4)
#define BHt SLOT(5)
#define KH SLOT(6)
#define VT SLOT(7)
#define MI SLOT(8)
#define MakT SLOT(9)
#define Rb SLOT(10)
#define Rk SLOT(11)
#define Attn SLOT(0)
#define KEt SLOT(1)
#define X1t SLOT(2)
#define X2t SLOT(3)
#define S8 SLOT(8)
#define S9 SLOT(9)
#define MAB ((LAS float*)(L + O_MAB))
#define LWf ((LAS float*)(L + O_LWF))
#define ICf ((LAS float*)(L + O_ICF))
#define WL ((LAS float*)(L + O_WL))
#define SCR ((LAS float*)(L + O_SCR))
    const int tid = F.tid, lane = F.lane, wave = F.wave;
    for (int c = F.bid; c < NCHK; c += F.G) {
        const int m0 = 64 * c; const bool first = (c & 127) == 0;
        {
            LAS unsigned char* L = LB();
            const int t = tid >> 3, q0 = (tid & 7) * 8;
            const float* Ff = (const float*)(F.ws + WS_F); const float* HF = (const float*)(F.ws + WS_HF); const float* mu_w = INP(I_MUW) + l * 64; const float* mu_a = INP(I_MUA) + l * 64;
            float cw[8], pw[8], ca[8], pa[8];
            const float* cur = Ff + (size_t)(m0 + t) * 144; const float* prv = (t > 0) ? cur - 144 : HF + (size_t)(c - 1) * 128;
#pragma unroll
            for (int j = 0; j < 8; ++j) { cw[j] = cur[q0 + j]; ca[j] = cur[64 + q0 + j]; }
            if (t > 0) {
#pragma unroll
                for (int j = 0; j < 8; ++j) { pw[j] = prv[q0 + j]; pa[j] = prv[64 + q0 + j]; }
            } else if (!first) {
#pragma unroll
                for (int j = 0; j < 8; ++j) { pw[j] = prv[q0 + j]; pa[j] = prv[64 + q0 + j]; }
            } else {
#pragma unroll
                for (int j = 0; j < 8; ++j) { pw[j] = 0.f; pa[j] = 0.f; }
            }
            float ow[8], oa[8];
#pragma unroll
            for (int j = 0; j < 8; ++j) { ow[j] = tanhf(cw[j] + (pw[j] - cw[j]) * mu_w[q0 + j]); oa[j] = ca[j] + (pa[j] - ca[j]) * mu_a[q0 + j]; }
            u32x4 o; o.x = pk2(ow[0], ow[1]); o.y = pk2(ow[2], ow[3]); o.z = pk2(ow[4], ow[5]); o.w = pk2(ow[6], ow[7]); *(LAS u32x4*)(TW + t * 72 + q0) = o;
            o.x = pk2(oa[0], oa[1]); o.y = pk2(oa[2], oa[3]); o.z = pk2(oa[4], oa[5]); o.w = pk2(oa[6], oa[7]); *(LAS u32x4*)(AL + t * 72 + q0) = o;
        }
        for (int h = 0; h < 8; ++h) {
            int tid = F.tid, lane = F.lane; asm volatile("" : "+v"(tid), "+v"(lane));
            {   LAS unsigned char* L = LB(); const int row = tid >> 3, c8 = tid & 7; const bf16_t* WLW = (const bf16_t*)(F.ws + WS_WLW); const bf16_t* WLA = (const bf16_t*)(F.ws + WS_WLA);
                *(LAS u32x4*)(S8 + row * 72 + c8 * 8) = *(const u32x4*)(WLW + (size_t)(h * 64 + row) * 64 + c8 * 8);
                *(LAS u32x4*)(S9 + row * 72 + c8 * 8) = *(const u32x4*)(WLA + (size_t)(h * 64 + row) * 64 + c8 * 8); }
            __syncthreads();
            { LAS unsigned char* L = LB(); const float* w0 = INP(I_W0) + l * 512; const float* a0 = INP(I_A0) + l * 512;
#pragma unroll
            for (int i = 0; i < 4; ++i) { const int idx = 4 * wave + i, which = idx >> 4, ti = (idx >> 2) & 3, ci = idx & 3;
                const f32x4 acc = mma_tile<64>((which ? AL : TW) + ti * 16 * 72, 72, (which ? S9 : S8) + ci * 16 * 72, 72, lane);
#pragma unroll
                for (int r = 0; r < 4; ++r) { const int t = ti * 16 + 4 * (lane >> 4) + r, ch = ci * 16 + (lane & 15);
                    if (which == 0) LWf[t * 65 + ch] = -DECAY_SCALE * sigmoidf_(acc[r] + w0[h * 64 + ch]); else ICf[t * 65 + ch] = sigmoidf_(acc[r] + a0[h * 64 + ch]); } } }
            __syncthreads();
            if (wave == 0) { LAS unsigned char* L = LB(); float run = 0.f;
#pragma unroll 8
                for (int t = 0; t < 64; ++t) { run += LWf[t * 65 + lane]; LWf[t * 65 + lane] = run; }
                WL[lane] = expf(run); }
            __syncthreads();
            float bonv[8]; const int t1 = tid >> 3, ch0 = (tid & 7) * 8, col1 = h * 64 + ch0;
            {   LAS unsigned char* L = LB(); const int t = t1;
                const bf16_t* Rg = (const bf16_t*)(F.ws + WS_R); const bf16_t* Kg = (const bf16_t*)(F.ws + WS_K); const bf16_t* Vg = (const bf16_t*)(F.ws + WS_V); const bf16_t* HR = (const bf16_t*)(F.ws + WS_HRKV);
                const float* mu_r = INP(I_MURKV) + (size_t)l * 1536; const float* mu_k = mu_r + 512; const float* mu_v = mu_r + 1024;
                const float* kkp = INP(I_KK) + l * 512; const float* kap = INP(I_KA) + l * 512; const float* rkp = INP(I_RK) + l * 512;
                const size_t off = (size_t)(m0 + t) * 512 + col1;
                const u32x4 rw = *(const u32x4*)(Rg + off), kw = *(const u32x4*)(Kg + off), vw = *(const u32x4*)(Vg + off);
                u32x4 rp = {0u, 0u, 0u, 0u}, kp = rp, vp = rp;
                if (t > 0) { rp = *(const u32x4*)(Rg + off - 512); kp = *(const u32x4*)(Kg + off - 512); vp = *(const u32x4*)(Vg + off - 512); }
                else if (!first) { const size_t ho = (size_t)(c - 1) * 512 + col1; rp = *(const u32x4*)(HR + ho); kp = *(const u32x4*)(HR + (size_t)NCHK * 512 + ho); vp = *(const u32x4*)(HR + (size_t)2 * NCHK * 512 + ho); }
                const unsigned rwa[4] = {rw.x, rw.y, rw.z, rw.w}, kwa[4] = {kw.x, kw.y, kw.z, kw.w}, vwa[4] = {vw.x, vw.y, vw.z, vw.w};
                const unsigned rpa[4] = {rp.x, rp.y, rp.z, rp.w}, kpa[4] = {kp.x, kp.y, kp.z, kp.w}, vpa[4] = {vp.x, vp.y, vp.z, vp.w};
                float rs[8], ks[8], vs[8], kkv[8], k2[8], ic[8]; float ss = 0.f, bs = 0.f;
#pragma unroll
                for (int j = 0; j < 8; ++j) { const int gch = col1 + j; const int q = j >> 1;
                    const float r_ = (j & 1) ? bfhi(rwa[q]) : bflo(rwa[q]), rq = (j & 1) ? bfhi(rpa[q]) : bflo(rpa[q]);
                    const float k_ = (j & 1) ? bfhi(kwa[q]) : bflo(kwa[q]), kq = (j & 1) ? bfhi(kpa[q]) : bflo(kpa[q]);
                    const float v_ = (j & 1) ? bfhi(vwa[q]) : bflo(vwa[q]), vq = (j & 1) ? bfhi(vpa[q]) : bflo(vpa[q]);
                    rs[j] = r_ + (rq - r_) * mu_r[gch]; ks[j] = k_ + (kq - k_) * mu_k[gch]; vs[j] = v_ + (vq - v_) * mu_v[gch];
                    ic[j] = ICf[t * 65 + ch0 + j];
                    kkv[j] = ks[j] * kkp[gch]; ss += kkv[j] * kkv[j];
                    k2[j] = ks[j] * (1.f + (ic[j] - 1.f) * kap[gch]); bs += rs[j] * k2[j] * rkp[gch]; }
                ss += __shfl_xor(ss, 1); ss += __shfl_xor(ss, 2); ss += __shfl_xor(ss, 4);
                bs += __shfl_xor(bs, 1); bs += __shfl_xor(bs, 2); bs += __shfl_xor(bs, 4);
                const float inv = 1.f / fmaxf(sqrtf(ss), 1e-12f);
                float vAT[8], vB[8], vK[8], vR[8], vBH[8], vKH[8];
#pragma unroll
                for (int j = 0; j < 8; ++j) { const int ch = ch0 + j;
                    const float LWt = LWf[t * 65 + ch], LWp = (t > 0) ? LWf[(t - 1) * 65 + ch] : 0.f, L63 = LWf[63 * 65 + ch];
                    const float kk = kkv[j] * inv, a = -kk, b = kk * ic[j];
                    const float e1 = expf(LWt), e2 = expf(-LWt), e3 = expf(LWp), e4 = expf(L63 - LWt);
                    vAT[j] = a * e3; vB[j] = b * e2; vK[j] = k2[j] * e2; vR[j] = rs[j] * e1; vBH[j] = b * e4; vKH[j] = k2[j] * e4; bonv[j] = bs * vs[j];
                    ATt[ch * 72 + t] = (bf16_t)f2bf(vAT[j]); BHt[ch * 72 + t] = (bf16_t)f2bf(vBH[j]); VT[ch * 72 + t] = (bf16_t)f2bf(vs[j]); }
                u32x4 o;
#define PK8(A_) (o[0] = pk2(A_[0], A_[1]), o[1] = pk2(A_[2], A_[3]), o[2] = pk2(A_[4], A_[5]), o[3] = pk2(A_[6], A_[7]), o)
                *(LAS u32x4*)(AT + t * 72 + ch0) = PK8(vAT); *(LAS u32x4*)(BTl + t * 72 + ch0) = PK8(vB); *(LAS u32x4*)(KTl + t * 72 + ch0) = PK8(vK);
                *(LAS u32x4*)(RT + t * 72 + ch0) = PK8(vR); *(LAS u32x4*)(KH + t * 72 + ch0) = PK8(vKH);
            }
            __syncthreads();
            { u32x4 o; *(u32x4*)((bf16_t*)(F.ws + WS_V) + (size_t)(m0 + t1) * 512 + col1) = PK8(bonv); }
            { LAS unsigned char* L = LB();
#pragma unroll
            for (int i = 0; i < 8; ++i) { const int p = wave >> 1, idx = 8 * (wave & 1) + i, ti = idx >> 2, si = idx & 3;
                const f32x4 acc = mma_tile<64>(((p < 2) ? AT : RT) + ti * 16 * 72, 72, ((p & 1) ? KTl : BTl) + si * 16 * 72, 72, lane);
#pragma unroll
                for (int r = 0; r < 4; ++r) { const int t = ti * 16 + 4 * (lane >> 4) + r, s = si * 16 + (lane & 15);
                    if (p == 0) MAB[t * 65 + s] = (s < t) ? acc[r] : 0.f;
                    else if (p == 1) MakT[s * 72 + t] = (bf16_t)f2bf((s < t) ? acc[r] : 0.f);
                    else if (p == 2) Rb[t * 72 + s] = (bf16_t)f2bf((s <= t) ? acc[r] : 0.f);
                    else Rk[t * 72 + s] = (bf16_t)f2bf((s <= t) ? acc[r] : 0.f); } } }
            __syncthreads();
            if (wave < 4 && lane < 16) { LAS unsigned char* L = LB(); const int b0 = 16 * wave; float x[16];
#pragma unroll
                for (int t = 0; t < 16; ++t) { float v = (t == lane) ? 1.f : 0.f;
#pragma unroll
                    for (int s = 0; s < 16; ++s) if (s < t) v += MAB[(b0 + t) * 65 + b0 + s] * x[s];
                    x[t] = v; }
#pragma unroll
                for (int t = 0; t < 16; ++t) MAB[(b0 + t) * 65 + b0 + lane] = x[t]; }
            __syncthreads();
            {   LAS unsigned char* L = LB(); const int pr = tid >> 8, e = tid & 255, rr = e >> 4, cc = e & 15, rb = pr ? 48 : 16, cb = pr ? 32 : 0; float v = 0.f;
#pragma unroll
                for (int s = 0; s < 16; ++s) v += MAB[(rb + rr) * 65 + cb + s] * MAB[(cb + s) * 65 + cb + cc];
                SCR[(pr * 16 + rr) * 33 + cc] = v; }
            __syncthreads();
            {   LAS unsigned char* L = LB(); const int pr = tid >> 8, e = tid & 255, rr = e >> 4, cc = e & 15, rb = pr ? 48 : 16, cb = pr ? 32 : 0; float v = 0.f;
#pragma unroll
                for (int s = 0; s < 16; ++s) v += MAB[(rb + rr) * 65 + rb + s] * SCR[(pr * 16 + s) * 33 + cc];
                MAB[(rb + rr) * 65 + cb + cc] = v; }
            __syncthreads();
            {   LAS unsigned char* L = LB(); float v2[2];
#pragma unroll
                for (int i = 0; i < 2; ++i) { const int e = tid * 2 + i, rr = e >> 5, cc = e & 31; float v = 0.f;
#pragma unroll 8
                    for (int s = 0; s < 32; ++s) v += MAB[(32 + rr) * 65 + s] * MAB[s * 65 + cc];
                    v2[i] = v; }
                SCR[((tid * 2) >> 5) * 33 + ((tid * 2) & 31)] = v2[0]; SCR[((tid * 2 + 1) >> 5) * 33 + ((tid * 2 + 1) & 31)] = v2[1]; }
            __syncthreads();
            {   LAS unsigned char* L = LB();
#pragma unroll
                for (int i = 0; i < 2; ++i) { const int e = tid * 2 + i, rr = e >> 5, cc = e & 31; float v = 0.f;
#pragma unroll 8
                    for (int s = 0; s < 32; ++s) v += MAB[(32 + rr) * 65 + 32 + s] * SCR[s * 33 + cc];
                    MAB[(32 + rr) * 65 + cc] = v; } }
            __syncthreads();
            {   LAS unsigned char* L = LB(); const int t = tid >> 3, s0 = (tid & 7) * 8; float x[8];
#pragma unroll
                for (int j = 0; j < 8; ++j) x[j] = MAB[t * 65 + s0 + j];
                u32x4 o; *(LAS u32x4*)(MI + t * 72 + s0) = PK8(x); }
            __syncthreads();
            { LAS unsigned char* L = LB();
#pragma unroll
            for (int i = 0; i < 4; ++i) { const int idx = 4 * wave + i, which = idx >> 4, ti = (idx >> 2) & 3, ci = idx & 3;
                const f32x4 acc = mma_tile<64>(MI + ti * 16 * 72, 72, (which ? MakT : ATt) + ci * 16 * 72, 72, lane);
#pragma unroll
                for (int r = 0; r < 4; ++r) { const int t = ti * 16 + 4 * (lane >> 4) + r, j = ci * 16 + (lane & 15); (which ? X2t : X1t)[j * 72 + t] = (bf16_t)f2bf(acc[r]); } } }
            __syncthreads();
            { LAS unsigned char* L = LB();
            bf16_t* QEw = (bf16_t*)(F.ws + WS_QE) + (size_t)(c * 8 + h) * 4096; bf16_t* TTw = (bf16_t*)(F.ws + WS_TT) + (size_t)(c * 8 + h) * 4096;
#pragma unroll
            for (int i = 0; i < 8; ++i) { const int p = wave >> 1, idx = 8 * (wave & 1) + i, ti = idx >> 2, si = idx & 3;
                const f32x4 acc = mma_tile<64>(((p == 0 || p == 1) ? Rb : (p == 2) ? X1t : X2t) + ti * 16 * 72, 72, ((p == 0) ? X1t : (p == 1) ? X2t : BHt) + si * 16 * 72, 72, lane);
#pragma unroll
                for (int r = 0; r < 4; ++r) { const int rw = ti * 16 + 4 * (lane >> 4) + r, cl = si * 16 + (lane & 15);
                    if (p == 0) QEw[rw * 64 + pi16(cl)] = (bf16_t)f2bf(acc[r] + bf2f(RT[rw * 72 + cl]));
                    else if (p == 1) Attn[rw * 72 + cl] = (bf16_t)f2bf(acc[r] + bf2f(Rk[rw * 72 + cl]));
                    else if (p == 2) TTw[cl * 64 + pi16(rw)] = (bf16_t)f2bf(acc[r] + ((rw == cl) ? WL[rw] : 0.f));
                    else KEt[cl * 72 + rw] = (bf16_t)f2bf(acc[r] + bf2f(KH[rw * 72 + cl])); } } }
            __syncthreads();
            bf16_t* Rg = (bf16_t*)(F.ws + WS_R); bf16_t* Kg = (bf16_t*)(F.ws + WS_K); LAS unsigned char* L = LB();
#pragma unroll
            for (int i = 0; i < 4; ++i) { const int idx = 4 * wave + i, which = idx >> 4, ti = (idx >> 2) & 3, ci = idx & 3;
                const f32x4 acc = mma_tile<64>((which ? VT : Attn) + ti * 16 * 72, 72, (which ? KEt : VT) + ci * 16 * 72, 72, lane);
#pragma unroll
                for (int r = 0; r < 4; ++r) { const int rw = ti * 16 + 4 * (lane >> 4) + r, cl = ci * 16 + (lane & 15);
                    if (which == 0) Kg[(size_t)(m0 + cl) * 512 + h * 64 + sg32(rw)] = (bf16_t)f2bf(acc[r]);
                    else Rg[(size_t)(m0 + rw) * 512 + h * 64 + sg32(cl)] = (bf16_t)f2bf(acc[r]); } }
        }
        __syncthreads();
    }
#undef SLOT
#undef PK8
#undef LB
#undef TW
#undef AL
#undef AT
#undef ATt
#undef BTl
#undef KTl
#undef RT
#undef BHt
#undef KH
#undef VT
#undef MI
#undef MakT
#undef Rb
#undef Rk
#undef Attn
#undef KEt
#undef X1t
#undef X2t
#undef S8
#undef S9
#undef MAB
#undef LWf
#undef ICf
#undef WL
#undef SCR
}

__device__ __forceinline__ bf16x8 cvt8(const f32x16& x, int s) {
    u32x4 w; w.x = pk2(x[8 * s + 0], x[8 * s + 1]); w.y = pk2(x[8 * s + 2], x[8 * s + 3]); w.z = pk2(x[8 * s + 4], x[8 * s + 5]); w.w = pk2(x[8 * s + 6], x[8 * s + 7]);
    return __builtin_bit_cast(bf16x8, w);
}
__device__ __forceinline__ f32x16 ld16bf(const bf16_t* p) {
    const u32x4 a = *(const u32x4*)p, b = *(const u32x4*)(p + 8); f32x16 r;
    r[0] = bflo(a.x); r[1] = bfhi(a.x); r[2] = bflo(a.y); r[3] = bfhi(a.y); r[4] = bflo(a.z); r[5] = bfhi(a.z); r[6] = bflo(a.w); r[7] = bfhi(a.w);
    r[8] = bflo(b.x); r[9] = bfhi(b.x); r[10] = bflo(b.y); r[11] = bfhi(b.y); r[12] = bflo(b.z); r[13] = bfhi(b.z); r[14] = bflo(b.w); r[15] = bfhi(b.w); return r;
}
__device__ __forceinline__ void st16bf(bf16_t* p, const f32x16& x) {
    u32x4 a, b; a.x = pk2(x[0], x[1]); a.y = pk2(x[2], x[3]); a.z = pk2(x[4], x[5]); a.w = pk2(x[6], x[7]); b.x = pk2(x[8], x[9]); b.y = pk2(x[10], x[11]); b.z = pk2(x[12], x[13]); b.w = pk2(x[14], x[15]);
    *(u32x4*)p = a; *(u32x4*)(p + 8) = b;
}
constexpr int KROW = 400;
__device__ __forceinline__ void attn_unit(const Ctx& F, int b, int c) {
    const int tid = F.tid, lane = F.lane, wave = F.wave, r32 = lane & 31, hi = lane >> 5, head = wave >> 1;
    const bf16_t* Q = (const bf16_t*)(F.ws + WS_Q); const bf16_t* KV = (const bf16_t*)(F.ws + WS_KVB) + (size_t)b * SEQ * 192; bf16_t* OL = (bf16_t*)(F.ws + WS_OL);
    const size_t mq = (size_t)b * SEQ + 64 * c + 32 * (wave & 1) + r32;
    bf16x8 qr[12];
#pragma unroll
    for (int d0 = 0; d0 < 12; ++d0) qr[d0] = *(const bf16x8*)(Q + mq * 768 + head * 192 + 16 * d0 + 8 * hi);
    {
        const float* rp = (const float*)(F.ws + WS_ROPE) + mq * 64;
#pragma unroll
        for (int d0 = 8; d0 < 10; ++d0) { const int j0 = 16 * (d0 - 8) + 8 * hi;
            const f32x4 c0 = *(const f32x4*)(rp + j0), c1 = *(const f32x4*)(rp + j0 + 4), s0 = *(const f32x4*)(rp + 32 + j0), s1 = *(const f32x4*)(rp + 32 + j0 + 4);
            const u32x4 a = __builtin_bit_cast(u32x4, qr[d0]), b = __builtin_bit_cast(u32x4, qr[d0 + 2]);
            const float x1[8] = {bflo(a.x), bfhi(a.x), bflo(a.y), bfhi(a.y), bflo(a.z), bfhi(a.z), bflo(a.w), bfhi(a.w)}, x2[8] = {bflo(b.x), bfhi(b.x), bflo(b.y), bfhi(b.y), bflo(b.z), bfhi(b.z), bflo(b.w), bfhi(b.w)};
            const float cs[8] = {c0[0], c0[1], c0[2], c0[3], c1[0], c1[1], c1[2], c1[3]}, sn[8] = {s0[0], s0[1], s0[2], s0[3], s1[0], s1[1], s1[2], s1[3]};
            float o1[8], o2[8];
#pragma unroll
            for (int e = 0; e < 8; ++e) { o1[e] = x1[e] * cs[e] - x2[e] * sn[e]; o2[e] = x1[e] * sn[e] + x2[e] * cs[e]; }
            u32x4 w1, w2; w1.x = pk2(o1[0], o1[1]); w1.y = pk2(o1[2], o1[3]); w1.z = pk2(o1[4], o1[5]); w1.w = pk2(o1[6], o1[7]); w2.x = pk2(o2[0], o2[1]); w2.y = pk2(o2[2], o2[3]); w2.z = pk2(o2[4], o2[5]); w2.w = pk2(o2[6], o2[7]);
            qr[d0] = __builtin_bit_cast(bf16x8, w1); qr[d0 + 2] = __builtin_bit_cast(bf16x8, w2); }
    }
    int prow[3], pcol[3];
#pragma unroll
    for (int i = 0; i < 3; ++i) { const int idx = tid + 512 * i; prow[i] = idx / 24; pcol[i] = idx % 24; }
    const int nt = c + 1;
    u32x4 st[3];
#pragma unroll
    for (int i = 0; i < 3; ++i) st[i] = *(const u32x4*)(KV + (size_t)prow[i] * 192 + pcol[i] * 8);
#pragma unroll
    for (int i = 0; i < 3; ++i) *(LAS u32x4*)(F.lds + prow[i] * KROW + pcol[i] * 16) = st[i];
    __syncthreads();
    f32x16 o[4];
#pragma unroll
    for (int d = 0; d < 4; ++d)
#pragma unroll
        for (int r = 0; r < 16; ++r) o[d][r] = 0.f;
    float mrun = -1e30f, lrun = 0.f;
    const int troff = (4 * hi + ((lane & 15) >> 2)) * KROW + (((lane >> 4) & 1) * 16 + (lane & 3) * 4) * 2;
    for (int kt = 0; kt < nt; ++kt) {
        LAS unsigned char* buf = F.lds + (kt & 1) * (64 * KROW);
        if (kt + 1 < nt) {
#pragma unroll
            for (int i = 0; i < 3; ++i) st[i] = *(const u32x4*)(KV + (size_t)((kt + 1) * 64 + prow[i]) * 192 + pcol[i] * 8);
        }
        f32x16 p0, p1;
#pragma unroll
        for (int r = 0; r < 16; ++r) { p0[r] = 0.f; p1[r] = 0.f; }
#pragma unroll
        for (int d0 = 0; d0 < 12; ++d0) {
            const bf16x8 a0 = *(const LAS bf16x8*)(buf + r32 * KROW + d0 * 32 + hi * 16), a1 = *(const LAS bf16x8*)(buf + (32 + r32) * KROW + d0 * 32 + hi * 16);
            p0 = __builtin_amdgcn_mfma_f32_32x32x16_bf16(a0, qr[d0], p0, 0, 0, 0); p1 = __builtin_amdgcn_mfma_f32_32x32x16_bf16(a1, qr[d0], p1, 0, 0, 0);
        }
        float mx = p0[0];
#pragma unroll
        for (int r = 0; r < 16; ++r) { mx = fmaxf(mx, p0[r]); mx = fmaxf(mx, p1[r]); }
        mx = fmaxf(mx, __shfl_xor(mx, 32));
        const float mnew = fmaxf(mrun, mx), alpha = exp2f(mrun - mnew); mrun = mnew;
        float ls = 0.f;
#pragma unroll
        for (int r = 0; r < 16; ++r) { p0[r] = exp2f(p0[r] - mnew); p1[r] = exp2f(p1[r] - mnew); ls += p0[r] + p1[r]; }
        lrun = lrun * alpha + ls;
#pragma unroll
        for (int d = 0; d < 4; ++d)
#pragma unroll
            for (int r = 0; r < 16; ++r) o[d][r] *= alpha;
#pragma unroll
        for (int s = 0; s < 4; ++s) {
            const bf16x8 pb = (s < 2) ? cvt8(p0, s & 1) : cvt8(p1, s & 1);
#pragma unroll
            for (int db = 0; db < 4; ++db) {
                const LAS unsigned char* vp = buf + troff + (16 * s) * KROW + db * 64;
                const v4i16_t lo = __builtin_amdgcn_ds_read_tr16_b64_v4i16((LAS v4i16_t*)vp), hh = __builtin_amdgcn_ds_read_tr16_b64_v4i16((LAS v4i16_t*)(vp + 8 * KROW));
                const bf16x8 va = {lo[0], lo[1], lo[2], lo[3], hh[0], hh[1], hh[2], hh[3]};
                o[db] = __builtin_amdgcn_mfma_f32_32x32x16_bf16(va, pb, o[db], 0, 0, 0);
            }
        }
        if (kt + 1 < nt) {
            LAS unsigned char* nb = F.lds + ((kt + 1) & 1) * (64 * KROW);
#pragma unroll
            for (int i = 0; i < 3; ++i) *(LAS u32x4*)(nb + prow[i] * KROW + pcol[i] * 16) = st[i];
        }
        __syncthreads();
    }
    lrun += __shfl_xor(lrun, 32);
    const float inv = 1.f / lrun;
#pragma unroll
    for (int db = 0; db < 4; ++db)
#pragma unroll
        for (int g = 0; g < 4; ++g) { u32x2 w; w.x = pk2(o[db][4 * g] * inv, o[db][4 * g + 1] * inv); w.y = pk2(o[db][4 * g + 2] * inv, o[db][4 * g + 3] * inv);
            *(u32x2*)(OL + mq * 512 + head * 128 + 32 * db + 8 * g + 4 * hi) = w; }
}
struct RwSet { bf16x8 ta[2][4]; u32x4 d[4]; };
__device__ __forceinline__ void rw_load(RwSet& s, const bf16_t* TTg, const bf16_t* Rg, int cg_, int h, int i, int r32, int hi) {
    const bf16_t* TTw = TTg + (size_t)(cg_ * 8 + h) * 4096; const bf16_t* Dw = Rg + ((size_t)64 * cg_ + i) * 512 + h * 64;
#pragma unroll
    for (int a = 0; a < 2; ++a)
#pragma unroll
        for (int s2 = 0; s2 < 4; ++s2) s.ta[a][s2] = *(const bf16x8*)(TTw + (32 * a + r32) * 64 + 16 * s2 + 8 * hi);
    s.d[0] = *(const u32x4*)(Dw + 16 * hi); s.d[1] = *(const u32x4*)(Dw + 16 * hi + 8); s.d[2] = *(const u32x4*)(Dw + 32 + 16 * hi); s.d[3] = *(const u32x4*)(Dw + 32 + 16 * hi + 8);
}
__device__ __forceinline__ f32x16 up16(const u32x4 a, const u32x4 b) { f32x16 r;
    r[0] = bflo(a.x); r[1] = bfhi(a.x); r[2] = bflo(a.y); r[3] = bfhi(a.y); r[4] = bflo(a.z); r[5] = bfhi(a.z); r[6] = bflo(a.w); r[7] = bfhi(a.w);
    r[8] = bflo(b.x); r[9] = bfhi(b.x); r[10] = bflo(b.y); r[11] = bfhi(b.y); r[12] = bflo(b.z); r[13] = bfhi(b.z); r[14] = bflo(b.w); r[15] = bfhi(b.w); return r; }
__device__ __forceinline__ void rw_step(f32x16& X0, f32x16& X1, const RwSet& s, bf16_t* Rg, int cg_, int h, int i, int hi, bool live) {
    const bf16x8 bf[4] = {cvt8(X0, 0), cvt8(X0, 1), cvt8(X1, 0), cvt8(X1, 1)};
    if (live) { bf16_t* Dw = Rg + ((size_t)64 * cg_ + i) * 512 + h * 64;
        *(bf16x8*)(Dw + 16 * hi) = bf[0]; *(bf16x8*)(Dw + 16 * hi + 8) = bf[1]; *(bf16x8*)(Dw + 32 + 16 * hi) = bf[2]; *(bf16x8*)(Dw + 32 + 16 * hi + 8) = bf[3]; }
    f32x16 n0 = up16(s.d[0], s.d[1]), n1 = up16(s.d[2], s.d[3]);
#pragma unroll
    for (int s2 = 0; s2 < 4; ++s2) { n0 = __builtin_amdgcn_mfma_f32_32x32x16_bf16(s.ta[0][s2], bf[s2], n0, 0, 0, 0); n1 = __builtin_amdgcn_mfma_f32_32x32x16_bf16(s.ta[1][s2], bf[s2], n1, 0, 0, 0); }
    X0 = n0; X1 = n1;
}
__device__ __forceinline__ void rwkv_scan(const Ctx& F, int b, int h, int half) {
    const int lane = F.lane, r32 = lane & 31, hi = lane >> 5, i = 32 * half + r32;
    const bf16_t* TTg = (const bf16_t*)(F.ws + WS_TT); bf16_t* Rg = (bf16_t*)(F.ws + WS_R);
    f32x16 X0, X1;
#pragma unroll
    for (int r = 0; r < 16; ++r) { X0[r] = 0.f; X1[r] = 0.f; }
    RwSet sA, sB, sC; const int c0 = b * 128;
    rw_load(sA, TTg, Rg, c0 + 0, h, i, r32, hi); rw_load(sB, TTg, Rg, c0 + 1, h, i, r32, hi); rw_load(sC, TTg, Rg, c0 + 2, h, i, r32, hi);
    for (int c = 0; c < 129; c += 3) {
        rw_step(X0, X1, sA, Rg, c0 + c, h, i, hi, true);          rw_load(sA, TTg, Rg, c0 + min(c + 3, 127), h, i, r32, hi);
        rw_step(X0, X1, sB, Rg, c0 + c + 1, h, i, hi, true);      rw_load(sB, TTg, Rg, c0 + min(c + 4, 127), h, i, r32, hi);
        rw_step(X0, X1, sC, Rg, c0 + min(c + 2, 127), h, i, hi, c + 2 < 128); rw_load(sC, TTg, Rg, c0 + min(c + 5, 127), h, i, r32, hi);
    }
}
__device__ __forceinline__ void ssd_scan(const Ctx& F, int item) {
    const int b = item >> 4, h = (item >> 1) & 7, hp = item & 1, g = h >> 2, hl = h & 3;
    const int piece = hp * 512 + F.tid;
    const int f = hl * 8192 + piece * 8, row = f >> 9, col = ssd_win_col(g, f & 511);
    bf16_t* ST = (bf16_t*)(F.ws + WS_XBC); const float* CDEC = (const float*)(F.ws + WS_CDEC);
    float st[8];
#pragma unroll
    for (int j = 0; j < 8; ++j) st[j] = 0.f;
    for (int c8 = 0; c8 < 128; c8 += 8) {
        u32x4 v[8]; float cd[8];
#pragma unroll
        for (int u = 0; u < 8; ++u) { const int cg_ = b * 128 + c8 + u; v[u] = *(const u32x4*)(ST + ((size_t)64 * cg_ + row) * 1024 + col); cd[u] = CDEC[cg_ * 8 + h]; }
#pragma unroll
        for (int u = 0; u < 8; ++u) { const int cg_ = b * 128 + c8 + u;
            u32x4 o; o.x = pk2(st[0], st[1]); o.y = pk2(st[2], st[3]); o.z = pk2(st[4], st[5]); o.w = pk2(st[6], st[7]);
            *(u32x4*)(ST + ((size_t)64 * cg_ + row) * 1024 + col) = o;
            const float x[8] = {bflo(v[u].x), bfhi(v[u].x), bflo(v[u].y), bfhi(v[u].y), bflo(v[u].z), bfhi(v[u].z), bflo(v[u].w), bfhi(v[u].w)};
#pragma unroll
            for (int j = 0; j < 8; ++j) st[j] = st[j] * cd[u] + x[j]; }
    }
}
__device__ __forceinline__ void p4_mix(const Ctx& F, int what = 3) {
    if (F.bid < 128) { if (!(what & 1)) return;
        const int b = F.bid >> 6, c = F.bid & 63;
        attn_unit(F, b, 127 - c); __syncthreads(); attn_unit(F, b, c);
    } else if (F.bid < 132) { if (what & 2) { const int task = (F.bid - 128) * 8 + F.wave; rwkv_scan(F, task >> 4, (task >> 1) & 7, task & 1); }
    } else if (F.bid < 164) { if (what & 2) ssd_scan(F, F.bid - 132); }
}
__device__ __forceinline__ void p5_assemble(const Ctx& F, int l) {
    bf16_t* GT = (bf16_t*)(F.ws + WS_GATES);
    {   pg8::Gemm g{(const bf16_t*)(F.ws + WS_OL), (const bf16_t*)(F.ws + WS_WUV), NT, 512, 512, 512, 512}; pg8::StaticOrder S; S.init(NT, 512, F.G, F.bid); EpiUV E{GT};
        pg8::gemm_phase<EpiUV, pg8::StaticOrder, true, true>(F.lds, F.wave, g, S, E); }
    __syncthreads();
    int lane = fresh_lane(); const int tid = F.wave * 64 + lane, wave = F.wave;
    const int gw = F.bid * NWAVES + F.wave, NGW = F.G * NWAVES;
    {   constexpr int O_CG = 0, O_PV = 17408, O_YL = 34816;
        const bf16_t* Cbuf = (const bf16_t*)(F.ws + WS_CB); const float* ECUM = (const float*)(F.ws + WS_ECUM); const bf16_t* ST = (const bf16_t*)(F.ws + WS_XBC); const bf16_t* YD = (const bf16_t*)(F.ws + WS_YD);
        const float* snw = INP(I_SSDNW) + l * 512;
        for (int c = F.bid; c < NCHK; c += F.G) {
            const size_t m0 = (size_t)64 * c;
            for (int g = 0; g < 2; ++g) {
                {   LAS bf16_t* Cg = (LAS bf16_t*)(F.lds + O_CG);
#pragma unroll
                    for (int i = 0; i < 2; ++i) { const int idx = tid + 512 * i, t = idx >> 4, c8 = idx & 15; *(LAS u32x4*)(Cg + t * 136 + c8 * 8) = *(const u32x4*)(Cbuf + (m0 + t) * 256 + g * 128 + c8 * 8); } }
                for (int hl = 0; hl < 4; ++hl) { const int h = 4 * g + hl;
                    {   LAS bf16_t* Pv = (LAS bf16_t*)(F.lds + O_PV);
#pragma unroll
                        for (int i = 0; i < 2; ++i) { const int idx = tid + 512 * i, pp = idx >> 4, c8 = idx & 15; const int f = hl * 8192 + pp * 128 + c8 * 8, row = f >> 9, col = ssd_win_col(g, f & 511);
                            *(LAS u32x4*)(Pv + pp * 136 + c8 * 8) = *(const u32x4*)(ST + (m0 + row) * 1024 + col); } }
                    __syncthreads();
                    {   LAS bf16_t* Cg = (LAS bf16_t*)(F.lds + O_CG); LAS bf16_t* Pv = (LAS bf16_t*)(F.lds + O_PV); LAS bf16_t* YL = (LAS bf16_t*)(F.lds + O_YL);
#pragma unroll
                        for (int i = 0; i < 2; ++i) { const int idx = 2 * wave + i, ti = idx >> 2, pi = idx & 3;
                            const f32x4 acc = mma_tile<128>(Cg + ti * 16 * 136, 136, Pv + pi * 16 * 136, 136, lane);
#pragma unroll
                            for (int r = 0; r < 4; ++r) { const int t = ti * 16 + 4 * (lane >> 4) + r, pp = pi * 16 + (lane & 15);
                                const float y = bf2f(YD[(m0 + t) * 512 + 64 * h + pp]) + acc[r] * ECUM[(size_t)(c * 8 + h) * 64 + t];
                                const float z = bf2f(GT[(m0 + t) * 1536 + 512 + 64 * h + pp]);
                                YL[t * 520 + 64 * h + pp] = (bf16_t)f2bf(y * siluf_(z)); } } }
                    __syncthreads();
                }
            }
            {   LAS bf16_t* YL = (LAS bf16_t*)(F.lds + O_YL);
#pragma unroll
                for (int rr = 0; rr < 8; ++rr) { const int t = 8 * wave + rr; const u32x4 w = *(const LAS u32x4*)(YL + t * 520 + 8 * lane);
                    const float v[8] = {bflo(w.x), bfhi(w.x), bflo(w.y), bfhi(w.y), bflo(w.z), bfhi(w.z), bflo(w.w), bfhi(w.w)};
                    float q = 0.f;
#pragma unroll
                    for (int j = 0; j < 8; ++j) q += v[j] * v[j];
                    const float rs = 1.f / sqrtf(wave_sum(q) * (1.f / 512.f) + EPS);
                    const f32x4 w0 = *(const f32x4*)(snw + 8 * lane), w1 = *(const f32x4*)(snw + 8 * lane + 4);
                    u32x4 o; o.x = pk2(v[0] * rs * w0[0], v[1] * rs * w0[1]); o.y = pk2(v[2] * rs * w0[2], v[3] * rs * w0[3]); o.z = pk2(v[4] * rs * w1[0], v[5] * rs * w1[1]); o.w = pk2(v[6] * rs * w1[2], v[7] * rs * w1[3]);
                    *(u32x4*)(GT + (m0 + t) * 1536 + 512 + 8 * lane) = o; } }
            __syncthreads();
        }
    }
    LAS float* SW = (LAS float*)(F.lds + F.wave * 16640);
    const bf16_t* Yt = (const bf16_t*)(F.ws + WS_K); const bf16_t* SF = (const bf16_t*)(F.ws + WS_R); const bf16_t* QEg = (const bf16_t*)(F.ws + WS_QE);
    const bf16_t* BON = (const bf16_t*)(F.ws + WS_V); const float* lw = INP(I_LNXW) + l * 512; const float* lb = INP(I_LNXB) + l * 512;
    for (int w = gw; w < NCHK * 8; w += NGW) {
        asm volatile("" : "+v"(lane));
        const int cg_ = w >> 3, h = w & 7, r32 = lane & 31, hi = lane >> 5; const size_t m0 = (size_t)64 * cg_;
        const bf16_t* QEw = QEg + (size_t)(cg_ * 8 + h) * 4096;
        bf16x8 qa[2][4];
#pragma unroll
        for (int tb = 0; tb < 2; ++tb)
#pragma unroll
            for (int s2 = 0; s2 < 4; ++s2) qa[tb][s2] = *(const bf16x8*)(QEw + (32 * tb + r32) * 64 + 16 * s2 + 8 * hi);
#pragma unroll
        for (int ih = 0; ih < 2; ++ih) { const size_t ro = (m0 + 32 * ih + r32) * 512 + h * 64;
            const bf16x8 bf[4] = {*(const bf16x8*)(SF + ro + 16 * hi), *(const bf16x8*)(SF + ro + 16 * hi + 8), *(const bf16x8*)(SF + ro + 32 + 16 * hi), *(const bf16x8*)(SF + ro + 32 + 16 * hi + 8)};
#pragma unroll
            for (int tb = 0; tb < 2; ++tb) { f32x16 y = ld16bf(Yt + ro + 32 * tb + 16 * hi);
#pragma unroll
                for (int s2 = 0; s2 < 4; ++s2) y = __builtin_amdgcn_mfma_f32_32x32x16_bf16(qa[tb][s2], bf[s2], y, 0, 0, 0);
#pragma unroll
                for (int r = 0; r < 16; ++r) SW[(32 * tb + crow(r, hi)) * 65 + 32 * ih + r32] = y[r]; } }
        LDS_WAIT();
        {   float y[64]; float sm = 0.f;
#pragma unroll
            for (int i = 0; i < 64; ++i) { y[i] = SW[lane * 65 + i]; sm += y[i]; }
            const float mean = sm * (1.f / 64.f); float q = 0.f;
#pragma unroll
            for (int i = 0; i < 64; ++i) { y[i] -= mean; q += y[i] * y[i]; }
            const float rs = 1.f / sqrtf(q * (1.f / 64.f) + GN_EPS);
#pragma unroll
            for (int i = 0; i < 64; ++i) SW[lane * 65 + i] = y[i] * rs; }
        LDS_WAIT();
#pragma unroll
        for (int it = 0; it < 8; ++it) { const int t = it * 8 + (lane >> 3), i0 = (lane & 7) * 8; const size_t row = m0 + t;
            const u32x4 bw = *(const u32x4*)(BON + row * 512 + h * 64 + i0); u32x4* gp = (u32x4*)(GT + row * 1536 + 1024 + h * 64 + i0); const u32x4 gv = *gp;
            const float bo[8] = {bflo(bw.x), bfhi(bw.x), bflo(bw.y), bfhi(bw.y), bflo(bw.z), bfhi(bw.z), bflo(bw.w), bfhi(bw.w)};
            const float gg[8] = {bflo(gv.x), bfhi(gv.x), bflo(gv.y), bfhi(gv.y), bflo(gv.z), bfhi(gv.z), bflo(gv.w), bfhi(gv.w)};
            float ov[8];
#pragma unroll
            for (int j = 0; j < 8; ++j) ov[j] = (SW[t * 65 + i0 + j] * lw[h * 64 + i0 + j] + lb[h * 64 + i0 + j] + bo[j]) * siluf_(gg[j]);
            u32x4 o; o.x = pk2(ov[0], ov[1]); o.y = pk2(ov[2], ov[3]); o.z = pk2(ov[4], ov[5]); o.w = pk2(ov[6], ov[7]); *gp = o; }
        LDS_WAIT();
    }
}
__device__ __forceinline__ void p7_final(const Ctx& F) {
    const int gw = F.bid * NWAVES + F.wave, NGW = F.G * NWAVES; const float* fw = INP(I_FNW);
    for (int m = gw; m < NT; m += NGW) {
        f32x4* xr = (f32x4*)(F.out + (size_t)m * DM) + F.lane; f32x4 v[4]; float s = 0.f;
#pragma unroll
        for (int j = 0; j < 4; ++j) { v[j] = xr[64 * j]; s += v[j].x * v[j].x + v[j].y * v[j].y + v[j].z * v[j].z + v[j].w * v[j].w; }
        const float rstd = 1.f / sqrtf(wave_sum(s) * (1.f / DM) + EPS);
#pragma unroll
        for (int j = 0; j < 4; ++j) xr[64 * j] = v[j] * rstd * *(const f32x4*)(fw + 4 * F.lane + 256 * j);
    }
}

#define LAYER(l) do { \
        const int pb = 1 + 8 * l; \
        if (IN(pb + 0)) { PHB(); if (l == 1) prep_weights(F, 1); p1_norm(F, l); SEAM(pb + 0); } \
        if (IN(pb + 1)) { PHB(); \
            pg8::Gemm g{(const bf16_t*)(F.ws + WS_XN), (const bf16_t*)(F.ws + WS_WIN), NT, NIN, DM, DM, DM}; pg8::StaticOrder S; S.init(NT, NIN, F.G, F.bid); \
            EpiIn E{F.ws, l}; \
            pg8::gemm_phase<EpiIn, pg8::StaticOrder, true, true>(F.lds, F.wave, g, S, E); \
            SEAM(pb + 1); \
        } \
        if (IN(pb + 2)) { PHB(); \
            pg8::Gemm g{(const bf16_t*)(F.ws + WS_QLAT), (const bf16_t*)(F.ws + WS_WQ), NT, 768, 256, 256, 256}; pg8::StaticOrder S; S.init(NT, 768, F.G, F.bid); \
            EpiQ E{F.ws, l}; \
            pg8::gemm_phase<EpiQ, pg8::StaticOrder, true, true>(F.lds, F.wave, g, S, E); \
            p3a_extras(F, l); \
            SEAM(pb + 2); \
        } \
        if (IN(pb + 3)) { PHB(); p3b_ssd(F, l); SEAM(pb + 3); } \
        if (IN(pb + 4)) { PHB(); p3c_rwkv(F, l); SEAM(pb + 4); } \
        if (IN(pb + 5)) { PHB(); p4_mix(F); SEAM(pb + 5); } \
        if (IN(pb + 6)) { PHB(); p5_assemble(F, l); SEAM(pb + 6); } \
        if (IN(pb + 7)) { PHB(); \
            pg8::Gemm g{(const bf16_t*)(F.ws + WS_GATES), (const bf16_t*)(F.ws + WS_WOUT), NT, DM, 1536, 1536, 1536}; pg8::StaticOrder S; S.init(NT, DM, F.G, F.bid); \
            EpiOut E{(l == 0) ? INP(I_X) : F.out, F.out, (const float*)(F.ws + WS_CTL + CTL_MOD) + (size_t)(l * 2) * 3072 + 2048}; \
            pg8::gemm_phase<EpiOut, pg8::StaticOrder, true, true>(F.lds, F.wave, g, S, E); \
            SEAM(pb + 7); \
        } \
    } while (0)
__global__ void __launch_bounds__(NTHR, 2) mk_fwd(Args args) {
    extern __shared__ __attribute__((aligned(16))) unsigned char lds_raw[];
    Ctx F; F.lds = (LAS unsigned char*)lds_raw; F.tid = threadIdx.x; F.lane = F.tid & 63; F.wave = __builtin_amdgcn_readfirstlane(F.tid >> 6);
    F.G = gridDim.x; F.bid = blockIdx.x; F.ws = args.ws; F.out = args.out; F.in = args.in;
    const int wave0 = F.wave;
    cg::grid_group grid = cg::this_grid();
#if MK_PER_PHASE
    const int lo = args.ph_lo, hi = args.ph_hi;
#else
    constexpr int lo = 0, hi = 18;
#endif
#ifndef MK_ONLY
#define MK_ONLY -1
#endif
#define IN(k) (lo <= (k) && (k) < hi && (MK_ONLY < 0 || MK_ONLY == ((k) == 0 ? 0 : (k) == 17 ? 17 : 1 + ((k) - 1) % 8)))
#define SEAM(k) do { if (IN((k) + 1)) grid.sync(); } while (0)
#define PHB() do { int b_ = blockIdx.x, g_ = gridDim.x, v_ = wave0; asm volatile("" : "+s"(b_), "+s"(g_), "+s"(v_)); F.bid = b_; F.G = g_; F.wave = v_; int t_ = v_ * 64 + (int)__builtin_amdgcn_mbcnt_hi(~0u, __builtin_amdgcn_mbcnt_lo(~0u, 0u)); asm volatile("; PHASE_MARK %0" : "+v"(t_)); F.tid = t_; F.lane = t_ & 63; unsigned char* w_ = args.ws; float* o_ = args.out; asm volatile("" : "+s"(w_), "+s"(o_)); F.ws = w_; F.out = o_; } while (0)
    if (IN(0)) { PHB(); p0_prologue(F); SEAM(0); }
    LAYER(0);
    LAYER(1);
    if (IN(17)) { PHB(); p7_final(F); }
#ifndef MK_RERUN
#define MK_RERUN 0
#endif
#define PHB2() do { int b_ = blockIdx.x, g_ = gridDim.x, v_ = wave0; asm volatile("" : "+s"(b_), "+s"(g_), "+s"(v_)); F.bid = b_; F.G = g_; F.wave = v_; int t_ = v_ * 64 + fresh_lane(); F.tid = t_; F.lane = t_ & 63; } while (0)
#if MK_RERUN
    { constexpr int l = 1;
    if (MK_RERUN & 1) { grid.sync(); PHB2(); p1_norm(F, l); }
    if (MK_RERUN & 2) { grid.sync(); PHB2(); pg8::Gemm g{(const bf16_t*)(F.ws + WS_XN), (const bf16_t*)(F.ws + WS_WIN), NT, NIN, DM, DM, DM}; pg8::StaticOrder S; S.init(NT, NIN, F.G, F.bid); EpiIn E{F.ws, l}; pg8::gemm_phase<EpiIn, pg8::StaticOrder, true, true>(F.lds, F.wave, g, S, E); }
    if (MK_RERUN & 4) { grid.sync(); PHB2(); pg8::Gemm g{(const bf16_t*)(F.ws + WS_QLAT), (const bf16_t*)(F.ws + WS_WQ), NT, 768, 256, 256, 256}; pg8::StaticOrder S; S.init(NT, 768, F.G, F.bid); EpiQ E{F.ws, l}; pg8::gemm_phase<EpiQ, pg8::StaticOrder, true, true>(F.lds, F.wave, g, S, E); p3a_extras(F, l); }
    if (MK_RERUN & 8) { grid.sync(); PHB2(); p3b_ssd(F, l); }
    if (MK_RERUN & 16) { grid.sync(); PHB2(); p3c_rwkv(F, l); }
    if (MK_RERUN & 32) { grid.sync(); PHB2(); p4_mix(F); }
    if (MK_RERUN & 512) { grid.sync(); PHB2(); p4_mix(F, 1); }
    if (MK_RERUN & 1024) { grid.sync(); PHB2(); p4_mix(F, 2); }
    if (MK_RERUN & 64) { grid.sync(); PHB2(); p5_assemble(F, l); }
    if (MK_RERUN & 128) { grid.sync(); PHB2(); pg8::Gemm g{(const bf16_t*)(F.ws + WS_GATES), (const bf16_t*)(F.ws + WS_WOUT), NT, DM, 1536, 1536, 1536}; pg8::StaticOrder S; S.init(NT, DM, F.G, F.bid);
        EpiOut E{INP(I_X), (float*)(F.ws + WS_XBC), (const float*)(F.ws + WS_CTL + CTL_MOD) + (size_t)(l * 2) * 3072 + 2048}; pg8::gemm_phase<EpiOut, pg8::StaticOrder, true, true>(F.lds, F.wave, g, S, E); }
    }
#endif
#undef IN
#undef SEAM
}
constexpr int N_PHASES = 18;

extern "C" void kernel_launch(void* const* d_in, const int* in_sizes, int n_in, void* d_out, int out_size, void* d_ws, size_t ws_size, hipStream_t stream) {
    static int grid = 0;
    if (grid == 0) {
        if (n_in != 31 || out_size != NT * DM || ws_size < WS_END) { fprintf(stderr, "kernel_launch: unexpected shapes (n_in %d, out %d, ws %zu)\n", n_in, out_size, ws_size); grid = -1; return; }
        int dev = 0, cus = 0, per_cu = 0;
        hipGetDevice(&dev); hipDeviceGetAttribute(&cus, hipDeviceAttributeMultiprocessorCount, dev);
        if (hipFuncSetAttribute((const void*)mk_fwd, hipFuncAttributeMaxDynamicSharedMemorySize, LDS_BYTES) != hipSuccess) { fprintf(stderr, "kernel_launch: hipFuncSetAttribute failed\n"); grid = -1; return; }
        hipOccupancyMaxActiveBlocksPerMultiprocessor(&per_cu, (const void*)mk_fwd, NTHR, LDS_BYTES);
        (void)hipGetLastError();
        if (per_cu < 1) per_cu = 1;
        grid = cus;
        fprintf(stderr, "kernel_launch: cus %d, occupancy query %d block(s)/CU, grid %d\n", cus, per_cu, grid);
    }
    if (grid < 0) return;
    hipMemsetAsync((char*)d_ws + WS_CTL, 0, CTL_BYTES, stream);
    Args a{};
    for (int i = 0; i < 31; ++i) a.in[i] = (const float*)d_in[i];
    a.out = (float*)d_out; a.ws = (unsigned char*)d_ws;
#if MK_PER_PHASE
    for (int p = 0; p < N_PHASES; ++p) { a.ph_lo = p; a.ph_hi = p + 1; hipLaunchKernelGGL(mk_fwd, dim3(grid), dim3(NTHR), LDS_BYTES, stream, a); }
#else
    a.ph_lo = 0; a.ph_hi = N_PHASES;
    void* params[] = {&a};
    hipError_t e = hipLaunchCooperativeKernel((const void*)mk_fwd, dim3(grid), dim3(NTHR), params, LDS_BYTES, stream);
    if (e != hipSuccess) fprintf(stderr, "kernel_launch: cooperative launch failed: %s\n", hipGetErrorString(e));
#endif
}
```

```cpp
#include <hip/hip_runtime.h>
#include <hip/hip_cooperative_groups.h>
#include <cstdio>
#include <cstdint>
namespace cg = cooperative_groups;

#define LAS __attribute__((address_space(3)))
#define GAS __attribute__((address_space(1)))
typedef unsigned short bf16_t;
typedef short bf16x8 __attribute__((ext_vector_type(8)));
typedef float f32x4 __attribute__((ext_vector_type(4)));
typedef float f32x2 __attribute__((ext_vector_type(2)));
typedef float f32x16 __attribute__((ext_vector_type(16)));
typedef unsigned u32x4 __attribute__((ext_vector_type(4)));
typedef unsigned u32x2 __attribute__((ext_vector_type(2)));
typedef short v4i16_t __attribute__((ext_vector_type(4)));

#ifndef MK_PER_PHASE
#define MK_PER_PHASE 0
#endif

namespace pg8 {
constexpr int BM = 256, BK = 64, HALF = 128, HTB = HALF * BK * 2, STAGE_BYTES = 8 * HTB, NXCD = 8, WGM = 8;
__host__ __device__ __forceinline__ int lds_byte(int r, int c) { const int st = (r >> 4) * 2 + (c >> 5), rr = r & 15, cc = c & 31, ob = rr * 64 + cc * 2; return st * 1024 + (ob ^ (((ob >> 9) & 1) << 5)); }
__host__ __device__ __forceinline__ void stage_rc(int b, int& R, int& C) { const int st = b / 1024, sb = b % 1024, swz = sb ^ (((sb >> 9) & 1) << 5); R = (st >> 1) * 16 + swz / 64; C = (st & 1) * 32 + (swz % 64) / 2; }
__host__ __device__ __forceinline__ int perm32(int rho) { const int n = rho >> 4, i = rho & 15; return 8 * (i >> 2) + 4 * n + (i & 3); }
struct Unit { int pm, pn; };
struct Gemm { const bf16_t* A; const bf16_t* Bt; int M, N, K, lda, ldb; };
struct StaticOrder {
    int nM, nN, nwg, G, c;
    __host__ __device__ void init(int M, int N, int G_, int c_) { nM = M / BM; nN = N / BM; nwg = nM * nN; G = G_; c = c_; }
    __host__ __device__ bool next(int i, Unit& u) const {
        const long L = (long)i * G + c; if (L >= nwg) return false;
        int wgid = (int)L; { const int q = nwg / NXCD, r = nwg % NXCD, xcd = wgid % NXCD, off = wgid / NXCD; wgid = (xcd < r ? xcd * (q + 1) : r * (q + 1) + (xcd - r) * q) + off; }
        const int nig = WGM * nN, gid = wgid / nig, fm = gid * WGM, gsz = (nM - fm) < WGM ? (nM - fm) : WGM;
        u.pm = fm + ((wgid % nig) % gsz); u.pn = (wgid % nig) / gsz; return true;
    }
};
template <class Epi, class Sched, bool ALIGN_EPI, bool SP2>
__device__ __forceinline__ void gemm_phase(LAS unsigned char* lds, int wave_id, const Gemm g, const Sched& S, const Epi& E) {
    int lane = (int)__builtin_amdgcn_mbcnt_hi(~0u, __builtin_amdgcn_mbcnt_lo(~0u, 0u)); asm volatile("" : "+v"(lane));
    const int wid = wave_id, tid = wid * 64 + lane, wr = wid >> 2, wc = wid & 3, fr = lane & 15, fq = lane >> 4;
    const int K = g.K, nt = K / BK;
    unsigned voffA[2], voffB[2];
#pragma unroll
    for (int i = 0; i < 2; ++i) { int R, C; stage_rc(tid * 16 + i * 8192, R, C); const int Rb = (R & ~31) + perm32(R & 31);
        voffA[i] = (unsigned)(R * g.lda + C) * 2u; voffB[i] = (unsigned)(Rb * g.ldb + C) * 2u; }
    const size_t kstep = (size_t)(BK * 2);
    const size_t hstepA = (size_t)HALF * g.lda * 2, hstepB = (size_t)HALF * g.ldb * 2;
    const size_t tstepA = 2 * hstepA, tstepB = 2 * hstepB;
    const unsigned ldsw = (unsigned)wid * 1024u, lds0 = (unsigned)(uintptr_t)lds;
    const int aoff = lds_byte(wr * 64 + fr, fq * 8), boff = lds_byte(wc * 32 + fr, fq * 8);
#define PG8_SA(b, h) (((b) * 2 + (h)) * HTB)
#define PG8_SB(b, h) ((4 + (b) * 2 + (h)) * HTB)
#define PG8_STAGE(bufoff, gbase, voff) do { _Pragma("unroll") for (int _i = 0; _i < 2; ++_i) { unsigned keep_; \
        asm volatile("s_mov_b32 %0, m0\n\ts_mov_b32 m0, %3\n\ts_nop 0\n\tglobal_load_lds_dwordx4 %1, %2\n\ts_mov_b32 m0, %0" : "=&s"(keep_) : "v"((voff)[_i]), "s"((const char*)(gbase)), "s"(lds0 + (unsigned)(bufoff) + ldsw + (unsigned)(_i * 8192)) : "memory"); } } while (0)
#define PG8_LDA(dst, b, h) do { _Pragma("unroll") for (int m = 0; m < 4; ++m) _Pragma("unroll") for (int k = 0; k < 2; ++k) dst[m][k] = *(const LAS bf16x8*)(lds + PG8_SA(b, h) + aoff + m * 2048 + k * 1024); } while (0)
#define PG8_LDB(dst, b, h) do { _Pragma("unroll") for (int n = 0; n < 2; ++n) _Pragma("unroll") for (int k = 0; k < 2; ++k) dst[n][k] = *(const LAS bf16x8*)(lds + PG8_SB(b, h) + boff + n * 2048 + k * 1024); } while (0)
#define PG8_MMA(ai, bj, At, Bt) do { __builtin_amdgcn_s_setprio(1); _Pragma("unroll") for (int m = 0; m < 4; ++m) _Pragma("unroll") for (int n = 0; n < 2; ++n) _Pragma("unroll") for (int k = 0; k < 2; ++k) \
        acc[ai][bj][m][n] = __builtin_amdgcn_mfma_f32_16x16x32_bf16(Bt[n][k], At[m][k], acc[ai][bj][m][n], 0, 0, 0); __builtin_amdgcn_s_setprio(0); } while (0)
#define PG8_WAIT_V(n) asm volatile("s_waitcnt vmcnt(" #n ")" ::: "memory")
#define PG8_WAIT_L(n) asm volatile("s_waitcnt lgkmcnt(" #n ")" ::: "memory")
#define PG8_BAR __builtin_amdgcn_s_barrier()
#define PG8_SCHED __builtin_amdgcn_sched_barrier(0)
    Unit cur, nxt; int ui = 0;
    if (!S.next(0, cur)) return;
    f32x4 acc[2][2][4][2];
#pragma unroll
    for (int a = 0; a < 2; ++a)
#pragma unroll
        for (int b = 0; b < 2; ++b)
#pragma unroll
            for (int m = 0; m < 4; ++m)
#pragma unroll
                for (int n = 0; n < 2; ++n) acc[a][b][m][n] = (f32x4){0.f, 0.f, 0.f, 0.f};
    bf16x8 At[4][2], B0[2][2], B1[2][2];
    const char* cA = (const char*)g.A + (size_t)cur.pm * tstepA; const char* cB = (const char*)g.Bt + (size_t)cur.pn * tstepB;
    if constexpr (SP2) {
        PG8_STAGE(PG8_SB(0, 0), cB, voffB); PG8_STAGE(PG8_SB(0, 1), cB + hstepB, voffB); PG8_STAGE(PG8_SA(0, 0), cA, voffA); PG8_STAGE(PG8_SA(0, 1), cA + hstepA, voffA);
        if (wr == 1) PG8_BAR;
        PG8_WAIT_V(2); PG8_BAR;
        PG8_STAGE(PG8_SB(1, 0), cB + kstep, voffB); PG8_STAGE(PG8_SA(1, 0), cA + kstep, voffA); PG8_STAGE(PG8_SB(1, 1), cB + hstepB + kstep, voffB);
        PG8_WAIT_V(6); PG8_BAR;
    } else {
        PG8_STAGE(PG8_SB(0, 0), cB, voffB); PG8_STAGE(PG8_SA(0, 0), cA, voffA); PG8_STAGE(PG8_SB(0, 1), cB + hstepB, voffB); PG8_STAGE(PG8_SA(0, 1), cA + hstepA, voffA);
        if (wr == 1) PG8_BAR;
        PG8_WAIT_V(4); PG8_BAR;
        PG8_STAGE(PG8_SB(1, 0), cB + kstep, voffB); PG8_STAGE(PG8_SA(1, 0), cA + kstep, voffA); PG8_STAGE(PG8_SB(1, 1), cB + hstepB + kstep, voffB);
        PG8_WAIT_V(6); PG8_BAR;
    }
    for (;;) {
        const bool has_next = S.next(ui + 1, nxt);
        const char* nA = has_next ? (const char*)g.A + (size_t)nxt.pm * tstepA : cA; const char* nB = has_next ? (const char*)g.Bt + (size_t)nxt.pn * tstepB : cB;
        for (int t = 0; t < nt; t += 2) {
            const bool last = (t == nt - 2);
            const char* a1 = cA + (size_t)(t + 1) * kstep;
            const char* a2 = last ? nA : cA + (size_t)(t + 2) * kstep; const char* b2 = last ? nB : cB + (size_t)(t + 2) * kstep;
            const char* a3 = a2 + kstep; const char* b3 = b2 + kstep;
            if constexpr (SP2) {
            PG8_LDB(B0, 0, 0); PG8_LDB(B1, 0, 1); PG8_SCHED; PG8_LDA(At, 0, 0); PG8_STAGE(PG8_SA(1, 1), a1 + hstepA, voffA);
            PG8_WAIT_V(8); PG8_WAIT_L(0); PG8_BAR; PG8_MMA(0, 0, At, B0); PG8_MMA(0, 1, At, B1); PG8_BAR; PG8_SCHED;
            PG8_LDA(At, 0, 1); PG8_STAGE(PG8_SB(0, 0), b2, voffB); PG8_STAGE(PG8_SB(0, 1), b2 + hstepB, voffB); PG8_STAGE(PG8_SA(0, 0), a2, voffA);
            PG8_WAIT_V(8); PG8_WAIT_L(0); PG8_BAR; PG8_MMA(1, 0, At, B0); PG8_MMA(1, 1, At, B1); PG8_BAR; PG8_SCHED;
            PG8_LDB(B0, 1, 0); PG8_LDB(B1, 1, 1); PG8_SCHED; PG8_LDA(At, 1, 0); PG8_STAGE(PG8_SA(0, 1), a2 + hstepA, voffA);
            PG8_WAIT_V(8); PG8_WAIT_L(0); PG8_BAR; PG8_MMA(0, 0, At, B0); PG8_MMA(0, 1, At, B1); PG8_BAR; PG8_SCHED;
            PG8_LDA(At, 1, 1); PG8_STAGE(PG8_SB(1, 0), b3, voffB); PG8_STAGE(PG8_SB(1, 1), b3 + hstepB, voffB); PG8_STAGE(PG8_SA(1, 0), a3, voffA);
            PG8_WAIT_V(8); PG8_WAIT_L(0); PG8_BAR; PG8_MMA(1, 0, At, B0); PG8_MMA(1, 1, At, B1); PG8_BAR; PG8_SCHED;
            } else {
            PG8_LDB(B0, 0, 0); PG8_SCHED; PG8_LDA(At, 0, 0); PG8_STAGE(PG8_SA(1, 1), a1 + hstepA, voffA);
            PG8_WAIT_L(8); PG8_BAR; PG8_WAIT_L(0); PG8_MMA(0, 0, At, B0); PG8_BAR; PG8_SCHED;
            PG8_LDB(B1, 0, 1); PG8_STAGE(PG8_SB(0, 0), b2, voffB);
            PG8_BAR; PG8_WAIT_L(0); PG8_MMA(0, 1, At, B1); PG8_BAR;
            PG8_LDA(At, 0, 1); PG8_STAGE(PG8_SA(0, 0), a2, voffA);
            PG8_BAR; PG8_WAIT_L(0); PG8_MMA(1, 0, At, B0); PG8_BAR; PG8_SCHED;
            PG8_STAGE(PG8_SB(0, 1), b2 + hstepB, voffB);
            PG8_WAIT_V(6); PG8_BAR; PG8_MMA(1, 1, At, B1); PG8_BAR;
            PG8_LDB(B0, 1, 0); PG8_SCHED; PG8_LDA(At, 1, 0); PG8_STAGE(PG8_SA(0, 1), a2 + hstepA, voffA);
            PG8_WAIT_L(8); PG8_BAR; PG8_WAIT_L(0); PG8_MMA(0, 0, At, B0); PG8_BAR; PG8_SCHED;
            PG8_LDB(B1, 1, 1); PG8_STAGE(PG8_SB(1, 0), b3, voffB);
            PG8_BAR; PG8_WAIT_L(0); PG8_MMA(0, 1, At, B1); PG8_BAR;
            PG8_LDA(At, 1, 1); PG8_STAGE(PG8_SA(1, 0), a3, voffA);
            PG8_BAR; PG8_WAIT_L(0); PG8_MMA(1, 0, At, B0); PG8_BAR; PG8_SCHED;
            PG8_STAGE(PG8_SB(1, 1), b3 + hstepB, voffB);
            PG8_WAIT_V(6); PG8_BAR; PG8_MMA(1, 1, At, B1); PG8_BAR;
            }
        }
        if constexpr (ALIGN_EPI) { if (wr == 0) PG8_BAR; }
        E(acc, cur, wr, wc, fr, fq);
        if (!has_next) break;
#pragma unroll
        for (int a = 0; a < 2; ++a)
#pragma unroll
            for (int b = 0; b < 2; ++b)
#pragma unroll
                for (int m = 0; m < 4; ++m)
#pragma unroll
                    for (int n = 0; n < 2; ++n) acc[a][b][m][n] = (f32x4){0.f, 0.f, 0.f, 0.f};
        cur = nxt; cA = nA; cB = nB; ++ui;
        if constexpr (ALIGN_EPI) { if (wr == 1) PG8_BAR; }
    }
    PG8_WAIT_V(0);
    if constexpr (!ALIGN_EPI) { if (wr == 0) PG8_BAR; }
    PG8_BAR;
#undef PG8_SA
#undef PG8_SB
#undef PG8_STAGE
#undef PG8_LDA
#undef PG8_LDB
#undef PG8_MMA
#undef PG8_WAIT_V
#undef PG8_WAIT_L
#undef PG8_BAR
#undef PG8_SCHED
}
}

constexpr int NT = 16384, SEQ = 8192, DM = 1024, DIN = 4680, NIN = 4864, NCHK = 256, NWAVES = 8, NTHR = 512;
constexpr float EPS = 1e-6f, GN_EPS = 64e-5f, DECAY_SCALE = 0.606531f;
constexpr float QSCALE = 0.07216878364870322f * 1.4426950408889634f;
constexpr size_t MiB = 1u << 20;
constexpr size_t WS_CTL = 0, CTL_BYTES = 1 * MiB;
constexpr size_t CTL_MOD = 65536;
constexpr size_t CTL_SSQ = 131072;
constexpr size_t WS_WIN = 1 * MiB;
constexpr size_t WS_CB = WS_WIN, WS_ECUM = WS_WIN + 8 * MiB, WS_CDEC = WS_ECUM + 512 * 1024;
constexpr size_t WS_WQ = 10 * MiB + 512 * 1024;
constexpr size_t WS_WUV = 11 * MiB;
constexpr size_t WS_WLW = 11 * MiB + 512 * 1024;
constexpr size_t WS_WLA = WS_WLW + 65536;
constexpr size_t WS_WOUT = 12 * MiB;
constexpr size_t WS_XN = 15 * MiB;
constexpr size_t WS_TT = WS_XN, WS_QE = WS_XN + 16 * MiB;
constexpr size_t WS_QLAT = 47 * MiB, WS_KVL = 55 * MiB;
constexpr size_t WS_OL = WS_QLAT;
constexpr size_t WS_GATES = 63 * MiB;
constexpr size_t WS_XBC = 111 * MiB;
constexpr size_t WS_R = 143 * MiB, WS_K = 159 * MiB, WS_V = 175 * MiB;
constexpr size_t WS_F = 191 * MiB;
constexpr size_t WS_Q = 200 * MiB;
constexpr size_t WS_KVB = 224 * MiB;
constexpr size_t WS_YD = 230 * MiB;
constexpr size_t WS_ROPE = 246 * MiB;
constexpr size_t WS_HX = 250 * MiB;
constexpr size_t WS_HRKV = WS_HX + 1536 * 1024;
constexpr size_t WS_HF = WS_HRKV + 768 * 1024;
constexpr size_t WS_END = 253 * MiB;
constexpr int LDS_BYTES = 152 * 1024;

#define LDS_WAIT() asm volatile("s_waitcnt lgkmcnt(0)" ::: "memory")
__device__ __forceinline__ unsigned f2bf(float f) { unsigned u = __builtin_bit_cast(unsigned, f); return (u + 0x7fffu + ((u >> 16) & 1u)) >> 16; }
__device__ __forceinline__ unsigned pk2(float lo, float hi) { return f2bf(lo) | (f2bf(hi) << 16); }
__device__ __forceinline__ float bf2f(unsigned short b) { return __builtin_bit_cast(float, (unsigned)b << 16); }
__device__ __forceinline__ float bflo(unsigned w) { return __builtin_bit_cast(float, w << 16); }
__device__ __forceinline__ float bfhi(unsigned w) { return __builtin_bit_cast(float, w & 0xffff0000u); }
__device__ __forceinline__ float wave_sum(float v) {
#pragma unroll
    for (int o = 1; o < 64; o <<= 1) v += __shfl_xor(v, o);
    return v;
}
__device__ __forceinline__ float sigmoidf_(float x) { return 1.f / (1.f + __expf(-x)); }
__device__ __forceinline__ float siluf_(float x) { return x / (1.f + __expf(-x)); }
__device__ __forceinline__ int pi16(int n) { const int x = n & 15; return (n & ~15) | ((x >= 4 && x < 8) ? x + 4 : (x >= 8 && x < 12) ? x - 4 : x); }
__device__ __forceinline__ int sg32(int x) { return (x & ~31) | (16 * ((x >> 2) & 1) + 4 * ((x & 31) >> 3) + (x & 3)); }
__device__ __forceinline__ int crow(int r, int hi) { return (r & 3) + 8 * (r >> 2) + 4 * hi; }

template <int K> __device__ __forceinline__ f32x4 mma_tile(const LAS bf16_t* A, int lda, const LAS bf16_t* Bt, int ldb, int lane) {
    f32x4 acc = {0.f, 0.f, 0.f, 0.f};
    const LAS bf16_t* ap = A + (lane & 15) * lda + (lane >> 4) * 8;
    const LAS bf16_t* bp = Bt + (lane & 15) * ldb + (lane >> 4) * 8;
#pragma unroll
    for (int k = 0; k < K; k += 32) {
        const bf16x8 a = *(const LAS bf16x8*)(ap + k), b = *(const LAS bf16x8*)(bp + k);
        acc = __builtin_amdgcn_mfma_f32_16x16x32_bf16(a, b, acc, 0, 0, 0);
    }
    return acc;
}

struct Args {
    const float* in[31]; float* out; unsigned char* ws; int ph_lo, ph_hi;
};
struct Ctx {
    LAS unsigned char* lds; int tid, lane, wave, G, bid;
    unsigned char* ws; float* out;
    const float* const* in;
};
__device__ __forceinline__ const float* ldin(const float* const* in, int i) { asm volatile("" : "+s"(i)); return (const float*)(const GAS float*)in[i]; }
#define INP(i) ldin(F.in, i)
__device__ __forceinline__ int fresh_lane() { int l_ = (int)__builtin_amdgcn_mbcnt_hi(~0u, __builtin_amdgcn_mbcnt_lo(~0u, 0u)); asm volatile("" : "+v"(l_)); return l_; }
enum { I_X = 0, I_C, I_POS, I_ADAW, I_ADAB, I_NORMW, I_WIN, I_QNW, I_WUQ, I_KVNW, I_WUKV, I_CONVW, I_CONVB, I_DTB, I_ALOG, I_DSKIP, I_SSDNW,
       I_MURKV, I_MUW, I_MUA, I_W0, I_WLB, I_A0, I_ALB, I_KK, I_KA, I_RK, I_LNXW, I_LNXB, I_WOUT, I_FNW };

__device__ __forceinline__ int win_src_col(int n) {
    if (n < 448) return n;
    if (n < 512) return -1;
    if (n < 1024) return 448 + (n - 512);
    if (n < 1536) return 960 + (n - 1024);
    if (n < 2560) return 1472 + (n - 1536);
    if (n < 3072) return 2504 + (n - 2560);
    if (n < 3584) return 3016 + (n - 3072);
    if (n < 4096) return 3528 + (n - 3584);
    if (n < 4608) return 4168 + (n - 4096);
    if (n < 4672) return 4040 + (n - 4608);
    if (n < 4736) return 4104 + (n - 4672);
    if (n < 4744) return 2496 + (n - 4736);
    return -1;
}
template <class Src> __device__ __forceinline__ void transpose_item(const Src& src, bf16_t* WT, int ldw, LAS float* scr, int kb, int nb, int lane) {
    const int k0 = 64 * kb, n0 = 32 * nb;
#pragma unroll 8
    for (int i = 0; i < 32; ++i) { const int kk = 2 * i + (lane >> 5); scr[kk * 33 + (lane & 31)] = src(k0 + kk, n0 + (lane & 31)); }
    LDS_WAIT();
    const int c = lane & 7;
#pragma unroll
    for (int j = 0; j < 4; ++j) { const int n = (lane >> 3) + 8 * j; const LAS float* s = scr + (8 * c) * 33 + n;
        u32x4 o; o.x = pk2(s[0 * 33], s[1 * 33]); o.y = pk2(s[2 * 33], s[3 * 33]); o.z = pk2(s[4 * 33], s[5 * 33]); o.w = pk2(s[6 * 33], s[7 * 33]);
        *(u32x4*)(WT + (size_t)(n0 + n) * ldw + k0 + 8 * c) = o; }
    LDS_WAIT();
}
__device__ __forceinline__ void prep_weights(const Ctx& F, int l) {
    LAS float* scr = (LAS float*)(F.lds + F.wave * 8448);
    const int gw = F.bid * NWAVES + F.wave, NGW = F.G * NWAVES;
    const float* w_in = INP(I_WIN) + (size_t)l * DM * DIN;
    const float* w_out = INP(I_WOUT) + (size_t)l * 1536 * 1024;
    const float* wlb = INP(I_WLB) + (size_t)l * 64 * 512;
    const float* alb = INP(I_ALB) + (size_t)l * 64 * 512;
    bf16_t* WIN = (bf16_t*)(F.ws + WS_WIN); bf16_t* WOUT = (bf16_t*)(F.ws + WS_WOUT); bf16_t* WLW = (bf16_t*)(F.ws + WS_WLW); bf16_t* WLA = (bf16_t*)(F.ws + WS_WLA);
    constexpr int I_IN = 16 * (NIN / 32), I_OUT = 24 * 32, I_LW = 16, I_LA = 16, NITEMS = I_IN + I_OUT + I_LW + I_LA;
    for (int it = gw; it < NITEMS; it += NGW) {
        int r = it;
        if (r < I_IN) { const int kb = r / (NIN / 32), nb = r % (NIN / 32);
            transpose_item([&](int k, int n) { const int sc = win_src_col(n); return sc >= 0 ? w_in[(size_t)k * DIN + sc] : 0.f; }, WIN, 1024, scr, kb, nb, F.lane); continue; }
        r -= I_IN;
        if (r < I_OUT) { const int kb = r / 32, nb = r % 32;
            transpose_item([&](int k, int n) { return w_out[(size_t)k * 1024 + n]; }, WOUT, 1536, scr, kb, nb, F.lane); continue; }
        r -= I_OUT;
        if (r < I_LW) { transpose_item([&](int k, int n) { return wlb[k * 512 + n]; }, WLW, 64, scr, 0, r, F.lane); continue; }
        r -= I_LW;
        transpose_item([&](int k, int n) { return alb[k * 512 + n]; }, WLA, 64, scr, 0, r, F.lane);
    }
    const float* wuq = INP(I_WUQ) + (size_t)l * 256 * 768; const float* wukv = INP(I_WUKV) + (size_t)l * 128 * 1024; const float* qnw = INP(I_QNW) + l * 256;
    bf16_t* WQ = (bf16_t*)(F.ws + WS_WQ); bf16_t* WUV = (bf16_t*)(F.ws + WS_WUV);
    const int gt = F.bid * NTHR + F.tid, NGT = F.G * NTHR;
    for (int e = gt; e < 768 * 256; e += NGT) {
        const int n = e >> 8, k = e & 255, h = n / 192, idx = n % 192; float v;
        if (idx < 128) {
            const f32x4* a = (const f32x4*)(wuq + (size_t)k * 768 + h * 192); const f32x4* b = (const f32x4*)(wukv + (size_t)idx * 1024 + h * 256);
            float s = 0.f;
#pragma unroll 8
            for (int d = 0; d < 32; ++d) { const f32x4 x = a[d], y = b[d]; s += x.x * y.x + x.y * y.y + x.z * y.z + x.w * y.w; }
            v = s;
        } else v = wuq[(size_t)k * 768 + n];
        WQ[e] = (bf16_t)f2bf(v * qnw[k]);
    }
    for (int e = gt; e < 512 * 512; e += NGT) {
        const int n = e >> 9, k = e & 511, h = n >> 7, d = n & 127, h2 = k >> 7, c = k & 127;
        WUV[e] = (h == h2) ? (bf16_t)f2bf(wukv[(size_t)c * 1024 + h * 256 + 128 + d]) : (bf16_t)0;
    }
}
__device__ __forceinline__ void p0_prologue(const Ctx& F) {
    prep_weights(F, 0);
    const int gw = F.bid * NWAVES + F.wave, NGW = F.G * NWAVES;
    float* MOD = (float*)(F.ws + WS_CTL + CTL_MOD);
    for (int it = gw; it < 2 * 12 * 32; it += NGW) {
        const int l = it / 384, r = it % 384, cb = r / 32, ks = r % 32;
        const float* aw = INP(I_ADAW) + (size_t)l * DM * 3072 + (size_t)(ks * 32) * 3072 + cb * 256 + F.lane * 4;
        const float* cc = INP(I_C);
        f32x4 a0 = {0.f, 0.f, 0.f, 0.f}, a1 = a0;
#pragma unroll 8
        for (int k = 0; k < 32; ++k) { const f32x4 w = *(const f32x4*)(aw + (size_t)k * 3072); const float s0 = siluf_(cc[ks * 32 + k]), s1 = siluf_(cc[DM + ks * 32 + k]); a0 += w * s0; a1 += w * s1; }
        if (ks == 0) { const f32x4 bb = *(const f32x4*)(INP(I_ADAB) + l * 3072 + cb * 256 + F.lane * 4); a0 += bb; a1 += bb; }
        float* m0 = MOD + (size_t)(l * 2 + 0) * 3072 + cb * 256 + F.lane * 4; float* m1 = m0 + 3072;
#pragma unroll
        for (int j = 0; j < 4; ++j) { atomicAdd(m0 + j, a0[j]); atomicAdd(m1 + j, a1[j]); }
    }
    float* ROPE = (float*)(F.ws + WS_ROPE); const int* pos = (const int*)INP(I_POS);
    for (int e = F.bid * NTHR + F.tid; e < NT * 32; e += F.G * NTHR) {
        const int m = e >> 5, i = e & 31;
        const float invf = powf(10000.f, -(float)i / 32.f); const float ang = (float)pos[m] * invf;
        const double a = (double)ang; const double kq = __builtin_rint(a * 0.15915494309189535); const float rr = (float)(a - kq * 6.283185307179586);
        ROPE[(size_t)m * 64 + i] = cosf(rr); ROPE[(size_t)m * 64 + 32 + i] = sinf(rr);
    }
}
__device__ __forceinline__ void p1_norm(const Ctx& F, int l) {
    const float* xin = (l == 0) ? INP(I_X) : F.out;
    const float* nw = INP(I_NORMW) + l * DM; const float* MOD = (const float*)(F.ws + WS_CTL + CTL_MOD);
    bf16_t* XN = (bf16_t*)(F.ws + WS_XN);
    const int gw = F.bid * NWAVES + F.wave, NGW = F.G * NWAVES;
    for (int m = gw; m < NT; m += NGW) {
        const int b = m >> 13; const float* md = MOD + (size_t)(l * 2 + b) * 3072;
        const f32x4* xr = (const f32x4*)(xin + (size_t)m * DM) + F.lane;
        f32x4 v[4]; float s = 0.f;
#pragma unroll
        for (int j = 0; j < 4; ++j) { v[j] = xr[64 * j]; s += v[j].x * v[j].x + v[j].y * v[j].y + v[j].z * v[j].z + v[j].w * v[j].w; }
        const float rstd = 1.f / sqrtf(wave_sum(s) * (1.f / DM) + EPS);
        unsigned long long* o8 = (unsigned long long*)(XN + (size_t)m * DM) + F.lane;
#pragma unroll
        for (int j = 0; j < 4; ++j) { const int c0 = 4 * F.lane + 256 * j;
            const f32x4 w = *(const f32x4*)(nw + c0), sh = *(const f32x4*)(md + c0), sc = *(const f32x4*)(md + 1024 + c0);
            const f32x4 y = v[j] * rstd * w * (sc + 1.f) + sh;
            o8[64 * j] = (unsigned long long)pk2(y.x, y.y) | ((unsigned long long)pk2(y.z, y.w) << 32); }
    }
}
__device__ __forceinline__ u32x4 pack8(f32x4 a, f32x4 b) { u32x4 w; w.x = pk2(a[0], a[1]); w.y = pk2(a[2], a[3]); w.z = pk2(b[0], b[1]); w.w = pk2(b[2], b[3]); return w; }
struct EpiIn {
    unsigned char* ws; int l;
    __device__ __forceinline__ void operator()(const f32x4 (&acc)[2][2][4][2], const pg8::Unit& u, int wr, int wc, int fr, int fq) const {
        { int ln_ = (int)__builtin_amdgcn_mbcnt_hi(~0u, __builtin_amdgcn_mbcnt_lo(~0u, 0u)); asm volatile("" : "+v"(ln_)); fr = ln_ & 15; fq = ln_ >> 4; }
        const int pn = u.pn; size_t bo; int ld, c0;
        if (pn == 0) { bo = WS_QLAT; ld = 256; c0 = 0; } else if (pn == 1) { bo = WS_KVL; ld = 256; c0 = 0; }
        else if (pn < 4) { bo = WS_GATES; ld = 1536; c0 = (pn - 2) * 256; } else if (pn < 6) { bo = WS_GATES; ld = 1536; c0 = 512 + (pn - 4) * 256; }
        else if (pn < 10) { bo = WS_XBC; ld = 1024; c0 = (pn - 6) * 256; } else if (pn < 12) { bo = WS_R; ld = 512; c0 = (pn - 10) * 256; }
        else if (pn < 14) { bo = WS_K; ld = 512; c0 = (pn - 12) * 256; } else if (pn < 16) { bo = WS_V; ld = 512; c0 = (pn - 14) * 256; }
        else if (pn < 18) { bo = WS_GATES; ld = 1536; c0 = 1024 + (pn - 16) * 256; } else { bo = WS_F; ld = 144; c0 = 0; }
        bf16_t* base = (bf16_t*)(ws + bo); float* F = (float*)(ws + WS_F);
        float* ssq_q = (float*)(ws + WS_CTL + CTL_SSQ) + (size_t)(l * 2) * NT; float* ssq_kv = ssq_q + NT;
        const int row0 = u.pm * 256 + wr * 64 + fr, col0 = wc * 32 + 8 * fq;
        if (pn < 18) {
#pragma unroll
            for (int ai = 0; ai < 2; ++ai)
#pragma unroll
                for (int m = 0; m < 4; ++m) { const int row = row0 + ai * 128 + m * 16; bf16_t* rp = base + (size_t)row * ld + c0 + col0;
#pragma unroll
                    for (int bj = 0; bj < 2; ++bj) *(u32x4*)(rp + bj * 128) = pack8(acc[ai][bj][m][0], acc[ai][bj][m][1]);
                    if (pn < 2) { float s = 0.f;
#pragma unroll
                        for (int bj = 0; bj < 2; ++bj) if (pn == 0 || bj == 0) {
#pragma unroll
                            for (int n = 0; n < 2; ++n) { const f32x4 x = acc[ai][bj][m][n]; s += x[0] * x[0] + x[1] * x[1] + x[2] * x[2] + x[3] * x[3]; } }
                        s += __shfl_xor(s, 16); s += __shfl_xor(s, 32);
                        if (fq == 0) atomicAdd((pn == 0 ? ssq_q : ssq_kv) + row, s); } }
        } else {
#pragma unroll
            for (int ai = 0; ai < 2; ++ai)
#pragma unroll
                for (int m = 0; m < 4; ++m) { const int row = row0 + ai * 128 + m * 16;
#pragma unroll
                    for (int bj = 0; bj < 2; ++bj) { const int c = bj * 128 + col0; if (c < 136) { float* fp = F + (size_t)row * 144 + c; *(f32x4*)fp = acc[ai][bj][m][0]; *(f32x4*)(fp + 4) = acc[ai][bj][m][1]; } } }
        }
    }
};
struct EpiQ {
    unsigned char* ws; int l;
    __device__ __forceinline__ void operator()(const f32x4 (&acc)[2][2][4][2], const pg8::Unit& u, int wr, int wc, int fr, int fq) const {
        { int ln_ = (int)__builtin_amdgcn_mbcnt_hi(~0u, __builtin_amdgcn_mbcnt_lo(~0u, 0u)); asm volatile("" : "+v"(ln_)); fr = ln_ & 15; fq = ln_ >> 4; }
        bf16_t* Q = (bf16_t*)(ws + WS_Q); const float* ssq = (const float*)(ws + WS_CTL + CTL_SSQ) + (size_t)(l * 2) * NT;
        const int row0 = u.pm * 256 + wr * 64 + fr, c0 = u.pn * 256 + wc * 32 + 8 * fq;
#pragma unroll
        for (int ai = 0; ai < 2; ++ai)
#pragma unroll
            for (int m = 0; m < 4; ++m) { const int row = row0 + ai * 128 + m * 16; const float sc = QSCALE / sqrtf(ssq[row] * (1.f / 256.f) + EPS); bf16_t* qp = Q + (size_t)row * 768 + c0;
#pragma unroll
                for (int bj = 0; bj < 2; ++bj) *(u32x4*)(qp + bj * 128) = pack8(acc[ai][bj][m][0] * sc, acc[ai][bj][m][1] * sc); }
    }
};
struct EpiUV {
    bf16_t* gates;
    __device__ __forceinline__ void operator()(const f32x4 (&acc)[2][2][4][2], const pg8::Unit& u, int wr, int wc, int fr, int fq) const {
        { int ln_ = (int)__builtin_amdgcn_mbcnt_hi(~0u, __builtin_amdgcn_mbcnt_lo(~0u, 0u)); asm volatile("" : "+v"(ln_)); fr = ln_ & 15; fq = ln_ >> 4; }
        const int row0 = u.pm * 256 + wr * 64 + fr;
#pragma unroll
        for (int ai = 0; ai < 2; ++ai)
#pragma unroll
            for (int m = 0; m < 4; ++m) { asm volatile("" ::: "memory"); const int row = row0 + ai * 128 + m * 16;
#pragma unroll
                for (int bj = 0; bj < 2; ++bj) { const int c = u.pn * 256 + bj * 128 + wc * 32 + 8 * fq; u32x4* gp = (u32x4*)(gates + (size_t)row * 1536 + c); const u32x4 gw = *gp;
                    f32x4 v0 = acc[ai][bj][m][0], v1 = acc[ai][bj][m][1];
                    v0[0] *= siluf_(bflo(gw.x)); v0[1] *= siluf_(bfhi(gw.x)); v0[2] *= siluf_(bflo(gw.y)); v0[3] *= siluf_(bfhi(gw.y));
                    v1[0] *= siluf_(bflo(gw.z)); v1[1] *= siluf_(bfhi(gw.z)); v1[2] *= siluf_(bflo(gw.w)); v1[3] *= siluf_(bfhi(gw.w));
                    *gp = pack8(v0, v1); } }
    }
};
struct EpiOut {
    const float* xin; float* xout; const float* gate;
    __device__ __forceinline__ void operator()(const f32x4 (&acc)[2][2][4][2], const pg8::Unit& u, int wr, int wc, int fr, int fq) const {
        { int ln_ = (int)__builtin_amdgcn_mbcnt_hi(~0u, __builtin_amdgcn_mbcnt_lo(~0u, 0u)); asm volatile("" : "+v"(ln_)); fr = ln_ & 15; fq = ln_ >> 4; }
        const int row0 = u.pm * 256 + wr * 64 + fr;
#pragma unroll
        for (int bj = 0; bj < 2; ++bj) { const int c = u.pn * 256 + bj * 128 + wc * 32 + 8 * fq;
#pragma unroll
            for (int ai = 0; ai < 2; ++ai)
#pragma unroll
                for (int m = 0; m < 4; ++m) { const int row = row0 + ai * 128 + m * 16; const float* gp = gate + (size_t)(row >> 13) * 3072 + c;
                    const f32x4 g0 = *(const f32x4*)gp, g1 = *(const f32x4*)(gp + 4);
                    const size_t off = (size_t)row * DM + c; const f32x4 x0 = *(const f32x4*)(xin + off), x1 = *(const f32x4*)(xin + off + 4);
                    *(f32x4*)(xout + off) = x0 + g0 * acc[ai][bj][m][0]; *(f32x4*)(xout + off + 4) = x1 + g1 * acc[ai][bj][m][1]; } }
    }
};

__device__ __forceinline__ void p3a_extras(const Ctx& F, int l) {
    const int tid_ = F.wave * 64 + fresh_lane();
    const int gt = F.bid * NTHR + tid_, NGT = F.G * NTHR;
    const bf16_t* KVL = (const bf16_t*)(F.ws + WS_KVL); bf16_t* KVB = (bf16_t*)(F.ws + WS_KVB);
    const float* ssq = (const float*)(F.ws + WS_CTL + CTL_SSQ) + (size_t)(l * 2 + 1) * NT; const float* kvnw = INP(I_KVNW) + l * 128;
    const float* ROPE = (const float*)(F.ws + WS_ROPE);
    for (int e = gt; e < NT * 24; e += NGT) {
        const int m = e / 24, g = e % 24;
        if (g < 16) {
            const u32x4 w = *(const u32x4*)(KVL + (size_t)m * 256 + 8 * g); const float rs = 1.f / sqrtf(ssq[m] * (1.f / 128.f) + EPS);
            const f32x4 n0 = *(const f32x4*)(kvnw + 8 * g), n1 = *(const f32x4*)(kvnw + 8 * g + 4);
            u32x4 o; o.x = pk2(bflo(w.x) * rs * n0[0], bfhi(w.x) * rs * n0[1]); o.y = pk2(bflo(w.y) * rs * n0[2], bfhi(w.y) * rs * n0[3]);
            o.z = pk2(bflo(w.z) * rs * n1[0], bfhi(w.z) * rs * n1[1]); o.w = pk2(bflo(w.w) * rs * n1[2], bfhi(w.w) * rs * n1[3]);
            *(u32x4*)(KVB + (size_t)m * 192 + 8 * g) = o;
        } else {
            const int i0 = 4 * (g - 16);
            const u32x2 a = *(const u32x2*)(KVL + (size_t)m * 256 + 128 + i0), b = *(const u32x2*)(KVL + (size_t)m * 256 + 160 + i0);
            const f32x4 cs = *(const f32x4*)(ROPE + (size_t)m * 64 + i0), sn = *(const f32x4*)(ROPE + (size_t)m * 64 + 32 + i0);
            const f32x4 x1 = {bflo(a.x), bfhi(a.x), bflo(a.y), bfhi(a.y)}, x2 = {bflo(b.x), bfhi(b.x), bflo(b.y), bfhi(b.y)};
            const f32x4 o1 = x1 * cs - x2 * sn, o2 = x1 * sn + x2 * cs;
            u32x2 w1, w2; w1.x = pk2(o1[0], o1[1]); w1.y = pk2(o1[2], o1[3]); w2.x = pk2(o2[0], o2[1]); w2.y = pk2(o2[2], o2[3]);
            *(u32x2*)(KVB + (size_t)m * 192 + 128 + i0) = w1; *(u32x2*)(KVB + (size_t)m * 192 + 160 + i0) = w2;
        }
    }
    const u32x4* XBC = (const u32x4*)(F.ws + WS_XBC); u32x4* HX = (u32x4*)(F.ws + WS_HX);
    for (int e = gt; e < NCHK * 3 * 128; e += NGT) { const int c = e / 384, r = e % 384, j = r >> 7, p = r & 127; HX[e] = XBC[(size_t)(64 * c + 61 + j) * 128 + p]; }
    u32x4* HR = (u32x4*)(F.ws + WS_HRKV);
    for (int e = gt; e < 3 * NCHK * 64; e += NGT) { const int w = e / (NCHK * 64), r = e % (NCHK * 64), c = r >> 6, p = r & 63;
        const u32x4* src = (const u32x4*)(F.ws + (w == 0 ? WS_R : w == 1 ? WS_K : WS_V)); HR[e] = src[(size_t)(64 * c + 63) * 64 + p]; }
    const f32x4* FF = (const f32x4*)(F.ws + WS_F); f32x4* HF = (f32x4*)(F.ws + WS_HF);
    for (int e = gt; e < NCHK * 32; e += NGT) { const int c = e >> 5, p = e & 31; HF[e] = FF[(size_t)(64 * c + 63) * 36 + p]; }
}

__device__ __forceinline__ int ssd_win_col(int g, int o) { return o < 256 ? 256 * g + o : o < 384 ? 512 + 128 * g + (o - 256) : 768 + 128 * g + (o - 384); }
__device__ __forceinline__ void p3b_ssd(const Ctx& F, int l) {
    constexpr int SC_C = 0, SC_B = 17408, SC_BT = 34816, SC_XST = 53248, SC_CB = 90112, SC_G = 106752, SC_XSD = 115968, SC_DT = 125184, SC_AC = 127232;
    LAS bf16_t* Cg = (LAS bf16_t*)(F.lds + SC_C); LAS bf16_t* Bg = (LAS bf16_t*)(F.lds + SC_B); LAS bf16_t* BT = (LAS bf16_t*)(F.lds + SC_BT);
    LAS bf16_t* XST = (LAS bf16_t*)(F.lds + SC_XST); LAS float* CB = (LAS float*)(F.lds + SC_CB); LAS bf16_t* Gh = (LAS bf16_t*)(F.lds + SC_G);
    LAS bf16_t* XSD = (LAS bf16_t*)(F.lds + SC_XSD); LAS float* DT = (LAS float*)(F.lds + SC_DT); LAS float* AC = (LAS float*)(F.lds + SC_AC);
    bf16_t* XBC = (bf16_t*)(F.ws + WS_XBC); const bf16_t* HX = (const bf16_t*)(F.ws + WS_HX); const float* Ff = (const float*)(F.ws + WS_F);
    bf16_t* Cbuf = (bf16_t*)(F.ws + WS_CB); float* ECUM = (float*)(F.ws + WS_ECUM); float* CDEC = (float*)(F.ws + WS_CDEC); bf16_t* YD = (bf16_t*)(F.ws + WS_YD);
    const float* convw = INP(I_CONVW) + (size_t)l * 4 * 1024; const float* convb = INP(I_CONVB) + l * 1024;
    const float* dtb = INP(I_DTB) + l * 8; const float* alog = INP(I_ALOG) + l * 8; const float* dskip = INP(I_DSKIP) + l * 8;
    const int tid = F.tid, lane = F.lane, wave = F.wave;
    for (int c = F.bid; c < NCHK; c += F.G) {
        const int m0 = 64 * c; const bool first = (c & 127) == 0;
        if (wave == 0) {
            const int t = lane;
#pragma unroll
            for (int h = 0; h < 8; ++h) {
                const float raw = Ff[(size_t)(m0 + t) * 144 + 128 + h] + dtb[h];
                const float dt = raw > 20.f ? raw : log1pf(expf(raw));
                float v = dt * (-expf(alog[h]));
#pragma unroll
                for (int o = 1; o < 64; o <<= 1) { const float y = __shfl_up(v, o); if (lane >= o) v += y; }
                DT[t * 8 + h] = dt; AC[t * 8 + h] = v;
                const float ev = expf(v); ECUM[(size_t)(c * 8 + h) * 64 + t] = ev; if (t == 63) CDEC[c * 8 + h] = ev;
            }
        }
        for (int g = 0; g < 2; ++g) {
            {
                const int col = ssd_win_col(g, tid);
                const float w0 = convw[col], w1 = convw[1024 + col], w2 = convw[2048 + col], w3 = convw[3072 + col], cb = convb[col];
                float h0 = 0.f, h1 = 0.f, h2 = 0.f;
                if (!first) { h0 = bf2f(HX[(size_t)((c - 1) * 3 + 0) * 1024 + col]); h1 = bf2f(HX[(size_t)((c - 1) * 3 + 1) * 1024 + col]); h2 = bf2f(HX[(size_t)((c - 1) * 3 + 2) * 1024 + col]); }
#pragma unroll 8
                for (int t = 0; t < 64; ++t) {
                    const float x = bf2f(XBC[(size_t)(m0 + t) * 1024 + col]);
                    const float u = w0 * h0 + w1 * h1 + w2 * h2 + w3 * x + cb; h0 = h1; h1 = h2; h2 = x;
                    const bf16_t bv = (bf16_t)f2bf(siluf_(u));
                    if (tid < 256) XST[tid * 72 + t] = bv;
                    else if (tid < 384) { const int n = tid - 256; Bg[t * 136 + n] = bv; BT[n * 72 + t] = bv; }
                    else { const int n = tid - 384; Cg[t * 136 + n] = bv; Cbuf[(size_t)(m0 + t) * 256 + g * 128 + n] = bv; }
                }
            }
            __syncthreads();
#pragma unroll
            for (int i = 0; i < 2; ++i) { const int idx = 2 * wave + i, ti = idx >> 2, si = idx & 3;
                const f32x4 acc = mma_tile<128>(Cg + ti * 16 * 136, 136, Bg + si * 16 * 136, 136, lane);
#pragma unroll
                for (int r = 0; r < 4; ++r) CB[(ti * 16 + 4 * (lane >> 4) + r) * 65 + si * 16 + (lane & 15)] = acc[r]; }
            __syncthreads();
            for (int hl = 0; hl < 4; ++hl) {
                const int h = 4 * g + hl;
                {   const int t = tid >> 3, s0 = (tid & 7) * 8; const float at = AC[t * 8 + h], a63 = AC[63 * 8 + h];
                    float gv[8], xv[8]; const u32x4 xw = *(const LAS u32x4*)(XST + (64 * hl + t) * 72 + s0);
                    const float xf[8] = {bflo(xw.x), bfhi(xw.x), bflo(xw.y), bfhi(xw.y), bflo(xw.z), bfhi(xw.z), bflo(xw.w), bfhi(xw.w)};
#pragma unroll
                    for (int j = 0; j < 8; ++j) { const int s = s0 + j; const float as = AC[s * 8 + h], ds = DT[s * 8 + h];
                        gv[j] = (s <= t) ? CB[t * 65 + s] * expf(at - as) * ds : 0.f; xv[j] = xf[j] * ds * expf(a63 - as); }
                    u32x4 o; o.x = pk2(gv[0], gv[1]); o.y = pk2(gv[2], gv[3]); o.z = pk2(gv[4], gv[5]); o.w = pk2(gv[6], gv[7]); *(LAS u32x4*)(Gh + t * 72 + s0) = o;
                    o.x = pk2(xv[0], xv[1]); o.y = pk2(xv[2], xv[3]); o.z = pk2(xv[4], xv[5]); o.w = pk2(xv[6], xv[7]); *(LAS u32x4*)(XSD + t * 72 + s0) = o; }
                __syncthreads();
                const float dsk = dskip[h];
#pragma unroll
                for (int i = 0; i < 2; ++i) { const int idx = 2 * wave + i, ti = idx >> 2, pi = idx & 3;
                    const f32x4 acc = mma_tile<64>(Gh + ti * 16 * 72, 72, XST + (64 * hl + 16 * pi) * 72, 72, lane);
#pragma unroll
                    for (int r = 0; r < 4; ++r) { const int t = ti * 16 + 4 * (lane >> 4) + r, p = pi * 16 + (lane & 15);
                        const float y = acc[r] + dsk * bf2f(XST[(64 * hl + p) * 72 + t]); YD[(size_t)(m0 + t) * 512 + 64 * h + p] = (bf16_t)f2bf(y); } }
#pragma unroll
                for (int i = 0; i < 4; ++i) { const int idx = 4 * wave + i, pi = idx >> 3, ni = idx & 7;
                    const f32x4 acc = mma_tile<64>(XSD + pi * 16 * 72, 72, BT + ni * 16 * 72, 72, lane);
#pragma unroll
                    for (int r = 0; r < 4; ++r) { const int p = pi * 16 + 4 * (lane >> 4) + r, n = ni * 16 + (lane & 15);
                        const int f = hl * 8192 + p * 128 + n, row = f >> 9, col = ssd_win_col(g, f & 511);
                        XBC[(size_t)(m0 + row) * 1024 + col] = (bf16_t)f2bf(acc[r]); } }
                __syncthreads();
            }
        }
    }
}

__device__ __forceinline__ void p3c_rwkv(const Ctx& F, int l) {
    constexpr int M9 = 9216, O_TW = 0, O_AL = 9216, O_SL = 18432, O_MAB = O_SL + 12 * M9  , O_LWF = O_SL + 10 * M9  , O_ICF = O_LWF + 16640, O_WL = O_MAB + 16640  , O_SCR = O_WL + 256;
    static_assert(O_ICF + 16640 <= O_MAB + 16640 && O_SCR + 4224 <= LDS_BYTES, "rwkv lds map");
#define LB() ({ LAS unsigned char* p_ = F.lds; asm volatile("" : "+s"(p_)); p_; })
#define SLOT(i) ((LAS bf16_t*)(L + O_SL + (i) * M9))
#define TW ((LAS bf16_t*)(L + O_TW))
#define AL ((LAS bf16_t*)(L + O_AL))
#define AT SLOT(0)
#define ATt SLOT(1)
#define BTl SLOT(2)
#define KTl SLOT(3)
#define RT SLOT(4)
#define BHt SLOT(5)
#define KH SLOT(6)
#define VT SLOT(7)
#define MI SLOT(8)
#define MakT SLOT(9)
#define Rb SLOT(10)
#define Rk SLOT(11)
#define Attn SLOT(0)
#define KEt SLOT(1)
#define X1t SLOT(2)
#define X2t SLOT(3)
#define S8 SLOT(8)
#define S9 SLOT(9)
#define MAB ((LAS float*)(L + O_MAB))
#define LWf ((LAS float*)(L + O_LWF))
#define ICf ((LAS float*)(L + O_ICF))
#define WL ((LAS float*)(L + O_WL))
#define SCR ((LAS float*)(L + O_SCR))
    const int tid = F.tid, lane = F.lane, wave = F.wave;
    for (int c = F.bid; c < NCHK; c += F.G) {
        const int m0 = 64 * c; const bool first = (c & 127) == 0;
        {
            LAS unsigned char* L = LB();
            const int t = tid >> 3, q0 = (tid & 7) * 8;
            const float* Ff = (const float*)(F.ws + WS_F); const float* HF = (const float*)(F.ws + WS_HF); const float* mu_w = INP(I_MUW) + l * 64; const float* mu_a = INP(I_MUA) + l * 64;
            float cw[8], pw[8], ca[8], pa[8];
            const float* cur = Ff + (size_t)(m0 + t) * 144; const float* prv = (t > 0) ? cur - 144 : HF + (size_t)(c - 1) * 128;
#pragma unroll
            for (int j = 0; j < 8; ++j) { cw[j] = cur[q0 + j]; ca[j] = cur[64 + q0 + j]; }
            if (t > 0) {
#pragma unroll
                for (int j = 0; j < 8; ++j) { pw[j] = prv[q0 + j]; pa[j] = prv[64 + q0 + j]; }
            } else if (!first) {
#pragma unroll
                for (int j = 0; j < 8; ++j) { pw[j] = prv[q0 + j]; pa[j] = prv[64 + q0 + j]; }
            } else {
#pragma unroll
                for (int j = 0; j < 8; ++j) { pw[j] = 0.f; pa[j] = 0.f; }
            }
            float ow[8], oa[8];
#pragma unroll
            for (int j = 0; j < 8; ++j) { ow[j] = tanhf(cw[j] + (pw[j] - cw[j]) * mu_w[q0 + j]); oa[j] = ca[j] + (pa[j] - ca[j]) * mu_a[q0 + j]; }
            u32x4 o; o.x = pk2(ow[0], ow[1]); o.y = pk2(ow[2], ow[3]); o.z = pk2(ow[4], ow[5]); o.w = pk2(ow[6], ow[7]); *(LAS u32x4*)(TW + t * 72 + q0) = o;
            o.x = pk2(oa[0], oa[1]); o.y = pk2(oa[2], oa[3]); o.z = pk2(oa[4], oa[5]); o.w = pk2(oa[6], oa[7]); *(LAS u32x4*)(AL + t * 72 + q0) = o;
        }
        for (int h = 0; h < 8; ++h) {
            int tid = F.tid, lane = F.lane; asm volatile("" : "+v"(tid), "+v"(lane));
            {   LAS unsigned char* L = LB(); const int row = tid >> 3, c8 = tid & 7; const bf16_t* WLW = (const bf16_t*)(F.ws + WS_WLW); const bf16_t* WLA = (const bf16_t*)(F.ws + WS_WLA);
                *(LAS u32x4*)(S8 + row * 72 + c8 * 8) = *(const u32x4*)(WLW + (size_t)(h * 64 + row) * 64 + c8 * 8);
                *(LAS u32x4*)(S9 + row * 72 + c8 * 8) = *(const u32x4*)(WLA + (size_t)(h * 64 + row) * 64 + c8 * 8); }
            __syncthreads();
            { LAS unsigned char* L = LB(); const float* w0 = INP(I_W0) + l * 512; const float* a0 = INP(I_A0) + l * 512;
#pragma unroll
            for (int i = 0; i < 4; ++i) { const int idx = 4 * wave + i, which = idx >> 4, ti = (idx >> 2) & 3, ci = idx & 3;
                const f32x4 acc = mma_tile<64>((which ? AL : TW) + ti * 16 * 72, 72, (which ? S9 : S8) + ci * 16 * 72, 72, lane);
#pragma unroll
                for (int r = 0; r < 4; ++r) { const int t = ti * 16 + 4 * (lane >> 4) + r, ch = ci * 16 + (lane & 15);
                    if (which == 0) LWf[t * 65 + ch] = -DECAY_SCALE * sigmoidf_(acc[r] + w0[h * 64 + ch]); else ICf[t * 65 + ch] = sigmoidf_(acc[r] + a0[h * 64 + ch]); } } }
            __syncthreads();
            if (wave == 0) { LAS unsigned char* L = LB(); float run = 0.f;
#pragma unroll 8
                for (int t = 0; t < 64; ++t) { run += LWf[t * 65 + lane]; LWf[t * 65 + lane] = run; }
                WL[lane] = expf(run); }
            __syncthreads();
            float bonv[8]; const int t1 = tid >> 3, ch0 = (tid & 7) * 8, col1 = h * 64 + ch0;
            {   LAS unsigned char* L = LB(); const int t = t1;
                const bf16_t* Rg = (const bf16_t*)(F.ws + WS_R); const bf16_t* Kg = (const bf16_t*)(F.ws + WS_K); const bf16_t* Vg = (const bf16_t*)(F.ws + WS_V); const bf16_t* HR = (const bf16_t*)(F.ws + WS_HRKV);
                const float* mu_r = INP(I_MURKV) + (size_t)l * 1536; const float* mu_k = mu_r + 512; const float* mu_v = mu_r + 1024;
                const float* kkp = INP(I_KK) + l * 512; const float* kap = INP(I_KA) + l * 512; const float* rkp = INP(I_RK) + l * 512;
                const size_t off = (size_t)(m0 + t) * 512 + col1;
                const u32x4 rw = *(const u32x4*)(Rg + off), kw = *(const u32x4*)(Kg + off), vw = *(const u32x4*)(Vg + off);
                u32x4 rp = {0u, 0u, 0u, 0u}, kp = rp, vp = rp;
                if (t > 0) { rp = *(const u32x4*)(Rg + off - 512); kp = *(const u32x4*)(Kg + off - 512); vp = *(const u32x4*)(Vg + off - 512); }
                else if (!first) { const size_t ho = (size_t)(c - 1) * 512 + col1; rp = *(const u32x4*)(HR + ho); kp = *(const u32x4*)(HR + (size_t)NCHK * 512 + ho); vp = *(const u32x4*)(HR + (size_t)2 * NCHK * 512 + ho); }
                const unsigned rwa[4] = {rw.x, rw.y, rw.z, rw.w}, kwa[4] = {kw.x, kw.y, kw.z, kw.w}, vwa[4] = {vw.x, vw.y, vw.z, vw.w};
                const unsigned rpa[4] = {rp.x, rp.y, rp.z, rp.w}, kpa[4] = {kp.x, kp.y, kp.z, kp.w}, vpa[4] = {vp.x, vp.y, vp.z, vp.w};
                float rs[8], ks[8], vs[8], kkv[8], k2[8], ic[8]; float ss = 0.f, bs = 0.f;
#pragma unroll
                for (int j = 0; j < 8; ++j) { const int gch = col1 + j; const int q = j >> 1;
                    const float r_ = (j & 1) ? bfhi(rwa[q]) : bflo(rwa[q]), rq = (j & 1) ? bfhi(rpa[q]) : bflo(rpa[q]);
                    const float k_ = (j & 1) ? bfhi(kwa[q]) : bflo(kwa[q]), kq = (j & 1) ? bfhi(kpa[q]) : bflo(kpa[q]);
                    const float v_ = (j & 1) ? bfhi(vwa[q]) : bflo(vwa[q]), vq = (j & 1) ? bfhi(vpa[q]) : bflo(vpa[q]);
                    rs[j] = r_ + (rq - r_) * mu_r[gch]; ks[j] = k_ + (kq - k_) * mu_k[gch]; vs[j] = v_ + (vq - v_) * mu_v[gch];
                    ic[j] = ICf[t * 65 + ch0 + j];
                    kkv[j] = ks[j] * kkp[gch]; ss += kkv[j] * kkv[j];
                    k2[j] = ks[j] * (1.f + (ic[j] - 1.f) * kap[gch]); bs += rs[j] * k2[j] * rkp[gch]; }
                ss += __shfl_xor(ss, 1); ss += __shfl_xor(ss, 2); ss += __shfl_xor(ss, 4);
                bs += __shfl_xor(bs, 1); bs += __shfl_xor(bs, 2); bs += __shfl_xor(bs, 4);
                const float inv = 1.f / fmaxf(sqrtf(ss), 1e-12f);
                float vAT[8], vB[8], vK[8], vR[8], vBH[8], vKH[8];
#pragma unroll
                for (int j = 0; j < 8; ++j) { const int ch = ch0 + j;
                    const float LWt = LWf[t * 65 + ch], LWp = (t > 0) ? LWf[(t - 1) * 65 + ch] : 0.f, L63 = LWf[63 * 65 + ch];
                    const float kk = kkv[j] * inv, a = -kk, b = kk * ic[j];
                    const float e1 = expf(LWt), e2 = expf(-LWt), e3 = expf(LWp), e4 = expf(L63 - LWt);
                    vAT[j] = a * e3; vB[j] = b * e2; vK[j] = k2[j] * e2; vR[j] = rs[j] * e1; vBH[j] = b * e4; vKH[j] = k2[j] * e4; bonv[j] = bs * vs[j];
                    ATt[ch * 72 + t] = (bf16_t)f2bf(vAT[j]); BHt[ch * 72 + t] = (bf16_t)f2bf(vBH[j]); VT[ch * 72 + t] = (bf16_t)f2bf(vs[j]); }
                u32x4 o;
#define PK8(A_) (o[0] = pk2(A_[0], A_[1]), o[1] = pk2(A_[2], A_[3]), o[2] = pk2(A_[4], A_[5]), o[3] = pk2(A_[6], A_[7]), o)
                *(LAS u32x4*)(AT + t * 72 + ch0) = PK8(vAT); *(LAS u32x4*)(BTl + t * 72 + ch0) = PK8(vB); *(LAS u32x4*)(KTl + t * 72 + ch0) = PK8(vK);
                *(LAS u32x4*)(RT + t * 72 + ch0) = PK8(vR); *(LAS u32x4*)(KH + t * 72 + ch0) = PK8(vKH);
            }
            __syncthreads();
            { u32x4 o; *(u32x4*)((bf16_t*)(F.ws + WS_V) + (size_t)(m0 + t1) * 512 + col1) = PK8(bonv); }
            { LAS unsigned char* L = LB();
#pragma unroll
            for (int i = 0; i < 8; ++i) { const int p = wave >> 1, idx = 8 * (wave & 1) + i, ti = idx >> 2, si = idx & 3;
                const f32x4 acc = mma_tile<64>(((p < 2) ? AT : RT) + ti * 16 * 72, 72, ((p & 1) ? KTl : BTl) + si * 16 * 72, 72, lane);
#pragma unroll
                for (int r = 0; r < 4; ++r) { const int t = ti * 16 + 4 * (lane >> 4) + r, s = si * 16 + (lane & 15);
                    if (p == 0) MAB[t * 65 + s] = (s < t) ? acc[r] : 0.f;
                    else if (p == 1) MakT[s * 72 + t] = (bf16_t)f2bf((s < t) ? acc[r] : 0.f);
                    else if (p == 2) Rb[t * 72 + s] = (bf16_t)f2bf((s <= t) ? acc[r] : 0.f);
                    else Rk[t * 72 + s] = (bf16_t)f2bf((s <= t) ? acc[r] : 0.f); } } }
            __syncthreads();
            if (wave < 4 && lane < 16) { LAS unsigned char* L = LB(); const int b0 = 16 * wave; float x[16];
#pragma unroll
                for (int t = 0; t < 16; ++t) { float v = (t == lane) ? 1.f : 0.f;
#pragma unroll
                    for (int s = 0; s < 16; ++s) if (s < t) v += MAB[(b0 + t) * 65 + b0 + s] * x[s];
                    x[t] = v; }
#pragma unroll
                for (int t = 0; t < 16; ++t) MAB[(b0 + t) * 65 + b0 + lane] = x[t]; }
            __syncthreads();
            {   LAS unsigned char* L = LB(); const int pr = tid >> 8, e = tid & 255, rr = e >> 4, cc = e & 15, rb = pr ? 48 : 16, cb = pr ? 32 : 0; float v = 0.f;
#pragma unroll
                for (int s = 0; s < 16; ++s) v += MAB[(rb + rr) * 65 + cb + s] * MAB[(cb + s) * 65 + cb + cc];
                SCR[(pr * 16 + rr) * 33 + cc] = v; }
            __syncthreads();
            {   LAS unsigned char* L = LB(); const int pr = tid >> 8, e = tid & 255, rr = e >> 4, cc = e & 15, rb = pr ? 48 : 16, cb = pr ? 32 : 0; float v = 0.f;
#pragma unroll
                for (int s = 0; s < 16; ++s) v += MAB[(rb + rr) * 65 + rb + s] * SCR[(pr * 16 + s) * 33 + cc];
                MAB[(rb + rr) * 65 + cb + cc] = v; }
            __syncthreads();
            {   LAS unsigned char* L = LB(); float v2[2];
#pragma unroll
                for (int i = 0; i < 2; ++i) { const int e = tid * 2 + i, rr = e >> 5, cc = e & 31; float v = 0.f;
#pragma unroll 8
                    for (int s = 0; s < 32; ++s) v += MAB[(32 + rr) * 65 + s] * MAB[s * 65 + cc];
                    v2[i] = v; }
                SCR[((tid * 2) >> 5) * 33 + ((tid * 2) & 31)] = v2[0]; SCR[((tid * 2 + 1) >> 5) * 33 + ((tid * 2 + 1) & 31)] = v2[1]; }
            __syncthreads();
            {   LAS unsigned char* L = LB();
#pragma unroll
                for (int i = 0; i < 2; ++i) { const int e = tid * 2 + i, rr = e >> 5, cc = e & 31; float v = 0.f;
#pragma unroll 8
                    for (int s = 0; s < 32; ++s) v += MAB[(32 + rr) * 65 + 32 + s] * SCR[s * 33 + cc];
                    MAB[(32 + rr) * 65 + cc] = v; } }
            __syncthreads();
            {   LAS unsigned char* L = LB(); const int t = tid >> 3, s0 = (tid & 7) * 8; float x[8];
#pragma unroll
                for (int j = 0; j < 8; ++j) x[j] = MAB[t * 65 + s0 + j];
                u32x4 o; *(LAS u32x4*)(MI + t * 72 + s0) = PK8(x); }
            __syncthreads();
            { LAS unsigned char* L = LB();
#pragma unroll
            for (int i = 0; i < 4; ++i) { const int idx = 4 * wave + i, which = idx >> 4, ti = (idx >> 2) & 3, ci = idx & 3;
                const f32x4 acc = mma_tile<64>(MI + ti * 16 * 72, 72, (which ? MakT : ATt) + ci * 16 * 72, 72, lane);
#pragma unroll
                for (int r = 0; r < 4; ++r) { const int t = ti * 16 + 4 * (lane >> 4) + r, j = ci * 16 + (lane & 15); (which ? X2t : X1t)[j * 72 + t] = (bf16_t)f2bf(acc[r]); } } }
            __syncthreads();
            { LAS unsigned char* L = LB();
            bf16_t* QEw = (bf16_t*)(F.ws + WS_QE) + (size_t)(c * 8 + h) * 4096; bf16_t* TTw = (bf16_t*)(F.ws + WS_TT) + (size_t)(c * 8 + h) * 4096;
#pragma unroll
            for (int i = 0; i < 8; ++i) { const int p = wave >> 1, idx = 8 * (wave & 1) + i, ti = idx >> 2, si = idx & 3;
                const f32x4 acc = mma_tile<64>(((p == 0 || p == 1) ? Rb : (p == 2) ? X1t : X2t) + ti * 16 * 72, 72, ((p == 0) ? X1t : (p == 1) ? X2t : BHt) + si * 16 * 72, 72, lane);
#pragma unroll
                for (int r = 0; r < 4; ++r) { const int rw = ti * 16 + 4 * (lane >> 4) + r, cl = si * 16 + (lane & 15);
                    if (p == 0) QEw[rw * 64 + pi16(cl)] = (bf16_t)f2bf(acc[r] + bf2f(RT[rw * 72 + cl]));
                    else if (p == 1) Attn[rw * 72 + cl] = (bf16_t)f2bf(acc[r] + bf2f(Rk[rw * 72 + cl]));
                    else if (p == 2) TTw[cl * 64 + pi16(rw)] = (bf16_t)f2bf(acc[r] + ((rw == cl) ? WL[rw] : 0.f));
                    else KEt[cl * 72 + rw] = (bf16_t)f2bf(acc[r] + bf2f(KH[rw * 72 + cl])); } } }
            __syncthreads();
            bf16_t* Rg = (bf16_t*)(F.ws + WS_R); bf16_t* Kg = (bf16_t*)(F.ws + WS_K); LAS unsigned char* L = LB();
#pragma unroll
            for (int i = 0; i < 4; ++i) { const int idx = 4 * wave + i, which = idx >> 4, ti = (idx >> 2) & 3, ci = idx & 3;
                const f32x4 acc = mma_tile<64>((which ? VT : Attn) + ti * 16 * 72, 72, (which ? KEt : VT) + ci * 16 * 72, 72, lane);
#pragma unroll
                for (int r = 0; r < 4; ++r) { const int rw = ti * 16 + 4 * (lane >> 4) + r, cl = ci * 16 + (lane & 15);
                    if (which == 0) Kg[(size_t)(m0 + cl) * 512 + h * 64 + sg32(rw)] = (bf16_t)f2bf(acc[r]);
                    else Rg[(size_t)(m0 + rw) * 512 + h * 64 + sg32(cl)] = (bf16_t)f2bf(acc[r]); } }
        }
        __syncthreads();
    }
#undef SLOT
#undef PK8
#undef LB
#undef TW
#undef AL
#undef AT
#undef ATt
#undef BTl
#undef KTl
#undef RT
#undef BHt
#undef KH
#undef VT
#undef MI
#undef MakT
#undef Rb
#undef Rk
#undef Attn
#undef KEt
#undef X1t
#undef X2t
#undef S8
#undef S9
#undef MAB
#undef LWf
#undef ICf
#undef WL
#undef SCR
}

__device__ __forceinline__ bf16x8 cvt8(const f32x16& x, int s) {
    u32x4 w; w.x = pk2(x[8 * s + 0], x[8 * s + 1]); w.y = pk2(x[8 * s + 2], x[8 * s + 3]); w.z = pk2(x[8 * s + 4], x[8 * s + 5]); w.w = pk2(x[8 * s + 6], x[8 * s + 7]);
    return __builtin_bit_cast(bf16x8, w);
}
__device__ __forceinline__ f32x16 ld16bf(const bf16_t* p) {
    const u32x4 a = *(const u32x4*)p, b = *(const u32x4*)(p + 8); f32x16 r;
    r[0] = bflo(a.x); r[1] = bfhi(a.x); r[2] = bflo(a.y); r[3] = bfhi(a.y); r[4] = bflo(a.z); r[5] = bfhi(a.z); r[6] = bflo(a.w); r[7] = bfhi(a.w);
    r[8] = bflo(b.x); r[9] = bfhi(b.x); r[10] = bflo(b.y); r[11] = bfhi(b.y); r[12] = bflo(b.z); r[13] = bfhi(b.z); r[14] = bflo(b.w); r[15] = bfhi(b.w); return r;
}
__device__ __forceinline__ void st16bf(bf16_t* p, const f32x16& x) {
    u32x4 a, b; a.x = pk2(x[0], x[1]); a.y = pk2(x[2], x[3]); a.z = pk2(x[4], x[5]); a.w = pk2(x[6], x[7]); b.x = pk2(x[8], x[9]); b.y = pk2(x[10], x[11]); b.z = pk2(x[12], x[13]); b.w = pk2(x[14], x[15]);
    *(u32x4*)p = a; *(u32x4*)(p + 8) = b;
}
constexpr int KROW = 400;
__device__ __forceinline__ void attn_unit(const Ctx& F, int b, int c) {
    const int tid = F.tid, lane = F.lane, wave = F.wave, r32 = lane & 31, hi = lane >> 5, head = wave >> 1;
    const bf16_t* Q = (const bf16_t*)(F.ws + WS_Q); const bf16_t* KV = (const bf16_t*)(F.ws + WS_KVB) + (size_t)b * SEQ * 192; bf16_t* OL = (bf16_t*)(F.ws + WS_OL);
    const size_t mq = (size_t)b * SEQ + 64 * c + 32 * (wave & 1) + r32;
    bf16x8 qr[12];
#pragma unroll
    for (int d0 = 0; d0 < 12; ++d0) qr[d0] = *(const bf16x8*)(Q + mq * 768 + head * 192 + 16 * d0 + 8 * hi);
    {
        const float* rp = (const float*)(F.ws + WS_ROPE) + mq * 64;
#pragma unroll
        for (int d0 = 8; d0 < 10; ++d0) { const int j0 = 16 * (d0 - 8) + 8 * hi;
            const f32x4 c0 = *(const f32x4*)(rp + j0), c1 = *(const f32x4*)(rp + j0 + 4), s0 = *(const f32x4*)(rp + 32 + j0), s1 = *(const f32x4*)(rp + 32 + j0 + 4);
            const u32x4 a = __builtin_bit_cast(u32x4, qr[d0]), b = __builtin_bit_cast(u32x4, qr[d0 + 2]);
            const float x1[8] = {bflo(a.x), bfhi(a.x), bflo(a.y), bfhi(a.y), bflo(a.z), bfhi(a.z), bflo(a.w), bfhi(a.w)}, x2[8] = {bflo(b.x), bfhi(b.x), bflo(b.y), bfhi(b.y), bflo(b.z), bfhi(b.z), bflo(b.w), bfhi(b.w)};
            const float cs[8] = {c0[0], c0[1], c0[2], c0[3], c1[0], c1[1], c1[2], c1[3]}, sn[8] = {s0[0], s0[1], s0[2], s0[3], s1[0], s1[1], s1[2], s1[3]};
            float o1[8], o2[8];
#pragma unroll
            for (int e = 0; e < 8; ++e) { o1[e] = x1[e] * cs[e] - x2[e] * sn[e]; o2[e] = x1[e] * sn[e] + x2[e] * cs[e]; }
            u32x4 w1, w2; w1.x = pk2(o1[0], o1[1]); w1.y = pk2(o1[2], o1[3]); w1.z = pk2(o1[4], o1[5]); w1.w = pk2(o1[6], o1[7]); w2.x = pk2(o2[0], o2[1]); w2.y = pk2(o2[2], o2[3]); w2.z = pk2(o2[4], o2[5]); w2.w = pk2(o2[6], o2[7]);
            qr[d0] = __builtin_bit_cast(bf16x8, w1); qr[d0 + 2] = __builtin_bit_cast(bf16x8, w2); }
    }
    int prow[3], pcol[3];
#pragma unroll
    for (int i = 0; i < 3; ++i) { const int idx = tid + 512 * i; prow[i] = idx / 24; pcol[i] = idx % 24; }
    const int nt = c + 1;
    u32x4 st[3];
#pragma unroll
    for (int i = 0; i < 3; ++i) st[i] = *(const u32x4*)(KV + (size_t)prow[i] * 192 + pcol[i] * 8);
#pragma unroll
    for (int i = 0; i < 3; ++i) *(LAS u32x4*)(F.lds + prow[i] * KROW + pcol[i] * 16) = st[i];
    __syncthreads();
    f32x16 o[4];
#pragma unroll
    for (int d = 0; d < 4; ++d)
#pragma unroll
        for (int r = 0; r < 16; ++r) o[d][r] = 0.f;
    float mrun = -1e30f, lrun = 0.f;
    const int troff = (4 * hi + ((lane & 15) >> 2)) * KROW + (((lane >> 4) & 1) * 16 + (lane & 3) * 4) * 2;
    for (int kt = 0; kt < nt; ++kt) {
        LAS unsigned char* buf = F.lds + (kt & 1) * (64 * KROW);
        if (kt + 1 < nt) {
#pragma unroll
            for (int i = 0; i < 3; ++i) st[i] = *(const u32x4*)(KV + (size_t)((kt + 1) * 64 + prow[i]) * 192 + pcol[i] * 8);
        }
        f32x16 p0, p1;
#pragma unroll
        for (int r = 0; r < 16; ++r) { p0[r] = 0.f; p1[r] = 0.f; }
#pragma unroll
        for (int d0 = 0; d0 < 12; ++d0) {
            const bf16x8 a0 = *(const LAS bf16x8*)(buf + r32 * KROW + d0 * 32 + hi * 16), a1 = *(const LAS bf16x8*)(buf + (32 + r32) * KROW + d0 * 32 + hi * 16);
            p0 = __builtin_amdgcn_mfma_f32_32x32x16_bf16(a0, qr[d0], p0, 0, 0, 0); p1 = __builtin_amdgcn_mfma_f32_32x32x16_bf16(a1, qr[d0], p1, 0, 0, 0);
        }
        float mx = p0[0];
#pragma unroll
        for (int r = 0; r < 16; ++r) { mx = fmaxf(mx, p0[r]); mx = fmaxf(mx, p1[r]); }
        mx = fmaxf(mx, __shfl_xor(mx, 32));
        const float mnew = fmaxf(mrun, mx), alpha = exp2f(mrun - mnew); mrun = mnew;
        float ls = 0.f;
#pragma unroll
        for (int r = 0; r < 16; ++r) { p0[r] = exp2f(p0[r] - mnew); p1[r] = exp2f(p1[r] - mnew); ls += p0[r] + p1[r]; }
        lrun = lrun * alpha + ls;
#pragma unroll
        for (int d = 0; d < 4; ++d)
#pragma unroll
            for (int r = 0; r < 16; ++r) o[d][r] *= alpha;
#pragma unroll
        for (int s = 0; s < 4; ++s) {
            const bf16x8 pb = (s < 2) ? cvt8(p0, s & 1) : cvt8(p1, s & 1);
#pragma unroll
            for (int db = 0; db < 4; ++db) {
                const LAS unsigned char* vp = buf + troff + (16 * s) * KROW + db * 64;
                const v4i16_t lo = __builtin_amdgcn_ds_read_tr16_b64_v4i16((LAS v4i16_t*)vp), hh = __builtin_amdgcn_ds_read_tr16_b64_v4i16((LAS v4i16_t*)(vp + 8 * KROW));
                const bf16x8 va = {lo[0], lo[1], lo[2], lo[3], hh[0], hh[1], hh[2], hh[3]};
                o[db] = __builtin_amdgcn_mfma_f32_32x32x16_bf16(va, pb, o[db], 0, 0, 0);
            }
        }
        if (kt + 1 < nt) {
            LAS unsigned char* nb = F.lds + ((kt + 1) & 1) * (64 * KROW);
#pragma unroll
            for (int i = 0; i < 3; ++i) *(LAS u32x4*)(nb + prow[i] * KROW + pcol[i] * 16) = st[i];
        }
        __syncthreads();
    }
    lrun += __shfl_xor(lrun, 32);
    const float inv = 1.f / lrun;
#pragma unroll
    for (int db = 0; db < 4; ++db)
#pragma unroll
        for (int g = 0; g < 4; ++g) { u32x2 w; w.x = pk2(o[db][4 * g] * inv, o[db][4 * g + 1] * inv); w.y = pk2(o[db][4 * g + 2] * inv, o[db][4 * g + 3] * inv);
            *(u32x2*)(OL + mq * 512 + head * 128 + 32 * db + 8 * g + 4 * hi) = w; }
}
struct RwSet { bf16x8 ta[2][4]; u32x4 d[4]; };
__device__ __forceinline__ void rw_load(RwSet& s, const bf16_t* TTg, const bf16_t* Rg, int cg_, int h, int i, int r32, int hi) {
    const bf16_t* TTw = TTg + (size_t)(cg_ * 8 + h) * 4096; const bf16_t* Dw = Rg + ((size_t)64 * cg_ + i) * 512 + h * 64;
#pragma unroll
    for (int a = 0; a < 2; ++a)
#pragma unroll
        for (int s2 = 0; s2 < 4; ++s2) s.ta[a][s2] = *(const bf16x8*)(TTw + (32 * a + r32) * 64 + 16 * s2 + 8 * hi);
    s.d[0] = *(const u32x4*)(Dw + 16 * hi); s.d[1] = *(const u32x4*)(Dw + 16 * hi + 8); s.d[2] = *(const u32x4*)(Dw + 32 + 16 * hi); s.d[3] = *(const u32x4*)(Dw + 32 + 16 * hi + 8);
}
__device__ __forceinline__ f32x16 up16(const u32x4 a, const u32x4 b) { f32x16 r;
    r[0] = bflo(a.x); r[1] = bfhi(a.x); r[2] = bflo(a.y); r[3] = bfhi(a.y); r[4] = bflo(a.z); r[5] = bfhi(a.z); r[6] = bflo(a.w); r[7] = bfhi(a.w);
    r[8] = bflo(b.x); r[9] = bfhi(b.x); r[10] = bflo(b.y); r[11] = bfhi(b.y); r[12] = bflo(b.z); r[13] = bfhi(b.z); r[14] = bflo(b.w); r[15] = bfhi(b.w); return r; }
__device__ __forceinline__ void rw_step(f32x16& X0, f32x16& X1, const RwSet& s, bf16_t* Rg, int cg_, int h, int i, int hi, bool live) {
    const bf16x8 bf[4] = {cvt8(X0, 0), cvt8(X0, 1), cvt8(X1, 0), cvt8(X1, 1)};
    if (live) { bf16_t* Dw = Rg + ((size_t)64 * cg_ + i) * 512 + h * 64;
        *(bf16x8*)(Dw + 16 * hi) = bf[0]; *(bf16x8*)(Dw + 16 * hi + 8) = bf[1]; *(bf16x8*)(Dw + 32 + 16 * hi) = bf[2]; *(bf16x8*)(Dw + 32 + 16 * hi + 8) = bf[3]; }
    f32x16 n0 = up16(s.d[0], s.d[1]), n1 = up16(s.d[2], s.d[3]);
#pragma unroll
    for (int s2 = 0; s2 < 4; ++s2) { n0 = __builtin_amdgcn_mfma_f32_32x32x16_bf16(s.ta[0][s2], bf[s2], n0, 0, 0, 0); n1 = __builtin_amdgcn_mfma_f32_32x32x16_bf16(s.ta[1][s2], bf[s2], n1, 0, 0, 0); }
    X0 = n0; X1 = n1;
}
__device__ __forceinline__ void rwkv_scan(const Ctx& F, int b, int h, int half) {
    const int lane = F.lane, r32 = lane & 31, hi = lane >> 5, i = 32 * half + r32;
    const bf16_t* TTg = (const bf16_t*)(F.ws + WS_TT); bf16_t* Rg = (bf16_t*)(F.ws + WS_R);
    f32x16 X0, X1;
#pragma unroll
    for (int r = 0; r < 16; ++r) { X0[r] = 0.f; X1[r] = 0.f; }
    RwSet sA, sB, sC; const int c0 = b * 128;
    rw_load(sA, TTg, Rg, c0 + 0, h, i, r32, hi); rw_load(sB, TTg, Rg, c0 + 1, h, i, r32, hi); rw_load(sC, TTg, Rg, c0 + 2, h, i, r32, hi);
    for (int c = 0; c < 129; c += 3) {
        rw_step(X0, X1, sA, Rg, c0 + c, h, i, hi, true);          rw_load(sA, TTg, Rg, c0 + min(c + 3, 127), h, i, r32, hi);
        rw_step(X0, X1, sB, Rg, c0 + c + 1, h, i, hi, true);      rw_load(sB, TTg, Rg, c0 + min(c + 4, 127), h, i, r32, hi);
        rw_step(X0, X1, sC, Rg, c0 + min(c + 2, 127), h, i, hi, c + 2 < 128); rw_load(sC, TTg, Rg, c0 + min(c + 5, 127), h, i, r32, hi);
    }
}
__device__ __forceinline__ void ssd_scan(const Ctx& F, int item) {
    const int b = item >> 4, h = (item >> 1) & 7, hp = item & 1, g = h >> 2, hl = h & 3;
    const int piece = hp * 512 + F.tid;
    const int f = hl * 8192 + piece * 8, row = f >> 9, col = ssd_win_col(g, f & 511);
    bf16_t* ST = (bf16_t*)(F.ws + WS_XBC); const float* CDEC = (const float*)(F.ws + WS_CDEC);
    float st[8];
#pragma unroll
    for (int j = 0; j < 8; ++j) st[j] = 0.f;
    for (int c8 = 0; c8 < 128; c8 += 8) {
        u32x4 v[8]; float cd[8];
#pragma unroll
        for (int u = 0; u < 8; ++u) { const int cg_ = b * 128 + c8 + u; v[u] = *(const u32x4*)(ST + ((size_t)64 * cg_ + row) * 1024 + col); cd[u] = CDEC[cg_ * 8 + h]; }
#pragma unroll
        for (int u = 0; u < 8; ++u) { const int cg_ = b * 128 + c8 + u;
            u32x4 o; o.x = pk2(st[0], st[1]); o.y = pk2(st[2], st[3]); o.z = pk2(st[4], st[5]); o.w = pk2(st[6], st[7]);
            *(u32x4*)(ST + ((size_t)64 * cg_ + row) * 1024 + col) = o;
            const float x[8] = {bflo(v[u].x), bfhi(v[u].x), bflo(v[u].y), bfhi(v[u].y), bflo(v[u].z), bfhi(v[u].z), bflo(v[u].w), bfhi(v[u].w)};
#pragma unroll
            for (int j = 0; j < 8; ++j) st[j] = st[j] * cd[u] + x[j]; }
    }
}
__device__ __forceinline__ void p4_mix(const Ctx& F, int what = 3) {
    if (F.bid < 128) { if (!(what & 1)) return;
        const int b = F.bid >> 6, c = F.bid & 63;
        attn_unit(F, b, 127 - c); __syncthreads(); attn_unit(F, b, c);
    } else if (F.bid < 132) { if (what & 2) { const int task = (F.bid - 128) * 8 + F.wave; rwkv_scan(F, task >> 4, (task >> 1) & 7, task & 1); }
    } else if (F.bid < 164) { if (what & 2) ssd_scan(F, F.bid - 132); }
}
__device__ __forceinline__ void p5_assemble(const Ctx& F, int l) {
    bf16_t* GT = (bf16_t*)(F.ws + WS_GATES);
    {   pg8::Gemm g{(const bf16_t*)(F.ws + WS_OL), (const bf16_t*)(F.ws + WS_WUV), NT, 512, 512, 512, 512}; pg8::StaticOrder S; S.init(NT, 512, F.G, F.bid); EpiUV E{GT};
        pg8::gemm_phase<EpiUV, pg8::StaticOrder, true, true>(F.lds, F.wave, g, S, E); }
    __syncthreads();
    int lane = fresh_lane(); const int tid = F.wave * 64 + lane, wave = F.wave;
    const int gw = F.bid * NWAVES + F.wave, NGW = F.G * NWAVES;
    {   constexpr int O_CG = 0, O_PV = 17408, O_YL = 34816;
        const bf16_t* Cbuf = (const bf16_t*)(F.ws + WS_CB); const float* ECUM = (const float*)(F.ws + WS_ECUM); const bf16_t* ST = (const bf16_t*)(F.ws + WS_XBC); const bf16_t* YD = (const bf16_t*)(F.ws + WS_YD);
        const float* snw = INP(I_SSDNW) + l * 512;
        for (int c = F.bid; c < NCHK; c += F.G) {
            const size_t m0 = (size_t)64 * c;
            for (int g = 0; g < 2; ++g) {
                {   LAS bf16_t* Cg = (LAS bf16_t*)(F.lds + O_CG);
#pragma unroll
                    for (int i = 0; i < 2; ++i) { const int idx = tid + 512 * i, t = idx >> 4, c8 = idx & 15; *(LAS u32x4*)(Cg + t * 136 + c8 * 8) = *(const u32x4*)(Cbuf + (m0 + t) * 256 + g * 128 + c8 * 8); } }
                for (int hl = 0; hl < 4; ++hl) { const int h = 4 * g + hl;
                    {   LAS bf16_t* Pv = (LAS bf16_t*)(F.lds + O_PV);
#pragma unroll
                        for (int i = 0; i < 2; ++i) { const int idx = tid + 512 * i, pp = idx >> 4, c8 = idx & 15; const int f = hl * 8192 + pp * 128 + c8 * 8, row = f >> 9, col = ssd_win_col(g, f & 511);
                            *(LAS u32x4*)(Pv + pp * 136 + c8 * 8) = *(const u32x4*)(ST + (m0 + row) * 1024 + col); } }
                    __syncthreads();
                    {   LAS bf16_t* Cg = (LAS bf16_t*)(F.lds + O_CG); LAS bf16_t* Pv = (LAS bf16_t*)(F.lds + O_PV); LAS bf16_t* YL = (LAS bf16_t*)(F.lds + O_YL);
#pragma unroll
                        for (int i = 0; i < 2; ++i) { const int idx = 2 * wave + i, ti = idx >> 2, pi = idx & 3;
                            const f32x4 acc = mma_tile<128>(Cg + ti * 16 * 136, 136, Pv + pi * 16 * 136, 136, lane);
#pragma unroll
                            for (int r = 0; r < 4; ++r) { const int t = ti * 16 + 4 * (lane >> 4) + r, pp = pi * 16 + (lane & 15);
                                const float y = bf2f(YD[(m0 + t) * 512 + 64 * h + pp]) + acc[r] * ECUM[(size_t)(c * 8 + h) * 64 + t];
                                const float z = bf2f(GT[(m0 + t) * 1536 + 512 + 64 * h + pp]);
                                YL[t * 520 + 64 * h + pp] = (bf16_t)f2bf(y * siluf_(z)); } } }
                    __syncthreads();
                }
            }
            {   LAS bf16_t* YL = (LAS bf16_t*)(F.lds + O_YL);
#pragma unroll
                for (int rr = 0; rr < 8; ++rr) { const int t = 8 * wave + rr; const u32x4 w = *(const LAS u32x4*)(YL + t * 520 + 8 * lane);
                    const float v[8] = {bflo(w.x), bfhi(w.x), bflo(w.y), bfhi(w.y), bflo(w.z), bfhi(w.z), bflo(w.w), bfhi(w.w)};
                    float q = 0.f;
#pragma unroll
                    for (int j = 0; j < 8; ++j) q += v[j] * v[j];
                    const float rs = 1.f / sqrtf(wave_sum(q) * (1.f / 512.f) + EPS);
                    const f32x4 w0 = *(const f32x4*)(snw + 8 * lane), w1 = *(const f32x4*)(snw + 8 * lane + 4);
                    u32x4 o; o.x = pk2(v[0] * rs * w0[0], v[1] * rs * w0[1]); o.y = pk2(v[2] * rs * w0[2], v[3] * rs * w0[3]); o.z = pk2(v[4] * rs * w1[0], v[5] * rs * w1[1]); o.w = pk2(v[6] * rs * w1[2], v[7] * rs * w1[3]);
                    *(u32x4*)(GT + (m0 + t) * 1536 + 512 + 8 * lane) = o; } }
            __syncthreads();
        }
    }
    LAS float* SW = (LAS float*)(F.lds + F.wave * 16640);
    const bf16_t* Yt = (const bf16_t*)(F.ws + WS_K); const bf16_t* SF = (const bf16_t*)(F.ws + WS_R); const bf16_t* QEg = (const bf16_t*)(F.ws + WS_QE);
    const bf16_t* BON = (const bf16_t*)(F.ws + WS_V); const float* lw = INP(I_LNXW) + l * 512; const float* lb = INP(I_LNXB) + l * 512;
    for (int w = gw; w < NCHK * 8; w += NGW) {
        asm volatile("" : "+v"(lane));
        const int cg_ = w >> 3, h = w & 7, r32 = lane & 31, hi = lane >> 5; const size_t m0 = (size_t)64 * cg_;
        const bf16_t* QEw = QEg + (size_t)(cg_ * 8 + h) * 4096;
        bf16x8 qa[2][4];
#pragma unroll
        for (int tb = 0; tb < 2; ++tb)
#pragma unroll
            for (int s2 = 0; s2 < 4; ++s2) qa[tb][s2] = *(const bf16x8*)(QEw + (32 * tb + r32) * 64 + 16 * s2 + 8 * hi);
#pragma unroll
        for (int ih = 0; ih < 2; ++ih) { const size_t ro = (m0 + 32 * ih + r32) * 512 + h * 64;
            const bf16x8 bf[4] = {*(const bf16x8*)(SF + ro + 16 * hi), *(const bf16x8*)(SF + ro + 16 * hi + 8), *(const bf16x8*)(SF + ro + 32 + 16 * hi), *(const bf16x8*)(SF + ro + 32 + 16 * hi + 8)};
#pragma unroll
            for (int tb = 0; tb < 2; ++tb) { f32x16 y = ld16bf(Yt + ro + 32 * tb + 16 * hi);
#pragma unroll
                for (int s2 = 0; s2 < 4; ++s2) y = __builtin_amdgcn_mfma_f32_32x32x16_bf16(qa[tb][s2], bf[s2], y, 0, 0, 0);
#pragma unroll
                for (int r = 0; r < 16; ++r) SW[(32 * tb + crow(r, hi)) * 65 + 32 * ih + r32] = y[r]; } }
        LDS_WAIT();
        {   float y[64]; float sm = 0.f;
#pragma unroll
            for (int i = 0; i < 64; ++i) { y[i] = SW[lane * 65 + i]; sm += y[i]; }
            const float mean = sm * (1.f / 64.f); float q = 0.f;
#pragma unroll
            for (int i = 0; i < 64; ++i) { y[i] -= mean; q += y[i] * y[i]; }
            const float rs = 1.f / sqrtf(q * (1.f / 64.f) + GN_EPS);
#pragma unroll
            for (int i = 0; i < 64; ++i) SW[lane * 65 + i] = y[i] * rs; }
        LDS_WAIT();
#pragma unroll
        for (int it = 0; it < 8; ++it) { const int t = it * 8 + (lane >> 3), i0 = (lane & 7) * 8; const size_t row = m0 + t;
            const u32x4 bw = *(const u32x4*)(BON + row * 512 + h * 64 + i0); u32x4* gp = (u32x4*)(GT + row * 1536 + 1024 + h * 64 + i0); const u32x4 gv = *gp;
            const float bo[8] = {bflo(bw.x), bfhi(bw.x), bflo(bw.y), bfhi(bw.y), bflo(bw.z), bfhi(bw.z), bflo(bw.w), bfhi(bw.w)};
            const float gg[8] = {bflo(gv.x), bfhi(gv.x), bflo(gv.y), bfhi(gv.y), bflo(gv.z), bfhi(gv.z), bflo(gv.w), bfhi(gv.w)};
            float ov[8];
#pragma unroll
            for (int j = 0; j < 8; ++j) ov[j] = (SW[t * 65 + i0 + j] * lw[h * 64 + i0 + j] + lb[h * 64 + i0 + j] + bo[j]) * siluf_(gg[j]);
            u32x4 o; o.x = pk2(ov[0], ov[1]); o.y = pk2(ov[2], ov[3]); o.z = pk2(ov[4], ov[5]); o.w = pk2(ov[6], ov[7]); *gp = o; }
        LDS_WAIT();
    }
}
__device__ __forceinline__ void p7_final(const Ctx& F) {
    const int gw = F.bid * NWAVES + F.wave, NGW = F.G * NWAVES; const float* fw = INP(I_FNW);
    for (int m = gw; m < NT; m += NGW) {
        f32x4* xr = (f32x4*)(F.out + (size_t)m * DM) + F.lane; f32x4 v[4]; float s = 0.f;
#pragma unroll
        for (int j = 0; j < 4; ++j) { v[j] = xr[64 * j]; s += v[j].x * v[j].x + v[j].y * v[j].y + v[j].z * v[j].z + v[j].w * v[j].w; }
        const float rstd = 1.f / sqrtf(wave_sum(s) * (1.f / DM) + EPS);
#pragma unroll
        for (int j = 0; j < 4; ++j) xr[64 * j] = v[j] * rstd * *(const f32x4*)(fw + 4 * F.lane + 256 * j);
    }
}

#define LAYER(l) do { \
        const int pb = 1 + 8 * l; \
        if (IN(pb + 0)) { PHB(); if (l == 1) prep_weights(F, 1); p1_norm(F, l); SEAM(pb + 0); } \
        if (IN(pb + 1)) { PHB(); \
            pg8::Gemm g{(const bf16_t*)(F.ws + WS_XN), (const bf16_t*)(F.ws + WS_WIN), NT, NIN, DM, DM, DM}; pg8::StaticOrder S; S.init(NT, NIN, F.G, F.bid); \
            EpiIn E{F.ws, l}; \
            pg8::gemm_phase<EpiIn, pg8::StaticOrder, true, true>(F.lds, F.wave, g, S, E); \
            SEAM(pb + 1); \
        } \
        if (IN(pb + 2)) { PHB(); \
            pg8::Gemm g{(const bf16_t*)(F.ws + WS_QLAT), (const bf16_t*)(F.ws + WS_WQ), NT, 768, 256, 256, 256}; pg8::StaticOrder S; S.init(NT, 768, F.G, F.bid); \
            EpiQ E{F.ws, l}; \
            pg8::gemm_phase<EpiQ, pg8::StaticOrder, true, true>(F.lds, F.wave, g, S, E); \
            p3a_extras(F, l); \
            SEAM(pb + 2); \
        } \
        if (IN(pb + 3)) { PHB(); p3b_ssd(F, l); SEAM(pb + 3); } \
        if (IN(pb + 4)) { PHB(); p3c_rwkv(F, l); SEAM(pb + 4); } \
        if (IN(pb + 5)) { PHB(); p4_mix(F); SEAM(pb + 5); } \
        if (IN(pb + 6)) { PHB(); p5_assemble(F, l); SEAM(pb + 6); } \
        if (IN(pb + 7)) { PHB(); \
            pg8::Gemm g{(const bf16_t*)(F.ws + WS_GATES), (const bf16_t*)(F.ws + WS_WOUT), NT, DM, 1536, 1536, 1536}; pg8::StaticOrder S; S.init(NT, DM, F.G, F.bid); \
            EpiOut E{(l == 0) ? INP(I_X) : F.out, F.out, (const float*)(F.ws + WS_CTL + CTL_MOD) + (size_t)(l * 2) * 3072 + 2048}; \
            pg8::gemm_phase<EpiOut, pg8::StaticOrder, true, true>(F.lds, F.wave, g, S, E); \
            SEAM(pb + 7); \
        } \
    } while (0)
__global__ void __launch_bounds__(NTHR, 2) mk_fwd(Args args) {
    extern __shared__ __attribute__((aligned(16))) unsigned char lds_raw[];
    Ctx F; F.lds = (LAS unsigned char*)lds_raw; F.tid = threadIdx.x; F.lane = F.tid & 63; F.wave = __builtin_amdgcn_readfirstlane(F.tid >> 6);
    F.G = gridDim.x; F.bid = blockIdx.x; F.ws = args.ws; F.out = args.out; F.in = args.in;
    const int wave0 = F.wave;
    cg::grid_group grid = cg::this_grid();
#if MK_PER_PHASE
    const int lo = args.ph_lo, hi = args.ph_hi;
#else
    constexpr int lo = 0, hi = 18;
#endif
#ifndef MK_ONLY
#define MK_ONLY -1
#endif
#define IN(k) (lo <= (k) && (k) < hi && (MK_ONLY < 0 || MK_ONLY == ((k) == 0 ? 0 : (k) == 17 ? 17 : 1 + ((k) - 1) % 8)))
#define SEAM(k) do { if (IN((k) + 1)) grid.sync(); } while (0)
#define PHB() do { int b_ = blockIdx.x, g_ = gridDim.x, v_ = wave0; asm volatile("" : "+s"(b_), "+s"(g_), "+s"(v_)); F.bid = b_; F.G = g_; F.wave = v_; int t_ = v_ * 64 + (int)__builtin_amdgcn_mbcnt_hi(~0u, __builtin_amdgcn_mbcnt_lo(~0u, 0u)); asm volatile("; PHASE_MARK %0" : "+v"(t_)); F.tid = t_; F.lane = t_ & 63; GAS unsigned char* w_ = (GAS unsigned char*)args.ws; GAS float* o_ = (GAS float*)args.out; asm volatile("" : "+s"(w_), "+s"(o_)); F.ws = (unsigned char*)w_; F.out = (float*)o_; } while (0)
    if (IN(0)) { PHB(); p0_prologue(F); SEAM(0); }
    LAYER(0);
    LAYER(1);
    if (IN(17)) { PHB(); p7_final(F); }
#ifndef MK_RERUN
#define MK_RERUN 0
#endif
#define PHB2() do { int b_ = blockIdx.x, g_ = gridDim.x, v_ = wave0; asm volatile("" : "+s"(b_), "+s"(g_), "+s"(v_)); F.bid = b_; F.G = g_; F.wave = v_; int t_ = v_ * 64 + fresh_lane(); F.tid = t_; F.lane = t_ & 63; } while (0)
#if MK_RERUN
    { constexpr int l = 1;
    if (MK_RERUN & 1) { grid.sync(); PHB2(); p1_norm(F, l); }
    if (MK_RERUN & 2) { grid.sync(); PHB2(); pg8::Gemm g{(const bf16_t*)(F.ws + WS_XN), (const bf16_t*)(F.ws + WS_WIN), NT, NIN, DM, DM, DM}; pg8::StaticOrder S; S.init(NT, NIN, F.G, F.bid); EpiIn E{F.ws, l}; pg8::gemm_phase<EpiIn, pg8::StaticOrder, true, true>(F.lds, F.wave, g, S, E); }
    if (MK_RERUN & 4) { grid.sync(); PHB2(); pg8::Gemm g{(const bf16_t*)(F.ws + WS_QLAT), (const bf16_t*)(F.ws + WS_WQ), NT, 768, 256, 256, 256}; pg8::StaticOrder S; S.init(NT, 768, F.G, F.bid); EpiQ E{F.ws, l}; pg8::gemm_phase<EpiQ, pg8::StaticOrder, true, true>(F.lds, F.wave, g, S, E); p3a_extras(F, l); }
    if (MK_RERUN & 8) { grid.sync(); PHB2(); p3b_ssd(F, l); }
    if (MK_RERUN & 16) { grid.sync(); PHB2(); p3c_rwkv(F, l); }
    if (MK_RERUN & 32) { grid.sync(); PHB2(); p4_mix(F); }
    if (MK_RERUN & 512) { grid.sync(); PHB2(); p4_mix(F, 1); }
    if (MK_RERUN & 1024) { grid.sync(); PHB2(); p4_mix(F, 2); }
    if (MK_RERUN & 64) { grid.sync(); PHB2(); p5_assemble(F, l); }
    if (MK_RERUN & 128) { grid.sync(); PHB2(); pg8::Gemm g{(const bf16_t*)(F.ws + WS_GATES), (const bf16_t*)(F.ws + WS_WOUT), NT, DM, 1536, 1536, 1536}; pg8::StaticOrder S; S.init(NT, DM, F.G, F.bid);
        EpiOut E{INP(I_X), (float*)(F.ws + WS_XBC), (const float*)(F.ws + WS_CTL + CTL_MOD) + (size_t)(l * 2) * 3072 + 2048}; pg8::gemm_phase<EpiOut, pg8::StaticOrder, true, true>(F.lds, F.wave, g, S, E); }
    }
#endif
#undef IN
#undef SEAM
}
constexpr int N_PHASES = 18;

extern "C" void kernel_launch(void* const* d_in, const int* in_sizes, int n_in, void* d_out, int out_size, void* d_ws, size_t ws_size, hipStream_t stream) {
    static int grid = 0;
    if (grid == 0) {
        if (n_in != 31 || out_size != NT * DM || ws_size < WS_END) { fprintf(stderr, "kernel_launch: unexpected shapes (n_in %d, out %d, ws %zu)\n", n_in, out_size, ws_size); grid = -1; return; }
        int dev = 0, cus = 0, per_cu = 0;
        hipGetDevice(&dev); hipDeviceGetAttribute(&cus, hipDeviceAttributeMultiprocessorCount, dev);
        if (hipFuncSetAttribute((const void*)mk_fwd, hipFuncAttributeMaxDynamicSharedMemorySize, LDS_BYTES) != hipSuccess) { fprintf(stderr, "kernel_launch: hipFuncSetAttribute failed\n"); grid = -1; return; }
        hipOccupancyMaxActiveBlocksPerMultiprocessor(&per_cu, (const void*)mk_fwd, NTHR, LDS_BYTES);
        (void)hipGetLastError();
        if (per_cu < 1) per_cu = 1;
        grid = cus;
        fprintf(stderr, "kernel_launch: cus %d, occupancy query %d block(s)/CU, grid %d\n", cus, per_cu, grid);
    }
    if (grid < 0) return;
    hipMemsetAsync((char*)d_ws + WS_CTL, 0, CTL_BYTES, stream);
    Args a{};
    for (int i = 0; i < 31; ++i) a.in[i] = (const float*)d_in[i];
    a.out = (float*)d_out; a.ws = (unsigned char*)d_ws;
#if MK_PER_PHASE
    for (int p = 0; p < N_PHASES; ++p) { a.ph_lo = p; a.ph_hi = p + 1; hipLaunchKernelGGL(mk_fwd, dim3(grid), dim3(NTHR), LDS_BYTES, stream, a); }
#else
    a.ph_lo = 0; a.ph_hi = N_PHASES;
    void* params[] = {&a};
    hipError_t e = hipLaunchCooperativeKernel((const void*)mk_fwd, dim3(grid), dim3(NTHR), params, LDS_BYTES, stream);
    if (e != hipSuccess) fprintf(stderr, "kernel_launch: cooperative launch failed: %s\n", hipGetErrorString(e));
#endif
}
```

```cpp
#include <hip/hip_runtime.h>
#include <hip/hip_cooperative_groups.h>
#include <cstdio>
#include <cstdint>
namespace cg = cooperative_groups;

#define LAS __attribute__((address_space(3)))
#define GAS __attribute__((address_space(1)))
typedef unsigned short bf16_t;
typedef short bf16x8 __attribute__((ext_vector_type(8)));
typedef float f32x4 __attribute__((ext_vector_type(4)));
typedef float f32x2 __attribute__((ext_vector_type(2)));
typedef float f32x16 __attribute__((ext_vector_type(16)));
typedef unsigned u32x4 __attribute__((ext_vector_type(4)));
typedef unsigned u32x2 __attribute__((ext_vector_type(2)));
typedef short v4i16_t __attribute__((ext_vector_type(4)));

#ifndef MK_PER_PHASE
#define MK_PER_PHASE 0
#endif

namespace pg8 {
constexpr int BM = 256, BK = 64, HALF = 128, HTB = HALF * BK * 2, STAGE_BYTES = 8 * HTB, NXCD = 8, WGM = 8;
__host__ __device__ __forceinline__ int lds_byte(int r, int c) { const int st = (r >> 4) * 2 + (c >> 5), rr = r & 15, cc = c & 31, ob = rr * 64 + cc * 2; return st * 1024 + (ob ^ (((ob >> 9) & 1) << 5)); }
__host__ __device__ __forceinline__ void stage_rc(int b, int& R, int& C) { const int st = b / 1024, sb = b % 1024, swz = sb ^ (((sb >> 9) & 1) << 5); R = (st >> 1) * 16 + swz / 64; C = (st & 1) * 32 + (swz % 64) / 2; }
__host__ __device__ __forceinline__ int perm32(int rho) { const int n = rho >> 4, i = rho & 15; return 8 * (i >> 2) + 4 * n + (i & 3); }
struct Unit { int pm, pn; };
struct Gemm { const bf16_t* A; const bf16_t* Bt; int M, N, K, lda, ldb; };
struct StaticOrder {
    int nM, nN, nwg, G, c;
    __host__ __device__ void init(int M, int N, int G_, int c_) { nM = M / BM; nN = N / BM; nwg = nM * nN; G = G_; c = c_; }
    __host__ __device__ bool next(int i, Unit& u) const {
        const long L = (long)i * G + c; if (L >= nwg) return false;
        int wgid = (int)L; { const int q = nwg / NXCD, r = nwg % NXCD, xcd = wgid % NXCD, off = wgid / NXCD; wgid = (xcd < r ? xcd * (q + 1) : r * (q + 1) + (xcd - r) * q) + off; }
        const int nig = WGM * nN, gid = wgid / nig, fm = gid * WGM, gsz = (nM - fm) < WGM ? (nM - fm) : WGM;
        u.pm = fm + ((wgid % nig) % gsz); u.pn = (wgid % nig) / gsz; return true;
    }
};
template <class Epi, class Sched, bool ALIGN_EPI, bool SP2>
__device__ __forceinline__ void gemm_phase(LAS unsigned char* lds, int wave_id, const Gemm g, const Sched& S, const Epi& E) {
    int lane = (int)__builtin_amdgcn_mbcnt_hi(~0u, __builtin_amdgcn_mbcnt_lo(~0u, 0u)); asm volatile("" : "+v"(lane));
    const int wid = wave_id, tid = wid * 64 + lane, wr = wid >> 2, wc = wid & 3, fr = lane & 15, fq = lane >> 4;
    const int K = g.K, nt = K / BK;
    unsigned voffA[2], voffB[2];
#pragma unroll
    for (int i = 0; i < 2; ++i) { int R, C; stage_rc(tid * 16 + i * 8192, R, C); const int Rb = (R & ~31) + perm32(R & 31);
        voffA[i] = (unsigned)(R * g.lda + C) * 2u; voffB[i] = (unsigned)(Rb * g.ldb + C) * 2u; }
    const size_t kstep = (size_t)(BK * 2);
    const size_t hstepA = (size_t)HALF * g.lda * 2, hstepB = (size_t)HALF * g.ldb * 2;
    const size_t tstepA = 2 * hstepA, tstepB = 2 * hstepB;
    const unsigned ldsw = (unsigned)wid * 1024u, lds0 = (unsigned)(uintptr_t)lds;
    const int aoff = lds_byte(wr * 64 + fr, fq * 8), boff = lds_byte(wc * 32 + fr, fq * 8);
#define PG8_SA(b, h) (((b) * 2 + (h)) * HTB)
#define PG8_SB(b, h) ((4 + (b) * 2 + (h)) * HTB)
#define PG8_STAGE(bufoff, gbase, voff) do { _Pragma("unroll") for (int _i = 0; _i < 2; ++_i) { unsigned keep_; \
        asm volatile("s_mov_b32 %0, m0\n\ts_mov_b32 m0, %3\n\ts_nop 0\n\tglobal_load_lds_dwordx4 %1, %2\n\ts_mov_b32 m0, %0" : "=&s"(keep_) : "v"((voff)[_i]), "s"((const char*)(gbase)), "s"(lds0 + (unsigned)(bufoff) + ldsw + (unsigned)(_i * 8192)) : "memory"); } } while (0)
#define PG8_LDA(dst, b, h) do { _Pragma("unroll") for (int m = 0; m < 4; ++m) _Pragma("unroll") for (int k = 0; k < 2; ++k) dst[m][k] = *(const LAS bf16x8*)(lds + PG8_SA(b, h) + aoff + m * 2048 + k * 1024); } while (0)
#define PG8_LDB(dst, b, h) do { _Pragma("unroll") for (int n = 0; n < 2; ++n) _Pragma("unroll") for (int k = 0; k < 2; ++k) dst[n][k] = *(const LAS bf16x8*)(lds + PG8_SB(b, h) + boff + n * 2048 + k * 1024); } while (0)
#define PG8_MMA(ai, bj, At, Bt) do { __builtin_amdgcn_s_setprio(1); _Pragma("unroll") for (int m = 0; m < 4; ++m) _Pragma("unroll") for (int n = 0; n < 2; ++n) _Pragma("unroll") for (int k = 0; k < 2; ++k) \
        acc[ai][bj][m][n] = __builtin_amdgcn_mfma_f32_16x16x32_bf16(Bt[n][k], At[m][k], acc[ai][bj][m][n], 0, 0, 0); __builtin_amdgcn_s_setprio(0); } while (0)
#define PG8_WAIT_V(n) asm volatile("s_waitcnt vmcnt(" #n ")" ::: "memory")
#define PG8_WAIT_L(n) asm volatile("s_waitcnt lgkmcnt(" #n ")" ::: "memory")
#define PG8_BAR __builtin_amdgcn_s_barrier()
#define PG8_SCHED __builtin_amdgcn_sched_barrier(0)
    Unit cur, nxt; int ui = 0;
    if (!S.next(0, cur)) return;
    f32x4 acc[2][2][4][2];
#pragma unroll
    for (int a = 0; a < 2; ++a)
#pragma unroll
        for (int b = 0; b < 2; ++b)
#pragma unroll
            for (int m = 0; m < 4; ++m)
#pragma unroll
                for (int n = 0; n < 2; ++n) acc[a][b][m][n] = (f32x4){0.f, 0.f, 0.f, 0.f};
    bf16x8 At[4][2], B0[2][2], B1[2][2];
    const char* cA = (const char*)g.A + (size_t)cur.pm * tstepA; const char* cB = (const char*)g.Bt + (size_t)cur.pn * tstepB;
    if constexpr (SP2) {
        PG8_STAGE(PG8_SB(0, 0), cB, voffB); PG8_STAGE(PG8_SB(0, 1), cB + hstepB, voffB); PG8_STAGE(PG8_SA(0, 0), cA, voffA); PG8_STAGE(PG8_SA(0, 1), cA + hstepA, voffA);
        if (wr == 1) PG8_BAR;
        PG8_WAIT_V(2); PG8_BAR;
        PG8_STAGE(PG8_SB(1, 0), cB + kstep, voffB); PG8_STAGE(PG8_SA(1, 0), cA + kstep, voffA); PG8_STAGE(PG8_SB(1, 1), cB + hstepB + kstep, voffB);
        PG8_WAIT_V(6); PG8_BAR;
    } else {
        PG8_STAGE(PG8_SB(0, 0), cB, voffB); PG8_STAGE(PG8_SA(0, 0), cA, voffA); PG8_STAGE(PG8_SB(0, 1), cB + hstepB, voffB); PG8_STAGE(PG8_SA(0, 1), cA + hstepA, voffA);
        if (wr == 1) PG8_BAR;
        PG8_WAIT_V(4); PG8_BAR;
        PG8_STAGE(PG8_SB(1, 0), cB + kstep, voffB); PG8_STAGE(PG8_SA(1, 0), cA + kstep, voffA); PG8_STAGE(PG8_SB(1, 1), cB + hstepB + kstep, voffB);
        PG8_WAIT_V(6); PG8_BAR;
    }
    for (;;) {
        const bool has_next = S.next(ui + 1, nxt);
        const char* nA = has_next ? (const char*)g.A + (size_t)nxt.pm * tstepA : cA; const char* nB = has_next ? (const char*)g.Bt + (size_t)nxt.pn * tstepB : cB;
        for (int t = 0; t < nt; t += 2) {
            const bool last = (t == nt - 2);
            const char* a1 = cA + (size_t)(t + 1) * kstep;
            const char* a2 = last ? nA : cA + (size_t)(t + 2) * kstep; const char* b2 = last ? nB : cB + (size_t)(t + 2) * kstep;
            const char* a3 = a2 + kstep; const char* b3 = b2 + kstep;
            if constexpr (SP2) {
            PG8_LDB(B0, 0, 0); PG8_LDB(B1, 0, 1); PG8_SCHED; PG8_LDA(At, 0, 0); PG8_STAGE(PG8_SA(1, 1), a1 + hstepA, voffA);
            PG8_WAIT_V(8); PG8_WAIT_L(0); PG8_BAR; PG8_MMA(0, 0, At, B0); PG8_MMA(0, 1, At, B1); PG8_BAR; PG8_SCHED;
            PG8_LDA(At, 0, 1); PG8_STAGE(PG8_SB(0, 0), b2, voffB); PG8_STAGE(PG8_SB(0, 1), b2 + hstepB, voffB); PG8_STAGE(PG8_SA(0, 0), a2, voffA);
            PG8_WAIT_V(8); PG8_WAIT_L(0); PG8_BAR; PG8_MMA(1, 0, At, B0); PG8_MMA(1, 1, At, B1); PG8_BAR; PG8_SCHED;
            PG8_LDB(B0, 1, 0); PG8_LDB(B1, 1, 1); PG8_SCHED; PG8_LDA(At, 1, 0); PG8_STAGE(PG8_SA(0, 1), a2 + hstepA, voffA);
            PG8_WAIT_V(8); PG8_WAIT_L(0); PG8_BAR; PG8_MMA(0, 0, At, B0); PG8_MMA(0, 1, At, B1); PG8_BAR; PG8_SCHED;
            PG8_LDA(At, 1, 1); PG8_STAGE(PG8_SB(1, 0), b3, voffB); PG8_STAGE(PG8_SB(1, 1), b3 + hstepB, voffB); PG8_STAGE(PG8_SA(1, 0), a3, voffA);
            PG8_WAIT_V(8); PG8_WAIT_L(0); PG8_BAR; PG8_MMA(1, 0, At, B0); PG8_MMA(1, 1, At, B1); PG8_BAR; PG8_SCHED;
            } else {
            PG8_LDB(B0, 0, 0); PG8_SCHED; PG8_LDA(At, 0, 0); PG8_STAGE(PG8_SA(1, 1), a1 + hstepA, voffA);
            PG8_WAIT_L(8); PG8_BAR; PG8_WAIT_L(0); PG8_MMA(0, 0, At, B0); PG8_BAR; PG8_SCHED;
            PG8_LDB(B1, 0, 1); PG8_STAGE(PG8_SB(0, 0), b2, voffB);
            PG8_BAR; PG8_WAIT_L(0); PG8_MMA(0, 1, At, B1); PG8_BAR;
            PG8_LDA(At, 0, 1); PG8_STAGE(PG8_SA(0, 0), a2, voffA);
            PG8_BAR; PG8_WAIT_L(0); PG8_MMA(1, 0, At, B0); PG8_BAR; PG8_SCHED;
            PG8_STAGE(PG8_SB(0, 1), b2 + hstepB, voffB);
            PG8_WAIT_V(6); PG8_BAR; PG8_MMA(1, 1, At, B1); PG8_BAR;
            PG8_LDB(B0, 1, 0); PG8_SCHED; PG8_LDA(At, 1, 0); PG8_STAGE(PG8_SA(0, 1), a2 + hstepA, voffA);
            PG8_WAIT_L(8); PG8_BAR; PG8_WAIT_L(0); PG8_MMA(0, 0, At, B0); PG8_BAR; PG8_SCHED;
            PG8_LDB(B1, 1, 1); PG8_STAGE(PG8_SB(1, 0), b3, voffB);
            PG8_BAR; PG8_WAIT_L(0); PG8_MMA(0, 1, At, B1); PG8_BAR;
            PG8_LDA(At, 1, 1); PG8_STAGE(PG8_SA(1, 0), a3, voffA);
            PG8_BAR; PG8_WAIT_L(0); PG8_MMA(1, 0, At, B0); PG8_BAR; PG8_SCHED;
            PG8_STAGE(PG8_SB(1, 1), b3 + hstepB, voffB);
            PG8_WAIT_V(6); PG8_BAR; PG8_MMA(1, 1, At, B1); PG8_BAR;
            }
        }
        if constexpr (ALIGN_EPI) { if (wr == 0) PG8_BAR; }
        E(acc, cur, wr, wc, fr, fq);
        if (!has_next) break;
#pragma unroll
        for (int a = 0; a < 2; ++a)
#pragma unroll
            for (int b = 0; b < 2; ++b)
#pragma unroll
                for (int m = 0; m < 4; ++m)
#pragma unroll
                    for (int n = 0; n < 2; ++n) acc[a][b][m][n] = (f32x4){0.f, 0.f, 0.f, 0.f};
        cur = nxt; cA = nA; cB = nB; ++ui;
        if constexpr (ALIGN_EPI) { if (wr == 1) PG8_BAR; }
    }
    PG8_WAIT_V(0);
    if constexpr (!ALIGN_EPI) { if (wr == 0) PG8_BAR; }
    PG8_BAR;
#undef PG8_SA
#undef PG8_SB
#undef PG8_STAGE
#undef PG8_LDA
#undef PG8_LDB
#undef PG8_MMA
#undef PG8_WAIT_V
#undef PG8_WAIT_L
#undef PG8_BAR
#undef PG8_SCHED
}
}

constexpr int NT = 16384, SEQ = 8192, DM = 1024, DIN = 4680, NIN = 4864, NCHK = 256, NWAVES = 8, NTHR = 512;
constexpr float EPS = 1e-6f, GN_EPS = 64e-5f, DECAY_SCALE = 0.606531f;
constexpr float QSCALE = 0.07216878364870322f * 1.4426950408889634f;
constexpr size_t MiB = 1u << 20;
constexpr size_t WS_CTL = 0, CTL_BYTES = 1 * MiB;
constexpr size_t CTL_MOD = 65536;
constexpr size_t CTL_SSQ = 131072;
constexpr size_t WS_WIN = 1 * MiB;
constexpr size_t WS_CB = WS_WIN, WS_ECUM = WS_WIN + 8 * MiB, WS_CDEC = WS_ECUM + 512 * 1024;
constexpr size_t WS_WQ = 10 * MiB + 512 * 1024;
constexpr size_t WS_WUV = 11 * MiB;
constexpr size_t WS_WLW = 11 * MiB + 512 * 1024;
constexpr size_t WS_WLA = WS_WLW + 65536;
constexpr size_t WS_WOUT = 12 * MiB;
constexpr size_t WS_XN = 15 * MiB;
constexpr size_t WS_TT = WS_XN, WS_QE = WS_XN + 16 * MiB;
constexpr size_t WS_QLAT = 47 * MiB, WS_KVL = 55 * MiB;
constexpr size_t WS_OL = WS_QLAT;
constexpr size_t WS_GATES = 63 * MiB;
constexpr size_t WS_XBC = 111 * MiB;
constexpr size_t WS_R = 143 * MiB, WS_K = 159 * MiB, WS_V = 175 * MiB;
constexpr size_t WS_F = 191 * MiB;
constexpr size_t WS_Q = 200 * MiB;
constexpr size_t WS_KVB = 224 * MiB;
constexpr size_t WS_YD = 230 * MiB;
constexpr size_t WS_ROPE = 246 * MiB;
constexpr size_t WS_HX = 250 * MiB;
constexpr size_t WS_HRKV = WS_HX + 1536 * 1024;
constexpr size_t WS_HF = WS_HRKV + 768 * 1024;
constexpr size_t WS_END = 253 * MiB;
constexpr int LDS_BYTES = 152 * 1024;

#define LDS_WAIT() asm volatile("s_waitcnt lgkmcnt(0)" ::: "memory")
__device__ __forceinline__ unsigned f2bf(float f) { unsigned u = __builtin_bit_cast(unsigned, f); return (u + 0x7fffu + ((u >> 16) & 1u)) >> 16; }
__device__ __forceinline__ unsigned pk2(float lo, float hi) { return f2bf(lo) | (f2bf(hi) << 16); }
__device__ __forceinline__ float bf2f(unsigned short b) { return __builtin_bit_cast(float, (unsigned)b << 16); }
__device__ __forceinline__ float bflo(unsigned w) { return __builtin_bit_cast(float, w << 16); }
__device__ __forceinline__ float bfhi(unsigned w) { return __builtin_bit_cast(float, w & 0xffff0000u); }
__device__ __forceinline__ float wave_sum(float v) {
#pragma unroll
    for (int o = 1; o < 64; o <<= 1) v += __shfl_xor(v, o);
    return v;
}
__device__ __forceinline__ float sigmoidf_(float x) { return 1.f / (1.f + __expf(-x)); }
__device__ __forceinline__ float siluf_(float x) { return x / (1.f + __expf(-x)); }
__device__ __forceinline__ int pi16(int n) { const int x = n & 15; return (n & ~15) | ((x >= 4 && x < 8) ? x + 4 : (x >= 8 && x < 12) ? x - 4 : x); }
__device__ __forceinline__ int sg32(int x) { return (x & ~31) | (16 * ((x >> 2) & 1) + 4 * ((x & 31) >> 3) + (x & 3)); }
__device__ __forceinline__ int crow(int r, int hi) { return (r & 3) + 8 * (r >> 2) + 4 * hi; }

template <int K> __device__ __forceinline__ f32x4 mma_tile(const LAS bf16_t* A, int lda, const LAS bf16_t* Bt, int ldb, int lane) {
    f32x4 acc = {0.f, 0.f, 0.f, 0.f};
    const LAS bf16_t* ap = A + (lane & 15) * lda + (lane >> 4) * 8;
    const LAS bf16_t* bp = Bt + (lane & 15) * ldb + (lane >> 4) * 8;
#pragma unroll
    for (int k = 0; k < K; k += 32) {
        const bf16x8 a = *(const LAS bf16x8*)(ap + k), b = *(const LAS bf16x8*)(bp + k);
        acc = __builtin_amdgcn_mfma_f32_16x16x32_bf16(a, b, acc, 0, 0, 0);
    }
    return acc;
}

struct Args {
    const float* in[31]; float* out; unsigned char* ws; int ph_lo, ph_hi;
};
struct Ctx {
    LAS unsigned char* lds; int tid, lane, wave, G, bid;
    unsigned char* ws; float* out;
    const float* const* in;
};
__device__ __forceinline__ const float* ldin(const float* const* in, int i) { asm volatile("" : "+s"(i)); return (const float*)(const GAS float*)in[i]; }
#define INP(i) ldin(F.in, i)
__device__ __forceinline__ int fresh_lane() { int l_ = (int)__builtin_amdgcn_mbcnt_hi(~0u, __builtin_amdgcn_mbcnt_lo(~0u, 0u)); asm volatile("" : "+v"(l_)); return l_; }
enum { I_X = 0, I_C, I_POS, I_ADAW, I_ADAB, I_NORMW, I_WIN, I_QNW, I_WUQ, I_KVNW, I_WUKV, I_CONVW, I_CONVB, I_DTB, I_ALOG, I_DSKIP, I_SSDNW,
       I_MURKV, I_MUW, I_MUA, I_W0, I_WLB, I_A0, I_ALB, I_KK, I_KA, I_RK, I_LNXW, I_LNXB, I_WOUT, I_FNW };

__device__ __forceinline__ int win_src_col(int n) {
    if (n < 448) return n;
    if (n < 512) return -1;
    if (n < 1024) return 448 + (n - 512);
    if (n < 1536) return 960 + (n - 1024);
    if (n < 2560) return 1472 + (n - 1536);
    if (n < 3072) return 2504 + (n - 2560);
    if (n < 3584) return 3016 + (n - 3072);
    if (n < 4096) return 3528 + (n - 3584);
    if (n < 4608) return 4168 + (n - 4096);
    if (n < 4672) return 4040 + (n - 4608);
    if (n < 4736) return 4104 + (n - 4672);
    if (n < 4744) return 2496 + (n - 4736);
    return -1;
}
template <class Src> __device__ __forceinline__ void transpose_item(const Src& src, bf16_t* WT, int ldw, LAS float* scr, int kb, int nb, int lane) {
    const int k0 = 64 * kb, n0 = 32 * nb;
#pragma unroll 8
    for (int i = 0; i < 32; ++i) { const int kk = 2 * i + (lane >> 5); scr[kk * 33 + (lane & 31)] = src(k0 + kk, n0 + (lane & 31)); }
    LDS_WAIT();
    const int c = lane & 7;
#pragma unroll
    for (int j = 0; j < 4; ++j) { const int n = (lane >> 3) + 8 * j; const LAS float* s = scr + (8 * c) * 33 + n;
        u32x4 o; o.x = pk2(s[0 * 33], s[1 * 33]); o.y = pk2(s[2 * 33], s[3 * 33]); o.z = pk2(s[4 * 33], s[5 * 33]); o.w = pk2(s[6 * 33], s[7 * 33]);
        *(u32x4*)(WT + (size_t)(n0 + n) * ldw + k0 + 8 * c) = o; }
    LDS_WAIT();
}
__device__ __forceinline__ void prep_weights(const Ctx& F, int l) {
    LAS float* scr = (LAS float*)(F.lds + F.wave * 8448);
    const int gw = F.bid * NWAVES + F.wave, NGW = F.G * NWAVES;
    const float* w_in = INP(I_WIN) + (size_t)l * DM * DIN;
    const float* w_out = INP(I_WOUT) + (size_t)l * 1536 * 1024;
    const float* wlb = INP(I_WLB) + (size_t)l * 64 * 512;
    const float* alb = INP(I_ALB) + (size_t)l * 64 * 512;
    bf16_t* WIN = (bf16_t*)(F.ws + WS_WIN); bf16_t* WOUT = (bf16_t*)(F.ws + WS_WOUT); bf16_t* WLW = (bf16_t*)(F.ws + WS_WLW); bf16_t* WLA = (bf16_t*)(F.ws + WS_WLA);
    constexpr int I_IN = 16 * (NIN / 32), I_OUT = 24 * 32, I_LW = 16, I_LA = 16, NITEMS = I_IN + I_OUT + I_LW + I_LA;
    for (int it = gw; it < NITEMS; it += NGW) {
        int r = it;
        if (r < I_IN) { const int kb = r / (NIN / 32), nb = r % (NIN / 32);
            transpose_item([&](int k, int n) { const int sc = win_src_col(n); return sc >= 0 ? w_in[(size_t)k * DIN + sc] : 0.f; }, WIN, 1024, scr, kb, nb, F.lane); continue; }
        r -= I_IN;
        if (r < I_OUT) { const int kb = r / 32, nb = r % 32;
            transpose_item([&](int k, int n) { return w_out[(size_t)k * 1024 + n]; }, WOUT, 1536, scr, kb, nb, F.lane); continue; }
        r -= I_OUT;
        if (r < I_LW) { transpose_item([&](int k, int n) { return wlb[k * 512 + n]; }, WLW, 64, scr, 0, r, F.lane); continue; }
        r -= I_LW;
        transpose_item([&](int k, int n) { return alb[k * 512 + n]; }, WLA, 64, scr, 0, r, F.lane);
    }
    const float* wuq = INP(I_WUQ) + (size_t)l * 256 * 768; const float* wukv = INP(I_WUKV) + (size_t)l * 128 * 1024; const float* qnw = INP(I_QNW) + l * 256;
    bf16_t* WQ = (bf16_t*)(F.ws + WS_WQ); bf16_t* WUV = (bf16_t*)(F.ws + WS_WUV);
    const int gt = F.bid * NTHR + F.tid, NGT = F.G * NTHR;
    for (int e = gt; e < 768 * 256; e += NGT) {
        const int n = e >> 8, k = e & 255, h = n / 192, idx = n % 192; float v;
        if (idx < 128) {
            const f32x4* a = (const f32x4*)(wuq + (size_t)k * 768 + h * 192); const f32x4* b = (const f32x4*)(wukv + (size_t)idx * 1024 + h * 256);
            float s = 0.f;
#pragma unroll 8
            for (int d = 0; d < 32; ++d) { const f32x4 x = a[d], y = b[d]; s += x.x * y.x + x.y * y.y + x.z * y.z + x.w * y.w; }
            v = s;
        } else v = wuq[(size_t)k * 768 + n];
        WQ[e] = (bf16_t)f2bf(v * qnw[k]);
    }
    for (int e = gt; e < 512 * 512; e += NGT) {
        const int n = e >> 9, k = e & 511, h = n >> 7, d = n & 127, h2 = k >> 7, c = k & 127;
        WUV[e] = (h == h2) ? (bf16_t)f2bf(wukv[(size_t)c * 1024 + h * 256 + 128 + d]) : (bf16_t)0;
    }
}
__device__ __forceinline__ void p0_prologue(const Ctx& F) {
    prep_weights(F, 0);
    const int gw = F.bid * NWAVES + F.wave, NGW = F.G * NWAVES;
    float* MOD = (float*)(F.ws + WS_CTL + CTL_MOD);
    for (int it = gw; it < 2 * 12 * 32; it += NGW) {
        const int l = it / 384, r = it % 384, cb = r / 32, ks = r % 32;
        const float* aw = INP(I_ADAW) + (size_t)l * DM * 3072 + (size_t)(ks * 32) * 3072 + cb * 256 + F.lane * 4;
        const float* cc = INP(I_C);
        f32x4 a0 = {0.f, 0.f, 0.f, 0.f}, a1 = a0;
#pragma unroll 8
        for (int k = 0; k < 32; ++k) { const f32x4 w = *(const f32x4*)(aw + (size_t)k * 3072); const float s0 = siluf_(cc[ks * 32 + k]), s1 = siluf_(cc[DM + ks * 32 + k]); a0 += w * s0; a1 += w * s1; }
        if (ks == 0) { const f32x4 bb = *(const f32x4*)(INP(I_ADAB) + l * 3072 + cb * 256 + F.lane * 4); a0 += bb; a1 += bb; }
        float* m0 = MOD + (size_t)(l * 2 + 0) * 3072 + cb * 256 + F.lane * 4; float* m1 = m0 + 3072;
#pragma unroll
        for (int j = 0; j < 4; ++j) { atomicAdd(m0 + j, a0[j]); atomicAdd(m1 + j, a1[j]); }
    }
    float* ROPE = (float*)(F.ws + WS_ROPE); const int* pos = (const int*)INP(I_POS);
    for (int e = F.bid * NTHR + F.tid; e < NT * 32; e += F.G * NTHR) {
        const int m = e >> 5, i = e & 31;
        const float invf = powf(10000.f, -(float)i / 32.f); const float ang = (float)pos[m] * invf;
        const double a = (double)ang; const double kq = __builtin_rint(a * 0.15915494309189535); const float rr = (float)(a - kq * 6.283185307179586);
        ROPE[(size_t)m * 64 + i] = cosf(rr); ROPE[(size_t)m * 64 + 32 + i] = sinf(rr);
    }
}
__device__ __forceinline__ void p1_norm(const Ctx& F, int l) {
    const float* xin = (l == 0) ? INP(I_X) : F.out;
    const float* nw = INP(I_NORMW) + l * DM; const float* MOD = (const float*)(F.ws + WS_CTL + CTL_MOD);
    bf16_t* XN = (bf16_t*)(F.ws + WS_XN);
    const int gw = F.bid * NWAVES + F.wave, NGW = F.G * NWAVES;
    for (int m = gw; m < NT; m += NGW) {
        const int b = m >> 13; const float* md = MOD + (size_t)(l * 2 + b) * 3072;
        const f32x4* xr = (const f32x4*)(xin + (size_t)m * DM) + F.lane;
        f32x4 v[4]; float s = 0.f;
#pragma unroll
        for (int j = 0; j < 4; ++j) { v[j] = xr[64 * j]; s += v[j].x * v[j].x + v[j].y * v[j].y + v[j].z * v[j].z + v[j].w * v[j].w; }
        const float rstd = 1.f / sqrtf(wave_sum(s) * (1.f / DM) + EPS);
        unsigned long long* o8 = (unsigned long long*)(XN + (size_t)m * DM) + F.lane;
#pragma unroll
        for (int j = 0; j < 4; ++j) { const int c0 = 4 * F.lane + 256 * j;
            const f32x4 w = *(const f32x4*)(nw + c0), sh = *(const f32x4*)(md + c0), sc = *(const f32x4*)(md + 1024 + c0);
            const f32x4 y = v[j] * rstd * w * (sc + 1.f) + sh;
            o8[64 * j] = (unsigned long long)pk2(y.x, y.y) | ((unsigned long long)pk2(y.z, y.w) << 32); }
    }
}
__device__ __forceinline__ u32x4 pack8(f32x4 a, f32x4 b) { u32x4 w; w.x = pk2(a[0], a[1]); w.y = pk2(a[2], a[3]); w.z = pk2(b[0], b[1]); w.w = pk2(b[2], b[3]); return w; }
struct EpiIn {
    unsigned char* ws; int l;
    __device__ __forceinline__ void operator()(const f32x4 (&acc)[2][2][4][2], const pg8::Unit& u, int wr, int wc, int fr, int fq) const {
        { int ln_ = (int)__builtin_amdgcn_mbcnt_hi(~0u, __builtin_amdgcn_mbcnt_lo(~0u, 0u)); asm volatile("" : "+v"(ln_)); fr = ln_ & 15; fq = ln_ >> 4; }
        const int pn = u.pn; size_t bo; int ld, c0;
        if (pn == 0) { bo = WS_QLAT; ld = 256; c0 = 0; } else if (pn == 1) { bo = WS_KVL; ld = 256; c0 = 0; }
        else if (pn < 4) { bo = WS_GATES; ld = 1536; c0 = (pn - 2) * 256; } else if (pn < 6) { bo = WS_GATES; ld = 1536; c0 = 512 + (pn - 4) * 256; }
        else if (pn < 10) { bo = WS_XBC; ld = 1024; c0 = (pn - 6) * 256; } else if (pn < 12) { bo = WS_R; ld = 512; c0 = (pn - 10) * 256; }
        else if (pn < 14) { bo = WS_K; ld = 512; c0 = (pn - 12) * 256; } else if (pn < 16) { bo = WS_V; ld = 512; c0 = (pn - 14) * 256; }
        else if (pn < 18) { bo = WS_GATES; ld = 1536; c0 = 1024 + (pn - 16) * 256; } else { bo = WS_F; ld = 144; c0 = 0; }
        bf16_t* base = (bf16_t*)(ws + bo); float* F = (float*)(ws + WS_F);
        float* ssq_q = (float*)(ws + WS_CTL + CTL_SSQ) + (size_t)(l * 2) * NT; float* ssq_kv = ssq_q + NT;
        const int row0 = u.pm * 256 + wr * 64 + fr, col0 = wc * 32 + 8 * fq;
        if (pn < 18) {
#pragma unroll
            for (int ai = 0; ai < 2; ++ai)
#pragma unroll
                for (int m = 0; m < 4; ++m) { const int row = row0 + ai * 128 + m * 16; bf16_t* rp = base + (size_t)row * ld + c0 + col0;
#pragma unroll
                    for (int bj = 0; bj < 2; ++bj) *(u32x4*)(rp + bj * 128) = pack8(acc[ai][bj][m][0], acc[ai][bj][m][1]);
                    if (pn < 2) { float s = 0.f;
#pragma unroll
                        for (int bj = 0; bj < 2; ++bj) if (pn == 0 || bj == 0) {
#pragma unroll
                            for (int n = 0; n < 2; ++n) { const f32x4 x = acc[ai][bj][m][n]; s += x[0] * x[0] + x[1] * x[1] + x[2] * x[2] + x[3] * x[3]; } }
                        s += __shfl_xor(s, 16); s += __shfl_xor(s, 32);
                        if (fq == 0) atomicAdd((pn == 0 ? ssq_q : ssq_kv) + row, s); } }
        } else {
#pragma unroll
            for (int ai = 0; ai < 2; ++ai)
#pragma unroll
                for (int m = 0; m < 4; ++m) { const int row = row0 + ai * 128 + m * 16;
#pragma unroll
                    for (int bj = 0; bj < 2; ++bj) { const int c = bj * 128 + col0; if (c < 136) { float* fp = F + (size_t)row * 144 + c; *(f32x4*)fp = acc[ai][bj][m][0]; *(f32x4*)(fp + 4) = acc[ai][bj][m][1]; } } }
        }
    }
};
struct EpiQ {
    unsigned char* ws; int l;
    __device__ __forceinline__ void operator()(const f32x4 (&acc)[2][2][4][2], const pg8::Unit& u, int wr, int wc, int fr, int fq) const {
        { int ln_ = (int)__builtin_amdgcn_mbcnt_hi(~0u, __builtin_amdgcn_mbcnt_lo(~0u, 0u)); asm volatile("" : "+v"(ln_)); fr = ln_ & 15; fq = ln_ >> 4; }
        bf16_t* Q = (bf16_t*)(ws + WS_Q); const float* ssq = (const float*)(ws + WS_CTL + CTL_SSQ) + (size_t)(l * 2) * NT;
        const int row0 = u.pm * 256 + wr * 64 + fr, c0 = u.pn * 256 + wc * 32 + 8 * fq;
#pragma unroll
        for (int ai = 0; ai < 2; ++ai)
#pragma unroll
            for (int m = 0; m < 4; ++m) { const int row = row0 + ai * 128 + m * 16; const float sc = QSCALE / sqrtf(ssq[row] * (1.f / 256.f) + EPS); bf16_t* qp = Q + (size_t)row * 768 + c0;
#pragma unroll
                for (int bj = 0; bj < 2; ++bj) *(u32x4*)(qp + bj * 128) = pack8(acc[ai][bj][m][0] * sc, acc[ai][bj][m][1] * sc); }
    }
};
struct EpiUV {
    bf16_t* gates;
    __device__ __forceinline__ void operator()(const f32x4 (&acc)[2][2][4][2], const pg8::Unit& u, int wr, int wc, int fr, int fq) const {
        { int ln_ = (int)__builtin_amdgcn_mbcnt_hi(~0u, __builtin_amdgcn_mbcnt_lo(~0u, 0u)); asm volatile("" : "+v"(ln_)); fr = ln_ & 15; fq = ln_ >> 4; }
        const int row0 = u.pm * 256 + wr * 64 + fr;
#pragma unroll
        for (int ai = 0; ai < 2; ++ai)
#pragma unroll
            for (int m = 0; m < 4; ++m) { asm volatile("" ::: "memory"); const int row = row0 + ai * 128 + m * 16;
#pragma unroll
                for (int bj = 0; bj < 2; ++bj) { const int c = u.pn * 256 + bj * 128 + wc * 32 + 8 * fq; u32x4* gp = (u32x4*)(gates + (size_t)row * 1536 + c); const u32x4 gw = *gp;
                    f32x4 v0 = acc[ai][bj][m][0], v1 = acc[ai][bj][m][1];
                    v0[0] *= siluf_(bflo(gw.x)); v0[1] *= siluf_(bfhi(gw.x)); v0[2] *= siluf_(bflo(gw.y)); v0[3] *= siluf_(bfhi(gw.y));
                    v1[0] *= siluf_(bflo(gw.z)); v1[1] *= siluf_(bfhi(gw.z)); v1[2] *= siluf_(bflo(gw.w)); v1[3] *= siluf_(bfhi(gw.w));
                    *gp = pack8(v0, v1); } }
    }
};
struct EpiOut {
    const float* xin; float* xout; const float* gate;
    __device__ __forceinline__ void operator()(const f32x4 (&acc)[2][2][4][2], const pg8::Unit& u, int wr, int wc, int fr, int fq) const {
        { int ln_ = (int)__builtin_amdgcn_mbcnt_hi(~0u, __builtin_amdgcn_mbcnt_lo(~0u, 0u)); asm volatile("" : "+v"(ln_)); fr = ln_ & 15; fq = ln_ >> 4; }
        const int row0 = u.pm * 256 + wr * 64 + fr;
#pragma unroll
        for (int bj = 0; bj < 2; ++bj) { const int c = u.pn * 256 + bj * 128 + wc * 32 + 8 * fq;
#pragma unroll
            for (int ai = 0; ai < 2; ++ai)
#pragma unroll
                for (int m = 0; m < 4; ++m) { const int row = row0 + ai * 128 + m * 16; const float* gp = gate + (size_t)(row >> 13) * 3072 + c;
                    const f32x4 g0 = *(const f32x4*)gp, g1 = *(const f32x4*)(gp + 4);
                    const size_t off = (size_t)row * DM + c; const f32x4 x0 = *(const f32x4*)(xin + off), x1 = *(const f32x4*)(xin + off + 4);
                    *(f32x4*)(xout + off) = x0 + g0 * acc[ai][bj][m][0]; *(f32x4*)(xout + off + 4) = x1 + g1 * acc[ai][bj][m][1]; } }
    }
};

__device__ __forceinline__ void p3a_extras(const Ctx& F, int l) {
    const int tid_ = F.wave * 64 + fresh_lane();
    const int gt = F.bid * NTHR + tid_, NGT = F.G * NTHR;
    const bf16_t* KVL = (const bf16_t*)(F.ws + WS_KVL); bf16_t* KVB = (bf16_t*)(F.ws + WS_KVB);
    const float* ssq = (const float*)(F.ws + WS_CTL + CTL_SSQ) + (size_t)(l * 2 + 1) * NT; const float* kvnw = INP(I_KVNW) + l * 128;
    const float* ROPE = (const float*)(F.ws + WS_ROPE);
    for (int e = gt; e < NT * 24; e += NGT) {
        const int m = e / 24, g = e % 24;
        if (g < 16) {
            const u32x4 w = *(const u32x4*)(KVL + (size_t)m * 256 + 8 * g); const float rs = 1.f / sqrtf(ssq[m] * (1.f / 128.f) + EPS);
            const f32x4 n0 = *(const f32x4*)(kvnw + 8 * g), n1 = *(const f32x4*)(kvnw + 8 * g + 4);
            u32x4 o; o.x = pk2(bflo(w.x) * rs * n0[0], bfhi(w.x) * rs * n0[1]); o.y = pk2(bflo(w.y) * rs * n0[2], bfhi(w.y) * rs * n0[3]);
            o.z = pk2(bflo(w.z) * rs * n1[0], bfhi(w.z) * rs * n1[1]); o.w = pk2(bflo(w.w) * rs * n1[2], bfhi(w.w) * rs * n1[3]);
            *(u32x4*)(KVB + (size_t)m * 192 + 8 * g) = o;
        } else {
            const int i0 = 4 * (g - 16);
            const u32x2 a = *(const u32x2*)(KVL + (size_t)m * 256 + 128 + i0), b = *(const u32x2*)(KVL + (size_t)m * 256 + 160 + i0);
            const f32x4 cs = *(const f32x4*)(ROPE + (size_t)m * 64 + i0), sn = *(const f32x4*)(ROPE + (size_t)m * 64 + 32 + i0);
            const f32x4 x1 = {bflo(a.x), bfhi(a.x), bflo(a.y), bfhi(a.y)}, x2 = {bflo(b.x), bfhi(b.x), bflo(b.y), bfhi(b.y)};
            const f32x4 o1 = x1 * cs - x2 * sn, o2 = x1 * sn + x2 * cs;
            u32x2 w1, w2; w1.x = pk2(o1[0], o1[1]); w1.y = pk2(o1[2], o1[3]); w2.x = pk2(o2[0], o2[1]); w2.y = pk2(o2[2], o2[3]);
            *(u32x2*)(KVB + (size_t)m * 192 + 128 + i0) = w1; *(u32x2*)(KVB + (size_t)m * 192 + 160 + i0) = w2;
        }
    }
    const u32x4* XBC = (const u32x4*)(F.ws + WS_XBC); u32x4* HX = (u32x4*)(F.ws + WS_HX);
    for (int e = gt; e < NCHK * 3 * 128; e += NGT) { const int c = e / 384, r = e % 384, j = r >> 7, p = r & 127; HX[e] = XBC[(size_t)(64 * c + 61 + j) * 128 + p]; }
    u32x4* HR = (u32x4*)(F.ws + WS_HRKV);
    for (int e = gt; e < 3 * NCHK * 64; e += NGT) { const int w = e / (NCHK * 64), r = e % (NCHK * 64), c = r >> 6, p = r & 63;
        const u32x4* src = (const u32x4*)(F.ws + (w == 0 ? WS_R : w == 1 ? WS_K : WS_V)); HR[e] = src[(size_t)(64 * c + 63) * 64 + p]; }
    const f32x4* FF = (const f32x4*)(F.ws + WS_F); f32x4* HF = (f32x4*)(F.ws + WS_HF);
    for (int e = gt; e < NCHK * 32; e += NGT) { const int c = e >> 5, p = e & 31; HF[e] = FF[(size_t)(64 * c + 63) * 36 + p]; }
}

__device__ __forceinline__ int ssd_win_col(int g, int o) { return o < 256 ? 256 * g + o : o < 384 ? 512 + 128 * g + (o - 256) : 768 + 128 * g + (o - 384); }
__device__ __forceinline__ void p3b_ssd(const Ctx& F, int l) {
    constexpr int SC_C = 0, SC_B = 17408, SC_BT = 34816, SC_XST = 53248, SC_CB = 90112, SC_G = 106752, SC_XSD = 115968, SC_DT = 125184, SC_AC = 127232;
    LAS bf16_t* Cg = (LAS bf16_t*)(F.lds + SC_C); LAS bf16_t* Bg = (LAS bf16_t*)(F.lds + SC_B); LAS bf16_t* BT = (LAS bf16_t*)(F.lds + SC_BT);
    LAS bf16_t* XST = (LAS bf16_t*)(F.lds + SC_XST); LAS float* CB = (LAS float*)(F.lds + SC_CB); LAS bf16_t* Gh = (LAS bf16_t*)(F.lds + SC_G);
    LAS bf16_t* XSD = (LAS bf16_t*)(F.lds + SC_XSD); LAS float* DT = (LAS float*)(F.lds + SC_DT); LAS float* AC = (LAS float*)(F.lds + SC_AC);
    bf16_t* XBC = (bf16_t*)(F.ws + WS_XBC); const bf16_t* HX = (const bf16_t*)(F.ws + WS_HX); const float* Ff = (const float*)(F.ws + WS_F);
    bf16_t* Cbuf = (bf16_t*)(F.ws + WS_CB); float* ECUM = (float*)(F.ws + WS_ECUM); float* CDEC = (float*)(F.ws + WS_CDEC); bf16_t* YD = (bf16_t*)(F.ws + WS_YD);
    const float* convw = INP(I_CONVW) + (size_t)l * 4 * 1024; const float* convb = INP(I_CONVB) + l * 1024;
    const float* dtb = INP(I_DTB) + l * 8; const float* alog = INP(I_ALOG) + l * 8; const float* dskip = INP(I_DSKIP) + l * 8;
    const int tid = F.tid, lane = F.lane, wave = F.wave;
    for (int c = F.bid; c < NCHK; c += F.G) {
        const int m0 = 64 * c; const bool first = (c & 127) == 0;
        if (wave == 0) {
            const int t = lane;
#pragma unroll
            for (int h = 0; h < 8; ++h) {
                const float raw = Ff[(size_t)(m0 + t) * 144 + 128 + h] + dtb[h];
                const float dt = raw > 20.f ? raw : log1pf(expf(raw));
                float v = dt * (-expf(alog[h]));
#pragma unroll
                for (int o = 1; o < 64; o <<= 1) { const float y = __shfl_up(v, o); if (lane >= o) v += y; }
                DT[t * 8 + h] = dt; AC[t * 8 + h] = v;
                const float ev = expf(v); ECUM[(size_t)(c * 8 + h) * 64 + t] = ev; if (t == 63) CDEC[c * 8 + h] = ev;
            }
        }
        for (int g = 0; g < 2; ++g) {
            {
                const int col = ssd_win_col(g, tid);
                const float w0 = convw[col], w1 = convw[1024 + col], w2 = convw[2048 + col], w3 = convw[3072 + col], cb = convb[col];
                float h0 = 0.f, h1 = 0.f, h2 = 0.f;
                if (!first) { h0 = bf2f(HX[(size_t)((c - 1) * 3 + 0) * 1024 + col]); h1 = bf2f(HX[(size_t)((c - 1) * 3 + 1) * 1024 + col]); h2 = bf2f(HX[(size_t)((c - 1) * 3 + 2) * 1024 + col]); }
#pragma unroll 8
                for (int t = 0; t < 64; ++t) {
                    const float x = bf2f(XBC[(size_t)(m0 + t) * 1024 + col]);
                    const float u = w0 * h0 + w1 * h1 + w2 * h2 + w3 * x + cb; h0 = h1; h1 = h2; h2 = x;
                    const bf16_t bv = (bf16_t)f2bf(siluf_(u));
                    if (tid < 256) XST[tid * 72 + t] = bv;
                    else if (tid < 384) { const int n = tid - 256; Bg[t * 136 + n] = bv; BT[n * 72 + t] = bv; }
                    else { const int n = tid - 384; Cg[t * 136 + n] = bv; Cbuf[(size_t)(m0 + t) * 256 + g * 128 + n] = bv; }
                }
            }
            __syncthreads();
#pragma unroll
            for (int i = 0; i < 2; ++i) { const int idx = 2 * wave + i, ti = idx >> 2, si = idx & 3;
                const f32x4 acc = mma_tile<128>(Cg + ti * 16 * 136, 136, Bg + si * 16 * 136, 136, lane);
#pragma unroll
                for (int r = 0; r < 4; ++r) CB[(ti * 16 + 4 * (lane >> 4) + r) * 65 + si * 16 + (lane & 15)] = acc[r]; }
            __syncthreads();
            for (int hl = 0; hl < 4; ++hl) {
                const int h = 4 * g + hl;
                {   const int t = tid >> 3, s0 = (tid & 7) * 8; const float at = AC[t * 8 + h], a63 = AC[63 * 8 + h];
                    float gv[8], xv[8]; const u32x4 xw = *(const LAS u32x4*)(XST + (64 * hl + t) * 72 + s0);
                    const float xf[8] = {bflo(xw.x), bfhi(xw.x), bflo(xw.y), bfhi(xw.y), bflo(xw.z), bfhi(xw.z), bflo(xw.w), bfhi(xw.w)};
#pragma unroll
                    for (int j = 0; j < 8; ++j) { const int s = s0 + j; const float as = AC[s * 8 + h], ds = DT[s * 8 + h];
                        gv[j] = (s <= t) ? CB[t * 65 + s] * expf(at - as) * ds : 0.f; xv[j] = xf[j] * ds * expf(a63 - as); }
                    u32x4 o; o.x = pk2(gv[0], gv[1]); o.y = pk2(gv[2], gv[3]); o.z = pk2(gv[4], gv[5]); o.w = pk2(gv[6], gv[7]); *(LAS u32x4*)(Gh + t * 72 + s0) = o;
                    o.x = pk2(xv[0], xv[1]); o.y = pk2(xv[2], xv[3]); o.z = pk2(xv[4], xv[5]); o.w = pk2(xv[6], xv[7]); *(LAS u32x4*)(XSD + t * 72 + s0) = o; }
                __syncthreads();
                const float dsk = dskip[h];
#pragma unroll
                for (int i = 0; i < 2; ++i) { const int idx = 2 * wave + i, ti = idx >> 2, pi = idx & 3;
                    const f32x4 acc = mma_tile<64>(Gh + ti * 16 * 72, 72, XST + (64 * hl + 16 * pi) * 72, 72, lane);
#pragma unroll
                    for (int r = 0; r < 4; ++r) { const int t = ti * 16 + 4 * (lane >> 4) + r, p = pi * 16 + (lane & 15);
                        const float y = acc[r] + dsk * bf2f(XST[(64 * hl + p) * 72 + t]); YD[(size_t)(m0 + t) * 512 + 64 * h + p] = (bf16_t)f2bf(y); } }
#pragma unroll
                for (int i = 0; i < 4; ++i) { const int idx = 4 * wave + i, pi = idx >> 3, ni = idx & 7;
                    const f32x4 acc = mma_tile<64>(XSD + pi * 16 * 72, 72, BT + ni * 16 * 72, 72, lane);
#pragma unroll
                    for (int r = 0; r < 4; ++r) { const int p = pi * 16 + 4 * (lane >> 4) + r, n = ni * 16 + (lane & 15);
                        const int f = hl * 8192 + p * 128 + n, row = f >> 9, col = ssd_win_col(g, f & 511);
                        XBC[(size_t)(m0 + row) * 1024 + col] = (bf16_t)f2bf(acc[r]); } }
                __syncthreads();
            }
        }
    }
}

__device__ __forceinline__ void p3c_rwkv(const Ctx& F, int l) {
    constexpr int M9 = 9216, O_TW = 0, O_AL = 9216, O_SL = 18432, O_MAB = O_SL + 12 * M9  , O_LWF = O_SL + 10 * M9  , O_ICF = O_LWF + 16640, O_WL = O_MAB + 16640  , O_SCR = O_WL + 256;
    static_assert(O_ICF + 16640 <= O_MAB + 16640 && O_SCR + 4224 <= LDS_BYTES, "rwkv lds map");
#define LB() ({ LAS unsigned char* p_ = F.lds; asm volatile("" : "+s"(p_)); p_; })
#define SLOT(i) ((LAS bf16_t*)(L + O_SL + (i) * M9))
#define TW ((LAS bf16_t*)(L + O_TW))
#define AL ((LAS bf16_t*)(L + O_AL))
#define AT SLOT(0)
#define ATt SLOT(1)
#define BTl SLOT(2)
#define KTl SLOT(3)
#define RT SLOT(4)
#define BHt SLOT(5)
#define KH SLOT(6)
#define VT SLOT(7)
#define MI SLOT(8)
#define MakT SLOT(9)
#define Rb SLOT(10)
#define Rk SLOT(11)
#define Attn SLOT(0)
#define KEt SLOT(1)
#define X1t SLOT(2)
#define X2t SLOT(3)
#define S8 SLOT(8)
#define S9 SLOT(9)
#define MAB ((LAS float*)(L + O_MAB))
#define LWf ((LAS float*)(L + O_LWF))
#define ICf ((LAS float*)(L + O_ICF))
#define WL ((LAS float*)(L + O_WL))
#define SCR ((LAS float*)(L + O_SCR))
    const int tid = F.tid, lane = F.lane, wave = F.wave;
    for (int c = F.bid; c < NCHK; c += F.G) {
        const int m0 = 64 * c; const bool first = (c & 127) == 0;
        {
            LAS unsigned char* L = LB();
            const int t = tid >> 3, q0 = (tid & 7) * 8;
            const float* Ff = (const float*)(F.ws + WS_F); const float* HF = (const float*)(F.ws + WS_HF); const float* mu_w = INP(I_MUW) + l * 64; const float* mu_a = INP(I_MUA) + l * 64;
            float cw[8], pw[8], ca[8], pa[8];
            const float* cur = Ff + (size_t)(m0 + t) * 144; const float* prv = (t > 0) ? cur - 144 : HF + (size_t)(c - 1) * 128;
#pragma unroll
            for (int j = 0; j < 8; ++j) { cw[j] = cur[q0 + j]; ca[j] = cur[64 + q0 + j]; }
            if (t > 0) {
#pragma unroll
                for (int j = 0; j < 8; ++j) { pw[j] = prv[q0 + j]; pa[j] = prv[64 + q0 + j]; }
            } else if (!first) {
#pragma unroll
                for (int j = 0; j < 8; ++j) { pw[j] = prv[q0 + j]; pa[j] = prv[64 + q0 + j]; }
            } else {
#pragma unroll
                for (int j = 0; j < 8; ++j) { pw[j] = 0.f; pa[j] = 0.f; }
            }
            float ow[8], oa[8];
#pragma unroll
            for (int j = 0; j < 8; ++j) { ow[j] = tanhf(cw[j] + (pw[j] - cw[j]) * mu_w[q0 + j]); oa[j] = ca[j] + (pa[j] - ca[j]) * mu_a[q0 + j]; }
            u32x4 o; o.x = pk2(ow[0], ow[1]); o.y = pk2(ow[2], ow[3]); o.z = pk2(ow[4], ow[5]); o.w = pk2(ow[6], ow[7]); *(LAS u32x4*)(TW + t * 72 + q0) = o;
            o.x = pk2(oa[0], oa[1]); o.y = pk2(oa[2], oa[3]); o.z = pk2(oa[4], oa[5]); o.w = pk2(oa[6], oa[7]); *(LAS u32x4*)(AL + t * 72 + q0) = o;
        }
        for (int h = 0; h < 8; ++h) {
            int tid = F.tid, lane = F.lane; asm volatile("" : "+v"(tid), "+v"(lane));
            {   LAS unsigned char* L = LB(); const int row = tid >> 3, c8 = tid & 7; const bf16_t* WLW = (const bf16_t*)(F.ws + WS_WLW); const bf16_t* WLA = (const bf16_t*)(F.ws + WS_WLA);
                *(LAS u32x4*)(S8 + row * 72 + c8 * 8) = *(const u32x4*)(WLW + (size_t)(h * 64 + row) * 64 + c8 * 8);
                *(LAS u32x4*)(S9 + row * 72 + c8 * 8) = *(const u32x4*)(WLA + (size_t)(h * 64 + row) * 64 + c8 * 8); }
            __syncthreads();
            { LAS unsigned char* L = LB(); const float* w0 = INP(I_W0) + l * 512; const float* a0 = INP(I_A0) + l * 512;
#pragma unroll
            for (int i = 0; i < 4; ++i) { const int idx = 4 * wave + i, which = idx >> 4, ti = (idx >> 2) & 3, ci = idx & 3;
                const f32x4 acc = mma_tile<64>((which ? AL : TW) + ti * 16 * 72, 72, (which ? S9 : S8) + ci * 16 * 72, 72, lane);
#pragma unroll
                for (int r = 0; r < 4; ++r) { const int t = ti * 16 + 4 * (lane >> 4) + r, ch = ci * 16 + (lane & 15);
                    if (which == 0) LWf[t * 65 + ch] = -DECAY_SCALE * sigmoidf_(acc[r] + w0[h * 64 + ch]); else ICf[t * 65 + ch] = sigmoidf_(acc[r] + a0[h * 64 + ch]); } } }
            __syncthreads();
            if (wave == 0) { LAS unsigned char* L = LB(); float run = 0.f;
#pragma unroll 8
                for (int t = 0; t < 64; ++t) { run += LWf[t * 65 + lane]; LWf[t * 65 + lane] = run; }
                WL[lane] = expf(run); }
            __syncthreads();
            float bonv[8]; const int t1 = tid >> 3, ch0 = (tid & 7) * 8, col1 = h * 64 + ch0;
            {   LAS unsigned char* L = LB(); const int t = t1;
                const bf16_t* Rg = (const bf16_t*)(F.ws + WS_R); const bf16_t* Kg = (const bf16_t*)(F.ws + WS_K); const bf16_t* Vg = (const bf16_t*)(F.ws + WS_V); const bf16_t* HR = (const bf16_t*)(F.ws + WS_HRKV);
                const float* mu_r = INP(I_MURKV) + (size_t)l * 1536; const float* mu_k = mu_r + 512; const float* mu_v = mu_r + 1024;
                const float* kkp = INP(I_KK) + l * 512; const float* kap = INP(I_KA) + l * 512; const float* rkp = INP(I_RK) + l * 512;
                const size_t off = (size_t)(m0 + t) * 512 + col1;
                const u32x4 rw = *(const u32x4*)(Rg + off), kw = *(const u32x4*)(Kg + off), vw = *(const u32x4*)(Vg + off);
                u32x4 rp = {0u, 0u, 0u, 0u}, kp = rp, vp = rp;
                if (t > 0) { rp = *(const u32x4*)(Rg + off - 512); kp = *(const u32x4*)(Kg + off - 512); vp = *(const u32x4*)(Vg + off - 512); }
                else if (!first) { const size_t ho = (size_t)(c - 1) * 512 + col1; rp = *(const u32x4*)(HR + ho); kp = *(const u32x4*)(HR + (size_t)NCHK * 512 + ho); vp = *(const u32x4*)(HR + (size_t)2 * NCHK * 512 + ho); }
                const unsigned rwa[4] = {rw.x, rw.y, rw.z, rw.w}, kwa[4] = {kw.x, kw.y, kw.z, kw.w}, vwa[4] = {vw.x, vw.y, vw.z, vw.w};
                const unsigned rpa[4] = {rp.x, rp.y, rp.z, rp.w}, kpa[4] = {kp.x, kp.y, kp.z, kp.w}, vpa[4] = {vp.x, vp.y, vp.z, vp.w};
                float rs[8], ks[8], vs[8], kkv[8], k2[8], ic[8]; float ss = 0.f, bs = 0.f;
#pragma unroll
                for (int j = 0; j < 8; ++j) { const int gch = col1 + j; const int q = j >> 1;
                    const float r_ = (j & 1) ? bfhi(rwa[q]) : bflo(rwa[q]), rq = (j & 1) ? bfhi(rpa[q]) : bflo(rpa[q]);
                    const float k_ = (j & 1) ? bfhi(kwa[q]) : bflo(kwa[q]), kq = (j & 1) ? bfhi(kpa[q]) : bflo(kpa[q]);
                    const float v_ = (j & 1) ? bfhi(vwa[q]) : bflo(vwa[q]), vq = (j & 1) ? bfhi(vpa[q]) : bflo(vpa[q]);
                    rs[j] = r_ + (rq - r_) * mu_r[gch]; ks[j] = k_ + (kq - k_) * mu_k[gch]; vs[j] = v_ + (vq - v_) * mu_v[gch];
                    ic[j] = ICf[t * 65 + ch0 + j];
                    kkv[j] = ks[j] * kkp[gch]; ss += kkv[j] * kkv[j];
                    k2[j] = ks[j] * (1.f + (ic[j] - 1.f) * kap[gch]); bs += rs[j] * k2[j] * rkp[gch]; }
                ss += __shfl_xor(ss, 1); ss += __shfl_xor(ss, 2); ss += __shfl_xor(ss, 4);
                bs += __shfl_xor(bs, 1); bs += __shfl_xor(bs, 2); bs += __shfl_xor(bs, 4);
                const float inv = 1.f / fmaxf(sqrtf(ss), 1e-12f);
                float vAT[8], vB[8], vK[8], vR[8], vBH[8], vKH[8];
#pragma unroll
                for (int j = 0; j < 8; ++j) { const int ch = ch0 + j;
                    const float LWt = LWf[t * 65 + ch], LWp = (t > 0) ? LWf[(t - 1) * 65 + ch] : 0.f, L63 = LWf[63 * 65 + ch];
                    const float kk = kkv[j] * inv, a = -kk, b = kk * ic[j];
                    const float e1 = expf(LWt), e2 = expf(-LWt), e3 = expf(LWp), e4 = expf(L63 - LWt);
                    vAT[j] = a * e3; vB[j] = b * e2; vK[j] = k2[j] * e2; vR[j] = rs[j] * e1; vBH[j] = b * e4; vKH[j] = k2[j] * e4; bonv[j] = bs * vs[j];
                    ATt[ch * 72 + t] = (bf16_t)f2bf(vAT[j]); BHt[ch * 72 + t] = (bf16_t)f2bf(vBH[j]); VT[ch * 72 + t] = (bf16_t)f2bf(vs[j]); }
                u32x4 o;
#define PK8(A_) (o[0] = pk2(A_[0], A_[1]), o[1] = pk2(A_[2], A_[3]), o[2] = pk2(A_[4], A_[5]), o[3] = pk2(A_[6], A_[7]), o)
                *(LAS u32x4*)(AT + t * 72 + ch0) = PK8(vAT); *(LAS u32x4*)(BTl + t * 72 + ch0) = PK8(vB); *(LAS u32x4*)(KTl + t * 72 + ch0) = PK8(vK);
                *(LAS u32x4*)(RT + t * 72 + ch0) = PK8(vR); *(LAS u32x4*)(KH + t * 72 + ch0) = PK8(vKH);
            }
            __syncthreads();
            { u32x4 o; *(u32x4*)((bf16_t*)(F.ws + WS_V) + (size_t)(m0 + t1) * 512 + col1) = PK8(bonv); }
            { LAS unsigned char* L = LB();
#pragma unroll
            for (int i = 0; i < 8; ++i) { const int p = wave >> 1, idx = 8 * (wave & 1) + i, ti = idx >> 2, si = idx & 3;
                const f32x4 acc = mma_tile<64>(((p < 2) ? AT : RT) + ti * 16 * 72, 72, ((p & 1) ? KTl : BTl) + si * 16 * 72, 72, lane);
#pragma unroll
                for (int r = 0; r < 4; ++r) { const int t = ti * 16 + 4 * (lane >> 4) + r, s = si * 16 + (lane & 15);
                    if (p == 0) MAB[t * 65 + s] = (s < t) ? acc[r] : 0.f;
                    else if (p == 1) MakT[s * 72 + t] = (bf16_t)f2bf((s < t) ? acc[r] : 0.f);
                    else if (p == 2) Rb[t * 72 + s] = (bf16_t)f2bf((s <= t) ? acc[r] : 0.f);
                    else Rk[t * 72 + s] = (bf16_t)f2bf((s <= t) ? acc[r] : 0.f); } } }
            __syncthreads();
            if (wave < 4 && lane < 16) { LAS unsigned char* L = LB(); const int b0 = 16 * wave; float x[16];
#pragma unroll
                for (int t = 0; t < 16; ++t) { float v = (t == lane) ? 1.f : 0.f;
#pragma unroll
                    for (int s = 0; s < 16; ++s) if (s < t) v += MAB[(b0 + t) * 65 + b0 + s] * x[s];
                    x[t] = v; }
#pragma unroll
                for (int t = 0; t < 16; ++t) MAB[(b0 + t) * 65 + b0 + lane] = x[t]; }
            __syncthreads();
            {   LAS unsigned char* L = LB(); const int pr = tid >> 8, e = tid & 255, rr = e >> 4, cc = e & 15, rb = pr ? 48 : 16, cb = pr ? 32 : 0; float v = 0.f;
#pragma unroll
                for (int s = 0; s < 16; ++s) v += MAB[(rb + rr) * 65 + cb + s] * MAB[(cb + s) * 65 + cb + cc];
                SCR[(pr * 16 + rr) * 33 + cc] = v; }
            __syncthreads();
            {   LAS unsigned char* L = LB(); const int pr = tid >> 8, e = tid & 255, rr = e >> 4, cc = e & 15, rb = pr ? 48 : 16, cb = pr ? 32 : 0; float v = 0.f;
#pragma unroll
                for (int s = 0; s < 16; ++s) v += MAB[(rb + rr) * 65 + rb + s] * SCR[(pr * 16 + s) * 33 + cc];
                MAB[(rb + rr) * 65 + cb + cc] = v; }
            __syncthreads();
            {   LAS unsigned char* L = LB(); float v2[2];
#pragma unroll
                for (int i = 0; i < 2; ++i) { const int e = tid * 2 + i, rr = e >> 5, cc = e & 31; float v = 0.f;
#pragma unroll 8
                    for (int s = 0; s < 32; ++s) v += MAB[(32 + rr) * 65 + s] * MAB[s * 65 + cc];
                    v2[i] = v; }
                SCR[((tid * 2) >> 5) * 33 + ((tid * 2) & 31)] = v2[0]; SCR[((tid * 2 + 1) >> 5) * 33 + ((tid * 2 + 1) & 31)] = v2[1]; }
            __syncthreads();
            {   LAS unsigned char* L = LB();
#pragma unroll
                for (int i = 0; i < 2; ++i) { const int e = tid * 2 + i, rr = e >> 5, cc = e & 31; float v = 0.f;
#pragma unroll 8
                    for (int s = 0; s < 32; ++s) v += MAB[(32 + rr) * 65 + 32 + s] * SCR[s * 33 + cc];
                    MAB[(32 + rr) * 65 + cc] = v; } }
            __syncthreads();
            {   LAS unsigned char* L = LB(); const int t = tid >> 3, s0 = (tid & 7) * 8; float x[8];
#pragma unroll
                for (int j = 0; j < 8; ++j) x[j] = MAB[t * 65 + s0 + j];
                u32x4 o; *(LAS u32x4*)(MI + t * 72 + s0) = PK8(x); }
            __syncthreads();
            { LAS unsigned char* L = LB();
#pragma unroll
            for (int i = 0; i < 4; ++i) { const int idx = 4 * wave + i, which = idx >> 4, ti = (idx >> 2) & 3, ci = idx & 3;
                const f32x4 acc = mma_tile<64>(MI + ti * 16 * 72, 72, (which ? MakT : ATt) + ci * 16 * 72, 72, lane);
#pragma unroll
                for (int r = 0; r < 4; ++r) { const int t = ti * 16 + 4 * (lane >> 4) + r, j = ci * 16 + (lane & 15); (which ? X2t : X1t)[j * 72 + t] = (bf16_t)f2bf(acc[r]); } } }
            __syncthreads();
            { LAS unsigned char* L = LB();
            bf16_t* QEw = (bf16_t*)(F.ws + WS_QE) + (size_t)(c * 8 + h) * 4096; bf16_t* TTw = (bf16_t*)(F.ws + WS_TT) + (size_t)(c * 8 + h) * 4096;
#pragma unroll
            for (int i = 0; i < 8; ++i) { const int p = wave >> 1, idx = 8 * (wave & 1) + i, ti = idx >> 2, si = idx & 3;
                const f32x4 acc = mma_tile<64>(((p == 0 || p == 1) ? Rb : (p == 2) ? X1t : X2t) + ti * 16 * 72, 72, ((p == 0) ? X1t : (p == 1) ? X2t : BHt) + si * 16 * 72, 72, lane);
#pragma unroll
                for (int r = 0; r < 4; ++r) { const int rw = ti * 16 + 4 * (lane >> 4) + r, cl = si * 16 + (lane & 15);
                    if (p == 0) QEw[rw * 64 + pi16(cl)] = (bf16_t)f2bf(acc[r] + bf2f(RT[rw * 72 + cl]));
                    else if (p == 1) Attn[rw * 72 + cl] = (bf16_t)f2bf(acc[r] + bf2f(Rk[rw * 72 + cl]));
                    else if (p == 2) TTw[cl * 64 + pi16(rw)] = (bf16_t)f2bf(acc[r] + ((rw == cl) ? WL[rw] : 0.f));
                    else KEt[cl * 72 + rw] = (bf16_t)f2bf(acc[r] + bf2f(KH[rw * 72 + cl])); } } }
            __syncthreads();
            bf16_t* Rg = (bf16_t*)(F.ws + WS_R); bf16_t* Kg = (bf16_t*)(F.ws + WS_K); LAS unsigned char* L = LB();
#pragma unroll
            for (int i = 0; i < 4; ++i) { const int idx = 4 * wave + i, which = idx >> 4, ti = (idx >> 2) & 3, ci = idx & 3;
                const f32x4 acc = mma_tile<64>((which ? VT : Attn) + ti * 16 * 72, 72, (which ? KEt : VT) + ci * 16 * 72, 72, lane);
#pragma unroll
                for (int r = 0; r < 4; ++r) { const int rw = ti * 16 + 4 * (lane >> 4) + r, cl = ci * 16 + (lane & 15);
                    if (which == 0) Kg[(size_t)(m0 + cl) * 512 + h * 64 + sg32(rw)] = (bf16_t)f2bf(acc[r]);
                    else Rg[(size_t)(m0 + rw) * 512 + h * 64 + sg32(cl)] = (bf16_t)f2bf(acc[r]); } }
        }
        __syncthreads();
    }
#undef SLOT
#undef PK8
#undef LB
#undef TW
#undef AL
#undef AT
#undef ATt
#undef BTl
#undef KTl
#undef RT
#undef BHt
#undef KH
#undef VT
#undef MI
#undef MakT
#undef Rb
#undef Rk
#undef Attn
#undef KEt
#undef X1t
#undef X2t
#undef S8
#undef S9
#undef MAB
#undef LWf
#undef ICf
#undef WL
#undef SCR
}

__device__ __forceinline__ bf16x8 cvt8(const f32x16& x, int s) {
    u32x4 w; w.x = pk2(x[8 * s + 0], x[8 * s + 1]); w.y = pk2(x[8 * s + 2], x[8 * s + 3]); w.z = pk2(x[8 * s + 4], x[8 * s + 5]); w.w = pk2(x[8 * s + 6], x[8 * s + 7]);
    return __builtin_bit_cast(bf16x8, w);
}
__device__ __forceinline__ f32x16 ld16bf(const bf16_t* p) {
    const u32x4 a = *(const u32x4*)p, b = *(const u32x4*)(p + 8); f32x16 r;
    r[0] = bflo(a.x); r[1] = bfhi(a.x); r[2] = bflo(a.y); r[3] = bfhi(a.y); r[4] = bflo(a.z); r[5] = bfhi(a.z); r[6] = bflo(a.w); r[7] = bfhi(a.w);
    r[8] = bflo(b.x); r[9] = bfhi(b.x); r[10] = bflo(b.y); r[11] = bfhi(b.y); r[12] = bflo(b.z); r[13] = bfhi(b.z); r[14] = bflo(b.w); r[15] = bfhi(b.w); return r;
}
__device__ __forceinline__ void st16bf(bf16_t* p, const f32x16& x) {
    u32x4 a, b; a.x = pk2(x[0], x[1]); a.y = pk2(x[2], x[3]); a.z = pk2(x[4], x[5]); a.w = pk2(x[6], x[7]); b.x = pk2(x[8], x[9]); b.y = pk2(x[10], x[11]); b.z = pk2(x[12], x[13]); b.w = pk2(x[14], x[15]);
    *(u32x4*)p = a; *(u32x4*)(p + 8) = b;
}
constexpr int KROW = 400;
__device__ __forceinline__ void attn_unit(const Ctx& F, int b, int c) {
    const int tid = F.tid, lane = F.lane, wave = F.wave, r32 = lane & 31, hi = lane >> 5, head = wave >> 1;
    const bf16_t* Q = (const bf16_t*)(F.ws + WS_Q); const bf16_t* KV = (const bf16_t*)(F.ws + WS_KVB) + (size_t)b * SEQ * 192; bf16_t* OL = (bf16_t*)(F.ws + WS_OL);
    const size_t mq = (size_t)b * SEQ + 64 * c + 32 * (wave & 1) + r32;
    bf16x8 qr[12];
#pragma unroll
    for (int d0 = 0; d0 < 12; ++d0) qr[d0] = *(const bf16x8*)(Q + mq * 768 + head * 192 + 16 * d0 + 8 * hi);
    {
        const float* rp = (const float*)(F.ws + WS_ROPE) + mq * 64;
#pragma unroll
        for (int d0 = 8; d0 < 10; ++d0) { const int j0 = 16 * (d0 - 8) + 8 * hi;
            const f32x4 c0 = *(const f32x4*)(rp + j0), c1 = *(const f32x4*)(rp + j0 + 4), s0 = *(const f32x4*)(rp + 32 + j0), s1 = *(const f32x4*)(rp + 32 + j0 + 4);
            const u32x4 a = __builtin_bit_cast(u32x4, qr[d0]), b = __builtin_bit_cast(u32x4, qr[d0 + 2]);
            const float x1[8] = {bflo(a.x), bfhi(a.x), bflo(a.y), bfhi(a.y), bflo(a.z), bfhi(a.z), bflo(a.w), bfhi(a.w)}, x2[8] = {bflo(b.x), bfhi(b.x), bflo(b.y), bfhi(b.y), bflo(b.z), bfhi(b.z), bflo(b.w), bfhi(b.w)};
            const float cs[8] = {c0[0], c0[1], c0[2], c0[3], c1[0], c1[1], c1[2], c1[3]}, sn[8] = {s0[0], s0[1], s0[2], s0[3], s1[0], s1[1], s1[2], s1[3]};
            float o1[8], o2[8];
#pragma unroll
            for (int e = 0; e < 8; ++e) { o1[e] = x1[e] * cs[e] - x2[e] * sn[e]; o2[e] = x1[e] * sn[e] + x2[e] * cs[e]; }
            u32x4 w1, w2; w1.x = pk2(o1[0], o1[1]); w1.y = pk2(o1[2], o1[3]); w1.z = pk2(o1[4], o1[5]); w1.w = pk2(o1[6], o1[7]); w2.x = pk2(o2[0], o2[1]); w2.y = pk2(o2[2], o2[3]); w2.z = pk2(o2[4], o2[5]); w2.w = pk2(o2[6], o2[7]);
            qr[d0] = __builtin_bit_cast(bf16x8, w1); qr[d0 + 2] = __builtin_bit_cast(bf16x8, w2); }
    }
    int prow[3], pcol[3];
#pragma unroll
    for (int i = 0; i < 3; ++i) { const int idx = tid + 512 * i; prow[i] = idx / 24; pcol[i] = idx % 24; }
    const int nt = c + 1;
    u32x4 st[3];
#pragma unroll
    for (int i = 0; i < 3; ++i) st[i] = *(const u32x4*)(KV + (size_t)prow[i] * 192 + pcol[i] * 8);
#pragma unroll
    for (int i = 0; i < 3; ++i) *(LAS u32x4*)(F.lds + prow[i] * KROW + pcol[i] * 16) = st[i];
    __syncthreads();
    f32x16 o[4];
#pragma unroll
    for (int d = 0; d < 4; ++d)
#pragma unroll
        for (int r = 0; r < 16; ++r) o[d][r] = 0.f;
    float mrun = -1e30f, lrun = 0.f;
    const int troff = (4 * hi + ((lane & 15) >> 2)) * KROW + (((lane >> 4) & 1) * 16 + (lane & 3) * 4) * 2;
    for (int kt = 0; kt < nt; ++kt) {
        LAS unsigned char* buf = F.lds + (kt & 1) * (64 * KROW);
        if (kt + 1 < nt) {
#pragma unroll
            for (int i = 0; i < 3; ++i) st[i] = *(const u32x4*)(KV + (size_t)((kt + 1) * 64 + prow[i]) * 192 + pcol[i] * 8);
        }
        f32x16 p0, p1;
#pragma unroll
        for (int r = 0; r < 16; ++r) { p0[r] = 0.f; p1[r] = 0.f; }
#pragma unroll
        for (int d0 = 0; d0 < 12; ++d0) {
            const bf16x8 a0 = *(const LAS bf16x8*)(buf + r32 * KROW + d0 * 32 + hi * 16), a1 = *(const LAS bf16x8*)(buf + (32 + r32) * KROW + d0 * 32 + hi * 16);
            p0 = __builtin_amdgcn_mfma_f32_32x32x16_bf16(a0, qr[d0], p0, 0, 0, 0); p1 = __builtin_amdgcn_mfma_f32_32x32x16_bf16(a1, qr[d0], p1, 0, 0, 0);
        }
        float mx = p0[0];
#pragma unroll
        for (int r = 0; r < 16; ++r) { mx = fmaxf(mx, p0[r]); mx = fmaxf(mx, p1[r]); }
        mx = fmaxf(mx, __shfl_xor(mx, 32));
        const float mnew = fmaxf(mrun, mx), alpha = exp2f(mrun - mnew); mrun = mnew;
        float ls = 0.f;
#pragma unroll
        for (int r = 0; r < 16; ++r) { p0[r] = exp2f(p0[r] - mnew); p1[r] = exp2f(p1[r] - mnew); ls += p0[r] + p1[r]; }
        lrun = lrun * alpha + ls;
#pragma unroll
        for (int d = 0; d < 4; ++d)
#pragma unroll
            for (int r = 0; r < 16; ++r) o[d][r] *= alpha;
#pragma unroll
        for (int s = 0; s < 4; ++s) {
            const bf16x8 pb = (s < 2) ? cvt8(p0, s & 1) : cvt8(p1, s & 1);
#pragma unroll
            for (int db = 0; db < 4; ++db) {
                const LAS unsigned char* vp = buf + troff + (16 * s) * KROW + db * 64;
                const v4i16_t lo = __builtin_amdgcn_ds_read_tr16_b64_v4i16((LAS v4i16_t*)vp), hh = __builtin_amdgcn_ds_read_tr16_b64_v4i16((LAS v4i16_t*)(vp + 8 * KROW));
                const bf16x8 va = {lo[0], lo[1], lo[2], lo[3], hh[0], hh[1], hh[2], hh[3]};
                o[db] = __builtin_amdgcn_mfma_f32_32x32x16_bf16(va, pb, o[db], 0, 0, 0);
            }
        }
        if (kt + 1 < nt) {
            LAS unsigned char* nb = F.lds + ((kt + 1) & 1) * (64 * KROW);
#pragma unroll
            for (int i = 0; i < 3; ++i) *(LAS u32x4*)(nb + prow[i] * KROW + pcol[i] * 16) = st[i];
        }
        __syncthreads();
    }
    lrun += __shfl_xor(lrun, 32);
    const float inv = 1.f / lrun;
#pragma unroll
    for (int db = 0; db < 4; ++db)
#pragma unroll
        for (int g = 0; g < 4; ++g) { u32x2 w; w.x = pk2(o[db][4 * g] * inv, o[db][4 * g + 1] * inv); w.y = pk2(o[db][4 * g + 2] * inv, o[db][4 * g + 3] * inv);
            *(u32x2*)(OL + mq * 512 + head * 128 + 32 * db + 8 * g + 4 * hi) = w; }
}
struct RwSet { bf16x8 ta[2][4]; u32x4 d[4]; };
__device__ __forceinline__ void rw_load(RwSet& s, const bf16_t* TTg, const bf16_t* Rg, int cg_, int h, int i, int r32, int hi) {
    const bf16_t* TTw = TTg + (size_t)(cg_ * 8 + h) * 4096; const bf16_t* Dw = Rg + ((size_t)64 * cg_ + i) * 512 + h * 64;
#pragma unroll
    for (int a = 0; a < 2; ++a)
#pragma unroll
        for (int s2 = 0; s2 < 4; ++s2) s.ta[a][s2] = *(const bf16x8*)(TTw + (32 * a + r32) * 64 + 16 * s2 + 8 * hi);
    s.d[0] = *(const u32x4*)(Dw + 16 * hi); s.d[1] = *(const u32x4*)(Dw + 16 * hi + 8); s.d[2] = *(const u32x4*)(Dw + 32 + 16 * hi); s.d[3] = *(const u32x4*)(Dw + 32 + 16 * hi + 8);
}
__device__ __forceinline__ f32x16 up16(const u32x4 a, const u32x4 b) { f32x16 r;
    r[0] = bflo(a.x); r[1] = bfhi(a.x); r[2] = bflo(a.y); r[3] = bfhi(a.y); r[4] = bflo(a.z); r[5] = bfhi(a.z); r[6] = bflo(a.w); r[7] = bfhi(a.w);
    r[8] = bflo(b.x); r[9] = bfhi(b.x); r[10] = bflo(b.y); r[11] = bfhi(b.y); r[12] = bflo(b.z); r[13] = bfhi(b.z); r[14] = bflo(b.w); r[15] = bfhi(b.w); return r; }
__device__ __forceinline__ void rw_step(f32x16& X0, f32x16& X1, const RwSet& s, bf16_t* Rg, int cg_, int h, int i, int hi, bool live) {
    const bf16x8 bf[4] = {cvt8(X0, 0), cvt8(X0, 1), cvt8(X1, 0), cvt8(X1, 1)};
    if (live) { bf16_t* Dw = Rg + ((size_t)64 * cg_ + i) * 512 + h * 64;
        *(bf16x8*)(Dw + 16 * hi) = bf[0]; *(bf16x8*)(Dw + 16 * hi + 8) = bf[1]; *(bf16x8*)(Dw + 32 + 16 * hi) = bf[2]; *(bf16x8*)(Dw + 32 + 16 * hi + 8) = bf[3]; }
    f32x16 n0 = up16(s.d[0], s.d[1]), n1 = up16(s.d[2], s.d[3]);
#pragma unroll
    for (int s2 = 0; s2 < 4; ++s2) { n0 = __builtin_amdgcn_mfma_f32_32x32x16_bf16(s.ta[0][s2], bf[s2], n0, 0, 0, 0); n1 = __builtin_amdgcn_mfma_f32_32x32x16_bf16(s.ta[1][s2], bf[s2], n1, 0, 0, 0); }
    X0 = n0; X1 = n1;
}
__device__ __forceinline__ void rwkv_scan(const Ctx& F, int b, int h, int half) {
    const int lane = F.lane, r32 = lane & 31, hi = lane >> 5, i = 32 * half + r32;
    const bf16_t* TTg = (const bf16_t*)(F.ws + WS_TT); bf16_t* Rg = (bf16_t*)(F.ws + WS_R);
    f32x16 X0, X1;
#pragma unroll
    for (int r = 0; r < 16; ++r) { X0[r] = 0.f; X1[r] = 0.f; }
    RwSet sA, sB, sC; const int c0 = b * 128;
    rw_load(sA, TTg, Rg, c0 + 0, h, i, r32, hi); rw_load(sB, TTg, Rg, c0 + 1, h, i, r32, hi); rw_load(sC, TTg, Rg, c0 + 2, h, i, r32, hi);
    for (int c = 0; c < 129; c += 3) {
        rw_step(X0, X1, sA, Rg, c0 + c, h, i, hi, true);          rw_load(sA, TTg, Rg, c0 + min(c + 3, 127), h, i, r32, hi);
        rw_step(X0, X1, sB, Rg, c0 + c + 1, h, i, hi, true);      rw_load(sB, TTg, Rg, c0 + min(c + 4, 127), h, i, r32, hi);
        rw_step(X0, X1, sC, Rg, c0 + min(c + 2, 127), h, i, hi, c + 2 < 128); rw_load(sC, TTg, Rg, c0 + min(c + 5, 127), h, i, r32, hi);
    }
}
__device__ __forceinline__ void ssd_scan(const Ctx& F, int item) {
    const int b = item >> 4, h = (item >> 1) & 7, hp = item & 1, g = h >> 2, hl = h & 3;
    const int piece = hp * 512 + F.tid;
    const int f = hl * 8192 + piece * 8, row = f >> 9, col = ssd_win_col(g, f & 511);
    bf16_t* ST = (bf16_t*)(F.ws + WS_XBC); const float* CDEC = (const float*)(F.ws + WS_CDEC);
    float st[8];
#pragma unroll
    for (int j = 0; j < 8; ++j) st[j] = 0.f;
    for (int c8 = 0; c8 < 128; c8 += 8) {
        u32x4 v[8]; float cd[8];
#pragma unroll
        for (int u = 0; u < 8; ++u) { const int cg_ = b * 128 + c8 + u; v[u] = *(const u32x4*)(ST + ((size_t)64 * cg_ + row) * 1024 + col); cd[u] = CDEC[cg_ * 8 + h]; }
#pragma unroll
        for (int u = 0; u < 8; ++u) { const int cg_ = b * 128 + c8 + u;
            u32x4 o; o.x = pk2(st[0], st[1]); o.y = pk2(st[2], st[3]); o.z = pk2(st[4], st[5]); o.w = pk2(st[6], st[7]);
            *(u32x4*)(ST + ((size_t)64 * cg_ + row) * 1024 + col) = o;
            const float x[8] = {bflo(v[u].x), bfhi(v[u].x), bflo(v[u].y), bfhi(v[u].y), bflo(v[u].z), bfhi(v[u].z), bflo(v[u].w), bfhi(v[u].w)};
#pragma unroll
            for (int j = 0; j < 8; ++j) st[j] = st[j] * cd[u] + x[j]; }
    }
}
__device__ __forceinline__ void p4_mix(const Ctx& F, int what = 3) {
    if (F.bid < 128) { if (!(what & 1)) return;
        const int b = F.bid >> 6, c = F.bid & 63;
        attn_unit(F, b, 127 - c); __syncthreads(); attn_unit(F, b, c);
    } else if (F.bid < 160) { if ((what & 2) && !(what & 8) && F.wave == 0) { const int task = F.bid - 128; rwkv_scan(F, task >> 4, (task >> 1) & 7, task & 1); }
    } else if (F.bid < 192) { if ((what & 2) && !(what & 4)) ssd_scan(F, F.bid - 160); }
}
__device__ __forceinline__ void p5_assemble(const Ctx& F, int l) {
    bf16_t* GT = (bf16_t*)(F.ws + WS_GATES);
    {   pg8::Gemm g{(const bf16_t*)(F.ws + WS_OL), (const bf16_t*)(F.ws + WS_WUV), NT, 512, 512, 512, 512}; pg8::StaticOrder S; S.init(NT, 512, F.G, F.bid); EpiUV E{GT};
        pg8::gemm_phase<EpiUV, pg8::StaticOrder, true, true>(F.lds, F.wave, g, S, E); }
    __syncthreads();
    int lane = fresh_lane(); const int tid = F.wave * 64 + lane, wave = F.wave;
    const int gw = F.bid * NWAVES + F.wave, NGW = F.G * NWAVES;
    {   constexpr int O_CG = 0, O_PV = 17408, O_YL = 34816;
        const bf16_t* Cbuf = (const bf16_t*)(F.ws + WS_CB); const float* ECUM = (const float*)(F.ws + WS_ECUM); const bf16_t* ST = (const bf16_t*)(F.ws + WS_XBC); const bf16_t* YD = (const bf16_t*)(F.ws + WS_YD);
        const float* snw = INP(I_SSDNW) + l * 512;
        for (int c = F.bid; c < NCHK; c += F.G) {
            const size_t m0 = (size_t)64 * c;
            for (int g = 0; g < 2; ++g) {
                {   LAS bf16_t* Cg = (LAS bf16_t*)(F.lds + O_CG);
#pragma unroll
                    for (int i = 0; i < 2; ++i) { const int idx = tid + 512 * i, t = idx >> 4, c8 = idx & 15; *(LAS u32x4*)(Cg + t * 136 + c8 * 8) = *(const u32x4*)(Cbuf + (m0 + t) * 256 + g * 128 + c8 * 8); } }
                for (int hl = 0; hl < 4; ++hl) { const int h = 4 * g + hl;
                    {   LAS bf16_t* Pv = (LAS bf16_t*)(F.lds + O_PV);
#pragma unroll
                        for (int i = 0; i < 2; ++i) { const int idx = tid + 512 * i, pp = idx >> 4, c8 = idx & 15; const int f = hl * 8192 + pp * 128 + c8 * 8, row = f >> 9, col = ssd_win_col(g, f & 511);
                            *(LAS u32x4*)(Pv + pp * 136 + c8 * 8) = *(const u32x4*)(ST + (m0 + row) * 1024 + col); } }
                    __syncthreads();
                    {   LAS bf16_t* Cg = (LAS bf16_t*)(F.lds + O_CG); LAS bf16_t* Pv = (LAS bf16_t*)(F.lds + O_PV); LAS bf16_t* YL = (LAS bf16_t*)(F.lds + O_YL);
#pragma unroll
                        for (int i = 0; i < 2; ++i) { const int idx = 2 * wave + i, ti = idx >> 2, pi = idx & 3;
                            const f32x4 acc = mma_tile<128>(Cg + ti * 16 * 136, 136, Pv + pi * 16 * 136, 136, lane);
#pragma unroll
                            for (int r = 0; r < 4; ++r) { const int t = ti * 16 + 4 * (lane >> 4) + r, pp = pi * 16 + (lane & 15);
                                const float y = bf2f(YD[(m0 + t) * 512 + 64 * h + pp]) + acc[r] * ECUM[(size_t)(c * 8 + h) * 64 + t];
                                const float z = bf2f(GT[(m0 + t) * 1536 + 512 + 64 * h + pp]);
                                YL[t * 520 + 64 * h + pp] = (bf16_t)f2bf(y * siluf_(z)); } } }
                    __syncthreads();
                }
            }
            {   LAS bf16_t* YL = (LAS bf16_t*)(F.lds + O_YL);
#pragma unroll
                for (int rr = 0; rr < 8; ++rr) { const int t = 8 * wave + rr; const u32x4 w = *(const LAS u32x4*)(YL + t * 520 + 8 * lane);
                    const float v[8] = {bflo(w.x), bfhi(w.x), bflo(w.y), bfhi(w.y), bflo(w.z), bfhi(w.z), bflo(w.w), bfhi(w.w)};
                    float q = 0.f;
#pragma unroll
                    for (int j = 0; j < 8; ++j) q += v[j] * v[j];
                    const float rs = 1.f / sqrtf(wave_sum(q) * (1.f / 512.f) + EPS);
                    const f32x4 w0 = *(const f32x4*)(snw + 8 * lane), w1 = *(const f32x4*)(snw + 8 * lane + 4);
                    u32x4 o; o.x = pk2(v[0] * rs * w0[0], v[1] * rs * w0[1]); o.y = pk2(v[2] * rs * w0[2], v[3] * rs * w0[3]); o.z = pk2(v[4] * rs * w1[0], v[5] * rs * w1[1]); o.w = pk2(v[6] * rs * w1[2], v[7] * rs * w1[3]);
                    *(u32x4*)(GT + (m0 + t) * 1536 + 512 + 8 * lane) = o; } }
            __syncthreads();
        }
    }
    LAS float* SW = (LAS float*)(F.lds + F.wave * 16640);
    const bf16_t* Yt = (const bf16_t*)(F.ws + WS_K); const bf16_t* SF = (const bf16_t*)(F.ws + WS_R); const bf16_t* QEg = (const bf16_t*)(F.ws + WS_QE);
    const bf16_t* BON = (const bf16_t*)(F.ws + WS_V); const float* lw = INP(I_LNXW) + l * 512; const float* lb = INP(I_LNXB) + l * 512;
    for (int w = gw; w < NCHK * 8; w += NGW) {
        asm volatile("" : "+v"(lane));
        const int cg_ = w >> 3, h = w & 7, r32 = lane & 31, hi = lane >> 5; const size_t m0 = (size_t)64 * cg_;
        const bf16_t* QEw = QEg + (size_t)(cg_ * 8 + h) * 4096;
        bf16x8 qa[2][4];
#pragma unroll
        for (int tb = 0; tb < 2; ++tb)
#pragma unroll
            for (int s2 = 0; s2 < 4; ++s2) qa[tb][s2] = *(const bf16x8*)(QEw + (32 * tb + r32) * 64 + 16 * s2 + 8 * hi);
#pragma unroll
        for (int ih = 0; ih < 2; ++ih) { const size_t ro = (m0 + 32 * ih + r32) * 512 + h * 64;
            const bf16x8 bf[4] = {*(const bf16x8*)(SF + ro + 16 * hi), *(const bf16x8*)(SF + ro + 16 * hi + 8), *(const bf16x8*)(SF + ro + 32 + 16 * hi), *(const bf16x8*)(SF + ro + 32 + 16 * hi + 8)};
#pragma unroll
            for (int tb = 0; tb < 2; ++tb) { f32x16 y = ld16bf(Yt + ro + 32 * tb + 16 * hi);
#pragma unroll
                for (int s2 = 0; s2 < 4; ++s2) y = __builtin_amdgcn_mfma_f32_32x32x16_bf16(qa[tb][s2], bf[s2], y, 0, 0, 0);
#pragma unroll
                for (int r = 0; r < 16; ++r) SW[(32 * tb + crow(r, hi)) * 65 + 32 * ih + r32] = y[r]; } }
        LDS_WAIT();
        {   float y[64]; float sm = 0.f;
#pragma unroll
            for (int i = 0; i < 64; ++i) { y[i] = SW[lane * 65 + i]; sm += y[i]; }
            const float mean = sm * (1.f / 64.f); float q = 0.f;
#pragma unroll
            for (int i = 0; i < 64; ++i) { y[i] -= mean; q += y[i] * y[i]; }
            const float rs = 1.f / sqrtf(q * (1.f / 64.f) + GN_EPS);
#pragma unroll
            for (int i = 0; i < 64; ++i) SW[lane * 65 + i] = y[i] * rs; }
        LDS_WAIT();
#pragma unroll
        for (int it = 0; it < 8; ++it) { const int t = it * 8 + (lane >> 3), i0 = (lane & 7) * 8; const size_t row = m0 + t;
            const u32x4 bw = *(const u32x4*)(BON + row * 512 + h * 64 + i0); u32x4* gp = (u32x4*)(GT + row * 1536 + 1024 + h * 64 + i0); const u32x4 gv = *gp;
            const float bo[8] = {bflo(bw.x), bfhi(bw.x), bflo(bw.y), bfhi(bw.y), bflo(bw.z), bfhi(bw.z), bflo(bw.w), bfhi(bw.w)};
            const float gg[8] = {bflo(gv.x), bfhi(gv.x), bflo(gv.y), bfhi(gv.y), bflo(gv.z), bfhi(gv.z), bflo(gv.w), bfhi(gv.w)};
            float ov[8];
#pragma unroll
            for (int j = 0; j < 8; ++j) ov[j] = (SW[t * 65 + i0 + j] * lw[h * 64 + i0 + j] + lb[h * 64 + i0 + j] + bo[j]) * siluf_(gg[j]);
            u32x4 o; o.x = pk2(ov[0], ov[1]); o.y = pk2(ov[2], ov[3]); o.z = pk2(ov[4], ov[5]); o.w = pk2(ov[6], ov[7]); *gp = o; }
        LDS_WAIT();
    }
}
__device__ __forceinline__ void p7_final(const Ctx& F) {
    const int gw = F.bid * NWAVES + F.wave, NGW = F.G * NWAVES; const float* fw = INP(I_FNW);
    for (int m = gw; m < NT; m += NGW) {
        f32x4* xr = (f32x4*)(F.out + (size_t)m * DM) + F.lane; f32x4 v[4]; float s = 0.f;
#pragma unroll
        for (int j = 0; j < 4; ++j) { v[j] = xr[64 * j]; s += v[j].x * v[j].x + v[j].y * v[j].y + v[j].z * v[j].z + v[j].w * v[j].w; }
        const float rstd = 1.f / sqrtf(wave_sum(s) * (1.f / DM) + EPS);
#pragma unroll
        for (int j = 0; j < 4; ++j) xr[64 * j] = v[j] * rstd * *(const f32x4*)(fw + 4 * F.lane + 256 * j);
    }
}

#define LAYER(l) do { \
        const int pb = 1 + 8 * l; \
        if (IN(pb + 0)) { PHB(); if (l == 1) prep_weights(F, 1); p1_norm(F, l); SEAM(pb + 0); } \
        if (IN(pb + 1)) { PHB(); \
            pg8::Gemm g{(const bf16_t*)(F.ws + WS_XN), (const bf16_t*)(F.ws + WS_WIN), NT, NIN, DM, DM, DM}; pg8::StaticOrder S; S.init(NT, NIN, F.G, F.bid); \
            EpiIn E{F.ws, l}; \
            pg8::gemm_phase<EpiIn, pg8::StaticOrder, true, true>(F.lds, F.wave, g, S, E); \
            SEAM(pb + 1); \
        } \
        if (IN(pb + 2)) { PHB(); \
            pg8::Gemm g{(const bf16_t*)(F.ws + WS_QLAT), (const bf16_t*)(F.ws + WS_WQ), NT, 768, 256, 256, 256}; pg8::StaticOrder S; S.init(NT, 768, F.G, F.bid); \
            EpiQ E{F.ws, l}; \
            pg8::gemm_phase<EpiQ, pg8::StaticOrder, true, true>(F.lds, F.wave, g, S, E); \
            p3a_extras(F, l); \
            SEAM(pb + 2); \
        } \
        if (IN(pb + 3)) { PHB(); p3b_ssd(F, l); SEAM(pb + 3); } \
        if (IN(pb + 4)) { PHB(); p3c_rwkv(F, l); SEAM(pb + 4); } \
        if (IN(pb + 5)) { PHB(); p4_mix(F); SEAM(pb + 5); } \
        if (IN(pb + 6)) { PHB(); p5_assemble(F, l); SEAM(pb + 6); } \
        if (IN(pb + 7)) { PHB(); \
            pg8::Gemm g{(const bf16_t*)(F.ws + WS_GATES), (const bf16_t*)(F.ws + WS_WOUT), NT, DM, 1536, 1536, 1536}; pg8::StaticOrder S; S.init(NT, DM, F.G, F.bid); \
            EpiOut E{(l == 0) ? INP(I_X) : F.out, F.out, (const float*)(F.ws + WS_CTL + CTL_MOD) + (size_t)(l * 2) * 3072 + 2048}; \
            pg8::gemm_phase<EpiOut, pg8::StaticOrder, true, true>(F.lds, F.wave, g, S, E); \
            SEAM(pb + 7); \
        } \
    } while (0)
__global__ void __launch_bounds__(NTHR, 2) mk_fwd(Args args) {
    extern __shared__ __attribute__((aligned(16))) unsigned char lds_raw[];
    Ctx F; F.lds = (LAS unsigned char*)lds_raw; F.tid = threadIdx.x; F.lane = F.tid & 63; F.wave = __builtin_amdgcn_readfirstlane(F.tid >> 6);
    F.G = gridDim.x; F.bid = blockIdx.x; F.ws = args.ws; F.out = args.out; F.in = args.in;
    const int wave0 = F.wave;
    cg::grid_group grid = cg::this_grid();
#if MK_PER_PHASE
    const int lo = args.ph_lo, hi = args.ph_hi;
#else
    constexpr int lo = 0, hi = 18;
#endif
#ifndef MK_ONLY
#define MK_ONLY -1
#endif
#define IN(k) (lo <= (k) && (k) < hi && (MK_ONLY < 0 || MK_ONLY == ((k) == 0 ? 0 : (k) == 17 ? 17 : 1 + ((k) - 1) % 8)))
#define SEAM(k) do { if (IN((k) + 1)) grid.sync(); } while (0)
#define PHB() do { int b_ = blockIdx.x, g_ = gridDim.x, v_ = wave0; asm volatile("" : "+s"(b_), "+s"(g_), "+s"(v_)); F.bid = b_; F.G = g_; F.wave = v_; int t_ = v_ * 64 + (int)__builtin_amdgcn_mbcnt_hi(~0u, __builtin_amdgcn_mbcnt_lo(~0u, 0u)); asm volatile("; PHASE_MARK %0" : "+v"(t_)); F.tid = t_; F.lane = t_ & 63; GAS unsigned char* w_ = (GAS unsigned char*)args.ws; GAS float* o_ = (GAS float*)args.out; asm volatile("" : "+s"(w_), "+s"(o_)); F.ws = (unsigned char*)w_; F.out = (float*)o_; } while (0)
    if (IN(0)) { PHB(); p0_prologue(F); SEAM(0); }
    LAYER(0);
    LAYER(1);
    if (IN(17)) { PHB(); p7_final(F); }
#ifndef MK_RERUN
#define MK_RERUN 0
#endif
#define PHB2() do { int b_ = blockIdx.x, g_ = gridDim.x, v_ = wave0; asm volatile("" : "+s"(b_), "+s"(g_), "+s"(v_)); F.bid = b_; F.G = g_; F.wave = v_; int t_ = v_ * 64 + fresh_lane(); F.tid = t_; F.lane = t_ & 63; } while (0)
#if MK_RERUN
    { constexpr int l = 1;
    if (MK_RERUN & 1) { grid.sync(); PHB2(); p1_norm(F, l); }
    if (MK_RERUN & 2) { grid.sync(); PHB2(); pg8::Gemm g{(const bf16_t*)(F.ws + WS_XN), (const bf16_t*)(F.ws + WS_WIN), NT, NIN, DM, DM, DM}; pg8::StaticOrder S; S.init(NT, NIN, F.G, F.bid); EpiIn E{F.ws, l}; pg8::gemm_phase<EpiIn, pg8::StaticOrder, true, true>(F.lds, F.wave, g, S, E); }
    if (MK_RERUN & 4) { grid.sync(); PHB2(); pg8::Gemm g{(const bf16_t*)(F.ws + WS_QLAT), (const bf16_t*)(F.ws + WS_WQ), NT, 768, 256, 256, 256}; pg8::StaticOrder S; S.init(NT, 768, F.G, F.bid); EpiQ E{F.ws, l}; pg8::gemm_phase<EpiQ, pg8::StaticOrder, true, true>(F.lds, F.wave, g, S, E); p3a_extras(F, l); }
    if (MK_RERUN & 8) { grid.sync(); PHB2(); p3b_ssd(F, l); }
    if (MK_RERUN & 16) { grid.sync(); PHB2(); p3c_rwkv(F, l); }
    if (MK_RERUN & 32) { grid.sync(); PHB2(); p4_mix(F); }
    if (MK_RERUN & 512) { grid.sync(); PHB2(); p4_mix(F, 1); }
    if (MK_RERUN & 1024) { grid.sync(); PHB2(); p4_mix(F, 2); }
    if (MK_RERUN & 2048) { grid.sync(); PHB2(); p4_mix(F, 2 | 4); }
    if (MK_RERUN & 4096) { grid.sync(); PHB2(); p4_mix(F, 2 | 8); }
    if (MK_RERUN & 64) { grid.sync(); PHB2(); p5_assemble(F, l); }
    if (MK_RERUN & 128) { grid.sync(); PHB2(); pg8::Gemm g{(const bf16_t*)(F.ws + WS_GATES), (const bf16_t*)(F.ws + WS_WOUT), NT, DM, 1536, 1536, 1536}; pg8::StaticOrder S; S.init(NT, DM, F.G, F.bid);
        EpiOut E{INP(I_X), (float*)(F.ws + WS_XBC), (const float*)(F.ws + WS_CTL + CTL_MOD) + (size_t)(l * 2) * 3072 + 2048}; pg8::gemm_phase<EpiOut, pg8::StaticOrder, true, true>(F.lds, F.wave, g, S, E); }
    }
#endif
#undef IN
#undef SEAM
}
constexpr int N_PHASES = 18;

extern "C" void kernel_launch(void* const* d_in, const int* in_sizes, int n_in, void* d_out, int out_size, void* d_ws, size_t ws_size, hipStream_t stream) {
    static int grid = 0;
    if (grid == 0) {
        if (n_in != 31 || out_size != NT * DM || ws_size < WS_END) { fprintf(stderr, "kernel_launch: unexpected shapes (n_in %d, out %d, ws %zu)\n", n_in, out_size, ws_size); grid = -1; return; }
        int dev = 0, cus = 0, per_cu = 0;
        hipGetDevice(&dev); hipDeviceGetAttribute(&cus, hipDeviceAttributeMultiprocessorCount, dev);
        if (hipFuncSetAttribute((const void*)mk_fwd, hipFuncAttributeMaxDynamicSharedMemorySize, LDS_BYTES) != hipSuccess) { fprintf(stderr, "kernel_launch: hipFuncSetAttribute failed\n"); grid = -1; return; }
        hipOccupancyMaxActiveBlocksPerMultiprocessor(&per_cu, (const void*)mk_fwd, NTHR, LDS_BYTES);
        (void)hipGetLastError();
        if (per_cu < 1) per_cu = 1;
        grid = cus;
        fprintf(stderr, "kernel_launch: cus %d, occupancy query %d block(s)/CU, grid %d\n", cus, per_cu, grid);
    }
    if (grid < 0) return;
    hipMemsetAsync((char*)d_ws + WS_CTL, 0, CTL_BYTES, stream);
    Args a{};
    for (int i = 0; i < 31; ++i) a.in[i] = (const float*)d_in[i];
    a.out = (float*)d_out; a.ws = (unsigned char*)d_ws;
#if MK_PER_PHASE
    for (int p = 0; p < N_PHASES; ++p) { a.ph_lo = p; a.ph_hi = p + 1; hipLaunchKernelGGL(mk_fwd, dim3(grid), dim3(NTHR), LDS_BYTES, stream, a); }
#else
    a.ph_lo = 0; a.ph_hi = N_PHASES;
    void* params[] = {&a};
    hipError_t e = hipLaunchCooperativeKernel((const void*)mk_fwd, dim3(grid), dim3(NTHR), params, LDS_BYTES, stream);
    if (e != hipSuccess) fprintf(stderr, "kernel_launch: cooperative launch failed: %s\n", hipGetErrorString(e));
#endif
}
```

```cpp
#include <hip/hip_runtime.h>
#include <hip/hip_cooperative_groups.h>
#include <cstdio>
#include <cstdint>
namespace cg = cooperative_groups;

#define LAS __attribute__((address_space(3)))
#define GAS __attribute__((address_space(1)))
typedef unsigned short bf16_t;
typedef short bf16x8 __attribute__((ext_vector_type(8)));
typedef float f32x4 __attribute__((ext_vector_type(4)));
typedef float f32x2 __attribute__((ext_vector_type(2)));
typedef float f32x16 __attribute__((ext_vector_type(16)));
typedef unsigned u32x4 __attribute__((ext_vector_type(4)));
typedef unsigned u32x2 __attribute__((ext_vector_type(2)));
typedef short v4i16_t __attribute__((ext_vector_type(4)));

#ifndef MK_PER_PHASE
#define MK_PER_PHASE 0
#endif

namespace pg8 {
constexpr int BM = 256, BK = 64, HALF = 128, HTB = HALF * BK * 2, STAGE_BYTES = 8 * HTB, NXCD = 8, WGM = 8;
__host__ __device__ __forceinline__ int lds_byte(int r, int c) { const int st = (r >> 4) * 2 + (c >> 5), rr = r & 15, cc = c & 31, ob = rr * 64 + cc * 2; return st * 1024 + (ob ^ (((ob >> 9) & 1) << 5)); }
__host__ __device__ __forceinline__ void stage_rc(int b, int& R, int& C) { const int st = b / 1024, sb = b % 1024, swz = sb ^ (((sb >> 9) & 1) << 5); R = (st >> 1) * 16 + swz / 64; C = (st & 1) * 32 + (swz % 64) / 2; }
__host__ __device__ __forceinline__ int perm32(int rho) { const int n = rho >> 4, i = rho & 15; return 8 * (i >> 2) + 4 * n + (i & 3); }
struct Unit { int pm, pn; };
struct Gemm { const bf16_t* A; const bf16_t* Bt; int M, N, K, lda, ldb; };
struct StaticOrder {
    int nM, nN, nwg, G, c;
    __host__ __device__ void init(int M, int N, int G_, int c_) { nM = M / BM; nN = N / BM; nwg = nM * nN; G = G_; c = c_; }
    __host__ __device__ bool next(int i, Unit& u) const {
        const long L = (long)i * G + c; if (L >= nwg) return false;
        int wgid = (int)L; { const int q = nwg / NXCD, r = nwg % NXCD, xcd = wgid % NXCD, off = wgid / NXCD; wgid = (xcd < r ? xcd * (q + 1) : r * (q + 1) + (xcd - r) * q) + off; }
        const int nig = WGM * nN, gid = wgid / nig, fm = gid * WGM, gsz = (nM - fm) < WGM ? (nM - fm) : WGM;
        u.pm = fm + ((wgid % nig) % gsz); u.pn = (wgid % nig) / gsz; return true;
    }
};
template <class Epi, class Sched, bool ALIGN_EPI, bool SP2>
__device__ __forceinline__ void gemm_phase(LAS unsigned char* lds, int wave_id, const Gemm g, const Sched& S, const Epi& E) {
    int lane = (int)__builtin_amdgcn_mbcnt_hi(~0u, __builtin_amdgcn_mbcnt_lo(~0u, 0u)); asm volatile("" : "+v"(lane));
    const int wid = wave_id, tid = wid * 64 + lane, wr = wid >> 2, wc = wid & 3, fr = lane & 15, fq = lane >> 4;
    const int K = g.K, nt = K / BK;
    unsigned voffA[2], voffB[2];
#pragma unroll
    for (int i = 0; i < 2; ++i) { int R, C; stage_rc(tid * 16 + i * 8192, R, C); const int Rb = (R & ~31) + perm32(R & 31);
        voffA[i] = (unsigned)(R * g.lda + C) * 2u; voffB[i] = (unsigned)(Rb * g.ldb + C) * 2u; }
    const size_t kstep = (size_t)(BK * 2);
    const size_t hstepA = (size_t)HALF * g.lda * 2, hstepB = (size_t)HALF * g.ldb * 2;
    const size_t tstepA = 2 * hstepA, tstepB = 2 * hstepB;
    const unsigned ldsw = (unsigned)wid * 1024u, lds0 = (unsigned)(uintptr_t)lds;
    const int aoff = lds_byte(wr * 64 + fr, fq * 8), boff = lds_byte(wc * 32 + fr, fq * 8);
#define PG8_SA(b, h) (((b) * 2 + (h)) * HTB)
#define PG8_SB(b, h) ((4 + (b) * 2 + (h)) * HTB)
#define PG8_STAGE(bufoff, gbase, voff) do { _Pragma("unroll") for (int _i = 0; _i < 2; ++_i) { unsigned keep_; \
        asm volatile("s_mov_b32 %0, m0\n\ts_mov_b32 m0, %3\n\ts_nop 0\n\tglobal_load_lds_dwordx4 %1, %2\n\ts_mov_b32 m0, %0" : "=&s"(keep_) : "v"((voff)[_i]), "s"((const char*)(gbase)), "s"(lds0 + (unsigned)(bufoff) + ldsw + (unsigned)(_i * 8192)) : "memory"); } } while (0)
#define PG8_LDA(dst, b, h) do { _Pragma("unroll") for (int m = 0; m < 4; ++m) _Pragma("unroll") for (int k = 0; k < 2; ++k) dst[m][k] = *(const LAS bf16x8*)(lds + PG8_SA(b, h) + aoff + m * 2048 + k * 1024); } while (0)
#define PG8_LDB(dst, b, h) do { _Pragma("unroll") for (int n = 0; n < 2; ++n) _Pragma("unroll") for (int k = 0; k < 2; ++k) dst[n][k] = *(const LAS bf16x8*)(lds + PG8_SB(b, h) + boff + n * 2048 + k * 1024); } while (0)
#define PG8_MMA(ai, bj, At, Bt) do { __builtin_amdgcn_s_setprio(1); _Pragma("unroll") for (int m = 0; m < 4; ++m) _Pragma("unroll") for (int n = 0; n < 2; ++n) _Pragma("unroll") for (int k = 0; k < 2; ++k) \
        acc[ai][bj][m][n] = __builtin_amdgcn_mfma_f32_16x16x32_bf16(Bt[n][k], At[m][k], acc[ai][bj][m][n], 0, 0, 0); __builtin_amdgcn_s_setprio(0); } while (0)
#define PG8_WAIT_V(n) asm volatile("s_waitcnt vmcnt(" #n ")" ::: "memory")
#define PG8_WAIT_L(n) asm volatile("s_waitcnt lgkmcnt(" #n ")" ::: "memory")
#define PG8_BAR __builtin_amdgcn_s_barrier()
#define PG8_SCHED __builtin_amdgcn_sched_barrier(0)
    Unit cur, nxt; int ui = 0;
    if (!S.next(0, cur)) return;
    f32x4 acc[2][2][4][2];
#pragma unroll
    for (int a = 0; a < 2; ++a)
#pragma unroll
        for (int b = 0; b < 2; ++b)
#pragma unroll
            for (int m = 0; m < 4; ++m)
#pragma unroll
                for (int n = 0; n < 2; ++n) acc[a][b][m][n] = (f32x4){0.f, 0.f, 0.f, 0.f};
    bf16x8 At[4][2], B0[2][2], B1[2][2];
    const char* cA = (const char*)g.A + (size_t)cur.pm * tstepA; const char* cB = (const char*)g.Bt + (size_t)cur.pn * tstepB;
    if constexpr (SP2) {
        PG8_STAGE(PG8_SB(0, 0), cB, voffB); PG8_STAGE(PG8_SB(0, 1), cB + hstepB, voffB); PG8_STAGE(PG8_SA(0, 0), cA, voffA); PG8_STAGE(PG8_SA(0, 1), cA + hstepA, voffA);
        if (wr == 1) PG8_BAR;
        PG8_WAIT_V(2); PG8_BAR;
        PG8_STAGE(PG8_SB(1, 0), cB + kstep, voffB); PG8_STAGE(PG8_SA(1, 0), cA + kstep, voffA); PG8_STAGE(PG8_SB(1, 1), cB + hstepB + kstep, voffB);
        PG8_WAIT_V(6); PG8_BAR;
    } else {
        PG8_STAGE(PG8_SB(0, 0), cB, voffB); PG8_STAGE(PG8_SA(0, 0), cA, voffA); PG8_STAGE(PG8_SB(0, 1), cB + hstepB, voffB); PG8_STAGE(PG8_SA(0, 1), cA + hstepA, voffA);
        if (wr == 1) PG8_BAR;
        PG8_WAIT_V(4); PG8_BAR;
        PG8_STAGE(PG8_SB(1, 0), cB + kstep, voffB); PG8_STAGE(PG8_SA(1, 0), cA + kstep, voffA); PG8_STAGE(PG8_SB(1, 1), cB + hstepB + kstep, voffB);
        PG8_WAIT_V(6); PG8_BAR;
    }
    for (;;) {
        const bool has_next = S.next(ui + 1, nxt);
        const char* nA = has_next ? (const char*)g.A + (size_t)nxt.pm * tstepA : cA; const char* nB = has_next ? (const char*)g.Bt + (size_t)nxt.pn * tstepB : cB;
        for (int t = 0; t < nt; t += 2) {
            const bool last = (t == nt - 2);
            const char* a1 = cA + (size_t)(t + 1) * kstep;
            const char* a2 = last ? nA : cA + (size_t)(t + 2) * kstep; const char* b2 = last ? nB : cB + (size_t)(t + 2) * kstep;
            const char* a3 = a2 + kstep; const char* b3 = b2 + kstep;
            if constexpr (SP2) {
            PG8_LDB(B0, 0, 0); PG8_LDB(B1, 0, 1); PG8_SCHED; PG8_LDA(At, 0, 0); PG8_STAGE(PG8_SA(1, 1), a1 + hstepA, voffA);
            PG8_WAIT_V(8); PG8_WAIT_L(0); PG8_BAR; PG8_MMA(0, 0, At, B0); PG8_MMA(0, 1, At, B1); PG8_BAR; PG8_SCHED;
            PG8_LDA(At, 0, 1); PG8_STAGE(PG8_SB(0, 0), b2, voffB); PG8_STAGE(PG8_SB(0, 1), b2 + hstepB, voffB); PG8_STAGE(PG8_SA(0, 0), a2, voffA);
            PG8_WAIT_V(8); PG8_WAIT_L(0); PG8_BAR; PG8_MMA(1, 0, At, B0); PG8_MMA(1, 1, At, B1); PG8_BAR; PG8_SCHED;
            PG8_LDB(B0, 1, 0); PG8_LDB(B1, 1, 1); PG8_SCHED; PG8_LDA(At, 1, 0); PG8_STAGE(PG8_SA(0, 1), a2 + hstepA, voffA);
            PG8_WAIT_V(8); PG8_WAIT_L(0); PG8_BAR; PG8_MMA(0, 0, At, B0); PG8_MMA(0, 1, At, B1); PG8_BAR; PG8_SCHED;
            PG8_LDA(At, 1, 1); PG8_STAGE(PG8_SB(1, 0), b3, voffB); PG8_STAGE(PG8_SB(1, 1), b3 + hstepB, voffB); PG8_STAGE(PG8_SA(1, 0), a3, voffA);
            PG8_WAIT_V(8); PG8_WAIT_L(0); PG8_BAR; PG8_MMA(1, 0, At, B0); PG8_MMA(1, 1, At, B1); PG8_BAR; PG8_SCHED;
            } else {
            PG8_LDB(B0, 0, 0); PG8_SCHED; PG8_LDA(At, 0, 0); PG8_STAGE(PG8_SA(1, 1), a1 + hstepA, voffA);
            PG8_WAIT_L(8); PG8_BAR; PG8_WAIT_L(0); PG8_MMA(0, 0, At, B0); PG8_BAR; PG8_SCHED;
            PG8_LDB(B1, 0, 1); PG8_STAGE(PG8_SB(0, 0), b2, voffB);
            PG8_BAR; PG8_WAIT_L(0); PG8_MMA(0, 1, At, B1); PG8_BAR;
            PG8_LDA(At, 0, 1); PG8_STAGE(PG8_SA(0, 0), a2, voffA);
            PG8_BAR; PG8_WAIT_L(0); PG8_MMA(1, 0, At, B0); PG8_BAR; PG8_SCHED;
            PG8_STAGE(PG8_SB(0, 1), b2 + hstepB, voffB);
            PG8_WAIT_V(6); PG8_BAR; PG8_MMA(1, 1, At, B1); PG8_BAR;
            PG8_LDB(B0, 1, 0); PG8_SCHED; PG8_LDA(At, 1, 0); PG8_STAGE(PG8_SA(0, 1), a2 + hstepA, voffA);
            PG8_WAIT_L(8); PG8_BAR; PG8_WAIT_L(0); PG8_MMA(0, 0, At, B0); PG8_BAR; PG8_SCHED;
            PG8_LDB(B1, 1, 1); PG8_STAGE(PG8_SB(1, 0), b3, voffB);
            PG8_BAR; PG8_WAIT_L(0); PG8_MMA(0, 1, At, B1); PG8_BAR;
            PG8_LDA(At, 1, 1); PG8_STAGE(PG8_SA(1, 0), a3, voffA);
            PG8_BAR; PG8_WAIT_L(0); PG8_MMA(1, 0, At, B0); PG8_BAR; PG8_SCHED;
            PG8_STAGE(PG8_SB(1, 1), b3 + hstepB, voffB);
            PG8_WAIT_V(6); PG8_BAR; PG8_MMA(1, 1, At, B1); PG8_BAR;
            }
        }
        if constexpr (ALIGN_EPI) { if (wr == 0) PG8_BAR; }
        E(acc, cur, wr, wc, fr, fq);
        if (!has_next) break;
#pragma unroll
        for (int a = 0; a < 2; ++a)
#pragma unroll
            for (int b = 0; b < 2; ++b)
#pragma unroll
                for (int m = 0; m < 4; ++m)
#pragma unroll
                    for (int n = 0; n < 2; ++n) acc[a][b][m][n] = (f32x4){0.f, 0.f, 0.f, 0.f};
        cur = nxt; cA = nA; cB = nB; ++ui;
        if constexpr (ALIGN_EPI) { if (wr == 1) PG8_BAR; }
    }
    PG8_WAIT_V(0);
    if constexpr (!ALIGN_EPI) { if (wr == 0) PG8_BAR; }
    PG8_BAR;
#undef PG8_SA
#undef PG8_SB
#undef PG8_STAGE
#undef PG8_LDA
#undef PG8_LDB
#undef PG8_MMA
#undef PG8_WAIT_V
#undef PG8_WAIT_L
#undef PG8_BAR
#undef PG8_SCHED
}
}

constexpr int NT = 16384, SEQ = 8192, DM = 1024, DIN = 4680, NIN = 4864, NCHK = 256, NWAVES = 8, NTHR = 512;
constexpr float EPS = 1e-6f, GN_EPS = 64e-5f, DECAY_SCALE = 0.606531f;
constexpr float QSCALE = 0.07216878364870322f * 1.4426950408889634f;
constexpr size_t MiB = 1u << 20;
constexpr size_t WS_CTL = 0, CTL_BYTES = 1 * MiB;
constexpr size_t CTL_MOD = 65536;
constexpr size_t CTL_SSQ = 131072;
constexpr size_t WS_WIN = 1 * MiB;
constexpr size_t WS_CB = WS_WIN, WS_ECUM = WS_WIN + 8 * MiB, WS_CDEC = WS_ECUM + 512 * 1024;
constexpr size_t WS_WQ = 10 * MiB + 512 * 1024;
constexpr size_t WS_WUV = 11 * MiB;
constexpr size_t WS_WLW = 11 * MiB + 512 * 1024;
constexpr size_t WS_WLA = WS_WLW + 65536;
constexpr size_t WS_WOUT = 12 * MiB;
constexpr size_t WS_XN = 15 * MiB;
constexpr size_t WS_TT = WS_XN, WS_QE = WS_XN + 16 * MiB;
constexpr size_t WS_QLAT = 47 * MiB, WS_KVL = 55 * MiB;
constexpr size_t WS_OL = WS_QLAT;
constexpr size_t WS_GATES = 63 * MiB;
constexpr size_t WS_XBC = 111 * MiB;
constexpr size_t WS_R = 143 * MiB, WS_K = 159 * MiB, WS_V = 175 * MiB;
constexpr size_t WS_F = 191 * MiB;
constexpr size_t WS_Q = 200 * MiB;
constexpr size_t WS_KVB = 224 * MiB;
constexpr size_t WS_YD = 230 * MiB;
constexpr size_t WS_ROPE = 246 * MiB;
constexpr size_t WS_HX = 250 * MiB;
constexpr size_t WS_HRKV = WS_HX + 1536 * 1024;
constexpr size_t WS_HF = WS_HRKV + 768 * 1024;
constexpr size_t WS_END = 253 * MiB;
constexpr int LDS_BYTES = 152 * 1024;

#define LDS_WAIT() asm volatile("s_waitcnt lgkmcnt(0)" ::: "memory")
__device__ __forceinline__ unsigned f2bf(float f) { unsigned u = __builtin_bit_cast(unsigned, f); return (u + 0x7fffu + ((u >> 16) & 1u)) >> 16; }
__device__ __forceinline__ unsigned pk2(float lo, float hi) { return f2bf(lo) | (f2bf(hi) << 16); }
__device__ __forceinline__ float bf2f(unsigned short b) { return __builtin_bit_cast(float, (unsigned)b << 16); }
__device__ __forceinline__ float bflo(unsigned w) { return __builtin_bit_cast(float, w << 16); }
__device__ __forceinline__ float bfhi(unsigned w) { return __builtin_bit_cast(float, w & 0xffff0000u); }
__device__ __forceinline__ float wave_sum(float v) {
#pragma unroll
    for (int o = 1; o < 64; o <<= 1) v += __shfl_xor(v, o);
    return v;
}
__device__ __forceinline__ float sigmoidf_(float x) { return 1.f / (1.f + __expf(-x)); }
__device__ __forceinline__ float siluf_(float x) { return x / (1.f + __expf(-x)); }
__device__ __forceinline__ int pi16(int n) { const int x = n & 15; return (n & ~15) | ((x >= 4 && x < 8) ? x + 4 : (x >= 8 && x < 12) ? x - 4 : x); }
__device__ __forceinline__ int sg32(int x) { return (x & ~31) | (16 * ((x >> 2) & 1) + 4 * ((x & 31) >> 3) + (x & 3)); }
__device__ __forceinline__ int crow(int r, int hi) { return (r & 3) + 8 * (r >> 2) + 4 * hi; }

template <int K> __device__ __forceinline__ f32x4 mma_tile(const LAS bf16_t* A, int lda, const LAS bf16_t* Bt, int ldb, int lane) {
    f32x4 acc = {0.f, 0.f, 0.f, 0.f};
    const LAS bf16_t* ap = A + (lane & 15) * lda + (lane >> 4) * 8;
    const LAS bf16_t* bp = Bt + (lane & 15) * ldb + (lane >> 4) * 8;
#pragma unroll
    for (int k = 0; k < K; k += 32) {
        const bf16x8 a = *(const LAS bf16x8*)(ap + k), b = *(const LAS bf16x8*)(bp + k);
        acc = __builtin_amdgcn_mfma_f32_16x16x32_bf16(a, b, acc, 0, 0, 0);
    }
    return acc;
}

struct Args {
    const float* in[31]; float* out; unsigned char* ws; int ph_lo, ph_hi;
};
struct Ctx {
    LAS unsigned char* lds; int tid, lane, wave, G, bid;
    unsigned char* ws; float* out;
    const float* const* in;
};
__device__ __forceinline__ const float* ldin(const float* const* in, int i) { asm volatile("" : "+s"(i)); return (const float*)(const GAS float*)in[i]; }
#define INP(i) ldin(F.in, i)
__device__ __forceinline__ int fresh_lane() { int l_ = (int)__builtin_amdgcn_mbcnt_hi(~0u, __builtin_amdgcn_mbcnt_lo(~0u, 0u)); asm volatile("" : "+v"(l_)); return l_; }
enum { I_X = 0, I_C, I_POS, I_ADAW, I_ADAB, I_NORMW, I_WIN, I_QNW, I_WUQ, I_KVNW, I_WUKV, I_CONVW, I_CONVB, I_DTB, I_ALOG, I_DSKIP, I_SSDNW,
       I_MURKV, I_MUW, I_MUA, I_W0, I_WLB, I_A0, I_ALB, I_KK, I_KA, I_RK, I_LNXW, I_LNXB, I_WOUT, I_FNW };

__device__ __forceinline__ int win_src_col(int n) {
    if (n < 448) return n;
    if (n < 512) return -1;
    if (n < 1024) return 448 + (n - 512);
    if (n < 1536) return 960 + (n - 1024);
    if (n < 2560) return 1472 + (n - 1536);
    if (n < 3072) return 2504 + (n - 2560);
    if (n < 3584) return 3016 + (n - 3072);
    if (n < 4096) return 3528 + (n - 3584);
    if (n < 4608) return 4168 + (n - 4096);
    if (n < 4672) return 4040 + (n - 4608);
    if (n < 4736) return 4104 + (n - 4672);
    if (n < 4744) return 2496 + (n - 4736);
    return -1;
}
template <class Src> __device__ __forceinline__ void transpose_item(const Src& src, bf16_t* WT, int ldw, LAS float* scr, int kb, int nb, int lane) {
    const int k0 = 64 * kb, n0 = 32 * nb;
#pragma unroll 8
    for (int i = 0; i < 32; ++i) { const int kk = 2 * i + (lane >> 5); scr[kk * 33 + (lane & 31)] = src(k0 + kk, n0 + (lane & 31)); }
    LDS_WAIT();
    const int c = lane & 7;
#pragma unroll
    for (int j = 0; j < 4; ++j) { const int n = (lane >> 3) + 8 * j; const LAS float* s = scr + (8 * c) * 33 + n;
        u32x4 o; o.x = pk2(s[0 * 33], s[1 * 33]); o.y = pk2(s[2 * 33], s[3 * 33]); o.z = pk2(s[4 * 33], s[5 * 33]); o.w = pk2(s[6 * 33], s[7 * 33]);
        *(u32x4*)(WT + (size_t)(n0 + n) * ldw + k0 + 8 * c) = o; }
    LDS_WAIT();
}
__device__ __forceinline__ void prep_weights(const Ctx& F, int l) {
    LAS float* scr = (LAS float*)(F.lds + F.wave * 8448);
    const int gw = F.bid * NWAVES + F.wave, NGW = F.G * NWAVES;
    const float* w_in = INP(I_WIN) + (size_t)l * DM * DIN;
    const float* w_out = INP(I_WOUT) + (size_t)l * 1536 * 1024;
    const float* wlb = INP(I_WLB) + (size_t)l * 64 * 512;
    const float* alb = INP(I_ALB) + (size_t)l * 64 * 512;
    bf16_t* WIN = (bf16_t*)(F.ws + WS_WIN); bf16_t* WOUT = (bf16_t*)(F.ws + WS_WOUT); bf16_t* WLW = (bf16_t*)(F.ws + WS_WLW); bf16_t* WLA = (bf16_t*)(F.ws + WS_WLA);
    constexpr int I_IN = 16 * (NIN / 32), I_OUT = 24 * 32, I_LW = 16, I_LA = 16, NITEMS = I_IN + I_OUT + I_LW + I_LA;
    for (int it = gw; it < NITEMS; it += NGW) {
        int r = it;
        if (r < I_IN) { const int kb = r / (NIN / 32), nb = r % (NIN / 32);
            transpose_item([&](int k, int n) { const int sc = win_src_col(n); return sc >= 0 ? w_in[(size_t)k * DIN + sc] : 0.f; }, WIN, 1024, scr, kb, nb, F.lane); continue; }
        r -= I_IN;
        if (r < I_OUT) { const int kb = r / 32, nb = r % 32;
            transpose_item([&](int k, int n) { return w_out[(size_t)k * 1024 + n]; }, WOUT, 1536, scr, kb, nb, F.lane); continue; }
        r -= I_OUT;
        if (r < I_LW) { transpose_item([&](int k, int n) { return wlb[k * 512 + n]; }, WLW, 64, scr, 0, r, F.lane); continue; }
        r -= I_LW;
        transpose_item([&](int k, int n) { return alb[k * 512 + n]; }, WLA, 64, scr, 0, r, F.lane);
    }
    const float* wuq = INP(I_WUQ) + (size_t)l * 256 * 768; const float* wukv = INP(I_WUKV) + (size_t)l * 128 * 1024; const float* qnw = INP(I_QNW) + l * 256;
    bf16_t* WQ = (bf16_t*)(F.ws + WS_WQ); bf16_t* WUV = (bf16_t*)(F.ws + WS_WUV);
    const int gt = F.bid * NTHR + F.tid, NGT = F.G * NTHR;
    for (int e = gt; e < 768 * 256; e += NGT) {
        const int n = e >> 8, k = e & 255, h = n / 192, idx = n % 192; float v;
        if (idx < 128) {
            const f32x4* a = (const f32x4*)(wuq + (size_t)k * 768 + h * 192); const f32x4* b = (const f32x4*)(wukv + (size_t)idx * 1024 + h * 256);
            float s = 0.f;
#pragma unroll 8
            for (int d = 0; d < 32; ++d) { const f32x4 x = a[d], y = b[d]; s += x.x * y.x + x.y * y.y + x.z * y.z + x.w * y.w; }
            v = s;
        } else v = wuq[(size_t)k * 768 + n];
        WQ[e] = (bf16_t)f2bf(v * qnw[k]);
    }
    for (int e = gt; e < 512 * 512; e += NGT) {
        const int n = e >> 9, k = e & 511, h = n >> 7, d = n & 127, h2 = k >> 7, c = k & 127;
        WUV[e] = (h == h2) ? (bf16_t)f2bf(wukv[(size_t)c * 1024 + h * 256 + 128 + d]) : (bf16_t)0;
    }
}
__device__ __forceinline__ void p0_prologue(const Ctx& F) {
    prep_weights(F, 0);
    const int gw = F.bid * NWAVES + F.wave, NGW = F.G * NWAVES;
    float* MOD = (float*)(F.ws + WS_CTL + CTL_MOD);
    for (int it = gw; it < 2 * 12 * 32; it += NGW) {
        const int l = it / 384, r = it % 384, cb = r / 32, ks = r % 32;
        const float* aw = INP(I_ADAW) + (size_t)l * DM * 3072 + (size_t)(ks * 32) * 3072 + cb * 256 + F.lane * 4;
        const float* cc = INP(I_C);
        f32x4 a0 = {0.f, 0.f, 0.f, 0.f}, a1 = a0;
#pragma unroll 8
        for (int k = 0; k < 32; ++k) { const f32x4 w = *(const f32x4*)(aw + (size_t)k * 3072); const float s0 = siluf_(cc[ks * 32 + k]), s1 = siluf_(cc[DM + ks * 32 + k]); a0 += w * s0; a1 += w * s1; }
        if (ks == 0) { const f32x4 bb = *(const f32x4*)(INP(I_ADAB) + l * 3072 + cb * 256 + F.lane * 4); a0 += bb; a1 += bb; }
        float* m0 = MOD + (size_t)(l * 2 + 0) * 3072 + cb * 256 + F.lane * 4; float* m1 = m0 + 3072;
#pragma unroll
        for (int j = 0; j < 4; ++j) { atomicAdd(m0 + j, a0[j]); atomicAdd(m1 + j, a1[j]); }
    }
    float* ROPE = (float*)(F.ws + WS_ROPE); const int* pos = (const int*)INP(I_POS);
    for (int e = F.bid * NTHR + F.tid; e < NT * 32; e += F.G * NTHR) {
        const int m = e >> 5, i = e & 31;
        const float invf = powf(10000.f, -(float)i / 32.f); const float ang = (float)pos[m] * invf;
        const double a = (double)ang; const double kq = __builtin_rint(a * 0.15915494309189535); const float rr = (float)(a - kq * 6.283185307179586);
        ROPE[(size_t)m * 64 + i] = cosf(rr); ROPE[(size_t)m * 64 + 32 + i] = sinf(rr);
    }
}
__device__ __forceinline__ void p1_norm(const Ctx& F, int l) {
    const float* xin = (l == 0) ? INP(I_X) : F.out;
    const float* nw = INP(I_NORMW) + l * DM; const float* MOD = (const float*)(F.ws + WS_CTL + CTL_MOD);
    bf16_t* XN = (bf16_t*)(F.ws + WS_XN);
    const int gw = F.bid * NWAVES + F.wave, NGW = F.G * NWAVES;
    for (int m = gw; m < NT; m += NGW) {
        const int b = m >> 13; const float* md = MOD + (size_t)(l * 2 + b) * 3072;
        const f32x4* xr = (const f32x4*)(xin + (size_t)m * DM) + F.lane;
        f32x4 v[4]; float s = 0.f;
#pragma unroll
        for (int j = 0; j < 4; ++j) { v[j] = xr[64 * j]; s += v[j].x * v[j].x + v[j].y * v[j].y + v[j].z * v[j].z + v[j].w * v[j].w; }
        const float rstd = 1.f / sqrtf(wave_sum(s) * (1.f / DM) + EPS);
        unsigned long long* o8 = (unsigned long long*)(XN + (size_t)m * DM) + F.lane;
#pragma unroll
        for (int j = 0; j < 4; ++j) { const int c0 = 4 * F.lane + 256 * j;
            const f32x4 w = *(const f32x4*)(nw + c0), sh = *(const f32x4*)(md + c0), sc = *(const f32x4*)(md + 1024 + c0);
            const f32x4 y = v[j] * rstd * w * (sc + 1.f) + sh;
            o8[64 * j] = (unsigned long long)pk2(y.x, y.y) | ((unsigned long long)pk2(y.z, y.w) << 32); }
    }
}
__device__ __forceinline__ u32x4 pack8(f32x4 a, f32x4 b) { u32x4 w; w.x = pk2(a[0], a[1]); w.y = pk2(a[2], a[3]); w.z = pk2(b[0], b[1]); w.w = pk2(b[2], b[3]); return w; }
struct EpiIn {
    unsigned char* ws; int l;
    __device__ __forceinline__ void operator()(const f32x4 (&acc)[2][2][4][2], const pg8::Unit& u, int wr, int wc, int fr, int fq) const {
        { int ln_ = (int)__builtin_amdgcn_mbcnt_hi(~0u, __builtin_amdgcn_mbcnt_lo(~0u, 0u)); asm volatile("" : "+v"(ln_)); fr = ln_ & 15; fq = ln_ >> 4; }
        const int pn = u.pn; size_t bo; int ld, c0;
        if (pn == 0) { bo = WS_QLAT; ld = 256; c0 = 0; } else if (pn == 1) { bo = WS_KVL; ld = 256; c0 = 0; }
        else if (pn < 4) { bo = WS_GATES; ld = 1536; c0 = (pn - 2) * 256; } else if (pn < 6) { bo = WS_GATES; ld = 1536; c0 = 512 + (pn - 4) * 256; }
        else if (pn < 10) { bo = WS_XBC; ld = 1024; c0 = (pn - 6) * 256; } else if (pn < 12) { bo = WS_R; ld = 512; c0 = (pn - 10) * 256; }
        else if (pn < 14) { bo = WS_K; ld = 512; c0 = (pn - 12) * 256; } else if (pn < 16) { bo = WS_V; ld = 512; c0 = (pn - 14) * 256; }
        else if (pn < 18) { bo = WS_GATES; ld = 1536; c0 = 1024 + (pn - 16) * 256; } else { bo = WS_F; ld = 144; c0 = 0; }
        bf16_t* base = (bf16_t*)(ws + bo); float* F = (float*)(ws + WS_F);
        float* ssq_q = (float*)(ws + WS_CTL + CTL_SSQ) + (size_t)(l * 2) * NT; float* ssq_kv = ssq_q + NT;
        const int row0 = u.pm * 256 + wr * 64 + fr, col0 = wc * 32 + 8 * fq;
        if (pn < 18) {
#pragma unroll
            for (int ai = 0; ai < 2; ++ai)
#pragma unroll
                for (int m = 0; m < 4; ++m) { const int row = row0 + ai * 128 + m * 16; bf16_t* rp = base + (size_t)row * ld + c0 + col0;
#pragma unroll
                    for (int bj = 0; bj < 2; ++bj) *(u32x4*)(rp + bj * 128) = pack8(acc[ai][bj][m][0], acc[ai][bj][m][1]);
                    if (pn < 2) { float s = 0.f;
#pragma unroll
                        for (int bj = 0; bj < 2; ++bj) if (pn == 0 || bj == 0) {
#pragma unroll
                            for (int n = 0; n < 2; ++n) { const f32x4 x = acc[ai][bj][m][n]; s += x[0] * x[0] + x[1] * x[1] + x[2] * x[2] + x[3] * x[3]; } }
                        s += __shfl_xor(s, 16); s += __shfl_xor(s, 32);
                        if (fq == 0) atomicAdd((pn == 0 ? ssq_q : ssq_kv) + row, s); } }
        } else {
#pragma unroll
            for (int ai = 0; ai < 2; ++ai)
#pragma unroll
                for (int m = 0; m < 4; ++m) { const int row = row0 + ai * 128 + m * 16;
#pragma unroll
                    for (int bj = 0; bj < 2; ++bj) { const int c = bj * 128 + col0; if (c < 136) { float* fp = F + (size_t)row * 144 + c; *(f32x4*)fp = acc[ai][bj][m][0]; *(f32x4*)(fp + 4) = acc[ai][bj][m][1]; } } }
        }
    }
};
struct EpiQ {
    unsigned char* ws; int l;
    __device__ __forceinline__ void operator()(const f32x4 (&acc)[2][2][4][2], const pg8::Unit& u, int wr, int wc, int fr, int fq) const {
        { int ln_ = (int)__builtin_amdgcn_mbcnt_hi(~0u, __builtin_amdgcn_mbcnt_lo(~0u, 0u)); asm volatile("" : "+v"(ln_)); fr = ln_ & 15; fq = ln_ >> 4; }
        bf16_t* Q = (bf16_t*)(ws + WS_Q); const float* ssq = (const float*)(ws + WS_CTL + CTL_SSQ) + (size_t)(l * 2) * NT;
        const int row0 = u.pm * 256 + wr * 64 + fr, c0 = u.pn * 256 + wc * 32 + 8 * fq;
#pragma unroll
        for (int ai = 0; ai < 2; ++ai)
#pragma unroll
            for (int m = 0; m < 4; ++m) { const int row = row0 + ai * 128 + m * 16; const float sc = QSCALE / sqrtf(ssq[row] * (1.f / 256.f) + EPS); bf16_t* qp = Q + (size_t)row * 768 + c0;
#pragma unroll
                for (int bj = 0; bj < 2; ++bj) *(u32x4*)(qp + bj * 128) = pack8(acc[ai][bj][m][0] * sc, acc[ai][bj][m][1] * sc); }
    }
};
struct EpiUV {
    bf16_t* gates;
    __device__ __forceinline__ void operator()(const f32x4 (&acc)[2][2][4][2], const pg8::Unit& u, int wr, int wc, int fr, int fq) const {
        { int ln_ = (int)__builtin_amdgcn_mbcnt_hi(~0u, __builtin_amdgcn_mbcnt_lo(~0u, 0u)); asm volatile("" : "+v"(ln_)); fr = ln_ & 15; fq = ln_ >> 4; }
        const int row0 = u.pm * 256 + wr * 64 + fr;
#pragma unroll
        for (int ai = 0; ai < 2; ++ai)
#pragma unroll
            for (int m = 0; m < 4; ++m) { asm volatile("" ::: "memory"); const int row = row0 + ai * 128 + m * 16;
#pragma unroll
                for (int bj = 0; bj < 2; ++bj) { const int c = u.pn * 256 + bj * 128 + wc * 32 + 8 * fq; u32x4* gp = (u32x4*)(gates + (size_t)row * 1536 + c); const u32x4 gw = *gp;
                    f32x4 v0 = acc[ai][bj][m][0], v1 = acc[ai][bj][m][1];
                    v0[0] *= siluf_(bflo(gw.x)); v0[1] *= siluf_(bfhi(gw.x)); v0[2] *= siluf_(bflo(gw.y)); v0[3] *= siluf_(bfhi(gw.y));
                    v1[0] *= siluf_(bflo(gw.z)); v1[1] *= siluf_(bfhi(gw.z)); v1[2] *= siluf_(bflo(gw.w)); v1[3] *= siluf_(bfhi(gw.w));
                    *gp = pack8(v0, v1); } }
    }
};
struct EpiOut {
    const float* xin; float* xout; const float* gate;
    __device__ __forceinline__ void operator()(const f32x4 (&acc)[2][2][4][2], const pg8::Unit& u, int wr, int wc, int fr, int fq) const {
        { int ln_ = (int)__builtin_amdgcn_mbcnt_hi(~0u, __builtin_amdgcn_mbcnt_lo(~0u, 0u)); asm volatile("" : "+v"(ln_)); fr = ln_ & 15; fq = ln_ >> 4; }
        const int row0 = u.pm * 256 + wr * 64 + fr;
#pragma unroll
        for (int bj = 0; bj < 2; ++bj) { const int c = u.pn * 256 + bj * 128 + wc * 32 + 8 * fq;
#pragma unroll
            for (int ai = 0; ai < 2; ++ai)
#pragma unroll
                for (int m = 0; m < 4; ++m) { const int row = row0 + ai * 128 + m * 16; const float* gp = gate + (size_t)(row >> 13) * 3072 + c;
                    const f32x4 g0 = *(const f32x4*)gp, g1 = *(const f32x4*)(gp + 4);
                    const size_t off = (size_t)row * DM + c; const f32x4 x0 = *(const f32x4*)(xin + off), x1 = *(const f32x4*)(xin + off + 4);
                    *(f32x4*)(xout + off) = x0 + g0 * acc[ai][bj][m][0]; *(f32x4*)(xout + off + 4) = x1 + g1 * acc[ai][bj][m][1]; } }
    }
};

__device__ __forceinline__ void p3a_extras(const Ctx& F, int l) {
    const int tid_ = F.wave * 64 + fresh_lane();
    const int gt = F.bid * NTHR + tid_, NGT = F.G * NTHR;
    const bf16_t* KVL = (const bf16_t*)(F.ws + WS_KVL); bf16_t* KVB = (bf16_t*)(F.ws + WS_KVB);
    const float* ssq = (const float*)(F.ws + WS_CTL + CTL_SSQ) + (size_t)(l * 2 + 1) * NT; const float* kvnw = INP(I_KVNW) + l * 128;
    const float* ROPE = (const float*)(F.ws + WS_ROPE);
    for (int e = gt; e < NT * 24; e += NGT) {
        const int m = e / 24, g = e % 24;
        if (g < 16) {
            const u32x4 w = *(const u32x4*)(KVL + (size_t)m * 256 + 8 * g); const float rs = 1.f / sqrtf(ssq[m] * (1.f / 128.f) + EPS);
            const f32x4 n0 = *(const f32x4*)(kvnw + 8 * g), n1 = *(const f32x4*)(kvnw + 8 * g + 4);
            u32x4 o; o.x = pk2(bflo(w.x) * rs * n0[0], bfhi(w.x) * rs * n0[1]); o.y = pk2(bflo(w.y) * rs * n0[2], bfhi(w.y) * rs * n0[3]);
            o.z = pk2(bflo(w.z) * rs * n1[0], bfhi(w.z) * rs * n1[1]); o.w = pk2(bflo(w.w) * rs * n1[2], bfhi(w.w) * rs * n1[3]);
            *(u32x4*)(KVB + (size_t)m * 192 + 8 * g) = o;
        } else {
            const int i0 = 4 * (g - 16);
            const u32x2 a = *(const u32x2*)(KVL + (size_t)m * 256 + 128 + i0), b = *(const u32x2*)(KVL + (size_t)m * 256 + 160 + i0);
            const f32x4 cs = *(const f32x4*)(ROPE + (size_t)m * 64 + i0), sn = *(const f32x4*)(ROPE + (size_t)m * 64 + 32 + i0);
            const f32x4 x1 = {bflo(a.x), bfhi(a.x), bflo(a.y), bfhi(a.y)}, x2 = {bflo(b.x), bfhi(b.x), bflo(b.y), bfhi(b.y)};
            const f32x4 o1 = x1 * cs - x2 * sn, o2 = x1 * sn + x2 * cs;
            u32x2 w1, w2; w1.x = pk2(o1[0], o1[1]); w1.y = pk2(o1[2], o1[3]); w2.x = pk2(o2[0], o2[1]); w2.y = pk2(o2[2], o2[3]);
            *(u32x2*)(KVB + (size_t)m * 192 + 128 + i0) = w1; *(u32x2*)(KVB + (size_t)m * 192 + 160 + i0) = w2;
        }
    }
    const u32x4* XBC = (const u32x4*)(F.ws + WS_XBC); u32x4* HX = (u32x4*)(F.ws + WS_HX);
    for (int e = gt; e < NCHK * 3 * 128; e += NGT) { const int c = e / 384, r = e % 384, j = r >> 7, p = r & 127; HX[e] = XBC[(size_t)(64 * c + 61 + j) * 128 + p]; }
    u32x4* HR = (u32x4*)(F.ws + WS_HRKV);
    for (int e = gt; e < 3 * NCHK * 64; e += NGT) { const int w = e / (NCHK * 64), r = e % (NCHK * 64), c = r >> 6, p = r & 63;
        const u32x4* src = (const u32x4*)(F.ws + (w == 0 ? WS_R : w == 1 ? WS_K : WS_V)); HR[e] = src[(size_t)(64 * c + 63) * 64 + p]; }
    const f32x4* FF = (const f32x4*)(F.ws + WS_F); f32x4* HF = (f32x4*)(F.ws + WS_HF);
    for (int e = gt; e < NCHK * 32; e += NGT) { const int c = e >> 5, p = e & 31; HF[e] = FF[(size_t)(64 * c + 63) * 36 + p]; }
}

__device__ __forceinline__ int ssd_win_col(int g, int o) { return o < 256 ? 256 * g + o : o < 384 ? 512 + 128 * g + (o - 256) : 768 + 128 * g + (o - 384); }
__device__ __forceinline__ void p3b_ssd(const Ctx& F, int l) {
    constexpr int SC_C = 0, SC_B = 17408, SC_BT = 34816, SC_XST = 53248, SC_CB = 90112, SC_G = 106752, SC_XSD = 115968, SC_DT = 125184, SC_AC = 127232;
    LAS bf16_t* Cg = (LAS bf16_t*)(F.lds + SC_C); LAS bf16_t* Bg = (LAS bf16_t*)(F.lds + SC_B); LAS bf16_t* BT = (LAS bf16_t*)(F.lds + SC_BT);
    LAS bf16_t* XST = (LAS bf16_t*)(F.lds + SC_XST); LAS float* CB = (LAS float*)(F.lds + SC_CB); LAS bf16_t* Gh = (LAS bf16_t*)(F.lds + SC_G);
    LAS bf16_t* XSD = (LAS bf16_t*)(F.lds + SC_XSD); LAS float* DT = (LAS float*)(F.lds + SC_DT); LAS float* AC = (LAS float*)(F.lds + SC_AC);
    bf16_t* XBC = (bf16_t*)(F.ws + WS_XBC); const bf16_t* HX = (const bf16_t*)(F.ws + WS_HX); const float* Ff = (const float*)(F.ws + WS_F);
    bf16_t* Cbuf = (bf16_t*)(F.ws + WS_CB); float* ECUM = (float*)(F.ws + WS_ECUM); float* CDEC = (float*)(F.ws + WS_CDEC); bf16_t* YD = (bf16_t*)(F.ws + WS_YD);
    const float* convw = INP(I_CONVW) + (size_t)l * 4 * 1024; const float* convb = INP(I_CONVB) + l * 1024;
    const float* dtb = INP(I_DTB) + l * 8; const float* alog = INP(I_ALOG) + l * 8; const float* dskip = INP(I_DSKIP) + l * 8;
    const int tid = F.tid, lane = F.lane, wave = F.wave;
    for (int c = F.bid; c < NCHK; c += F.G) {
        const int m0 = 64 * c; const bool first = (c & 127) == 0;
        if (wave == 0) {
            const int t = lane;
#pragma unroll
            for (int h = 0; h < 8; ++h) {
                const float raw = Ff[(size_t)(m0 + t) * 144 + 128 + h] + dtb[h];
                const float dt = raw > 20.f ? raw : log1pf(expf(raw));
                float v = dt * (-expf(alog[h]));
#pragma unroll
                for (int o = 1; o < 64; o <<= 1) { const float y = __shfl_up(v, o); if (lane >= o) v += y; }
                DT[t * 8 + h] = dt; AC[t * 8 + h] = v;
                const float ev = expf(v); ECUM[(size_t)(c * 8 + h) * 64 + t] = ev; if (t == 63) CDEC[c * 8 + h] = ev;
            }
        }
        for (int g = 0; g < 2; ++g) {
            {
                const int col = ssd_win_col(g, tid);
                const float w0 = convw[col], w1 = convw[1024 + col], w2 = convw[2048 + col], w3 = convw[3072 + col], cb = convb[col];
                float h0 = 0.f, h1 = 0.f, h2 = 0.f;
                if (!first) { h0 = bf2f(HX[(size_t)((c - 1) * 3 + 0) * 1024 + col]); h1 = bf2f(HX[(size_t)((c - 1) * 3 + 1) * 1024 + col]); h2 = bf2f(HX[(size_t)((c - 1) * 3 + 2) * 1024 + col]); }
#pragma unroll 8
                for (int t = 0; t < 64; ++t) {
                    const float x = bf2f(XBC[(size_t)(m0 + t) * 1024 + col]);
                    const float u = w0 * h0 + w1 * h1 + w2 * h2 + w3 * x + cb; h0 = h1; h1 = h2; h2 = x;
                    const bf16_t bv = (bf16_t)f2bf(siluf_(u));
                    if (tid < 256) XST[tid * 72 + t] = bv;
                    else if (tid < 384) { const int n = tid - 256; Bg[t * 136 + n] = bv; BT[n * 72 + t] = bv; }
                    else { const int n = tid - 384; Cg[t * 136 + n] = bv; Cbuf[(size_t)(m0 + t) * 256 + g * 128 + n] = bv; }
                }
            }
            __syncthreads();
#pragma unroll
            for (int i = 0; i < 2; ++i) { const int idx = 2 * wave + i, ti = idx >> 2, si = idx & 3;
                const f32x4 acc = mma_tile<128>(Cg + ti * 16 * 136, 136, Bg + si * 16 * 136, 136, lane);
#pragma unroll
                for (int r = 0; r < 4; ++r) CB[(ti * 16 + 4 * (lane >> 4) + r) * 65 + si * 16 + (lane & 15)] = acc[r]; }
            __syncthreads();
            for (int hl = 0; hl < 4; ++hl) {
                const int h = 4 * g + hl;
                {   const int t = tid >> 3, s0 = (tid & 7) * 8; const float at = AC[t * 8 + h], a63 = AC[63 * 8 + h];
                    float gv[8], xv[8]; const u32x4 xw = *(const LAS u32x4*)(XST + (64 * hl + t) * 72 + s0);
                    const float xf[8] = {bflo(xw.x), bfhi(xw.x), bflo(xw.y), bfhi(xw.y), bflo(xw.z), bfhi(xw.z), bflo(xw.w), bfhi(xw.w)};
#pragma unroll
                    for (int j = 0; j < 8; ++j) { const int s = s0 + j; const float as = AC[s * 8 + h], ds = DT[s * 8 + h];
                        gv[j] = (s <= t) ? CB[t * 65 + s] * expf(at - as) * ds : 0.f; xv[j] = xf[j] * ds * expf(a63 - as); }
                    u32x4 o; o.x = pk2(gv[0], gv[1]); o.y = pk2(gv[2], gv[3]); o.z = pk2(gv[4], gv[5]); o.w = pk2(gv[6], gv[7]); *(LAS u32x4*)(Gh + t * 72 + s0) = o;
                    o.x = pk2(xv[0], xv[1]); o.y = pk2(xv[2], xv[3]); o.z = pk2(xv[4], xv[5]); o.w = pk2(xv[6], xv[7]); *(LAS u32x4*)(XSD + t * 72 + s0) = o; }
                __syncthreads();
                const float dsk = dskip[h];
#pragma unroll
                for (int i = 0; i < 2; ++i) { const int idx = 2 * wave + i, ti = idx >> 2, pi = idx & 3;
                    const f32x4 acc = mma_tile<64>(Gh + ti * 16 * 72, 72, XST + (64 * hl + 16 * pi) * 72, 72, lane);
#pragma unroll
                    for (int r = 0; r < 4; ++r) { const int t = ti * 16 + 4 * (lane >> 4) + r, p = pi * 16 + (lane & 15);
                        const float y = acc[r] + dsk * bf2f(XST[(64 * hl + p) * 72 + t]); YD[(size_t)(m0 + t) * 512 + 64 * h + p] = (bf16_t)f2bf(y); } }
#pragma unroll
                for (int i = 0; i < 4; ++i) { const int idx = 4 * wave + i, pi = idx >> 3, ni = idx & 7;
                    const f32x4 acc = mma_tile<64>(XSD + pi * 16 * 72, 72, BT + ni * 16 * 72, 72, lane);
#pragma unroll
                    for (int r = 0; r < 4; ++r) { const int p = pi * 16 + 4 * (lane >> 4) + r, n = ni * 16 + (lane & 15);
                        const int f = hl * 8192 + p * 128 + n, row = f >> 9, col = ssd_win_col(g, f & 511);
                        XBC[(size_t)(m0 + row) * 1024 + col] = (bf16_t)f2bf(acc[r]); } }
                __syncthreads();
            }
        }
    }
}

__device__ __forceinline__ void p3c_rwkv(const Ctx& F, int l) {
    constexpr int M9 = 9216, O_TW = 0, O_AL = 9216, O_SL = 18432, O_MAB = O_SL + 12 * M9  , O_LWF = O_SL + 10 * M9  , O_ICF = O_LWF + 16640, O_WL = O_MAB + 16640  , O_SCR = O_WL + 256;
    static_assert(O_ICF + 16640 <= O_MAB + 16640 && O_SCR + 4224 <= LDS_BYTES, "rwkv lds map");
#define LB() ({ LAS unsigned char* p_ = F.lds; asm volatile("" : "+s"(p_)); p_; })
#define SLOT(i) ((LAS bf16_t*)(L + O_SL + (i) * M9))
#define TW ((LAS bf16_t*)(L + O_TW))
#define AL ((LAS bf16_t*)(L + O_AL))
#define AT SLOT(0)
#define ATt SLOT(1)
#define BTl SLOT(2)
#define KTl SLOT(3)
#define RT SLOT(4)
#define BHt SLOT(5)
#define KH SLOT(6)
#define VT SLOT(7)
#define MI SLOT(8)
#define MakT SLOT(9)
#define Rb SLOT(10)
#define Rk SLOT(11)
#define Attn SLOT(0)
#define KEt SLOT(1)
#define X1t SLOT(2)
#define X2t SLOT(3)
#define S8 SLOT(8)
#define S9 SLOT(9)
#define MAB ((LAS float*)(L + O_MAB))
#define LWf ((LAS float*)(L + O_LWF))
#define ICf ((LAS float*)(L + O_ICF))
#define WL ((LAS float*)(L + O_WL))
#define SCR ((LAS float*)(L + O_SCR))
    const int tid = F.tid, lane = F.lane, wave = F.wave;
    for (int c = F.bid; c < NCHK; c += F.G) {
        const int m0 = 64 * c; const bool first = (c & 127) == 0;
        {
            LAS unsigned char* L = LB();
            const int t = tid >> 3, q0 = (tid & 7) * 8;
            const float* Ff = (const float*)(F.ws + WS_F); const float* HF = (const float*)(F.ws + WS_HF); const float* mu_w = INP(I_MUW) + l * 64; const float* mu_a = INP(I_MUA) + l * 64;
            float cw[8], pw[8], ca[8], pa[8];
            const float* cur = Ff + (size_t)(m0 + t) * 144; const float* prv = (t > 0) ? cur - 144 : HF + (size_t)(c - 1) * 128;
#pragma unroll
            for (int j = 0; j < 8; ++j) { cw[j] = cur[q0 + j]; ca[j] = cur[64 + q0 + j]; }
            if (t > 0) {
#pragma unroll
                for (int j = 0; j < 8; ++j) { pw[j] = prv[q0 + j]; pa[j] = prv[64 + q0 + j]; }
            } else if (!first) {
#pragma unroll
                for (int j = 0; j < 8; ++j) { pw[j] = prv[q0 + j]; pa[j] = prv[64 + q0 + j]; }
            } else {
#pragma unroll
                for (int j = 0; j < 8; ++j) { pw[j] = 0.f; pa[j] = 0.f; }
            }
            float ow[8], oa[8];
#pragma unroll
            for (int j = 0; j < 8; ++j) { ow[j] = tanhf(cw[j] + (pw[j] - cw[j]) * mu_w[q0 + j]); oa[j] = ca[j] + (pa[j] - ca[j]) * mu_a[q0 + j]; }
            u32x4 o; o.x = pk2(ow[0], ow[1]); o.y = pk2(ow[2], ow[3]); o.z = pk2(ow[4], ow[5]); o.w = pk2(ow[6], ow[7]); *(LAS u32x4*)(TW + t * 72 + q0) = o;
            o.x = pk2(oa[0], oa[1]); o.y = pk2(oa[2], oa[3]); o.z = pk2(oa[4], oa[5]); o.w = pk2(oa[6], oa[7]); *(LAS u32x4*)(AL + t * 72 + q0) = o;
        }
        for (int h = 0; h < 8; ++h) {
            int tid = F.tid, lane = F.lane; asm volatile("" : "+v"(tid), "+v"(lane));
            {   LAS unsigned char* L = LB(); const int row = tid >> 3, c8 = tid & 7; const bf16_t* WLW = (const bf16_t*)(F.ws + WS_WLW); const bf16_t* WLA = (const bf16_t*)(F.ws + WS_WLA);
                *(LAS u32x4*)(S8 + row * 72 + c8 * 8) = *(const u32x4*)(WLW + (size_t)(h * 64 + row) * 64 + c8 * 8);
                *(LAS u32x4*)(S9 + row * 72 + c8 * 8) = *(const u32x4*)(WLA + (size_t)(h * 64 + row) * 64 + c8 * 8); }
            __syncthreads();
            { LAS unsigned char* L = LB(); const float* w0 = INP(I_W0) + l * 512; const float* a0 = INP(I_A0) + l * 512;
#pragma unroll
            for (int i = 0; i < 4; ++i) { const int idx = 4 * wave + i, which = idx >> 4, ti = (idx >> 2) & 3, ci = idx & 3;
                const f32x4 acc = mma_tile<64>((which ? AL : TW) + ti * 16 * 72, 72, (which ? S9 : S8) + ci * 16 * 72, 72, lane);
#pragma unroll
                for (int r = 0; r < 4; ++r) { const int t = ti * 16 + 4 * (lane >> 4) + r, ch = ci * 16 + (lane & 15);
                    if (which == 0) LWf[t * 65 + ch] = -DECAY_SCALE * sigmoidf_(acc[r] + w0[h * 64 + ch]); else ICf[t * 65 + ch] = sigmoidf_(acc[r] + a0[h * 64 + ch]); } } }
            __syncthreads();
            if (wave == 0) { LAS unsigned char* L = LB(); float run = 0.f;
#pragma unroll 8
                for (int t = 0; t < 64; ++t) { run += LWf[t * 65 + lane]; LWf[t * 65 + lane] = run; }
                WL[lane] = expf(run); }
            __syncthreads();
            float bonv[8]; const int t1 = tid >> 3, ch0 = (tid & 7) * 8, col1 = h * 64 + ch0;
            {   LAS unsigned char* L = LB(); const int t = t1;
                const bf16_t* Rg = (const bf16_t*)(F.ws + WS_R); const bf16_t* Kg = (const bf16_t*)(F.ws + WS_K); const bf16_t* Vg = (const bf16_t*)(F.ws + WS_V); const bf16_t* HR = (const bf16_t*)(F.ws + WS_HRKV);
                const float* mu_r = INP(I_MURKV) + (size_t)l * 1536; const float* mu_k = mu_r + 512; const float* mu_v = mu_r + 1024;
                const float* kkp = INP(I_KK) + l * 512; const float* kap = INP(I_KA) + l * 512; const float* rkp = INP(I_RK) + l * 512;
                const size_t off = (size_t)(m0 + t) * 512 + col1;
                const u32x4 rw = *(const u32x4*)(Rg + off), kw = *(const u32x4*)(Kg + off), vw = *(const u32x4*)(Vg + off);
                u32x4 rp = {0u, 0u, 0u, 0u}, kp = rp, vp = rp;
                if (t > 0) { rp = *(const u32x4*)(Rg + off - 512); kp = *(const u32x4*)(Kg + off - 512); vp = *(const u32x4*)(Vg + off - 512); }
                else if (!first) { const size_t ho = (size_t)(c - 1) * 512 + col1; rp = *(const u32x4*)(HR + ho); kp = *(const u32x4*)(HR + (size_t)NCHK * 512 + ho); vp = *(const u32x4*)(HR + (size_t)2 * NCHK * 512 + ho); }
                const unsigned rwa[4] = {rw.x, rw.y, rw.z, rw.w}, kwa[4] = {kw.x, kw.y, kw.z, kw.w}, vwa[4] = {vw.x, vw.y, vw.z, vw.w};
                const unsigned rpa[4] = {rp.x, rp.y, rp.z, rp.w}, kpa[4] = {kp.x, kp.y, kp.z, kp.w}, vpa[4] = {vp.x, vp.y, vp.z, vp.w};
                float rs[8], ks[8], vs[8], kkv[8], k2[8], ic[8]; float ss = 0.f, bs = 0.f;
#pragma unroll
                for (int j = 0; j < 8; ++j) { const int gch = col1 + j; const int q = j >> 1;
                    const float r_ = (j & 1) ? bfhi(rwa[q]) : bflo(rwa[q]), rq = (j & 1) ? bfhi(rpa[q]) : bflo(rpa[q]);
                    const float k_ = (j & 1) ? bfhi(kwa[q]) : bflo(kwa[q]), kq = (j & 1) ? bfhi(kpa[q]) : bflo(kpa[q]);
                    const float v_ = (j & 1) ? bfhi(vwa[q]) : bflo(vwa[q]), vq = (j & 1) ? bfhi(vpa[q]) : bflo(vpa[q]);
                    rs[j] = r_ + (rq - r_) * mu_r[gch]; ks[j] = k_ + (kq - k_) * mu_k[gch]; vs[j] = v_ + (vq - v_) * mu_v[gch];
                    ic[j] = ICf[t * 65 + ch0 + j];
                    kkv[j] = ks[j] * kkp[gch]; ss += kkv[j] * kkv[j];
                    k2[j] = ks[j] * (1.f + (ic[j] - 1.f) * kap[gch]); bs += rs[j] * k2[j] * rkp[gch]; }
                ss += __shfl_xor(ss, 1); ss += __shfl_xor(ss, 2); ss += __shfl_xor(ss, 4);
                bs += __shfl_xor(bs, 1); bs += __shfl_xor(bs, 2); bs += __shfl_xor(bs, 4);
                const float inv = 1.f / fmaxf(sqrtf(ss), 1e-12f);
                float vAT[8], vB[8], vK[8], vR[8], vBH[8], vKH[8];
#pragma unroll
                for (int j = 0; j < 8; ++j) { const int ch = ch0 + j;
                    const float LWt = LWf[t * 65 + ch], LWp = (t > 0) ? LWf[(t - 1) * 65 + ch] : 0.f, L63 = LWf[63 * 65 + ch];
                    const float kk = kkv[j] * inv, a = -kk, b = kk * ic[j];
                    const float e1 = expf(LWt), e2 = expf(-LWt), e3 = expf(LWp), e4 = expf(L63 - LWt);
                    vAT[j] = a * e3; vB[j] = b * e2; vK[j] = k2[j] * e2; vR[j] = rs[j] * e1; vBH[j] = b * e4; vKH[j] = k2[j] * e4; bonv[j] = bs * vs[j];
                    ATt[ch * 72 + t] = (bf16_t)f2bf(vAT[j]); BHt[ch * 72 + t] = (bf16_t)f2bf(vBH[j]); VT[ch * 72 + t] = (bf16_t)f2bf(vs[j]); }
                u32x4 o;
#define PK8(A_) (o[0] = pk2(A_[0], A_[1]), o[1] = pk2(A_[2], A_[3]), o[2] = pk2(A_[4], A_[5]), o[3] = pk2(A_[6], A_[7]), o)
                *(LAS u32x4*)(AT + t * 72 + ch0) = PK8(vAT); *(LAS u32x4*)(BTl + t * 72 + ch0) = PK8(vB); *(LAS u32x4*)(KTl + t * 72 + ch0) = PK8(vK);
                *(LAS u32x4*)(RT + t * 72 + ch0) = PK8(vR); *(LAS u32x4*)(KH + t * 72 + ch0) = PK8(vKH);
            }
            __syncthreads();
            { u32x4 o; *(u32x4*)((bf16_t*)(F.ws + WS_V) + (size_t)(m0 + t1) * 512 + col1) = PK8(bonv); }
            { LAS unsigned char* L = LB();
#pragma unroll
            for (int i = 0; i < 8; ++i) { const int p = wave >> 1, idx = 8 * (wave & 1) + i, ti = idx >> 2, si = idx & 3;
                const f32x4 acc = mma_tile<64>(((p < 2) ? AT : RT) + ti * 16 * 72, 72, ((p & 1) ? KTl : BTl) + si * 16 * 72, 72, lane);
#pragma unroll
                for (int r = 0; r < 4; ++r) { const int t = ti * 16 + 4 * (lane >> 4) + r, s = si * 16 + (lane & 15);
                    if (p == 0) MAB[t * 65 + s] = (s < t) ? acc[r] : 0.f;
                    else if (p == 1) MakT[s * 72 + t] = (bf16_t)f2bf((s < t) ? acc[r] : 0.f);
                    else if (p == 2) Rb[t * 72 + s] = (bf16_t)f2bf((s <= t) ? acc[r] : 0.f);
                    else Rk[t * 72 + s] = (bf16_t)f2bf((s <= t) ? acc[r] : 0.f); } } }
            __syncthreads();
            if (wave < 4 && lane < 16) { LAS unsigned char* L = LB(); const int b0 = 16 * wave; float x[16];
#pragma unroll
                for (int t = 0; t < 16; ++t) { float v = (t == lane) ? 1.f : 0.f;
#pragma unroll
                    for (int s = 0; s < 16; ++s) if (s < t) v += MAB[(b0 + t) * 65 + b0 + s] * x[s];
                    x[t] = v; }
#pragma unroll
                for (int t = 0; t < 16; ++t) MAB[(b0 + t) * 65 + b0 + lane] = x[t]; }
            __syncthreads();
            {   LAS unsigned char* L = LB(); const int pr = tid >> 8, e = tid & 255, rr = e >> 4, cc = e & 15, rb = pr ? 48 : 16, cb = pr ? 32 : 0; float v = 0.f;
#pragma unroll
                for (int s = 0; s < 16; ++s) v += MAB[(rb + rr) * 65 + cb + s] * MAB[(cb + s) * 65 + cb + cc];
                SCR[(pr * 16 + rr) * 33 + cc] = v; }
            __syncthreads();
            {   LAS unsigned char* L = LB(); const int pr = tid >> 8, e = tid & 255, rr = e >> 4, cc = e & 15, rb = pr ? 48 : 16, cb = pr ? 32 : 0; float v = 0.f;
#pragma unroll
                for (int s = 0; s < 16; ++s) v += MAB[(rb + rr) * 65 + rb + s] * SCR[(pr * 16 + s) * 33 + cc];
                MAB[(rb + rr) * 65 + cb + cc] = v; }
            __syncthreads();
            {   LAS unsigned char* L = LB(); float v2[2];
#pragma unroll
                for (int i = 0; i < 2; ++i) { const int e = tid * 2 + i, rr = e >> 5, cc = e & 31; float v = 0.f;
#pragma unroll 8
                    for (int s = 0; s < 32; ++s) v += MAB[(32 + rr) * 65 + s] * MAB[s * 65 + cc];
                    v2[i] = v; }
                SCR[((tid * 2) >> 5) * 33 + ((tid * 2) & 31)] = v2[0]; SCR[((tid * 2 + 1) >> 5) * 33 + ((tid * 2 + 1) & 31)] = v2[1]; }
            __syncthreads();
            {   LAS unsigned char* L = LB();
#pragma unroll
                for (int i = 0; i < 2; ++i) { const int e = tid * 2 + i, rr = e >> 5, cc = e & 31; float v = 0.f;
#pragma unroll 8
                    for (int s = 0; s < 32; ++s) v += MAB[(32 + rr) * 65 + 32 + s] * SCR[s * 33 + cc];
                    MAB[(32 + rr) * 65 + cc] = v; } }
            __syncthreads();
            {   LAS unsigned char* L = LB(); const int t = tid >> 3, s0 = (tid & 7) * 8; float x[8];
#pragma unroll
                for (int j = 0; j < 8; ++j) x[j] = MAB[t * 65 + s0 + j];
                u32x4 o; *(LAS u32x4*)(MI + t * 72 + s0) = PK8(x); }
            __syncthreads();
            { LAS unsigned char* L = LB();
#pragma unroll
            for (int i = 0; i < 4; ++i) { const int idx = 4 * wave + i, which = idx >> 4, ti = (idx >> 2) & 3, ci = idx & 3;
                const f32x4 acc = mma_tile<64>(MI + ti * 16 * 72, 72, (which ? MakT : ATt) + ci * 16 * 72, 72, lane);
#pragma unroll
                for (int r = 0; r < 4; ++r) { const int t = ti * 16 + 4 * (lane >> 4) + r, j = ci * 16 + (lane & 15); (which ? X2t : X1t)[j * 72 + t] = (bf16_t)f2bf(acc[r]); } } }
            __syncthreads();
            { LAS unsigned char* L = LB();
            bf16_t* QEw = (bf16_t*)(F.ws + WS_QE) + (size_t)(c * 8 + h) * 4096; bf16_t* TTw = (bf16_t*)(F.ws + WS_TT) + (size_t)(c * 8 + h) * 4096;
#pragma unroll
            for (int i = 0; i < 8; ++i) { const int p = wave >> 1, idx = 8 * (wave & 1) + i, ti = idx >> 2, si = idx & 3;
                const f32x4 acc = mma_tile<64>(((p == 0 || p == 1) ? Rb : (p == 2) ? X1t : X2t) + ti * 16 * 72, 72, ((p == 0) ? X1t : (p == 1) ? X2t : BHt) + si * 16 * 72, 72, lane);
#pragma unroll
                for (int r = 0; r < 4; ++r) { const int rw = ti * 16 + 4 * (lane >> 4) + r, cl = si * 16 + (lane & 15);
                    if (p == 0) QEw[rw * 64 + pi16(cl)] = (bf16_t)f2bf(acc[r] + bf2f(RT[rw * 72 + cl]));
                    else if (p == 1) Attn[rw * 72 + cl] = (bf16_t)f2bf(acc[r] + bf2f(Rk[rw * 72 + cl]));
                    else if (p == 2) TTw[cl * 64 + pi16(rw)] = (bf16_t)f2bf(acc[r] + ((rw == cl) ? WL[rw] : 0.f));
                    else KEt[cl * 72 + rw] = (bf16_t)f2bf(acc[r] + bf2f(KH[rw * 72 + cl])); } } }
            __syncthreads();
            bf16_t* Rg = (bf16_t*)(F.ws + WS_R); bf16_t* Kg = (bf16_t*)(F.ws + WS_K); LAS unsigned char* L = LB();
#pragma unroll
            for (int i = 0; i < 4; ++i) { const int idx = 4 * wave + i, which = idx >> 4, ti = (idx >> 2) & 3, ci = idx & 3;
                const f32x4 acc = mma_tile<64>((which ? VT : Attn) + ti * 16 * 72, 72, (which ? KEt : VT) + ci * 16 * 72, 72, lane);
#pragma unroll
                for (int r = 0; r < 4; ++r) { const int rw = ti * 16 + 4 * (lane >> 4) + r, cl = ci * 16 + (lane & 15);
                    if (which == 0) Kg[(size_t)(m0 + cl) * 512 + h * 64 + sg32(rw)] = (bf16_t)f2bf(acc[r]);
                    else Rg[(size_t)(m0 + rw) * 512 + h * 64 + sg32(cl)] = (bf16_t)f2bf(acc[r]); } }
        }
        __syncthreads();
    }
#undef SLOT
#undef PK8
#undef LB
#undef TW
#undef AL
#undef AT
#undef ATt
#undef BTl
#undef KTl
#undef RT
#undef BHt
#undef KH
#undef VT
#undef MI
#undef MakT
#undef Rb
#undef Rk
#undef Attn
#undef KEt
#undef X1t
#undef X2t
#undef S8
#undef S9
#undef MAB
#undef LWf
#undef ICf
#undef WL
#undef SCR
}

__device__ __forceinline__ bf16x8 cvt8(const f32x16& x, int s) {
    u32x4 w; w.x = pk2(x[8 * s + 0], x[8 * s + 1]); w.y = pk2(x[8 * s + 2], x[8 * s + 3]); w.z = pk2(x[8 * s + 4], x[8 * s + 5]); w.w = pk2(x[8 * s + 6], x[8 * s + 7]);
    return __builtin_bit_cast(bf16x8, w);
}
__device__ __forceinline__ f32x16 ld16bf(const bf16_t* p) {
    const u32x4 a = *(const u32x4*)p, b = *(const u32x4*)(p + 8); f32x16 r;
    r[0] = bflo(a.x); r[1] = bfhi(a.x); r[2] = bflo(a.y); r[3] = bfhi(a.y); r[4] = bflo(a.z); r[5] = bfhi(a.z); r[6] = bflo(a.w); r[7] = bfhi(a.w);
    r[8] = bflo(b.x); r[9] = bfhi(b.x); r[10] = bflo(b.y); r[11] = bfhi(b.y); r[12] = bflo(b.z); r[13] = bfhi(b.z); r[14] = bflo(b.w); r[15] = bfhi(b.w); return r;
}
__device__ __forceinline__ void st16bf(bf16_t* p, const f32x16& x) {
    u32x4 a, b; a.x = pk2(x[0], x[1]); a.y = pk2(x[2], x[3]); a.z = pk2(x[4], x[5]); a.w = pk2(x[6], x[7]); b.x = pk2(x[8], x[9]); b.y = pk2(x[10], x[11]); b.z = pk2(x[12], x[13]); b.w = pk2(x[14], x[15]);
    *(u32x4*)p = a; *(u32x4*)(p + 8) = b;
}
constexpr int KROW = 400;
__device__ __forceinline__ void attn_unit(const Ctx& F, int b, int c) {
    const int tid = F.tid, lane = F.lane, wave = F.wave, r32 = lane & 31, hi = lane >> 5, head = wave >> 1;
    const bf16_t* Q = (const bf16_t*)(F.ws + WS_Q); const bf16_t* KV = (const bf16_t*)(F.ws + WS_KVB) + (size_t)b * SEQ * 192; bf16_t* OL = (bf16_t*)(F.ws + WS_OL);
    const size_t mq = (size_t)b * SEQ + 64 * c + 32 * (wave & 1) + r32;
    bf16x8 qr[12];
#pragma unroll
    for (int d0 = 0; d0 < 12; ++d0) qr[d0] = *(const bf16x8*)(Q + mq * 768 + head * 192 + 16 * d0 + 8 * hi);
    {
        const float* rp = (const float*)(F.ws + WS_ROPE) + mq * 64;
#pragma unroll
        for (int d0 = 8; d0 < 10; ++d0) { const int j0 = 16 * (d0 - 8) + 8 * hi;
            const f32x4 c0 = *(const f32x4*)(rp + j0), c1 = *(const f32x4*)(rp + j0 + 4), s0 = *(const f32x4*)(rp + 32 + j0), s1 = *(const f32x4*)(rp + 32 + j0 + 4);
            const u32x4 a = __builtin_bit_cast(u32x4, qr[d0]), b = __builtin_bit_cast(u32x4, qr[d0 + 2]);
            const float x1[8] = {bflo(a.x), bfhi(a.x), bflo(a.y), bfhi(a.y), bflo(a.z), bfhi(a.z), bflo(a.w), bfhi(a.w)}, x2[8] = {bflo(b.x), bfhi(b.x), bflo(b.y), bfhi(b.y), bflo(b.z), bfhi(b.z), bflo(b.w), bfhi(b.w)};
            const float cs[8] = {c0[0], c0[1], c0[2], c0[3], c1[0], c1[1], c1[2], c1[3]}, sn[8] = {s0[0], s0[1], s0[2], s0[3], s1[0], s1[1], s1[2], s1[3]};
            float o1[8], o2[8];
#pragma unroll
            for (int e = 0; e < 8; ++e) { o1[e] = x1[e] * cs[e] - x2[e] * sn[e]; o2[e] = x1[e] * sn[e] + x2[e] * cs[e]; }
            u32x4 w1, w2; w1.x = pk2(o1[0], o1[1]); w1.y = pk2(o1[2], o1[3]); w1.z = pk2(o1[4], o1[5]); w1.w = pk2(o1[6], o1[7]); w2.x = pk2(o2[0], o2[1]); w2.y = pk2(o2[2], o2[3]); w2.z = pk2(o2[4], o2[5]); w2.w = pk2(o2[6], o2[7]);
            qr[d0] = __builtin_bit_cast(bf16x8, w1); qr[d0 + 2] = __builtin_bit_cast(bf16x8, w2); }
    }
    int prow[3], pcol[3];
#pragma unroll
    for (int i = 0; i < 3; ++i) { const int idx = tid + 512 * i; prow[i] = idx / 24; pcol[i] = idx % 24; }
    const int nt = c + 1;
    u32x4 st[3];
#pragma unroll
    for (int i = 0; i < 3; ++i) st[i] = *(const u32x4*)(KV + (size_t)prow[i] * 192 + pcol[i] * 8);
#pragma unroll
    for (int i = 0; i < 3; ++i) *(LAS u32x4*)(F.lds + prow[i] * KROW + pcol[i] * 16) = st[i];
    __syncthreads();
    f32x16 o[4];
#pragma unroll
    for (int d = 0; d < 4; ++d)
#pragma unroll
        for (int r = 0; r < 16; ++r) o[d][r] = 0.f;
    float mrun = -1e30f, lrun = 0.f;
    const int troff = (4 * hi + ((lane & 15) >> 2)) * KROW + (((lane >> 4) & 1) * 16 + (lane & 3) * 4) * 2;
    for (int kt = 0; kt < nt; ++kt) {
        LAS unsigned char* buf = F.lds + (kt & 1) * (64 * KROW);
        if (kt + 1 < nt) {
#pragma unroll
            for (int i = 0; i < 3; ++i) st[i] = *(const u32x4*)(KV + (size_t)((kt + 1) * 64 + prow[i]) * 192 + pcol[i] * 8);
        }
        f32x16 p0, p1;
#pragma unroll
        for (int r = 0; r < 16; ++r) { p0[r] = 0.f; p1[r] = 0.f; }
#pragma unroll
        for (int d0 = 0; d0 < 12; ++d0) {
            const bf16x8 a0 = *(const LAS bf16x8*)(buf + r32 * KROW + d0 * 32 + hi * 16), a1 = *(const LAS bf16x8*)(buf + (32 + r32) * KROW + d0 * 32 + hi * 16);
            p0 = __builtin_amdgcn_mfma_f32_32x32x16_bf16(a0, qr[d0], p0, 0, 0, 0); p1 = __builtin_amdgcn_mfma_f32_32x32x16_bf16(a1, qr[d0], p1, 0, 0, 0);
        }
        float mx = p0[0];
#pragma unroll
        for (int r = 0; r < 16; ++r) { mx = fmaxf(mx, p0[r]); mx = fmaxf(mx, p1[r]); }
        mx = fmaxf(mx, __shfl_xor(mx, 32));
        const float mnew = fmaxf(mrun, mx), alpha = exp2f(mrun - mnew); mrun = mnew;
        float ls = 0.f;
#pragma unroll
        for (int r = 0; r < 16; ++r) { p0[r] = exp2f(p0[r] - mnew); p1[r] = exp2f(p1[r] - mnew); ls += p0[r] + p1[r]; }
        lrun = lrun * alpha + ls;
#pragma unroll
        for (int d = 0; d < 4; ++d)
#pragma unroll
            for (int r = 0; r < 16; ++r) o[d][r] *= alpha;
#pragma unroll
        for (int s = 0; s < 4; ++s) {
            const bf16x8 pb = (s < 2) ? cvt8(p0, s & 1) : cvt8(p1, s & 1);
#pragma unroll
            for (int db = 0; db < 4; ++db) {
                const LAS unsigned char* vp = buf + troff + (16 * s) * KROW + db * 64;
                const v4i16_t lo = __builtin_amdgcn_ds_read_tr16_b64_v4i16((LAS v4i16_t*)vp), hh = __builtin_amdgcn_ds_read_tr16_b64_v4i16((LAS v4i16_t*)(vp + 8 * KROW));
                const bf16x8 va = {lo[0], lo[1], lo[2], lo[3], hh[0], hh[1], hh[2], hh[3]};
                o[db] = __builtin_amdgcn_mfma_f32_32x32x16_bf16(va, pb, o[db], 0, 0, 0);
            }
        }
        if (kt + 1 < nt) {
            LAS unsigned char* nb = F.lds + ((kt + 1) & 1) * (64 * KROW);
#pragma unroll
            for (int i = 0; i < 3; ++i) *(LAS u32x4*)(nb + prow[i] * KROW + pcol[i] * 16) = st[i];
        }
        __syncthreads();
    }
    lrun += __shfl_xor(lrun, 32);
    const float inv = 1.f / lrun;
#pragma unroll
    for (int db = 0; db < 4; ++db)
#pragma unroll
        for (int g = 0; g < 4; ++g) { u32x2 w; w.x = pk2(o[db][4 * g] * inv, o[db][4 * g + 1] * inv); w.y = pk2(o[db][4 * g + 2] * inv, o[db][4 * g + 3] * inv);
            *(u32x2*)(OL + mq * 512 + head * 128 + 32 * db + 8 * g + 4 * hi) = w; }
}
struct RwSet { bf16x8 ta[2][4]; u32x4 d[4]; };
__device__ __forceinline__ void rw_load(RwSet& s, const bf16_t* TTg, const bf16_t* Rg, int cg_, int h, int i, int r32, int hi) {
    const bf16_t* TTw = TTg + (size_t)(cg_ * 8 + h) * 4096; const bf16_t* Dw = Rg + ((size_t)64 * cg_ + i) * 512 + h * 64;
#pragma unroll
    for (int a = 0; a < 2; ++a)
#pragma unroll
        for (int s2 = 0; s2 < 4; ++s2) s.ta[a][s2] = *(const bf16x8*)(TTw + (32 * a + r32) * 64 + 16 * s2 + 8 * hi);
    s.d[0] = *(const u32x4*)(Dw + 16 * hi); s.d[1] = *(const u32x4*)(Dw + 16 * hi + 8); s.d[2] = *(const u32x4*)(Dw + 32 + 16 * hi); s.d[3] = *(const u32x4*)(Dw + 32 + 16 * hi + 8);
}
__device__ __forceinline__ f32x16 up16(const u32x4 a, const u32x4 b) { f32x16 r;
    r[0] = bflo(a.x); r[1] = bfhi(a.x); r[2] = bflo(a.y); r[3] = bfhi(a.y); r[4] = bflo(a.z); r[5] = bfhi(a.z); r[6] = bflo(a.w); r[7] = bfhi(a.w);
    r[8] = bflo(b.x); r[9] = bfhi(b.x); r[10] = bflo(b.y); r[11] = bfhi(b.y); r[12] = bflo(b.z); r[13] = bfhi(b.z); r[14] = bflo(b.w); r[15] = bfhi(b.w); return r; }
__device__ __forceinline__ void rw_step(f32x16& X0, f32x16& X1, const RwSet& s, bf16_t* Rg, int cg_, int h, int i, int hi, bool live) {
    const bf16x8 bf[4] = {cvt8(X0, 0), cvt8(X0, 1), cvt8(X1, 0), cvt8(X1, 1)};
    if (live) { bf16_t* Dw = Rg + ((size_t)64 * cg_ + i) * 512 + h * 64;
        *(bf16x8*)(Dw + 16 * hi) = bf[0]; *(bf16x8*)(Dw + 16 * hi + 8) = bf[1]; *(bf16x8*)(Dw + 32 + 16 * hi) = bf[2]; *(bf16x8*)(Dw + 32 + 16 * hi + 8) = bf[3]; }
    f32x16 n0 = up16(s.d[0], s.d[1]), n1 = up16(s.d[2], s.d[3]);
#pragma unroll
    for (int s2 = 0; s2 < 4; ++s2) { n0 = __builtin_amdgcn_mfma_f32_32x32x16_bf16(s.ta[0][s2], bf[s2], n0, 0, 0, 0); n1 = __builtin_amdgcn_mfma_f32_32x32x16_bf16(s.ta[1][s2], bf[s2], n1, 0, 0, 0); }
    X0 = n0; X1 = n1;
}
__device__ __forceinline__ void rwkv_scan(const Ctx& F, int b, int h, int half) {
    const int lane = F.lane, r32 = lane & 31, hi = lane >> 5, i = 32 * half + r32;
    const bf16_t* TTg = (const bf16_t*)(F.ws + WS_TT); bf16_t* Rg = (bf16_t*)(F.ws + WS_R);
    f32x16 X0, X1;
#pragma unroll
    for (int r = 0; r < 16; ++r) { X0[r] = 0.f; X1[r] = 0.f; }
    RwSet sA, sB, sC; const int c0 = b * 128;
    rw_load(sA, TTg, Rg, c0 + 0, h, i, r32, hi); rw_load(sB, TTg, Rg, c0 + 1, h, i, r32, hi); rw_load(sC, TTg, Rg, c0 + 2, h, i, r32, hi);
    for (int c = 0; c < 129; c += 3) {
        rw_step(X0, X1, sA, Rg, c0 + c, h, i, hi, true);          rw_load(sA, TTg, Rg, c0 + min(c + 3, 127), h, i, r32, hi);
        rw_step(X0, X1, sB, Rg, c0 + c + 1, h, i, hi, true);      rw_load(sB, TTg, Rg, c0 + min(c + 4, 127), h, i, r32, hi);
        rw_step(X0, X1, sC, Rg, c0 + min(c + 2, 127), h, i, hi, c + 2 < 128); rw_load(sC, TTg, Rg, c0 + min(c + 5, 127), h, i, r32, hi);
    }
}
__device__ __forceinline__ void ssd_scan(const Ctx& F, int item) {
    const int b = item >> 4, h = (item >> 1) & 7, hp = item & 1, g = h >> 2, hl = h & 3;
    const int piece = hp * 512 + F.tid;
    const int f = hl * 8192 + piece * 8, row = f >> 9, col = ssd_win_col(g, f & 511);
    bf16_t* ST = (bf16_t*)(F.ws + WS_XBC); const float* CDEC = (const float*)(F.ws + WS_CDEC);
    float st[8];
#pragma unroll
    for (int j = 0; j < 8; ++j) st[j] = 0.f;
    for (int c8 = 0; c8 < 128; c8 += 8) {
        u32x4 v[8]; float cd[8];
#pragma unroll
        for (int u = 0; u < 8; ++u) { const int cg_ = b * 128 + c8 + u; v[u] = *(const u32x4*)(ST + ((size_t)64 * cg_ + row) * 1024 + col); cd[u] = CDEC[cg_ * 8 + h]; }
#pragma unroll
        for (int u = 0; u < 8; ++u) { const int cg_ = b * 128 + c8 + u;
            u32x4 o; o.x = pk2(st[0], st[1]); o.y = pk2(st[2], st[3]); o.z = pk2(st[4], st[5]); o.w = pk2(st[6], st[7]);
            *(u32x4*)(ST + ((size_t)64 * cg_ + row) * 1024 + col) = o;
            const float x[8] = {bflo(v[u].x), bfhi(v[u].x), bflo(v[u].y), bfhi(v[u].y), bflo(v[u].z), bfhi(v[u].z), bflo(v[u].w), bfhi(v[u].w)};
#pragma unroll
            for (int j = 0; j < 8; ++j) st[j] = st[j] * cd[u] + x[j]; }
    }
}
__device__ __forceinline__ void p4_mix(const Ctx& F, int what = 3) {
    if (F.bid < 128) { if (!(what & 1)) return;
        const int b = F.bid >> 6, c = F.bid & 63;
        attn_unit(F, b, 127 - c); __syncthreads(); attn_unit(F, b, c);
    } else if (F.bid < 160) { if ((what & 2) && !(what & 8) && F.wave == 0) { const int task = F.bid - 128; rwkv_scan(F, task >> 4, (task >> 1) & 7, task & 1); }
    } else if (F.bid < 192) { if ((what & 2) && !(what & 4)) ssd_scan(F, F.bid - 160); }
}
__device__ __forceinline__ void p5_assemble(const Ctx& F, int l) {
    bf16_t* GT = (bf16_t*)(F.ws + WS_GATES);
    {   pg8::Gemm g{(const bf16_t*)(F.ws + WS_OL), (const bf16_t*)(F.ws + WS_WUV), NT, 512, 512, 512, 512}; pg8::StaticOrder S; S.init(NT, 512, F.G, F.bid); EpiUV E{GT};
        pg8::gemm_phase<EpiUV, pg8::StaticOrder, true, true>(F.lds, F.wave, g, S, E); }
    __syncthreads();
    int lane = fresh_lane(); const int tid = F.wave * 64 + lane, wave = F.wave;
    const int gw = F.bid * NWAVES + F.wave, NGW = F.G * NWAVES;
    {   constexpr int O_CG = 0, O_PV = 17408, O_YL = 34816;
        const bf16_t* Cbuf = (const bf16_t*)(F.ws + WS_CB); const float* ECUM = (const float*)(F.ws + WS_ECUM); const bf16_t* ST = (const bf16_t*)(F.ws + WS_XBC); const bf16_t* YD = (const bf16_t*)(F.ws + WS_YD);
        const float* snw = INP(I_SSDNW) + l * 512;
        for (int c = F.bid; c < NCHK; c += F.G) {
            const size_t m0 = (size_t)64 * c;
            for (int g = 0; g < 2; ++g) {
                {   LAS bf16_t* Cg = (LAS bf16_t*)(F.lds + O_CG);
#pragma unroll
                    for (int i = 0; i < 2; ++i) { const int idx = tid + 512 * i, t = idx >> 4, c8 = idx & 15; *(LAS u32x4*)(Cg + t * 136 + c8 * 8) = *(const u32x4*)(Cbuf + (m0 + t) * 256 + g * 128 + c8 * 8); } }
                for (int hl = 0; hl < 4; ++hl) { const int h = 4 * g + hl;
                    {   LAS bf16_t* Pv = (LAS bf16_t*)(F.lds + O_PV);
#pragma unroll
                        for (int i = 0; i < 2; ++i) { const int idx = tid + 512 * i, pp = idx >> 4, c8 = idx & 15; const int f = hl * 8192 + pp * 128 + c8 * 8, row = f >> 9, col = ssd_win_col(g, f & 511);
                            *(LAS u32x4*)(Pv + pp * 136 + c8 * 8) = *(const u32x4*)(ST + (m0 + row) * 1024 + col); } }
                    __syncthreads();
                    {   LAS bf16_t* Cg = (LAS bf16_t*)(F.lds + O_CG); LAS bf16_t* Pv = (LAS bf16_t*)(F.lds + O_PV); LAS bf16_t* YL = (LAS bf16_t*)(F.lds + O_YL);
#pragma unroll
                        for (int i = 0; i < 2; ++i) { const int idx = 2 * wave + i, ti = idx >> 2, pi = idx & 3;
                            const f32x4 acc = mma_tile<128>(Cg + ti * 16 * 136, 136, Pv + pi * 16 * 136, 136, lane);
#pragma unroll
                            for (int r = 0; r < 4; ++r) { const int t = ti * 16 + 4 * (lane >> 4) + r, pp = pi * 16 + (lane & 15);
                                const float y = bf2f(YD[(m0 + t) * 512 + 64 * h + pp]) + acc[r] * ECUM[(size_t)(c * 8 + h) * 64 + t];
                                const float z = bf2f(GT[(m0 + t) * 1536 + 512 + 64 * h + pp]);
                                YL[t * 520 + 64 * h + pp] = (bf16_t)f2bf(y * siluf_(z)); } } }
                    __syncthreads();
                }
            }
            {   LAS bf16_t* YL = (LAS bf16_t*)(F.lds + O_YL);
#pragma unroll
                for (int rr = 0; rr < 8; ++rr) { const int t = 8 * wave + rr; const u32x4 w = *(const LAS u32x4*)(YL + t * 520 + 8 * lane);
                    const float v[8] = {bflo(w.x), bfhi(w.x), bflo(w.y), bfhi(w.y), bflo(w.z), bfhi(w.z), bflo(w.w), bfhi(w.w)};
                    float q = 0.f;
#pragma unroll
                    for (int j = 0; j < 8; ++j) q += v[j] * v[j];
                    const float rs = 1.f / sqrtf(wave_sum(q) * (1.f / 512.f) + EPS);
                    const f32x4 w0 = *(const f32x4*)(snw + 8 * lane), w1 = *(const f32x4*)(snw + 8 * lane + 4);
                    u32x4 o; o.x = pk2(v[0] * rs * w0[0], v[1] * rs * w0[1]); o.y = pk2(v[2] * rs * w0[2], v[3] * rs * w0[3]); o.z = pk2(v[4] * rs * w1[0], v[5] * rs * w1[1]); o.w = pk2(v[6] * rs * w1[2], v[7] * rs * w1[3]);
                    *(u32x4*)(GT + (m0 + t) * 1536 + 512 + 8 * lane) = o; } }
            __syncthreads();
        }
    }
    LAS float* SW = (LAS float*)(F.lds + F.wave * 16640);
    const bf16_t* Yt = (const bf16_t*)(F.ws + WS_K); const bf16_t* SF = (const bf16_t*)(F.ws + WS_R); const bf16_t* QEg = (const bf16_t*)(F.ws + WS_QE);
    const bf16_t* BON = (const bf16_t*)(F.ws + WS_V); const float* lw = INP(I_LNXW) + l * 512; const float* lb = INP(I_LNXB) + l * 512;
    for (int w = gw; w < NCHK * 8; w += NGW) {
        asm volatile("" : "+v"(lane));
        const int cg_ = w >> 3, h = w & 7, r32 = lane & 31, hi = lane >> 5; const size_t m0 = (size_t)64 * cg_;
        const bf16_t* QEw = QEg + (size_t)(cg_ * 8 + h) * 4096;
        bf16x8 qa[2][4];
#pragma unroll
        for (int tb = 0; tb < 2; ++tb)
#pragma unroll
            for (int s2 = 0; s2 < 4; ++s2) qa[tb][s2] = *(const bf16x8*)(QEw + (32 * tb + r32) * 64 + 16 * s2 + 8 * hi);
#pragma unroll
        for (int ih = 0; ih < 2; ++ih) { const size_t ro = (m0 + 32 * ih + r32) * 512 + h * 64;
            const bf16x8 bf[4] = {*(const bf16x8*)(SF + ro + 16 * hi), *(const bf16x8*)(SF + ro + 16 * hi + 8), *(const bf16x8*)(SF + ro + 32 + 16 * hi), *(const bf16x8*)(SF + ro + 32 + 16 * hi + 8)};
#pragma unroll
            for (int tb = 0; tb < 2; ++tb) { f32x16 y = ld16bf(Yt + ro + 32 * tb + 16 * hi);
#pragma unroll
                for (int s2 = 0; s2 < 4; ++s2) y = __builtin_amdgcn_mfma_f32_32x32x16_bf16(qa[tb][s2], bf[s2], y, 0, 0, 0);
#pragma unroll
                for (int r = 0; r < 16; ++r) SW[(32 * tb + crow(r, hi)) * 65 + 32 * ih + r32] = y[r]; } }
        LDS_WAIT();
        {   float y[64]; float sm = 0.f;
#pragma unroll
            for (int i = 0; i < 64; ++i) { y[i] = SW[lane * 65 + i]; sm += y[i]; }
            const float mean = sm * (1.f / 64.f); float q = 0.f;
#pragma unroll
            for (int i = 0; i < 64; ++i) { y[i] -= mean; q += y[i] * y[i]; }
            const float rs = 1.f / sqrtf(q * (1.f / 64.f) + GN_EPS);
#pragma unroll
            for (int i = 0; i < 64; ++i) SW[lane * 65 + i] = y[i] * rs; }
        LDS_WAIT();
#pragma unroll
        for (int it = 0; it < 8; ++it) { const int t = it * 8 + (lane >> 3), i0 = (lane & 7) * 8; const size_t row = m0 + t;
            const u32x4 bw = *(const u32x4*)(BON + row * 512 + h * 64 + i0); u32x4* gp = (u32x4*)(GT + row * 1536 + 1024 + h * 64 + i0); const u32x4 gv = *gp;
            const float bo[8] = {bflo(bw.x), bfhi(bw.x), bflo(bw.y), bfhi(bw.y), bflo(bw.z), bfhi(bw.z), bflo(bw.w), bfhi(bw.w)};
            const float gg[8] = {bflo(gv.x), bfhi(gv.x), bflo(gv.y), bfhi(gv.y), bflo(gv.z), bfhi(gv.z), bflo(gv.w), bfhi(gv.w)};
            float ov[8];
#pragma unroll
            for (int j = 0; j < 8; ++j) ov[j] = (SW[t * 65 + i0 + j] * lw[h * 64 + i0 + j] + lb[h * 64 + i0 + j] + bo[j]) * siluf_(gg[j]);
            u32x4 o; o.x = pk2(ov[0], ov[1]); o.y = pk2(ov[2], ov[3]); o.z = pk2(ov[4], ov[5]); o.w = pk2(ov[6], ov[7]); *gp = o; }
        LDS_WAIT();
    }
}
__device__ __forceinline__ void p7_final(const Ctx& F) {
    const int gw = F.bid * NWAVES + F.wave, NGW = F.G * NWAVES; const float* fw = INP(I_FNW);
    for (int m = gw; m < NT; m += NGW) {
        f32x4* xr = (f32x4*)(F.out + (size_t)m * DM) + F.lane; f32x4 v[4]; float s = 0.f;
#pragma unroll
        for (int j = 0; j < 4; ++j) { v[j] = xr[64 * j]; s += v[j].x * v[j].x + v[j].y * v[j].y + v[j].z * v[j].z + v[j].w * v[j].w; }
        const float rstd = 1.f / sqrtf(wave_sum(s) * (1.f / DM) + EPS);
#pragma unroll
        for (int j = 0; j < 4; ++j) xr[64 * j] = v[j] * rstd * *(const f32x4*)(fw + 4 * F.lane + 256 * j);
    }
}

#define RLX_AGENT __ATOMIC_RELAXED, __HIP_MEMORY_SCOPE_AGENT
#define XB_TMO      128
#define XB_XCNT(j)  (256  + 64 * (j))
#define XB_XSUB(j)  (1280 + 64 * (j))
#define XB_XGEN(j)  (2304 + 64 * (j))
#define XB_TOP      3328
#define XB_TOPGEN   3392
#define XCD_BAR_WORDS 3456
#define XB_SPIN_CAP (1u << 18)

__device__ __forceinline__ unsigned xb_ld(unsigned* p)              { return __hip_atomic_load(p, __ATOMIC_RELAXED, __HIP_MEMORY_SCOPE_AGENT); }
__device__ __forceinline__ unsigned xb_add(unsigned* p, unsigned v) { return __hip_atomic_fetch_add(p, v, __ATOMIC_RELAXED, __HIP_MEMORY_SCOPE_AGENT); }
__device__ __forceinline__ unsigned xb_xcc_id() { return (unsigned)__builtin_amdgcn_s_getreg((3 << 11) | 20) & 0xFu; }
#define XB_SPIN(cond, bar) do { unsigned _sp = 0; while (cond) { __builtin_amdgcn_s_sleep(1); \
    if ((++_sp & 255u) == 0u) { if (xb_ld(&(bar)[XB_TMO])) break; if (_sp > XB_SPIN_CAP) { atomicAdd(&(bar)[XB_TMO], 1u); break; } } } } while (0)

struct XcdBarrier {
    unsigned* bar; unsigned x;
    volatile LAS unsigned* st;
};

__device__ __forceinline__ XcdBarrier xcd_barrier_post(unsigned* bar, volatile LAS unsigned* st) {
    XcdBarrier b; b.bar = bar; b.x = xb_xcc_id(); b.st = st;
    if (threadIdx.x == 0) (void)xb_add(&bar[XB_XCNT(b.x)], 1u);
    return b;
}
__device__ __forceinline__ void xcd_barrier_complete(unsigned* bar, unsigned x, unsigned& nloc, unsigned& nx) {
    const unsigned G = gridDim.x * gridDim.y * gridDim.z;
    unsigned sum, cnt, mine, sp = 0u;
    for (;;) {
        sum = 0u; cnt = 0u; mine = 0u;
#pragma unroll
        for (unsigned j = 0; j < 16; ++j) { const unsigned c = xb_ld(&bar[XB_XCNT(j)]); sum += c; cnt += (c > 0u) ? 1u : 0u; mine = (j == x) ? c : mine; }
        if (sum == G) break;
        __builtin_amdgcn_s_sleep(1);
        if ((++sp & 255u) == 0u) { if (xb_ld(&bar[XB_TMO])) break; if (sp > XB_SPIN_CAP) { atomicAdd(&bar[XB_TMO], 1u); break; } }
    }
    nloc = mine > 0u ? mine : 1u; nx = cnt > 0u ? cnt : 1u;
}

__device__ __forceinline__ void xcd_barrier(const XcdBarrier& b) {
    asm volatile("s_waitcnt vmcnt(0)" ::: "memory");
    __syncthreads();
    if (threadIdx.x == 0) {
        unsigned* bar = b.bar;
        __builtin_amdgcn_s_waitcnt(0);
        unsigned nloc = b.st[0], nx = b.st[1];
        if (nloc == 0u) { xcd_barrier_complete(bar, b.x, nloc, nx); b.st[0] = nloc; b.st[1] = nx; }
        const unsigned old = xb_add(&bar[XB_XSUB(b.x)], 1u);
        const unsigned gen = old / nloc;
        if (old + 1u == (gen + 1u) * nloc) {
            __builtin_amdgcn_fence(__ATOMIC_RELEASE, "agent");
            asm volatile("s_waitcnt vmcnt(0)" ::: "memory");
            const unsigned og = xb_add(&bar[XB_TOP], 1u);
            const unsigned tg = og / nx;
            if (og + 1u == (tg + 1u) * nx) xb_add(&bar[XB_TOPGEN], 1u);
            else XB_SPIN(xb_ld(&bar[XB_TOPGEN]) == tg, bar);
            __builtin_amdgcn_fence(__ATOMIC_ACQUIRE, "agent");
            xb_add(&bar[XB_XGEN(b.x)], 1u);
            asm volatile("s_waitcnt vmcnt(0)" ::: "memory");
        } else {
            XB_SPIN(xb_ld(&bar[XB_XGEN(b.x)]) == gen, bar);
            __builtin_amdgcn_fence(__ATOMIC_ACQUIRE, "agent");
            asm volatile("s_waitcnt vmcnt(0)" ::: "memory");
        }
    }
    __syncthreads();
}


#define LAYER(l) do { \
        const int pb = 1 + 8 * l; \
        if (IN(pb + 0)) { PHB(); if (l == 1) prep_weights(F, 1); p1_norm(F, l); SEAM(pb + 0); } \
        if (IN(pb + 1)) { PHB(); \
            pg8::Gemm g{(const bf16_t*)(F.ws + WS_XN), (const bf16_t*)(F.ws + WS_WIN), NT, NIN, DM, DM, DM}; pg8::StaticOrder S; S.init(NT, NIN, F.G, F.bid); \
            EpiIn E{F.ws, l}; \
            pg8::gemm_phase<EpiIn, pg8::StaticOrder, true, true>(F.lds, F.wave, g, S, E); \
            SEAM(pb + 1); \
        } \
        if (IN(pb + 2)) { PHB(); \
            pg8::Gemm g{(const bf16_t*)(F.ws + WS_QLAT), (const bf16_t*)(F.ws + WS_WQ), NT, 768, 256, 256, 256}; pg8::StaticOrder S; S.init(NT, 768, F.G, F.bid); \
            EpiQ E{F.ws, l}; \
            pg8::gemm_phase<EpiQ, pg8::StaticOrder, true, true>(F.lds, F.wave, g, S, E); \
            p3a_extras(F, l); \
            SEAM(pb + 2); \
        } \
        if (IN(pb + 3)) { PHB(); p3b_ssd(F, l); SEAM(pb + 3); } \
        if (IN(pb + 4)) { PHB(); p3c_rwkv(F, l); SEAM(pb + 4); } \
        if (IN(pb + 5)) { PHB(); p4_mix(F); SEAM(pb + 5); } \
        if (IN(pb + 6)) { PHB(); p5_assemble(F, l); SEAM(pb + 6); } \
        if (IN(pb + 7)) { PHB(); \
            pg8::Gemm g{(const bf16_t*)(F.ws + WS_GATES), (const bf16_t*)(F.ws + WS_WOUT), NT, DM, 1536, 1536, 1536}; pg8::StaticOrder S; S.init(NT, DM, F.G, F.bid); \
            EpiOut E{(l == 0) ? INP(I_X) : F.out, F.out, (const float*)(F.ws + WS_CTL + CTL_MOD) + (size_t)(l * 2) * 3072 + 2048}; \
            pg8::gemm_phase<EpiOut, pg8::StaticOrder, true, true>(F.lds, F.wave, g, S, E); \
            SEAM(pb + 7); \
        } \
    } while (0)
__global__ void __launch_bounds__(NTHR, 2) mk_fwd(Args args) {
    extern __shared__ __attribute__((aligned(16))) unsigned char lds_raw[];
    Ctx F; F.lds = (LAS unsigned char*)lds_raw; F.tid = threadIdx.x; F.lane = F.tid & 63; F.wave = __builtin_amdgcn_readfirstlane(F.tid >> 6);
    F.G = gridDim.x; F.bid = blockIdx.x; F.ws = args.ws; F.out = args.out; F.in = args.in;
    const int wave0 = F.wave;
    cg::grid_group grid = cg::this_grid();
    volatile LAS unsigned* xst = (volatile LAS unsigned*)(F.lds + LDS_BYTES - 256);
    if (threadIdx.x < 2) xst[threadIdx.x] = 0u;
    __syncthreads();
    const XcdBarrier xbar = xcd_barrier_post((unsigned*)(args.ws + WS_CTL) + 4096, xst);
#if MK_PER_PHASE
    const int lo = args.ph_lo, hi = args.ph_hi;
#else
    constexpr int lo = 0, hi = 18;
#endif
#ifndef MK_ONLY
#define MK_ONLY -1
#endif
#define IN(k) (lo <= (k) && (k) < hi && (MK_ONLY < 0 || MK_ONLY == ((k) == 0 ? 0 : (k) == 17 ? 17 : 1 + ((k) - 1) % 8)))
#if MK_PER_PHASE
#define SEAM(k) do { } while (0)
#else
#define SEAM(k) do { if ((k) == 0) grid.sync(); else xcd_barrier(xbar); } while (0)
#endif
#define PHB() do { int b_ = blockIdx.x, g_ = gridDim.x, v_ = wave0; asm volatile("" : "+s"(b_), "+s"(g_), "+s"(v_)); F.bid = b_; F.G = g_; F.wave = v_; int t_ = v_ * 64 + (int)__builtin_amdgcn_mbcnt_hi(~0u, __builtin_amdgcn_mbcnt_lo(~0u, 0u)); asm volatile("; PHASE_MARK %0" : "+v"(t_)); F.tid = t_; F.lane = t_ & 63; unsigned wl_ = __builtin_amdgcn_readfirstlane((unsigned)(uintptr_t)args.ws), wh_ = __builtin_amdgcn_readfirstlane((unsigned)((uintptr_t)args.ws >> 32)), ol_ = __builtin_amdgcn_readfirstlane((unsigned)(uintptr_t)args.out), oh_ = __builtin_amdgcn_readfirstlane((unsigned)((uintptr_t)args.out >> 32)); asm volatile("" : "+s"(wl_), "+s"(wh_), "+s"(ol_), "+s"(oh_)); F.ws = (unsigned char*)(GAS unsigned char*)(((uintptr_t)wh_ << 32) | wl_); F.out = (float*)(GAS float*)(((uintptr_t)oh_ << 32) | ol_); } while (0)
    if (IN(0)) { PHB(); p0_prologue(F); SEAM(0); }
    LAYER(0);
    LAYER(1);
    if (IN(17)) { PHB(); p7_final(F); }
#ifndef MK_RERUN
#define MK_RERUN 0
#endif
#define PHB2() do { int b_ = blockIdx.x, g_ = gridDim.x, v_ = wave0; asm volatile("" : "+s"(b_), "+s"(g_), "+s"(v_)); F.bid = b_; F.G = g_; F.wave = v_; int t_ = v_ * 64 + fresh_lane(); F.tid = t_; F.lane = t_ & 63; } while (0)
#if MK_RERUN
    { constexpr int l = 1;
    if (MK_RERUN & 1) { xcd_barrier(xbar); PHB2(); p1_norm(F, l); }
    if (MK_RERUN & 2) { xcd_barrier(xbar); PHB2(); pg8::Gemm g{(const bf16_t*)(F.ws + WS_XN), (const bf16_t*)(F.ws + WS_WIN), NT, NIN, DM, DM, DM}; pg8::StaticOrder S; S.init(NT, NIN, F.G, F.bid); EpiIn E{F.ws, l}; pg8::gemm_phase<EpiIn, pg8::StaticOrder, true, true>(F.lds, F.wave, g, S, E); }
    if (MK_RERUN & 4) { xcd_barrier(xbar); PHB2(); pg8::Gemm g{(const bf16_t*)(F.ws + WS_QLAT), (const bf16_t*)(F.ws + WS_WQ), NT, 768, 256, 256, 256}; pg8::StaticOrder S; S.init(NT, 768, F.G, F.bid); EpiQ E{F.ws, l}; pg8::gemm_phase<EpiQ, pg8::StaticOrder, true, true>(F.lds, F.wave, g, S, E); p3a_extras(F, l); }
    if (MK_RERUN & 8) { xcd_barrier(xbar); PHB2(); p3b_ssd(F, l); }
    if (MK_RERUN & 16) { xcd_barrier(xbar); PHB2(); p3c_rwkv(F, l); }
    if (MK_RERUN & 32) { xcd_barrier(xbar); PHB2(); p4_mix(F); }
    if (MK_RERUN & 512) { xcd_barrier(xbar); PHB2(); p4_mix(F, 1); }
    if (MK_RERUN & 1024) { xcd_barrier(xbar); PHB2(); p4_mix(F, 2); }
    if (MK_RERUN & 2048) { xcd_barrier(xbar); PHB2(); p4_mix(F, 2 | 4); }
    if (MK_RERUN & 4096) { xcd_barrier(xbar); PHB2(); p4_mix(F, 2 | 8); }
    if (MK_RERUN & 64) { xcd_barrier(xbar); PHB2(); p5_assemble(F, l); }
    if (MK_RERUN & 128) { xcd_barrier(xbar); PHB2(); pg8::Gemm g{(const bf16_t*)(F.ws + WS_GATES), (const bf16_t*)(F.ws + WS_WOUT), NT, DM, 1536, 1536, 1536}; pg8::StaticOrder S; S.init(NT, DM, F.G, F.bid);
        EpiOut E{INP(I_X), (float*)(F.ws + WS_XBC), (const float*)(F.ws + WS_CTL + CTL_MOD) + (size_t)(l * 2) * 3072 + 2048}; pg8::gemm_phase<EpiOut, pg8::StaticOrder, true, true>(F.lds, F.wave, g, S, E); }
    }
#endif
#undef IN
#undef SEAM
}
constexpr int N_PHASES = 18;

extern "C" void kernel_launch(void* const* d_in, const int* in_sizes, int n_in, void* d_out, int out_size, void* d_ws, size_t ws_size, hipStream_t stream) {
    static int grid = 0;
    if (grid == 0) {
        if (n_in != 31 || out_size != NT * DM || ws_size < WS_END) { fprintf(stderr, "kernel_launch: unexpected shapes (n_in %d, out %d, ws %zu)\n", n_in, out_size, ws_size); grid = -1; return; }
        int dev = 0, cus = 0, per_cu = 0;
        hipGetDevice(&dev); hipDeviceGetAttribute(&cus, hipDeviceAttributeMultiprocessorCount, dev);
        if (hipFuncSetAttribute((const void*)mk_fwd, hipFuncAttributeMaxDynamicSharedMemorySize, LDS_BYTES) != hipSuccess) { fprintf(stderr, "kernel_launch: hipFuncSetAttribute failed\n"); grid = -1; return; }
        hipOccupancyMaxActiveBlocksPerMultiprocessor(&per_cu, (const void*)mk_fwd, NTHR, LDS_BYTES);
        (void)hipGetLastError();
        if (per_cu < 1) per_cu = 1;
        grid = cus;
        fprintf(stderr, "kernel_launch: cus %d, occupancy query %d block(s)/CU, grid %d\n", cus, per_cu, grid);
    }
    if (grid < 0) return;
    hipMemsetAsync((char*)d_ws + WS_CTL, 0, CTL_BYTES, stream);
    Args a{};
    for (int i = 0; i < 31; ++i) a.in[i] = (const float*)d_in[i];
    a.out = (float*)d_out; a.ws = (unsigned char*)d_ws;
#if MK_PER_PHASE
    for (int p = 0; p < N_PHASES; ++p) { a.ph_lo = p; a.ph_hi = p + 1; hipLaunchKernelGGL(mk_fwd, dim3(grid), dim3(NTHR), LDS_BYTES, stream, a); }
#else
    a.ph_lo = 0; a.ph_hi = N_PHASES;
    void* params[] = {&a};
    hipError_t e = hipLaunchCooperativeKernel((const void*)mk_fwd, dim3(grid), dim3(NTHR), params, LDS_BYTES, stream);
    if (e != hipSuccess) fprintf(stderr, "kernel_launch: cooperative launch failed: %s\n", hipGetErrorString(e));
#endif
}
```

```cpp
#include <hip/hip_runtime.h>
#include <hip/hip_cooperative_groups.h>
#include <cstdio>
#include <cstdint>
namespace cg = cooperative_groups;

#define LAS __attribute__((address_space(3)))
#define GAS __attribute__((address_space(1)))
typedef unsigned short bf16_t;
typedef short bf16x8 __attribute__((ext_vector_type(8)));
typedef float f32x4 __attribute__((ext_vector_type(4)));
typedef float f32x2 __attribute__((ext_vector_type(2)));
typedef float f32x16 __attribute__((ext_vector_type(16)));
typedef unsigned u32x4 __attribute__((ext_vector_type(4)));
typedef unsigned u32x2 __attribute__((ext_vector_type(2)));
typedef short v4i16_t __attribute__((ext_vector_type(4)));

#ifndef MK_PER_PHASE
#define MK_PER_PHASE 0
#endif

namespace pg8 {
constexpr int BM = 256, BK = 64, HALF = 128, HTB = HALF * BK * 2, STAGE_BYTES = 8 * HTB, NXCD = 8, WGM = 8;
__host__ __device__ __forceinline__ int lds_byte(int r, int c) { const int st = (r >> 4) * 2 + (c >> 5), rr = r & 15, cc = c & 31, ob = rr * 64 + cc * 2; return st * 1024 + (ob ^ (((ob >> 9) & 1) << 5)); }
__host__ __device__ __forceinline__ void stage_rc(int b, int& R, int& C) { const int st = b / 1024, sb = b % 1024, swz = sb ^ (((sb >> 9) & 1) << 5); R = (st >> 1) * 16 + swz / 64; C = (st & 1) * 32 + (swz % 64) / 2; }
__host__ __device__ __forceinline__ int perm32(int rho) { const int n = rho >> 4, i = rho & 15; return 8 * (i >> 2) + 4 * n + (i & 3); }
struct Unit { int pm, pn; };
struct Gemm { const bf16_t* A; const bf16_t* Bt; int M, N, K, lda, ldb; };
struct StaticOrder {
    int nM, nN, nwg, G, c;
    __host__ __device__ void init(int M, int N, int G_, int c_) { nM = M / BM; nN = N / BM; nwg = nM * nN; G = G_; c = c_; }
    __host__ __device__ bool next(int i, Unit& u) const {
        const long L = (long)i * G + c; if (L >= nwg) return false;
        int wgid = (int)L; { const int q = nwg / NXCD, r = nwg % NXCD, xcd = wgid % NXCD, off = wgid / NXCD; wgid = (xcd < r ? xcd * (q + 1) : r * (q + 1) + (xcd - r) * q) + off; }
        const int nig = WGM * nN, gid = wgid / nig, fm = gid * WGM, gsz = (nM - fm) < WGM ? (nM - fm) : WGM;
        u.pm = fm + ((wgid % nig) % gsz); u.pn = (wgid % nig) / gsz; return true;
    }
};
template <class Epi, class Sched, bool ALIGN_EPI, bool SP2>
__device__ __forceinline__ void gemm_phase(LAS unsigned char* lds, int wave_id, const Gemm g, const Sched& S, const Epi& E) {
    int lane = (int)__builtin_amdgcn_mbcnt_hi(~0u, __builtin_amdgcn_mbcnt_lo(~0u, 0u)); asm volatile("" : "+v"(lane));
    const int wid = wave_id, tid = wid * 64 + lane, wr = wid >> 2, wc = wid & 3, fr = lane & 15, fq = lane >> 4;
    const int K = g.K, nt = K / BK;
    unsigned voffA[2], voffB[2];
#pragma unroll
    for (int i = 0; i < 2; ++i) { int R, C; stage_rc(tid * 16 + i * 8192, R, C); const int Rb = (R & ~31) + perm32(R & 31);
        voffA[i] = (unsigned)(R * g.lda + C) * 2u; voffB[i] = (unsigned)(Rb * g.ldb + C) * 2u; }
    const size_t kstep = (size_t)(BK * 2);
    const size_t hstepA = (size_t)HALF * g.lda * 2, hstepB = (size_t)HALF * g.ldb * 2;
    const size_t tstepA = 2 * hstepA, tstepB = 2 * hstepB;
    const unsigned ldsw = (unsigned)wid * 1024u, lds0 = (unsigned)(uintptr_t)lds;
    const int aoff = lds_byte(wr * 64 + fr, fq * 8), boff = lds_byte(wc * 32 + fr, fq * 8);
#define PG8_SA(b, h) (((b) * 2 + (h)) * HTB)
#define PG8_SB(b, h) ((4 + (b) * 2 + (h)) * HTB)
#define PG8_STAGE(bufoff, gbase, voff) do { _Pragma("unroll") for (int _i = 0; _i < 2; ++_i) { unsigned keep_; \
        asm volatile("s_mov_b32 %0, m0\n\ts_mov_b32 m0, %3\n\ts_nop 0\n\tglobal_load_lds_dwordx4 %1, %2\n\ts_mov_b32 m0, %0" : "=&s"(keep_) : "v"((voff)[_i]), "s"((const char*)(gbase)), "s"(lds0 + (unsigned)(bufoff) + ldsw + (unsigned)(_i * 8192)) : "memory"); } } while (0)
#define PG8_LDA(dst, b, h) do { _Pragma("unroll") for (int m = 0; m < 4; ++m) _Pragma("unroll") for (int k = 0; k < 2; ++k) dst[m][k] = *(const LAS bf16x8*)(lds + PG8_SA(b, h) + aoff + m * 2048 + k * 1024); } while (0)
#define PG8_LDB(dst, b, h) do { _Pragma("unroll") for (int n = 0; n < 2; ++n) _Pragma("unroll") for (int k = 0; k < 2; ++k) dst[n][k] = *(const LAS bf16x8*)(lds + PG8_SB(b, h) + boff + n * 2048 + k * 1024); } while (0)
#define PG8_MMA(ai, bj, At, Bt) do { __builtin_amdgcn_s_setprio(1); _Pragma("unroll") for (int m = 0; m < 4; ++m) _Pragma("unroll") for (int n = 0; n < 2; ++n) _Pragma("unroll") for (int k = 0; k < 2; ++k) \
        acc[ai][bj][m][n] = __builtin_amdgcn_mfma_f32_16x16x32_bf16(Bt[n][k], At[m][k], acc[ai][bj][m][n], 0, 0, 0); __builtin_amdgcn_s_setprio(0); } while (0)
#define PG8_WAIT_V(n) asm volatile("s_waitcnt vmcnt(" #n ")" ::: "memory")
#define PG8_WAIT_L(n) asm volatile("s_waitcnt lgkmcnt(" #n ")" ::: "memory")
#define PG8_BAR __builtin_amdgcn_s_barrier()
#define PG8_SCHED __builtin_amdgcn_sched_barrier(0)
    Unit cur, nxt; int ui = 0;
    if (!S.next(0, cur)) return;
    f32x4 acc[2][2][4][2];
#pragma unroll
    for (int a = 0; a < 2; ++a)
#pragma unroll
        for (int b = 0; b < 2; ++b)
#pragma unroll
            for (int m = 0; m < 4; ++m)
#pragma unroll
                for (int n = 0; n < 2; ++n) acc[a][b][m][n] = (f32x4){0.f, 0.f, 0.f, 0.f};
    bf16x8 At[4][2], B0[2][2], B1[2][2];
    const char* cA = (const char*)g.A + (size_t)cur.pm * tstepA; const char* cB = (const char*)g.Bt + (size_t)cur.pn * tstepB;
    if constexpr (SP2) {
        PG8_STAGE(PG8_SB(0, 0), cB, voffB); PG8_STAGE(PG8_SB(0, 1), cB + hstepB, voffB); PG8_STAGE(PG8_SA(0, 0), cA, voffA); PG8_STAGE(PG8_SA(0, 1), cA + hstepA, voffA);
        if (wr == 1) PG8_BAR;
        PG8_WAIT_V(2); PG8_BAR;
        PG8_STAGE(PG8_SB(1, 0), cB + kstep, voffB); PG8_STAGE(PG8_SA(1, 0), cA + kstep, voffA); PG8_STAGE(PG8_SB(1, 1), cB + hstepB + kstep, voffB);
        PG8_WAIT_V(6); PG8_BAR;
    } else {
        PG8_STAGE(PG8_SB(0, 0), cB, voffB); PG8_STAGE(PG8_SA(0, 0), cA, voffA); PG8_STAGE(PG8_SB(0, 1), cB + hstepB, voffB); PG8_STAGE(PG8_SA(0, 1), cA + hstepA, voffA);
        if (wr == 1) PG8_BAR;
        PG8_WAIT_V(4); PG8_BAR;
        PG8_STAGE(PG8_SB(1, 0), cB + kstep, voffB); PG8_STAGE(PG8_SA(1, 0), cA + kstep, voffA); PG8_STAGE(PG8_SB(1, 1), cB + hstepB + kstep, voffB);
        PG8_WAIT_V(6); PG8_BAR;
    }
    for (;;) {
        const bool has_next = S.next(ui + 1, nxt);
        const char* nA = has_next ? (const char*)g.A + (size_t)nxt.pm * tstepA : cA; const char* nB = has_next ? (const char*)g.Bt + (size_t)nxt.pn * tstepB : cB;
        for (int t = 0; t < nt; t += 2) {
            const bool last = (t == nt - 2);
            const char* a1 = cA + (size_t)(t + 1) * kstep;
            const char* a2 = last ? nA : cA + (size_t)(t + 2) * kstep; const char* b2 = last ? nB : cB + (size_t)(t + 2) * kstep;
            const char* a3 = a2 + kstep; const char* b3 = b2 + kstep;
            if constexpr (SP2) {
            PG8_LDB(B0, 0, 0); PG8_LDB(B1, 0, 1); PG8_SCHED; PG8_LDA(At, 0, 0); PG8_STAGE(PG8_SA(1, 1), a1 + hstepA, voffA);
            PG8_WAIT_V(8); PG8_WAIT_L(0); PG8_BAR; PG8_MMA(0, 0, At, B0); PG8_MMA(0, 1, At, B1); PG8_BAR; PG8_SCHED;
            PG8_LDA(At, 0, 1); PG8_STAGE(PG8_SB(0, 0), b2, voffB); PG8_STAGE(PG8_SB(0, 1), b2 + hstepB, voffB); PG8_STAGE(PG8_SA(0, 0), a2, voffA);
            PG8_WAIT_V(8); PG8_WAIT_L(0); PG8_BAR; PG8_MMA(1, 0, At, B0); PG8_MMA(1, 1, At, B1); PG8_BAR; PG8_SCHED;
            PG8_LDB(B0, 1, 0); PG8_LDB(B1, 1, 1); PG8_SCHED; PG8_LDA(At, 1, 0); PG8_STAGE(PG8_SA(0, 1), a2 + hstepA, voffA);
            PG8_WAIT_V(8); PG8_WAIT_L(0); PG8_BAR; PG8_MMA(0, 0, At, B0); PG8_MMA(0, 1, At, B1); PG8_BAR; PG8_SCHED;
            PG8_LDA(At, 1, 1); PG8_STAGE(PG8_SB(1, 0), b3, voffB); PG8_STAGE(PG8_SB(1, 1), b3 + hstepB, voffB); PG8_STAGE(PG8_SA(1, 0), a3, voffA);
            PG8_WAIT_V(8); PG8_WAIT_L(0); PG8_BAR; PG8_MMA(1, 0, At, B0); PG8_MMA(1, 1, At, B1); PG8_BAR; PG8_SCHED;
            } else {
            PG8_LDB(B0, 0, 0); PG8_SCHED; PG8_LDA(At, 0, 0); PG8_STAGE(PG8_SA(1, 1), a1 + hstepA, voffA);
            PG8_WAIT_L(8); PG8_BAR; PG8_WAIT_L(0); PG8_MMA(0, 0, At, B0); PG8_BAR; PG8_SCHED;
            PG8_LDB(B1, 0, 1); PG8_STAGE(PG8_SB(0, 0), b2, voffB);
            PG8_BAR; PG8_WAIT_L(0); PG8_MMA(0, 1, At, B1); PG8_BAR;
            PG8_LDA(At, 0, 1); PG8_STAGE(PG8_SA(0, 0), a2, voffA);
            PG8_BAR; PG8_WAIT_L(0); PG8_MMA(1, 0, At, B0); PG8_BAR; PG8_SCHED;
            PG8_STAGE(PG8_SB(0, 1), b2 + hstepB, voffB);
            PG8_WAIT_V(6); PG8_BAR; PG8_MMA(1, 1, At, B1); PG8_BAR;
            PG8_LDB(B0, 1, 0); PG8_SCHED; PG8_LDA(At, 1, 0); PG8_STAGE(PG8_SA(0, 1), a2 + hstepA, voffA);
            PG8_WAIT_L(8); PG8_BAR; PG8_WAIT_L(0); PG8_MMA(0, 0, At, B0); PG8_BAR; PG8_SCHED;
            PG8_LDB(B1, 1, 1); PG8_STAGE(PG8_SB(1, 0), b3, voffB);
            PG8_BAR; PG8_WAIT_L(0); PG8_MMA(0, 1, At, B1); PG8_BAR;
            PG8_LDA(At, 1, 1); PG8_STAGE(PG8_SA(1, 0), a3, voffA);
            PG8_BAR; PG8_WAIT_L(0); PG8_MMA(1, 0, At, B0); PG8_BAR; PG8_SCHED;
            PG8_STAGE(PG8_SB(1, 1), b3 + hstepB, voffB);
            PG8_WAIT_V(6); PG8_BAR; PG8_MMA(1, 1, At, B1); PG8_BAR;
            }
        }
        if constexpr (ALIGN_EPI) { if (wr == 0) PG8_BAR; }
        E(acc, cur, wr, wc, fr, fq);
        if (!has_next) break;
#pragma unroll
        for (int a = 0; a < 2; ++a)
#pragma unroll
            for (int b = 0; b < 2; ++b)
#pragma unroll
                for (int m = 0; m < 4; ++m)
#pragma unroll
                    for (int n = 0; n < 2; ++n) acc[a][b][m][n] = (f32x4){0.f, 0.f, 0.f, 0.f};
        cur = nxt; cA = nA; cB = nB; ++ui;
        if constexpr (ALIGN_EPI) { if (wr == 1) PG8_BAR; }
    }
    PG8_WAIT_V(0);
    if constexpr (!ALIGN_EPI) { if (wr == 0) PG8_BAR; }
    PG8_BAR;
#undef PG8_SA
#undef PG8_SB
#undef PG8_STAGE
#undef PG8_LDA
#undef PG8_LDB
#undef PG8_MMA
#undef PG8_WAIT_V
#undef PG8_WAIT_L
#undef PG8_BAR
#undef PG8_SCHED
}
}

constexpr int NT = 16384, SEQ = 8192, DM = 1024, DIN = 4680, NIN = 4864, NCHK = 256, NWAVES = 8, NTHR = 512;
constexpr float EPS = 1e-6f, GN_EPS = 64e-5f, DECAY_SCALE = 0.606531f;
constexpr float QSCALE = 0.07216878364870322f * 1.4426950408889634f;
constexpr size_t MiB = 1u << 20;
constexpr size_t WS_CTL = 0, CTL_BYTES = 1 * MiB;
constexpr size_t CTL_MOD = 65536;
constexpr size_t CTL_SSQ = 131072;
constexpr size_t WS_WIN = 1 * MiB;
constexpr size_t WS_CB = WS_WIN, WS_ECUM = WS_WIN + 8 * MiB, WS_CDEC = WS_ECUM + 512 * 1024;
constexpr size_t WS_WQ = 10 * MiB + 512 * 1024;
constexpr size_t WS_WUV = 11 * MiB;
constexpr size_t WS_WLW = 11 * MiB + 512 * 1024;
constexpr size_t WS_WLA = WS_WLW + 65536;
constexpr size_t WS_WOUT = 12 * MiB;
constexpr size_t WS_XN = 15 * MiB;
constexpr size_t WS_TT = WS_XN, WS_QE = WS_XN + 16 * MiB;
constexpr size_t WS_QLAT = 47 * MiB, WS_KVL = 55 * MiB;
constexpr size_t WS_OL = WS_QLAT;
constexpr size_t WS_GATES = 63 * MiB;
constexpr size_t WS_XBC = 111 * MiB;
constexpr size_t WS_R = 143 * MiB, WS_K = 159 * MiB, WS_V = 175 * MiB;
constexpr size_t WS_F = 191 * MiB;
constexpr size_t WS_Q = 200 * MiB;
constexpr size_t WS_KVB = 224 * MiB;
constexpr size_t WS_YD = 230 * MiB;
constexpr size_t WS_ROPE = 246 * MiB;
constexpr size_t WS_HX = 250 * MiB;
constexpr size_t WS_HRKV = WS_HX + 1536 * 1024;
constexpr size_t WS_HF = WS_HRKV + 768 * 1024;
constexpr size_t WS_END = 253 * MiB;
constexpr int LDS_BYTES = 152 * 1024;

#define LDS_WAIT() asm volatile("s_waitcnt lgkmcnt(0)" ::: "memory")
__device__ __forceinline__ unsigned f2bf(float f) { unsigned u = __builtin_bit_cast(unsigned, f); return (u + 0x7fffu + ((u >> 16) & 1u)) >> 16; }
__device__ __forceinline__ unsigned pk2(float lo, float hi) { return f2bf(lo) | (f2bf(hi) << 16); }
__device__ __forceinline__ float bf2f(unsigned short b) { return __builtin_bit_cast(float, (unsigned)b << 16); }
__device__ __forceinline__ float bflo(unsigned w) { return __builtin_bit_cast(float, w << 16); }
__device__ __forceinline__ float bfhi(unsigned w) { return __builtin_bit_cast(float, w & 0xffff0000u); }
__device__ __forceinline__ float wave_sum(float v) {
#pragma unroll
    for (int o = 1; o < 64; o <<= 1) v += __shfl_xor(v, o);
    return v;
}
__device__ __forceinline__ float sigmoidf_(float x) { return 1.f / (1.f + __expf(-x)); }
__device__ __forceinline__ float siluf_(float x) { return x / (1.f + __expf(-x)); }
__device__ __forceinline__ int pi16(int n) { const int x = n & 15; return (n & ~15) | ((x >= 4 && x < 8) ? x + 4 : (x >= 8 && x < 12) ? x - 4 : x); }
__device__ __forceinline__ int sg32(int x) { return (x & ~31) | (16 * ((x >> 2) & 1) + 4 * ((x & 31) >> 3) + (x & 3)); }
__device__ __forceinline__ int crow(int r, int hi) { return (r & 3) + 8 * (r >> 2) + 4 * hi; }

template <int K> __device__ __forceinline__ f32x4 mma_tile(const LAS bf16_t* A, int lda, const LAS bf16_t* Bt, int ldb, int lane) {
    f32x4 acc = {0.f, 0.f, 0.f, 0.f};
    const LAS bf16_t* ap = A + (lane & 15) * lda + (lane >> 4) * 8;
    const LAS bf16_t* bp = Bt + (lane & 15) * ldb + (lane >> 4) * 8;
#pragma unroll
    for (int k = 0; k < K; k += 32) {
        const bf16x8 a = *(const LAS bf16x8*)(ap + k), b = *(const LAS bf16x8*)(bp + k);
        acc = __builtin_amdgcn_mfma_f32_16x16x32_bf16(a, b, acc, 0, 0, 0);
    }
    return acc;
}

struct Args {
    const float* in[31]; float* out; unsigned char* ws; int ph_lo, ph_hi;
};
struct Ctx {
    LAS unsigned char* lds; int tid, lane, wave, G, bid;
    unsigned char* ws; float* out;
    const float* const* in;
};
__device__ __forceinline__ const float* ldin(const float* const* in, int i) { asm volatile("" : "+s"(i)); return (const float*)(const GAS float*)in[i]; }
#define INP(i) ldin(F.in, i)
__device__ __forceinline__ int fresh_lane() { int l_ = (int)__builtin_amdgcn_mbcnt_hi(~0u, __builtin_amdgcn_mbcnt_lo(~0u, 0u)); asm volatile("" : "+v"(l_)); return l_; }
enum { I_X = 0, I_C, I_POS, I_ADAW, I_ADAB, I_NORMW, I_WIN, I_QNW, I_WUQ, I_KVNW, I_WUKV, I_CONVW, I_CONVB, I_DTB, I_ALOG, I_DSKIP, I_SSDNW,
       I_MURKV, I_MUW, I_MUA, I_W0, I_WLB, I_A0, I_ALB, I_KK, I_KA, I_RK, I_LNXW, I_LNXB, I_WOUT, I_FNW };

__device__ __forceinline__ int win_src_col(int n) {
    if (n < 448) return n;
    if (n < 512) return -1;
    if (n < 1024) return 448 + (n - 512);
    if (n < 1536) return 960 + (n - 1024);
    if (n < 2560) return 1472 + (n - 1536);
    if (n < 3072) return 2504 + (n - 2560);
    if (n < 3584) return 3016 + (n - 3072);
    if (n < 4096) return 3528 + (n - 3584);
    if (n < 4608) return 4168 + (n - 4096);
    if (n < 4672) return 4040 + (n - 4608);
    if (n < 4736) return 4104 + (n - 4672);
    if (n < 4744) return 2496 + (n - 4736);
    return -1;
}
template <class Src> __device__ __forceinline__ void transpose_item(const Src& src, bf16_t* WT, int ldw, LAS float* scr, int kb, int nb, int lane) {
    const int k0 = 64 * kb, n0 = 32 * nb;
#pragma unroll 8
    for (int i = 0; i < 32; ++i) { const int kk = 2 * i + (lane >> 5); scr[kk * 33 + (lane & 31)] = src(k0 + kk, n0 + (lane & 31)); }
    LDS_WAIT();
    const int c = lane & 7;
#pragma unroll
    for (int j = 0; j < 4; ++j) { const int n = (lane >> 3) + 8 * j; const LAS float* s = scr + (8 * c) * 33 + n;
        u32x4 o; o.x = pk2(s[0 * 33], s[1 * 33]); o.y = pk2(s[2 * 33], s[3 * 33]); o.z = pk2(s[4 * 33], s[5 * 33]); o.w = pk2(s[6 * 33], s[7 * 33]);
        *(u32x4*)(WT + (size_t)(n0 + n) * ldw + k0 + 8 * c) = o; }
    LDS_WAIT();
}
__device__ __forceinline__ void prep_weights(const Ctx& F, int l) {
    LAS float* scr = (LAS float*)(F.lds + F.wave * 8448);
    const int gw = F.bid * NWAVES + F.wave, NGW = F.G * NWAVES;
    const float* w_in = INP(I_WIN) + (size_t)l * DM * DIN;
    const float* w_out = INP(I_WOUT) + (size_t)l * 1536 * 1024;
    const float* wlb = INP(I_WLB) + (size_t)l * 64 * 512;
    const float* alb = INP(I_ALB) + (size_t)l * 64 * 512;
    bf16_t* WIN = (bf16_t*)(F.ws + WS_WIN); bf16_t* WOUT = (bf16_t*)(F.ws + WS_WOUT); bf16_t* WLW = (bf16_t*)(F.ws + WS_WLW); bf16_t* WLA = (bf16_t*)(F.ws + WS_WLA);
    constexpr int I_IN = 16 * (NIN / 32), I_OUT = 24 * 32, I_LW = 16, I_LA = 16, NITEMS = I_IN + I_OUT + I_LW + I_LA;
    for (int it = gw; it < NITEMS; it += NGW) {
        int r = it;
        if (r < I_IN) { const int kb = r / (NIN / 32), nb = r % (NIN / 32);
            transpose_item([&](int k, int n) { const int sc = win_src_col(n); return sc >= 0 ? w_in[(size_t)k * DIN + sc] : 0.f; }, WIN, 1024, scr, kb, nb, F.lane); continue; }
        r -= I_IN;
        if (r < I_OUT) { const int kb = r / 32, nb = r % 32;
            transpose_item([&](int k, int n) { return w_out[(size_t)k * 1024 + n]; }, WOUT, 1536, scr, kb, nb, F.lane); continue; }
        r -= I_OUT;
        if (r < I_LW) { transpose_item([&](int k, int n) { return wlb[k * 512 + n]; }, WLW, 64, scr, 0, r, F.lane); continue; }
        r -= I_LW;
        transpose_item([&](int k, int n) { return alb[k * 512 + n]; }, WLA, 64, scr, 0, r, F.lane);
    }
    const float* wuq = INP(I_WUQ) + (size_t)l * 256 * 768; const float* wukv = INP(I_WUKV) + (size_t)l * 128 * 1024; const float* qnw = INP(I_QNW) + l * 256;
    bf16_t* WQ = (bf16_t*)(F.ws + WS_WQ); bf16_t* WUV = (bf16_t*)(F.ws + WS_WUV);
    const int gt = F.bid * NTHR + F.tid, NGT = F.G * NTHR;
    for (int e = gt; e < 768 * 256; e += NGT) {
        const int n = e >> 8, k = e & 255, h = n / 192, idx = n % 192; float v;
        if (idx < 128) {
            const f32x4* a = (const f32x4*)(wuq + (size_t)k * 768 + h * 192); const f32x4* b = (const f32x4*)(wukv + (size_t)idx * 1024 + h * 256);
            float s = 0.f;
#pragma unroll 8
            for (int d = 0; d < 32; ++d) { const f32x4 x = a[d], y = b[d]; s += x.x * y.x + x.y * y.y + x.z * y.z + x.w * y.w; }
            v = s;
        } else v = wuq[(size_t)k * 768 + n];
        WQ[e] = (bf16_t)f2bf(v * qnw[k]);
    }
    for (int e = gt; e < 512 * 512; e += NGT) {
        const int n = e >> 9, k = e & 511, h = n >> 7, d = n & 127, h2 = k >> 7, c = k & 127;
        WUV[e] = (h == h2) ? (bf16_t)f2bf(wukv[(size_t)c * 1024 + h * 256 + 128 + d]) : (bf16_t)0;
    }
}
__device__ __forceinline__ void p0_prologue(const Ctx& F) {
    prep_weights(F, 0);
    const int gw = F.bid * NWAVES + F.wave, NGW = F.G * NWAVES;
    float* MOD = (float*)(F.ws + WS_CTL + CTL_MOD);
    for (int it = gw; it < 2 * 12 * 32; it += NGW) {
        const int l = it / 384, r = it % 384, cb = r / 32, ks = r % 32;
        const float* aw = INP(I_ADAW) + (size_t)l * DM * 3072 + (size_t)(ks * 32) * 3072 + cb * 256 + F.lane * 4;
        const float* cc = INP(I_C);
        f32x4 a0 = {0.f, 0.f, 0.f, 0.f}, a1 = a0;
#pragma unroll 8
        for (int k = 0; k < 32; ++k) { const f32x4 w = *(const f32x4*)(aw + (size_t)k * 3072); const float s0 = siluf_(cc[ks * 32 + k]), s1 = siluf_(cc[DM + ks * 32 + k]); a0 += w * s0; a1 += w * s1; }
        if (ks == 0) { const f32x4 bb = *(const f32x4*)(INP(I_ADAB) + l * 3072 + cb * 256 + F.lane * 4); a0 += bb; a1 += bb; }
        float* m0 = MOD + (size_t)(l * 2 + 0) * 3072 + cb * 256 + F.lane * 4; float* m1 = m0 + 3072;
#pragma unroll
        for (int j = 0; j < 4; ++j) { atomicAdd(m0 + j, a0[j]); atomicAdd(m1 + j, a1[j]); }
    }
    float* ROPE = (float*)(F.ws + WS_ROPE); const int* pos = (const int*)INP(I_POS);
    for (int e = F.bid * NTHR + F.tid; e < NT * 32; e += F.G * NTHR) {
        const int m = e >> 5, i = e & 31;
        const float invf = powf(10000.f, -(float)i / 32.f); const float ang = (float)pos[m] * invf;
        const double a = (double)ang; const double kq = __builtin_rint(a * 0.15915494309189535); const float rr = (float)(a - kq * 6.283185307179586);
        ROPE[(size_t)m * 64 + i] = cosf(rr); ROPE[(size_t)m * 64 + 32 + i] = sinf(rr);
    }
}
__device__ __forceinline__ void p1_norm(const Ctx& F, int l) {
    const float* xin = (l == 0) ? INP(I_X) : F.out;
    const float* nw = INP(I_NORMW) + l * DM; const float* MOD = (const float*)(F.ws + WS_CTL + CTL_MOD);
    bf16_t* XN = (bf16_t*)(F.ws + WS_XN);
    const int gw = F.bid * NWAVES + F.wave, NGW = F.G * NWAVES;
    for (int m = gw; m < NT; m += NGW) {
        const int b = m >> 13; const float* md = MOD + (size_t)(l * 2 + b) * 3072;
        const f32x4* xr = (const f32x4*)(xin + (size_t)m * DM) + F.lane;
        f32x4 v[4]; float s = 0.f;
#pragma unroll
        for (int j = 0; j < 4; ++j) { v[j] = xr[64 * j]; s += v[j].x * v[j].x + v[j].y * v[j].y + v[j].z * v[j].z + v[j].w * v[j].w; }
        const float rstd = 1.f / sqrtf(wave_sum(s) * (1.f / DM) + EPS);
        unsigned long long* o8 = (unsigned long long*)(XN + (size_t)m * DM) + F.lane;
#pragma unroll
        for (int j = 0; j < 4; ++j) { const int c0 = 4 * F.lane + 256 * j;
            const f32x4 w = *(const f32x4*)(nw + c0), sh = *(const f32x4*)(md + c0), sc = *(const f32x4*)(md + 1024 + c0);
            const f32x4 y = v[j] * rstd * w * (sc + 1.f) + sh;
            o8[64 * j] = (unsigned long long)pk2(y.x, y.y) | ((unsigned long long)pk2(y.z, y.w) << 32); }
    }
}
__device__ __forceinline__ u32x4 pack8(f32x4 a, f32x4 b) { u32x4 w; w.x = pk2(a[0], a[1]); w.y = pk2(a[2], a[3]); w.z = pk2(b[0], b[1]); w.w = pk2(b[2], b[3]); return w; }
struct EpiIn {
    unsigned char* ws; int l;
    __device__ __forceinline__ void operator()(const f32x4 (&acc)[2][2][4][2], const pg8::Unit& u, int wr, int wc, int fr, int fq) const {
        { int ln_ = (int)__builtin_amdgcn_mbcnt_hi(~0u, __builtin_amdgcn_mbcnt_lo(~0u, 0u)); asm volatile("" : "+v"(ln_)); fr = ln_ & 15; fq = ln_ >> 4; }
        const int pn = u.pn; size_t bo; int ld, c0;
        if (pn == 0) { bo = WS_QLAT; ld = 256; c0 = 0; } else if (pn == 1) { bo = WS_KVL; ld = 256; c0 = 0; }
        else if (pn < 4) { bo = WS_GATES; ld = 1536; c0 = (pn - 2) * 256; } else if (pn < 6) { bo = WS_GATES; ld = 1536; c0 = 512 + (pn - 4) * 256; }
        else if (pn < 10) { bo = WS_XBC; ld = 1024; c0 = (pn - 6) * 256; } else if (pn < 12) { bo = WS_R; ld = 512; c0 = (pn - 10) * 256; }
        else if (pn < 14) { bo = WS_K; ld = 512; c0 = (pn - 12) * 256; } else if (pn < 16) { bo = WS_V; ld = 512; c0 = (pn - 14) * 256; }
        else if (pn < 18) { bo = WS_GATES; ld = 1536; c0 = 1024 + (pn - 16) * 256; } else { bo = WS_F; ld = 144; c0 = 0; }
        bf16_t* base = (bf16_t*)(ws + bo); float* F = (float*)(ws + WS_F);
        float* ssq_q = (float*)(ws + WS_CTL + CTL_SSQ) + (size_t)(l * 2) * NT; float* ssq_kv = ssq_q + NT;
        const int row0 = u.pm * 256 + wr * 64 + fr, col0 = wc * 32 + 8 * fq;
        if (pn < 18) {
#pragma unroll
            for (int ai = 0; ai < 2; ++ai)
#pragma unroll
                for (int m = 0; m < 4; ++m) { const int row = row0 + ai * 128 + m * 16; bf16_t* rp = base + (size_t)row * ld + c0 + col0;
#pragma unroll
                    for (int bj = 0; bj < 2; ++bj) *(u32x4*)(rp + bj * 128) = pack8(acc[ai][bj][m][0], acc[ai][bj][m][1]);
                    if (pn < 2) { float s = 0.f;
#pragma unroll
                        for (int bj = 0; bj < 2; ++bj) if (pn == 0 || bj == 0) {
#pragma unroll
                            for (int n = 0; n < 2; ++n) { const f32x4 x = acc[ai][bj][m][n]; s += x[0] * x[0] + x[1] * x[1] + x[2] * x[2] + x[3] * x[3]; } }
                        s += __shfl_xor(s, 16); s += __shfl_xor(s, 32);
                        if (fq == 0) atomicAdd((pn == 0 ? ssq_q : ssq_kv) + row, s); } }
        } else {
#pragma unroll
            for (int ai = 0; ai < 2; ++ai)
#pragma unroll
                for (int m = 0; m < 4; ++m) { const int row = row0 + ai * 128 + m * 16;
#pragma unroll
                    for (int bj = 0; bj < 2; ++bj) { const int c = bj * 128 + col0; if (c < 136) { float* fp = F + (size_t)row * 144 + c; *(f32x4*)fp = acc[ai][bj][m][0]; *(f32x4*)(fp + 4) = acc[ai][bj][m][1]; } } }
        }
    }
};
struct EpiQ {
    unsigned char* ws; int l;
    __device__ __forceinline__ void operator()(const f32x4 (&acc)[2][2][4][2], const pg8::Unit& u, int wr, int wc, int fr, int fq) const {
        { int ln_ = (int)__builtin_amdgcn_mbcnt_hi(~0u, __builtin_amdgcn_mbcnt_lo(~0u, 0u)); asm volatile("" : "+v"(ln_)); fr = ln_ & 15; fq = ln_ >> 4; }
        bf16_t* Q = (bf16_t*)(ws + WS_Q); const float* ssq = (const float*)(ws + WS_CTL + CTL_SSQ) + (size_t)(l * 2) * NT;
        const int row0 = u.pm * 256 + wr * 64 + fr, c0 = u.pn * 256 + wc * 32 + 8 * fq;
#pragma unroll
        for (int ai = 0; ai < 2; ++ai)
#pragma unroll
            for (int m = 0; m < 4; ++m) { const int row = row0 + ai * 128 + m * 16; const float sc = QSCALE / sqrtf(ssq[row] * (1.f / 256.f) + EPS); bf16_t* qp = Q + (size_t)row * 768 + c0;
#pragma unroll
                for (int bj = 0; bj < 2; ++bj) *(u32x4*)(qp + bj * 128) = pack8(acc[ai][bj][m][0] * sc, acc[ai][bj][m][1] * sc); }
    }
};
struct EpiUV {
    bf16_t* gates;
    __device__ __forceinline__ void operator()(const f32x4 (&acc)[2][2][4][2], const pg8::Unit& u, int wr, int wc, int fr, int fq) const {
        { int ln_ = (int)__builtin_amdgcn_mbcnt_hi(~0u, __builtin_amdgcn_mbcnt_lo(~0u, 0u)); asm volatile("" : "+v"(ln_)); fr = ln_ & 15; fq = ln_ >> 4; }
        const int row0 = u.pm * 256 + wr * 64 + fr;
#pragma unroll
        for (int ai = 0; ai < 2; ++ai)
#pragma unroll
            for (int m = 0; m < 4; ++m) { asm volatile("" ::: "memory"); const int row = row0 + ai * 128 + m * 16;
#pragma unroll
                for (int bj = 0; bj < 2; ++bj) { const int c = u.pn * 256 + bj * 128 + wc * 32 + 8 * fq; u32x4* gp = (u32x4*)(gates + (size_t)row * 1536 + c); const u32x4 gw = *gp;
                    f32x4 v0 = acc[ai][bj][m][0], v1 = acc[ai][bj][m][1];
                    v0[0] *= siluf_(bflo(gw.x)); v0[1] *= siluf_(bfhi(gw.x)); v0[2] *= siluf_(bflo(gw.y)); v0[3] *= siluf_(bfhi(gw.y));
                    v1[0] *= siluf_(bflo(gw.z)); v1[1] *= siluf_(bfhi(gw.z)); v1[2] *= siluf_(bflo(gw.w)); v1[3] *= siluf_(bfhi(gw.w));
                    *gp = pack8(v0, v1); } }
    }
};
struct EpiOut {
    const float* xin; float* xout; const float* gate;
    __device__ __forceinline__ void operator()(const f32x4 (&acc)[2][2][4][2], const pg8::Unit& u, int wr, int wc, int fr, int fq) const {
        { int ln_ = (int)__builtin_amdgcn_mbcnt_hi(~0u, __builtin_amdgcn_mbcnt_lo(~0u, 0u)); asm volatile("" : "+v"(ln_)); fr = ln_ & 15; fq = ln_ >> 4; }
        const int row0 = u.pm * 256 + wr * 64 + fr;
#pragma unroll
        for (int bj = 0; bj < 2; ++bj) { const int c = u.pn * 256 + bj * 128 + wc * 32 + 8 * fq;
#pragma unroll
            for (int ai = 0; ai < 2; ++ai)
#pragma unroll
                for (int m = 0; m < 4; ++m) { const int row = row0 + ai * 128 + m * 16; const float* gp = gate + (size_t)(row >> 13) * 3072 + c;
                    const f32x4 g0 = *(const f32x4*)gp, g1 = *(const f32x4*)(gp + 4);
                    const size_t off = (size_t)row * DM + c; const f32x4 x0 = *(const f32x4*)(xin + off), x1 = *(const f32x4*)(xin + off + 4);
                    *(f32x4*)(xout + off) = x0 + g0 * acc[ai][bj][m][0]; *(f32x4*)(xout + off + 4) = x1 + g1 * acc[ai][bj][m][1]; } }
    }
};

__device__ __forceinline__ void p3a_extras(const Ctx& F, int l) {
    const int tid_ = F.wave * 64 + fresh_lane();
    const int gt = F.bid * NTHR + tid_, NGT = F.G * NTHR;
    const bf16_t* KVL = (const bf16_t*)(F.ws + WS_KVL); bf16_t* KVB = (bf16_t*)(F.ws + WS_KVB);
    const float* ssq = (const float*)(F.ws + WS_CTL + CTL_SSQ) + (size_t)(l * 2 + 1) * NT; const float* kvnw = INP(I_KVNW) + l * 128;
    const float* ROPE = (const float*)(F.ws + WS_ROPE);
    for (int e = gt; e < NT * 24; e += NGT) {
        const int m = e / 24, g = e % 24;
        if (g < 16) {
            const u32x4 w = *(const u32x4*)(KVL + (size_t)m * 256 + 8 * g); const float rs = 1.f / sqrtf(ssq[m] * (1.f / 128.f) + EPS);
            const f32x4 n0 = *(const f32x4*)(kvnw + 8 * g), n1 = *(const f32x4*)(kvnw + 8 * g + 4);
            u32x4 o; o.x = pk2(bflo(w.x) * rs * n0[0], bfhi(w.x) * rs * n0[1]); o.y = pk2(bflo(w.y) * rs * n0[2], bfhi(w.y) * rs * n0[3]);
            o.z = pk2(bflo(w.z) * rs * n1[0], bfhi(w.z) * rs * n1[1]); o.w = pk2(bflo(w.w) * rs * n1[2], bfhi(w.w) * rs * n1[3]);
            *(u32x4*)(KVB + (size_t)m * 192 + 8 * g) = o;
        } else {
            const int i0 = 4 * (g - 16);
            const u32x2 a = *(const u32x2*)(KVL + (size_t)m * 256 + 128 + i0), b = *(const u32x2*)(KVL + (size_t)m * 256 + 160 + i0);
            const f32x4 cs = *(const f32x4*)(ROPE + (size_t)m * 64 + i0), sn = *(const f32x4*)(ROPE + (size_t)m * 64 + 32 + i0);
            const f32x4 x1 = {bflo(a.x), bfhi(a.x), bflo(a.y), bfhi(a.y)}, x2 = {bflo(b.x), bfhi(b.x), bflo(b.y), bfhi(b.y)};
            const f32x4 o1 = x1 * cs - x2 * sn, o2 = x1 * sn + x2 * cs;
            u32x2 w1, w2; w1.x = pk2(o1[0], o1[1]); w1.y = pk2(o1[2], o1[3]); w2.x = pk2(o2[0], o2[1]); w2.y = pk2(o2[2], o2[3]);
            *(u32x2*)(KVB + (size_t)m * 192 + 128 + i0) = w1; *(u32x2*)(KVB + (size_t)m * 192 + 160 + i0) = w2;
        }
    }
    const u32x4* XBC = (const u32x4*)(F.ws + WS_XBC); u32x4* HX = (u32x4*)(F.ws + WS_HX);
    for (int e = gt; e < NCHK * 3 * 128; e += NGT) { const int c = e / 384, r = e % 384, j = r >> 7, p = r & 127; HX[e] = XBC[(size_t)(64 * c + 61 + j) * 128 + p]; }
    u32x4* HR = (u32x4*)(F.ws + WS_HRKV);
    for (int e = gt; e < 3 * NCHK * 64; e += NGT) { const int w = e / (NCHK * 64), r = e % (NCHK * 64), c = r >> 6, p = r & 63;
        const u32x4* src = (const u32x4*)(F.ws + (w == 0 ? WS_R : w == 1 ? WS_K : WS_V)); HR[e] = src[(size_t)(64 * c + 63) * 64 + p]; }
    const f32x4* FF = (const f32x4*)(F.ws + WS_F); f32x4* HF = (f32x4*)(F.ws + WS_HF);
    for (int e = gt; e < NCHK * 32; e += NGT) { const int c = e >> 5, p = e & 31; HF[e] = FF[(size_t)(64 * c + 63) * 36 + p]; }
}

__device__ __forceinline__ int ssd_win_col(int g, int o) { return o < 256 ? 256 * g + o : o < 384 ? 512 + 128 * g + (o - 256) : 768 + 128 * g + (o - 384); }
__device__ __forceinline__ void p3b_ssd(const Ctx& F, int l) {
    constexpr int SC_C = 0, SC_B = 17408, SC_BT = 34816, SC_XST = 53248, SC_CB = 90112, SC_G = 106752, SC_XSD = 115968, SC_DT = 125184, SC_AC = 127232;
    LAS bf16_t* Cg = (LAS bf16_t*)(F.lds + SC_C); LAS bf16_t* Bg = (LAS bf16_t*)(F.lds + SC_B); LAS bf16_t* BT = (LAS bf16_t*)(F.lds + SC_BT);
    LAS bf16_t* XST = (LAS bf16_t*)(F.lds + SC_XST); LAS float* CB = (LAS float*)(F.lds + SC_CB); LAS bf16_t* Gh = (LAS bf16_t*)(F.lds + SC_G);
    LAS bf16_t* XSD = (LAS bf16_t*)(F.lds + SC_XSD); LAS float* DT = (LAS float*)(F.lds + SC_DT); LAS float* AC = (LAS float*)(F.lds + SC_AC);
    bf16_t* XBC = (bf16_t*)(F.ws + WS_XBC); const bf16_t* HX = (const bf16_t*)(F.ws + WS_HX); const float* Ff = (const float*)(F.ws + WS_F);
    bf16_t* Cbuf = (bf16_t*)(F.ws + WS_CB); float* ECUM = (float*)(F.ws + WS_ECUM); float* CDEC = (float*)(F.ws + WS_CDEC); bf16_t* YD = (bf16_t*)(F.ws + WS_YD);
    const float* convw = INP(I_CONVW) + (size_t)l * 4 * 1024; const float* convb = INP(I_CONVB) + l * 1024;
    const float* dtb = INP(I_DTB) + l * 8; const float* alog = INP(I_ALOG) + l * 8; const float* dskip = INP(I_DSKIP) + l * 8;
    const int tid = F.tid, lane = F.lane, wave = F.wave;
    for (int c = F.bid; c < NCHK; c += F.G) {
        const int m0 = 64 * c; const bool first = (c & 127) == 0;
        if (wave == 0) {
            const int t = lane;
#pragma unroll
            for (int h = 0; h < 8; ++h) {
                const float raw = Ff[(size_t)(m0 + t) * 144 + 128 + h] + dtb[h];
                const float dt = raw > 20.f ? raw : log1pf(expf(raw));
                float v = dt * (-expf(alog[h]));
#pragma unroll
                for (int o = 1; o < 64; o <<= 1) { const float y = __shfl_up(v, o); if (lane >= o) v += y; }
                DT[t * 8 + h] = dt; AC[t * 8 + h] = v;
                const float ev = expf(v); ECUM[(size_t)(c * 8 + h) * 64 + t] = ev; if (t == 63) CDEC[c * 8 + h] = ev;
            }
        }
        for (int g = 0; g < 2; ++g) {
            {
                const int col = ssd_win_col(g, tid);
                const float w0 = convw[col], w1 = convw[1024 + col], w2 = convw[2048 + col], w3 = convw[3072 + col], cb = convb[col];
                float h0 = 0.f, h1 = 0.f, h2 = 0.f;
                if (!first) { h0 = bf2f(HX[(size_t)((c - 1) * 3 + 0) * 1024 + col]); h1 = bf2f(HX[(size_t)((c - 1) * 3 + 1) * 1024 + col]); h2 = bf2f(HX[(size_t)((c - 1) * 3 + 2) * 1024 + col]); }
#pragma unroll 8
                for (int t = 0; t < 64; ++t) {
                    const float x = bf2f(XBC[(size_t)(m0 + t) * 1024 + col]);
                    const float u = w0 * h0 + w1 * h1 + w2 * h2 + w3 * x + cb; h0 = h1; h1 = h2; h2 = x;
                    const bf16_t bv = (bf16_t)f2bf(siluf_(u));
                    if (tid < 256) XST[tid * 72 + t] = bv;
                    else if (tid < 384) { const int n = tid - 256; Bg[t * 136 + n] = bv; BT[n * 72 + t] = bv; }
                    else { const int n = tid - 384; Cg[t * 136 + n] = bv; Cbuf[(size_t)(m0 + t) * 256 + g * 128 + n] = bv; }
                }
            }
            __syncthreads();
#pragma unroll
            for (int i = 0; i < 2; ++i) { const int idx = 2 * wave + i, ti = idx >> 2, si = idx & 3;
                const f32x4 acc = mma_tile<128>(Cg + ti * 16 * 136, 136, Bg + si * 16 * 136, 136, lane);
#pragma unroll
                for (int r = 0; r < 4; ++r) CB[(ti * 16 + 4 * (lane >> 4) + r) * 65 + si * 16 + (lane & 15)] = acc[r]; }
            __syncthreads();
            for (int hl = 0; hl < 4; ++hl) {
                const int h = 4 * g + hl;
                {   const int t = tid >> 3, s0 = (tid & 7) * 8; const float at = AC[t * 8 + h], a63 = AC[63 * 8 + h];
                    float gv[8], xv[8]; const u32x4 xw = *(const LAS u32x4*)(XST + (64 * hl + t) * 72 + s0);
                    const float xf[8] = {bflo(xw.x), bfhi(xw.x), bflo(xw.y), bfhi(xw.y), bflo(xw.z), bfhi(xw.z), bflo(xw.w), bfhi(xw.w)};
#pragma unroll
                    for (int j = 0; j < 8; ++j) { const int s = s0 + j; const float as = AC[s * 8 + h], ds = DT[s * 8 + h];
                        gv[j] = (s <= t) ? CB[t * 65 + s] * expf(at - as) * ds : 0.f; xv[j] = xf[j] * ds * expf(a63 - as); }
                    u32x4 o; o.x = pk2(gv[0], gv[1]); o.y = pk2(gv[2], gv[3]); o.z = pk2(gv[4], gv[5]); o.w = pk2(gv[6], gv[7]); *(LAS u32x4*)(Gh + t * 72 + s0) = o;
                    o.x = pk2(xv[0], xv[1]); o.y = pk2(xv[2], xv[3]); o.z = pk2(xv[4], xv[5]); o.w = pk2(xv[6], xv[7]); *(LAS u32x4*)(XSD + t * 72 + s0) = o; }
                __syncthreads();
                const float dsk = dskip[h];
#pragma unroll
                for (int i = 0; i < 2; ++i) { const int idx = 2 * wave + i, ti = idx >> 2, pi = idx & 3;
                    const f32x4 acc = mma_tile<64>(Gh + ti * 16 * 72, 72, XST + (64 * hl + 16 * pi) * 72, 72, lane);
#pragma unroll
                    for (int r = 0; r < 4; ++r) { const int t = ti * 16 + 4 * (lane >> 4) + r, p = pi * 16 + (lane & 15);
                        const float y = acc[r] + dsk * bf2f(XST[(64 * hl + p) * 72 + t]); YD[(size_t)(m0 + t) * 512 + 64 * h + p] = (bf16_t)f2bf(y); } }
#pragma unroll
                for (int i = 0; i < 4; ++i) { const int idx = 4 * wave + i, pi = idx >> 3, ni = idx & 7;
                    const f32x4 acc = mma_tile<64>(XSD + pi * 16 * 72, 72, BT + ni * 16 * 72, 72, lane);
#pragma unroll
                    for (int r = 0; r < 4; ++r) { const int p = pi * 16 + 4 * (lane >> 4) + r, n = ni * 16 + (lane & 15);
                        const int f = hl * 8192 + p * 128 + n, row = f >> 9, col = ssd_win_col(g, f & 511);
                        XBC[(size_t)(m0 + row) * 1024 + col] = (bf16_t)f2bf(acc[r]); } }
                __syncthreads();
            }
        }
    }
}

__device__ __forceinline__ void p3c_rwkv(const Ctx& F, int l) {
    constexpr int M9 = 9216, O_TW = 0, O_AL = 9216, O_SL = 18432, O_MAB = O_SL + 12 * M9  , O_LWF = O_SL + 10 * M9  , O_ICF = O_LWF + 16640, O_WL = O_MAB + 16640  , O_SCR = O_WL + 256;
    static_assert(O_ICF + 16640 <= O_MAB + 16640 && O_SCR + 4224 <= LDS_BYTES, "rwkv lds map");
#define LB() ({ LAS unsigned char* p_ = F.lds; asm volatile("" : "+s"(p_)); p_; })
#define SLOT(i) ((LAS bf16_t*)(L + O_SL + (i) * M9))
#define TW ((LAS bf16_t*)(L + O_TW))
#define AL ((LAS bf16_t*)(L + O_AL))
#define AT SLOT(0)
#define ATt SLOT(1)
#define BTl SLOT(2)
#define KTl SLOT(3)
#define RT SLOT(4)
#define BHt SLOT(5)
#define KH SLOT(6)
#define VT SLOT(7)
#define MI SLOT(8)
#define MakT SLOT(9)
#define Rb SLOT(10)
#define Rk SLOT(11)
#define Attn SLOT(0)
#define KEt SLOT(1)
#define X1t SLOT(2)
#define X2t SLOT(3)
#define S8 SLOT(8)
#define S9 SLOT(9)
#define MAB ((LAS float*)(L + O_MAB))
#define LWf ((LAS float*)(L + O_LWF))
#define ICf ((LAS float*)(L + O_ICF))
#define WL ((LAS float*)(L + O_WL))
#define SCR ((LAS float*)(L + O_SCR))
    const int tid = F.tid, lane = F.lane, wave = F.wave;
    for (int c = F.bid; c < NCHK; c += F.G) {
        const int m0 = 64 * c; const bool first = (c & 127) == 0;
        {
            LAS unsigned char* L = LB();
            const int t = tid >> 3, q0 = (tid & 7) * 8;
            const float* Ff = (const float*)(F.ws + WS_F); const float* HF = (const float*)(F.ws + WS_HF); const float* mu_w = INP(I_MUW) + l * 64; const float* mu_a = INP(I_MUA) + l * 64;
            float cw[8], pw[8], ca[8], pa[8];
            const float* cur = Ff + (size_t)(m0 + t) * 144; const float* prv = (t > 0) ? cur - 144 : HF + (size_t)(c - 1) * 128;
#pragma unroll
            for (int j = 0; j < 8; ++j) { cw[j] = cur[q0 + j]; ca[j] = cur[64 + q0 + j]; }
            if (t > 0) {
#pragma unroll
                for (int j = 0; j < 8; ++j) { pw[j] = prv[q0 + j]; pa[j] = prv[64 + q0 + j]; }
            } else if (!first) {
#pragma unroll
                for (int j = 0; j < 8; ++j) { pw[j] = prv[q0 + j]; pa[j] = prv[64 + q0 + j]; }
            } else {
#pragma unroll
                for (int j = 0; j < 8; ++j) { pw[j] = 0.f; pa[j] = 0.f; }
            }
            float ow[8], oa[8];
#pragma unroll
            for (int j = 0; j < 8; ++j) { ow[j] = tanhf(cw[j] + (pw[j] - cw[j]) * mu_w[q0 + j]); oa[j] = ca[j] + (pa[j] - ca[j]) * mu_a[q0 + j]; }
            u32x4 o; o.x = pk2(ow[0], ow[1]); o.y = pk2(ow[2], ow[3]); o.z = pk2(ow[4], ow[5]); o.w = pk2(ow[6], ow[7]); *(LAS u32x4*)(TW + t * 72 + q0) = o;
            o.x = pk2(oa[0], oa[1]); o.y = pk2(oa[2], oa[3]); o.z = pk2(oa[4], oa[5]); o.w = pk2(oa[6], oa[7]); *(LAS u32x4*)(AL + t * 72 + q0) = o;
        }
        for (int h = 0; h < 8; ++h) {
            int tid = F.tid, lane = F.lane; asm volatile("" : "+v"(tid), "+v"(lane));
            {   LAS unsigned char* L = LB(); const int row = tid >> 3, c8 = tid & 7; const bf16_t* WLW = (const bf16_t*)(F.ws + WS_WLW); const bf16_t* WLA = (const bf16_t*)(F.ws + WS_WLA);
                *(LAS u32x4*)(S8 + row * 72 + c8 * 8) = *(const u32x4*)(WLW + (size_t)(h * 64 + row) * 64 + c8 * 8);
                *(LAS u32x4*)(S9 + row * 72 + c8 * 8) = *(const u32x4*)(WLA + (size_t)(h * 64 + row) * 64 + c8 * 8); }
            __syncthreads();
            { LAS unsigned char* L = LB(); const float* w0 = INP(I_W0) + l * 512; const float* a0 = INP(I_A0) + l * 512;
#pragma unroll
            for (int i = 0; i < 4; ++i) { const int idx = 4 * wave + i, which = idx >> 4, ti = (idx >> 2) & 3, ci = idx & 3;
                const f32x4 acc = mma_tile<64>((which ? AL : TW) + ti * 16 * 72, 72, (which ? S9 : S8) + ci * 16 * 72, 72, lane);
#pragma unroll
                for (int r = 0; r < 4; ++r) { const int t = ti * 16 + 4 * (lane >> 4) + r, ch = ci * 16 + (lane & 15);
                    if (which == 0) LWf[t * 65 + ch] = -DECAY_SCALE * sigmoidf_(acc[r] + w0[h * 64 + ch]); else ICf[t * 65 + ch] = sigmoidf_(acc[r] + a0[h * 64 + ch]); } } }
            __syncthreads();
            if (wave == 0) { LAS unsigned char* L = LB(); float run = 0.f;
#pragma unroll 8
                for (int t = 0; t < 64; ++t) { run += LWf[t * 65 + lane]; LWf[t * 65 + lane] = run; }
                WL[lane] = expf(run); }
            __syncthreads();
            float bonv[8]; const int t1 = tid >> 3, ch0 = (tid & 7) * 8, col1 = h * 64 + ch0;
            {   LAS unsigned char* L = LB(); const int t = t1;
                const bf16_t* Rg = (const bf16_t*)(F.ws + WS_R); const bf16_t* Kg = (const bf16_t*)(F.ws + WS_K); const bf16_t* Vg = (const bf16_t*)(F.ws + WS_V); const bf16_t* HR = (const bf16_t*)(F.ws + WS_HRKV);
                const float* mu_r = INP(I_MURKV) + (size_t)l * 1536; const float* mu_k = mu_r + 512; const float* mu_v = mu_r + 1024;
                const float* kkp = INP(I_KK) + l * 512; const float* kap = INP(I_KA) + l * 512; const float* rkp = INP(I_RK) + l * 512;
                const size_t off = (size_t)(m0 + t) * 512 + col1;
                const u32x4 rw = *(const u32x4*)(Rg + off), kw = *(const u32x4*)(Kg + off), vw = *(const u32x4*)(Vg + off);
                u32x4 rp = {0u, 0u, 0u, 0u}, kp = rp, vp = rp;
                if (t > 0) { rp = *(const u32x4*)(Rg + off - 512); kp = *(const u32x4*)(Kg + off - 512); vp = *(const u32x4*)(Vg + off - 512); }
                else if (!first) { const size_t ho = (size_t)(c - 1) * 512 + col1; rp = *(const u32x4*)(HR + ho); kp = *(const u32x4*)(HR + (size_t)NCHK * 512 + ho); vp = *(const u32x4*)(HR + (size_t)2 * NCHK * 512 + ho); }
                const unsigned rwa[4] = {rw.x, rw.y, rw.z, rw.w}, kwa[4] = {kw.x, kw.y, kw.z, kw.w}, vwa[4] = {vw.x, vw.y, vw.z, vw.w};
                const unsigned rpa[4] = {rp.x, rp.y, rp.z, rp.w}, kpa[4] = {kp.x, kp.y, kp.z, kp.w}, vpa[4] = {vp.x, vp.y, vp.z, vp.w};
                float rs[8], ks[8], vs[8], kkv[8], k2[8], ic[8]; float ss = 0.f, bs = 0.f;
#pragma unroll
                for (int j = 0; j < 8; ++j) { const int gch = col1 + j; const int q = j >> 1;
                    const float r_ = (j & 1) ? bfhi(rwa[q]) : bflo(rwa[q]), rq = (j & 1) ? bfhi(rpa[q]) : bflo(rpa[q]);
                    const float k_ = (j & 1) ? bfhi(kwa[q]) : bflo(kwa[q]), kq = (j & 1) ? bfhi(kpa[q]) : bflo(kpa[q]);
                    const float v_ = (j & 1) ? bfhi(vwa[q]) : bflo(vwa[q]), vq = (j & 1) ? bfhi(vpa[q]) : bflo(vpa[q]);
                    rs[j] = r_ + (rq - r_) * mu_r[gch]; ks[j] = k_ + (kq - k_) * mu_k[gch]; vs[j] = v_ + (vq - v_) * mu_v[gch];
                    ic[j] = ICf[t * 65 + ch0 + j];
                    kkv[j] = ks[j] * kkp[gch]; ss += kkv[j] * kkv[j];
                    k2[j] = ks[j] * (1.f + (ic[j] - 1.f) * kap[gch]); bs += rs[j] * k2[j] * rkp[gch]; }
                ss += __shfl_xor(ss, 1); ss += __shfl_xor(ss, 2); ss += __shfl_xor(ss, 4);
                bs += __shfl_xor(bs, 1); bs += __shfl_xor(bs, 2); bs += __shfl_xor(bs, 4);
                const float inv = 1.f / fmaxf(sqrtf(ss), 1e-12f);
                float vAT[8], vB[8], vK[8], vR[8], vBH[8], vKH[8];
#pragma unroll
                for (int j = 0; j < 8; ++j) { const int ch = ch0 + j;
                    const float LWt = LWf[t * 65 + ch], LWp = (t > 0) ? LWf[(t - 1) * 65 + ch] : 0.f, L63 = LWf[63 * 65 + ch];
                    const float kk = kkv[j] * inv, a = -kk, b = kk * ic[j];
                    const float e1 = expf(LWt), e2 = expf(-LWt), e3 = expf(LWp), e4 = expf(L63 - LWt);
                    vAT[j] = a * e3; vB[j] = b * e2; vK[j] = k2[j] * e2; vR[j] = rs[j] * e1; vBH[j] = b * e4; vKH[j] = k2[j] * e4; bonv[j] = bs * vs[j];
                    ATt[ch * 72 + t] = (bf16_t)f2bf(vAT[j]); BHt[ch * 72 + t] = (bf16_t)f2bf(vBH[j]); VT[ch * 72 + t] = (bf16_t)f2bf(vs[j]); }
                u32x4 o;
#define PK8(A_) (o[0] = pk2(A_[0], A_[1]), o[1] = pk2(A_[2], A_[3]), o[2] = pk2(A_[4], A_[5]), o[3] = pk2(A_[6], A_[7]), o)
                *(LAS u32x4*)(AT + t * 72 + ch0) = PK8(vAT); *(LAS u32x4*)(BTl + t * 72 + ch0) = PK8(vB); *(LAS u32x4*)(KTl + t * 72 + ch0) = PK8(vK);
                *(LAS u32x4*)(RT + t * 72 + ch0) = PK8(vR); *(LAS u32x4*)(KH + t * 72 + ch0) = PK8(vKH);
            }
            __syncthreads();
            { u32x4 o; *(u32x4*)((bf16_t*)(F.ws + WS_V) + (size_t)(m0 + t1) * 512 + col1) = PK8(bonv); }
            { LAS unsigned char* L = LB();
#pragma unroll
            for (int i = 0; i < 8; ++i) { const int p = wave >> 1, idx = 8 * (wave & 1) + i, ti = idx >> 2, si = idx & 3;
                const f32x4 acc = mma_tile<64>(((p < 2) ? AT : RT) + ti * 16 * 72, 72, ((p & 1) ? KTl : BTl) + si * 16 * 72, 72, lane);
#pragma unroll
                for (int r = 0; r < 4; ++r) { const int t = ti * 16 + 4 * (lane >> 4) + r, s = si * 16 + (lane & 15);
                    if (p == 0) MAB[t * 65 + s] = (s < t) ? acc[r] : 0.f;
                    else if (p == 1) MakT[s * 72 + t] = (bf16_t)f2bf((s < t) ? acc[r] : 0.f);
                    else if (p == 2) Rb[t * 72 + s] = (bf16_t)f2bf((s <= t) ? acc[r] : 0.f);
                    else Rk[t * 72 + s] = (bf16_t)f2bf((s <= t) ? acc[r] : 0.f); } } }
            __syncthreads();
            if (wave < 4 && lane < 16) { LAS unsigned char* L = LB(); const int b0 = 16 * wave; float x[16];
#pragma unroll
                for (int t = 0; t < 16; ++t) { float v = (t == lane) ? 1.f : 0.f;
#pragma unroll
                    for (int s = 0; s < 16; ++s) if (s < t) v += MAB[(b0 + t) * 65 + b0 + s] * x[s];
                    x[t] = v; }
#pragma unroll
                for (int t = 0; t < 16; ++t) MAB[(b0 + t) * 65 + b0 + lane] = x[t]; }
            __syncthreads();
            {   LAS unsigned char* L = LB(); const int pr = tid >> 8, e = tid & 255, rr = e >> 4, cc = e & 15, rb = pr ? 48 : 16, cb = pr ? 32 : 0; float v = 0.f;
#pragma unroll
                for (int s = 0; s < 16; ++s) v += MAB[(rb + rr) * 65 + cb + s] * MAB[(cb + s) * 65 + cb + cc];
                SCR[(pr * 16 + rr) * 33 + cc] = v; }
            __syncthreads();
            {   LAS unsigned char* L = LB(); const int pr = tid >> 8, e = tid & 255, rr = e >> 4, cc = e & 15, rb = pr ? 48 : 16, cb = pr ? 32 : 0; float v = 0.f;
#pragma unroll
                for (int s = 0; s < 16; ++s) v += MAB[(rb + rr) * 65 + rb + s] * SCR[(pr * 16 + s) * 33 + cc];
                MAB[(rb + rr) * 65 + cb + cc] = v; }
            __syncthreads();
            {   LAS unsigned char* L = LB(); float v2[2];
#pragma unroll
                for (int i = 0; i < 2; ++i) { const int e = tid * 2 + i, rr = e >> 5, cc = e & 31; float v = 0.f;
#pragma unroll 8
                    for (int s = 0; s < 32; ++s) v += MAB[(32 + rr) * 65 + s] * MAB[s * 65 + cc];
                    v2[i] = v; }
                SCR[((tid * 2) >> 5) * 33 + ((tid * 2) & 31)] = v2[0]; SCR[((tid * 2 + 1) >> 5) * 33 + ((tid * 2 + 1) & 31)] = v2[1]; }
            __syncthreads();
            {   LAS unsigned char* L = LB();
#pragma unroll
                for (int i = 0; i < 2; ++i) { const int e = tid * 2 + i, rr = e >> 5, cc = e & 31; float v = 0.f;
#pragma unroll 8
                    for (int s = 0; s < 32; ++s) v += MAB[(32 + rr) * 65 + 32 + s] * SCR[s * 33 + cc];
                    MAB[(32 + rr) * 65 + cc] = v; } }
            __syncthreads();
            {   LAS unsigned char* L = LB(); const int t = tid >> 3, s0 = (tid & 7) * 8; float x[8];
#pragma unroll
                for (int j = 0; j < 8; ++j) x[j] = MAB[t * 65 + s0 + j];
                u32x4 o; *(LAS u32x4*)(MI + t * 72 + s0) = PK8(x); }
            __syncthreads();
            { LAS unsigned char* L = LB();
#pragma unroll
            for (int i = 0; i < 4; ++i) { const int idx = 4 * wave + i, which = idx >> 4, ti = (idx >> 2) & 3, ci = idx & 3;
                const f32x4 acc = mma_tile<64>(MI + ti * 16 * 72, 72, (which ? MakT : ATt) + ci * 16 * 72, 72, lane);
#pragma unroll
                for (int r = 0; r < 4; ++r) { const int t = ti * 16 + 4 * (lane >> 4) + r, j = ci * 16 + (lane & 15); (which ? X2t : X1t)[j * 72 + t] = (bf16_t)f2bf(acc[r]); } } }
            __syncthreads();
            { LAS unsigned char* L = LB();
            bf16_t* QEw = (bf16_t*)(F.ws + WS_QE) + (size_t)(c * 8 + h) * 4096; bf16_t* TTw = (bf16_t*)(F.ws + WS_TT) + (size_t)(c * 8 + h) * 4096;
#pragma unroll
            for (int i = 0; i < 8; ++i) { const int p = wave >> 1, idx = 8 * (wave & 1) + i, ti = idx >> 2, si = idx & 3;
                const f32x4 acc = mma_tile<64>(((p == 0 || p == 1) ? Rb : (p == 2) ? X1t : X2t) + ti * 16 * 72, 72, ((p == 0) ? X1t : (p == 1) ? X2t : BHt) + si * 16 * 72, 72, lane);
#pragma unroll
                for (int r = 0; r < 4; ++r) { const int rw = ti * 16 + 4 * (lane >> 4) + r, cl = si * 16 + (lane & 15);
                    if (p == 0) QEw[rw * 64 + pi16(cl)] = (bf16_t)f2bf(acc[r] + bf2f(RT[rw * 72 + cl]));
                    else if (p == 1) Attn[rw * 72 + cl] = (bf16_t)f2bf(acc[r] + bf2f(Rk[rw * 72 + cl]));
                    else if (p == 2) TTw[cl * 64 + pi16(rw)] = (bf16_t)f2bf(acc[r] + ((rw == cl) ? WL[rw] : 0.f));
                    else KEt[cl * 72 + rw] = (bf16_t)f2bf(acc[r] + bf2f(KH[rw * 72 + cl])); } } }
            __syncthreads();
            bf16_t* Rg = (bf16_t*)(F.ws + WS_R); bf16_t* Kg = (bf16_t*)(F.ws + WS_K); LAS unsigned char* L = LB();
#pragma unroll
            for (int i = 0; i < 4; ++i) { const int idx = 4 * wave + i, which = idx >> 4, ti = (idx >> 2) & 3, ci = idx & 3;
                const f32x4 acc = mma_tile<64>((which ? VT : Attn) + ti * 16 * 72, 72, (which ? KEt : VT) + ci * 16 * 72, 72, lane);
#pragma unroll
                for (int r = 0; r < 4; ++r) { const int rw = ti * 16 + 4 * (lane >> 4) + r, cl = ci * 16 + (lane & 15);
                    if (which == 0) Kg[(size_t)(m0 + cl) * 512 + h * 64 + sg32(rw)] = (bf16_t)f2bf(acc[r]);
                    else Rg[(size_t)(m0 + rw) * 512 + h * 64 + sg32(cl)] = (bf16_t)f2bf(acc[r]); } }
        }
        __syncthreads();
    }
#undef SLOT
#undef PK8
#undef LB
#undef TW
#undef AL
#undef AT
#undef ATt
#undef BTl
#undef KTl
#undef RT
#undef BHt
#undef KH
#undef VT
#undef MI
#undef MakT
#undef Rb
#undef Rk
#undef Attn
#undef KEt
#undef X1t
#undef X2t
#undef S8
#undef S9
#undef MAB
#undef LWf
#undef ICf
#undef WL
#undef SCR
}

__device__ __forceinline__ bf16x8 cvt8(const f32x16& x, int s) {
    u32x4 w; w.x = pk2(x[8 * s + 0], x[8 * s + 1]); w.y = pk2(x[8 * s + 2], x[8 * s + 3]); w.z = pk2(x[8 * s + 4], x[8 * s + 5]); w.w = pk2(x[8 * s + 6], x[8 * s + 7]);
    return __builtin_bit_cast(bf16x8, w);
}
__device__ __forceinline__ f32x16 ld16bf(const bf16_t* p) {
    const u32x4 a = *(const u32x4*)p, b = *(const u32x4*)(p + 8); f32x16 r;
    r[0] = bflo(a.x); r[1] = bfhi(a.x); r[2] = bflo(a.y); r[3] = bfhi(a.y); r[4] = bflo(a.z); r[5] = bfhi(a.z); r[6] = bflo(a.w); r[7] = bfhi(a.w);
    r[8] = bflo(b.x); r[9] = bfhi(b.x); r[10] = bflo(b.y); r[11] = bfhi(b.y); r[12] = bflo(b.z); r[13] = bfhi(b.z); r[14] = bflo(b.w); r[15] = bfhi(b.w); return r;
}
__device__ __forceinline__ void st16bf(bf16_t* p, const f32x16& x) {
    u32x4 a, b; a.x = pk2(x[0], x[1]); a.y = pk2(x[2], x[3]); a.z = pk2(x[4], x[5]); a.w = pk2(x[6], x[7]); b.x = pk2(x[8], x[9]); b.y = pk2(x[10], x[11]); b.z = pk2(x[12], x[13]); b.w = pk2(x[14], x[15]);
    *(u32x4*)p = a; *(u32x4*)(p + 8) = b;
}
constexpr int KROW = 400;
constexpr int KTILE = 64 * KROW;
__device__ __forceinline__ void attn_unit(const Ctx& F, int b, int c, int hp) {
    const int tid = F.tid, lane = F.lane, wave = F.wave, r32 = lane & 31, hi = lane >> 5, grp = wave >> 2, wq = wave & 3, head = 2 * hp + (wq >> 1);
    const bf16_t* Q = (const bf16_t*)(F.ws + WS_Q); const bf16_t* KV = (const bf16_t*)(F.ws + WS_KVB) + (size_t)b * SEQ * 192; bf16_t* OL = (bf16_t*)(F.ws + WS_OL);
    const size_t mq = (size_t)b * SEQ + 64 * c + 32 * (wq & 1) + r32;
    bf16x8 qr[12];
#pragma unroll
    for (int d0 = 0; d0 < 12; ++d0) qr[d0] = *(const bf16x8*)(Q + mq * 768 + head * 192 + 16 * d0 + 8 * hi);
    {
        const float* rp = (const float*)(F.ws + WS_ROPE) + mq * 64;
#pragma unroll
        for (int d0 = 8; d0 < 10; ++d0) { const int j0 = 16 * (d0 - 8) + 8 * hi;
            const f32x4 c0 = *(const f32x4*)(rp + j0), c1 = *(const f32x4*)(rp + j0 + 4), s0 = *(const f32x4*)(rp + 32 + j0), s1 = *(const f32x4*)(rp + 32 + j0 + 4);
            const u32x4 a = __builtin_bit_cast(u32x4, qr[d0]), bq = __builtin_bit_cast(u32x4, qr[d0 + 2]);
            const float x1[8] = {bflo(a.x), bfhi(a.x), bflo(a.y), bfhi(a.y), bflo(a.z), bfhi(a.z), bflo(a.w), bfhi(a.w)}, x2[8] = {bflo(bq.x), bfhi(bq.x), bflo(bq.y), bfhi(bq.y), bflo(bq.z), bfhi(bq.z), bflo(bq.w), bfhi(bq.w)};
            const float cs[8] = {c0[0], c0[1], c0[2], c0[3], c1[0], c1[1], c1[2], c1[3]}, sn[8] = {s0[0], s0[1], s0[2], s0[3], s1[0], s1[1], s1[2], s1[3]};
            float o1[8], o2[8];
#pragma unroll
            for (int e = 0; e < 8; ++e) { o1[e] = x1[e] * cs[e] - x2[e] * sn[e]; o2[e] = x1[e] * sn[e] + x2[e] * cs[e]; }
            u32x4 w1, w2; w1.x = pk2(o1[0], o1[1]); w1.y = pk2(o1[2], o1[3]); w1.z = pk2(o1[4], o1[5]); w1.w = pk2(o1[6], o1[7]); w2.x = pk2(o2[0], o2[1]); w2.y = pk2(o2[2], o2[3]); w2.z = pk2(o2[4], o2[5]); w2.w = pk2(o2[6], o2[7]);
            qr[d0] = __builtin_bit_cast(bf16x8, w1); qr[d0 + 2] = __builtin_bit_cast(bf16x8, w2); }
    }
    int poff[3]; int goff[3];
#pragma unroll
    for (int i = 0; i < 3; ++i) { const int idx = tid + 512 * i, row = idx / 24, col = idx % 24; poff[i] = row * KROW + col * 16; goff[i] = row * 192 + col * 8; }
    const int nt = c + 1, ns = (nt + 1) >> 1;
    u32x4 st[6];
#pragma unroll
    for (int i = 0; i < 3; ++i) st[i] = *(const u32x4*)(KV + goff[i]);
    if (nt > 1) {
#pragma unroll
        for (int i = 0; i < 3; ++i) st[3 + i] = *(const u32x4*)(KV + (size_t)64 * 192 + goff[i]);
    }
#pragma unroll
    for (int i = 0; i < 3; ++i) { *(LAS u32x4*)(F.lds + poff[i]) = st[i]; if (nt > 1) *(LAS u32x4*)(F.lds + KTILE + poff[i]) = st[3 + i]; }
    __syncthreads();
    f32x16 o[4];
#pragma unroll
    for (int d = 0; d < 4; ++d)
#pragma unroll
        for (int r = 0; r < 16; ++r) o[d][r] = 0.f;
    float mrun = -1e30f, lrun = 0.f;
    const int troff = (4 * hi + ((lane & 15) >> 2)) * KROW + (((lane >> 4) & 1) * 16 + (lane & 3) * 4) * 2;
    const int koff = r32 * KROW + hi * 16;
    for (int s = 0; s < ns; ++s) {
        const bool more = (s + 1 < ns), more2 = (2 * s + 3 < nt);
        if (more) {
#pragma unroll
            for (int i = 0; i < 3; ++i) st[i] = *(const u32x4*)(KV + (size_t)(2 * s + 2) * 64 * 192 + goff[i]);
            if (more2) {
#pragma unroll
                for (int i = 0; i < 3; ++i) st[3 + i] = *(const u32x4*)(KV + (size_t)(2 * s + 3) * 64 * 192 + goff[i]);
            }
        }
        if (2 * s + grp < nt) {
            const LAS unsigned char* buf = F.lds + ((s & 1) * 2 + grp) * KTILE;
            f32x16 p0, p1;
#pragma unroll
            for (int r = 0; r < 16; ++r) { p0[r] = 0.f; p1[r] = 0.f; }
            bf16x8 ka[3][2];
#pragma unroll
            for (int d0 = 0; d0 < 2; ++d0) { ka[d0][0] = *(const LAS bf16x8*)(buf + koff + d0 * 32); ka[d0][1] = *(const LAS bf16x8*)(buf + koff + 32 * KROW + d0 * 32); }
#pragma unroll
            for (int d0 = 0; d0 < 12; ++d0) {
                if (d0 + 2 < 12) { ka[(d0 + 2) % 3][0] = *(const LAS bf16x8*)(buf + koff + (d0 + 2) * 32); ka[(d0 + 2) % 3][1] = *(const LAS bf16x8*)(buf + koff + 32 * KROW + (d0 + 2) * 32); }
                p0 = __builtin_amdgcn_mfma_f32_32x32x16_bf16(ka[d0 % 3][0], qr[d0], p0, 0, 0, 0); p1 = __builtin_amdgcn_mfma_f32_32x32x16_bf16(ka[d0 % 3][1], qr[d0], p1, 0, 0, 0);
            }
            v4i16_t vl[2][4], vh[2][4];
#pragma unroll
            for (int db = 0; db < 4; ++db) { const LAS unsigned char* vp = buf + troff + db * 64; vl[0][db] = __builtin_amdgcn_ds_read_tr16_b64_v4i16((LAS v4i16_t*)vp); vh[0][db] = __builtin_amdgcn_ds_read_tr16_b64_v4i16((LAS v4i16_t*)(vp + 8 * KROW)); }
            float mx = fmaxf(p0[0], p1[0]);
#pragma unroll
            for (int r = 1; r < 16; ++r) mx = fmaxf(mx, fmaxf(p0[r], p1[r]));
            mx = fmaxf(mx, __shfl_xor(mx, 32));
            if (__any(mx > mrun + 8.f)) {
                const float mnew = fmaxf(mrun, mx), alpha = __builtin_amdgcn_exp2f(mrun - mnew); mrun = mnew; lrun *= alpha;
#pragma unroll
                for (int d = 0; d < 4; ++d)
#pragma unroll
                    for (int r = 0; r < 16; ++r) o[d][r] *= alpha;
            }
            float ls = 0.f;
#pragma unroll
            for (int r = 0; r < 16; ++r) { p0[r] = __builtin_amdgcn_exp2f(p0[r] - mrun); p1[r] = __builtin_amdgcn_exp2f(p1[r] - mrun); ls += p0[r] + p1[r]; }
            lrun += ls;
#pragma unroll
            for (int ks = 0; ks < 4; ++ks) {
                if (ks + 1 < 4) {
#pragma unroll
                    for (int db = 0; db < 4; ++db) { const LAS unsigned char* vp = buf + troff + (16 * (ks + 1)) * KROW + db * 64;
                        vl[(ks + 1) & 1][db] = __builtin_amdgcn_ds_read_tr16_b64_v4i16((LAS v4i16_t*)vp); vh[(ks + 1) & 1][db] = __builtin_amdgcn_ds_read_tr16_b64_v4i16((LAS v4i16_t*)(vp + 8 * KROW)); }
                }
                const bf16x8 pb = (ks < 2) ? cvt8(p0, ks & 1) : cvt8(p1, ks & 1);
#pragma unroll
                for (int db = 0; db < 4; ++db) { const v4i16_t lo = vl[ks & 1][db], hh = vh[ks & 1][db];
                    const bf16x8 va = {lo[0], lo[1], lo[2], lo[3], hh[0], hh[1], hh[2], hh[3]};
                    o[db] = __builtin_amdgcn_mfma_f32_32x32x16_bf16(va, pb, o[db], 0, 0, 0); }
            }
        }
        if (more) {
            LAS unsigned char* nb = F.lds + (((s + 1) & 1) * 2) * KTILE;
#pragma unroll
            for (int i = 0; i < 3; ++i) { *(LAS u32x4*)(nb + poff[i]) = st[i]; if (more2) *(LAS u32x4*)(nb + KTILE + poff[i]) = st[3 + i]; }
        }
        __syncthreads();
    }
    lrun += __shfl_xor(lrun, 32);
    LAS float* xb = (LAS float*)(F.lds + wq * (66 * 64 * 4));
    if (grp == 1) {
#pragma unroll
        for (int d = 0; d < 4; ++d)
#pragma unroll
            for (int r = 0; r < 16; ++r) xb[(d * 16 + r) * 64 + lane] = o[d][r];
        xb[64 * 64 + lane] = mrun; xb[65 * 64 + lane] = lrun;
    }
    __syncthreads();
    if (grp == 0) {
        const float m2 = xb[64 * 64 + lane], l2 = xb[65 * 64 + lane];
        const float mm = fmaxf(mrun, m2), a1 = __builtin_amdgcn_exp2f(mrun - mm), a2 = __builtin_amdgcn_exp2f(m2 - mm);
        const float inv = 1.f / (lrun * a1 + l2 * a2), f1 = a1 * inv, f2 = a2 * inv;
#pragma unroll
        for (int db = 0; db < 4; ++db)
#pragma unroll
            for (int g = 0; g < 4; ++g) { float v[4];
#pragma unroll
                for (int e = 0; e < 4; ++e) v[e] = o[db][4 * g + e] * f1 + xb[(db * 16 + 4 * g + e) * 64 + lane] * f2;
                u32x2 w; w.x = pk2(v[0], v[1]); w.y = pk2(v[2], v[3]);
                *(u32x2*)(OL + mq * 512 + head * 128 + 32 * db + 8 * g + 4 * hi) = w; }
    }
    __syncthreads();
}
struct RwSet { bf16x8 ta[2][4]; u32x4 d[4]; };
__device__ __forceinline__ void rw_load(RwSet& s, const bf16_t* TTg, const bf16_t* Rg, int cg_, int h, int i, int r32, int hi) {
    const bf16_t* TTw = TTg + (size_t)(cg_ * 8 + h) * 4096; const bf16_t* Dw = Rg + ((size_t)64 * cg_ + i) * 512 + h * 64;
#pragma unroll
    for (int a = 0; a < 2; ++a)
#pragma unroll
        for (int s2 = 0; s2 < 4; ++s2) s.ta[a][s2] = *(const bf16x8*)(TTw + (32 * a + r32) * 64 + 16 * s2 + 8 * hi);
    s.d[0] = *(const u32x4*)(Dw + 16 * hi); s.d[1] = *(const u32x4*)(Dw + 16 * hi + 8); s.d[2] = *(const u32x4*)(Dw + 32 + 16 * hi); s.d[3] = *(const u32x4*)(Dw + 32 + 16 * hi + 8);
}
__device__ __forceinline__ f32x16 up16(const u32x4 a, const u32x4 b) { f32x16 r;
    r[0] = bflo(a.x); r[1] = bfhi(a.x); r[2] = bflo(a.y); r[3] = bfhi(a.y); r[4] = bflo(a.z); r[5] = bfhi(a.z); r[6] = bflo(a.w); r[7] = bfhi(a.w);
    r[8] = bflo(b.x); r[9] = bfhi(b.x); r[10] = bflo(b.y); r[11] = bfhi(b.y); r[12] = bflo(b.z); r[13] = bfhi(b.z); r[14] = bflo(b.w); r[15] = bfhi(b.w); return r; }
__device__ __forceinline__ void rw_step(f32x16& X0, f32x16& X1, const RwSet& s, bf16_t* Rg, int cg_, int h, int i, int hi, bool live) {
    const bf16x8 bf[4] = {cvt8(X0, 0), cvt8(X0, 1), cvt8(X1, 0), cvt8(X1, 1)};
    if (live) { bf16_t* Dw = Rg + ((size_t)64 * cg_ + i) * 512 + h * 64;
        *(bf16x8*)(Dw + 16 * hi) = bf[0]; *(bf16x8*)(Dw + 16 * hi + 8) = bf[1]; *(bf16x8*)(Dw + 32 + 16 * hi) = bf[2]; *(bf16x8*)(Dw + 32 + 16 * hi + 8) = bf[3]; }
    f32x16 n0 = up16(s.d[0], s.d[1]), n1 = up16(s.d[2], s.d[3]);
#pragma unroll
    for (int s2 = 0; s2 < 4; ++s2) { n0 = __builtin_amdgcn_mfma_f32_32x32x16_bf16(s.ta[0][s2], bf[s2], n0, 0, 0, 0); n1 = __builtin_amdgcn_mfma_f32_32x32x16_bf16(s.ta[1][s2], bf[s2], n1, 0, 0, 0); }
    X0 = n0; X1 = n1;
}
__device__ __forceinline__ void rwkv_scan(const Ctx& F, int b, int h, int half) {
    const int lane = F.lane, r32 = lane & 31, hi = lane >> 5, i = 32 * half + r32;
    const bf16_t* TTg = (const bf16_t*)(F.ws + WS_TT); bf16_t* Rg = (bf16_t*)(F.ws + WS_R);
    f32x16 X0, X1;
#pragma unroll
    for (int r = 0; r < 16; ++r) { X0[r] = 0.f; X1[r] = 0.f; }
    RwSet sA, sB, sC; const int c0 = b * 128;
    rw_load(sA, TTg, Rg, c0 + 0, h, i, r32, hi); rw_load(sB, TTg, Rg, c0 + 1, h, i, r32, hi); rw_load(sC, TTg, Rg, c0 + 2, h, i, r32, hi);
    for (int c = 0; c < 129; c += 3) {
        rw_step(X0, X1, sA, Rg, c0 + c, h, i, hi, true);          rw_load(sA, TTg, Rg, c0 + min(c + 3, 127), h, i, r32, hi);
        rw_step(X0, X1, sB, Rg, c0 + c + 1, h, i, hi, true);      rw_load(sB, TTg, Rg, c0 + min(c + 4, 127), h, i, r32, hi);
        rw_step(X0, X1, sC, Rg, c0 + min(c + 2, 127), h, i, hi, c + 2 < 128); rw_load(sC, TTg, Rg, c0 + min(c + 5, 127), h, i, r32, hi);
    }
}
__device__ __forceinline__ void ssd_scan(const Ctx& F, int item) {
    const int b = item >> 4, h = (item >> 1) & 7, hp = item & 1, g = h >> 2, hl = h & 3;
    const int piece = hp * 512 + F.tid;
    const int f = hl * 8192 + piece * 8, row = f >> 9, col = ssd_win_col(g, f & 511);
    bf16_t* ST = (bf16_t*)(F.ws + WS_XBC); const float* CDEC = (const float*)(F.ws + WS_CDEC);
    float st[8];
#pragma unroll
    for (int j = 0; j < 8; ++j) st[j] = 0.f;
    for (int c8 = 0; c8 < 128; c8 += 8) {
        u32x4 v[8]; float cd[8];
#pragma unroll
        for (int u = 0; u < 8; ++u) { const int cg_ = b * 128 + c8 + u; v[u] = *(const u32x4*)(ST + ((size_t)64 * cg_ + row) * 1024 + col); cd[u] = CDEC[cg_ * 8 + h]; }
#pragma unroll
        for (int u = 0; u < 8; ++u) { const int cg_ = b * 128 + c8 + u;
            u32x4 o; o.x = pk2(st[0], st[1]); o.y = pk2(st[2], st[3]); o.z = pk2(st[4], st[5]); o.w = pk2(st[6], st[7]);
            *(u32x4*)(ST + ((size_t)64 * cg_ + row) * 1024 + col) = o;
            const float x[8] = {bflo(v[u].x), bfhi(v[u].x), bflo(v[u].y), bfhi(v[u].y), bflo(v[u].z), bfhi(v[u].z), bflo(v[u].w), bfhi(v[u].w)};
#pragma unroll
            for (int j = 0; j < 8; ++j) st[j] = st[j] * cd[u] + x[j]; }
    }
}
__device__ __forceinline__ void p4_mix(const Ctx& F, int what = 3) {
    if (what & 2) {
        if (F.bid < 32) { if (!(what & 8) && F.wave == 0) rwkv_scan(F, F.bid >> 4, (F.bid >> 1) & 7, F.bid & 1); }
        else if (F.bid < 64) { if (!(what & 4)) ssd_scan(F, F.bid - 32); }
        __syncthreads();
    }
    if (what & 1) {
        const int b = F.bid >> 7, hp = (F.bid >> 6) & 1, c = F.bid & 63;
        attn_unit(F, b, 127 - c, hp); attn_unit(F, b, c, hp);
    }
}
__device__ __forceinline__ void p5_assemble(const Ctx& F, int l) {
    bf16_t* GT = (bf16_t*)(F.ws + WS_GATES);
    {   pg8::Gemm g{(const bf16_t*)(F.ws + WS_OL), (const bf16_t*)(F.ws + WS_WUV), NT, 512, 512, 512, 512}; pg8::StaticOrder S; S.init(NT, 512, F.G, F.bid); EpiUV E{GT};
        pg8::gemm_phase<EpiUV, pg8::StaticOrder, true, true>(F.lds, F.wave, g, S, E); }
    __syncthreads();
    int lane = fresh_lane(); const int tid = F.wave * 64 + lane, wave = F.wave;
    const int gw = F.bid * NWAVES + F.wave, NGW = F.G * NWAVES;
    {   constexpr int O_CG = 0, O_PV = 17408, O_YL = 34816;
        const bf16_t* Cbuf = (const bf16_t*)(F.ws + WS_CB); const float* ECUM = (const float*)(F.ws + WS_ECUM); const bf16_t* ST = (const bf16_t*)(F.ws + WS_XBC); const bf16_t* YD = (const bf16_t*)(F.ws + WS_YD);
        const float* snw = INP(I_SSDNW) + l * 512;
        for (int c = F.bid; c < NCHK; c += F.G) {
            const size_t m0 = (size_t)64 * c;
            for (int g = 0; g < 2; ++g) {
                {   LAS bf16_t* Cg = (LAS bf16_t*)(F.lds + O_CG);
#pragma unroll
                    for (int i = 0; i < 2; ++i) { const int idx = tid + 512 * i, t = idx >> 4, c8 = idx & 15; *(LAS u32x4*)(Cg + t * 136 + c8 * 8) = *(const u32x4*)(Cbuf + (m0 + t) * 256 + g * 128 + c8 * 8); } }
                for (int hl = 0; hl < 4; ++hl) { const int h = 4 * g + hl;
                    {   LAS bf16_t* Pv = (LAS bf16_t*)(F.lds + O_PV);
#pragma unroll
                        for (int i = 0; i < 2; ++i) { const int idx = tid + 512 * i, pp = idx >> 4, c8 = idx & 15; const int f = hl * 8192 + pp * 128 + c8 * 8, row = f >> 9, col = ssd_win_col(g, f & 511);
                            *(LAS u32x4*)(Pv + pp * 136 + c8 * 8) = *(const u32x4*)(ST + (m0 + row) * 1024 + col); } }
                    __syncthreads();
                    {   LAS bf16_t* Cg = (LAS bf16_t*)(F.lds + O_CG); LAS bf16_t* Pv = (LAS bf16_t*)(F.lds + O_PV); LAS bf16_t* YL = (LAS bf16_t*)(F.lds + O_YL);
#pragma unroll
                        for (int i = 0; i < 2; ++i) { const int idx = 2 * wave + i, ti = idx >> 2, pi = idx & 3;
                            const f32x4 acc = mma_tile<128>(Cg + ti * 16 * 136, 136, Pv + pi * 16 * 136, 136, lane);
#pragma unroll
                            for (int r = 0; r < 4; ++r) { const int t = ti * 16 + 4 * (lane >> 4) + r, pp = pi * 16 + (lane & 15);
                                const float y = bf2f(YD[(m0 + t) * 512 + 64 * h + pp]) + acc[r] * ECUM[(size_t)(c * 8 + h) * 64 + t];
                                const float z = bf2f(GT[(m0 + t) * 1536 + 512 + 64 * h + pp]);
                                YL[t * 520 + 64 * h + pp] = (bf16_t)f2bf(y * siluf_(z)); } } }
                    __syncthreads();
                }
            }
            {   LAS bf16_t* YL = (LAS bf16_t*)(F.lds + O_YL);
#pragma unroll
                for (int rr = 0; rr < 8; ++rr) { const int t = 8 * wave + rr; const u32x4 w = *(const LAS u32x4*)(YL + t * 520 + 8 * lane);
                    const float v[8] = {bflo(w.x), bfhi(w.x), bflo(w.y), bfhi(w.y), bflo(w.z), bfhi(w.z), bflo(w.w), bfhi(w.w)};
                    float q = 0.f;
#pragma unroll
                    for (int j = 0; j < 8; ++j) q += v[j] * v[j];
                    const float rs = 1.f / sqrtf(wave_sum(q) * (1.f / 512.f) + EPS);
                    const f32x4 w0 = *(const f32x4*)(snw + 8 * lane), w1 = *(const f32x4*)(snw + 8 * lane + 4);
                    u32x4 o; o.x = pk2(v[0] * rs * w0[0], v[1] * rs * w0[1]); o.y = pk2(v[2] * rs * w0[2], v[3] * rs * w0[3]); o.z = pk2(v[4] * rs * w1[0], v[5] * rs * w1[1]); o.w = pk2(v[6] * rs * w1[2], v[7] * rs * w1[3]);
                    *(u32x4*)(GT + (m0 + t) * 1536 + 512 + 8 * lane) = o; } }
            __syncthreads();
        }
    }
    LAS float* SW = (LAS float*)(F.lds + F.wave * 16640);
    const bf16_t* Yt = (const bf16_t*)(F.ws + WS_K); const bf16_t* SF = (const bf16_t*)(F.ws + WS_R); const bf16_t* QEg = (const bf16_t*)(F.ws + WS_QE);
    const bf16_t* BON = (const bf16_t*)(F.ws + WS_V); const float* lw = INP(I_LNXW) + l * 512; const float* lb = INP(I_LNXB) + l * 512;
    for (int w = gw; w < NCHK * 8; w += NGW) {
        asm volatile("" : "+v"(lane));
        const int cg_ = w >> 3, h = w & 7, r32 = lane & 31, hi = lane >> 5; const size_t m0 = (size_t)64 * cg_;
        const bf16_t* QEw = QEg + (size_t)(cg_ * 8 + h) * 4096;
        bf16x8 qa[2][4];
#pragma unroll
        for (int tb = 0; tb < 2; ++tb)
#pragma unroll
            for (int s2 = 0; s2 < 4; ++s2) qa[tb][s2] = *(const bf16x8*)(QEw + (32 * tb + r32) * 64 + 16 * s2 + 8 * hi);
#pragma unroll
        for (int ih = 0; ih < 2; ++ih) { const size_t ro = (m0 + 32 * ih + r32) * 512 + h * 64;
            const bf16x8 bf[4] = {*(const bf16x8*)(SF + ro + 16 * hi), *(const bf16x8*)(SF + ro + 16 * hi + 8), *(const bf16x8*)(SF + ro + 32 + 16 * hi), *(const bf16x8*)(SF + ro + 32 + 16 * hi + 8)};
#pragma unroll
            for (int tb = 0; tb < 2; ++tb) { f32x16 y = ld16bf(Yt + ro + 32 * tb + 16 * hi);
#pragma unroll
                for (int s2 = 0; s2 < 4; ++s2) y = __builtin_amdgcn_mfma_f32_32x32x16_bf16(qa[tb][s2], bf[s2], y, 0, 0, 0);
#pragma unroll
                for (int r = 0; r < 16; ++r) SW[(32 * tb + crow(r, hi)) * 65 + 32 * ih + r32] = y[r]; } }
        LDS_WAIT();
        {   float y[64]; float sm = 0.f;
#pragma unroll
            for (int i = 0; i < 64; ++i) { y[i] = SW[lane * 65 + i]; sm += y[i]; }
            const float mean = sm * (1.f / 64.f); float q = 0.f;
#pragma unroll
            for (int i = 0; i < 64; ++i) { y[i] -= mean; q += y[i] * y[i]; }
            const float rs = 1.f / sqrtf(q * (1.f / 64.f) + GN_EPS);
#pragma unroll
            for (int i = 0; i < 64; ++i) SW[lane * 65 + i] = y[i] * rs; }
        LDS_WAIT();
#pragma unroll
        for (int it = 0; it < 8; ++it) { const int t = it * 8 + (lane >> 3), i0 = (lane & 7) * 8; const size_t row = m0 + t;
            const u32x4 bw = *(const u32x4*)(BON + row * 512 + h * 64 + i0); u32x4* gp = (u32x4*)(GT + row * 1536 + 1024 + h * 64 + i0); const u32x4 gv = *gp;
            const float bo[8] = {bflo(bw.x), bfhi(bw.x), bflo(bw.y), bfhi(bw.y), bflo(bw.z), bfhi(bw.z), bflo(bw.w), bfhi(bw.w)};
            const float gg[8] = {bflo(gv.x), bfhi(gv.x), bflo(gv.y), bfhi(gv.y), bflo(gv.z), bfhi(gv.z), bflo(gv.w), bfhi(gv.w)};
            float ov[8];
#pragma unroll
            for (int j = 0; j < 8; ++j) ov[j] = (SW[t * 65 + i0 + j] * lw[h * 64 + i0 + j] + lb[h * 64 + i0 + j] + bo[j]) * siluf_(gg[j]);
            u32x4 o; o.x = pk2(ov[0], ov[1]); o.y = pk2(ov[2], ov[3]); o.z = pk2(ov[4], ov[5]); o.w = pk2(ov[6], ov[7]); *gp = o; }
        LDS_WAIT();
    }
}
__device__ __forceinline__ void p7_final(const Ctx& F) {
    const int gw = F.bid * NWAVES + F.wave, NGW = F.G * NWAVES; const float* fw = INP(I_FNW);
    for (int m = gw; m < NT; m += NGW) {
        f32x4* xr = (f32x4*)(F.out + (size_t)m * DM) + F.lane; f32x4 v[4]; float s = 0.f;
#pragma unroll
        for (int j = 0; j < 4; ++j) { v[j] = xr[64 * j]; s += v[j].x * v[j].x + v[j].y * v[j].y + v[j].z * v[j].z + v[j].w * v[j].w; }
        const float rstd = 1.f / sqrtf(wave_sum(s) * (1.f / DM) + EPS);
#pragma unroll
        for (int j = 0; j < 4; ++j) xr[64 * j] = v[j] * rstd * *(const f32x4*)(fw + 4 * F.lane + 256 * j);
    }
}

#define RLX_AGENT __ATOMIC_RELAXED, __HIP_MEMORY_SCOPE_AGENT
#define XB_TMO      128
#define XB_XCNT(j)  (256  + 64 * (j))
#define XB_XSUB(j)  (1280 + 64 * (j))
#define XB_XGEN(j)  (2304 + 64 * (j))
#define XB_TOP      3328
#define XB_TOPGEN   3392
#define XCD_BAR_WORDS 3456
#define XB_SPIN_CAP (1u << 18)

__device__ __forceinline__ unsigned xb_ld(unsigned* p)              { return __hip_atomic_load(p, __ATOMIC_RELAXED, __HIP_MEMORY_SCOPE_AGENT); }
__device__ __forceinline__ unsigned xb_add(unsigned* p, unsigned v) { return __hip_atomic_fetch_add(p, v, __ATOMIC_RELAXED, __HIP_MEMORY_SCOPE_AGENT); }
__device__ __forceinline__ unsigned xb_xcc_id() { return (unsigned)__builtin_amdgcn_s_getreg((3 << 11) | 20) & 0xFu; }
#define XB_SPIN(cond, bar) do { unsigned _sp = 0; while (cond) { __builtin_amdgcn_s_sleep(1); \
    if ((++_sp & 255u) == 0u) { if (xb_ld(&(bar)[XB_TMO])) break; if (_sp > XB_SPIN_CAP) { atomicAdd(&(bar)[XB_TMO], 1u); break; } } } } while (0)

struct XcdBarrier {
    unsigned* bar; unsigned x;
    volatile LAS unsigned* st;
};

__device__ __forceinline__ XcdBarrier xcd_barrier_post(unsigned* bar, volatile LAS unsigned* st) {
    XcdBarrier b; b.bar = bar; b.x = xb_xcc_id(); b.st = st;
    if (threadIdx.x == 0) (void)xb_add(&bar[XB_XCNT(b.x)], 1u);
    return b;
}
__device__ __forceinline__ void xcd_barrier_complete(unsigned* bar, unsigned x, unsigned& nloc, unsigned& nx) {
    const unsigned G = gridDim.x * gridDim.y * gridDim.z;
    unsigned sum, cnt, mine, sp = 0u;
    for (;;) {
        sum = 0u; cnt = 0u; mine = 0u;
#pragma unroll
        for (unsigned j = 0; j < 16; ++j) { const unsigned c = xb_ld(&bar[XB_XCNT(j)]); sum += c; cnt += (c > 0u) ? 1u : 0u; mine = (j == x) ? c : mine; }
        if (sum == G) break;
        __builtin_amdgcn_s_sleep(1);
        if ((++sp & 255u) == 0u) { if (xb_ld(&bar[XB_TMO])) break; if (sp > XB_SPIN_CAP) { atomicAdd(&bar[XB_TMO], 1u); break; } }
    }
    nloc = mine > 0u ? mine : 1u; nx = cnt > 0u ? cnt : 1u;
}

__device__ __forceinline__ void xcd_barrier(const XcdBarrier& b) {
    asm volatile("s_waitcnt vmcnt(0)" ::: "memory");
    __syncthreads();
    if (threadIdx.x == 0) {
        unsigned* bar = b.bar;
        __builtin_amdgcn_s_waitcnt(0);
        unsigned nloc = b.st[0], nx = b.st[1];
        if (nloc == 0u) { xcd_barrier_complete(bar, b.x, nloc, nx); b.st[0] = nloc; b.st[1] = nx; }
        const unsigned old = xb_add(&bar[XB_XSUB(b.x)], 1u);
        const unsigned gen = old / nloc;
        if (old + 1u == (gen + 1u) * nloc) {
            __builtin_amdgcn_fence(__ATOMIC_RELEASE, "agent");
            asm volatile("s_waitcnt vmcnt(0)" ::: "memory");
            const unsigned og = xb_add(&bar[XB_TOP], 1u);
            const unsigned tg = og / nx;
            if (og + 1u == (tg + 1u) * nx) xb_add(&bar[XB_TOPGEN], 1u);
            else XB_SPIN(xb_ld(&bar[XB_TOPGEN]) == tg, bar);
            __builtin_amdgcn_fence(__ATOMIC_ACQUIRE, "agent");
            xb_add(&bar[XB_XGEN(b.x)], 1u);
            asm volatile("s_waitcnt vmcnt(0)" ::: "memory");
        } else {
            XB_SPIN(xb_ld(&bar[XB_XGEN(b.x)]) == gen, bar);
            __builtin_amdgcn_fence(__ATOMIC_ACQUIRE, "agent");
            asm volatile("s_waitcnt vmcnt(0)" ::: "memory");
        }
    }
    __syncthreads();
}


#define LAYER(l) do { \
        const int pb = 1 + 8 * l; \
        if (IN(pb + 0)) { PHB(); if (l == 1) prep_weights(F, 1); p1_norm(F, l); SEAM(pb + 0); } \
        if (IN(pb + 1)) { PHB(); \
            pg8::Gemm g{(const bf16_t*)(F.ws + WS_XN), (const bf16_t*)(F.ws + WS_WIN), NT, NIN, DM, DM, DM}; pg8::StaticOrder S; S.init(NT, NIN, F.G, F.bid); \
            EpiIn E{F.ws, l}; \
            pg8::gemm_phase<EpiIn, pg8::StaticOrder, true, true>(F.lds, F.wave, g, S, E); \
            SEAM(pb + 1); \
        } \
        if (IN(pb + 2)) { PHB(); \
            pg8::Gemm g{(const bf16_t*)(F.ws + WS_QLAT), (const bf16_t*)(F.ws + WS_WQ), NT, 768, 256, 256, 256}; pg8::StaticOrder S; S.init(NT, 768, F.G, F.bid); \
            EpiQ E{F.ws, l}; \
            pg8::gemm_phase<EpiQ, pg8::StaticOrder, true, true>(F.lds, F.wave, g, S, E); \
            p3a_extras(F, l); \
            SEAM(pb + 2); \
        } \
        if (IN(pb + 3)) { PHB(); p3b_ssd(F, l); SEAM(pb + 3); } \
        if (IN(pb + 4)) { PHB(); p3c_rwkv(F, l); SEAM(pb + 4); } \
        if (IN(pb + 5)) { PHB(); p4_mix(F); SEAM(pb + 5); } \
        if (IN(pb + 6)) { PHB(); p5_assemble(F, l); SEAM(pb + 6); } \
        if (IN(pb + 7)) { PHB(); \
            pg8::Gemm g{(const bf16_t*)(F.ws + WS_GATES), (const bf16_t*)(F.ws + WS_WOUT), NT, DM, 1536, 1536, 1536}; pg8::StaticOrder S; S.init(NT, DM, F.G, F.bid); \
            EpiOut E{(l == 0) ? INP(I_X) : F.out, F.out, (const float*)(F.ws + WS_CTL + CTL_MOD) + (size_t)(l * 2) * 3072 + 2048}; \
            pg8::gemm_phase<EpiOut, pg8::StaticOrder, true, true>(F.lds, F.wave, g, S, E); \
            SEAM(pb + 7); \
        } \
    } while (0)
__global__ void __launch_bounds__(NTHR, 2) mk_fwd(Args args) {
    extern __shared__ __attribute__((aligned(16))) unsigned char lds_raw[];
    Ctx F; F.lds = (LAS unsigned char*)lds_raw; F.tid = threadIdx.x; F.lane = F.tid & 63; F.wave = __builtin_amdgcn_readfirstlane(F.tid >> 6);
    F.G = gridDim.x; F.bid = blockIdx.x; F.ws = args.ws; F.out = args.out; F.in = args.in;
    const int wave0 = F.wave;
    cg::grid_group grid = cg::this_grid();
    volatile LAS unsigned* xst = (volatile LAS unsigned*)(F.lds + LDS_BYTES - 256);
    if (threadIdx.x < 2) xst[threadIdx.x] = 0u;
    __syncthreads();
    const XcdBarrier xbar = xcd_barrier_post((unsigned*)(args.ws + WS_CTL) + 4096, xst);
#if MK_PER_PHASE
    const int lo = args.ph_lo, hi = args.ph_hi;
#else
    constexpr int lo = 0, hi = 18;
#endif
#ifndef MK_ONLY
#define MK_ONLY -1
#endif
#define IN(k) (lo <= (k) && (k) < hi && (MK_ONLY < 0 || MK_ONLY == ((k) == 0 ? 0 : (k) == 17 ? 17 : 1 + ((k) - 1) % 8)))
#if MK_PER_PHASE
#define SEAM(k) do { } while (0)
#else
#define SEAM(k) do { if ((k) == 0) grid.sync(); else xcd_barrier(xbar); } while (0)
#endif
#define PHB() do { int b_ = blockIdx.x, g_ = gridDim.x, v_ = wave0; asm volatile("" : "+s"(b_), "+s"(g_), "+s"(v_)); F.bid = b_; F.G = g_; F.wave = v_; int t_ = v_ * 64 + (int)__builtin_amdgcn_mbcnt_hi(~0u, __builtin_amdgcn_mbcnt_lo(~0u, 0u)); asm volatile("; PHASE_MARK %0" : "+v"(t_)); F.tid = t_; F.lane = t_ & 63; unsigned wl_ = __builtin_amdgcn_readfirstlane((unsigned)(uintptr_t)args.ws), wh_ = __builtin_amdgcn_readfirstlane((unsigned)((uintptr_t)args.ws >> 32)), ol_ = __builtin_amdgcn_readfirstlane((unsigned)(uintptr_t)args.out), oh_ = __builtin_amdgcn_readfirstlane((unsigned)((uintptr_t)args.out >> 32)); asm volatile("" : "+s"(wl_), "+s"(wh_), "+s"(ol_), "+s"(oh_)); F.ws = (unsigned char*)(GAS unsigned char*)(((uintptr_t)wh_ << 32) | wl_); F.out = (float*)(GAS float*)(((uintptr_t)oh_ << 32) | ol_); } while (0)
    if (IN(0)) { PHB(); p0_prologue(F); SEAM(0); }
    LAYER(0);
    LAYER(1);
    if (IN(17)) { PHB(); p7_final(F); }
#ifndef MK_RERUN
#define MK_RERUN 0
#endif
#define PHB2() do { int b_ = blockIdx.x, g_ = gridDim.x, v_ = wave0; asm volatile("" : "+s"(b_), "+s"(g_), "+s"(v_)); F.bid = b_; F.G = g_; F.wave = v_; int t_ = v_ * 64 + fresh_lane(); F.tid = t_; F.lane = t_ & 63; } while (0)
#if MK_RERUN
    { constexpr int l = 1;
    if (MK_RERUN & 1) { xcd_barrier(xbar); PHB2(); p1_norm(F, l); }
    if (MK_RERUN & 2) { xcd_barrier(xbar); PHB2(); pg8::Gemm g{(const bf16_t*)(F.ws + WS_XN), (const bf16_t*)(F.ws + WS_WIN), NT, NIN, DM, DM, DM}; pg8::StaticOrder S; S.init(NT, NIN, F.G, F.bid); EpiIn E{F.ws, l}; pg8::gemm_phase<EpiIn, pg8::StaticOrder, true, true>(F.lds, F.wave, g, S, E); }
    if (MK_RERUN & 4) { xcd_barrier(xbar); PHB2(); pg8::Gemm g{(const bf16_t*)(F.ws + WS_QLAT), (const bf16_t*)(F.ws + WS_WQ), NT, 768, 256, 256, 256}; pg8::StaticOrder S; S.init(NT, 768, F.G, F.bid); EpiQ E{F.ws, l}; pg8::gemm_phase<EpiQ, pg8::StaticOrder, true, true>(F.lds, F.wave, g, S, E); p3a_extras(F, l); }
    if (MK_RERUN & 8) { xcd_barrier(xbar); PHB2(); p3b_ssd(F, l); }
    if (MK_RERUN & 16) { xcd_barrier(xbar); PHB2(); p3c_rwkv(F, l); }
    if (MK_RERUN & 32) { xcd_barrier(xbar); PHB2(); p4_mix(F); }
    if (MK_RERUN & 512) { xcd_barrier(xbar); PHB2(); p4_mix(F, 1); }
    if (MK_RERUN & 1024) { xcd_barrier(xbar); PHB2(); p4_mix(F, 2); }
    if (MK_RERUN & 2048) { xcd_barrier(xbar); PHB2(); p4_mix(F, 2 | 4); }
    if (MK_RERUN & 4096) { xcd_barrier(xbar); PHB2(); p4_mix(F, 2 | 8); }
    if (MK_RERUN & 64) { xcd_barrier(xbar); PHB2(); p5_assemble(F, l); }
    if (MK_RERUN & 128) { xcd_barrier(xbar); PHB2(); pg8::Gemm g{(const bf16_t*)(F.ws + WS_GATES), (const bf16_t*)(F.ws + WS_WOUT), NT, DM, 1536, 1536, 1536}; pg8::StaticOrder S; S.init(NT, DM, F.G, F.bid);
        EpiOut E{INP(I_X), (float*)(F.ws + WS_XBC), (const float*)(F.ws + WS_CTL + CTL_MOD) + (size_t)(l * 2) * 3072 + 2048}; pg8::gemm_phase<EpiOut, pg8::StaticOrder, true, true>(F.lds, F.wave, g, S, E); }
    }
#endif
#undef IN
#undef SEAM
}
constexpr int N_PHASES = 18;

extern "C" void kernel_launch(void* const* d_in, const int* in_sizes, int n_in, void* d_out, int out_size, void* d_ws, size_t ws_size, hipStream_t stream) {
    static int grid = 0;
    if (grid == 0) {
        if (n_in != 31 || out_size != NT * DM || ws_size < WS_END) { fprintf(stderr, "kernel_launch: unexpected shapes (n_in %d, out %d, ws %zu)\n", n_in, out_size, ws_size); grid = -1; return; }
        int dev = 0, cus = 0, per_cu = 0;
        hipGetDevice(&dev); hipDeviceGetAttribute(&cus, hipDeviceAttributeMultiprocessorCount, dev);
        if (hipFuncSetAttribute((const void*)mk_fwd, hipFuncAttributeMaxDynamicSharedMemorySize, LDS_BYTES) != hipSuccess) { fprintf(stderr, "kernel_launch: hipFuncSetAttribute failed\n"); grid = -1; return; }
        hipOccupancyMaxActiveBlocksPerMultiprocessor(&per_cu, (const void*)mk_fwd, NTHR, LDS_BYTES);
        (void)hipGetLastError();
        if (per_cu < 1) per_cu = 1;
        grid = cus;
        fprintf(stderr, "kernel_launch: cus %d, occupancy query %d block(s)/CU, grid %d\n", cus, per_cu, grid);
    }
    if (grid < 0) return;
    hipMemsetAsync((char*)d_ws + WS_CTL, 0, CTL_BYTES, stream);
    Args a{};
    for (int i = 0; i < 31; ++i) a.in[i] = (const float*)d_in[i];
    a.out = (float*)d_out; a.ws = (unsigned char*)d_ws;
#if MK_PER_PHASE
    for (int p = 0; p < N_PHASES; ++p) { a.ph_lo = p; a.ph_hi = p + 1; hipLaunchKernelGGL(mk_fwd, dim3(grid), dim3(NTHR), LDS_BYTES, stream, a); }
#else
    a.ph_lo = 0; a.ph_hi = N_PHASES;
    void* params[] = {&a};
    hipError_t e = hipLaunchCooperativeKernel((const void*)mk_fwd, dim3(grid), dim3(NTHR), params, LDS_BYTES, stream);
    if (e != hipSuccess) fprintf(stderr, "kernel_launch: cooperative launch failed: %s\n", hipGetErrorString(e));
#endif
}
```

```cpp
#include <hip/hip_runtime.h>
#include <hip/hip_cooperative_groups.h>
#include <cstdio>
#include <cstdint>
namespace cg = cooperative_groups;

#define LAS __attribute__((address_space(3)))
#define GAS __attribute__((address_space(1)))
typedef unsigned short bf16_t;
typedef short bf16x8 __attribute__((ext_vector_type(8)));
typedef float f32x4 __attribute__((ext_vector_type(4)));
typedef float f32x2 __attribute__((ext_vector_type(2)));
typedef float f32x16 __attribute__((ext_vector_type(16)));
typedef unsigned u32x4 __attribute__((ext_vector_type(4)));
typedef unsigned u32x2 __attribute__((ext_vector_type(2)));
typedef short v4i16_t __attribute__((ext_vector_type(4)));

#ifndef MK_PER_PHASE
#define MK_PER_PHASE 0
#endif

namespace pg8 {
constexpr int BM = 256, BK = 64, HALF = 128, HTB = HALF * BK * 2, STAGE_BYTES = 8 * HTB, NXCD = 8, WGM = 8;
__host__ __device__ __forceinline__ int lds_byte(int r, int c) { const int st = (r >> 4) * 2 + (c >> 5), rr = r & 15, cc = c & 31, ob = rr * 64 + cc * 2; return st * 1024 + (ob ^ (((ob >> 9) & 1) << 5)); }
__host__ __device__ __forceinline__ void stage_rc(int b, int& R, int& C) { const int st = b / 1024, sb = b % 1024, swz = sb ^ (((sb >> 9) & 1) << 5); R = (st >> 1) * 16 + swz / 64; C = (st & 1) * 32 + (swz % 64) / 2; }
__host__ __device__ __forceinline__ int perm32(int rho) { const int n = rho >> 4, i = rho & 15; return 8 * (i >> 2) + 4 * n + (i & 3); }
struct Unit { int pm, pn; };
struct Gemm { const bf16_t* A; const bf16_t* Bt; int M, N, K, lda, ldb; };
struct StaticOrder {
    int nM, nN, nwg, G, c;
    __host__ __device__ void init(int M, int N, int G_, int c_) { nM = M / BM; nN = N / BM; nwg = nM * nN; G = G_; c = c_; }
    __host__ __device__ bool next(int i, Unit& u) const {
        const long L = (long)i * G + c; if (L >= nwg) return false;
        int wgid = (int)L; { const int q = nwg / NXCD, r = nwg % NXCD, xcd = wgid % NXCD, off = wgid / NXCD; wgid = (xcd < r ? xcd * (q + 1) : r * (q + 1) + (xcd - r) * q) + off; }
        const int nig = WGM * nN, gid = wgid / nig, fm = gid * WGM, gsz = (nM - fm) < WGM ? (nM - fm) : WGM;
        u.pm = fm + ((wgid % nig) % gsz); u.pn = (wgid % nig) / gsz; return true;
    }
};
template <class Epi, class Sched, bool ALIGN_EPI, bool SP2>
__device__ __forceinline__ void gemm_phase(LAS unsigned char* lds, int wave_id, const Gemm g, const Sched& S, const Epi& E) {
    int lane = (int)__builtin_amdgcn_mbcnt_hi(~0u, __builtin_amdgcn_mbcnt_lo(~0u, 0u)); asm volatile("" : "+v"(lane));
    const int wid = wave_id, tid = wid * 64 + lane, wr = wid >> 2, wc = wid & 3, fr = lane & 15, fq = lane >> 4;
    const int K = g.K, nt = K / BK;
    unsigned voffA[2], voffB[2];
#pragma unroll
    for (int i = 0; i < 2; ++i) { int R, C; stage_rc(tid * 16 + i * 8192, R, C); const int Rb = (R & ~31) + perm32(R & 31);
        voffA[i] = (unsigned)(R * g.lda + C) * 2u; voffB[i] = (unsigned)(Rb * g.ldb + C) * 2u; }
    const size_t kstep = (size_t)(BK * 2);
    const size_t hstepA = (size_t)HALF * g.lda * 2, hstepB = (size_t)HALF * g.ldb * 2;
    const size_t tstepA = 2 * hstepA, tstepB = 2 * hstepB;
    const unsigned ldsw = (unsigned)wid * 1024u, lds0 = (unsigned)(uintptr_t)lds;
    const int aoff = lds_byte(wr * 64 + fr, fq * 8), boff = lds_byte(wc * 32 + fr, fq * 8);
#define PG8_SA(b, h) (((b) * 2 + (h)) * HTB)
#define PG8_SB(b, h) ((4 + (b) * 2 + (h)) * HTB)
#define PG8_STAGE(bufoff, gbase, voff) do { _Pragma("unroll") for (int _i = 0; _i < 2; ++_i) { unsigned keep_; \
        asm volatile("s_mov_b32 %0, m0\n\ts_mov_b32 m0, %3\n\ts_nop 0\n\tglobal_load_lds_dwordx4 %1, %2\n\ts_mov_b32 m0, %0" : "=&s"(keep_) : "v"((voff)[_i]), "s"((const char*)(gbase)), "s"(lds0 + (unsigned)(bufoff) + ldsw + (unsigned)(_i * 8192)) : "memory"); } } while (0)
#define PG8_LDA(dst, b, h) do { _Pragma("unroll") for (int m = 0; m < 4; ++m) _Pragma("unroll") for (int k = 0; k < 2; ++k) dst[m][k] = *(const LAS bf16x8*)(lds + PG8_SA(b, h) + aoff + m * 2048 + k * 1024); } while (0)
#define PG8_LDB(dst, b, h) do { _Pragma("unroll") for (int n = 0; n < 2; ++n) _Pragma("unroll") for (int k = 0; k < 2; ++k) dst[n][k] = *(const LAS bf16x8*)(lds + PG8_SB(b, h) + boff + n * 2048 + k * 1024); } while (0)
#define PG8_MMA(ai, bj, At, Bt) do { __builtin_amdgcn_s_setprio(1); _Pragma("unroll") for (int m = 0; m < 4; ++m) _Pragma("unroll") for (int n = 0; n < 2; ++n) _Pragma("unroll") for (int k = 0; k < 2; ++k) \
        acc[ai][bj][m][n] = __builtin_amdgcn_mfma_f32_16x16x32_bf16(Bt[n][k], At[m][k], acc[ai][bj][m][n], 0, 0, 0); __builtin_amdgcn_s_setprio(0); } while (0)
#define PG8_WAIT_V(n) asm volatile("s_waitcnt vmcnt(" #n ")" ::: "memory")
#define PG8_WAIT_L(n) asm volatile("s_waitcnt lgkmcnt(" #n ")" ::: "memory")
#define PG8_BAR __builtin_amdgcn_s_barrier()
#define PG8_SCHED __builtin_amdgcn_sched_barrier(0)
    Unit cur, nxt; int ui = 0;
    if (!S.next(0, cur)) return;
    f32x4 acc[2][2][4][2];
#pragma unroll
    for (int a = 0; a < 2; ++a)
#pragma unroll
        for (int b = 0; b < 2; ++b)
#pragma unroll
            for (int m = 0; m < 4; ++m)
#pragma unroll
                for (int n = 0; n < 2; ++n) acc[a][b][m][n] = (f32x4){0.f, 0.f, 0.f, 0.f};
    bf16x8 At[4][2], B0[2][2], B1[2][2];
    const char* cA = (const char*)g.A + (size_t)cur.pm * tstepA; const char* cB = (const char*)g.Bt + (size_t)cur.pn * tstepB;
    if constexpr (SP2) {
        PG8_STAGE(PG8_SB(0, 0), cB, voffB); PG8_STAGE(PG8_SB(0, 1), cB + hstepB, voffB); PG8_STAGE(PG8_SA(0, 0), cA, voffA); PG8_STAGE(PG8_SA(0, 1), cA + hstepA, voffA);
        if (wr == 1) PG8_BAR;
        PG8_WAIT_V(2); PG8_BAR;
        PG8_STAGE(PG8_SB(1, 0), cB + kstep, voffB); PG8_STAGE(PG8_SA(1, 0), cA + kstep, voffA); PG8_STAGE(PG8_SB(1, 1), cB + hstepB + kstep, voffB);
        PG8_WAIT_V(6); PG8_BAR;
    } else {
        PG8_STAGE(PG8_SB(0, 0), cB, voffB); PG8_STAGE(PG8_SA(0, 0), cA, voffA); PG8_STAGE(PG8_SB(0, 1), cB + hstepB, voffB); PG8_STAGE(PG8_SA(0, 1), cA + hstepA, voffA);
        if (wr == 1) PG8_BAR;
        PG8_WAIT_V(4); PG8_BAR;
        PG8_STAGE(PG8_SB(1, 0), cB + kstep, voffB); PG8_STAGE(PG8_SA(1, 0), cA + kstep, voffA); PG8_STAGE(PG8_SB(1, 1), cB + hstepB + kstep, voffB);
        PG8_WAIT_V(6); PG8_BAR;
    }
    for (;;) {
        const bool has_next = S.next(ui + 1, nxt);
        const char* nA = has_next ? (const char*)g.A + (size_t)nxt.pm * tstepA : cA; const char* nB = has_next ? (const char*)g.Bt + (size_t)nxt.pn * tstepB : cB;
        for (int t = 0; t < nt; t += 2) {
            const bool last = (t == nt - 2);
            const char* a1 = cA + (size_t)(t + 1) * kstep;
            const char* a2 = last ? nA : cA + (size_t)(t + 2) * kstep; const char* b2 = last ? nB : cB + (size_t)(t + 2) * kstep;
            const char* a3 = a2 + kstep; const char* b3 = b2 + kstep;
            if constexpr (SP2) {
            PG8_LDB(B0, 0, 0); PG8_LDB(B1, 0, 1); PG8_SCHED; PG8_LDA(At, 0, 0); PG8_STAGE(PG8_SA(1, 1), a1 + hstepA, voffA);
            PG8_WAIT_V(8); PG8_WAIT_L(0); PG8_BAR; PG8_MMA(0, 0, At, B0); PG8_MMA(0, 1, At, B1); PG8_BAR; PG8_SCHED;
            PG8_LDA(At, 0, 1); PG8_STAGE(PG8_SB(0, 0), b2, voffB); PG8_STAGE(PG8_SB(0, 1), b2 + hstepB, voffB); PG8_STAGE(PG8_SA(0, 0), a2, voffA);
            PG8_WAIT_V(8); PG8_WAIT_L(0); PG8_BAR; PG8_MMA(1, 0, At, B0); PG8_MMA(1, 1, At, B1); PG8_BAR; PG8_SCHED;
            PG8_LDB(B0, 1, 0); PG8_LDB(B1, 1, 1); PG8_SCHED; PG8_LDA(At, 1, 0); PG8_STAGE(PG8_SA(0, 1), a2 + hstepA, voffA);
            PG8_WAIT_V(8); PG8_WAIT_L(0); PG8_BAR; PG8_MMA(0, 0, At, B0); PG8_MMA(0, 1, At, B1); PG8_BAR; PG8_SCHED;
            PG8_LDA(At, 1, 1); PG8_STAGE(PG8_SB(1, 0), b3, voffB); PG8_STAGE(PG8_SB(1, 1), b3 + hstepB, voffB); PG8_STAGE(PG8_SA(1, 0), a3, voffA);
            PG8_WAIT_V(8); PG8_WAIT_L(0); PG8_BAR; PG8_MMA(1, 0, At, B0); PG8_MMA(1, 1, At, B1); PG8_BAR; PG8_SCHED;
            } else {
            PG8_LDB(B0, 0, 0); PG8_SCHED; PG8_LDA(At, 0, 0); PG8_STAGE(PG8_SA(1, 1), a1 + hstepA, voffA);
            PG8_WAIT_L(8); PG8_BAR; PG8_WAIT_L(0); PG8_MMA(0, 0, At, B0); PG8_BAR; PG8_SCHED;
            PG8_LDB(B1, 0, 1); PG8_STAGE(PG8_SB(0, 0), b2, voffB);
            PG8_BAR; PG8_WAIT_L(0); PG8_MMA(0, 1, At, B1); PG8_BAR;
            PG8_LDA(At, 0, 1); PG8_STAGE(PG8_SA(0, 0), a2, voffA);
            PG8_BAR; PG8_WAIT_L(0); PG8_MMA(1, 0, At, B0); PG8_BAR; PG8_SCHED;
            PG8_STAGE(PG8_SB(0, 1), b2 + hstepB, voffB);
            PG8_WAIT_V(6); PG8_BAR; PG8_MMA(1, 1, At, B1); PG8_BAR;
            PG8_LDB(B0, 1, 0); PG8_SCHED; PG8_LDA(At, 1, 0); PG8_STAGE(PG8_SA(0, 1), a2 + hstepA, voffA);
            PG8_WAIT_L(8); PG8_BAR; PG8_WAIT_L(0); PG8_MMA(0, 0, At, B0); PG8_BAR; PG8_SCHED;
            PG8_LDB(B1, 1, 1); PG8_STAGE(PG8_SB(1, 0), b3, voffB);
            PG8_BAR; PG8_WAIT_L(0); PG8_MMA(0, 1, At, B1); PG8_BAR;
            PG8_LDA(At, 1, 1); PG8_STAGE(PG8_SA(1, 0), a3, voffA);
            PG8_BAR; PG8_WAIT_L(0); PG8_MMA(1, 0, At, B0); PG8_BAR; PG8_SCHED;
            PG8_STAGE(PG8_SB(1, 1), b3 + hstepB, voffB);
            PG8_WAIT_V(6); PG8_BAR; PG8_MMA(1, 1, At, B1); PG8_BAR;
            }
        }
        if constexpr (ALIGN_EPI) { if (wr == 0) PG8_BAR; }
        E(acc, cur, wr, wc, fr, fq);
        if (!has_next) break;
#pragma unroll
        for (int a = 0; a < 2; ++a)
#pragma unroll
            for (int b = 0; b < 2; ++b)
#pragma unroll
                for (int m = 0; m < 4; ++m)
#pragma unroll
                    for (int n = 0; n < 2; ++n) acc[a][b][m][n] = (f32x4){0.f, 0.f, 0.f, 0.f};
        cur = nxt; cA = nA; cB = nB; ++ui;
        if constexpr (ALIGN_EPI) { if (wr == 1) PG8_BAR; }
    }
    PG8_WAIT_V(0);
    if constexpr (!ALIGN_EPI) { if (wr == 0) PG8_BAR; }
    PG8_BAR;
#undef PG8_SA
#undef PG8_SB
#undef PG8_STAGE
#undef PG8_LDA
#undef PG8_LDB
#undef PG8_MMA
#undef PG8_WAIT_V
#undef PG8_WAIT_L
#undef PG8_BAR
#undef PG8_SCHED
}
}

constexpr int NT = 16384, SEQ = 8192, DM = 1024, DIN = 4680, NIN = 4864, NCHK = 256, NWAVES = 8, NTHR = 512;
constexpr float EPS = 1e-6f, GN_EPS = 64e-5f, DECAY_SCALE = 0.606531f;
constexpr float QSCALE = 0.07216878364870322f * 1.4426950408889634f;
constexpr size_t MiB = 1u << 20;
constexpr size_t WS_CTL = 0, CTL_BYTES = 1 * MiB;
constexpr size_t CTL_MOD = 65536;
constexpr size_t CTL_SSQ = 131072;
constexpr size_t WS_WIN = 1 * MiB;
constexpr size_t WS_CB = WS_WIN, WS_ECUM = WS_WIN + 8 * MiB, WS_CDEC = WS_ECUM + 512 * 1024;
constexpr size_t WS_WQ = 10 * MiB + 512 * 1024;
constexpr size_t WS_WUV = 11 * MiB;
constexpr size_t WS_WLW = 11 * MiB + 512 * 1024;
constexpr size_t WS_WLA = WS_WLW + 65536;
constexpr size_t WS_WOUT = 12 * MiB;
constexpr size_t WS_XN = 15 * MiB;
constexpr size_t WS_TT = WS_XN, WS_QE = WS_XN + 16 * MiB;
constexpr size_t WS_QLAT = 47 * MiB, WS_KVL = 55 * MiB;
constexpr size_t WS_OL = WS_QLAT;
constexpr size_t WS_GATES = 63 * MiB;
constexpr size_t WS_XBC = 111 * MiB;
constexpr size_t WS_R = 143 * MiB, WS_K = 159 * MiB, WS_V = 175 * MiB;
constexpr size_t WS_F = 191 * MiB;
constexpr size_t WS_Q = 200 * MiB;
constexpr size_t WS_KVB = 224 * MiB;
constexpr size_t WS_YD = 230 * MiB;
constexpr size_t WS_ROPE = 246 * MiB;
constexpr size_t WS_HX = 250 * MiB;
constexpr size_t WS_HRKV = WS_HX + 1536 * 1024;
constexpr size_t WS_HF = WS_HRKV + 768 * 1024;
constexpr size_t WS_END = 253 * MiB;
constexpr int LDS_BYTES = 152 * 1024;

#define LDS_WAIT() asm volatile("s_waitcnt lgkmcnt(0)" ::: "memory")
__device__ __forceinline__ unsigned f2bf(float f) { unsigned u = __builtin_bit_cast(unsigned, f); return (u + 0x7fffu + ((u >> 16) & 1u)) >> 16; }
typedef __bf16 bf16x2_hw __attribute__((ext_vector_type(2)));
__device__ __forceinline__ unsigned pk2(float lo, float hi) { const f32x2 v = {lo, hi}; return __builtin_bit_cast(unsigned, __builtin_convertvector(v, bf16x2_hw)); }
__device__ __forceinline__ float bf2f(unsigned short b) { return __builtin_bit_cast(float, (unsigned)b << 16); }
__device__ __forceinline__ float bflo(unsigned w) { return __builtin_bit_cast(float, w << 16); }
__device__ __forceinline__ float bfhi(unsigned w) { return __builtin_bit_cast(float, w & 0xffff0000u); }
__device__ __forceinline__ float wave_sum(float v) {
#pragma unroll
    for (int o = 1; o < 64; o <<= 1) v += __shfl_xor(v, o);
    return v;
}
__device__ __forceinline__ float sigmoidf_(float x) { return 1.f / (1.f + __expf(-x)); }
__device__ __forceinline__ float siluf_(float x) { return x / (1.f + __expf(-x)); }
__device__ __forceinline__ int pi16(int n) { const int x = n & 15; return (n & ~15) | ((x >= 4 && x < 8) ? x + 4 : (x >= 8 && x < 12) ? x - 4 : x); }
__device__ __forceinline__ int sg32(int x) { return (x & ~31) | (16 * ((x >> 2) & 1) + 4 * ((x & 31) >> 3) + (x & 3)); }
__device__ __forceinline__ int crow(int r, int hi) { return (r & 3) + 8 * (r >> 2) + 4 * hi; }

template <int K> __device__ __forceinline__ f32x4 mma_tile(const LAS bf16_t* A, int lda, const LAS bf16_t* Bt, int ldb, int lane) {
    f32x4 acc = {0.f, 0.f, 0.f, 0.f};
    const LAS bf16_t* ap = A + (lane & 15) * lda + (lane >> 4) * 8;
    const LAS bf16_t* bp = Bt + (lane & 15) * ldb + (lane >> 4) * 8;
#pragma unroll
    for (int k = 0; k < K; k += 32) {
        const bf16x8 a = *(const LAS bf16x8*)(ap + k), b = *(const LAS bf16x8*)(bp + k);
        acc = __builtin_amdgcn_mfma_f32_16x16x32_bf16(a, b, acc, 0, 0, 0);
    }
    return acc;
}

struct Args {
    const float* in[31]; float* out; unsigned char* ws; int ph_lo, ph_hi;
};
struct Ctx {
    LAS unsigned char* lds; int tid, lane, wave, G, bid;
    unsigned char* ws; float* out;
    const float* const* in;
};
__device__ __forceinline__ const float* ldin(const float* const* in, int i) { asm volatile("" : "+s"(i)); return (const float*)(const GAS float*)in[i]; }
#define INP(i) ldin(F.in, i)
__device__ __forceinline__ int fresh_lane() { int l_ = (int)__builtin_amdgcn_mbcnt_hi(~0u, __builtin_amdgcn_mbcnt_lo(~0u, 0u)); asm volatile("" : "+v"(l_)); return l_; }
enum { I_X = 0, I_C, I_POS, I_ADAW, I_ADAB, I_NORMW, I_WIN, I_QNW, I_WUQ, I_KVNW, I_WUKV, I_CONVW, I_CONVB, I_DTB, I_ALOG, I_DSKIP, I_SSDNW,
       I_MURKV, I_MUW, I_MUA, I_W0, I_WLB, I_A0, I_ALB, I_KK, I_KA, I_RK, I_LNXW, I_LNXB, I_WOUT, I_FNW };

__device__ __forceinline__ int win_src_col(int n) {
    if (n < 448) return n;
    if (n < 512) return -1;
    if (n < 1024) return 448 + (n - 512);
    if (n < 1536) return 960 + (n - 1024);
    if (n < 2560) return 1472 + (n - 1536);
    if (n < 3072) return 2504 + (n - 2560);
    if (n < 3584) return 3016 + (n - 3072);
    if (n < 4096) return 3528 + (n - 3584);
    if (n < 4608) return 4168 + (n - 4096);
    if (n < 4672) return 4040 + (n - 4608);
    if (n < 4736) return 4104 + (n - 4672);
    if (n < 4744) return 2496 + (n - 4736);
    return -1;
}
template <class Src> __device__ __forceinline__ void transpose_item(const Src& src, bf16_t* WT, int ldw, LAS float* scr, int kb, int nb, int lane) {
    const int k0 = 64 * kb, n0 = 32 * nb;
#pragma unroll 8
    for (int i = 0; i < 32; ++i) { const int kk = 2 * i + (lane >> 5); scr[kk * 33 + (lane & 31)] = src(k0 + kk, n0 + (lane & 31)); }
    LDS_WAIT();
    const int c = lane & 7;
#pragma unroll
    for (int j = 0; j < 4; ++j) { const int n = (lane >> 3) + 8 * j; const LAS float* s = scr + (8 * c) * 33 + n;
        u32x4 o; o.x = pk2(s[0 * 33], s[1 * 33]); o.y = pk2(s[2 * 33], s[3 * 33]); o.z = pk2(s[4 * 33], s[5 * 33]); o.w = pk2(s[6 * 33], s[7 * 33]);
        *(u32x4*)(WT + (size_t)(n0 + n) * ldw + k0 + 8 * c) = o; }
    LDS_WAIT();
}
__device__ __forceinline__ void prep_weights(const Ctx& F, int l) {
    LAS float* scr = (LAS float*)(F.lds + F.wave * 8448);
    const int gw = F.bid * NWAVES + F.wave, NGW = F.G * NWAVES;
    const float* w_in = INP(I_WIN) + (size_t)l * DM * DIN;
    const float* w_out = INP(I_WOUT) + (size_t)l * 1536 * 1024;
    const float* wlb = INP(I_WLB) + (size_t)l * 64 * 512;
    const float* alb = INP(I_ALB) + (size_t)l * 64 * 512;
    bf16_t* WIN = (bf16_t*)(F.ws + WS_WIN); bf16_t* WOUT = (bf16_t*)(F.ws + WS_WOUT); bf16_t* WLW = (bf16_t*)(F.ws + WS_WLW); bf16_t* WLA = (bf16_t*)(F.ws + WS_WLA);
    constexpr int I_IN = 16 * (NIN / 32), I_OUT = 24 * 32, I_LW = 16, I_LA = 16, NITEMS = I_IN + I_OUT + I_LW + I_LA;
    for (int it = gw; it < NITEMS; it += NGW) {
        int r = it;
        if (r < I_IN) { const int kb = r / (NIN / 32), nb = r % (NIN / 32);
            transpose_item([&](int k, int n) { const int sc = win_src_col(n); return sc >= 0 ? w_in[(size_t)k * DIN + sc] : 0.f; }, WIN, 1024, scr, kb, nb, F.lane); continue; }
        r -= I_IN;
        if (r < I_OUT) { const int kb = r / 32, nb = r % 32;
            transpose_item([&](int k, int n) { return w_out[(size_t)k * 1024 + n]; }, WOUT, 1536, scr, kb, nb, F.lane); continue; }
        r -= I_OUT;
        if (r < I_LW) { transpose_item([&](int k, int n) { return wlb[k * 512 + n]; }, WLW, 64, scr, 0, r, F.lane); continue; }
        r -= I_LW;
        transpose_item([&](int k, int n) { return alb[k * 512 + n]; }, WLA, 64, scr, 0, r, F.lane);
    }
    const float* wuq = INP(I_WUQ) + (size_t)l * 256 * 768; const float* wukv = INP(I_WUKV) + (size_t)l * 128 * 1024; const float* qnw = INP(I_QNW) + l * 256;
    bf16_t* WQ = (bf16_t*)(F.ws + WS_WQ); bf16_t* WUV = (bf16_t*)(F.ws + WS_WUV);
    const int gt = F.bid * NTHR + F.tid, NGT = F.G * NTHR;
    for (int e = gt; e < 768 * 256; e += NGT) {
        const int n = e >> 8, k = e & 255, h = n / 192, idx = n % 192; float v;
        if (idx < 128) {
            const f32x4* a = (const f32x4*)(wuq + (size_t)k * 768 + h * 192); const f32x4* b = (const f32x4*)(wukv + (size_t)idx * 1024 + h * 256);
            float s = 0.f;
#pragma unroll 8
            for (int d = 0; d < 32; ++d) { const f32x4 x = a[d], y = b[d]; s += x.x * y.x + x.y * y.y + x.z * y.z + x.w * y.w; }
            v = s;
        } else v = wuq[(size_t)k * 768 + n];
        WQ[e] = (bf16_t)f2bf(v * qnw[k]);
    }
    for (int e = gt; e < 512 * 512; e += NGT) {
        const int n = e >> 9, k = e & 511, h = n >> 7, d = n & 127, h2 = k >> 7, c = k & 127;
        WUV[e] = (h == h2) ? (bf16_t)f2bf(wukv[(size_t)c * 1024 + h * 256 + 128 + d]) : (bf16_t)0;
    }
}
__device__ __forceinline__ void p0_prologue(const Ctx& F) {
    prep_weights(F, 0);
    const int gw = F.bid * NWAVES + F.wave, NGW = F.G * NWAVES;
    float* MOD = (float*)(F.ws + WS_CTL + CTL_MOD);
    for (int it = gw; it < 2 * 12 * 32; it += NGW) {
        const int l = it / 384, r = it % 384, cb = r / 32, ks = r % 32;
        const float* aw = INP(I_ADAW) + (size_t)l * DM * 3072 + (size_t)(ks * 32) * 3072 + cb * 256 + F.lane * 4;
        const float* cc = INP(I_C);
        f32x4 a0 = {0.f, 0.f, 0.f, 0.f}, a1 = a0;
#pragma unroll 8
        for (int k = 0; k < 32; ++k) { const f32x4 w = *(const f32x4*)(aw + (size_t)k * 3072); const float s0 = siluf_(cc[ks * 32 + k]), s1 = siluf_(cc[DM + ks * 32 + k]); a0 += w * s0; a1 += w * s1; }
        if (ks == 0) { const f32x4 bb = *(const f32x4*)(INP(I_ADAB) + l * 3072 + cb * 256 + F.lane * 4); a0 += bb; a1 += bb; }
        float* m0 = MOD + (size_t)(l * 2 + 0) * 3072 + cb * 256 + F.lane * 4; float* m1 = m0 + 3072;
#pragma unroll
        for (int j = 0; j < 4; ++j) { atomicAdd(m0 + j, a0[j]); atomicAdd(m1 + j, a1[j]); }
    }
    float* ROPE = (float*)(F.ws + WS_ROPE); const int* pos = (const int*)INP(I_POS);
    for (int e = F.bid * NTHR + F.tid; e < NT * 32; e += F.G * NTHR) {
        const int m = e >> 5, i = e & 31;
        const float invf = powf(10000.f, -(float)i / 32.f); const float ang = (float)pos[m] * invf;
        const double a = (double)ang; const double kq = __builtin_rint(a * 0.15915494309189535); const float rr = (float)(a - kq * 6.283185307179586);
        ROPE[(size_t)m * 64 + i] = cosf(rr); ROPE[(size_t)m * 64 + 32 + i] = sinf(rr);
    }
}
__device__ __forceinline__ void p1_norm(const Ctx& F, int l) {
    const float* xin = (l == 0) ? INP(I_X) : F.out;
    const float* nw = INP(I_NORMW) + l * DM; const float* MOD = (const float*)(F.ws + WS_CTL + CTL_MOD);
    bf16_t* XN = (bf16_t*)(F.ws + WS_XN);
    const int gw = F.bid * NWAVES + F.wave, NGW = F.G * NWAVES;
    for (int m = gw; m < NT; m += NGW) {
        const int b = m >> 13; const float* md = MOD + (size_t)(l * 2 + b) * 3072;
        const f32x4* xr = (const f32x4*)(xin + (size_t)m * DM) + F.lane;
        f32x4 v[4]; float s = 0.f;
#pragma unroll
        for (int j = 0; j < 4; ++j) { v[j] = xr[64 * j]; s += v[j].x * v[j].x + v[j].y * v[j].y + v[j].z * v[j].z + v[j].w * v[j].w; }
        const float rstd = 1.f / sqrtf(wave_sum(s) * (1.f / DM) + EPS);
        unsigned long long* o8 = (unsigned long long*)(XN + (size_t)m * DM) + F.lane;
#pragma unroll
        for (int j = 0; j < 4; ++j) { const int c0 = 4 * F.lane + 256 * j;
            const f32x4 w = *(const f32x4*)(nw + c0), sh = *(const f32x4*)(md + c0), sc = *(const f32x4*)(md + 1024 + c0);
            const f32x4 y = v[j] * rstd * w * (sc + 1.f) + sh;
            o8[64 * j] = (unsigned long long)pk2(y.x, y.y) | ((unsigned long long)pk2(y.z, y.w) << 32); }
    }
}
__device__ __forceinline__ u32x4 pack8(f32x4 a, f32x4 b) { u32x4 w; w.x = pk2(a[0], a[1]); w.y = pk2(a[2], a[3]); w.z = pk2(b[0], b[1]); w.w = pk2(b[2], b[3]); return w; }
struct EpiIn {
    unsigned char* ws; int l;
    __device__ __forceinline__ void operator()(const f32x4 (&acc)[2][2][4][2], const pg8::Unit& u, int wr, int wc, int fr, int fq) const {
        { int ln_ = (int)__builtin_amdgcn_mbcnt_hi(~0u, __builtin_amdgcn_mbcnt_lo(~0u, 0u)); asm volatile("" : "+v"(ln_)); fr = ln_ & 15; fq = ln_ >> 4; }
        const int pn = u.pn; size_t bo; int ld, c0;
        if (pn == 0) { bo = WS_QLAT; ld = 256; c0 = 0; } else if (pn == 1) { bo = WS_KVL; ld = 256; c0 = 0; }
        else if (pn < 4) { bo = WS_GATES; ld = 1536; c0 = (pn - 2) * 256; } else if (pn < 6) { bo = WS_GATES; ld = 1536; c0 = 512 + (pn - 4) * 256; }
        else if (pn < 10) { bo = WS_XBC; ld = 1024; c0 = (pn - 6) * 256; } else if (pn < 12) { bo = WS_R; ld = 512; c0 = (pn - 10) * 256; }
        else if (pn < 14) { bo = WS_K; ld = 512; c0 = (pn - 12) * 256; } else if (pn < 16) { bo = WS_V; ld = 512; c0 = (pn - 14) * 256; }
        else if (pn < 18) { bo = WS_GATES; ld = 1536; c0 = 1024 + (pn - 16) * 256; } else { bo = WS_F; ld = 144; c0 = 0; }
        bf16_t* base = (bf16_t*)(ws + bo); float* F = (float*)(ws + WS_F);
        float* ssq_q = (float*)(ws + WS_CTL + CTL_SSQ) + (size_t)(l * 2) * NT; float* ssq_kv = ssq_q + NT;
        const int row0 = u.pm * 256 + wr * 64 + fr, col0 = wc * 32 + 8 * fq;
        if (pn < 18) {
#pragma unroll
            for (int ai = 0; ai < 2; ++ai)
#pragma unroll
                for (int m = 0; m < 4; ++m) { const int row = row0 + ai * 128 + m * 16; bf16_t* rp = base + (size_t)row * ld + c0 + col0;
#pragma unroll
                    for (int bj = 0; bj < 2; ++bj) *(u32x4*)(rp + bj * 128) = pack8(acc[ai][bj][m][0], acc[ai][bj][m][1]);
                    if (pn < 2) { float s = 0.f;
#pragma unroll
                        for (int bj = 0; bj < 2; ++bj) if (pn == 0 || bj == 0) {
#pragma unroll
                            for (int n = 0; n < 2; ++n) { const f32x4 x = acc[ai][bj][m][n]; s += x[0] * x[0] + x[1] * x[1] + x[2] * x[2] + x[3] * x[3]; } }
                        s += __shfl_xor(s, 16); s += __shfl_xor(s, 32);
                        if (fq == 0) atomicAdd((pn == 0 ? ssq_q : ssq_kv) + row, s); } }
        } else {
#pragma unroll
            for (int ai = 0; ai < 2; ++ai)
#pragma unroll
                for (int m = 0; m < 4; ++m) { const int row = row0 + ai * 128 + m * 16;
#pragma unroll
                    for (int bj = 0; bj < 2; ++bj) { const int c = bj * 128 + col0; if (c < 136) { float* fp = F + (size_t)row * 144 + c; *(f32x4*)fp = acc[ai][bj][m][0]; *(f32x4*)(fp + 4) = acc[ai][bj][m][1]; } } }
        }
    }
};
struct EpiQ {
    unsigned char* ws; int l;
    __device__ __forceinline__ void operator()(const f32x4 (&acc)[2][2][4][2], const pg8::Unit& u, int wr, int wc, int fr, int fq) const {
        { int ln_ = (int)__builtin_amdgcn_mbcnt_hi(~0u, __builtin_amdgcn_mbcnt_lo(~0u, 0u)); asm volatile("" : "+v"(ln_)); fr = ln_ & 15; fq = ln_ >> 4; }
        bf16_t* Q = (bf16_t*)(ws + WS_Q); const float* ssq = (const float*)(ws + WS_CTL + CTL_SSQ) + (size_t)(l * 2) * NT;
        const int row0 = u.pm * 256 + wr * 64 + fr, c0 = u.pn * 256 + wc * 32 + 8 * fq;
#pragma unroll
        for (int ai = 0; ai < 2; ++ai)
#pragma unroll
            for (int m = 0; m < 4; ++m) { const int row = row0 + ai * 128 + m * 16; const float sc = QSCALE / sqrtf(ssq[row] * (1.f / 256.f) + EPS); bf16_t* qp = Q + (size_t)row * 768 + c0;
#pragma unroll
                for (int bj = 0; bj < 2; ++bj) *(u32x4*)(qp + bj * 128) = pack8(acc[ai][bj][m][0] * sc, acc[ai][bj][m][1] * sc); }
    }
};
struct EpiUV {
    bf16_t* gates;
    __device__ __forceinline__ void operator()(const f32x4 (&acc)[2][2][4][2], const pg8::Unit& u, int wr, int wc, int fr, int fq) const {
        { int ln_ = (int)__builtin_amdgcn_mbcnt_hi(~0u, __builtin_amdgcn_mbcnt_lo(~0u, 0u)); asm volatile("" : "+v"(ln_)); fr = ln_ & 15; fq = ln_ >> 4; }
        const int row0 = u.pm * 256 + wr * 64 + fr;
#pragma unroll
        for (int ai = 0; ai < 2; ++ai)
#pragma unroll
            for (int m = 0; m < 4; ++m) { asm volatile("" ::: "memory"); const int row = row0 + ai * 128 + m * 16;
#pragma unroll
                for (int bj = 0; bj < 2; ++bj) { const int c = u.pn * 256 + bj * 128 + wc * 32 + 8 * fq; u32x4* gp = (u32x4*)(gates + (size_t)row * 1536 + c); const u32x4 gw = *gp;
                    f32x4 v0 = acc[ai][bj][m][0], v1 = acc[ai][bj][m][1];
                    v0[0] *= siluf_(bflo(gw.x)); v0[1] *= siluf_(bfhi(gw.x)); v0[2] *= siluf_(bflo(gw.y)); v0[3] *= siluf_(bfhi(gw.y));
                    v1[0] *= siluf_(bflo(gw.z)); v1[1] *= siluf_(bfhi(gw.z)); v1[2] *= siluf_(bflo(gw.w)); v1[3] *= siluf_(bfhi(gw.w));
                    *gp = pack8(v0, v1); } }
    }
};
struct EpiOut {
    const float* xin; float* xout; const float* gate;
    __device__ __forceinline__ void operator()(const f32x4 (&acc)[2][2][4][2], const pg8::Unit& u, int wr, int wc, int fr, int fq) const {
        { int ln_ = (int)__builtin_amdgcn_mbcnt_hi(~0u, __builtin_amdgcn_mbcnt_lo(~0u, 0u)); asm volatile("" : "+v"(ln_)); fr = ln_ & 15; fq = ln_ >> 4; }
        const int row0 = u.pm * 256 + wr * 64 + fr;
#pragma unroll
        for (int bj = 0; bj < 2; ++bj) { const int c = u.pn * 256 + bj * 128 + wc * 32 + 8 * fq;
#pragma unroll
            for (int ai = 0; ai < 2; ++ai)
#pragma unroll
                for (int m = 0; m < 4; ++m) { const int row = row0 + ai * 128 + m * 16; const float* gp = gate + (size_t)(row >> 13) * 3072 + c;
                    const f32x4 g0 = *(const f32x4*)gp, g1 = *(const f32x4*)(gp + 4);
                    const size_t off = (size_t)row * DM + c; const f32x4 x0 = *(const f32x4*)(xin + off), x1 = *(const f32x4*)(xin + off + 4);
                    *(f32x4*)(xout + off) = x0 + g0 * acc[ai][bj][m][0]; *(f32x4*)(xout + off + 4) = x1 + g1 * acc[ai][bj][m][1]; } }
    }
};

__device__ __forceinline__ void p3a_extras(const Ctx& F, int l) {
    const int tid_ = F.wave * 64 + fresh_lane();
    const int gt = F.bid * NTHR + tid_, NGT = F.G * NTHR;
    const bf16_t* KVL = (const bf16_t*)(F.ws + WS_KVL); bf16_t* KVB = (bf16_t*)(F.ws + WS_KVB);
    const float* ssq = (const float*)(F.ws + WS_CTL + CTL_SSQ) + (size_t)(l * 2 + 1) * NT; const float* kvnw = INP(I_KVNW) + l * 128;
    const float* ROPE = (const float*)(F.ws + WS_ROPE);
    for (int e = gt; e < NT * 24; e += NGT) {
        const int m = e / 24, g = e % 24;
        if (g < 16) {
            const u32x4 w = *(const u32x4*)(KVL + (size_t)m * 256 + 8 * g); const float rs = 1.f / sqrtf(ssq[m] * (1.f / 128.f) + EPS);
            const f32x4 n0 = *(const f32x4*)(kvnw + 8 * g), n1 = *(const f32x4*)(kvnw + 8 * g + 4);
            u32x4 o; o.x = pk2(bflo(w.x) * rs * n0[0], bfhi(w.x) * rs * n0[1]); o.y = pk2(bflo(w.y) * rs * n0[2], bfhi(w.y) * rs * n0[3]);
            o.z = pk2(bflo(w.z) * rs * n1[0], bfhi(w.z) * rs * n1[1]); o.w = pk2(bflo(w.w) * rs * n1[2], bfhi(w.w) * rs * n1[3]);
            *(u32x4*)(KVB + (size_t)m * 192 + 8 * g) = o;
        } else {
            const int i0 = 4 * (g - 16);
            const u32x2 a = *(const u32x2*)(KVL + (size_t)m * 256 + 128 + i0), b = *(const u32x2*)(KVL + (size_t)m * 256 + 160 + i0);
            const f32x4 cs = *(const f32x4*)(ROPE + (size_t)m * 64 + i0), sn = *(const f32x4*)(ROPE + (size_t)m * 64 + 32 + i0);
            const f32x4 x1 = {bflo(a.x), bfhi(a.x), bflo(a.y), bfhi(a.y)}, x2 = {bflo(b.x), bfhi(b.x), bflo(b.y), bfhi(b.y)};
            const f32x4 o1 = x1 * cs - x2 * sn, o2 = x1 * sn + x2 * cs;
            u32x2 w1, w2; w1.x = pk2(o1[0], o1[1]); w1.y = pk2(o1[2], o1[3]); w2.x = pk2(o2[0], o2[1]); w2.y = pk2(o2[2], o2[3]);
            *(u32x2*)(KVB + (size_t)m * 192 + 128 + i0) = w1; *(u32x2*)(KVB + (size_t)m * 192 + 160 + i0) = w2;
        }
    }
    const u32x4* XBC = (const u32x4*)(F.ws + WS_XBC); u32x4* HX = (u32x4*)(F.ws + WS_HX);
    for (int e = gt; e < NCHK * 3 * 128; e += NGT) { const int c = e / 384, r = e % 384, j = r >> 7, p = r & 127; HX[e] = XBC[(size_t)(64 * c + 61 + j) * 128 + p]; }
    u32x4* HR = (u32x4*)(F.ws + WS_HRKV);
    for (int e = gt; e < 3 * NCHK * 64; e += NGT) { const int w = e / (NCHK * 64), r = e % (NCHK * 64), c = r >> 6, p = r & 63;
        const u32x4* src = (const u32x4*)(F.ws + (w == 0 ? WS_R : w == 1 ? WS_K : WS_V)); HR[e] = src[(size_t)(64 * c + 63) * 64 + p]; }
    const f32x4* FF = (const f32x4*)(F.ws + WS_F); f32x4* HF = (f32x4*)(F.ws + WS_HF);
    for (int e = gt; e < NCHK * 32; e += NGT) { const int c = e >> 5, p = e & 31; HF[e] = FF[(size_t)(64 * c + 63) * 36 + p]; }
}

__device__ __forceinline__ int ssd_win_col(int g, int o) { return o < 256 ? 256 * g + o : o < 384 ? 512 + 128 * g + (o - 256) : 768 + 128 * g + (o - 384); }
__device__ __forceinline__ void p3b_ssd(const Ctx& F, int l) {
    constexpr int SC_C = 0, SC_B = 17408, SC_BT = 34816, SC_XST = 53248, SC_CB = 90112, SC_G = 106752, SC_XSD = 115968, SC_DT = 125184, SC_AC = 127232;
    LAS bf16_t* Cg = (LAS bf16_t*)(F.lds + SC_C); LAS bf16_t* Bg = (LAS bf16_t*)(F.lds + SC_B); LAS bf16_t* BT = (LAS bf16_t*)(F.lds + SC_BT);
    LAS bf16_t* XST = (LAS bf16_t*)(F.lds + SC_XST); LAS float* CB = (LAS float*)(F.lds + SC_CB); LAS bf16_t* Gh = (LAS bf16_t*)(F.lds + SC_G);
    LAS bf16_t* XSD = (LAS bf16_t*)(F.lds + SC_XSD); LAS float* DT = (LAS float*)(F.lds + SC_DT); LAS float* AC = (LAS float*)(F.lds + SC_AC);
    bf16_t* XBC = (bf16_t*)(F.ws + WS_XBC); const bf16_t* HX = (const bf16_t*)(F.ws + WS_HX); const float* Ff = (const float*)(F.ws + WS_F);
    bf16_t* Cbuf = (bf16_t*)(F.ws + WS_CB); float* ECUM = (float*)(F.ws + WS_ECUM); float* CDEC = (float*)(F.ws + WS_CDEC); bf16_t* YD = (bf16_t*)(F.ws + WS_YD);
    const float* convw = INP(I_CONVW) + (size_t)l * 4 * 1024; const float* convb = INP(I_CONVB) + l * 1024;
    const float* dtb = INP(I_DTB) + l * 8; const float* alog = INP(I_ALOG) + l * 8; const float* dskip = INP(I_DSKIP) + l * 8;
    const int tid = F.tid, lane = F.lane, wave = F.wave;
    for (int c = F.bid; c < NCHK; c += F.G) {
        const int m0 = 64 * c; const bool first = (c & 127) == 0;
        if (wave == 0) {
            const int t = lane;
#pragma unroll
            for (int h = 0; h < 8; ++h) {
                const float raw = Ff[(size_t)(m0 + t) * 144 + 128 + h] + dtb[h];
                const float dt = raw > 20.f ? raw : log1pf(expf(raw));
                float v = dt * (-expf(alog[h]));
#pragma unroll
                for (int o = 1; o < 64; o <<= 1) { const float y = __shfl_up(v, o); if (lane >= o) v += y; }
                DT[t * 8 + h] = dt; AC[t * 8 + h] = v;
                const float ev = expf(v); ECUM[(size_t)(c * 8 + h) * 64 + t] = ev; if (t == 63) CDEC[c * 8 + h] = ev;
            }
        }
        for (int g = 0; g < 2; ++g) {
            {
                const int col = ssd_win_col(g, tid);
                const float w0 = convw[col], w1 = convw[1024 + col], w2 = convw[2048 + col], w3 = convw[3072 + col], cb = convb[col];
                float h0 = 0.f, h1 = 0.f, h2 = 0.f;
                if (!first) { h0 = bf2f(HX[(size_t)((c - 1) * 3 + 0) * 1024 + col]); h1 = bf2f(HX[(size_t)((c - 1) * 3 + 1) * 1024 + col]); h2 = bf2f(HX[(size_t)((c - 1) * 3 + 2) * 1024 + col]); }
#pragma unroll 8
                for (int t = 0; t < 64; ++t) {
                    const float x = bf2f(XBC[(size_t)(m0 + t) * 1024 + col]);
                    const float u = w0 * h0 + w1 * h1 + w2 * h2 + w3 * x + cb; h0 = h1; h1 = h2; h2 = x;
                    const bf16_t bv = (bf16_t)f2bf(siluf_(u));
                    if (tid < 256) XST[tid * 72 + t] = bv;
                    else if (tid < 384) { const int n = tid - 256; Bg[t * 136 + n] = bv; BT[n * 72 + t] = bv; }
                    else { const int n = tid - 384; Cg[t * 136 + n] = bv; Cbuf[(size_t)(m0 + t) * 256 + g * 128 + n] = bv; }
                }
            }
            __syncthreads();
#pragma unroll
            for (int i = 0; i < 2; ++i) { const int idx = 2 * wave + i, ti = idx >> 2, si = idx & 3;
                const f32x4 acc = mma_tile<128>(Cg + ti * 16 * 136, 136, Bg + si * 16 * 136, 136, lane);
#pragma unroll
                for (int r = 0; r < 4; ++r) CB[(ti * 16 + 4 * (lane >> 4) + r) * 65 + si * 16 + (lane & 15)] = acc[r]; }
            __syncthreads();
            for (int hl = 0; hl < 4; ++hl) {
                const int h = 4 * g + hl;
                {   const int t = tid >> 3, s0 = (tid & 7) * 8; const float at = AC[t * 8 + h], a63 = AC[63 * 8 + h];
                    float gv[8], xv[8]; const u32x4 xw = *(const LAS u32x4*)(XST + (64 * hl + t) * 72 + s0);
                    const float xf[8] = {bflo(xw.x), bfhi(xw.x), bflo(xw.y), bfhi(xw.y), bflo(xw.z), bfhi(xw.z), bflo(xw.w), bfhi(xw.w)};
#pragma unroll
                    for (int j = 0; j < 8; ++j) { const int s = s0 + j; const float as = AC[s * 8 + h], ds = DT[s * 8 + h];
                        gv[j] = (s <= t) ? CB[t * 65 + s] * expf(at - as) * ds : 0.f; xv[j] = xf[j] * ds * expf(a63 - as); }
                    u32x4 o; o.x = pk2(gv[0], gv[1]); o.y = pk2(gv[2], gv[3]); o.z = pk2(gv[4], gv[5]); o.w = pk2(gv[6], gv[7]); *(LAS u32x4*)(Gh + t * 72 + s0) = o;
                    o.x = pk2(xv[0], xv[1]); o.y = pk2(xv[2], xv[3]); o.z = pk2(xv[4], xv[5]); o.w = pk2(xv[6], xv[7]); *(LAS u32x4*)(XSD + t * 72 + s0) = o; }
                __syncthreads();
                const float dsk = dskip[h];
#pragma unroll
                for (int i = 0; i < 2; ++i) { const int idx = 2 * wave + i, ti = idx >> 2, pi = idx & 3;
                    const f32x4 acc = mma_tile<64>(Gh + ti * 16 * 72, 72, XST + (64 * hl + 16 * pi) * 72, 72, lane);
#pragma unroll
                    for (int r = 0; r < 4; ++r) { const int t = ti * 16 + 4 * (lane >> 4) + r, p = pi * 16 + (lane & 15);
                        const float y = acc[r] + dsk * bf2f(XST[(64 * hl + p) * 72 + t]); YD[(size_t)(m0 + t) * 512 + 64 * h + p] = (bf16_t)f2bf(y); } }
#pragma unroll
                for (int i = 0; i < 4; ++i) { const int idx = 4 * wave + i, pi = idx >> 3, ni = idx & 7;
                    const f32x4 acc = mma_tile<64>(XSD + pi * 16 * 72, 72, BT + ni * 16 * 72, 72, lane);
#pragma unroll
                    for (int r = 0; r < 4; ++r) { const int p = pi * 16 + 4 * (lane >> 4) + r, n = ni * 16 + (lane & 15);
                        const int f = hl * 8192 + p * 128 + n, row = f >> 9, col = ssd_win_col(g, f & 511);
                        XBC[(size_t)(m0 + row) * 1024 + col] = (bf16_t)f2bf(acc[r]); } }
                __syncthreads();
            }
        }
    }
}

__device__ __forceinline__ void p3c_rwkv(const Ctx& F, int l) {
    constexpr int M9 = 9216, O_TW = 0, O_AL = 9216, O_SL = 18432, O_MAB = O_SL + 12 * M9  , O_LWF = O_SL + 10 * M9  , O_ICF = O_LWF + 16640, O_WL = O_MAB + 16640  , O_SCR = O_WL + 256;
    static_assert(O_ICF + 16640 <= O_MAB + 16640 && O_SCR + 4224 <= LDS_BYTES, "rwkv lds map");
#define LB() ({ LAS unsigned char* p_ = F.lds; asm volatile("" : "+s"(p_)); p_; })
#define SLOT(i) ((LAS bf16_t*)(L + O_SL + (i) * M9))
#define TW ((LAS bf16_t*)(L + O_TW))
#define AL ((LAS bf16_t*)(L + O_AL))
#define AT SLOT(0)
#define ATt SLOT(1)
#define BTl SLOT(2)
#define KTl SLOT(3)
#define RT SLOT(4)
#define BHt SLOT(5)
#define KH SLOT(6)
#define VT SLOT(7)
#define MI SLOT(8)
#define MakT SLOT(9)
#define Rb SLOT(10)
#define Rk SLOT(11)
#define Attn SLOT(0)
#define KEt SLOT(1)
#define X1t SLOT(2)
#define X2t SLOT(3)
#define S8 SLOT(8)
#define S9 SLOT(9)
#define MAB ((LAS float*)(L + O_MAB))
#define LWf ((LAS float*)(L + O_LWF))
#define ICf ((LAS float*)(L + O_ICF))
#define WL ((LAS float*)(L + O_WL))
#define SCR ((LAS float*)(L + O_SCR))
    const int tid = F.tid, lane = F.lane, wave = F.wave;
    for (int c = F.bid; c < NCHK; c += F.G) {
        const int m0 = 64 * c; const bool first = (c & 127) == 0;
        {
            LAS unsigned char* L = LB();
            const int t = tid >> 3, q0 = (tid & 7) * 8;
            const float* Ff = (const float*)(F.ws + WS_F); const float* HF = (const float*)(F.ws + WS_HF); const float* mu_w = INP(I_MUW) + l * 64; const float* mu_a = INP(I_MUA) + l * 64;
            float cw[8], pw[8], ca[8], pa[8];
            const float* cur = Ff + (size_t)(m0 + t) * 144; const float* prv = (t > 0) ? cur - 144 : HF + (size_t)(c - 1) * 128;
#pragma unroll
            for (int j = 0; j < 8; ++j) { cw[j] = cur[q0 + j]; ca[j] = cur[64 + q0 + j]; }
            if (t > 0) {
#pragma unroll
                for (int j = 0; j < 8; ++j) { pw[j] = prv[q0 + j]; pa[j] = prv[64 + q0 + j]; }
            } else if (!first) {
#pragma unroll
                for (int j = 0; j < 8; ++j) { pw[j] = prv[q0 + j]; pa[j] = prv[64 + q0 + j]; }
            } else {
#pragma unroll
                for (int j = 0; j < 8; ++j) { pw[j] = 0.f; pa[j] = 0.f; }
            }
            float ow[8], oa[8];
#pragma unroll
            for (int j = 0; j < 8; ++j) { ow[j] = tanhf(cw[j] + (pw[j] - cw[j]) * mu_w[q0 + j]); oa[j] = ca[j] + (pa[j] - ca[j]) * mu_a[q0 + j]; }
            u32x4 o; o.x = pk2(ow[0], ow[1]); o.y = pk2(ow[2], ow[3]); o.z = pk2(ow[4], ow[5]); o.w = pk2(ow[6], ow[7]); *(LAS u32x4*)(TW + t * 72 + q0) = o;
            o.x = pk2(oa[0], oa[1]); o.y = pk2(oa[2], oa[3]); o.z = pk2(oa[4], oa[5]); o.w = pk2(oa[6], oa[7]); *(LAS u32x4*)(AL + t * 72 + q0) = o;
        }
        for (int h = 0; h < 8; ++h) {
            int tid = F.tid, lane = F.lane; asm volatile("" : "+v"(tid), "+v"(lane));
            {   LAS unsigned char* L = LB(); const int row = tid >> 3, c8 = tid & 7; const bf16_t* WLW = (const bf16_t*)(F.ws + WS_WLW); const bf16_t* WLA = (const bf16_t*)(F.ws + WS_WLA);
                *(LAS u32x4*)(S8 + row * 72 + c8 * 8) = *(const u32x4*)(WLW + (size_t)(h * 64 + row) * 64 + c8 * 8);
                *(LAS u32x4*)(S9 + row * 72 + c8 * 8) = *(const u32x4*)(WLA + (size_t)(h * 64 + row) * 64 + c8 * 8); }
            __syncthreads();
            { LAS unsigned char* L = LB(); const float* w0 = INP(I_W0) + l * 512; const float* a0 = INP(I_A0) + l * 512;
#pragma unroll
            for (int i = 0; i < 4; ++i) { const int idx = 4 * wave + i, which = idx >> 4, ti = (idx >> 2) & 3, ci = idx & 3;
                const f32x4 acc = mma_tile<64>((which ? AL : TW) + ti * 16 * 72, 72, (which ? S9 : S8) + ci * 16 * 72, 72, lane);
#pragma unroll
                for (int r = 0; r < 4; ++r) { const int t = ti * 16 + 4 * (lane >> 4) + r, ch = ci * 16 + (lane & 15);
                    if (which == 0) LWf[t * 65 + ch] = -DECAY_SCALE * sigmoidf_(acc[r] + w0[h * 64 + ch]); else ICf[t * 65 + ch] = sigmoidf_(acc[r] + a0[h * 64 + ch]); } } }
            __syncthreads();
            if (wave == 0) { LAS unsigned char* L = LB(); float run = 0.f;
#pragma unroll 8
                for (int t = 0; t < 64; ++t) { run += LWf[t * 65 + lane]; LWf[t * 65 + lane] = run; }
                WL[lane] = expf(run); }
            __syncthreads();
            float bonv[8]; const int t1 = tid >> 3, ch0 = (tid & 7) * 8, col1 = h * 64 + ch0;
            {   LAS unsigned char* L = LB(); const int t = t1;
                const bf16_t* Rg = (const bf16_t*)(F.ws + WS_R); const bf16_t* Kg = (const bf16_t*)(F.ws + WS_K); const bf16_t* Vg = (const bf16_t*)(F.ws + WS_V); const bf16_t* HR = (const bf16_t*)(F.ws + WS_HRKV);
                const float* mu_r = INP(I_MURKV) + (size_t)l * 1536; const float* mu_k = mu_r + 512; const float* mu_v = mu_r + 1024;
                const float* kkp = INP(I_KK) + l * 512; const float* kap = INP(I_KA) + l * 512; const float* rkp = INP(I_RK) + l * 512;
                const size_t off = (size_t)(m0 + t) * 512 + col1;
                const u32x4 rw = *(const u32x4*)(Rg + off), kw = *(const u32x4*)(Kg + off), vw = *(const u32x4*)(Vg + off);
                u32x4 rp = {0u, 0u, 0u, 0u}, kp = rp, vp = rp;
                if (t > 0) { rp = *(const u32x4*)(Rg + off - 512); kp = *(const u32x4*)(Kg + off - 512); vp = *(const u32x4*)(Vg + off - 512); }
                else if (!first) { const size_t ho = (size_t)(c - 1) * 512 + col1; rp = *(const u32x4*)(HR + ho); kp = *(const u32x4*)(HR + (size_t)NCHK * 512 + ho); vp = *(const u32x4*)(HR + (size_t)2 * NCHK * 512 + ho); }
                const unsigned rwa[4] = {rw.x, rw.y, rw.z, rw.w}, kwa[4] = {kw.x, kw.y, kw.z, kw.w}, vwa[4] = {vw.x, vw.y, vw.z, vw.w};
                const unsigned rpa[4] = {rp.x, rp.y, rp.z, rp.w}, kpa[4] = {kp.x, kp.y, kp.z, kp.w}, vpa[4] = {vp.x, vp.y, vp.z, vp.w};
                float rs[8], ks[8], vs[8], kkv[8], k2[8], ic[8]; float ss = 0.f, bs = 0.f;
#pragma unroll
                for (int j = 0; j < 8; ++j) { const int gch = col1 + j; const int q = j >> 1;
                    const float r_ = (j & 1) ? bfhi(rwa[q]) : bflo(rwa[q]), rq = (j & 1) ? bfhi(rpa[q]) : bflo(rpa[q]);
                    const float k_ = (j & 1) ? bfhi(kwa[q]) : bflo(kwa[q]), kq = (j & 1) ? bfhi(kpa[q]) : bflo(kpa[q]);
                    const float v_ = (j & 1) ? bfhi(vwa[q]) : bflo(vwa[q]), vq = (j & 1) ? bfhi(vpa[q]) : bflo(vpa[q]);
                    rs[j] = r_ + (rq - r_) * mu_r[gch]; ks[j] = k_ + (kq - k_) * mu_k[gch]; vs[j] = v_ + (vq - v_) * mu_v[gch];
                    ic[j] = ICf[t * 65 + ch0 + j];
                    kkv[j] = ks[j] * kkp[gch]; ss += kkv[j] * kkv[j];
                    k2[j] = ks[j] * (1.f + (ic[j] - 1.f) * kap[gch]); bs += rs[j] * k2[j] * rkp[gch]; }
                ss += __shfl_xor(ss, 1); ss += __shfl_xor(ss, 2); ss += __shfl_xor(ss, 4);
                bs += __shfl_xor(bs, 1); bs += __shfl_xor(bs, 2); bs += __shfl_xor(bs, 4);
                const float inv = 1.f / fmaxf(sqrtf(ss), 1e-12f);
                float vAT[8], vB[8], vK[8], vR[8], vBH[8], vKH[8];
#pragma unroll
                for (int j = 0; j < 8; ++j) { const int ch = ch0 + j;
                    const float LWt = LWf[t * 65 + ch], LWp = (t > 0) ? LWf[(t - 1) * 65 + ch] : 0.f, L63 = LWf[63 * 65 + ch];
                    const float kk = kkv[j] * inv, a = -kk, b = kk * ic[j];
                    const float e1 = expf(LWt), e2 = expf(-LWt), e3 = expf(LWp), e4 = expf(L63 - LWt);
                    vAT[j] = a * e3; vB[j] = b * e2; vK[j] = k2[j] * e2; vR[j] = rs[j] * e1; vBH[j] = b * e4; vKH[j] = k2[j] * e4; bonv[j] = bs * vs[j];
                    ATt[ch * 72 + t] = (bf16_t)f2bf(vAT[j]); BHt[ch * 72 + t] = (bf16_t)f2bf(vBH[j]); VT[ch * 72 + t] = (bf16_t)f2bf(vs[j]); }
                u32x4 o;
#define PK8(A_) (o[0] = pk2(A_[0], A_[1]), o[1] = pk2(A_[2], A_[3]), o[2] = pk2(A_[4], A_[5]), o[3] = pk2(A_[6], A_[7]), o)
                *(LAS u32x4*)(AT + t * 72 + ch0) = PK8(vAT); *(LAS u32x4*)(BTl + t * 72 + ch0) = PK8(vB); *(LAS u32x4*)(KTl + t * 72 + ch0) = PK8(vK);
                *(LAS u32x4*)(RT + t * 72 + ch0) = PK8(vR); *(LAS u32x4*)(KH + t * 72 + ch0) = PK8(vKH);
            }
            __syncthreads();
            { u32x4 o; *(u32x4*)((bf16_t*)(F.ws + WS_V) + (size_t)(m0 + t1) * 512 + col1) = PK8(bonv); }
            { LAS unsigned char* L = LB();
#pragma unroll
            for (int i = 0; i < 8; ++i) { const int p = wave >> 1, idx = 8 * (wave & 1) + i, ti = idx >> 2, si = idx & 3;
                const f32x4 acc = mma_tile<64>(((p < 2) ? AT : RT) + ti * 16 * 72, 72, ((p & 1) ? KTl : BTl) + si * 16 * 72, 72, lane);
#pragma unroll
                for (int r = 0; r < 4; ++r) { const int t = ti * 16 + 4 * (lane >> 4) + r, s = si * 16 + (lane & 15);
                    if (p == 0) MAB[t * 65 + s] = (s < t) ? acc[r] : 0.f;
                    else if (p == 1) MakT[s * 72 + t] = (bf16_t)f2bf((s < t) ? acc[r] : 0.f);
                    else if (p == 2) Rb[t * 72 + s] = (bf16_t)f2bf((s <= t) ? acc[r] : 0.f);
                    else Rk[t * 72 + s] = (bf16_t)f2bf((s <= t) ? acc[r] : 0.f); } } }
            __syncthreads();
            if (wave < 4 && lane < 16) { LAS unsigned char* L = LB(); const int b0 = 16 * wave; float x[16];
#pragma unroll
                for (int t = 0; t < 16; ++t) { float v = (t == lane) ? 1.f : 0.f;
#pragma unroll
                    for (int s = 0; s < 16; ++s) if (s < t) v += MAB[(b0 + t) * 65 + b0 + s] * x[s];
                    x[t] = v; }
#pragma unroll
                for (int t = 0; t < 16; ++t) MAB[(b0 + t) * 65 + b0 + lane] = x[t]; }
            __syncthreads();
            {   LAS unsigned char* L = LB(); const int pr = tid >> 8, e = tid & 255, rr = e >> 4, cc = e & 15, rb = pr ? 48 : 16, cb = pr ? 32 : 0; float v = 0.f;
#pragma unroll
                for (int s = 0; s < 16; ++s) v += MAB[(rb + rr) * 65 + cb + s] * MAB[(cb + s) * 65 + cb + cc];
                SCR[(pr * 16 + rr) * 33 + cc] = v; }
            __syncthreads();
            {   LAS unsigned char* L = LB(); const int pr = tid >> 8, e = tid & 255, rr = e >> 4, cc = e & 15, rb = pr ? 48 : 16, cb = pr ? 32 : 0; float v = 0.f;
#pragma unroll
                for (int s = 0; s < 16; ++s) v += MAB[(rb + rr) * 65 + rb + s] * SCR[(pr * 16 + s) * 33 + cc];
                MAB[(rb + rr) * 65 + cb + cc] = v; }
            __syncthreads();
            {   LAS unsigned char* L = LB(); float v2[2];
#pragma unroll
                for (int i = 0; i < 2; ++i) { const int e = tid * 2 + i, rr = e >> 5, cc = e & 31; float v = 0.f;
#pragma unroll 8
                    for (int s = 0; s < 32; ++s) v += MAB[(32 + rr) * 65 + s] * MAB[s * 65 + cc];
                    v2[i] = v; }
                SCR[((tid * 2) >> 5) * 33 + ((tid * 2) & 31)] = v2[0]; SCR[((tid * 2 + 1) >> 5) * 33 + ((tid * 2 + 1) & 31)] = v2[1]; }
            __syncthreads();
            {   LAS unsigned char* L = LB();
#pragma unroll
                for (int i = 0; i < 2; ++i) { const int e = tid * 2 + i, rr = e >> 5, cc = e & 31; float v = 0.f;
#pragma unroll 8
                    for (int s = 0; s < 32; ++s) v += MAB[(32 + rr) * 65 + 32 + s] * SCR[s * 33 + cc];
                    MAB[(32 + rr) * 65 + cc] = v; } }
            __syncthreads();
            {   LAS unsigned char* L = LB(); const int t = tid >> 3, s0 = (tid & 7) * 8; float x[8];
#pragma unroll
                for (int j = 0; j < 8; ++j) x[j] = MAB[t * 65 + s0 + j];
                u32x4 o; *(LAS u32x4*)(MI + t * 72 + s0) = PK8(x); }
            __syncthreads();
            { LAS unsigned char* L = LB();
#pragma unroll
            for (int i = 0; i < 4; ++i) { const int idx = 4 * wave + i, which = idx >> 4, ti = (idx >> 2) & 3, ci = idx & 3;
                const f32x4 acc = mma_tile<64>(MI + ti * 16 * 72, 72, (which ? MakT : ATt) + ci * 16 * 72, 72, lane);
#pragma unroll
                for (int r = 0; r < 4; ++r) { const int t = ti * 16 + 4 * (lane >> 4) + r, j = ci * 16 + (lane & 15); (which ? X2t : X1t)[j * 72 + t] = (bf16_t)f2bf(acc[r]); } } }
            __syncthreads();
            { LAS unsigned char* L = LB();
            bf16_t* QEw = (bf16_t*)(F.ws + WS_QE) + (size_t)(c * 8 + h) * 4096; bf16_t* TTw = (bf16_t*)(F.ws + WS_TT) + (size_t)(c * 8 + h) * 4096;
#pragma unroll
            for (int i = 0; i < 8; ++i) { const int p = wave >> 1, idx = 8 * (wave & 1) + i, ti = idx >> 2, si = idx & 3;
                const f32x4 acc = mma_tile<64>(((p == 0 || p == 1) ? Rb : (p == 2) ? X1t : X2t) + ti * 16 * 72, 72, ((p == 0) ? X1t : (p == 1) ? X2t : BHt) + si * 16 * 72, 72, lane);
#pragma unroll
                for (int r = 0; r < 4; ++r) { const int rw = ti * 16 + 4 * (lane >> 4) + r, cl = si * 16 + (lane & 15);
                    if (p == 0) QEw[rw * 64 + pi16(cl)] = (bf16_t)f2bf(acc[r] + bf2f(RT[rw * 72 + cl]));
                    else if (p == 1) Attn[rw * 72 + cl] = (bf16_t)f2bf(acc[r] + bf2f(Rk[rw * 72 + cl]));
                    else if (p == 2) TTw[cl * 64 + pi16(rw)] = (bf16_t)f2bf(acc[r] + ((rw == cl) ? WL[rw] : 0.f));
                    else KEt[cl * 72 + rw] = (bf16_t)f2bf(acc[r] + bf2f(KH[rw * 72 + cl])); } } }
            __syncthreads();
            bf16_t* Rg = (bf16_t*)(F.ws + WS_R); bf16_t* Kg = (bf16_t*)(F.ws + WS_K); LAS unsigned char* L = LB();
#pragma unroll
            for (int i = 0; i < 4; ++i) { const int idx = 4 * wave + i, which = idx >> 4, ti = (idx >> 2) & 3, ci = idx & 3;
                const f32x4 acc = mma_tile<64>((which ? VT : Attn) + ti * 16 * 72, 72, (which ? KEt : VT) + ci * 16 * 72, 72, lane);
#pragma unroll
                for (int r = 0; r < 4; ++r) { const int rw = ti * 16 + 4 * (lane >> 4) + r, cl = ci * 16 + (lane & 15);
                    if (which == 0) Kg[(size_t)(m0 + cl) * 512 + h * 64 + sg32(rw)] = (bf16_t)f2bf(acc[r]);
                    else Rg[(size_t)(m0 + rw) * 512 + h * 64 + sg32(cl)] = (bf16_t)f2bf(acc[r]); } }
        }
        __syncthreads();
    }
#undef SLOT
#undef PK8
#undef LB
#undef TW
#undef AL
#undef AT
#undef ATt
#undef BTl
#undef KTl
#undef RT
#undef BHt
#undef KH
#undef VT
#undef MI
#undef MakT
#undef Rb
#undef Rk
#undef Attn
#undef KEt
#undef X1t
#undef X2t
#undef S8
#undef S9
#undef MAB
#undef LWf
#undef ICf
#undef WL
#undef SCR
}

__device__ __forceinline__ bf16x8 cvt8(const f32x16& x, int s) {
    u32x4 w; w.x = pk2(x[8 * s + 0], x[8 * s + 1]); w.y = pk2(x[8 * s + 2], x[8 * s + 3]); w.z = pk2(x[8 * s + 4], x[8 * s + 5]); w.w = pk2(x[8 * s + 6], x[8 * s + 7]);
    return __builtin_bit_cast(bf16x8, w);
}
__device__ __forceinline__ f32x16 ld16bf(const bf16_t* p) {
    const u32x4 a = *(const u32x4*)p, b = *(const u32x4*)(p + 8); f32x16 r;
    r[0] = bflo(a.x); r[1] = bfhi(a.x); r[2] = bflo(a.y); r[3] = bfhi(a.y); r[4] = bflo(a.z); r[5] = bfhi(a.z); r[6] = bflo(a.w); r[7] = bfhi(a.w);
    r[8] = bflo(b.x); r[9] = bfhi(b.x); r[10] = bflo(b.y); r[11] = bfhi(b.y); r[12] = bflo(b.z); r[13] = bfhi(b.z); r[14] = bflo(b.w); r[15] = bfhi(b.w); return r;
}
__device__ __forceinline__ void st16bf(bf16_t* p, const f32x16& x) {
    u32x4 a, b; a.x = pk2(x[0], x[1]); a.y = pk2(x[2], x[3]); a.z = pk2(x[4], x[5]); a.w = pk2(x[6], x[7]); b.x = pk2(x[8], x[9]); b.y = pk2(x[10], x[11]); b.z = pk2(x[12], x[13]); b.w = pk2(x[14], x[15]);
    *(u32x4*)p = a; *(u32x4*)(p + 8) = b;
}
__device__ __forceinline__ float max3f(float a, float b, float c) { float r; asm("v_max3_f32 %0, %1, %2, %3" : "=v"(r) : "v"(a), "v"(b), "v"(c)); return r; }
constexpr int KROW = 400;
constexpr int KTILE = 64 * KROW;
template <int VAR> __device__ __forceinline__ void attn_unit(const Ctx& F, int b, int c, int hp) {
    const int tid = F.tid, lane = F.lane, wave = F.wave, r32 = lane & 31, hi = lane >> 5, grp = wave >> 2, wq = wave & 3, head = 2 * hp + (wq >> 1);
    const bf16_t* Q = (const bf16_t*)(F.ws + WS_Q); const bf16_t* KV = (const bf16_t*)(F.ws + WS_KVB) + (size_t)b * SEQ * 192; bf16_t* OL = (bf16_t*)(F.ws + WS_OL);
    const size_t mq = (size_t)b * SEQ + 64 * c + 32 * (wq & 1) + r32;
    bf16x8 qr[12];
#pragma unroll
    for (int d0 = 0; d0 < 12; ++d0) qr[d0] = *(const bf16x8*)(Q + mq * 768 + head * 192 + 16 * d0 + 8 * hi);
    {
        const float* rp = (const float*)(F.ws + WS_ROPE) + mq * 64;
#pragma unroll
        for (int d0 = 8; d0 < 10; ++d0) { const int j0 = 16 * (d0 - 8) + 8 * hi;
            const f32x4 c0 = *(const f32x4*)(rp + j0), c1 = *(const f32x4*)(rp + j0 + 4), s0 = *(const f32x4*)(rp + 32 + j0), s1 = *(const f32x4*)(rp + 32 + j0 + 4);
            const u32x4 a = __builtin_bit_cast(u32x4, qr[d0]), bq = __builtin_bit_cast(u32x4, qr[d0 + 2]);
            const float x1[8] = {bflo(a.x), bfhi(a.x), bflo(a.y), bfhi(a.y), bflo(a.z), bfhi(a.z), bflo(a.w), bfhi(a.w)}, x2[8] = {bflo(bq.x), bfhi(bq.x), bflo(bq.y), bfhi(bq.y), bflo(bq.z), bfhi(bq.z), bflo(bq.w), bfhi(bq.w)};
            const float cs[8] = {c0[0], c0[1], c0[2], c0[3], c1[0], c1[1], c1[2], c1[3]}, sn[8] = {s0[0], s0[1], s0[2], s0[3], s1[0], s1[1], s1[2], s1[3]};
            float o1[8], o2[8];
#pragma unroll
            for (int e = 0; e < 8; ++e) { o1[e] = x1[e] * cs[e] - x2[e] * sn[e]; o2[e] = x1[e] * sn[e] + x2[e] * cs[e]; }
            u32x4 w1, w2; w1.x = pk2(o1[0], o1[1]); w1.y = pk2(o1[2], o1[3]); w1.z = pk2(o1[4], o1[5]); w1.w = pk2(o1[6], o1[7]); w2.x = pk2(o2[0], o2[1]); w2.y = pk2(o2[2], o2[3]); w2.z = pk2(o2[4], o2[5]); w2.w = pk2(o2[6], o2[7]);
            qr[d0] = __builtin_bit_cast(bf16x8, w1); qr[d0 + 2] = __builtin_bit_cast(bf16x8, w2); }
    }
    int poff[3]; int goff[3];
#pragma unroll
    for (int i = 0; i < 3; ++i) { const int idx = tid + 512 * i, row = idx / 24, col = idx % 24; poff[i] = row * KROW + col * 16; goff[i] = row * 192 + col * 8; }
    const int nt = c + 1, ns = (nt + 1) >> 1;
    u32x4 st[6];
#pragma unroll
    for (int i = 0; i < 3; ++i) st[i] = *(const u32x4*)(KV + goff[i]);
    if (nt > 1) {
#pragma unroll
        for (int i = 0; i < 3; ++i) st[3 + i] = *(const u32x4*)(KV + (size_t)64 * 192 + goff[i]);
    }
#pragma unroll
    for (int i = 0; i < 3; ++i) { *(LAS u32x4*)(F.lds + poff[i]) = st[i]; if (nt > 1) *(LAS u32x4*)(F.lds + KTILE + poff[i]) = st[3 + i]; }
    __syncthreads();
    f32x16 o[4];
#pragma unroll
    for (int d = 0; d < 4; ++d)
#pragma unroll
        for (int r = 0; r < 16; ++r) o[d][r] = 0.f;
    float mrun = -1e30f, lrun = 0.f;
    const int troff = (4 * hi + ((lane & 15) >> 2)) * KROW + (((lane >> 4) & 1) * 16 + (lane & 3) * 4) * 2;
    const int koff = r32 * KROW + hi * 16;
    for (int s = 0; s < ns; ++s) {
        const bool more = (s + 1 < ns), more2 = (2 * s + 3 < nt);
        if (more && !(VAR & 1)) {
#pragma unroll
            for (int i = 0; i < 3; ++i) st[i] = *(const u32x4*)(KV + (size_t)(2 * s + 2) * 64 * 192 + goff[i]);
            if (more2) {
#pragma unroll
                for (int i = 0; i < 3; ++i) st[3 + i] = *(const u32x4*)(KV + (size_t)(2 * s + 3) * 64 * 192 + goff[i]);
            }
        }
        if (2 * s + grp < nt) {
            const LAS unsigned char* buf = F.lds + ((s & 1) * 2 + grp) * KTILE;
            f32x16 p0, p1;
#pragma unroll
            for (int r = 0; r < 16; ++r) { p0[r] = 0.f; p1[r] = 0.f; }
            bf16x8 ka[3][2];
#pragma unroll
            for (int d0 = 0; d0 < 2; ++d0) { ka[d0][0] = *(const LAS bf16x8*)(buf + koff + d0 * 32); ka[d0][1] = *(const LAS bf16x8*)(buf + koff + 32 * KROW + d0 * 32); }
#pragma unroll
            for (int d0 = 0; d0 < 12; ++d0) {
                if (d0 + 2 < 12) { ka[(d0 + 2) % 3][0] = *(const LAS bf16x8*)(buf + koff + (d0 + 2) * 32); ka[(d0 + 2) % 3][1] = *(const LAS bf16x8*)(buf + koff + 32 * KROW + (d0 + 2) * 32); }
                if (!(VAR & 4)) { p0 = __builtin_amdgcn_mfma_f32_32x32x16_bf16(ka[d0 % 3][0], qr[d0], p0, 0, 0, 0); p1 = __builtin_amdgcn_mfma_f32_32x32x16_bf16(ka[d0 % 3][1], qr[d0], p1, 0, 0, 0); } else { asm volatile("" :: "v"(ka[d0 % 3][0]), "v"(ka[d0 % 3][1])); }
            }
            v4i16_t vl[2][4], vh[2][4];
#pragma unroll
            for (int db = 0; db < 4; ++db) { const LAS unsigned char* vp = buf + troff + db * 64; vl[0][db] = __builtin_amdgcn_ds_read_tr16_b64_v4i16((LAS v4i16_t*)vp); vh[0][db] = __builtin_amdgcn_ds_read_tr16_b64_v4i16((LAS v4i16_t*)(vp + 8 * KROW)); }
            float mx = max3f(p0[0], p1[0], p0[1]), my = max3f(p1[1], p0[2], p1[2]);
#pragma unroll
            for (int r = 3; r < 15; r += 2) { mx = max3f(mx, p0[r], p1[r]); my = max3f(my, p0[r + 1], p1[r + 1]); }
            mx = max3f(mx, my, fmaxf(p0[15], p1[15]));
            mx = fmaxf(mx, __shfl_xor(mx, 32));
            if (!(VAR & 8) && __any(mx > mrun + 8.f)) {
                const float mnew = fmaxf(mrun, mx), alpha = __builtin_amdgcn_exp2f(mrun - mnew); mrun = mnew; lrun *= alpha;
#pragma unroll
                for (int d = 0; d < 4; ++d)
#pragma unroll
                    for (int r = 0; r < 16; ++r) o[d][r] *= alpha;
            }
            float ls = 0.f;
#pragma unroll
            for (int r = 0; r < 16; ++r) { if (!(VAR & 8)) { p0[r] = __builtin_amdgcn_exp2f(p0[r] - mrun); p1[r] = __builtin_amdgcn_exp2f(p1[r] - mrun); } ls += p0[r] + p1[r]; }
            lrun += ls;
#pragma unroll
            for (int ks = 0; ks < 4; ++ks) {
                if (ks + 1 < 4) {
#pragma unroll
                    for (int db = 0; db < 4; ++db) { const LAS unsigned char* vp = buf + troff + (16 * (ks + 1)) * KROW + db * 64;
                        vl[(ks + 1) & 1][db] = __builtin_amdgcn_ds_read_tr16_b64_v4i16((LAS v4i16_t*)vp); vh[(ks + 1) & 1][db] = __builtin_amdgcn_ds_read_tr16_b64_v4i16((LAS v4i16_t*)(vp + 8 * KROW)); }
                }
                const bf16x8 pb = (ks < 2) ? cvt8(p0, ks & 1) : cvt8(p1, ks & 1);
#pragma unroll
                for (int db = 0; db < 4; ++db) { const v4i16_t lo = vl[ks & 1][db], hh = vh[ks & 1][db];
                    const bf16x8 va = {lo[0], lo[1], lo[2], lo[3], hh[0], hh[1], hh[2], hh[3]};
                    if (!(VAR & 2)) o[db] = __builtin_amdgcn_mfma_f32_32x32x16_bf16(va, pb, o[db], 0, 0, 0); else asm volatile("" :: "v"(va), "v"(pb)); }
            }
        }
        if (more && !(VAR & 1)) {
            LAS unsigned char* nb = F.lds + (((s + 1) & 1) * 2) * KTILE;
#pragma unroll
            for (int i = 0; i < 3; ++i) { *(LAS u32x4*)(nb + poff[i]) = st[i]; if (more2) *(LAS u32x4*)(nb + KTILE + poff[i]) = st[3 + i]; }
        }
        __syncthreads();
    }
    lrun += __shfl_xor(lrun, 32);
    LAS float* xb = (LAS float*)(F.lds + wq * (66 * 64 * 4));
    if (grp == 1) {
#pragma unroll
        for (int d = 0; d < 4; ++d)
#pragma unroll
            for (int r = 0; r < 16; ++r) xb[(d * 16 + r) * 64 + lane] = o[d][r];
        xb[64 * 64 + lane] = mrun; xb[65 * 64 + lane] = lrun;
    }
    __syncthreads();
    if (grp == 0) {
        const float m2 = xb[64 * 64 + lane], l2 = xb[65 * 64 + lane];
        const float mm = fmaxf(mrun, m2), a1 = __builtin_amdgcn_exp2f(mrun - mm), a2 = __builtin_amdgcn_exp2f(m2 - mm);
        const float inv = 1.f / (lrun * a1 + l2 * a2), f1 = a1 * inv, f2 = a2 * inv;
#pragma unroll
        for (int db = 0; db < 4; ++db)
#pragma unroll
            for (int g = 0; g < 4; ++g) { float v[4];
#pragma unroll
                for (int e = 0; e < 4; ++e) v[e] = o[db][4 * g + e] * f1 + xb[(db * 16 + 4 * g + e) * 64 + lane] * f2;
                u32x2 w; w.x = pk2(v[0], v[1]); w.y = pk2(v[2], v[3]);
                *(u32x2*)(OL + mq * 512 + head * 128 + 32 * db + 8 * g + 4 * hi) = w; }
    }
    __syncthreads();
}
struct RwSet { bf16x8 ta[2][4]; u32x4 d[4]; };
__device__ __forceinline__ void rw_load(RwSet& s, const bf16_t* TTg, const bf16_t* Rg, int cg_, int h, int i, int r32, int hi) {
    const bf16_t* TTw = TTg + (size_t)(cg_ * 8 + h) * 4096; const bf16_t* Dw = Rg + ((size_t)64 * cg_ + i) * 512 + h * 64;
#pragma unroll
    for (int a = 0; a < 2; ++a)
#pragma unroll
        for (int s2 = 0; s2 < 4; ++s2) s.ta[a][s2] = *(const bf16x8*)(TTw + (32 * a + r32) * 64 + 16 * s2 + 8 * hi);
    s.d[0] = *(const u32x4*)(Dw + 16 * hi); s.d[1] = *(const u32x4*)(Dw + 16 * hi + 8); s.d[2] = *(const u32x4*)(Dw + 32 + 16 * hi); s.d[3] = *(const u32x4*)(Dw + 32 + 16 * hi + 8);
}
__device__ __forceinline__ f32x16 up16(const u32x4 a, const u32x4 b) { f32x16 r;
    r[0] = bflo(a.x); r[1] = bfhi(a.x); r[2] = bflo(a.y); r[3] = bfhi(a.y); r[4] = bflo(a.z); r[5] = bfhi(a.z); r[6] = bflo(a.w); r[7] = bfhi(a.w);
    r[8] = bflo(b.x); r[9] = bfhi(b.x); r[10] = bflo(b.y); r[11] = bfhi(b.y); r[12] = bflo(b.z); r[13] = bfhi(b.z); r[14] = bflo(b.w); r[15] = bfhi(b.w); return r; }
__device__ __forceinline__ void rw_step(f32x16& X0, f32x16& X1, const RwSet& s, bf16_t* Rg, int cg_, int h, int i, int hi, bool live) {
    const bf16x8 bf[4] = {cvt8(X0, 0), cvt8(X0, 1), cvt8(X1, 0), cvt8(X1, 1)};
    if (live) { bf16_t* Dw = Rg + ((size_t)64 * cg_ + i) * 512 + h * 64;
        *(bf16x8*)(Dw + 16 * hi) = bf[0]; *(bf16x8*)(Dw + 16 * hi + 8) = bf[1]; *(bf16x8*)(Dw + 32 + 16 * hi) = bf[2]; *(bf16x8*)(Dw + 32 + 16 * hi + 8) = bf[3]; }
    f32x16 n0 = up16(s.d[0], s.d[1]), n1 = up16(s.d[2], s.d[3]);
#pragma unroll
    for (int s2 = 0; s2 < 4; ++s2) { n0 = __builtin_amdgcn_mfma_f32_32x32x16_bf16(s.ta[0][s2], bf[s2], n0, 0, 0, 0); n1 = __builtin_amdgcn_mfma_f32_32x32x16_bf16(s.ta[1][s2], bf[s2], n1, 0, 0, 0); }
    X0 = n0; X1 = n1;
}
__device__ __forceinline__ void rwkv_scan(const Ctx& F, int b, int h, int half) {
    const int lane = F.lane, r32 = lane & 31, hi = lane >> 5, i = 32 * half + r32;
    const bf16_t* TTg = (const bf16_t*)(F.ws + WS_TT); bf16_t* Rg = (bf16_t*)(F.ws + WS_R);
    f32x16 X0, X1;
#pragma unroll
    for (int r = 0; r < 16; ++r) { X0[r] = 0.f; X1[r] = 0.f; }
    RwSet sA, sB, sC; const int c0 = b * 128;
    rw_load(sA, TTg, Rg, c0 + 0, h, i, r32, hi); rw_load(sB, TTg, Rg, c0 + 1, h, i, r32, hi); rw_load(sC, TTg, Rg, c0 + 2, h, i, r32, hi);
    for (int c = 0; c < 129; c += 3) {
        rw_step(X0, X1, sA, Rg, c0 + c, h, i, hi, true);          rw_load(sA, TTg, Rg, c0 + min(c + 3, 127), h, i, r32, hi);
        rw_step(X0, X1, sB, Rg, c0 + c + 1, h, i, hi, true);      rw_load(sB, TTg, Rg, c0 + min(c + 4, 127), h, i, r32, hi);
        rw_step(X0, X1, sC, Rg, c0 + min(c + 2, 127), h, i, hi, c + 2 < 128); rw_load(sC, TTg, Rg, c0 + min(c + 5, 127), h, i, r32, hi);
    }
}
__device__ __forceinline__ void ssd_scan(const Ctx& F, int item) {
    const int b = item >> 4, h = (item >> 1) & 7, hp = item & 1, g = h >> 2, hl = h & 3;
    const int piece = hp * 512 + F.tid;
    const int f = hl * 8192 + piece * 8, row = f >> 9, col = ssd_win_col(g, f & 511);
    bf16_t* ST = (bf16_t*)(F.ws + WS_XBC); const float* CDEC = (const float*)(F.ws + WS_CDEC);
    float st[8];
#pragma unroll
    for (int j = 0; j < 8; ++j) st[j] = 0.f;
    for (int c8 = 0; c8 < 128; c8 += 8) {
        u32x4 v[8]; float cd[8];
#pragma unroll
        for (int u = 0; u < 8; ++u) { const int cg_ = b * 128 + c8 + u; v[u] = *(const u32x4*)(ST + ((size_t)64 * cg_ + row) * 1024 + col); cd[u] = CDEC[cg_ * 8 + h]; }
#pragma unroll
        for (int u = 0; u < 8; ++u) { const int cg_ = b * 128 + c8 + u;
            u32x4 o; o.x = pk2(st[0], st[1]); o.y = pk2(st[2], st[3]); o.z = pk2(st[4], st[5]); o.w = pk2(st[6], st[7]);
            *(u32x4*)(ST + ((size_t)64 * cg_ + row) * 1024 + col) = o;
            const float x[8] = {bflo(v[u].x), bfhi(v[u].x), bflo(v[u].y), bfhi(v[u].y), bflo(v[u].z), bfhi(v[u].z), bflo(v[u].w), bfhi(v[u].w)};
#pragma unroll
            for (int j = 0; j < 8; ++j) st[j] = st[j] * cd[u] + x[j]; }
    }
}
template <int VAR = 0> __device__ __forceinline__ void p4_mix(const Ctx& F, int what = 3) {
    if (what & 2) {
        if (F.bid < 32) { if (!(what & 8) && F.wave == 0) rwkv_scan(F, F.bid >> 4, (F.bid >> 1) & 7, F.bid & 1); }
        else if (F.bid < 64) { if (!(what & 4)) ssd_scan(F, F.bid - 32); }
        __syncthreads();
    }
    if (what & 1) {
        const int x = F.bid & 7, u = (x >> 1) * 32 + (F.bid >> 3), b = x & 1, hp = u >> 6, c = u & 63;
        attn_unit<VAR>(F, b, 127 - c, hp); attn_unit<VAR>(F, b, c, hp);
    }
}
__device__ __forceinline__ void p5_assemble(const Ctx& F, int l) {
    bf16_t* GT = (bf16_t*)(F.ws + WS_GATES);
    {   pg8::Gemm g{(const bf16_t*)(F.ws + WS_OL), (const bf16_t*)(F.ws + WS_WUV), NT, 512, 512, 512, 512}; pg8::StaticOrder S; S.init(NT, 512, F.G, F.bid); EpiUV E{GT};
        pg8::gemm_phase<EpiUV, pg8::StaticOrder, true, true>(F.lds, F.wave, g, S, E); }
    __syncthreads();
    int lane = fresh_lane(); const int tid = F.wave * 64 + lane, wave = F.wave;
    const int gw = F.bid * NWAVES + F.wave, NGW = F.G * NWAVES;
    {   constexpr int O_CG = 0, O_PV = 17408, O_YL = 34816;
        const bf16_t* Cbuf = (const bf16_t*)(F.ws + WS_CB); const float* ECUM = (const float*)(F.ws + WS_ECUM); const bf16_t* ST = (const bf16_t*)(F.ws + WS_XBC); const bf16_t* YD = (const bf16_t*)(F.ws + WS_YD);
        const float* snw = INP(I_SSDNW) + l * 512;
        for (int c = F.bid; c < NCHK; c += F.G) {
            const size_t m0 = (size_t)64 * c;
            for (int g = 0; g < 2; ++g) {
                {   LAS bf16_t* Cg = (LAS bf16_t*)(F.lds + O_CG);
#pragma unroll
                    for (int i = 0; i < 2; ++i) { const int idx = tid + 512 * i, t = idx >> 4, c8 = idx & 15; *(LAS u32x4*)(Cg + t * 136 + c8 * 8) = *(const u32x4*)(Cbuf + (m0 + t) * 256 + g * 128 + c8 * 8); } }
                for (int hl = 0; hl < 4; ++hl) { const int h = 4 * g + hl;
                    {   LAS bf16_t* Pv = (LAS bf16_t*)(F.lds + O_PV);
#pragma unroll
                        for (int i = 0; i < 2; ++i) { const int idx = tid + 512 * i, pp = idx >> 4, c8 = idx & 15; const int f = hl * 8192 + pp * 128 + c8 * 8, row = f >> 9, col = ssd_win_col(g, f & 511);
                            *(LAS u32x4*)(Pv + pp * 136 + c8 * 8) = *(const u32x4*)(ST + (m0 + row) * 1024 + col); } }
                    __syncthreads();
                    {   LAS bf16_t* Cg = (LAS bf16_t*)(F.lds + O_CG); LAS bf16_t* Pv = (LAS bf16_t*)(F.lds + O_PV); LAS bf16_t* YL = (LAS bf16_t*)(F.lds + O_YL);
#pragma unroll
                        for (int i = 0; i < 2; ++i) { const int idx = 2 * wave + i, ti = idx >> 2, pi = idx & 3;
                            const f32x4 acc = mma_tile<128>(Cg + ti * 16 * 136, 136, Pv + pi * 16 * 136, 136, lane);
#pragma unroll
                            for (int r = 0; r < 4; ++r) { const int t = ti * 16 + 4 * (lane >> 4) + r, pp = pi * 16 + (lane & 15);
                                const float y = bf2f(YD[(m0 + t) * 512 + 64 * h + pp]) + acc[r] * ECUM[(size_t)(c * 8 + h) * 64 + t];
                                const float z = bf2f(GT[(m0 + t) * 1536 + 512 + 64 * h + pp]);
                                YL[t * 520 + 64 * h + pp] = (bf16_t)f2bf(y * siluf_(z)); } } }
                    __syncthreads();
                }
            }
            {   LAS bf16_t* YL = (LAS bf16_t*)(F.lds + O_YL);
#pragma unroll
                for (int rr = 0; rr < 8; ++rr) { const int t = 8 * wave + rr; const u32x4 w = *(const LAS u32x4*)(YL + t * 520 + 8 * lane);
                    const float v[8] = {bflo(w.x), bfhi(w.x), bflo(w.y), bfhi(w.y), bflo(w.z), bfhi(w.z), bflo(w.w), bfhi(w.w)};
                    float q = 0.f;
#pragma unroll
                    for (int j = 0; j < 8; ++j) q += v[j] * v[j];
                    const float rs = 1.f / sqrtf(wave_sum(q) * (1.f / 512.f) + EPS);
                    const f32x4 w0 = *(const f32x4*)(snw + 8 * lane), w1 = *(const f32x4*)(snw + 8 * lane + 4);
                    u32x4 o; o.x = pk2(v[0] * rs * w0[0], v[1] * rs * w0[1]); o.y = pk2(v[2] * rs * w0[2], v[3] * rs * w0[3]); o.z = pk2(v[4] * rs * w1[0], v[5] * rs * w1[1]); o.w = pk2(v[6] * rs * w1[2], v[7] * rs * w1[3]);
                    *(u32x4*)(GT + (m0 + t) * 1536 + 512 + 8 * lane) = o; } }
            __syncthreads();
        }
    }
    LAS float* SW = (LAS float*)(F.lds + F.wave * 16640);
    const bf16_t* Yt = (const bf16_t*)(F.ws + WS_K); const bf16_t* SF = (const bf16_t*)(F.ws + WS_R); const bf16_t* QEg = (const bf16_t*)(F.ws + WS_QE);
    const bf16_t* BON = (const bf16_t*)(F.ws + WS_V); const float* lw = INP(I_LNXW) + l * 512; const float* lb = INP(I_LNXB) + l * 512;
    for (int w = gw; w < NCHK * 8; w += NGW) {
        asm volatile("" : "+v"(lane));
        const int cg_ = w >> 3, h = w & 7, r32 = lane & 31, hi = lane >> 5; const size_t m0 = (size_t)64 * cg_;
        const bf16_t* QEw = QEg + (size_t)(cg_ * 8 + h) * 4096;
        bf16x8 qa[2][4];
#pragma unroll
        for (int tb = 0; tb < 2; ++tb)
#pragma unroll
            for (int s2 = 0; s2 < 4; ++s2) qa[tb][s2] = *(const bf16x8*)(QEw + (32 * tb + r32) * 64 + 16 * s2 + 8 * hi);
#pragma unroll
        for (int ih = 0; ih < 2; ++ih) { const size_t ro = (m0 + 32 * ih + r32) * 512 + h * 64;
            const bf16x8 bf[4] = {*(const bf16x8*)(SF + ro + 16 * hi), *(const bf16x8*)(SF + ro + 16 * hi + 8), *(const bf16x8*)(SF + ro + 32 + 16 * hi), *(const bf16x8*)(SF + ro + 32 + 16 * hi + 8)};
#pragma unroll
            for (int tb = 0; tb < 2; ++tb) { f32x16 y = ld16bf(Yt + ro + 32 * tb + 16 * hi);
#pragma unroll
                for (int s2 = 0; s2 < 4; ++s2) y = __builtin_amdgcn_mfma_f32_32x32x16_bf16(qa[tb][s2], bf[s2], y, 0, 0, 0);
#pragma unroll
                for (int r = 0; r < 16; ++r) SW[(32 * tb + crow(r, hi)) * 65 + 32 * ih + r32] = y[r]; } }
        LDS_WAIT();
        {   float y[64]; float sm = 0.f;
#pragma unroll
            for (int i = 0; i < 64; ++i) { y[i] = SW[lane * 65 + i]; sm += y[i]; }
            const float mean = sm * (1.f / 64.f); float q = 0.f;
#pragma unroll
            for (int i = 0; i < 64; ++i) { y[i] -= mean; q += y[i] * y[i]; }
            const float rs = 1.f / sqrtf(q * (1.f / 64.f) + GN_EPS);
#pragma unroll
            for (int i = 0; i < 64; ++i) SW[lane * 65 + i] = y[i] * rs; }
        LDS_WAIT();
#pragma unroll
        for (int it = 0; it < 8; ++it) { const int t = it * 8 + (lane >> 3), i0 = (lane & 7) * 8; const size_t row = m0 + t;
            const u32x4 bw = *(const u32x4*)(BON + row * 512 + h * 64 + i0); u32x4* gp = (u32x4*)(GT + row * 1536 + 1024 + h * 64 + i0); const u32x4 gv = *gp;
            const float bo[8] = {bflo(bw.x), bfhi(bw.x), bflo(bw.y), bfhi(bw.y), bflo(bw.z), bfhi(bw.z), bflo(bw.w), bfhi(bw.w)};
            const float gg[8] = {bflo(gv.x), bfhi(gv.x), bflo(gv.y), bfhi(gv.y), bflo(gv.z), bfhi(gv.z), bflo(gv.w), bfhi(gv.w)};
            float ov[8];
#pragma unroll
            for (int j = 0; j < 8; ++j) ov[j] = (SW[t * 65 + i0 + j] * lw[h * 64 + i0 + j] + lb[h * 64 + i0 + j] + bo[j]) * siluf_(gg[j]);
            u32x4 o; o.x = pk2(ov[0], ov[1]); o.y = pk2(ov[2], ov[3]); o.z = pk2(ov[4], ov[5]); o.w = pk2(ov[6], ov[7]); *gp = o; }
        LDS_WAIT();
    }
}
__device__ __forceinline__ void p7_final(const Ctx& F) {
    const int gw = F.bid * NWAVES + F.wave, NGW = F.G * NWAVES; const float* fw = INP(I_FNW);
    for (int m = gw; m < NT; m += NGW) {
        f32x4* xr = (f32x4*)(F.out + (size_t)m * DM) + F.lane; f32x4 v[4]; float s = 0.f;
#pragma unroll
        for (int j = 0; j < 4; ++j) { v[j] = xr[64 * j]; s += v[j].x * v[j].x + v[j].y * v[j].y + v[j].z * v[j].z + v[j].w * v[j].w; }
        const float rstd = 1.f / sqrtf(wave_sum(s) * (1.f / DM) + EPS);
#pragma unroll
        for (int j = 0; j < 4; ++j) xr[64 * j] = v[j] * rstd * *(const f32x4*)(fw + 4 * F.lane + 256 * j);
    }
}

#define RLX_AGENT __ATOMIC_RELAXED, __HIP_MEMORY_SCOPE_AGENT
#define XB_TMO      128
#define XB_XCNT(j)  (256  + 64 * (j))
#define XB_XSUB(j)  (1280 + 64 * (j))
#define XB_XGEN(j)  (2304 + 64 * (j))
#define XB_TOP      3328
#define XB_TOPGEN   3392
#define XCD_BAR_WORDS 3456
#define XB_SPIN_CAP (1u << 18)

__device__ __forceinline__ unsigned xb_ld(unsigned* p)              { return __hip_atomic_load(p, __ATOMIC_RELAXED, __HIP_MEMORY_SCOPE_AGENT); }
__device__ __forceinline__ unsigned xb_add(unsigned* p, unsigned v) { return __hip_atomic_fetch_add(p, v, __ATOMIC_RELAXED, __HIP_MEMORY_SCOPE_AGENT); }
__device__ __forceinline__ unsigned xb_xcc_id() { return (unsigned)__builtin_amdgcn_s_getreg((3 << 11) | 20) & 0xFu; }
#define XB_SPIN(cond, bar) do { unsigned _sp = 0; while (cond) { __builtin_amdgcn_s_sleep(1); \
    if ((++_sp & 255u) == 0u) { if (xb_ld(&(bar)[XB_TMO])) break; if (_sp > XB_SPIN_CAP) { atomicAdd(&(bar)[XB_TMO], 1u); break; } } } } while (0)

struct XcdBarrier {
    unsigned* bar; unsigned x;
    volatile LAS unsigned* st;
};

__device__ __forceinline__ XcdBarrier xcd_barrier_post(unsigned* bar, volatile LAS unsigned* st) {
    XcdBarrier b; b.bar = bar; b.x = xb_xcc_id(); b.st = st;
    if (threadIdx.x == 0) (void)xb_add(&bar[XB_XCNT(b.x)], 1u);
    return b;
}
__device__ __forceinline__ void xcd_barrier_complete(unsigned* bar, unsigned x, unsigned& nloc, unsigned& nx) {
    const unsigned G = gridDim.x * gridDim.y * gridDim.z;
    unsigned sum, cnt, mine, sp = 0u;
    for (;;) {
        sum = 0u; cnt = 0u; mine = 0u;
#pragma unroll
        for (unsigned j = 0; j < 16; ++j) { const unsigned c = xb_ld(&bar[XB_XCNT(j)]); sum += c; cnt += (c > 0u) ? 1u : 0u; mine = (j == x) ? c : mine; }
        if (sum == G) break;
        __builtin_amdgcn_s_sleep(1);
        if ((++sp & 255u) == 0u) { if (xb_ld(&bar[XB_TMO])) break; if (sp > XB_SPIN_CAP) { atomicAdd(&bar[XB_TMO], 1u); break; } }
    }
    nloc = mine > 0u ? mine : 1u; nx = cnt > 0u ? cnt : 1u;
}

__device__ __forceinline__ void xcd_barrier(const XcdBarrier& b) {
    asm volatile("s_waitcnt vmcnt(0)" ::: "memory");
    __syncthreads();
    if (threadIdx.x == 0) {
        unsigned* bar = b.bar;
        __builtin_amdgcn_s_waitcnt(0);
        unsigned nloc = b.st[0], nx = b.st[1];
        if (nloc == 0u) { xcd_barrier_complete(bar, b.x, nloc, nx); b.st[0] = nloc; b.st[1] = nx; }
        const unsigned old = xb_add(&bar[XB_XSUB(b.x)], 1u);
        const unsigned gen = old / nloc;
        if (old + 1u == (gen + 1u) * nloc) {
            __builtin_amdgcn_fence(__ATOMIC_RELEASE, "agent");
            asm volatile("s_waitcnt vmcnt(0)" ::: "memory");
            const unsigned og = xb_add(&bar[XB_TOP], 1u);
            const unsigned tg = og / nx;
            if (og + 1u == (tg + 1u) * nx) xb_add(&bar[XB_TOPGEN], 1u);
            else XB_SPIN(xb_ld(&bar[XB_TOPGEN]) == tg, bar);
            __builtin_amdgcn_fence(__ATOMIC_ACQUIRE, "agent");
            xb_add(&bar[XB_XGEN(b.x)], 1u);
            asm volatile("s_waitcnt vmcnt(0)" ::: "memory");
        } else {
            XB_SPIN(xb_ld(&bar[XB_XGEN(b.x)]) == gen, bar);
            __builtin_amdgcn_fence(__ATOMIC_ACQUIRE, "agent");
            asm volatile("s_waitcnt vmcnt(0)" ::: "memory");
        }
    }
    __syncthreads();
}


#define LAYER(l) do { \
        const int pb = 1 + 8 * l; \
        if (IN(pb + 0)) { PHB(); if (l == 1) prep_weights(F, 1); p1_norm(F, l); SEAM(pb + 0); } \
        if (IN(pb + 1)) { PHB(); \
            pg8::Gemm g{(const bf16_t*)(F.ws + WS_XN), (const bf16_t*)(F.ws + WS_WIN), NT, NIN, DM, DM, DM}; pg8::StaticOrder S; S.init(NT, NIN, F.G, F.bid); \
            EpiIn E{F.ws, l}; \
            pg8::gemm_phase<EpiIn, pg8::StaticOrder, true, true>(F.lds, F.wave, g, S, E); \
            SEAM(pb + 1); \
        } \
        if (IN(pb + 2)) { PHB(); \
            pg8::Gemm g{(const bf16_t*)(F.ws + WS_QLAT), (const bf16_t*)(F.ws + WS_WQ), NT, 768, 256, 256, 256}; pg8::StaticOrder S; S.init(NT, 768, F.G, F.bid); \
            EpiQ E{F.ws, l}; \
            pg8::gemm_phase<EpiQ, pg8::StaticOrder, true, true>(F.lds, F.wave, g, S, E); \
            p3a_extras(F, l); \
            SEAM(pb + 2); \
        } \
        if (IN(pb + 3)) { PHB(); p3b_ssd(F, l); SEAM(pb + 3); } \
        if (IN(pb + 4)) { PHB(); p3c_rwkv(F, l); SEAM(pb + 4); } \
        if (IN(pb + 5)) { PHB(); p4_mix(F); SEAM(pb + 5); } \
        if (IN(pb + 6)) { PHB(); p5_assemble(F, l); SEAM(pb + 6); } \
        if (IN(pb + 7)) { PHB(); \
            pg8::Gemm g{(const bf16_t*)(F.ws + WS_GATES), (const bf16_t*)(F.ws + WS_WOUT), NT, DM, 1536, 1536, 1536}; pg8::StaticOrder S; S.init(NT, DM, F.G, F.bid); \
            EpiOut E{(l == 0) ? INP(I_X) : F.out, F.out, (const float*)(F.ws + WS_CTL + CTL_MOD) + (size_t)(l * 2) * 3072 + 2048}; \
            pg8::gemm_phase<EpiOut, pg8::StaticOrder, true, true>(F.lds, F.wave, g, S, E); \
            SEAM(pb + 7); \
        } \
    } while (0)
__global__ void __launch_bounds__(NTHR, 2) mk_fwd(Args args) {
    extern __shared__ __attribute__((aligned(16))) unsigned char lds_raw[];
    Ctx F; F.lds = (LAS unsigned char*)lds_raw; F.tid = threadIdx.x; F.lane = F.tid & 63; F.wave = __builtin_amdgcn_readfirstlane(F.tid >> 6);
    F.G = gridDim.x; F.bid = blockIdx.x; F.ws = args.ws; F.out = args.out; F.in = args.in;
    const int wave0 = F.wave;
    cg::grid_group grid = cg::this_grid();
    volatile LAS unsigned* xst = (volatile LAS unsigned*)(F.lds + LDS_BYTES - 256);
    if (threadIdx.x < 2) xst[threadIdx.x] = 0u;
    __syncthreads();
    const XcdBarrier xbar = xcd_barrier_post((unsigned*)(args.ws + WS_CTL) + 4096, xst);
#if MK_PER_PHASE
    const int lo = args.ph_lo, hi = args.ph_hi;
#else
    constexpr int lo = 0, hi = 18;
#endif
#ifndef MK_ONLY
#define MK_ONLY -1
#endif
#define IN(k) (lo <= (k) && (k) < hi && (MK_ONLY < 0 || MK_ONLY == ((k) == 0 ? 0 : (k) == 17 ? 17 : 1 + ((k) - 1) % 8)))
#if MK_PER_PHASE
#define SEAM(k) do { } while (0)
#else
#define SEAM(k) do { if ((k) == 0) grid.sync(); else xcd_barrier(xbar); } while (0)
#endif
#define PHB() do { int b_ = blockIdx.x, g_ = gridDim.x, v_ = wave0; asm volatile("" : "+s"(b_), "+s"(g_), "+s"(v_)); F.bid = b_; F.G = g_; F.wave = v_; int t_ = v_ * 64 + (int)__builtin_amdgcn_mbcnt_hi(~0u, __builtin_amdgcn_mbcnt_lo(~0u, 0u)); asm volatile("; PHASE_MARK %0" : "+v"(t_)); F.tid = t_; F.lane = t_ & 63; unsigned wl_ = __builtin_amdgcn_readfirstlane((unsigned)(uintptr_t)args.ws), wh_ = __builtin_amdgcn_readfirstlane((unsigned)((uintptr_t)args.ws >> 32)), ol_ = __builtin_amdgcn_readfirstlane((unsigned)(uintptr_t)args.out), oh_ = __builtin_amdgcn_readfirstlane((unsigned)((uintptr_t)args.out >> 32)); asm volatile("" : "+s"(wl_), "+s"(wh_), "+s"(ol_), "+s"(oh_)); F.ws = (unsigned char*)(GAS unsigned char*)(((uintptr_t)wh_ << 32) | wl_); F.out = (float*)(GAS float*)(((uintptr_t)oh_ << 32) | ol_); } while (0)
    if (IN(0)) { PHB(); p0_prologue(F); SEAM(0); }
    LAYER(0);
    LAYER(1);
    if (IN(17)) { PHB(); p7_final(F); }
#ifndef MK_RERUN
#define MK_RERUN 0
#endif
#define PHB2() do { int b_ = blockIdx.x, g_ = gridDim.x, v_ = wave0; asm volatile("" : "+s"(b_), "+s"(g_), "+s"(v_)); F.bid = b_; F.G = g_; F.wave = v_; int t_ = v_ * 64 + fresh_lane(); F.tid = t_; F.lane = t_ & 63; } while (0)
#if MK_RERUN
    { constexpr int l = 1;
    if (MK_RERUN & 1) { xcd_barrier(xbar); PHB2(); p1_norm(F, l); }
    if (MK_RERUN & 2) { xcd_barrier(xbar); PHB2(); pg8::Gemm g{(const bf16_t*)(F.ws + WS_XN), (const bf16_t*)(F.ws + WS_WIN), NT, NIN, DM, DM, DM}; pg8::StaticOrder S; S.init(NT, NIN, F.G, F.bid); EpiIn E{F.ws, l}; pg8::gemm_phase<EpiIn, pg8::StaticOrder, true, true>(F.lds, F.wave, g, S, E); }
    if (MK_RERUN & 4) { xcd_barrier(xbar); PHB2(); pg8::Gemm g{(const bf16_t*)(F.ws + WS_QLAT), (const bf16_t*)(F.ws + WS_WQ), NT, 768, 256, 256, 256}; pg8::StaticOrder S; S.init(NT, 768, F.G, F.bid); EpiQ E{F.ws, l}; pg8::gemm_phase<EpiQ, pg8::StaticOrder, true, true>(F.lds, F.wave, g, S, E); p3a_extras(F, l); }
    if (MK_RERUN & 8) { xcd_barrier(xbar); PHB2(); p3b_ssd(F, l); }
    if (MK_RERUN & 16) { xcd_barrier(xbar); PHB2(); p3c_rwkv(F, l); }
    if (MK_RERUN & 32) { xcd_barrier(xbar); PHB2(); p4_mix(F); }
#ifndef MK_AVAR
#define MK_AVAR 0
#endif
    if (MK_RERUN & 512) { xcd_barrier(xbar); PHB2(); p4_mix<MK_AVAR>(F, 1); }
    if (MK_RERUN & 1024) { xcd_barrier(xbar); PHB2(); p4_mix(F, 2); }
    if (MK_RERUN & 2048) { xcd_barrier(xbar); PHB2(); p4_mix(F, 2 | 4); }
    if (MK_RERUN & 4096) { xcd_barrier(xbar); PHB2(); p4_mix(F, 2 | 8); }
    if (MK_RERUN & 64) { xcd_barrier(xbar); PHB2(); p5_assemble(F, l); }
    if (MK_RERUN & 128) { xcd_barrier(xbar); PHB2(); pg8::Gemm g{(const bf16_t*)(F.ws + WS_GATES), (const bf16_t*)(F.ws + WS_WOUT), NT, DM, 1536, 1536, 1536}; pg8::StaticOrder S; S.init(NT, DM, F.G, F.bid);
        EpiOut E{INP(I_X), (float*)(F.ws + WS_XBC), (const float*)(F.ws + WS_CTL + CTL_MOD) + (size_t)(l * 2) * 3072 + 2048}; pg8::gemm_phase<EpiOut, pg8::StaticOrder, true, true>(F.lds, F.wave, g, S, E); }
    }
#endif
#undef IN
#undef SEAM
}
constexpr int N_PHASES = 18;

extern "C" void kernel_launch(void* const* d_in, const int* in_sizes, int n_in, void* d_out, int out_size, void* d_ws, size_t ws_size, hipStream_t stream) {
    static int grid = 0;
    if (grid == 0) {
        if (n_in != 31 || out_size != NT * DM || ws_size < WS_END) { fprintf(stderr, "kernel_launch: unexpected shapes (n_in %d, out %d, ws %zu)\n", n_in, out_size, ws_size); grid = -1; return; }
        int dev = 0, cus = 0, per_cu = 0;
        hipGetDevice(&dev); hipDeviceGetAttribute(&cus, hipDeviceAttributeMultiprocessorCount, dev);
        if (hipFuncSetAttribute((const void*)mk_fwd, hipFuncAttributeMaxDynamicSharedMemorySize, LDS_BYTES) != hipSuccess) { fprintf(stderr, "kernel_launch: hipFuncSetAttribute failed\n"); grid = -1; return; }
        hipOccupancyMaxActiveBlocksPerMultiprocessor(&per_cu, (const void*)mk_fwd, NTHR, LDS_BYTES);
        (void)hipGetLastError();
        if (per_cu < 1) per_cu = 1;
        grid = cus;
        fprintf(stderr, "kernel_launch: cus %d, occupancy query %d block(s)/CU, grid %d\n", cus, per_cu, grid);
    }
    if (grid < 0) return;
    hipMemsetAsync((char*)d_ws + WS_CTL, 0, CTL_BYTES, stream);
    Args a{};
    for (int i = 0; i < 31; ++i) a.in[i] = (const float*)d_in[i];
    a.out = (float*)d_out; a.ws = (unsigned char*)d_ws;
#if MK_PER_PHASE
    for (int p = 0; p < N_PHASES; ++p) { a.ph_lo = p; a.ph_hi = p + 1; hipLaunchKernelGGL(mk_fwd, dim3(grid), dim3(NTHR), LDS_BYTES, stream, a); }
#else
    a.ph_lo = 0; a.ph_hi = N_PHASES;
    void* params[] = {&a};
    hipError_t e = hipLaunchCooperativeKernel((const void*)mk_fwd, dim3(grid), dim3(NTHR), params, LDS_BYTES, stream);
    if (e != hipSuccess) fprintf(stderr, "kernel_launch: cooperative launch failed: %s\n", hipGetErrorString(e));
#endif
}
```

```cpp
#include <hip/hip_runtime.h>
#include <hip/hip_cooperative_groups.h>
#include <cstdio>
#include <cstdint>
namespace cg = cooperative_groups;

#define LAS __attribute__((address_space(3)))
#define GAS __attribute__((address_space(1)))
typedef unsigned short bf16_t;
typedef short bf16x8 __attribute__((ext_vector_type(8)));
typedef float f32x4 __attribute__((ext_vector_type(4)));
typedef float f32x2 __attribute__((ext_vector_type(2)));
typedef float f32x16 __attribute__((ext_vector_type(16)));
typedef unsigned u32x4 __attribute__((ext_vector_type(4)));
typedef unsigned u32x2 __attribute__((ext_vector_type(2)));
typedef short v4i16_t __attribute__((ext_vector_type(4)));

#ifndef MK_PER_PHASE
#define MK_PER_PHASE 0
#endif

namespace pg8 {
constexpr int BM = 256, BK = 64, HALF = 128, HTB = HALF * BK * 2, STAGE_BYTES = 8 * HTB, NXCD = 8, WGM = 8;
__host__ __device__ __forceinline__ int lds_byte(int r, int c) { const int st = (r >> 4) * 2 + (c >> 5), rr = r & 15, cc = c & 31, ob = rr * 64 + cc * 2; return st * 1024 + (ob ^ (((ob >> 9) & 1) << 5)); }
__host__ __device__ __forceinline__ void stage_rc(int b, int& R, int& C) { const int st = b / 1024, sb = b % 1024, swz = sb ^ (((sb >> 9) & 1) << 5); R = (st >> 1) * 16 + swz / 64; C = (st & 1) * 32 + (swz % 64) / 2; }
__host__ __device__ __forceinline__ int perm32(int rho) { const int n = rho >> 4, i = rho & 15; return 8 * (i >> 2) + 4 * n + (i & 3); }
struct Unit { int pm, pn; };
struct Gemm { const bf16_t* A; const bf16_t* Bt; int M, N, K, lda, ldb; int kdiag = 0; };
struct StaticOrder {
    int nM, nN, nwg, G, c;
    __host__ __device__ void init(int M, int N, int G_, int c_) { nM = M / BM; nN = N / BM; nwg = nM * nN; G = G_; c = c_; }
    __host__ __device__ bool next(int i, Unit& u) const {
        const long L = (long)i * G + c; if (L >= nwg) return false;
        int wgid = (int)L; { const int q = nwg / NXCD, r = nwg % NXCD, xcd = wgid % NXCD, off = wgid / NXCD; wgid = (xcd < r ? xcd * (q + 1) : r * (q + 1) + (xcd - r) * q) + off; }
        const int nig = WGM * nN, gid = wgid / nig, fm = gid * WGM, gsz = (nM - fm) < WGM ? (nM - fm) : WGM;
        u.pm = fm + ((wgid % nig) % gsz); u.pn = (wgid % nig) / gsz; return true;
    }
};
template <class Epi, class Sched, bool ALIGN_EPI, bool SP2>
__device__ __forceinline__ void gemm_phase(LAS unsigned char* lds, int wave_id, const Gemm g, const Sched& S, const Epi& E) {
    int lane = (int)__builtin_amdgcn_mbcnt_hi(~0u, __builtin_amdgcn_mbcnt_lo(~0u, 0u)); asm volatile("" : "+v"(lane));
    const int wid = wave_id, tid = wid * 64 + lane, wr = wid >> 2, wc = wid & 3, fr = lane & 15, fq = lane >> 4;
    const int K = g.K, nt = K / BK;
    unsigned voffA[2], voffB[2];
#pragma unroll
    for (int i = 0; i < 2; ++i) { int R, C; stage_rc(tid * 16 + i * 8192, R, C); const int Rb = (R & ~31) + perm32(R & 31);
        voffA[i] = (unsigned)(R * g.lda + C) * 2u; voffB[i] = (unsigned)(Rb * g.ldb + C) * 2u; }
    const size_t kstep = (size_t)(BK * 2);
    const size_t hstepA = (size_t)HALF * g.lda * 2, hstepB = (size_t)HALF * g.ldb * 2;
    const size_t tstepA = 2 * hstepA, tstepB = 2 * hstepB;
    const unsigned ldsw = (unsigned)wid * 1024u, lds0 = (unsigned)(uintptr_t)lds;
    const int aoff = lds_byte(wr * 64 + fr, fq * 8), boff = lds_byte(wc * 32 + fr, fq * 8);
#define PG8_SA(b, h) (((b) * 2 + (h)) * HTB)
#define PG8_SB(b, h) ((4 + (b) * 2 + (h)) * HTB)
#define PG8_STAGE(bufoff, gbase, voff) do { _Pragma("unroll") for (int _i = 0; _i < 2; ++_i) { unsigned keep_; \
        asm volatile("s_mov_b32 %0, m0\n\ts_mov_b32 m0, %3\n\ts_nop 0\n\tglobal_load_lds_dwordx4 %1, %2\n\ts_mov_b32 m0, %0" : "=&s"(keep_) : "v"((voff)[_i]), "s"((const char*)(gbase)), "s"(lds0 + (unsigned)(bufoff) + ldsw + (unsigned)(_i * 8192)) : "memory"); } } while (0)
#define PG8_LDA(dst, b, h) do { _Pragma("unroll") for (int m = 0; m < 4; ++m) _Pragma("unroll") for (int k = 0; k < 2; ++k) dst[m][k] = *(const LAS bf16x8*)(lds + PG8_SA(b, h) + aoff + m * 2048 + k * 1024); } while (0)
#define PG8_LDB(dst, b, h) do { _Pragma("unroll") for (int n = 0; n < 2; ++n) _Pragma("unroll") for (int k = 0; k < 2; ++k) dst[n][k] = *(const LAS bf16x8*)(lds + PG8_SB(b, h) + boff + n * 2048 + k * 1024); } while (0)
#define PG8_MMA(ai, bj, At, Bt) do { __builtin_amdgcn_s_setprio(1); _Pragma("unroll") for (int m = 0; m < 4; ++m) _Pragma("unroll") for (int n = 0; n < 2; ++n) _Pragma("unroll") for (int k = 0; k < 2; ++k) \
        acc[ai][bj][m][n] = __builtin_amdgcn_mfma_f32_16x16x32_bf16(Bt[n][k], At[m][k], acc[ai][bj][m][n], 0, 0, 0); __builtin_amdgcn_s_setprio(0); } while (0)
#define PG8_WAIT_V(n) asm volatile("s_waitcnt vmcnt(" #n ")" ::: "memory")
#define PG8_WAIT_L(n) asm volatile("s_waitcnt lgkmcnt(" #n ")" ::: "memory")
#define PG8_BAR __builtin_amdgcn_s_barrier()
#define PG8_SCHED __builtin_amdgcn_sched_barrier(0)
    Unit cur, nxt; int ui = 0;
    if (!S.next(0, cur)) return;
    f32x4 acc[2][2][4][2];
#pragma unroll
    for (int a = 0; a < 2; ++a)
#pragma unroll
        for (int b = 0; b < 2; ++b)
#pragma unroll
            for (int m = 0; m < 4; ++m)
#pragma unroll
                for (int n = 0; n < 2; ++n) acc[a][b][m][n] = (f32x4){0.f, 0.f, 0.f, 0.f};
    bf16x8 At[4][2], B0[2][2], B1[2][2];
    const char* cA = (const char*)g.A + (size_t)cur.pm * tstepA + (size_t)cur.pn * g.kdiag * 2; const char* cB = (const char*)g.Bt + (size_t)cur.pn * tstepB + (size_t)cur.pn * g.kdiag * 2;
    if constexpr (SP2) {
        PG8_STAGE(PG8_SB(0, 0), cB, voffB); PG8_STAGE(PG8_SB(0, 1), cB + hstepB, voffB); PG8_STAGE(PG8_SA(0, 0), cA, voffA); PG8_STAGE(PG8_SA(0, 1), cA + hstepA, voffA);
        if (wr == 1) PG8_BAR;
        PG8_WAIT_V(2); PG8_BAR;
        PG8_STAGE(PG8_SB(1, 0), cB + kstep, voffB); PG8_STAGE(PG8_SA(1, 0), cA + kstep, voffA); PG8_STAGE(PG8_SB(1, 1), cB + hstepB + kstep, voffB);
        PG8_WAIT_V(6); PG8_BAR;
    } else {
        PG8_STAGE(PG8_SB(0, 0), cB, voffB); PG8_STAGE(PG8_SA(0, 0), cA, voffA); PG8_STAGE(PG8_SB(0, 1), cB + hstepB, voffB); PG8_STAGE(PG8_SA(0, 1), cA + hstepA, voffA);
        if (wr == 1) PG8_BAR;
        PG8_WAIT_V(4); PG8_BAR;
        PG8_STAGE(PG8_SB(1, 0), cB + kstep, voffB); PG8_STAGE(PG8_SA(1, 0), cA + kstep, voffA); PG8_STAGE(PG8_SB(1, 1), cB + hstepB + kstep, voffB);
        PG8_WAIT_V(6); PG8_BAR;
    }
    for (;;) {
        const bool has_next = S.next(ui + 1, nxt);
        const char* nA = has_next ? (const char*)g.A + (size_t)nxt.pm * tstepA + (size_t)nxt.pn * g.kdiag * 2 : cA; const char* nB = has_next ? (const char*)g.Bt + (size_t)nxt.pn * tstepB + (size_t)nxt.pn * g.kdiag * 2 : cB;
        for (int t = 0; t < nt; t += 2) {
            const bool last = (t == nt - 2);
            const char* a1 = cA + (size_t)(t + 1) * kstep;
            const char* a2 = last ? nA : cA + (size_t)(t + 2) * kstep; const char* b2 = last ? nB : cB + (size_t)(t + 2) * kstep;
            const char* a3 = a2 + kstep; const char* b3 = b2 + kstep;
            if constexpr (SP2) {
            PG8_LDB(B0, 0, 0); PG8_LDB(B1, 0, 1); PG8_SCHED; PG8_LDA(At, 0, 0); PG8_STAGE(PG8_SA(1, 1), a1 + hstepA, voffA);
            PG8_WAIT_V(8); PG8_WAIT_L(0); PG8_BAR; PG8_MMA(0, 0, At, B0); PG8_MMA(0, 1, At, B1); PG8_BAR; PG8_SCHED;
            PG8_LDA(At, 0, 1); PG8_STAGE(PG8_SB(0, 0), b2, voffB); PG8_STAGE(PG8_SB(0, 1), b2 + hstepB, voffB); PG8_STAGE(PG8_SA(0, 0), a2, voffA);
            PG8_WAIT_V(8); PG8_WAIT_L(0); PG8_BAR; PG8_MMA(1, 0, At, B0); PG8_MMA(1, 1, At, B1); PG8_BAR; PG8_SCHED;
            PG8_LDB(B0, 1, 0); PG8_LDB(B1, 1, 1); PG8_SCHED; PG8_LDA(At, 1, 0); PG8_STAGE(PG8_SA(0, 1), a2 + hstepA, voffA);
            PG8_WAIT_V(8); PG8_WAIT_L(0); PG8_BAR; PG8_MMA(0, 0, At, B0); PG8_MMA(0, 1, At, B1); PG8_BAR; PG8_SCHED;
            PG8_LDA(At, 1, 1); PG8_STAGE(PG8_SB(1, 0), b3, voffB); PG8_STAGE(PG8_SB(1, 1), b3 + hstepB, voffB); PG8_STAGE(PG8_SA(1, 0), a3, voffA);
            PG8_WAIT_V(8); PG8_WAIT_L(0); PG8_BAR; PG8_MMA(1, 0, At, B0); PG8_MMA(1, 1, At, B1); PG8_BAR; PG8_SCHED;
            } else {
            PG8_LDB(B0, 0, 0); PG8_SCHED; PG8_LDA(At, 0, 0); PG8_STAGE(PG8_SA(1, 1), a1 + hstepA, voffA);
            PG8_WAIT_L(8); PG8_BAR; PG8_WAIT_L(0); PG8_MMA(0, 0, At, B0); PG8_BAR; PG8_SCHED;
            PG8_LDB(B1, 0, 1); PG8_STAGE(PG8_SB(0, 0), b2, voffB);
            PG8_BAR; PG8_WAIT_L(0); PG8_MMA(0, 1, At, B1); PG8_BAR;
            PG8_LDA(At, 0, 1); PG8_STAGE(PG8_SA(0, 0), a2, voffA);
            PG8_BAR; PG8_WAIT_L(0); PG8_MMA(1, 0, At, B0); PG8_BAR; PG8_SCHED;
            PG8_STAGE(PG8_SB(0, 1), b2 + hstepB, voffB);
            PG8_WAIT_V(6); PG8_BAR; PG8_MMA(1, 1, At, B1); PG8_BAR;
            PG8_LDB(B0, 1, 0); PG8_SCHED; PG8_LDA(At, 1, 0); PG8_STAGE(PG8_SA(0, 1), a2 + hstepA, voffA);
            PG8_WAIT_L(8); PG8_BAR; PG8_WAIT_L(0); PG8_MMA(0, 0, At, B0); PG8_BAR; PG8_SCHED;
            PG8_LDB(B1, 1, 1); PG8_STAGE(PG8_SB(1, 0), b3, voffB);
            PG8_BAR; PG8_WAIT_L(0); PG8_MMA(0, 1, At, B1); PG8_BAR;
            PG8_LDA(At, 1, 1); PG8_STAGE(PG8_SA(1, 0), a3, voffA);
            PG8_BAR; PG8_WAIT_L(0); PG8_MMA(1, 0, At, B0); PG8_BAR; PG8_SCHED;
            PG8_STAGE(PG8_SB(1, 1), b3 + hstepB, voffB);
            PG8_WAIT_V(6); PG8_BAR; PG8_MMA(1, 1, At, B1); PG8_BAR;
            }
        }
        if constexpr (ALIGN_EPI) { if (wr == 0) PG8_BAR; }
        E(acc, cur, wr, wc, fr, fq);
        if (!has_next) break;
#pragma unroll
        for (int a = 0; a < 2; ++a)
#pragma unroll
            for (int b = 0; b < 2; ++b)
#pragma unroll
                for (int m = 0; m < 4; ++m)
#pragma unroll
                    for (int n = 0; n < 2; ++n) acc[a][b][m][n] = (f32x4){0.f, 0.f, 0.f, 0.f};
        cur = nxt; cA = nA; cB = nB; ++ui;
        if constexpr (ALIGN_EPI) { if (wr == 1) PG8_BAR; }
    }
    PG8_WAIT_V(0);
    if constexpr (!ALIGN_EPI) { if (wr == 0) PG8_BAR; }
    PG8_BAR;
#undef PG8_SA
#undef PG8_SB
#undef PG8_STAGE
#undef PG8_LDA
#undef PG8_LDB
#undef PG8_MMA
#undef PG8_WAIT_V
#undef PG8_WAIT_L
#undef PG8_BAR
#undef PG8_SCHED
}
}

constexpr int NT = 16384, SEQ = 8192, DM = 1024, DIN = 4680, NIN = 4864, NCHK = 256, NWAVES = 8, NTHR = 512;
constexpr float EPS = 1e-6f, GN_EPS = 64e-5f, DECAY_SCALE = 0.606531f;
constexpr float QSCALE = 0.07216878364870322f * 1.4426950408889634f;
constexpr size_t MiB = 1u << 20;
constexpr size_t WS_CTL = 0, CTL_BYTES = 1 * MiB;
constexpr size_t CTL_MOD = 65536;
constexpr size_t CTL_SSQ = 131072;
constexpr size_t WS_WIN = 1 * MiB;
constexpr size_t WS_CB = WS_WIN, WS_ECUM = WS_WIN + 8 * MiB, WS_CDEC = WS_ECUM + 512 * 1024;
constexpr size_t WS_WQ = 10 * MiB + 512 * 1024;
constexpr size_t WS_WUV = 11 * MiB;
constexpr size_t WS_WLW = 11 * MiB + 512 * 1024;
constexpr size_t WS_WLA = WS_WLW + 65536;
constexpr size_t WS_WOUT = 12 * MiB;
constexpr size_t WS_XN = 15 * MiB;
constexpr size_t WS_TT = WS_XN, WS_QE = WS_XN + 16 * MiB;
constexpr size_t WS_QLAT = 47 * MiB, WS_KVL = 55 * MiB;
constexpr size_t WS_OL = WS_QLAT;
constexpr size_t WS_GATES = 63 * MiB;
constexpr size_t WS_XBC = 111 * MiB;
constexpr size_t WS_R = 143 * MiB, WS_K = 159 * MiB, WS_V = 175 * MiB;
constexpr size_t WS_F = 191 * MiB;
constexpr size_t WS_Q = 200 * MiB;
constexpr size_t WS_KVB = 224 * MiB;
constexpr size_t WS_YD = 230 * MiB;
constexpr size_t WS_ROPE = 246 * MiB;
constexpr size_t WS_HX = 250 * MiB;
constexpr size_t WS_HRKV = WS_HX + 1536 * 1024;
constexpr size_t WS_HF = WS_HRKV + 768 * 1024;
constexpr size_t WS_END = 253 * MiB;
constexpr int LDS_BYTES = 152 * 1024;

#define LDS_WAIT() asm volatile("s_waitcnt lgkmcnt(0)" ::: "memory")
typedef __bf16 bf16x2_hw __attribute__((ext_vector_type(2)));
__device__ __forceinline__ unsigned pk2(float lo, float hi) { const f32x2 v = {lo, hi}; return __builtin_bit_cast(unsigned, __builtin_convertvector(v, bf16x2_hw)); }
__device__ __forceinline__ unsigned f2bf(float f) { return pk2(f, 0.f) & 0xffffu; }
__device__ __forceinline__ float bf2f(unsigned short b) { return __builtin_bit_cast(float, (unsigned)b << 16); }
__device__ __forceinline__ float bflo(unsigned w) { return __builtin_bit_cast(float, w << 16); }
__device__ __forceinline__ float bfhi(unsigned w) { return __builtin_bit_cast(float, w & 0xffff0000u); }
__device__ __forceinline__ float wave_sum(float v) {
#pragma unroll
    for (int o = 1; o < 64; o <<= 1) v += __shfl_xor(v, o);
    return v;
}
__device__ __forceinline__ float sigmoidf_(float x) { return __builtin_amdgcn_rcpf(1.f + __expf(-x)); }
__device__ __forceinline__ float siluf_(float x) { return x * __builtin_amdgcn_rcpf(1.f + __expf(-x)); }
__device__ __forceinline__ int pi16(int n) { const int x = n & 15; return (n & ~15) | ((x >= 4 && x < 8) ? x + 4 : (x >= 8 && x < 12) ? x - 4 : x); }
__device__ __forceinline__ int sg32(int x) { return (x & ~31) | (16 * ((x >> 2) & 1) + 4 * ((x & 31) >> 3) + (x & 3)); }
__device__ __forceinline__ int crow(int r, int hi) { return (r & 3) + 8 * (r >> 2) + 4 * hi; }

template <int K> __device__ __forceinline__ f32x4 mma_tile(const LAS bf16_t* A, int lda, const LAS bf16_t* Bt, int ldb, int lane) {
    f32x4 acc = {0.f, 0.f, 0.f, 0.f};
    const LAS bf16_t* ap = A + (lane & 15) * lda + (lane >> 4) * 8;
    const LAS bf16_t* bp = Bt + (lane & 15) * ldb + (lane >> 4) * 8;
#pragma unroll
    for (int k = 0; k < K; k += 32) {
        const bf16x8 a = *(const LAS bf16x8*)(ap + k), b = *(const LAS bf16x8*)(bp + k);
        acc = __builtin_amdgcn_mfma_f32_16x16x32_bf16(a, b, acc, 0, 0, 0);
    }
    return acc;
}

template <int V> struct IC { static constexpr int value = V; };
template <bool KX> __device__ __forceinline__ bf16x8 frag16(const LAS bf16_t* M, int ld, int x0, int k0, int lane) {
    if constexpr (!KX) return *(const LAS bf16x8*)(M + (x0 + (lane & 15)) * ld + k0 + 8 * (lane >> 4));
    else { const LAS bf16_t* p = M + (k0 + 8 * (lane >> 4) + ((lane & 15) >> 2)) * ld + x0 + 4 * (lane & 3);
        const v4i16_t lo = __builtin_amdgcn_ds_read_tr16_b64_v4i16((LAS v4i16_t*)p), hi = __builtin_amdgcn_ds_read_tr16_b64_v4i16((LAS v4i16_t*)(p + 4 * ld));
        return (bf16x8){lo[0], lo[1], lo[2], lo[3], hi[0], hi[1], hi[2], hi[3]}; }
}
template <int K, bool AKX, bool BKX> __device__ __forceinline__ f32x4 mma_tile2(const LAS bf16_t* A, int lda, int m0, const LAS bf16_t* B, int ldb, int n0, int lane) {
    f32x4 acc = {0.f, 0.f, 0.f, 0.f};
#pragma unroll
    for (int k = 0; k < K; k += 32) acc = __builtin_amdgcn_mfma_f32_16x16x32_bf16(frag16<AKX>(A, lda, m0, k, lane), frag16<BKX>(B, ldb, n0, k, lane), acc, 0, 0, 0);
    return acc;
}
struct Args {
    const float* in[31]; float* out; unsigned char* ws; int ph_lo, ph_hi;
};
struct Ctx {
    LAS unsigned char* lds; int tid, lane, wave, G, bid;
    unsigned char* ws; float* out;
    const float* const* in;
};
__device__ __forceinline__ const float* ldin(const float* const* in, int i) { asm volatile("" : "+s"(i)); return (const float*)(const GAS float*)in[i]; }
#define INP(i) ldin(F.in, i)
__device__ __forceinline__ int fresh_lane() { int l_ = (int)__builtin_amdgcn_mbcnt_hi(~0u, __builtin_amdgcn_mbcnt_lo(~0u, 0u)); asm volatile("" : "+v"(l_)); return l_; }
enum { I_X = 0, I_C, I_POS, I_ADAW, I_ADAB, I_NORMW, I_WIN, I_QNW, I_WUQ, I_KVNW, I_WUKV, I_CONVW, I_CONVB, I_DTB, I_ALOG, I_DSKIP, I_SSDNW,
       I_MURKV, I_MUW, I_MUA, I_W0, I_WLB, I_A0, I_ALB, I_KK, I_KA, I_RK, I_LNXW, I_LNXB, I_WOUT, I_FNW };

__device__ __forceinline__ int win_src_col(int n) {
    if (n < 448) return n;
    if (n < 512) return -1;
    if (n < 1024) return 448 + (n - 512);
    if (n < 1536) return 960 + (n - 1024);
    if (n < 2560) return 1472 + (n - 1536);
    if (n < 3072) return 2504 + (n - 2560);
    if (n < 3584) return 3016 + (n - 3072);
    if (n < 4096) return 3528 + (n - 3584);
    if (n < 4608) return 4168 + (n - 4096);
    if (n < 4672) return 4040 + (n - 4608);
    if (n < 4736) return 4104 + (n - 4672);
    if (n < 4744) return 2496 + (n - 4736);
    return -1;
}
template <class Src4> __device__ __forceinline__ void transpose_item(const Src4& src4, bf16_t* WT, int ldw, LAS float* scr, int kb, int nb, int lane) {
    const int k0 = 64 * kb, n0 = 64 * nb;
#pragma unroll 8
    for (int i = 0; i < 16; ++i) { const int kk = 4 * i + (lane >> 4), nn = 4 * (lane & 15); const f32x4 v = src4(k0 + kk, n0 + nn);
        LAS float* d = scr + kk * 65 + nn; d[0] = v[0]; d[1] = v[1]; d[2] = v[2]; d[3] = v[3]; }
    LDS_WAIT();
    const int c = lane & 7;
#pragma unroll
    for (int j = 0; j < 8; ++j) { const int n = (lane >> 3) + 8 * j; const LAS float* sp = scr + (8 * c) * 65 + n;
        u32x4 o; o.x = pk2(sp[0 * 65], sp[1 * 65]); o.y = pk2(sp[2 * 65], sp[3 * 65]); o.z = pk2(sp[4 * 65], sp[5 * 65]); o.w = pk2(sp[6 * 65], sp[7 * 65]);
        *(u32x4*)(WT + (size_t)(n0 + n) * ldw + k0 + 8 * c) = o; }
    LDS_WAIT();
}
__device__ __forceinline__ void prep_weights(const Ctx& F, int l) {
    LAS float* scr = (LAS float*)(F.lds + F.wave * 16640);
    const int gw = F.bid * NWAVES + F.wave, NGW = F.G * NWAVES;
    const float* w_in = INP(I_WIN) + (size_t)l * DM * DIN;
    const float* w_out = INP(I_WOUT) + (size_t)l * 1536 * 1024;
    const float* wlb = INP(I_WLB) + (size_t)l * 64 * 512;
    const float* alb = INP(I_ALB) + (size_t)l * 64 * 512;
    bf16_t* WIN = (bf16_t*)(F.ws + WS_WIN); bf16_t* WOUT = (bf16_t*)(F.ws + WS_WOUT); bf16_t* WLW = (bf16_t*)(F.ws + WS_WLW); bf16_t* WLA = (bf16_t*)(F.ws + WS_WLA);
    constexpr int I_IN = 16 * (NIN / 64), I_OUT = 24 * 16, I_LW = 8, I_LA = 8, NITEMS = I_IN + I_OUT + I_LW + I_LA;
    for (int it = gw; it < NITEMS; it += NGW) {
        int r = it;
        if (r < I_IN) { const int kb = r / (NIN / 64), nb = r % (NIN / 64);
            transpose_item([&](int k, int n) { const int sc = win_src_col(n); return sc >= 0 ? *(const f32x4*)(w_in + (size_t)k * DIN + sc) : (f32x4){0.f, 0.f, 0.f, 0.f}; }, WIN, 1024, scr, kb, nb, F.lane); continue; }
        r -= I_IN;
        if (r < I_OUT) { const int kb = r / 16, nb = r % 16;
            transpose_item([&](int k, int n) { return *(const f32x4*)(w_out + (size_t)k * 1024 + n); }, WOUT, 1536, scr, kb, nb, F.lane); continue; }
        r -= I_OUT;
        if (r < I_LW) { transpose_item([&](int k, int n) { return *(const f32x4*)(wlb + k * 512 + n); }, WLW, 64, scr, 0, r, F.lane); continue; }
        r -= I_LW;
        transpose_item([&](int k, int n) { return *(const f32x4*)(alb + k * 512 + n); }, WLA, 64, scr, 0, r, F.lane);
    }
    const float* wuq = INP(I_WUQ) + (size_t)l * 256 * 768; const float* wukv = INP(I_WUKV) + (size_t)l * 128 * 1024; const float* qnw = INP(I_QNW) + l * 256;
    bf16_t* WQ = (bf16_t*)(F.ws + WS_WQ); bf16_t* WUV = (bf16_t*)(F.ws + WS_WUV);
    const int gt = F.bid * NTHR + F.tid, NGT = F.G * NTHR;
    for (int e = gt; e < 768 * 256; e += NGT) {
        const int n = e >> 8, k = e & 255, h = n / 192, idx = n % 192; float v;
        if (idx < 128) {
            const f32x4* a = (const f32x4*)(wuq + (size_t)k * 768 + h * 192); const f32x4* b = (const f32x4*)(wukv + (size_t)idx * 1024 + h * 256);
            float s = 0.f;
#pragma unroll 8
            for (int d = 0; d < 32; ++d) { const f32x4 x = a[d], y = b[d]; s += x.x * y.x + x.y * y.y + x.z * y.z + x.w * y.w; }
            v = s;
        } else v = wuq[(size_t)k * 768 + n];
        WQ[e] = (bf16_t)f2bf(v * qnw[k]);
    }
    for (int e = gt; e < 512 * 512; e += NGT) {
        const int n = e >> 9, k = e & 511, h = n >> 7, d = n & 127, h2 = k >> 7, c = k & 127;
        WUV[e] = (h == h2) ? (bf16_t)f2bf(wukv[(size_t)c * 1024 + h * 256 + 128 + d]) : (bf16_t)0;
    }
}
__device__ __forceinline__ void p0_mod(const Ctx& F) {
    const int gw = F.bid * NWAVES + F.wave, NGW = F.G * NWAVES;
    float* MOD = (float*)(F.ws + WS_CTL + CTL_MOD);
    for (int it = gw; it < 2 * 12 * 32; it += NGW) {
        const int l = it / 384, r = it % 384, cb = r / 32, ks = r % 32;
        const float* aw = INP(I_ADAW) + (size_t)l * DM * 3072 + (size_t)(ks * 32) * 3072 + cb * 256 + F.lane * 4;
        const float* cc = INP(I_C);
        f32x4 a0 = {0.f, 0.f, 0.f, 0.f}, a1 = a0;
#pragma unroll 8
        for (int k = 0; k < 32; ++k) { const f32x4 w = *(const f32x4*)(aw + (size_t)k * 3072); const float s0 = siluf_(cc[ks * 32 + k]), s1 = siluf_(cc[DM + ks * 32 + k]); a0 += w * s0; a1 += w * s1; }
        if (ks == 0) { const f32x4 bb = *(const f32x4*)(INP(I_ADAB) + l * 3072 + cb * 256 + F.lane * 4); a0 += bb; a1 += bb; }
        float* m0 = MOD + (size_t)(l * 2 + 0) * 3072 + cb * 256 + F.lane * 4; float* m1 = m0 + 3072;
#pragma unroll
        for (int j = 0; j < 4; ++j) { atomicAdd(m0 + j, a0[j]); atomicAdd(m1 + j, a1[j]); }
    }
}
__device__ __forceinline__ void p0_rope(const Ctx& F) {
    float* ROPE = (float*)(F.ws + WS_ROPE); const int* pos = (const int*)INP(I_POS);
    for (int e = F.bid * NTHR + F.tid; e < NT * 32; e += F.G * NTHR) {
        const int m = e >> 5, i = e & 31;
        const float invf = powf(10000.f, -(float)i / 32.f); const float ang = (float)pos[m] * invf;
        const double a = (double)ang; const double kq = __builtin_rint(a * 0.15915494309189535); const float rr = (float)(a - kq * 6.283185307179586);
        ROPE[(size_t)m * 64 + i] = cosf(rr); ROPE[(size_t)m * 64 + 32 + i] = sinf(rr);
    }
}
__device__ __forceinline__ void p1_norm(const Ctx& F, int l) {
    const float* xin = (l == 0) ? INP(I_X) : F.out;
    const float* nw = INP(I_NORMW) + l * DM; const float* MOD = (const float*)(F.ws + WS_CTL + CTL_MOD);
    bf16_t* XN = (bf16_t*)(F.ws + WS_XN);
    const int gw = F.bid * NWAVES + F.wave, NGW = F.G * NWAVES;
    for (int m = gw; m < NT; m += NGW) {
        const int b = m >> 13; const float* md = MOD + (size_t)(l * 2 + b) * 3072;
        const f32x4* xr = (const f32x4*)(xin + (size_t)m * DM) + F.lane;
        f32x4 v[4]; float s = 0.f;
#pragma unroll
        for (int j = 0; j < 4; ++j) { v[j] = xr[64 * j]; s += v[j].x * v[j].x + v[j].y * v[j].y + v[j].z * v[j].z + v[j].w * v[j].w; }
        const float rstd = 1.f / sqrtf(wave_sum(s) * (1.f / DM) + EPS);
        unsigned long long* o8 = (unsigned long long*)(XN + (size_t)m * DM) + F.lane;
#pragma unroll
        for (int j = 0; j < 4; ++j) { const int c0 = 4 * F.lane + 256 * j;
            const f32x4 w = *(const f32x4*)(nw + c0), sh = *(const f32x4*)(md + c0), sc = *(const f32x4*)(md + 1024 + c0);
            const f32x4 y = v[j] * rstd * w * (sc + 1.f) + sh;
            o8[64 * j] = (unsigned long long)pk2(y.x, y.y) | ((unsigned long long)pk2(y.z, y.w) << 32); }
    }
}
__device__ __forceinline__ u32x4 pack8(f32x4 a, f32x4 b) { u32x4 w; w.x = pk2(a[0], a[1]); w.y = pk2(a[2], a[3]); w.z = pk2(b[0], b[1]); w.w = pk2(b[2], b[3]); return w; }
struct EpiIn {
    unsigned char* ws; int l;
    __device__ __forceinline__ void operator()(const f32x4 (&acc)[2][2][4][2], const pg8::Unit& u, int wr, int wc, int fr, int fq) const {
        { int ln_ = (int)__builtin_amdgcn_mbcnt_hi(~0u, __builtin_amdgcn_mbcnt_lo(~0u, 0u)); asm volatile("" : "+v"(ln_)); fr = ln_ & 15; fq = ln_ >> 4; }
        const int pn = u.pn; size_t bo; int ld, c0;
        if (pn == 0) { bo = WS_QLAT; ld = 256; c0 = 0; } else if (pn == 1) { bo = WS_KVL; ld = 256; c0 = 0; }
        else if (pn < 4) { bo = WS_GATES; ld = 1536; c0 = (pn - 2) * 256; } else if (pn < 6) { bo = WS_GATES; ld = 1536; c0 = 512 + (pn - 4) * 256; }
        else if (pn < 10) { bo = WS_XBC; ld = 1024; c0 = (pn - 6) * 256; } else if (pn < 12) { bo = WS_R; ld = 512; c0 = (pn - 10) * 256; }
        else if (pn < 14) { bo = WS_K; ld = 512; c0 = (pn - 12) * 256; } else if (pn < 16) { bo = WS_V; ld = 512; c0 = (pn - 14) * 256; }
        else if (pn < 18) { bo = WS_GATES; ld = 1536; c0 = 1024 + (pn - 16) * 256; } else { bo = WS_F; ld = 144; c0 = 0; }
        bf16_t* base = (bf16_t*)(ws + bo); float* F = (float*)(ws + WS_F);
        float* ssq_q = (float*)(ws + WS_CTL + CTL_SSQ) + (size_t)(l * 2) * NT; float* ssq_kv = ssq_q + NT;
        const int row0 = u.pm * 256 + wr * 64 + fr, col0 = wc * 32 + 8 * fq;
        if (pn < 18) {
#pragma unroll
            for (int ai = 0; ai < 2; ++ai)
#pragma unroll
                for (int m = 0; m < 4; ++m) { const int row = row0 + ai * 128 + m * 16; bf16_t* rp = base + (size_t)row * ld + c0 + col0;
#pragma unroll
                    for (int bj = 0; bj < 2; ++bj) *(u32x4*)(rp + bj * 128) = pack8(acc[ai][bj][m][0], acc[ai][bj][m][1]);
                    if (m == 3 && pn >= 6 && pn < 16) {
                        const int chunk = row >> 6;
                        if (pn < 10) { if (fr >= 13) { bf16_t* hp = (bf16_t*)(ws + WS_HX) + (size_t)(chunk * 3 + (fr - 13)) * 1024 + c0 + col0;
#pragma unroll
                                for (int bj = 0; bj < 2; ++bj) *(u32x4*)(hp + bj * 128) = pack8(acc[ai][bj][m][0], acc[ai][bj][m][1]); } }
                        else if (fr == 15) { bf16_t* hp = (bf16_t*)(ws + WS_HRKV) + (size_t)((pn - 10) >> 1) * NCHK * 512 + (size_t)chunk * 512 + c0 + col0;
#pragma unroll
                            for (int bj = 0; bj < 2; ++bj) *(u32x4*)(hp + bj * 128) = pack8(acc[ai][bj][m][0], acc[ai][bj][m][1]); } }
                    if (pn < 2) { float s = 0.f;
#pragma unroll
                        for (int bj = 0; bj < 2; ++bj) if (pn == 0 || bj == 0) {
#pragma unroll
                            for (int n = 0; n < 2; ++n) { const f32x4 x = acc[ai][bj][m][n]; s += x[0] * x[0] + x[1] * x[1] + x[2] * x[2] + x[3] * x[3]; } }
                        s += __shfl_xor(s, 16); s += __shfl_xor(s, 32);
                        if (fq == 0) atomicAdd((pn == 0 ? ssq_q : ssq_kv) + row, s); } }
        } else {
#pragma unroll
            for (int ai = 0; ai < 2; ++ai)
#pragma unroll
                for (int m = 0; m < 4; ++m) { const int row = row0 + ai * 128 + m * 16;
#pragma unroll
                    for (int bj = 0; bj < 2; ++bj) { const int c = bj * 128 + col0; if (c < 136) { float* fp = F + (size_t)row * 144 + c; *(f32x4*)fp = acc[ai][bj][m][0]; *(f32x4*)(fp + 4) = acc[ai][bj][m][1]; } }
                    if (m == 3 && fr == 15) { float* hf = (float*)(ws + WS_HF) + (size_t)(row >> 6) * 128 + col0; *(f32x4*)hf = acc[ai][0][m][0]; *(f32x4*)(hf + 4) = acc[ai][0][m][1]; } }
        }
    }
};
struct EpiQ {
    unsigned char* ws; int l;
    __device__ __forceinline__ void operator()(const f32x4 (&acc)[2][2][4][2], const pg8::Unit& u, int wr, int wc, int fr, int fq) const {
        { int ln_ = (int)__builtin_amdgcn_mbcnt_hi(~0u, __builtin_amdgcn_mbcnt_lo(~0u, 0u)); asm volatile("" : "+v"(ln_)); fr = ln_ & 15; fq = ln_ >> 4; }
        bf16_t* Q = (bf16_t*)(ws + WS_Q); const float* ssq = (const float*)(ws + WS_CTL + CTL_SSQ) + (size_t)(l * 2) * NT;
        const int row0 = u.pm * 256 + wr * 64 + fr, c0 = u.pn * 256 + wc * 32 + 8 * fq;
#pragma unroll
        for (int ai = 0; ai < 2; ++ai)
#pragma unroll
            for (int m = 0; m < 4; ++m) { const int row = row0 + ai * 128 + m * 16; const float sc = QSCALE / sqrtf(ssq[row] * (1.f / 256.f) + EPS); bf16_t* qp = Q + (size_t)row * 768 + c0;
#pragma unroll
                for (int bj = 0; bj < 2; ++bj) *(u32x4*)(qp + bj * 128) = pack8(acc[ai][bj][m][0] * sc, acc[ai][bj][m][1] * sc); }
    }
};
struct EpiUV {
    bf16_t* gates;
    __device__ __forceinline__ void operator()(const f32x4 (&acc)[2][2][4][2], const pg8::Unit& u, int wr, int wc, int fr, int fq) const {
        { int ln_ = (int)__builtin_amdgcn_mbcnt_hi(~0u, __builtin_amdgcn_mbcnt_lo(~0u, 0u)); asm volatile("" : "+v"(ln_)); fr = ln_ & 15; fq = ln_ >> 4; }
        const int row0 = u.pm * 256 + wr * 64 + fr;
#pragma unroll
        for (int ai = 0; ai < 2; ++ai)
#pragma unroll
            for (int m = 0; m < 4; ++m) { asm volatile("" ::: "memory"); const int row = row0 + ai * 128 + m * 16;
#pragma unroll
                for (int bj = 0; bj < 2; ++bj) { const int c = u.pn * 256 + bj * 128 + wc * 32 + 8 * fq; u32x4* gp = (u32x4*)(gates + (size_t)row * 1536 + c); const u32x4 gw = *gp;
                    f32x4 v0 = acc[ai][bj][m][0], v1 = acc[ai][bj][m][1];
                    v0[0] *= siluf_(bflo(gw.x)); v0[1] *= siluf_(bfhi(gw.x)); v0[2] *= siluf_(bflo(gw.y)); v0[3] *= siluf_(bfhi(gw.y));
                    v1[0] *= siluf_(bflo(gw.z)); v1[1] *= siluf_(bfhi(gw.z)); v1[2] *= siluf_(bflo(gw.w)); v1[3] *= siluf_(bfhi(gw.w));
                    *gp = pack8(v0, v1); } }
    }
};
struct EpiOut {
    const float* xin; float* xout; const float* gate;
    __device__ __forceinline__ void operator()(const f32x4 (&acc)[2][2][4][2], const pg8::Unit& u, int wr, int wc, int fr, int fq) const {
        { int ln_ = (int)__builtin_amdgcn_mbcnt_hi(~0u, __builtin_amdgcn_mbcnt_lo(~0u, 0u)); asm volatile("" : "+v"(ln_)); fr = ln_ & 15; fq = ln_ >> 4; }
        const int row0 = u.pm * 256 + wr * 64 + fr;
#pragma unroll
        for (int bj = 0; bj < 2; ++bj) { const int c = u.pn * 256 + bj * 128 + wc * 32 + 8 * fq;
#pragma unroll
            for (int ai = 0; ai < 2; ++ai)
#pragma unroll
                for (int m = 0; m < 4; ++m) { const int row = row0 + ai * 128 + m * 16; const float* gp = gate + (size_t)(row >> 13) * 3072 + c;
                    const f32x4 g0 = *(const f32x4*)gp, g1 = *(const f32x4*)(gp + 4);
                    const size_t off = (size_t)row * DM + c; const f32x4 x0 = *(const f32x4*)(xin + off), x1 = *(const f32x4*)(xin + off + 4);
                    *(f32x4*)(xout + off) = x0 + g0 * acc[ai][bj][m][0]; *(f32x4*)(xout + off + 4) = x1 + g1 * acc[ai][bj][m][1]; } }
    }
};

__device__ __forceinline__ void p3a_extras(const Ctx& F, int l) {
    const int tid_ = F.wave * 64 + fresh_lane();
    const int gt = F.bid * NTHR + tid_, NGT = F.G * NTHR;
    const bf16_t* KVL = (const bf16_t*)(F.ws + WS_KVL); bf16_t* KVB = (bf16_t*)(F.ws + WS_KVB);
    const float* ssq = (const float*)(F.ws + WS_CTL + CTL_SSQ) + (size_t)(l * 2 + 1) * NT; const float* kvnw = INP(I_KVNW) + l * 128;
    const float* ROPE = (const float*)(F.ws + WS_ROPE);
    for (int e = gt; e < NT * 24; e += NGT) {
        const int m = e / 24, g = e % 24;
        if (g < 16) {
            const u32x4 w = *(const u32x4*)(KVL + (size_t)m * 256 + 8 * g); const float rs = 1.f / sqrtf(ssq[m] * (1.f / 128.f) + EPS);
            const f32x4 n0 = *(const f32x4*)(kvnw + 8 * g), n1 = *(const f32x4*)(kvnw + 8 * g + 4);
            u32x4 o; o.x = pk2(bflo(w.x) * rs * n0[0], bfhi(w.x) * rs * n0[1]); o.y = pk2(bflo(w.y) * rs * n0[2], bfhi(w.y) * rs * n0[3]);
            o.z = pk2(bflo(w.z) * rs * n1[0], bfhi(w.z) * rs * n1[1]); o.w = pk2(bflo(w.w) * rs * n1[2], bfhi(w.w) * rs * n1[3]);
            *(u32x4*)(KVB + (size_t)m * 192 + 8 * g) = o;
        } else {
            const int i0 = 4 * (g - 16);
            const u32x2 a = *(const u32x2*)(KVL + (size_t)m * 256 + 128 + i0), b = *(const u32x2*)(KVL + (size_t)m * 256 + 160 + i0);
            const f32x4 cs = *(const f32x4*)(ROPE + (size_t)m * 64 + i0), sn = *(const f32x4*)(ROPE + (size_t)m * 64 + 32 + i0);
            const f32x4 x1 = {bflo(a.x), bfhi(a.x), bflo(a.y), bfhi(a.y)}, x2 = {bflo(b.x), bfhi(b.x), bflo(b.y), bfhi(b.y)};
            const f32x4 o1 = x1 * cs - x2 * sn, o2 = x1 * sn + x2 * cs;
            u32x2 w1, w2; w1.x = pk2(o1[0], o1[1]); w1.y = pk2(o1[2], o1[3]); w2.x = pk2(o2[0], o2[1]); w2.y = pk2(o2[2], o2[3]);
            *(u32x2*)(KVB + (size_t)m * 192 + 128 + i0) = w1; *(u32x2*)(KVB + (size_t)m * 192 + 160 + i0) = w2;
        }
    }
}

__device__ __forceinline__ int ssd_win_col(int g, int o) { return o < 256 ? 256 * g + o : o < 384 ? 512 + 128 * g + (o - 256) : 768 + 128 * g + (o - 384); }
template <int VAR = 0> __device__ __forceinline__ void p3b_ssd(const Ctx& F, int l) {
    constexpr int SC_C = 0, SC_B = 17408, SC_BT = 34816, SC_XST = 53248, SC_CB = 90112, SC_G = 106752, SC_XSD = 115968, SC_DT = 125184, SC_AC = 127232, SC_YS = 129280  , SC_STS = 137472  ;
    static_assert(SC_STS + 16384 <= LDS_BYTES - 256, "ssd lds map");
    LAS bf16_t* Cg = (LAS bf16_t*)(F.lds + SC_C); LAS bf16_t* Bg = (LAS bf16_t*)(F.lds + SC_B); LAS bf16_t* BT = (LAS bf16_t*)(F.lds + SC_BT);
    LAS bf16_t* XST = (LAS bf16_t*)(F.lds + SC_XST); LAS float* CB = (LAS float*)(F.lds + SC_CB); LAS bf16_t* Gh = (LAS bf16_t*)(F.lds + SC_G);
    LAS bf16_t* YS = (LAS bf16_t*)(F.lds + SC_YS); LAS bf16_t* STS = (LAS bf16_t*)(F.lds + SC_STS);
    LAS bf16_t* XSD = (LAS bf16_t*)(F.lds + SC_XSD); LAS float* DT = (LAS float*)(F.lds + SC_DT); LAS float* AC = (LAS float*)(F.lds + SC_AC);
    bf16_t* XBC = (bf16_t*)(F.ws + WS_XBC); const bf16_t* HX = (const bf16_t*)(F.ws + WS_HX); const float* Ff = (const float*)(F.ws + WS_F);
    bf16_t* Cbuf = (bf16_t*)(F.ws + WS_CB); float* ECUM = (float*)(F.ws + WS_ECUM); float* CDEC = (float*)(F.ws + WS_CDEC); bf16_t* YD = (bf16_t*)(F.ws + WS_YD);
    const float* convw = INP(I_CONVW) + (size_t)l * 4 * 1024; const float* convb = INP(I_CONVB) + l * 1024;
    const float* dtb = INP(I_DTB) + l * 8; const float* alog = INP(I_ALOG) + l * 8; const float* dskip = INP(I_DSKIP) + l * 8;
    const int tid = F.tid, lane = F.lane, wave = F.wave;
    for (int c = F.bid; c < NCHK; c += F.G) {
        const int m0 = 64 * c; const bool first = (c & 127) == 0;
        if (wave == 0) {
            const int t = lane;
#pragma unroll
            for (int h = 0; h < 8; ++h) {
                const float raw = Ff[(size_t)(m0 + t) * 144 + 128 + h] + dtb[h];
                const float dt = raw > 20.f ? raw : log1pf(expf(raw));
                float v = dt * (-expf(alog[h]));
#pragma unroll
                for (int o = 1; o < 64; o <<= 1) { const float y = __shfl_up(v, o); if (lane >= o) v += y; }
                DT[h * 64 + t] = dt; AC[h * 64 + t] = v;
                const float ev = expf(v); ECUM[(size_t)(c * 8 + h) * 64 + t] = ev; if (t == 63) CDEC[c * 8 + h] = ev;
            }
        }
        for (int g = 0; g < 2; ++g) {
            if (!(VAR & 1)) {
                const int col = ssd_win_col(g, tid);
                const float w0 = convw[col], w1 = convw[1024 + col], w2 = convw[2048 + col], w3 = convw[3072 + col], cb = convb[col];
                float h0 = 0.f, h1 = 0.f, h2 = 0.f;
                if (!first) { h0 = bf2f(HX[(size_t)((c - 1) * 3 + 0) * 1024 + col]); h1 = bf2f(HX[(size_t)((c - 1) * 3 + 1) * 1024 + col]); h2 = bf2f(HX[(size_t)((c - 1) * 3 + 2) * 1024 + col]); }
                bf16_t xr[64];
#pragma unroll
                for (int t = 0; t < 64; ++t) xr[t] = XBC[(size_t)(m0 + t) * 1024 + col];
#pragma unroll
                for (int t8 = 0; t8 < 64; t8 += 8) {
                    float y[8];
#pragma unroll
                    for (int e = 0; e < 8; ++e) { const float x = bf2f(xr[t8 + e]); const float u = w0 * h0 + w1 * h1 + w2 * h2 + w3 * x + cb; h0 = h1; h1 = h2; h2 = x; y[e] = siluf_(u); }
                    u32x4 o; o.x = pk2(y[0], y[1]); o.y = pk2(y[2], y[3]); o.z = pk2(y[4], y[5]); o.w = pk2(y[6], y[7]);
                    if (tid < 256) *(LAS u32x4*)(XST + tid * 72 + t8) = o;
                    else if (tid < 384) { const int n = tid - 256; *(LAS u32x4*)(BT + n * 72 + t8) = o;
#pragma unroll
                        for (int e = 0; e < 8; ++e) Bg[(t8 + e) * 136 + n] = (bf16_t)f2bf(y[e]); }
                    else { const int n = tid - 384;
#pragma unroll
                        for (int e = 0; e < 8; ++e) Cg[(t8 + e) * 136 + n] = (bf16_t)f2bf(y[e]); }
                }
            }
            __syncthreads();
#pragma unroll
            for (int i = 0; i < 2; ++i) { const int idx = tid + 512 * i, t = idx >> 4, c8 = idx & 15;
                *(u32x4*)(Cbuf + (size_t)(m0 + t) * 256 + g * 128 + c8 * 8) = *(const LAS u32x4*)(Cg + t * 136 + c8 * 8); }
#pragma unroll
            for (int i = 0; i < 2; ++i) { const int idx = 2 * wave + i, ti = idx >> 2, si = idx & 3;
                const f32x4 acc = mma_tile<128>(Cg + ti * 16 * 136, 136, Bg + si * 16 * 136, 136, lane);
#pragma unroll
                for (int r = 0; r < 4; ++r) CB[(ti * 16 + 4 * (lane >> 4) + r) * 68 + si * 16 + (lane & 15)] = acc[r]; }
            __syncthreads();
            if (!(VAR & 2)) {
                const int hl = wave >> 1, hf = wave & 1, h = 4 * g + hl, fr = lane & 15, fk = lane >> 4;
                const LAS float* ACh = AC + h * 64; const LAS float* DTh = DT + h * 64; const float a63 = ACh[63], dsk = dskip[h];
#pragma unroll
                for (int ti2 = 0; ti2 < 2; ++ti2) { const int ti = 2 * hf + ti2, t = 16 * ti + fr; const float at = ACh[t];
                    bf16x8 ga[2];
#pragma unroll
                    for (int ks = 0; ks < 2; ++ks) { const int s0 = 32 * ks + 8 * fk;
                        const f32x4 c0 = *(const LAS f32x4*)(CB + t * 68 + s0), c1 = *(const LAS f32x4*)(CB + t * 68 + s0 + 4), a0 = *(const LAS f32x4*)(ACh + s0), a1 = *(const LAS f32x4*)(ACh + s0 + 4), d0 = *(const LAS f32x4*)(DTh + s0), d1 = *(const LAS f32x4*)(DTh + s0 + 4);
                        float gv[8];
#pragma unroll
                        for (int j = 0; j < 4; ++j) { gv[j] = (s0 + j <= t) ? c0[j] * __expf(at - a0[j]) * d0[j] : 0.f; gv[4 + j] = (s0 + 4 + j <= t) ? c1[j] * __expf(at - a1[j]) * d1[j] : 0.f; }
                        u32x4 w; w.x = pk2(gv[0], gv[1]); w.y = pk2(gv[2], gv[3]); w.z = pk2(gv[4], gv[5]); w.w = pk2(gv[6], gv[7]); ga[ks] = __builtin_bit_cast(bf16x8, w); }
#pragma unroll
                    for (int pi = 0; pi < 4; ++pi) { f32x4 acc = {0.f, 0.f, 0.f, 0.f};
#pragma unroll
                        for (int ks = 0; ks < 2; ++ks) acc = __builtin_amdgcn_mfma_f32_16x16x32_bf16(ga[ks], *(const LAS bf16x8*)(XST + (64 * hl + 16 * pi + fr) * 72 + 32 * ks + 8 * fk), acc, 0, 0, 0);
#pragma unroll
                        for (int r = 0; r < 4; ++r) { const int tt = 16 * ti + 4 * fk + r, pp = 16 * pi + fr;
                            YD[(size_t)(m0 + tt) * 512 + 64 * h + pp] = (bf16_t)f2bf(acc[r] + dsk * bf2f(XST[(64 * hl + pp) * 72 + tt])); } }
                }
                {   float fac[2][8];
#pragma unroll
                    for (int ks = 0; ks < 2; ++ks) { const int s0 = 32 * ks + 8 * fk; const f32x4 a0 = *(const LAS f32x4*)(ACh + s0), a1 = *(const LAS f32x4*)(ACh + s0 + 4), d0 = *(const LAS f32x4*)(DTh + s0), d1 = *(const LAS f32x4*)(DTh + s0 + 4);
#pragma unroll
                        for (int j = 0; j < 4; ++j) { fac[ks][j] = d0[j] * __expf(a63 - a0[j]); fac[ks][4 + j] = d1[j] * __expf(a63 - a1[j]); } }
#pragma unroll
                    for (int pi2 = 0; pi2 < 2; ++pi2) { const int pi = 2 * hf + pi2; bf16x8 xa[2];
#pragma unroll
                        for (int ks = 0; ks < 2; ++ks) { const u32x4 xw = *(const LAS u32x4*)(XST + (64 * hl + 16 * pi + fr) * 72 + 32 * ks + 8 * fk);
                            u32x4 w; w.x = pk2(bflo(xw.x) * fac[ks][0], bfhi(xw.x) * fac[ks][1]); w.y = pk2(bflo(xw.y) * fac[ks][2], bfhi(xw.y) * fac[ks][3]); w.z = pk2(bflo(xw.z) * fac[ks][4], bfhi(xw.z) * fac[ks][5]); w.w = pk2(bflo(xw.w) * fac[ks][6], bfhi(xw.w) * fac[ks][7]);
                            xa[ks] = __builtin_bit_cast(bf16x8, w); }
#pragma unroll
                        for (int ni = 0; ni < 8; ++ni) { f32x4 acc = {0.f, 0.f, 0.f, 0.f};
#pragma unroll
                            for (int ks = 0; ks < 2; ++ks) acc = __builtin_amdgcn_mfma_f32_16x16x32_bf16(xa[ks], *(const LAS bf16x8*)(BT + (16 * ni + fr) * 72 + 32 * ks + 8 * fk), acc, 0, 0, 0);
#pragma unroll
                            for (int r = 0; r < 4; ++r) { const int pp = 16 * pi + 4 * fk + r, n = 16 * ni + fr; const int f = hl * 8192 + pp * 128 + n, wr = f >> 9, col = ssd_win_col(g, f & 511);
                                XBC[(size_t)(m0 + wr) * 1024 + col] = (bf16_t)f2bf(acc[r]); } }
                    }
                }
            }
            __syncthreads();
        }
    }
}

template <int VAR = 0> __device__ __forceinline__ void p3c_rwkv(const Ctx& F, int l) {
    constexpr int M9 = 9216, O_TW = 0, O_AL = 9216, O_SL = 18432, O_MAB = O_SL + 12 * M9  , O_LWF = O_SL + 10 * M9  , O_ICF = O_LWF + 17408, O_WL = O_MAB + 16640  , O_SCR = O_WL + 256, O_PAR = O_SCR + 4224  ;
    static_assert(O_ICF + 17408 <= O_MAB + 16640 && O_PAR + 2048 <= LDS_BYTES - 256, "rwkv lds map");
#define LB() ({ LAS unsigned char* p_ = F.lds; asm volatile("" : "+s"(p_)); p_; })
#define SLOT(i) ((LAS bf16_t*)(L + O_SL + (i) * M9))
#define TW ((LAS bf16_t*)(L + O_TW))
#define AL ((LAS bf16_t*)(L + O_AL))
#define AT SLOT(0)
#define ATt SLOT(1)
#define BTl SLOT(2)
#define KTl SLOT(3)
#define RT SLOT(4)
#define BHt SLOT(5)
#define KH SLOT(6)
#define VT SLOT(7)
#define MI SLOT(8)
#define MakT SLOT(9)
#define Rb SLOT(10)
#define Rk SLOT(11)
#define Attn SLOT(0)
#define KEt SLOT(1)
#define X1t SLOT(2)
#define X2t SLOT(3)
#define S8 SLOT(8)
#define S9 SLOT(9)
#define MAB ((LAS float*)(L + O_MAB))
#define LWf ((LAS float*)(L + O_LWF))
#define ICf ((LAS float*)(L + O_ICF))
#define WL ((LAS float*)(L + O_WL))
#define SCR ((LAS float*)(L + O_SCR))
#define PAR ((LAS float*)(L + O_PAR))
    const int tid = F.tid, lane = F.lane, wave = F.wave;
    for (int c = F.bid; c < NCHK; c += F.G) {
        const int m0 = 64 * c; const bool first = (c & 127) == 0;
        {
            LAS unsigned char* L = LB();
            const int t = tid >> 3, q0 = (tid & 7) * 8;
            const float* Ff = (const float*)(F.ws + WS_F); const float* HF = (const float*)(F.ws + WS_HF); const float* mu_w = INP(I_MUW) + l * 64; const float* mu_a = INP(I_MUA) + l * 64;
            float cw[8], pw[8], ca[8], pa[8];
            const float* cur = Ff + (size_t)(m0 + t) * 144; const float* prv = (t > 0) ? cur - 144 : HF + (size_t)(c - 1) * 128;
#pragma unroll
            for (int j = 0; j < 8; ++j) { cw[j] = cur[q0 + j]; ca[j] = cur[64 + q0 + j]; }
            if (t > 0) {
#pragma unroll
                for (int j = 0; j < 8; ++j) { pw[j] = prv[q0 + j]; pa[j] = prv[64 + q0 + j]; }
            } else if (!first) {
#pragma unroll
                for (int j = 0; j < 8; ++j) { pw[j] = prv[q0 + j]; pa[j] = prv[64 + q0 + j]; }
            } else {
#pragma unroll
                for (int j = 0; j < 8; ++j) { pw[j] = 0.f; pa[j] = 0.f; }
            }
            float ow[8], oa[8];
#pragma unroll
            for (int j = 0; j < 8; ++j) { ow[j] = tanhf(cw[j] + (pw[j] - cw[j]) * mu_w[q0 + j]); oa[j] = ca[j] + (pa[j] - ca[j]) * mu_a[q0 + j]; }
            u32x4 o; o.x = pk2(ow[0], ow[1]); o.y = pk2(ow[2], ow[3]); o.z = pk2(ow[4], ow[5]); o.w = pk2(ow[6], ow[7]); *(LAS u32x4*)(TW + t * 72 + q0) = o;
            o.x = pk2(oa[0], oa[1]); o.y = pk2(oa[2], oa[3]); o.z = pk2(oa[4], oa[5]); o.w = pk2(oa[6], oa[7]); *(LAS u32x4*)(AL + t * 72 + q0) = o;
        }
        u32x4 nlw, nla; float npar;
        auto head_fetch = [&](int h_, int tid_) { const int row = tid_ >> 3, c8 = tid_ & 7; const bf16_t* WLW = (const bf16_t*)(F.ws + WS_WLW); const bf16_t* WLA = (const bf16_t*)(F.ws + WS_WLA);
            nlw = *(const u32x4*)(WLW + (size_t)(h_ * 64 + row) * 64 + c8 * 8); nla = *(const u32x4*)(WLA + (size_t)(h_ * 64 + row) * 64 + c8 * 8);
            const int pi = tid_ >> 6, pc = tid_ & 63;
            const float* src = (pi < 3) ? INP(I_MURKV) + (size_t)l * 1536 + pi * 512 : (pi == 3) ? INP(I_KK) + l * 512 : (pi == 4) ? INP(I_KA) + l * 512 : (pi == 5) ? INP(I_RK) + l * 512 : (pi == 6) ? INP(I_W0) + l * 512 : INP(I_A0) + l * 512;
            npar = src[h_ * 64 + pc]; };
        head_fetch(0, F.tid);
        for (int h = 0; h < 8; ++h) {
            int tid = F.tid, lane = F.lane; asm volatile("" : "+v"(tid), "+v"(lane));
            const int t1 = tid >> 3, ch0 = (tid & 7) * 8, col1 = h * 64 + ch0;
            u32x4 rw, kw, vw, rp = {0u, 0u, 0u, 0u}, kp = rp, vp = rp;
            {   const bf16_t* Rg = (const bf16_t*)(F.ws + WS_R); const bf16_t* Kg = (const bf16_t*)(F.ws + WS_K); const bf16_t* Vg = (const bf16_t*)(F.ws + WS_V); const bf16_t* HR = (const bf16_t*)(F.ws + WS_HRKV);
                const size_t off = (size_t)(m0 + t1) * 512 + col1;
                rw = *(const u32x4*)(Rg + off); kw = *(const u32x4*)(Kg + off); vw = *(const u32x4*)(Vg + off);
                if (t1 > 0) { rp = *(const u32x4*)(Rg + off - 512); kp = *(const u32x4*)(Kg + off - 512); vp = *(const u32x4*)(Vg + off - 512); }
                else if (!first) { const size_t ho = (size_t)(c - 1) * 512 + col1; rp = *(const u32x4*)(HR + ho); kp = *(const u32x4*)(HR + (size_t)NCHK * 512 + ho); vp = *(const u32x4*)(HR + (size_t)2 * NCHK * 512 + ho); } }
            {   LAS unsigned char* L = LB(); const int row = tid >> 3, c8 = tid & 7;
                *(LAS u32x4*)(S8 + row * 72 + c8 * 8) = nlw; *(LAS u32x4*)(S9 + row * 72 + c8 * 8) = nla; PAR[(tid >> 6) * 64 + (tid & 63)] = npar; }
            if (h < 7) head_fetch(h + 1, tid);
            __syncthreads();
            if (!(VAR & 16)) {   LAS unsigned char* L = LB(); const int which = wave >> 2, ci = wave & 3, ch = ci * 16 + (lane & 15), g4 = lane >> 4;
                const float bias = PAR[(6 + which) * 64 + ch]; float carry = 0.f;
#pragma unroll
                for (int ti = 0; ti < 4; ++ti) {
                    const f32x4 acc = mma_tile<64>((which ? AL : TW) + ti * 16 * 72, 72, (which ? S9 : S8) + ci * 16 * 72, 72, lane);
                    if (which == 0) {
                        float a[4];
#pragma unroll
                        for (int r = 0; r < 4; ++r) a[r] = -DECAY_SCALE * sigmoidf_(acc[r] + bias);
                        a[1] += a[0]; a[2] += a[1]; a[3] += a[2];
                        float tot = a[3]; const float u1 = __shfl_up(tot, 16); if (g4 >= 1) tot += u1; const float u2 = __shfl_up(tot, 32); if (g4 >= 2) tot += u2;
                        const float base = carry + tot - a[3];
#pragma unroll
                        for (int r = 0; r < 4; ++r) LWf[(ti * 16 + 4 * g4 + r) * 68 + ch] = base + a[r];
                        carry += __shfl(tot, 48 + (lane & 15));
                    } else {
#pragma unroll
                        for (int r = 0; r < 4; ++r) ICf[(ti * 16 + 4 * g4 + r) * 68 + ch] = sigmoidf_(acc[r] + bias);
                    }
                }
                if (which == 0 && g4 == 0) WL[ch] = __expf(carry);
            }
            __syncthreads();
            float bonv[8] = {0.f, 0.f, 0.f, 0.f, 0.f, 0.f, 0.f, 0.f};
            if (!(VAR & 2)) {   LAS unsigned char* L = LB(); const int t = t1;
                const unsigned rwa[4] = {rw.x, rw.y, rw.z, rw.w}, kwa[4] = {kw.x, kw.y, kw.z, kw.w}, vwa[4] = {vw.x, vw.y, vw.z, vw.w};
                const unsigned rpa[4] = {rp.x, rp.y, rp.z, rp.w}, kpa[4] = {kp.x, kp.y, kp.z, kp.w}, vpa[4] = {vp.x, vp.y, vp.z, vp.w};
                float rs[8], ks[8], vs[8], kkv[8], k2[8], ic[8]; float ss = 0.f, bs = 0.f;
                float pr_[6][8], lwt[8], lwp[8], l63[8];
#pragma unroll
                for (int q = 0; q < 6; ++q) { const f32x4 a = *(const LAS f32x4*)(PAR + q * 64 + ch0), b = *(const LAS f32x4*)(PAR + q * 64 + ch0 + 4);
                    pr_[q][0] = a[0]; pr_[q][1] = a[1]; pr_[q][2] = a[2]; pr_[q][3] = a[3]; pr_[q][4] = b[0]; pr_[q][5] = b[1]; pr_[q][6] = b[2]; pr_[q][7] = b[3]; }
                {   const f32x4 a = *(const LAS f32x4*)(ICf + t * 68 + ch0), b = *(const LAS f32x4*)(ICf + t * 68 + ch0 + 4); ic[0] = a[0]; ic[1] = a[1]; ic[2] = a[2]; ic[3] = a[3]; ic[4] = b[0]; ic[5] = b[1]; ic[6] = b[2]; ic[7] = b[3];
                    const f32x4 c0 = *(const LAS f32x4*)(LWf + t * 68 + ch0), c1 = *(const LAS f32x4*)(LWf + t * 68 + ch0 + 4); lwt[0] = c0[0]; lwt[1] = c0[1]; lwt[2] = c0[2]; lwt[3] = c0[3]; lwt[4] = c1[0]; lwt[5] = c1[1]; lwt[6] = c1[2]; lwt[7] = c1[3];
                    const int tp = (t > 0) ? t - 1 : 0; const f32x4 d0 = *(const LAS f32x4*)(LWf + tp * 68 + ch0), d1 = *(const LAS f32x4*)(LWf + tp * 68 + ch0 + 4); const float pm_ = (t > 0) ? 1.f : 0.f;
                    lwp[0] = d0[0] * pm_; lwp[1] = d0[1] * pm_; lwp[2] = d0[2] * pm_; lwp[3] = d0[3] * pm_; lwp[4] = d1[0] * pm_; lwp[5] = d1[1] * pm_; lwp[6] = d1[2] * pm_; lwp[7] = d1[3] * pm_;
                    const f32x4 e0 = *(const LAS f32x4*)(LWf + 63 * 68 + ch0), e1 = *(const LAS f32x4*)(LWf + 63 * 68 + ch0 + 4); l63[0] = e0[0]; l63[1] = e0[1]; l63[2] = e0[2]; l63[3] = e0[3]; l63[4] = e1[0]; l63[5] = e1[1]; l63[6] = e1[2]; l63[7] = e1[3]; }
#pragma unroll
                for (int j = 0; j < 8; ++j) { const int q = j >> 1;
                    const float r_ = (j & 1) ? bfhi(rwa[q]) : bflo(rwa[q]), rq = (j & 1) ? bfhi(rpa[q]) : bflo(rpa[q]);
                    const float k_ = (j & 1) ? bfhi(kwa[q]) : bflo(kwa[q]), kq = (j & 1) ? bfhi(kpa[q]) : bflo(kpa[q]);
                    const float v_ = (j & 1) ? bfhi(vwa[q]) : bflo(vwa[q]), vq = (j & 1) ? bfhi(vpa[q]) : bflo(vpa[q]);
                    rs[j] = r_ + (rq - r_) * pr_[0][j]; ks[j] = k_ + (kq - k_) * pr_[1][j]; vs[j] = v_ + (vq - v_) * pr_[2][j];
                    kkv[j] = ks[j] * pr_[3][j]; ss += kkv[j] * kkv[j];
                    k2[j] = ks[j] * (1.f + (ic[j] - 1.f) * pr_[4][j]); bs += rs[j] * k2[j] * pr_[5][j]; }
                ss += __shfl_xor(ss, 1); ss += __shfl_xor(ss, 2); ss += __shfl_xor(ss, 4);
                bs += __shfl_xor(bs, 1); bs += __shfl_xor(bs, 2); bs += __shfl_xor(bs, 4);
                const float inv = __builtin_amdgcn_rsqf(fmaxf(ss, 1e-24f));
                float vAT[8], vB[8], vK[8], vR[8], vBH[8], vKH[8];
#pragma unroll
                for (int j = 0; j < 8; ++j) { const int ch = ch0 + j;
                    const float LWt = lwt[j], LWp = lwp[j], L63 = l63[j];
                    const float kk = kkv[j] * inv, a = -kk, b = kk * ic[j];
                    const float e1 = __expf(LWt), e2 = __expf(-LWt), e3 = __expf(LWp), e4 = __expf(L63 - LWt);
                    vAT[j] = a * e3; vB[j] = b * e2; vK[j] = k2[j] * e2; vR[j] = rs[j] * e1; vBH[j] = b * e4; vKH[j] = k2[j] * e4; bonv[j] = bs * vs[j];
                    (void)ch; }
                u32x4 o;
#define PK8(A_) (o[0] = pk2(A_[0], A_[1]), o[1] = pk2(A_[2], A_[3]), o[2] = pk2(A_[4], A_[5]), o[3] = pk2(A_[6], A_[7]), o)
                *(LAS u32x4*)(AT + t * 72 + ch0) = PK8(vAT); *(LAS u32x4*)(BTl + t * 72 + ch0) = PK8(vB); *(LAS u32x4*)(KTl + t * 72 + ch0) = PK8(vK);
                *(LAS u32x4*)(RT + t * 72 + ch0) = PK8(vR); *(LAS u32x4*)(KH + t * 72 + ch0) = PK8(vKH); *(LAS u32x4*)(BHt + t * 72 + ch0) = PK8(vBH); *(LAS u32x4*)(VT + t * 72 + ch0) = PK8(vs);
            }
            __syncthreads();
            { u32x4 o; *(u32x4*)((bf16_t*)(F.ws + WS_V) + (size_t)(m0 + t1) * 512 + col1) = PK8(bonv); }
            if (!(VAR & 8)) { LAS unsigned char* L = LB();
                auto run2 = [&](auto PT) { constexpr int p = decltype(PT)::value;
                    f32x4 acc[8];
#pragma unroll
                    for (int i = 0; i < 8; ++i) { const int idx = 8 * (wave & 1) + i, ti = idx >> 2, si = idx & 3;
                        acc[i] = mma_tile<64>(((p < 2) ? AT : RT) + ti * 16 * 72, 72, ((p & 1) ? KTl : BTl) + si * 16 * 72, 72, lane); }
#pragma unroll
                    for (int i = 0; i < 8; ++i) { const int idx = 8 * (wave & 1) + i, ti = idx >> 2, si = idx & 3;
#pragma unroll
                        for (int r = 0; r < 4; ++r) { const int t = ti * 16 + 4 * (lane >> 4) + r, s = si * 16 + (lane & 15);
                            if (p == 0) MAB[t * 65 + s] = (s < t) ? acc[i][r] : 0.f;
                            else if (p == 1) MakT[s * 72 + t] = (bf16_t)f2bf((s < t) ? acc[i][r] : 0.f);
                            else if (p == 2) Rb[t * 72 + s] = (bf16_t)f2bf((s <= t) ? acc[i][r] : 0.f);
                            else Rk[t * 72 + s] = (bf16_t)f2bf((s <= t) ? acc[i][r] : 0.f); } } };
                const int pw = wave >> 1;
                if (pw == 0) run2(IC<0>{}); else if (pw == 1) run2(IC<1>{}); else if (pw == 2) run2(IC<2>{}); else run2(IC<3>{}); }
            __syncthreads();
            if (!(VAR & 1)) {
            if (wave < 4 && lane < 16) { LAS unsigned char* L = LB(); const int b0 = 16 * wave; float x[16];
#pragma unroll
                for (int t = 0; t < 16; ++t) { float v = (t == lane) ? 1.f : 0.f;
#pragma unroll
                    for (int s = 0; s < 16; ++s) if (s < t) v += MAB[(b0 + t) * 65 + b0 + s] * x[s];
                    x[t] = v; }
#pragma unroll
                for (int t = 0; t < 16; ++t) MAB[(b0 + t) * 65 + b0 + lane] = x[t]; }
            __syncthreads();
            if (wave < 2) { LAS unsigned char* L = LB(); const int pr = wave, rb = pr ? 48 : 16, cb = pr ? 32 : 0, fr = lane & 15, fk = lane >> 4; f32x4 acc = {0.f, 0.f, 0.f, 0.f};
#pragma unroll
                for (int ks = 0; ks < 4; ++ks) acc = __builtin_amdgcn_mfma_f32_16x16x4f32(MAB[(rb + fr) * 65 + cb + 4 * ks + fk], MAB[(cb + 4 * ks + fk) * 65 + cb + fr], acc, 0, 0, 0);
#pragma unroll
                for (int r = 0; r < 4; ++r) SCR[(pr * 16 + 4 * fk + r) * 33 + fr] = acc[r]; }
            __syncthreads();
            if (wave < 2) { LAS unsigned char* L = LB(); const int pr = wave, rb = pr ? 48 : 16, cb = pr ? 32 : 0, fr = lane & 15, fk = lane >> 4; f32x4 acc = {0.f, 0.f, 0.f, 0.f};
#pragma unroll
                for (int ks = 0; ks < 4; ++ks) acc = __builtin_amdgcn_mfma_f32_16x16x4f32(MAB[(rb + fr) * 65 + rb + 4 * ks + fk], SCR[(pr * 16 + 4 * ks + fk) * 33 + fr], acc, 0, 0, 0);
#pragma unroll
                for (int r = 0; r < 4; ++r) MAB[(rb + 4 * fk + r) * 65 + cb + fr] = acc[r]; }
            __syncthreads();
            if (wave < 4) { LAS unsigned char* L = LB(); const int ti = wave >> 1, ci = wave & 1, fr = lane & 15, fk = lane >> 4; f32x4 acc = {0.f, 0.f, 0.f, 0.f};
#pragma unroll
                for (int ks = 0; ks < 8; ++ks) acc = __builtin_amdgcn_mfma_f32_16x16x4f32(MAB[(32 + 16 * ti + fr) * 65 + 4 * ks + fk], MAB[(4 * ks + fk) * 65 + 16 * ci + fr], acc, 0, 0, 0);
#pragma unroll
                for (int r = 0; r < 4; ++r) SCR[(16 * ti + 4 * fk + r) * 33 + 16 * ci + fr] = acc[r]; }
            __syncthreads();
            if (wave < 4) { LAS unsigned char* L = LB(); const int ti = wave >> 1, ci = wave & 1, fr = lane & 15, fk = lane >> 4; f32x4 acc = {0.f, 0.f, 0.f, 0.f};
#pragma unroll
                for (int ks = 0; ks < 8; ++ks) acc = __builtin_amdgcn_mfma_f32_16x16x4f32(MAB[(32 + 16 * ti + fr) * 65 + 32 + 4 * ks + fk], SCR[(4 * ks + fk) * 33 + 16 * ci + fr], acc, 0, 0, 0);
#pragma unroll
                for (int r = 0; r < 4; ++r) MAB[(32 + 16 * ti + 4 * fk + r) * 65 + 16 * ci + fr] = acc[r]; }
            __syncthreads();
            {   LAS unsigned char* L = LB(); const int t = tid >> 3, s0 = (tid & 7) * 8; float x[8];
#pragma unroll
                for (int j = 0; j < 8; ++j) x[j] = MAB[t * 65 + s0 + j];
                u32x4 o; *(LAS u32x4*)(MI + t * 72 + s0) = PK8(x); }
            __syncthreads();
            }
            if (!(VAR & 4)) { LAS unsigned char* L = LB();
#pragma unroll
            for (int i = 0; i < 4; ++i) { const int idx = 4 * wave + i, ti = (idx >> 2) & 3, ci = idx & 3; LAS bf16_t* osel = (wave >> 2) ? X2t : X1t;
                const f32x4 acc = (wave >> 2) ? mma_tile<64>(MI + ti * 16 * 72, 72, MakT + ci * 16 * 72, 72, lane) : mma_tile2<64, false, true>(MI, 72, ti * 16, AT, 72, ci * 16, lane);
#pragma unroll
                for (int r = 0; r < 4; ++r) { const int t = ti * 16 + 4 * (lane >> 4) + r, j = ci * 16 + (lane & 15); osel[j * 72 + t] = (bf16_t)f2bf(acc[r]); } } }
            __syncthreads();
            if (!(VAR & 4)) { LAS unsigned char* L = LB();
                auto run5 = [&](auto PT) { constexpr int p = decltype(PT)::value;
                    f32x4 acc[8];
#pragma unroll
                    for (int i = 0; i < 8; ++i) { const int idx = 8 * (wave & 1) + i, ti = idx >> 2, si = idx & 3;
                        if constexpr (p < 2) acc[i] = mma_tile<64>(Rb + ti * 16 * 72, 72, ((p == 0) ? X1t : X2t) + si * 16 * 72, 72, lane);
                        else acc[i] = mma_tile2<64, false, true>((p == 2) ? X1t : X2t, 72, ti * 16, BHt, 72, si * 16, lane);
#pragma unroll
                        for (int r = 0; r < 4; ++r) { const int rw = ti * 16 + 4 * (lane >> 4) + r, cl = si * 16 + (lane & 15);
                            acc[i][r] += (p == 0) ? bf2f(RT[rw * 72 + cl]) : (p == 1) ? bf2f(Rk[rw * 72 + cl]) : (p == 2) ? ((rw == cl) ? WL[rw] : 0.f) : bf2f(KH[rw * 72 + cl]); } }
#pragma unroll
                    for (int i = 0; i < 8; ++i) { const int idx = 8 * (wave & 1) + i, ti = idx >> 2, si = idx & 3;
#pragma unroll
                        for (int r = 0; r < 4; ++r) { const int rw = ti * 16 + 4 * (lane >> 4) + r, cl = si * 16 + (lane & 15);
                            if (p == 0) SLOT(8)[rw * 64 + pi16(cl)] = (bf16_t)f2bf(acc[i][r]);
                            else if (p == 1) Attn[rw * 72 + cl] = (bf16_t)f2bf(acc[i][r]);
                            else if (p == 2) SLOT(9)[cl * 64 + pi16(rw)] = (bf16_t)f2bf(acc[i][r]);
                            else KEt[cl * 72 + rw] = (bf16_t)f2bf(acc[i][r]); } } };
                const int pw = wave >> 1;
                if (pw == 0) run5(IC<0>{}); else if (pw == 1) run5(IC<1>{}); else if (pw == 2) run5(IC<2>{}); else run5(IC<3>{}); }
            __syncthreads();
            {   LAS unsigned char* L = LB();
                *(u32x4*)((bf16_t*)(F.ws + WS_QE) + (size_t)(c * 8 + h) * 4096 + tid * 8) = *(const LAS u32x4*)(SLOT(8) + tid * 8);
                *(u32x4*)((bf16_t*)(F.ws + WS_TT) + (size_t)(c * 8 + h) * 4096 + tid * 8) = *(const LAS u32x4*)(SLOT(9) + tid * 8); }
            LAS unsigned char* L = LB();
#pragma unroll
            for (int i = 0; i < 4; ++i) { const int idx = 4 * wave + i, which = wave >> 2, ti = (idx >> 2) & 3, ci = idx & 3;
                const f32x4 acc = which ? mma_tile2<64, true, false>(VT, 72, ti * 16, KEt, 72, ci * 16, lane) : mma_tile2<64, false, true>(Attn, 72, ti * 16, VT, 72, ci * 16, lane);
#pragma unroll
                for (int r = 0; r < 4; ++r) { const int rw = ti * 16 + 4 * (lane >> 4) + r, cl = ci * 16 + (lane & 15);
                    const int o = which ? rw * 64 + sg32(cl) : cl * 64 + sg32(rw);
                    (which ? SLOT(3) : SLOT(2))[o] = (bf16_t)f2bf(acc[r]); } }
            __syncthreads();
            {   const int row = tid >> 3, c8 = tid & 7;
                *(u32x4*)((bf16_t*)(F.ws + WS_K) + (size_t)(m0 + row) * 512 + h * 64 + c8 * 8) = *(const LAS u32x4*)(SLOT(2) + tid * 8);
                *(u32x4*)((bf16_t*)(F.ws + WS_R) + (size_t)(m0 + row) * 512 + h * 64 + c8 * 8) = *(const LAS u32x4*)(SLOT(3) + tid * 8); }
        }
        __syncthreads();
    }
#undef SLOT
#undef PK8
#undef LB
#undef TW
#undef AL
#undef AT
#undef ATt
#undef BTl
#undef KTl
#undef RT
#undef BHt
#undef KH
#undef VT
#undef MI
#undef MakT
#undef Rb
#undef Rk
#undef Attn
#undef KEt
#undef X1t
#undef X2t
#undef S8
#undef S9
#undef MAB
#undef LWf
#undef ICf
#undef WL
#undef SCR
#undef PAR
}

__device__ __forceinline__ bf16x8 cvt8(const f32x16& x, int s) {
    u32x4 w; w.x = pk2(x[8 * s + 0], x[8 * s + 1]); w.y = pk2(x[8 * s + 2], x[8 * s + 3]); w.z = pk2(x[8 * s + 4], x[8 * s + 5]); w.w = pk2(x[8 * s + 6], x[8 * s + 7]);
    return __builtin_bit_cast(bf16x8, w);
}
__device__ __forceinline__ f32x16 ld16bf(const bf16_t* p) {
    const u32x4 a = *(const u32x4*)p, b = *(const u32x4*)(p + 8); f32x16 r;
    r[0] = bflo(a.x); r[1] = bfhi(a.x); r[2] = bflo(a.y); r[3] = bfhi(a.y); r[4] = bflo(a.z); r[5] = bfhi(a.z); r[6] = bflo(a.w); r[7] = bfhi(a.w);
    r[8] = bflo(b.x); r[9] = bfhi(b.x); r[10] = bflo(b.y); r[11] = bfhi(b.y); r[12] = bflo(b.z); r[13] = bfhi(b.z); r[14] = bflo(b.w); r[15] = bfhi(b.w); return r;
}
__device__ __forceinline__ void st16bf(bf16_t* p, const f32x16& x) {
    u32x4 a, b; a.x = pk2(x[0], x[1]); a.y = pk2(x[2], x[3]); a.z = pk2(x[4], x[5]); a.w = pk2(x[6], x[7]); b.x = pk2(x[8], x[9]); b.y = pk2(x[10], x[11]); b.z = pk2(x[12], x[13]); b.w = pk2(x[14], x[15]);
    *(u32x4*)p = a; *(u32x4*)(p + 8) = b;
}
__device__ __forceinline__ float max3f(float a, float b, float c) { float r; asm("v_max3_f32 %0, %1, %2, %3" : "=v"(r) : "v"(a), "v"(b), "v"(c)); return r; }
__device__ __forceinline__ int ktile_off(int row, int ch) { return 3072 * (row >> 3) + 512 * (ch >> 2) + 64 * (row & 7) + 16 * ((ch & 3) ^ ((row >> 2) & 3)); }
constexpr int KTILE = 24576;
template <int VAR> __device__ __forceinline__ void attn_unit(const Ctx& F, int b, int c, int hp) {
    const int tid = F.tid, lane = F.lane, wave = F.wave, r32 = lane & 31, hi = lane >> 5, grp = wave >> 2, wq = wave & 3, head = 2 * hp + (wq >> 1);
    const bf16_t* Q = (const bf16_t*)(F.ws + WS_Q); const bf16_t* KV = (const bf16_t*)(F.ws + WS_KVB) + (size_t)b * SEQ * 192; bf16_t* OL = (bf16_t*)(F.ws + WS_OL);
    const size_t mq = (size_t)b * SEQ + 64 * c + 32 * (wq & 1) + r32;
    bf16x8 qr[12];
#pragma unroll
    for (int d0 = 0; d0 < 12; ++d0) qr[d0] = *(const bf16x8*)(Q + mq * 768 + head * 192 + 16 * d0 + 8 * hi);
    {
        const float* rp = (const float*)(F.ws + WS_ROPE) + mq * 64;
#pragma unroll
        for (int d0 = 8; d0 < 10; ++d0) { const int j0 = 16 * (d0 - 8) + 8 * hi;
            const f32x4 c0 = *(const f32x4*)(rp + j0), c1 = *(const f32x4*)(rp + j0 + 4), s0 = *(const f32x4*)(rp + 32 + j0), s1 = *(const f32x4*)(rp + 32 + j0 + 4);
            const u32x4 a = __builtin_bit_cast(u32x4, qr[d0]), bq = __builtin_bit_cast(u32x4, qr[d0 + 2]);
            const float x1[8] = {bflo(a.x), bfhi(a.x), bflo(a.y), bfhi(a.y), bflo(a.z), bfhi(a.z), bflo(a.w), bfhi(a.w)}, x2[8] = {bflo(bq.x), bfhi(bq.x), bflo(bq.y), bfhi(bq.y), bflo(bq.z), bfhi(bq.z), bflo(bq.w), bfhi(bq.w)};
            const float cs[8] = {c0[0], c0[1], c0[2], c0[3], c1[0], c1[1], c1[2], c1[3]}, sn[8] = {s0[0], s0[1], s0[2], s0[3], s1[0], s1[1], s1[2], s1[3]};
            float o1[8], o2[8];
#pragma unroll
            for (int e = 0; e < 8; ++e) { o1[e] = x1[e] * cs[e] - x2[e] * sn[e]; o2[e] = x1[e] * sn[e] + x2[e] * cs[e]; }
            u32x4 w1, w2; w1.x = pk2(o1[0], o1[1]); w1.y = pk2(o1[2], o1[3]); w1.z = pk2(o1[4], o1[5]); w1.w = pk2(o1[6], o1[7]); w2.x = pk2(o2[0], o2[1]); w2.y = pk2(o2[2], o2[3]); w2.z = pk2(o2[4], o2[5]); w2.w = pk2(o2[6], o2[7]);
            qr[d0] = __builtin_bit_cast(bf16x8, w1); qr[d0 + 2] = __builtin_bit_cast(bf16x8, w2); }
    }
    int poff[3]; int goff[3];
#pragma unroll
    for (int i = 0; i < 3; ++i) { const int idx = tid + 512 * i, row = idx / 24, col = idx % 24; poff[i] = ktile_off(row, col); goff[i] = row * 192 + col * 8; }
    const int nt = c + 1, ns = (VAR & 64) ? 0 : (nt + 1) >> 1;
    u32x4 st[6];
#pragma unroll
    for (int i = 0; i < 3; ++i) st[i] = *(const u32x4*)(KV + goff[i]);
    if (nt > 1) {
#pragma unroll
        for (int i = 0; i < 3; ++i) st[3 + i] = *(const u32x4*)(KV + (size_t)64 * 192 + goff[i]);
    }
#pragma unroll
    for (int i = 0; i < 3; ++i) { *(LAS u32x4*)(F.lds + poff[i]) = st[i]; if (nt > 1) *(LAS u32x4*)(F.lds + KTILE + poff[i]) = st[3 + i]; }
    __syncthreads();
    f32x16 o[4];
#pragma unroll
    for (int d = 0; d < 4; ++d)
#pragma unroll
        for (int r = 0; r < 16; ++r) o[d][r] = 0.f;
    float mrun = -1e30f, lrun = 0.f;
    const int kx_ = (r32 >> 2) & 3, kbase = 3072 * (r32 >> 3) + 64 * (r32 & 7), koffE = kbase + 16 * (hi ^ kx_), koffO = kbase + 16 * ((2 + hi) ^ kx_);
    const int tq_ = (lane & 15) >> 2, tp_ = lane & 3, tgl_ = (lane >> 4) & 1, trb = 64 * (4 * hi + tq_) + 8 * (tp_ & 1);
    const int tro0 = trb + 16 * ((2 * tgl_ + (tp_ >> 1)) ^ (hi & 3)), tro1 = trb + 16 * ((2 * tgl_ + (tp_ >> 1)) ^ ((2 + hi) & 3)) + 3072;
    for (int s = 0; s < ns; ++s) {
        const bool more = (s + 1 < ns), more2 = (2 * s + 3 < nt);
        if (more && !(VAR & 1)) {
#pragma unroll
            for (int i = 0; i < 3; ++i) st[i] = *(const u32x4*)(KV + (size_t)(2 * s + 2) * 64 * 192 + goff[i]);
            if (more2) {
#pragma unroll
                for (int i = 0; i < 3; ++i) st[3 + i] = *(const u32x4*)(KV + (size_t)(2 * s + 3) * 64 * 192 + goff[i]);
            }
        }
        if (2 * s + grp < nt) {
            const LAS unsigned char* buf = F.lds + ((s & 1) * 2 + grp) * KTILE;
            f32x16 p0, p1, q0, q1;
#pragma unroll
            for (int r = 0; r < 16; ++r) { p0[r] = 0.f; p1[r] = 0.f; q0[r] = 0.f; q1[r] = 0.f; }
            bf16x8 ka[3][2];
            if (VAR & 32) {
#pragma unroll
                for (int q = 0; q < 3; ++q) { ka[q][0] = qr[q]; ka[q][1] = qr[q + 3]; } }
#define KLD(slot, d0) do { if (VAR & 32) { asm volatile("" : "+v"(ka[slot][0]), "+v"(ka[slot][1])); break; } ka[slot][0] = *(const LAS bf16x8*)(buf + (((d0) & 1) ? koffO : koffE) + 512 * ((d0) >> 1)); ka[slot][1] = *(const LAS bf16x8*)(buf + (((d0) & 1) ? koffO : koffE) + 12288 + 512 * ((d0) >> 1)); } while (0)
            KLD(0, 0); KLD(1, 1); KLD(2, 2);
#pragma unroll
            for (int d0 = 0; d0 < 12; ++d0) {
                __builtin_amdgcn_sched_barrier(0);
                if (VAR & 16) { if (d0 & 1) { q0 = __builtin_amdgcn_mfma_f32_32x32x16_bf16(ka[d0 % 3][0], qr[d0], q0, 0, 0, 0); q1 = __builtin_amdgcn_mfma_f32_32x32x16_bf16(ka[d0 % 3][1], qr[d0], q1, 0, 0, 0); } else { p0 = __builtin_amdgcn_mfma_f32_32x32x16_bf16(ka[d0 % 3][0], qr[d0], p0, 0, 0, 0); p1 = __builtin_amdgcn_mfma_f32_32x32x16_bf16(ka[d0 % 3][1], qr[d0], p1, 0, 0, 0); } }
                else if (!(VAR & 4)) { p0 = __builtin_amdgcn_mfma_f32_32x32x16_bf16(ka[d0 % 3][0], qr[d0], p0, 0, 0, 0); p1 = __builtin_amdgcn_mfma_f32_32x32x16_bf16(ka[d0 % 3][1], qr[d0], p1, 0, 0, 0); } else { asm volatile("" :: "v"(ka[d0 % 3][0]), "v"(ka[d0 % 3][1])); }
                __builtin_amdgcn_sched_barrier(0);
                if (d0 + 3 < 12) KLD(d0 % 3, d0 + 3);
            }
            __builtin_amdgcn_sched_barrier(0);
            if (VAR & 16) {
#pragma unroll
                for (int r = 0; r < 16; ++r) { p0[r] += q0[r]; p1[r] += q1[r]; } }
#undef KLD
            v4i16_t vl[2][4], vh[2][4];
#pragma unroll
            for (int db = 0; db < 4; ++db) { vl[0][db] = __builtin_amdgcn_ds_read_tr16_b64_v4i16((LAS v4i16_t*)(buf + tro0 + 512 * db)); vh[0][db] = __builtin_amdgcn_ds_read_tr16_b64_v4i16((LAS v4i16_t*)(buf + tro1 + 512 * db)); }
            float mx = max3f(p0[0], p1[0], p0[1]), my = max3f(p1[1], p0[2], p1[2]);
#pragma unroll
            for (int r = 3; r < 15; r += 2) { mx = max3f(mx, p0[r], p1[r]); my = max3f(my, p0[r + 1], p1[r + 1]); }
            mx = max3f(mx, my, fmaxf(p0[15], p1[15]));
            mx = fmaxf(mx, __shfl_xor(mx, 32));
            if (!(VAR & 8) && __any(mx > mrun + 8.f)) {
                const float mnew = fmaxf(mrun, mx), alpha = __builtin_amdgcn_exp2f(mrun - mnew); mrun = mnew; lrun *= alpha;
#pragma unroll
                for (int d = 0; d < 4; ++d)
#pragma unroll
                    for (int r = 0; r < 16; ++r) o[d][r] *= alpha;
            }
            float ls = 0.f;
#pragma unroll
            for (int r = 0; r < 16; ++r) { if (!(VAR & 8)) { p0[r] = __builtin_amdgcn_exp2f(p0[r] - mrun); p1[r] = __builtin_amdgcn_exp2f(p1[r] - mrun); } ls += p0[r] + p1[r]; }
            lrun += ls;
#pragma unroll
            for (int ks = 0; ks < 4; ++ks) {
                if (ks + 1 < 4) {
#pragma unroll
                    for (int db = 0; db < 4; ++db) {
                        vl[(ks + 1) & 1][db] = __builtin_amdgcn_ds_read_tr16_b64_v4i16((LAS v4i16_t*)(buf + tro0 + 6144 * (ks + 1) + 512 * db)); vh[(ks + 1) & 1][db] = __builtin_amdgcn_ds_read_tr16_b64_v4i16((LAS v4i16_t*)(buf + tro1 + 6144 * (ks + 1) + 512 * db)); }
                }
                const bf16x8 pb = (ks < 2) ? cvt8(p0, ks & 1) : cvt8(p1, ks & 1);
#pragma unroll
                for (int db = 0; db < 4; ++db) { const v4i16_t lo = vl[ks & 1][db], hh = vh[ks & 1][db];
                    const bf16x8 va = {lo[0], lo[1], lo[2], lo[3], hh[0], hh[1], hh[2], hh[3]};
                    if (!(VAR & 2)) o[db] = __builtin_amdgcn_mfma_f32_32x32x16_bf16(va, pb, o[db], 0, 0, 0); else asm volatile("" :: "v"(va), "v"(pb)); }
            }
        }
        if (more && !(VAR & 1)) {
            LAS unsigned char* nb = F.lds + (((s + 1) & 1) * 2) * KTILE;
#pragma unroll
            for (int i = 0; i < 3; ++i) { *(LAS u32x4*)(nb + poff[i]) = st[i]; if (more2) *(LAS u32x4*)(nb + KTILE + poff[i]) = st[3 + i]; }
        }
        __syncthreads();
    }
    lrun += __shfl_xor(lrun, 32);
    LAS float* xb = (LAS float*)(F.lds + wq * (66 * 64 * 4));
    if (grp == 1) {
#pragma unroll
        for (int d = 0; d < 4; ++d)
#pragma unroll
            for (int r = 0; r < 16; ++r) xb[(d * 16 + r) * 64 + lane] = o[d][r];
        xb[64 * 64 + lane] = mrun; xb[65 * 64 + lane] = lrun;
    }
    __syncthreads();
    if (grp == 0) {
        const float m2 = xb[64 * 64 + lane], l2 = xb[65 * 64 + lane];
        const float mm = fmaxf(mrun, m2), a1 = __builtin_amdgcn_exp2f(mrun - mm), a2 = __builtin_amdgcn_exp2f(m2 - mm);
        const float inv = 1.f / (lrun * a1 + l2 * a2), f1 = a1 * inv, f2 = a2 * inv;
#pragma unroll
        for (int db = 0; db < 4; ++db)
#pragma unroll
            for (int g = 0; g < 4; ++g) { float v[4];
#pragma unroll
                for (int e = 0; e < 4; ++e) v[e] = o[db][4 * g + e] * f1 + xb[(db * 16 + 4 * g + e) * 64 + lane] * f2;
                u32x2 w; w.x = pk2(v[0], v[1]); w.y = pk2(v[2], v[3]);
                *(u32x2*)(OL + mq * 512 + head * 128 + 32 * db + 8 * g + 4 * hi) = w; }
    }
    __syncthreads();
}
struct RwSet { bf16x8 ta[2][4]; u32x4 d[4]; };
__device__ __forceinline__ void rw_load(RwSet& s, const bf16_t* TTg, const bf16_t* Rg, int cg_, int h, int i, int r32, int hi) {
    const bf16_t* TTw = TTg + (size_t)(cg_ * 8 + h) * 4096; const bf16_t* Dw = Rg + ((size_t)64 * cg_ + i) * 512 + h * 64;
#pragma unroll
    for (int a = 0; a < 2; ++a)
#pragma unroll
        for (int s2 = 0; s2 < 4; ++s2) s.ta[a][s2] = *(const bf16x8*)(TTw + (32 * a + r32) * 64 + 16 * s2 + 8 * hi);
    s.d[0] = *(const u32x4*)(Dw + 16 * hi); s.d[1] = *(const u32x4*)(Dw + 16 * hi + 8); s.d[2] = *(const u32x4*)(Dw + 32 + 16 * hi); s.d[3] = *(const u32x4*)(Dw + 32 + 16 * hi + 8);
}
__device__ __forceinline__ f32x16 up16(const u32x4 a, const u32x4 b) { f32x16 r;
    r[0] = bflo(a.x); r[1] = bfhi(a.x); r[2] = bflo(a.y); r[3] = bfhi(a.y); r[4] = bflo(a.z); r[5] = bfhi(a.z); r[6] = bflo(a.w); r[7] = bfhi(a.w);
    r[8] = bflo(b.x); r[9] = bfhi(b.x); r[10] = bflo(b.y); r[11] = bfhi(b.y); r[12] = bflo(b.z); r[13] = bfhi(b.z); r[14] = bflo(b.w); r[15] = bfhi(b.w); return r; }
__device__ __forceinline__ void rw_step(f32x16& X0, f32x16& X1, const RwSet& s, bf16_t* Rg, int cg_, int h, int i, int hi, bool live) {
    const bf16x8 bf[4] = {cvt8(X0, 0), cvt8(X0, 1), cvt8(X1, 0), cvt8(X1, 1)};
    if (live) { bf16_t* Dw = Rg + ((size_t)64 * cg_ + i) * 512 + h * 64;
        *(bf16x8*)(Dw + 16 * hi) = bf[0]; *(bf16x8*)(Dw + 16 * hi + 8) = bf[1]; *(bf16x8*)(Dw + 32 + 16 * hi) = bf[2]; *(bf16x8*)(Dw + 32 + 16 * hi + 8) = bf[3]; }
    f32x16 n0 = up16(s.d[0], s.d[1]), n1 = up16(s.d[2], s.d[3]);
#pragma unroll
    for (int s2 = 0; s2 < 4; ++s2) { n0 = __builtin_amdgcn_mfma_f32_32x32x16_bf16(s.ta[0][s2], bf[s2], n0, 0, 0, 0); n1 = __builtin_amdgcn_mfma_f32_32x32x16_bf16(s.ta[1][s2], bf[s2], n1, 0, 0, 0); }
    X0 = n0; X1 = n1;
}
__device__ __forceinline__ void rwkv_scan(const Ctx& F, int b, int h, int half) {
    const int lane = F.lane, r32 = lane & 31, hi = lane >> 5, i = 32 * half + r32;
    const bf16_t* TTg = (const bf16_t*)(F.ws + WS_TT); bf16_t* Rg = (bf16_t*)(F.ws + WS_R);
    f32x16 X0, X1;
#pragma unroll
    for (int r = 0; r < 16; ++r) { X0[r] = 0.f; X1[r] = 0.f; }
    RwSet sA, sB, sC; const int c0 = b * 128;
    rw_load(sA, TTg, Rg, c0 + 0, h, i, r32, hi); rw_load(sB, TTg, Rg, c0 + 1, h, i, r32, hi); rw_load(sC, TTg, Rg, c0 + 2, h, i, r32, hi);
    for (int c = 0; c < 129; c += 3) {
        rw_step(X0, X1, sA, Rg, c0 + c, h, i, hi, true);          rw_load(sA, TTg, Rg, c0 + min(c + 3, 127), h, i, r32, hi);
        rw_step(X0, X1, sB, Rg, c0 + c + 1, h, i, hi, true);      rw_load(sB, TTg, Rg, c0 + min(c + 4, 127), h, i, r32, hi);
        rw_step(X0, X1, sC, Rg, c0 + min(c + 2, 127), h, i, hi, c + 2 < 128); rw_load(sC, TTg, Rg, c0 + min(c + 5, 127), h, i, r32, hi);
    }
}
__device__ __forceinline__ void ssd_scan(const Ctx& F, int item) {
    const int b = item >> 4, h = (item >> 1) & 7, hp = item & 1, g = h >> 2, hl = h & 3;
    const int piece = hp * 512 + F.tid;
    const int f = hl * 8192 + piece * 8, row = f >> 9, col = ssd_win_col(g, f & 511);
    bf16_t* ST = (bf16_t*)(F.ws + WS_XBC); const float* CDEC = (const float*)(F.ws + WS_CDEC);
    float st[8];
#pragma unroll
    for (int j = 0; j < 8; ++j) st[j] = 0.f;
    for (int c8 = 0; c8 < 128; c8 += 8) {
        u32x4 v[8]; float cd[8];
#pragma unroll
        for (int u = 0; u < 8; ++u) { const int cg_ = b * 128 + c8 + u; v[u] = *(const u32x4*)(ST + ((size_t)64 * cg_ + row) * 1024 + col); cd[u] = CDEC[cg_ * 8 + h]; }
#pragma unroll
        for (int u = 0; u < 8; ++u) { const int cg_ = b * 128 + c8 + u;
            u32x4 o; o.x = pk2(st[0], st[1]); o.y = pk2(st[2], st[3]); o.z = pk2(st[4], st[5]); o.w = pk2(st[6], st[7]);
            *(u32x4*)(ST + ((size_t)64 * cg_ + row) * 1024 + col) = o;
            const float x[8] = {bflo(v[u].x), bfhi(v[u].x), bflo(v[u].y), bfhi(v[u].y), bflo(v[u].z), bfhi(v[u].z), bflo(v[u].w), bfhi(v[u].w)};
#pragma unroll
            for (int j = 0; j < 8; ++j) st[j] = st[j] * cd[u] + x[j]; }
    }
}
constexpr size_t CTL_QUEUE = 32768;
template <int VAR = 0> __device__ __forceinline__ void p4_mix(const Ctx& F, int qslot, int what = 3) {
    const int x = F.bid & 7, li = F.bid >> 3;
    if ((what & 2) && li < 8) { const int st = li * 8 + x;
        if (st < 32) { if (!(what & 8) && F.wave == 0) rwkv_scan(F, st >> 4, (st >> 1) & 7, st & 1); }
        else if (!(what & 4)) ssd_scan(F, st - 32); }
    if (what & 1) {
        unsigned* ctr = (unsigned*)(F.ws + WS_CTL + CTL_QUEUE) + (qslot * 8 + x) * 64;
        volatile LAS int* qw = (volatile LAS int*)(F.lds + LDS_BYTES - 128);
        for (;;) {
            if (F.tid == 0) *qw = (int)__hip_atomic_fetch_add(ctr, 1u, __ATOMIC_RELAXED, __HIP_MEMORY_SCOPE_AGENT);
            __syncthreads();
            const int k = *qw;
            __syncthreads();
            if (k >= 64) break;
            const int rb = 4 * k + (x >> 1), c = 127 - (rb >> 1), hp = rb & 1, b = x & 1;
            attn_unit<VAR>(F, b, c, hp);
        }
    }
}
template <int VAR = 0> __device__ __forceinline__ void p5_assemble(const Ctx& F, int l) {
    bf16_t* GT = (bf16_t*)(F.ws + WS_GATES);
    if (!(VAR & 1)) {   pg8::Gemm g{(const bf16_t*)(F.ws + WS_OL), (const bf16_t*)(F.ws + WS_WUV), NT, 512, 256, 512, 512, 256};     pg8::StaticOrder S; S.init(NT, 512, F.G, F.bid); EpiUV E{GT};
        pg8::gemm_phase<EpiUV, pg8::StaticOrder, true, true>(F.lds, F.wave, g, S, E); }
    __syncthreads();
    int lane = fresh_lane(); const int tid = F.wave * 64 + lane, wave = F.wave;
    const int gw = F.bid * NWAVES + F.wave, NGW = F.G * NWAVES;
    {   constexpr int O_CC = 0, O_YO = 33792;
        const bf16_t* Cbuf = (const bf16_t*)(F.ws + WS_CB); const float* ECUM = (const float*)(F.ws + WS_ECUM); const bf16_t* ST = (const bf16_t*)(F.ws + WS_XBC); const bf16_t* YD = (const bf16_t*)(F.ws + WS_YD);
        const float* snw = INP(I_SSDNW) + l * 512;
        for (int c = F.bid; c < ((VAR & 2) ? 0 : NCHK); c += F.G) {
            const size_t m0 = (size_t)64 * c; const int h = wave, g = h >> 2, hl = h & 3;
            bf16x8 pf[4][4];
#pragma unroll
            for (int pi = 0; pi < 4; ++pi)
#pragma unroll
                for (int ks = 0; ks < 4; ++ks) { const int f = hl * 8192 + (16 * pi + (lane & 15)) * 128 + 32 * ks + 8 * (lane >> 4), row = f >> 9, col = ssd_win_col(g, f & 511);
                    pf[pi][ks] = *(const bf16x8*)(ST + (m0 + row) * 1024 + col); }
            {   LAS bf16_t* CC = (LAS bf16_t*)(F.lds + O_CC);
#pragma unroll
                for (int i = 0; i < 4; ++i) { const int idx = tid + 512 * i, t = idx >> 5, c8 = idx & 31; *(LAS u32x4*)(CC + t * 264 + c8 * 8) = *(const u32x4*)(Cbuf + (m0 + t) * 256 + c8 * 8); } }
            __syncthreads();
            {   const LAS bf16_t* CC = (const LAS bf16_t*)(F.lds + O_CC) + g * 128; LAS bf16_t* YO = (LAS bf16_t*)(F.lds + O_YO);
#pragma unroll
                for (int ti = 0; ti < 4; ++ti) {
                    bf16x8 af[4];
#pragma unroll
                    for (int ks = 0; ks < 4; ++ks) af[ks] = *(const LAS bf16x8*)(CC + (16 * ti + (lane & 15)) * 264 + 32 * ks + 8 * (lane >> 4));
                    float ec[4];
#pragma unroll
                    for (int r = 0; r < 4; ++r) ec[r] = ECUM[(size_t)(c * 8 + h) * 64 + 16 * ti + 4 * (lane >> 4) + r];
#pragma unroll
                    for (int pi = 0; pi < 4; ++pi) { f32x4 acc = {0.f, 0.f, 0.f, 0.f};
#pragma unroll
                        for (int ks = 0; ks < 4; ++ks) acc = __builtin_amdgcn_mfma_f32_16x16x32_bf16(af[ks], pf[pi][ks], acc, 0, 0, 0);
#pragma unroll
                        for (int r = 0; r < 4; ++r) YO[(16 * ti + 4 * (lane >> 4) + r) * 520 + 64 * h + 16 * pi + (lane & 15)] = (bf16_t)f2bf(acc[r] * ec[r]); }
                }
            }
            __syncthreads();
            {   const LAS bf16_t* YO = (const LAS bf16_t*)(F.lds + O_YO);
                u32x4 ydv[8], zv[8];
#pragma unroll
                for (int rr = 0; rr < 8; ++rr) { const int t = 8 * wave + rr; ydv[rr] = *(const u32x4*)(YD + (m0 + t) * 512 + 8 * lane); zv[rr] = *(const u32x4*)(GT + (m0 + t) * 1536 + 512 + 8 * lane); }
                const f32x4 w0 = *(const f32x4*)(snw + 8 * lane), w1 = *(const f32x4*)(snw + 8 * lane + 4);
#pragma unroll
                for (int rr = 0; rr < 8; ++rr) { const int t = 8 * wave + rr; const u32x4 w = *(const LAS u32x4*)(YO + t * 520 + 8 * lane);
                    const unsigned wa[4] = {w.x, w.y, w.z, w.w}, ya[4] = {ydv[rr].x, ydv[rr].y, ydv[rr].z, ydv[rr].w}, za[4] = {zv[rr].x, zv[rr].y, zv[rr].z, zv[rr].w};
                    float v[8]; float q = 0.f;
#pragma unroll
                    for (int j = 0; j < 8; ++j) { const int k2 = j >> 1; const float yo = (j & 1) ? bfhi(wa[k2]) : bflo(wa[k2]), yd = (j & 1) ? bfhi(ya[k2]) : bflo(ya[k2]), zz = (j & 1) ? bfhi(za[k2]) : bflo(za[k2]);
                        v[j] = (yd + yo) * siluf_(zz); q += v[j] * v[j]; }
                    const float rs = __builtin_amdgcn_rsqf(wave_sum(q) * (1.f / 512.f) + EPS);
                    u32x4 o; o.x = pk2(v[0] * rs * w0[0], v[1] * rs * w0[1]); o.y = pk2(v[2] * rs * w0[2], v[3] * rs * w0[3]); o.z = pk2(v[4] * rs * w1[0], v[5] * rs * w1[1]); o.w = pk2(v[6] * rs * w1[2], v[7] * rs * w1[3]);
                    *(u32x4*)(GT + (m0 + t) * 1536 + 512 + 8 * lane) = o; } }
            __syncthreads();
        }
    }
    LAS float* SW = (LAS float*)(F.lds + F.wave * 16640);
    const bf16_t* Yt = (const bf16_t*)(F.ws + WS_K); const bf16_t* SF = (const bf16_t*)(F.ws + WS_R); const bf16_t* QEg = (const bf16_t*)(F.ws + WS_QE);
    const bf16_t* BON = (const bf16_t*)(F.ws + WS_V); const float* lw = INP(I_LNXW) + l * 512; const float* lb = INP(I_LNXB) + l * 512;
    for (int w = gw; w < ((VAR & 4) ? 0 : NCHK * 8); w += NGW) {
        asm volatile("" : "+v"(lane));
        const int cg_ = w >> 3, h = w & 7, r32 = lane & 31, hi = lane >> 5; const size_t m0 = (size_t)64 * cg_;
        const bf16_t* QEw = QEg + (size_t)(cg_ * 8 + h) * 4096;
        bf16x8 qa[2][4];
#pragma unroll
        for (int tb = 0; tb < 2; ++tb)
#pragma unroll
            for (int s2 = 0; s2 < 4; ++s2) qa[tb][s2] = *(const bf16x8*)(QEw + (32 * tb + r32) * 64 + 16 * s2 + 8 * hi);
#pragma unroll
        for (int ih = 0; ih < 2; ++ih) { const size_t ro = (m0 + 32 * ih + r32) * 512 + h * 64;
            const bf16x8 bf[4] = {*(const bf16x8*)(SF + ro + 16 * hi), *(const bf16x8*)(SF + ro + 16 * hi + 8), *(const bf16x8*)(SF + ro + 32 + 16 * hi), *(const bf16x8*)(SF + ro + 32 + 16 * hi + 8)};
#pragma unroll
            for (int tb = 0; tb < 2; ++tb) { f32x16 y = ld16bf(Yt + ro + 32 * tb + 16 * hi);
#pragma unroll
                for (int s2 = 0; s2 < 4; ++s2) y = __builtin_amdgcn_mfma_f32_32x32x16_bf16(qa[tb][s2], bf[s2], y, 0, 0, 0);
#pragma unroll
                for (int r = 0; r < 16; ++r) SW[(32 * tb + crow(r, hi)) * 65 + 32 * ih + r32] = y[r]; } }
        LDS_WAIT();
        {   float y[64]; float sm = 0.f;
#pragma unroll
            for (int i = 0; i < 64; ++i) { y[i] = SW[lane * 65 + i]; sm += y[i]; }
            const float mean = sm * (1.f / 64.f); float q = 0.f;
#pragma unroll
            for (int i = 0; i < 64; ++i) { y[i] -= mean; q += y[i] * y[i]; }
            const float rs = 1.f / sqrtf(q * (1.f / 64.f) + GN_EPS);
#pragma unroll
            for (int i = 0; i < 64; ++i) SW[lane * 65 + i] = y[i] * rs; }
        LDS_WAIT();
        u32x4 bwv[8], gvv[8];
#pragma unroll
        for (int it = 0; it < 8; ++it) { const int t = it * 8 + (lane >> 3), i0 = (lane & 7) * 8; const size_t row = m0 + t;
            bwv[it] = *(const u32x4*)(BON + row * 512 + h * 64 + i0); gvv[it] = *(const u32x4*)(GT + row * 1536 + 1024 + h * 64 + i0); }
#pragma unroll
        for (int it = 0; it < 8; ++it) { const int t = it * 8 + (lane >> 3), i0 = (lane & 7) * 8; const size_t row = m0 + t;
            const u32x4 bw = bwv[it]; u32x4* gp = (u32x4*)(GT + row * 1536 + 1024 + h * 64 + i0); const u32x4 gv = gvv[it];
            const float bo[8] = {bflo(bw.x), bfhi(bw.x), bflo(bw.y), bfhi(bw.y), bflo(bw.z), bfhi(bw.z), bflo(bw.w), bfhi(bw.w)};
            const float gg[8] = {bflo(gv.x), bfhi(gv.x), bflo(gv.y), bfhi(gv.y), bflo(gv.z), bfhi(gv.z), bflo(gv.w), bfhi(gv.w)};
            float ov[8];
#pragma unroll
            for (int j = 0; j < 8; ++j) ov[j] = (SW[t * 65 + i0 + j] * lw[h * 64 + i0 + j] + lb[h * 64 + i0 + j] + bo[j]) * siluf_(gg[j]);
            u32x4 o; o.x = pk2(ov[0], ov[1]); o.y = pk2(ov[2], ov[3]); o.z = pk2(ov[4], ov[5]); o.w = pk2(ov[6], ov[7]); *gp = o; }
        LDS_WAIT();
    }
}
__device__ __forceinline__ void p7_final(const Ctx& F) {
    const int gw = F.bid * NWAVES + F.wave, NGW = F.G * NWAVES; const float* fw = INP(I_FNW);
    for (int m = gw; m < NT; m += NGW) {
        f32x4* xr = (f32x4*)(F.out + (size_t)m * DM) + F.lane; f32x4 v[4]; float s = 0.f;
#pragma unroll
        for (int j = 0; j < 4; ++j) { v[j] = xr[64 * j]; s += v[j].x * v[j].x + v[j].y * v[j].y + v[j].z * v[j].z + v[j].w * v[j].w; }
        const float rstd = 1.f / sqrtf(wave_sum(s) * (1.f / DM) + EPS);
#pragma unroll
        for (int j = 0; j < 4; ++j) xr[64 * j] = v[j] * rstd * *(const f32x4*)(fw + 4 * F.lane + 256 * j);
    }
}

#define RLX_AGENT __ATOMIC_RELAXED, __HIP_MEMORY_SCOPE_AGENT
#define XB_TMO      128
#define XB_XCNT(j)  (256  + 64 * (j))
#define XB_XSUB(j)  (1280 + 64 * (j))
#define XB_XGEN(j)  (2304 + 64 * (j))
#define XB_TOP      3328
#define XB_TOPGEN   3392
#define XCD_BAR_WORDS 3456
#define XB_SPIN_CAP (1u << 18)

__device__ __forceinline__ unsigned xb_ld(unsigned* p)              { return __hip_atomic_load(p, __ATOMIC_RELAXED, __HIP_MEMORY_SCOPE_AGENT); }
__device__ __forceinline__ unsigned xb_add(unsigned* p, unsigned v) { return __hip_atomic_fetch_add(p, v, __ATOMIC_RELAXED, __HIP_MEMORY_SCOPE_AGENT); }
__device__ __forceinline__ unsigned xb_xcc_id() { return (unsigned)__builtin_amdgcn_s_getreg((3 << 11) | 20) & 0xFu; }
#define XB_SPIN(cond, bar) do { unsigned _sp = 0; while (cond) { __builtin_amdgcn_s_sleep(1); \
    if ((++_sp & 255u) == 0u) { if (xb_ld(&(bar)[XB_TMO])) break; if (_sp > XB_SPIN_CAP) { atomicAdd(&(bar)[XB_TMO], 1u); break; } } } } while (0)

struct XcdBarrier {
    unsigned* bar; unsigned x;
    volatile LAS unsigned* st;
};

__device__ __forceinline__ XcdBarrier xcd_barrier_post(unsigned* bar, volatile LAS unsigned* st) {
    XcdBarrier b; b.bar = bar; b.x = xb_xcc_id(); b.st = st;
    if (threadIdx.x == 0) (void)xb_add(&bar[XB_XCNT(b.x)], 1u);
    return b;
}
__device__ __forceinline__ void xcd_barrier_complete(unsigned* bar, unsigned x, unsigned& nloc, unsigned& nx) {
    const unsigned G = gridDim.x * gridDim.y * gridDim.z;
    unsigned sum, cnt, mine, sp = 0u;
    for (;;) {
        sum = 0u; cnt = 0u; mine = 0u;
#pragma unroll
        for (unsigned j = 0; j < 16; ++j) { const unsigned c = xb_ld(&bar[XB_XCNT(j)]); sum += c; cnt += (c > 0u) ? 1u : 0u; mine = (j == x) ? c : mine; }
        if (sum == G) break;
        __builtin_amdgcn_s_sleep(1);
        if ((++sp & 255u) == 0u) { if (xb_ld(&bar[XB_TMO])) break; if (sp > XB_SPIN_CAP) { atomicAdd(&bar[XB_TMO], 1u); break; } }
    }
    nloc = mine > 0u ? mine : 1u; nx = cnt > 0u ? cnt : 1u;
}

__device__ __forceinline__ void xcd_barrier(const XcdBarrier& b) {
    asm volatile("s_waitcnt vmcnt(0)" ::: "memory");
    __syncthreads();
    if (threadIdx.x == 0) {
        unsigned* bar = b.bar;
        __builtin_amdgcn_s_waitcnt(0);
        unsigned nloc = b.st[0], nx = b.st[1];
        if (nloc == 0u) { xcd_barrier_complete(bar, b.x, nloc, nx); b.st[0] = nloc; b.st[1] = nx; }
        const unsigned old = xb_add(&bar[XB_XSUB(b.x)], 1u);
        const unsigned gen = old / nloc;
        if (old + 1u == (gen + 1u) * nloc) {
            __builtin_amdgcn_fence(__ATOMIC_RELEASE, "agent");
            asm volatile("s_waitcnt vmcnt(0)" ::: "memory");
            const unsigned og = xb_add(&bar[XB_TOP], 1u);
            const unsigned tg = og / nx;
            if (og + 1u == (tg + 1u) * nx) xb_add(&bar[XB_TOPGEN], 1u);
            else XB_SPIN(xb_ld(&bar[XB_TOPGEN]) == tg, bar);
            __builtin_amdgcn_fence(__ATOMIC_ACQUIRE, "agent");
            xb_add(&bar[XB_XGEN(b.x)], 1u);
            asm volatile("s_waitcnt vmcnt(0)" ::: "memory");
        } else {
            XB_SPIN(xb_ld(&bar[XB_XGEN(b.x)]) == gen, bar);
            __builtin_amdgcn_fence(__ATOMIC_ACQUIRE, "agent");
            asm volatile("s_waitcnt vmcnt(0)" ::: "memory");
        }
    }
    __syncthreads();
}


#define LAYER(l) do { \
        const int pb = 1 + 8 * l; \
        if (IN(pb + 0)) { PHB(); prep_weights(F, l); if (l == 0) p0_rope(F); p1_norm(F, l); SEAM(pb + 0); } \
        if (IN(pb + 1)) { PHB(); \
            pg8::Gemm g{(const bf16_t*)(F.ws + WS_XN), (const bf16_t*)(F.ws + WS_WIN), NT, NIN, DM, DM, DM}; pg8::StaticOrder S; S.init(NT, NIN, F.G, F.bid); \
            EpiIn E{F.ws, l}; \
            pg8::gemm_phase<EpiIn, pg8::StaticOrder, true, true>(F.lds, F.wave, g, S, E); \
            SEAM(pb + 1); \
        } \
        if (IN(pb + 2)) { PHB(); \
            pg8::Gemm g{(const bf16_t*)(F.ws + WS_QLAT), (const bf16_t*)(F.ws + WS_WQ), NT, 768, 256, 256, 256}; pg8::StaticOrder S; S.init(NT, 768, F.G, F.bid); \
            EpiQ E{F.ws, l}; \
            pg8::gemm_phase<EpiQ, pg8::StaticOrder, true, true>(F.lds, F.wave, g, S, E); \
            p3a_extras(F, l); \
        } \
        if (IN(pb + 3)) { PHB(); p3b_ssd(F, l); __syncthreads(); } \
        if (IN(pb + 4)) { PHB(); p3c_rwkv(F, l); SEAM(pb + 4); } \
        if (IN(pb + 5)) { PHB(); p4_mix(F, l); SEAM(pb + 5); } \
        if (IN(pb + 6)) { PHB(); p5_assemble(F, l); SEAM(pb + 6); } \
        if (IN(pb + 7)) { PHB(); \
            pg8::Gemm g{(const bf16_t*)(F.ws + WS_GATES), (const bf16_t*)(F.ws + WS_WOUT), NT, DM, 1536, 1536, 1536}; pg8::StaticOrder S; S.init(NT, DM, F.G, F.bid); \
            EpiOut E{(l == 0) ? INP(I_X) : F.out, F.out, (const float*)(F.ws + WS_CTL + CTL_MOD) + (size_t)(l * 2) * 3072 + 2048}; \
            pg8::gemm_phase<EpiOut, pg8::StaticOrder, true, true>(F.lds, F.wave, g, S, E); \
            SEAM(pb + 7); \
        } \
    } while (0)
__global__ void __launch_bounds__(NTHR, 2) mk_fwd(Args args) {
    extern __shared__ __attribute__((aligned(16))) unsigned char lds_raw[];
    Ctx F; F.lds = (LAS unsigned char*)lds_raw; F.tid = threadIdx.x; F.lane = F.tid & 63; F.wave = __builtin_amdgcn_readfirstlane(F.tid >> 6);
    F.G = gridDim.x; F.bid = blockIdx.x; F.ws = args.ws; F.out = args.out; F.in = args.in;
    const int wave0 = F.wave;
    cg::grid_group grid = cg::this_grid();
    volatile LAS unsigned* xst = (volatile LAS unsigned*)(F.lds + LDS_BYTES - 256);
    if (threadIdx.x < 2) xst[threadIdx.x] = 0u;
    __syncthreads();
    const XcdBarrier xbar = xcd_barrier_post((unsigned*)(args.ws + WS_CTL) + 4096, xst);
#if MK_PER_PHASE
    const int lo = args.ph_lo, hi = args.ph_hi;
#else
    constexpr int lo = 0, hi = 18;
#endif
#ifndef MK_ONLY
#define MK_ONLY -1
#endif
#define IN(k) (lo <= (k) && (k) < hi && (MK_ONLY < 0 || MK_ONLY == ((k) == 0 ? 0 : (k) == 17 ? 17 : 1 + ((k) - 1) % 8)))
#if MK_PER_PHASE
#define SEAM(k) do { } while (0)
#else
#define SEAM(k) do { xcd_barrier(xbar); } while (0)
#endif
#define PHB() do { int b_ = blockIdx.x, g_ = gridDim.x, v_ = wave0; asm volatile("" : "+s"(b_), "+s"(g_), "+s"(v_)); F.bid = b_; F.G = g_; F.wave = v_; int t_ = v_ * 64 + (int)__builtin_amdgcn_mbcnt_hi(~0u, __builtin_amdgcn_mbcnt_lo(~0u, 0u)); asm volatile("; PHASE_MARK %0" : "+v"(t_)); F.tid = t_; F.lane = t_ & 63; unsigned wl_ = __builtin_amdgcn_readfirstlane((unsigned)(uintptr_t)args.ws), wh_ = __builtin_amdgcn_readfirstlane((unsigned)((uintptr_t)args.ws >> 32)), ol_ = __builtin_amdgcn_readfirstlane((unsigned)(uintptr_t)args.out), oh_ = __builtin_amdgcn_readfirstlane((unsigned)((uintptr_t)args.out >> 32)); asm volatile("" : "+s"(wl_), "+s"(wh_), "+s"(ol_), "+s"(oh_)); F.ws = (unsigned char*)(GAS unsigned char*)(((uintptr_t)wh_ << 32) | wl_); F.out = (float*)(GAS float*)(((uintptr_t)oh_ << 32) | ol_); } while (0)
    if (IN(0)) { PHB(); p0_mod(F); SEAM(0); }
    LAYER(0);
    LAYER(1);
    if (IN(17)) { PHB(); p7_final(F); }
#ifndef MK_RERUN
#define MK_RERUN 0
#endif
#define PHB2() do { int b_ = blockIdx.x, g_ = gridDim.x, v_ = wave0; asm volatile("" : "+s"(b_), "+s"(g_), "+s"(v_)); F.bid = b_; F.G = g_; F.wave = v_; int t_ = v_ * 64 + fresh_lane(); F.tid = t_; F.lane = t_ & 63; } while (0)
#if MK_RERUN
    { constexpr int l = 1;
    if (MK_RERUN & 1) { xcd_barrier(xbar); PHB2(); p1_norm(F, l); }
    if (MK_RERUN & 8192) { xcd_barrier(xbar); PHB2(); prep_weights(F, 1); }
    if (MK_RERUN & 2) { xcd_barrier(xbar); PHB2(); pg8::Gemm g{(const bf16_t*)(F.ws + WS_XN), (const bf16_t*)(F.ws + WS_WIN), NT, NIN, DM, DM, DM}; pg8::StaticOrder S; S.init(NT, NIN, F.G, F.bid); EpiIn E{F.ws, l}; pg8::gemm_phase<EpiIn, pg8::StaticOrder, true, true>(F.lds, F.wave, g, S, E); }
    if (MK_RERUN & 4) { xcd_barrier(xbar); PHB2(); pg8::Gemm g{(const bf16_t*)(F.ws + WS_QLAT), (const bf16_t*)(F.ws + WS_WQ), NT, 768, 256, 256, 256}; pg8::StaticOrder S; S.init(NT, 768, F.G, F.bid); EpiQ E{F.ws, l}; pg8::gemm_phase<EpiQ, pg8::StaticOrder, true, true>(F.lds, F.wave, g, S, E); p3a_extras(F, l); }
    if (MK_RERUN & 8) { xcd_barrier(xbar); PHB2(); p3b_ssd<MK_AVAR>(F, l); }
    if (MK_RERUN & 16) { xcd_barrier(xbar); PHB2(); p3c_rwkv<MK_AVAR>(F, l); }
    if (MK_RERUN & 32) { xcd_barrier(xbar); PHB2(); p4_mix(F, 2); }
#ifndef MK_AVAR
#define MK_AVAR 0
#endif
    if (MK_RERUN & 512) { xcd_barrier(xbar); PHB2(); p4_mix<MK_AVAR>(F, 2, 1); }
    if (MK_RERUN & 1024) { xcd_barrier(xbar); PHB2(); p4_mix(F, 2, 2); }
    if (MK_RERUN & 2048) { xcd_barrier(xbar); PHB2(); p4_mix(F, 2, 2 | 4); }
    if (MK_RERUN & 4096) { xcd_barrier(xbar); PHB2(); p4_mix(F, 2, 2 | 8); }
    if (MK_RERUN & 64) { xcd_barrier(xbar); PHB2(); p5_assemble<MK_AVAR>(F, l); }
    if (MK_RERUN & 128) { xcd_barrier(xbar); PHB2(); pg8::Gemm g{(const bf16_t*)(F.ws + WS_GATES), (const bf16_t*)(F.ws + WS_WOUT), NT, DM, 1536, 1536, 1536}; pg8::StaticOrder S; S.init(NT, DM, F.G, F.bid);
        EpiOut E{INP(I_X), (float*)(F.ws + WS_XBC), (const float*)(F.ws + WS_CTL + CTL_MOD) + (size_t)(l * 2) * 3072 + 2048}; pg8::gemm_phase<EpiOut, pg8::StaticOrder, true, true>(F.lds, F.wave, g, S, E); }
    }
#endif
#undef IN
#undef SEAM
}
constexpr int N_PHASES = 18;

extern "C" void kernel_launch(void* const* d_in, const int* in_sizes, int n_in, void* d_out, int out_size, void* d_ws, size_t ws_size, hipStream_t stream) {
    static int grid = 0;
    if (grid == 0) {
        if (n_in != 31 || out_size != NT * DM || ws_size < WS_END) { fprintf(stderr, "kernel_launch: unexpected shapes (n_in %d, out %d, ws %zu)\n", n_in, out_size, ws_size); grid = -1; return; }
        int dev = 0, cus = 0, per_cu = 0;
        hipGetDevice(&dev); hipDeviceGetAttribute(&cus, hipDeviceAttributeMultiprocessorCount, dev);
        if (hipFuncSetAttribute((const void*)mk_fwd, hipFuncAttributeMaxDynamicSharedMemorySize, LDS_BYTES) != hipSuccess) { fprintf(stderr, "kernel_launch: hipFuncSetAttribute failed\n"); grid = -1; return; }
        hipOccupancyMaxActiveBlocksPerMultiprocessor(&per_cu, (const void*)mk_fwd, NTHR, LDS_BYTES);
        (void)hipGetLastError();
        if (per_cu < 1) per_cu = 1;
        grid = cus;
        fprintf(stderr, "kernel_launch: cus %d, occupancy query %d block(s)/CU, grid %d\n", cus, per_cu, grid);
    }
    if (grid < 0) return;
    hipMemsetAsync((char*)d_ws + WS_CTL, 0, CTL_BYTES, stream);
    Args a{};
    for (int i = 0; i < 31; ++i) a.in[i] = (const float*)d_in[i];
    a.out = (float*)d_out; a.ws = (unsigned char*)d_ws;
#if MK_PER_PHASE
    for (int p = 0; p < N_PHASES; ++p) { a.ph_lo = p; a.ph_hi = p + 1; hipLaunchKernelGGL(mk_fwd, dim3(grid), dim3(NTHR), LDS_BYTES, stream, a); }
#else
    a.ph_lo = 0; a.ph_hi = N_PHASES;
    void* params[] = {&a};
    hipError_t e = hipLaunchCooperativeKernel((const void*)mk_fwd, dim3(grid), dim3(NTHR), params, LDS_BYTES, stream);
    if (e != hipSuccess) fprintf(stderr, "kernel_launch: cooperative launch failed: %s\n", hipGetErrorString(e));
#endif
}
```

```cpp
#include <hip/hip_runtime.h>
#include <hip/hip_cooperative_groups.h>
#include <cstdio>
#include <cstdint>
namespace cg = cooperative_groups;

#define LAS __attribute__((address_space(3)))
#define GAS __attribute__((address_space(1)))
typedef unsigned short bf16_t;
typedef short bf16x8 __attribute__((ext_vector_type(8)));
typedef float f32x4 __attribute__((ext_vector_type(4)));
typedef float f32x2 __attribute__((ext_vector_type(2)));
typedef float f32x16 __attribute__((ext_vector_type(16)));
typedef unsigned u32x4 __attribute__((ext_vector_type(4)));
typedef unsigned u32x2 __attribute__((ext_vector_type(2)));
typedef short v4i16_t __attribute__((ext_vector_type(4)));

#ifndef MK_PER_PHASE
#define MK_PER_PHASE 0
#endif

namespace pg8 {
constexpr int BM = 256, BK = 64, HALF = 128, HTB = HALF * BK * 2, STAGE_BYTES = 8 * HTB, NXCD = 8, WGM = 8;
__host__ __device__ __forceinline__ int lds_byte(int r, int c) { const int st = (r >> 4) * 2 + (c >> 5), rr = r & 15, cc = c & 31, ob = rr * 64 + cc * 2; return st * 1024 + (ob ^ (((ob >> 9) & 1) << 5)); }
__host__ __device__ __forceinline__ void stage_rc(int b, int& R, int& C) { const int st = b / 1024, sb = b % 1024, swz = sb ^ (((sb >> 9) & 1) << 5); R = (st >> 1) * 16 + swz / 64; C = (st & 1) * 32 + (swz % 64) / 2; }
__host__ __device__ __forceinline__ int perm32(int rho) { const int n = rho >> 4, i = rho & 15; return 8 * (i >> 2) + 4 * n + (i & 3); }
struct Unit { int pm, pn; };
struct Gemm { const bf16_t* A; const bf16_t* Bt; int M, N, K, lda, ldb; int kdiag = 0; };
struct StaticOrder {
    int nM, nN, nwg, G, c;
    __host__ __device__ void init(int M, int N, int G_, int c_) { nM = M / BM; nN = N / BM; nwg = nM * nN; G = G_; c = c_; }
    __host__ __device__ bool next(int i, Unit& u) const {
        const long L = (long)i * G + c; if (L >= nwg) return false;
        int wgid = (int)L; { const int q = nwg / NXCD, r = nwg % NXCD, xcd = wgid % NXCD, off = wgid / NXCD; wgid = (xcd < r ? xcd * (q + 1) : r * (q + 1) + (xcd - r) * q) + off; }
        const int nig = WGM * nN, gid = wgid / nig, fm = gid * WGM, gsz = (nM - fm) < WGM ? (nM - fm) : WGM;
        u.pm = fm + ((wgid % nig) % gsz); u.pn = (wgid % nig) / gsz; return true;
    }
};
template <class Epi, class Sched, bool ALIGN_EPI, bool SP2>
__device__ __forceinline__ void gemm_phase(LAS unsigned char* lds, int wave_id, const Gemm g, const Sched& S, const Epi& E) {
    int lane = (int)__builtin_amdgcn_mbcnt_hi(~0u, __builtin_amdgcn_mbcnt_lo(~0u, 0u)); asm volatile("" : "+v"(lane));
    const int wid = wave_id, tid = wid * 64 + lane, wr = wid >> 2, wc = wid & 3, fr = lane & 15, fq = lane >> 4;
    const int K = g.K, nt = K / BK;
    unsigned voffA[2], voffB[2];
#pragma unroll
    for (int i = 0; i < 2; ++i) { int R, C; stage_rc(tid * 16 + i * 8192, R, C); const int Rb = (R & ~31) + perm32(R & 31);
        voffA[i] = (unsigned)(R * g.lda + C) * 2u; voffB[i] = (unsigned)(Rb * g.ldb + C) * 2u; }
    const size_t kstep = (size_t)(BK * 2);
    const size_t hstepA = (size_t)HALF * g.lda * 2, hstepB = (size_t)HALF * g.ldb * 2;
    const size_t tstepA = 2 * hstepA, tstepB = 2 * hstepB;
    const unsigned ldsw = (unsigned)wid * 1024u, lds0 = (unsigned)(uintptr_t)lds;
    const int aoff = lds_byte(wr * 64 + fr, fq * 8), boff = lds_byte(wc * 32 + fr, fq * 8);
#define PG8_SA(b, h) (((b) * 2 + (h)) * HTB)
#define PG8_SB(b, h) ((4 + (b) * 2 + (h)) * HTB)
#define PG8_STAGE(bufoff, gbase, voff) do { _Pragma("unroll") for (int _i = 0; _i < 2; ++_i) { unsigned keep_; \
        asm volatile("s_mov_b32 %0, m0\n\ts_mov_b32 m0, %3\n\ts_nop 0\n\tglobal_load_lds_dwordx4 %1, %2\n\ts_mov_b32 m0, %0" : "=&s"(keep_) : "v"((voff)[_i]), "s"((const char*)(gbase)), "s"(lds0 + (unsigned)(bufoff) + ldsw + (unsigned)(_i * 8192)) : "memory"); } } while (0)
#define PG8_LDA(dst, b, h) do { _Pragma("unroll") for (int m = 0; m < 4; ++m) _Pragma("unroll") for (int k = 0; k < 2; ++k) dst[m][k] = *(const LAS bf16x8*)(lds + PG8_SA(b, h) + aoff + m * 2048 + k * 1024); } while (0)
#define PG8_LDB(dst, b, h) do { _Pragma("unroll") for (int n = 0; n < 2; ++n) _Pragma("unroll") for (int k = 0; k < 2; ++k) dst[n][k] = *(const LAS bf16x8*)(lds + PG8_SB(b, h) + boff + n * 2048 + k * 1024); } while (0)
#define PG8_MMA(ai, bj, At, Bt) do { __builtin_amdgcn_s_setprio(1); _Pragma("unroll") for (int m = 0; m < 4; ++m) _Pragma("unroll") for (int n = 0; n < 2; ++n) _Pragma("unroll") for (int k = 0; k < 2; ++k) \
        acc[ai][bj][m][n] = __builtin_amdgcn_mfma_f32_16x16x32_bf16(Bt[n][k], At[m][k], acc[ai][bj][m][n], 0, 0, 0); __builtin_amdgcn_s_setprio(0); } while (0)
#define PG8_WAIT_V(n) asm volatile("s_waitcnt vmcnt(" #n ")" ::: "memory")
#define PG8_WAIT_L(n) asm volatile("s_waitcnt lgkmcnt(" #n ")" ::: "memory")
#define PG8_BAR __builtin_amdgcn_s_barrier()
#define PG8_SCHED __builtin_amdgcn_sched_barrier(0)
    Unit cur, nxt; int ui = 0;
    if (!S.next(0, cur)) return;
    f32x4 acc[2][2][4][2];
#pragma unroll
    for (int a = 0; a < 2; ++a)
#pragma unroll
        for (int b = 0; b < 2; ++b)
#pragma unroll
            for (int m = 0; m < 4; ++m)
#pragma unroll
                for (int n = 0; n < 2; ++n) acc[a][b][m][n] = (f32x4){0.f, 0.f, 0.f, 0.f};
    bf16x8 At[4][2], B0[2][2], B1[2][2];
    const char* cA = (const char*)g.A + (size_t)cur.pm * tstepA + (size_t)cur.pn * g.kdiag * 2; const char* cB = (const char*)g.Bt + (size_t)cur.pn * tstepB + (size_t)cur.pn * g.kdiag * 2;
    if constexpr (SP2) {
        PG8_STAGE(PG8_SB(0, 0), cB, voffB); PG8_STAGE(PG8_SB(0, 1), cB + hstepB, voffB); PG8_STAGE(PG8_SA(0, 0), cA, voffA); PG8_STAGE(PG8_SA(0, 1), cA + hstepA, voffA);
        if (wr == 1) PG8_BAR;
        PG8_WAIT_V(2); PG8_BAR;
        PG8_STAGE(PG8_SB(1, 0), cB + kstep, voffB); PG8_STAGE(PG8_SA(1, 0), cA + kstep, voffA); PG8_STAGE(PG8_SB(1, 1), cB + hstepB + kstep, voffB);
        PG8_WAIT_V(6); PG8_BAR;
    } else {
        PG8_STAGE(PG8_SB(0, 0), cB, voffB); PG8_STAGE(PG8_SA(0, 0), cA, voffA); PG8_STAGE(PG8_SB(0, 1), cB + hstepB, voffB); PG8_STAGE(PG8_SA(0, 1), cA + hstepA, voffA);
        if (wr == 1) PG8_BAR;
        PG8_WAIT_V(4); PG8_BAR;
        PG8_STAGE(PG8_SB(1, 0), cB + kstep, voffB); PG8_STAGE(PG8_SA(1, 0), cA + kstep, voffA); PG8_STAGE(PG8_SB(1, 1), cB + hstepB + kstep, voffB);
        PG8_WAIT_V(6); PG8_BAR;
    }
    for (;;) {
        const bool has_next = S.next(ui + 1, nxt);
        const char* nA = has_next ? (const char*)g.A + (size_t)nxt.pm * tstepA + (size_t)nxt.pn * g.kdiag * 2 : cA; const char* nB = has_next ? (const char*)g.Bt + (size_t)nxt.pn * tstepB + (size_t)nxt.pn * g.kdiag * 2 : cB;
        for (int t = 0; t < nt; t += 2) {
            const bool last = (t == nt - 2);
            const char* a1 = cA + (size_t)(t + 1) * kstep;
            const char* a2 = last ? nA : cA + (size_t)(t + 2) * kstep; const char* b2 = last ? nB : cB + (size_t)(t + 2) * kstep;
            const char* a3 = a2 + kstep; const char* b3 = b2 + kstep;
            if constexpr (SP2) {
            PG8_LDB(B0, 0, 0); PG8_LDB(B1, 0, 1); PG8_SCHED; PG8_LDA(At, 0, 0); PG8_STAGE(PG8_SA(1, 1), a1 + hstepA, voffA);
            PG8_WAIT_V(8); PG8_WAIT_L(0); PG8_BAR; PG8_MMA(0, 0, At, B0); PG8_MMA(0, 1, At, B1); PG8_BAR; PG8_SCHED;
            PG8_LDA(At, 0, 1); PG8_STAGE(PG8_SB(0, 0), b2, voffB); PG8_STAGE(PG8_SB(0, 1), b2 + hstepB, voffB); PG8_STAGE(PG8_SA(0, 0), a2, voffA);
            PG8_WAIT_V(8); PG8_WAIT_L(0); PG8_BAR; PG8_MMA(1, 0, At, B0); PG8_MMA(1, 1, At, B1); PG8_BAR; PG8_SCHED;
            PG8_LDB(B0, 1, 0); PG8_LDB(B1, 1, 1); PG8_SCHED; PG8_LDA(At, 1, 0); PG8_STAGE(PG8_SA(0, 1), a2 + hstepA, voffA);
            PG8_WAIT_V(8); PG8_WAIT_L(0); PG8_BAR; PG8_MMA(0, 0, At, B0); PG8_MMA(0, 1, At, B1); PG8_BAR; PG8_SCHED;
            PG8_LDA(At, 1, 1); PG8_STAGE(PG8_SB(1, 0), b3, voffB); PG8_STAGE(PG8_SB(1, 1), b3 + hstepB, voffB); PG8_STAGE(PG8_SA(1, 0), a3, voffA);
            PG8_WAIT_V(8); PG8_WAIT_L(0); PG8_BAR; PG8_MMA(1, 0, At, B0); PG8_MMA(1, 1, At, B1); PG8_BAR; PG8_SCHED;
            } else {
            PG8_LDB(B0, 0, 0); PG8_SCHED; PG8_LDA(At, 0, 0); PG8_STAGE(PG8_SA(1, 1), a1 + hstepA, voffA);
            PG8_WAIT_L(8); PG8_BAR; PG8_WAIT_L(0); PG8_MMA(0, 0, At, B0); PG8_BAR; PG8_SCHED;
            PG8_LDB(B1, 0, 1); PG8_STAGE(PG8_SB(0, 0), b2, voffB);
            PG8_BAR; PG8_WAIT_L(0); PG8_MMA(0, 1, At, B1); PG8_BAR;
            PG8_LDA(At, 0, 1); PG8_STAGE(PG8_SA(0, 0), a2, voffA);
            PG8_BAR; PG8_WAIT_L(0); PG8_MMA(1, 0, At, B0); PG8_BAR; PG8_SCHED;
            PG8_STAGE(PG8_SB(0, 1), b2 + hstepB, voffB);
            PG8_WAIT_V(6); PG8_BAR; PG8_MMA(1, 1, At, B1); PG8_BAR;
            PG8_LDB(B0, 1, 0); PG8_SCHED; PG8_LDA(At, 1, 0); PG8_STAGE(PG8_SA(0, 1), a2 + hstepA, voffA);
            PG8_WAIT_L(8); PG8_BAR; PG8_WAIT_L(0); PG8_MMA(0, 0, At, B0); PG8_BAR; PG8_SCHED;
            PG8_LDB(B1, 1, 1); PG8_STAGE(PG8_SB(1, 0), b3, voffB);
            PG8_BAR; PG8_WAIT_L(0); PG8_MMA(0, 1, At, B1); PG8_BAR;
            PG8_LDA(At, 1, 1); PG8_STAGE(PG8_SA(1, 0), a3, voffA);
            PG8_BAR; PG8_WAIT_L(0); PG8_MMA(1, 0, At, B0); PG8_BAR; PG8_SCHED;
            PG8_STAGE(PG8_SB(1, 1), b3 + hstepB, voffB);
            PG8_WAIT_V(6); PG8_BAR; PG8_MMA(1, 1, At, B1); PG8_BAR;
            }
        }
        if constexpr (ALIGN_EPI) { if (wr == 0) PG8_BAR; }
        E(acc, cur, wr, wc, fr, fq);
        if (!has_next) break;
#pragma unroll
        for (int a = 0; a < 2; ++a)
#pragma unroll
            for (int b = 0; b < 2; ++b)
#pragma unroll
                for (int m = 0; m < 4; ++m)
#pragma unroll
                    for (int n = 0; n < 2; ++n) acc[a][b][m][n] = (f32x4){0.f, 0.f, 0.f, 0.f};
        cur = nxt; cA = nA; cB = nB; ++ui;
        if constexpr (ALIGN_EPI) { if (wr == 1) PG8_BAR; }
    }
    PG8_WAIT_V(0);
    if constexpr (!ALIGN_EPI) { if (wr == 0) PG8_BAR; }
    PG8_BAR;
#undef PG8_SA
#undef PG8_SB
#undef PG8_STAGE
#undef PG8_LDA
#undef PG8_LDB
#undef PG8_MMA
#undef PG8_WAIT_V
#undef PG8_WAIT_L
#undef PG8_BAR
#undef PG8_SCHED
}
}

constexpr int NT = 16384, SEQ = 8192, DM = 1024, DIN = 4680, NIN = 4864, NCHK = 256, NWAVES = 8, NTHR = 512;
constexpr float EPS = 1e-6f, GN_EPS = 64e-5f, DECAY_SCALE = 0.606531f;
constexpr float QSCALE = 0.07216878364870322f * 1.4426950408889634f;
constexpr size_t MiB = 1u << 20;
constexpr size_t WS_CTL = 0, CTL_BYTES = 1 * MiB;
constexpr size_t CTL_MOD = 65536;
constexpr size_t CTL_SSQ = 131072;
constexpr size_t WS_WIN = 1 * MiB;
constexpr size_t WS_CB = WS_WIN, WS_ECUM = WS_WIN + 8 * MiB, WS_CDEC = WS_ECUM + 512 * 1024;
constexpr size_t WS_WQ = 10 * MiB + 512 * 1024;
constexpr size_t WS_WUV = 11 * MiB;
constexpr size_t WS_WLW = 11 * MiB + 512 * 1024;
constexpr size_t WS_WLA = WS_WLW + 65536;
constexpr size_t WS_WOUT = 12 * MiB;
constexpr size_t WS_XN = 15 * MiB;
constexpr size_t WS_TT = WS_XN, WS_QE = WS_XN + 16 * MiB;
constexpr size_t WS_QLAT = 47 * MiB, WS_KVL = 55 * MiB;
constexpr size_t WS_OL = WS_QLAT;
constexpr size_t WS_GATES = 63 * MiB;
constexpr size_t WS_XBC = 111 * MiB;
constexpr size_t WS_R = 143 * MiB, WS_K = 159 * MiB, WS_V = 175 * MiB;
constexpr size_t WS_F = 191 * MiB;
constexpr size_t WS_Q = 200 * MiB;
constexpr size_t WS_KVB = 224 * MiB;
constexpr size_t WS_YD = 230 * MiB;
constexpr size_t WS_ROPE = 246 * MiB;
constexpr size_t WS_HX = 250 * MiB;
constexpr size_t WS_HRKV = WS_HX + 1536 * 1024;
constexpr size_t WS_HF = WS_HRKV + 768 * 1024;
constexpr size_t WS_END = 253 * MiB;
constexpr int LDS_BYTES = 152 * 1024;

#define LDS_WAIT() asm volatile("s_waitcnt lgkmcnt(0)" ::: "memory")
typedef __bf16 bf16x2_hw __attribute__((ext_vector_type(2)));
__device__ __forceinline__ unsigned pk2(float lo, float hi) { const f32x2 v = {lo, hi}; return __builtin_bit_cast(unsigned, __builtin_convertvector(v, bf16x2_hw)); }
__device__ __forceinline__ unsigned f2bf(float f) { return pk2(f, 0.f) & 0xffffu; }
__device__ __forceinline__ float bf2f(unsigned short b) { return __builtin_bit_cast(float, (unsigned)b << 16); }
__device__ __forceinline__ float bflo(unsigned w) { return __builtin_bit_cast(float, w << 16); }
__device__ __forceinline__ float bfhi(unsigned w) { return __builtin_bit_cast(float, w & 0xffff0000u); }
__device__ __forceinline__ float wave_sum(float v) {
#pragma unroll
    for (int o = 1; o < 64; o <<= 1) v += __shfl_xor(v, o);
    return v;
}
__device__ __forceinline__ float sigmoidf_(float x) { return __builtin_amdgcn_rcpf(1.f + __expf(-x)); }
__device__ __forceinline__ float siluf_(float x) { return x * __builtin_amdgcn_rcpf(1.f + __expf(-x)); }
__device__ __forceinline__ int pi16(int n) { const int x = n & 15; return (n & ~15) | ((x >= 4 && x < 8) ? x + 4 : (x >= 8 && x < 12) ? x - 4 : x); }
__device__ __forceinline__ int sg32(int x) { return (x & ~31) | (16 * ((x >> 2) & 1) + 4 * ((x & 31) >> 3) + (x & 3)); }
__device__ __forceinline__ int crow(int r, int hi) { return (r & 3) + 8 * (r >> 2) + 4 * hi; }

template <int K> __device__ __forceinline__ f32x4 mma_tile(const LAS bf16_t* A, int lda, const LAS bf16_t* Bt, int ldb, int lane) {
    f32x4 acc = {0.f, 0.f, 0.f, 0.f};
    const LAS bf16_t* ap = A + (lane & 15) * lda + (lane >> 4) * 8;
    const LAS bf16_t* bp = Bt + (lane & 15) * ldb + (lane >> 4) * 8;
#pragma unroll
    for (int k = 0; k < K; k += 32) {
        const bf16x8 a = *(const LAS bf16x8*)(ap + k), b = *(const LAS bf16x8*)(bp + k);
        acc = __builtin_amdgcn_mfma_f32_16x16x32_bf16(a, b, acc, 0, 0, 0);
    }
    return acc;
}

template <int V> struct IC { static constexpr int value = V; };
template <bool KX> __device__ __forceinline__ bf16x8 frag16(const LAS bf16_t* M, int ld, int x0, int k0, int lane) {
    if constexpr (!KX) return *(const LAS bf16x8*)(M + (x0 + (lane & 15)) * ld + k0 + 8 * (lane >> 4));
    else { const LAS bf16_t* p = M + (k0 + 8 * (lane >> 4) + ((lane & 15) >> 2)) * ld + x0 + 4 * (lane & 3);
        const v4i16_t lo = __builtin_amdgcn_ds_read_tr16_b64_v4i16((LAS v4i16_t*)p), hi = __builtin_amdgcn_ds_read_tr16_b64_v4i16((LAS v4i16_t*)(p + 4 * ld));
        return (bf16x8){lo[0], lo[1], lo[2], lo[3], hi[0], hi[1], hi[2], hi[3]}; }
}
template <int K, bool AKX, bool BKX> __device__ __forceinline__ f32x4 mma_tile2(const LAS bf16_t* A, int lda, int m0, const LAS bf16_t* B, int ldb, int n0, int lane) {
    f32x4 acc = {0.f, 0.f, 0.f, 0.f};
#pragma unroll
    for (int k = 0; k < K; k += 32) acc = __builtin_amdgcn_mfma_f32_16x16x32_bf16(frag16<AKX>(A, lda, m0, k, lane), frag16<BKX>(B, ldb, n0, k, lane), acc, 0, 0, 0);
    return acc;
}
struct Args {
    const float* in[31]; float* out; unsigned char* ws; int ph_lo, ph_hi;
};
struct Ctx {
    LAS unsigned char* lds; int tid, lane, wave, G, bid;
    unsigned char* ws; float* out;
    const float* const* in;
};
__device__ __forceinline__ const float* ldin(const float* const* in, int i) { asm volatile("" : "+s"(i)); return (const float*)(const GAS float*)in[i]; }
#define INP(i) ldin(F.in, i)
__device__ __forceinline__ int fresh_lane() { int l_ = (int)__builtin_amdgcn_mbcnt_hi(~0u, __builtin_amdgcn_mbcnt_lo(~0u, 0u)); asm volatile("" : "+v"(l_)); return l_; }
enum { I_X = 0, I_C, I_POS, I_ADAW, I_ADAB, I_NORMW, I_WIN, I_QNW, I_WUQ, I_KVNW, I_WUKV, I_CONVW, I_CONVB, I_DTB, I_ALOG, I_DSKIP, I_SSDNW,
       I_MURKV, I_MUW, I_MUA, I_W0, I_WLB, I_A0, I_ALB, I_KK, I_KA, I_RK, I_LNXW, I_LNXB, I_WOUT, I_FNW };

__device__ __forceinline__ int win_src_col(int n) {
    if (n < 448) return n;
    if (n < 512) return -1;
    if (n < 1024) return 448 + (n - 512);
    if (n < 1536) return 960 + (n - 1024);
    if (n < 2560) return 1472 + (n - 1536);
    if (n < 3072) return 2504 + (n - 2560);
    if (n < 3584) return 3016 + (n - 3072);
    if (n < 4096) return 3528 + (n - 3584);
    if (n < 4608) return 4168 + (n - 4096);
    if (n < 4672) return 4040 + (n - 4608);
    if (n < 4736) return 4104 + (n - 4672);
    if (n < 4744) return 2496 + (n - 4736);
    return -1;
}
template <class Src4> __device__ __forceinline__ void transpose_item(const Src4& src4, bf16_t* WT, int ldw, LAS float* scr, int kb, int nb, int lane) {
    const int k0 = 64 * kb, n0 = 64 * nb;
#pragma unroll 8
    for (int i = 0; i < 16; ++i) { const int kk = 4 * i + (lane >> 4), nn = 4 * (lane & 15); const f32x4 v = src4(k0 + kk, n0 + nn);
        LAS float* d = scr + kk * 65 + nn; d[0] = v[0]; d[1] = v[1]; d[2] = v[2]; d[3] = v[3]; }
    LDS_WAIT();
    const int c = lane & 7;
#pragma unroll
    for (int j = 0; j < 8; ++j) { const int n = (lane >> 3) + 8 * j; const LAS float* sp = scr + (8 * c) * 65 + n;
        u32x4 o; o.x = pk2(sp[0 * 65], sp[1 * 65]); o.y = pk2(sp[2 * 65], sp[3 * 65]); o.z = pk2(sp[4 * 65], sp[5 * 65]); o.w = pk2(sp[6 * 65], sp[7 * 65]);
        *(u32x4*)(WT + (size_t)(n0 + n) * ldw + k0 + 8 * c) = o; }
    LDS_WAIT();
}
__device__ __forceinline__ void prep_weights(const Ctx& F, int l) {
    LAS float* scr = (LAS float*)(F.lds + F.wave * 16640);
    const int gw = F.bid * NWAVES + F.wave, NGW = F.G * NWAVES;
    const float* w_in = INP(I_WIN) + (size_t)l * DM * DIN;
    const float* w_out = INP(I_WOUT) + (size_t)l * 1536 * 1024;
    const float* wlb = INP(I_WLB) + (size_t)l * 64 * 512;
    const float* alb = INP(I_ALB) + (size_t)l * 64 * 512;
    bf16_t* WIN = (bf16_t*)(F.ws + WS_WIN); bf16_t* WOUT = (bf16_t*)(F.ws + WS_WOUT); bf16_t* WLW = (bf16_t*)(F.ws + WS_WLW); bf16_t* WLA = (bf16_t*)(F.ws + WS_WLA);
    constexpr int I_IN = 16 * (NIN / 64), I_OUT = 24 * 16, I_LW = 8, I_LA = 8, NITEMS = I_IN + I_OUT + I_LW + I_LA;
    for (int it = gw; it < NITEMS; it += NGW) {
        int r = it;
        if (r < I_IN) { const int kb = r / (NIN / 64), nb = r % (NIN / 64);
            transpose_item([&](int k, int n) { const int sc = win_src_col(n); return sc >= 0 ? *(const f32x4*)(w_in + (size_t)k * DIN + sc) : (f32x4){0.f, 0.f, 0.f, 0.f}; }, WIN, 1024, scr, kb, nb, F.lane); continue; }
        r -= I_IN;
        if (r < I_OUT) { const int kb = r / 16, nb = r % 16;
            transpose_item([&](int k, int n) { return *(const f32x4*)(w_out + (size_t)k * 1024 + n); }, WOUT, 1536, scr, kb, nb, F.lane); continue; }
        r -= I_OUT;
        if (r < I_LW) { transpose_item([&](int k, int n) { return *(const f32x4*)(wlb + k * 512 + n); }, WLW, 64, scr, 0, r, F.lane); continue; }
        r -= I_LW;
        transpose_item([&](int k, int n) { return *(const f32x4*)(alb + k * 512 + n); }, WLA, 64, scr, 0, r, F.lane);
    }
    const float* wuq = INP(I_WUQ) + (size_t)l * 256 * 768; const float* wukv = INP(I_WUKV) + (size_t)l * 128 * 1024; const float* qnw = INP(I_QNW) + l * 256;
    bf16_t* WQ = (bf16_t*)(F.ws + WS_WQ); bf16_t* WUV = (bf16_t*)(F.ws + WS_WUV);
    const int gt = F.bid * NTHR + F.tid, NGT = F.G * NTHR;
    for (int e = gt; e < 768 * 256; e += NGT) {
        const int n = e >> 8, k = e & 255, h = n / 192, idx = n % 192; float v;
        if (idx < 128) {
            const f32x4* a = (const f32x4*)(wuq + (size_t)k * 768 + h * 192); const f32x4* b = (const f32x4*)(wukv + (size_t)idx * 1024 + h * 256);
            float s = 0.f;
#pragma unroll 8
            for (int d = 0; d < 32; ++d) { const f32x4 x = a[d], y = b[d]; s += x.x * y.x + x.y * y.y + x.z * y.z + x.w * y.w; }
            v = s;
        } else v = wuq[(size_t)k * 768 + n];
        WQ[e] = (bf16_t)f2bf(v * qnw[k]);
    }
    for (int e = gt; e < 512 * 512; e += NGT) {
        const int n = e >> 9, k = e & 511, h = n >> 7, d = n & 127, h2 = k >> 7, c = k & 127;
        WUV[e] = (h == h2) ? (bf16_t)f2bf(wukv[(size_t)c * 1024 + h * 256 + 128 + d]) : (bf16_t)0;
    }
}
__device__ __forceinline__ void p0_mod(const Ctx& F) {
    const int gw = F.bid * NWAVES + F.wave, NGW = F.G * NWAVES;
    float* MOD = (float*)(F.ws + WS_CTL + CTL_MOD);
    for (int it = gw; it < 2 * 12 * 32; it += NGW) {
        const int l = it / 384, r = it % 384, cb = r / 32, ks = r % 32;
        const float* aw = INP(I_ADAW) + (size_t)l * DM * 3072 + (size_t)(ks * 32) * 3072 + cb * 256 + F.lane * 4;
        const float* cc = INP(I_C);
        f32x4 a0 = {0.f, 0.f, 0.f, 0.f}, a1 = a0;
#pragma unroll 8
        for (int k = 0; k < 32; ++k) { const f32x4 w = *(const f32x4*)(aw + (size_t)k * 3072); const float s0 = siluf_(cc[ks * 32 + k]), s1 = siluf_(cc[DM + ks * 32 + k]); a0 += w * s0; a1 += w * s1; }
        if (ks == 0) { const f32x4 bb = *(const f32x4*)(INP(I_ADAB) + l * 3072 + cb * 256 + F.lane * 4); a0 += bb; a1 += bb; }
        float* m0 = MOD + (size_t)(l * 2 + 0) * 3072 + cb * 256 + F.lane * 4; float* m1 = m0 + 3072;
#pragma unroll
        for (int j = 0; j < 4; ++j) { atomicAdd(m0 + j, a0[j]); atomicAdd(m1 + j, a1[j]); }
    }
}
__device__ __forceinline__ void p0_rope(const Ctx& F) {
    float* ROPE = (float*)(F.ws + WS_ROPE); const int* pos = (const int*)INP(I_POS);
    for (int e = F.bid * NTHR + F.tid; e < NT * 32; e += F.G * NTHR) {
        const int m = e >> 5, i = e & 31;
        const float invf = powf(10000.f, -(float)i / 32.f); const float ang = (float)pos[m] * invf;
        const double a = (double)ang; const double kq = __builtin_rint(a * 0.15915494309189535); const float rr = (float)(a - kq * 6.283185307179586);
        ROPE[(size_t)m * 64 + i] = cosf(rr); ROPE[(size_t)m * 64 + 32 + i] = sinf(rr);
    }
}
__device__ __forceinline__ void p1_norm(const Ctx& F, int l) {
    const float* xin = (l == 0) ? INP(I_X) : F.out;
    const float* nw = INP(I_NORMW) + l * DM; const float* MOD = (const float*)(F.ws + WS_CTL + CTL_MOD);
    bf16_t* XN = (bf16_t*)(F.ws + WS_XN);
    const int gw = F.bid * NWAVES + F.wave, NGW = F.G * NWAVES;
    for (int m = gw; m < NT; m += NGW) {
        const int b = m >> 13; const float* md = MOD + (size_t)(l * 2 + b) * 3072;
        const f32x4* xr = (const f32x4*)(xin + (size_t)m * DM) + F.lane;
        f32x4 v[4]; float s = 0.f;
#pragma unroll
        for (int j = 0; j < 4; ++j) { v[j] = xr[64 * j]; s += v[j].x * v[j].x + v[j].y * v[j].y + v[j].z * v[j].z + v[j].w * v[j].w; }
        const float rstd = 1.f / sqrtf(wave_sum(s) * (1.f / DM) + EPS);
        unsigned long long* o8 = (unsigned long long*)(XN + (size_t)m * DM) + F.lane;
#pragma unroll
        for (int j = 0; j < 4; ++j) { const int c0 = 4 * F.lane + 256 * j;
            const f32x4 w = *(const f32x4*)(nw + c0), sh = *(const f32x4*)(md + c0), sc = *(const f32x4*)(md + 1024 + c0);
            const f32x4 y = v[j] * rstd * w * (sc + 1.f) + sh;
            o8[64 * j] = (unsigned long long)pk2(y.x, y.y) | ((unsigned long long)pk2(y.z, y.w) << 32); }
    }
}
__device__ __forceinline__ u32x4 pack8(f32x4 a, f32x4 b) { u32x4 w; w.x = pk2(a[0], a[1]); w.y = pk2(a[2], a[3]); w.z = pk2(b[0], b[1]); w.w = pk2(b[2], b[3]); return w; }
struct EpiIn {
    unsigned char* ws; int l;
    __device__ __forceinline__ void operator()(const f32x4 (&acc)[2][2][4][2], const pg8::Unit& u, int wr, int wc, int fr, int fq) const {
        { int ln_ = (int)__builtin_amdgcn_mbcnt_hi(~0u, __builtin_amdgcn_mbcnt_lo(~0u, 0u)); asm volatile("" : "+v"(ln_)); fr = ln_ & 15; fq = ln_ >> 4; }
        const int pn = u.pn; size_t bo; int ld, c0;
        if (pn == 0) { bo = WS_QLAT; ld = 256; c0 = 0; } else if (pn == 1) { bo = WS_KVL; ld = 256; c0 = 0; }
        else if (pn < 4) { bo = WS_GATES; ld = 1536; c0 = (pn - 2) * 256; } else if (pn < 6) { bo = WS_GATES; ld = 1536; c0 = 512 + (pn - 4) * 256; }
        else if (pn < 10) { bo = WS_XBC; ld = 1024; c0 = (pn - 6) * 256; } else if (pn < 12) { bo = WS_R; ld = 512; c0 = (pn - 10) * 256; }
        else if (pn < 14) { bo = WS_K; ld = 512; c0 = (pn - 12) * 256; } else if (pn < 16) { bo = WS_V; ld = 512; c0 = (pn - 14) * 256; }
        else if (pn < 18) { bo = WS_GATES; ld = 1536; c0 = 1024 + (pn - 16) * 256; } else { bo = WS_F; ld = 144; c0 = 0; }
        bf16_t* base = (bf16_t*)(ws + bo); float* F = (float*)(ws + WS_F);
        float* ssq_q = (float*)(ws + WS_CTL + CTL_SSQ) + (size_t)(l * 2) * NT; float* ssq_kv = ssq_q + NT;
        const int row0 = u.pm * 256 + wr * 64 + fr, col0 = wc * 32 + 8 * fq;
        if (pn < 18) {
#pragma unroll
            for (int ai = 0; ai < 2; ++ai)
#pragma unroll
                for (int m = 0; m < 4; ++m) { const int row = row0 + ai * 128 + m * 16; bf16_t* rp = base + (size_t)row * ld + c0 + col0;
#pragma unroll
                    for (int bj = 0; bj < 2; ++bj) *(u32x4*)(rp + bj * 128) = pack8(acc[ai][bj][m][0], acc[ai][bj][m][1]);
                    if (m == 3 && pn >= 6 && pn < 16) {
                        const int chunk = row >> 6;
                        if (pn < 10) { if (fr >= 13) { bf16_t* hp = (bf16_t*)(ws + WS_HX) + (size_t)(chunk * 3 + (fr - 13)) * 1024 + c0 + col0;
#pragma unroll
                                for (int bj = 0; bj < 2; ++bj) *(u32x4*)(hp + bj * 128) = pack8(acc[ai][bj][m][0], acc[ai][bj][m][1]); } }
                        else if (fr == 15) { bf16_t* hp = (bf16_t*)(ws + WS_HRKV) + (size_t)((pn - 10) >> 1) * NCHK * 512 + (size_t)chunk * 512 + c0 + col0;
#pragma unroll
                            for (int bj = 0; bj < 2; ++bj) *(u32x4*)(hp + bj * 128) = pack8(acc[ai][bj][m][0], acc[ai][bj][m][1]); } }
                    if (pn < 2) { float s = 0.f;
#pragma unroll
                        for (int bj = 0; bj < 2; ++bj) if (pn == 0 || bj == 0) {
#pragma unroll
                            for (int n = 0; n < 2; ++n) { const f32x4 x = acc[ai][bj][m][n]; s += x[0] * x[0] + x[1] * x[1] + x[2] * x[2] + x[3] * x[3]; } }
                        s += __shfl_xor(s, 16); s += __shfl_xor(s, 32);
                        if (fq == 0) atomicAdd((pn == 0 ? ssq_q : ssq_kv) + row, s); } }
        } else {
#pragma unroll
            for (int ai = 0; ai < 2; ++ai)
#pragma unroll
                for (int m = 0; m < 4; ++m) { const int row = row0 + ai * 128 + m * 16;
#pragma unroll
                    for (int bj = 0; bj < 2; ++bj) { const int c = bj * 128 + col0; if (c < 136) { float* fp = F + (size_t)row * 144 + c; *(f32x4*)fp = acc[ai][bj][m][0]; *(f32x4*)(fp + 4) = acc[ai][bj][m][1]; } }
                    if (m == 3 && fr == 15) { float* hf = (float*)(ws + WS_HF) + (size_t)(row >> 6) * 128 + col0; *(f32x4*)hf = acc[ai][0][m][0]; *(f32x4*)(hf + 4) = acc[ai][0][m][1]; } }
        }
    }
};
struct EpiQ {
    unsigned char* ws; int l;
    __device__ __forceinline__ void operator()(const f32x4 (&acc)[2][2][4][2], const pg8::Unit& u, int wr, int wc, int fr, int fq) const {
        { int ln_ = (int)__builtin_amdgcn_mbcnt_hi(~0u, __builtin_amdgcn_mbcnt_lo(~0u, 0u)); asm volatile("" : "+v"(ln_)); fr = ln_ & 15; fq = ln_ >> 4; }
        bf16_t* Q = (bf16_t*)(ws + WS_Q); const float* ssq = (const float*)(ws + WS_CTL + CTL_SSQ) + (size_t)(l * 2) * NT;
        const int row0 = u.pm * 256 + wr * 64 + fr, c0 = u.pn * 256 + wc * 32 + 8 * fq;
#pragma unroll
        for (int ai = 0; ai < 2; ++ai)
#pragma unroll
            for (int m = 0; m < 4; ++m) { const int row = row0 + ai * 128 + m * 16; const float sc = QSCALE / sqrtf(ssq[row] * (1.f / 256.f) + EPS); bf16_t* qp = Q + (size_t)row * 768 + c0;
#pragma unroll
                for (int bj = 0; bj < 2; ++bj) *(u32x4*)(qp + bj * 128) = pack8(acc[ai][bj][m][0] * sc, acc[ai][bj][m][1] * sc); }
    }
};
struct EpiUV {
    bf16_t* gates;
    __device__ __forceinline__ void operator()(const f32x4 (&acc)[2][2][4][2], const pg8::Unit& u, int wr, int wc, int fr, int fq) const {
        { int ln_ = (int)__builtin_amdgcn_mbcnt_hi(~0u, __builtin_amdgcn_mbcnt_lo(~0u, 0u)); asm volatile("" : "+v"(ln_)); fr = ln_ & 15; fq = ln_ >> 4; }
        const int row0 = u.pm * 256 + wr * 64 + fr;
#pragma unroll
        for (int ai = 0; ai < 2; ++ai)
#pragma unroll
            for (int m = 0; m < 4; ++m) { asm volatile("" ::: "memory"); const int row = row0 + ai * 128 + m * 16;
#pragma unroll
                for (int bj = 0; bj < 2; ++bj) { const int c = u.pn * 256 + bj * 128 + wc * 32 + 8 * fq; u32x4* gp = (u32x4*)(gates + (size_t)row * 1536 + c); const u32x4 gw = *gp;
                    f32x4 v0 = acc[ai][bj][m][0], v1 = acc[ai][bj][m][1];
                    v0[0] *= siluf_(bflo(gw.x)); v0[1] *= siluf_(bfhi(gw.x)); v0[2] *= siluf_(bflo(gw.y)); v0[3] *= siluf_(bfhi(gw.y));
                    v1[0] *= siluf_(bflo(gw.z)); v1[1] *= siluf_(bfhi(gw.z)); v1[2] *= siluf_(bflo(gw.w)); v1[3] *= siluf_(bfhi(gw.w));
                    *gp = pack8(v0, v1); } }
    }
};
struct EpiOut {
    const float* xin; float* xout; const float* gate;
    __device__ __forceinline__ void operator()(const f32x4 (&acc)[2][2][4][2], const pg8::Unit& u, int wr, int wc, int fr, int fq) const {
        { int ln_ = (int)__builtin_amdgcn_mbcnt_hi(~0u, __builtin_amdgcn_mbcnt_lo(~0u, 0u)); asm volatile("" : "+v"(ln_)); fr = ln_ & 15; fq = ln_ >> 4; }
        const int row0 = u.pm * 256 + wr * 64 + fr;
#pragma unroll
        for (int bj = 0; bj < 2; ++bj) { const int c = u.pn * 256 + bj * 128 + wc * 32 + 8 * fq;
#pragma unroll
            for (int ai = 0; ai < 2; ++ai)
#pragma unroll
                for (int m = 0; m < 4; ++m) { const int row = row0 + ai * 128 + m * 16; const float* gp = gate + (size_t)(row >> 13) * 3072 + c;
                    const f32x4 g0 = *(const f32x4*)gp, g1 = *(const f32x4*)(gp + 4);
                    const size_t off = (size_t)row * DM + c; const f32x4 x0 = *(const f32x4*)(xin + off), x1 = *(const f32x4*)(xin + off + 4);
                    *(f32x4*)(xout + off) = x0 + g0 * acc[ai][bj][m][0]; *(f32x4*)(xout + off + 4) = x1 + g1 * acc[ai][bj][m][1]; } }
    }
};

__device__ __forceinline__ void p3a_extras(const Ctx& F, int l) {
    const int tid_ = F.wave * 64 + fresh_lane();
    const int gt = F.bid * NTHR + tid_, NGT = F.G * NTHR;
    const bf16_t* KVL = (const bf16_t*)(F.ws + WS_KVL); bf16_t* KVB = (bf16_t*)(F.ws + WS_KVB);
    const float* ssq = (const float*)(F.ws + WS_CTL + CTL_SSQ) + (size_t)(l * 2 + 1) * NT; const float* kvnw = INP(I_KVNW) + l * 128;
    const float* ROPE = (const float*)(F.ws + WS_ROPE);
    for (int e = gt; e < NT * 24; e += NGT) {
        const int m = e / 24, g = e % 24;
        if (g < 16) {
            const u32x4 w = *(const u32x4*)(KVL + (size_t)m * 256 + 8 * g); const float rs = 1.f / sqrtf(ssq[m] * (1.f / 128.f) + EPS);
            const f32x4 n0 = *(const f32x4*)(kvnw + 8 * g), n1 = *(const f32x4*)(kvnw + 8 * g + 4);
            u32x4 o; o.x = pk2(bflo(w.x) * rs * n0[0], bfhi(w.x) * rs * n0[1]); o.y = pk2(bflo(w.y) * rs * n0[2], bfhi(w.y) * rs * n0[3]);
            o.z = pk2(bflo(w.z) * rs * n1[0], bfhi(w.z) * rs * n1[1]); o.w = pk2(bflo(w.w) * rs * n1[2], bfhi(w.w) * rs * n1[3]);
            *(u32x4*)(KVB + (size_t)m * 192 + 8 * g) = o;
        } else {
            const int i0 = 4 * (g - 16);
            const u32x2 a = *(const u32x2*)(KVL + (size_t)m * 256 + 128 + i0), b = *(const u32x2*)(KVL + (size_t)m * 256 + 160 + i0);
            const f32x4 cs = *(const f32x4*)(ROPE + (size_t)m * 64 + i0), sn = *(const f32x4*)(ROPE + (size_t)m * 64 + 32 + i0);
            const f32x4 x1 = {bflo(a.x), bfhi(a.x), bflo(a.y), bfhi(a.y)}, x2 = {bflo(b.x), bfhi(b.x), bflo(b.y), bfhi(b.y)};
            const f32x4 o1 = x1 * cs - x2 * sn, o2 = x1 * sn + x2 * cs;
            u32x2 w1, w2; w1.x = pk2(o1[0], o1[1]); w1.y = pk2(o1[2], o1[3]); w2.x = pk2(o2[0], o2[1]); w2.y = pk2(o2[2], o2[3]);
            *(u32x2*)(KVB + (size_t)m * 192 + 128 + i0) = w1; *(u32x2*)(KVB + (size_t)m * 192 + 160 + i0) = w2;
        }
    }
}

__device__ __forceinline__ int ssd_win_col(int g, int o) { return o < 256 ? 256 * g + o : o < 384 ? 512 + 128 * g + (o - 256) : 768 + 128 * g + (o - 384); }
template <int VAR = 0> __device__ __forceinline__ void p3b_ssd(const Ctx& F, int l) {
    constexpr int SC_C = 0, SC_B = 17408, SC_BT = 34816, SC_XST = 53248, SC_CB = 90112, SC_G = 106752, SC_XSD = 115968, SC_DT = 125184, SC_AC = 127232, SC_YS = 129280  , SC_STS = 137472  ;
    static_assert(SC_STS + 16384 <= LDS_BYTES - 256, "ssd lds map");
    LAS bf16_t* Cg = (LAS bf16_t*)(F.lds + SC_C); LAS bf16_t* Bg = (LAS bf16_t*)(F.lds + SC_B); LAS bf16_t* BT = (LAS bf16_t*)(F.lds + SC_BT);
    LAS bf16_t* XST = (LAS bf16_t*)(F.lds + SC_XST); LAS float* CB = (LAS float*)(F.lds + SC_CB); LAS bf16_t* Gh = (LAS bf16_t*)(F.lds + SC_G);
    LAS bf16_t* YS = (LAS bf16_t*)(F.lds + SC_YS); LAS bf16_t* STS = (LAS bf16_t*)(F.lds + SC_STS);
    LAS bf16_t* XSD = (LAS bf16_t*)(F.lds + SC_XSD); LAS float* DT = (LAS float*)(F.lds + SC_DT); LAS float* AC = (LAS float*)(F.lds + SC_AC);
    bf16_t* XBC = (bf16_t*)(F.ws + WS_XBC); const bf16_t* HX = (const bf16_t*)(F.ws + WS_HX); const float* Ff = (const float*)(F.ws + WS_F);
    bf16_t* Cbuf = (bf16_t*)(F.ws + WS_CB); float* ECUM = (float*)(F.ws + WS_ECUM); float* CDEC = (float*)(F.ws + WS_CDEC); bf16_t* YD = (bf16_t*)(F.ws + WS_YD);
    const float* convw = INP(I_CONVW) + (size_t)l * 4 * 1024; const float* convb = INP(I_CONVB) + l * 1024;
    const float* dtb = INP(I_DTB) + l * 8; const float* alog = INP(I_ALOG) + l * 8; const float* dskip = INP(I_DSKIP) + l * 8;
    const int tid = F.tid, lane = F.lane, wave = F.wave;
    for (int c = F.bid; c < NCHK; c += F.G) {
        const int m0 = 64 * c; const bool first = (c & 127) == 0;
        {
            const int t = lane;
            { const int h = wave;
                const float raw = Ff[(size_t)(m0 + t) * 144 + 128 + h] + dtb[h];
                const float dt = raw > 20.f ? raw : log1pf(expf(raw));
                float v = dt * (-expf(alog[h]));
#pragma unroll
                for (int o = 1; o < 64; o <<= 1) { const float y = __shfl_up(v, o); if (lane >= o) v += y; }
                DT[h * 64 + t] = dt; AC[h * 64 + t] = v;
                const float ev = expf(v); ECUM[(size_t)(c * 8 + h) * 64 + t] = ev; if (t == 63) CDEC[c * 8 + h] = ev;
            }
        }
        for (int g = 0; g < 2; ++g) {
            if (!(VAR & 1)) {
                const int cgp = tid & 63, rg = tid >> 6, col = ssd_win_col(g, 8 * cgp), t0 = 8 * rg;
                u32x4 xr[11];
#pragma unroll
                for (int i = 0; i < 11; ++i) { const int t = t0 - 3 + i;
                    if (t >= 0) xr[i] = *(const u32x4*)(XBC + (size_t)(m0 + t) * 1024 + col);
                    else if (!first) xr[i] = *(const u32x4*)(HX + (size_t)((c - 1) * 3 + i) * 1024 + col);
                    else xr[i] = (u32x4){0u, 0u, 0u, 0u}; }
                float wv[4][8], bv8[8];
#pragma unroll
                for (int j = 0; j < 4; ++j) { const f32x4 a = *(const f32x4*)(convw + j * 1024 + col), b2 = *(const f32x4*)(convw + j * 1024 + col + 4);
                    wv[j][0] = a[0]; wv[j][1] = a[1]; wv[j][2] = a[2]; wv[j][3] = a[3]; wv[j][4] = b2[0]; wv[j][5] = b2[1]; wv[j][6] = b2[2]; wv[j][7] = b2[3]; }
                { const f32x4 a = *(const f32x4*)(convb + col), b2 = *(const f32x4*)(convb + col + 4); bv8[0] = a[0]; bv8[1] = a[1]; bv8[2] = a[2]; bv8[3] = a[3]; bv8[4] = b2[0]; bv8[5] = b2[1]; bv8[6] = b2[2]; bv8[7] = b2[3]; }
                float y[8][8];
#pragma unroll
                for (int e = 0; e < 8; ++e) {
                    const unsigned x0[4] = {xr[e].x, xr[e].y, xr[e].z, xr[e].w}, x1[4] = {xr[e + 1].x, xr[e + 1].y, xr[e + 1].z, xr[e + 1].w}, x2[4] = {xr[e + 2].x, xr[e + 2].y, xr[e + 2].z, xr[e + 2].w}, x3[4] = {xr[e + 3].x, xr[e + 3].y, xr[e + 3].z, xr[e + 3].w};
#pragma unroll
                    for (int k = 0; k < 8; ++k) { const int q = k >> 1;
                        const float a0 = (k & 1) ? bfhi(x0[q]) : bflo(x0[q]), a1 = (k & 1) ? bfhi(x1[q]) : bflo(x1[q]), a2 = (k & 1) ? bfhi(x2[q]) : bflo(x2[q]), a3 = (k & 1) ? bfhi(x3[q]) : bflo(x3[q]);
                        y[e][k] = siluf_(wv[0][k] * a0 + wv[1][k] * a1 + wv[2][k] * a2 + wv[3][k] * a3 + bv8[k]); } }
                if (cgp >= 32) { LAS bf16_t* nat = (cgp < 48) ? Bg + 8 * (cgp - 32) : Cg + 8 * (cgp - 48);
#pragma unroll
                    for (int e = 0; e < 8; ++e) { u32x4 o; o.x = pk2(y[e][0], y[e][1]); o.y = pk2(y[e][2], y[e][3]); o.z = pk2(y[e][4], y[e][5]); o.w = pk2(y[e][6], y[e][7]); *(LAS u32x4*)(nat + (t0 + e) * 136) = o; } }
                if (cgp < 48) { LAS bf16_t* trn = (cgp < 32) ? XST + (8 * cgp) * 72 : BT + (8 * (cgp - 32)) * 72;
#pragma unroll
                    for (int k = 0; k < 8; ++k) { u32x4 o; o.x = pk2(y[0][k], y[1][k]); o.y = pk2(y[2][k], y[3][k]); o.z = pk2(y[4][k], y[5][k]); o.w = pk2(y[6][k], y[7][k]); *(LAS u32x4*)(trn + k * 72 + t0) = o; } }
            }
            __syncthreads();
#pragma unroll
            for (int i = 0; i < 2; ++i) { const int idx = tid + 512 * i, t = idx >> 4, c8 = idx & 15;
                *(u32x4*)(Cbuf + (size_t)(m0 + t) * 256 + g * 128 + c8 * 8) = *(const LAS u32x4*)(Cg + t * 136 + c8 * 8); }
#pragma unroll
            for (int i = 0; i < 2; ++i) { const int idx = 2 * wave + i, ti = idx >> 2, si = idx & 3;
                const f32x4 acc = mma_tile<128>(Cg + ti * 16 * 136, 136, Bg + si * 16 * 136, 136, lane);
#pragma unroll
                for (int r = 0; r < 4; ++r) CB[(ti * 16 + 4 * (lane >> 4) + r) * 68 + si * 16 + (lane & 15)] = acc[r]; }
            __syncthreads();
            if (!(VAR & 2)) {
                const int hl = wave >> 1, hf = wave & 1, h = 4 * g + hl, fr = lane & 15, fk = lane >> 4;
                const LAS float* ACh = AC + h * 64; const LAS float* DTh = DT + h * 64; const float a63 = ACh[63], dsk = dskip[h];
#pragma unroll
                for (int ti2 = 0; ti2 < 2; ++ti2) { const int ti = 2 * hf + ti2, t = 16 * ti + fr; const float at = ACh[t];
                    bf16x8 ga[2];
#pragma unroll
                    for (int ks = 0; ks < 2; ++ks) { const int s0 = 32 * ks + 8 * fk;
                        const f32x4 c0 = *(const LAS f32x4*)(CB + t * 68 + s0), c1 = *(const LAS f32x4*)(CB + t * 68 + s0 + 4), a0 = *(const LAS f32x4*)(ACh + s0), a1 = *(const LAS f32x4*)(ACh + s0 + 4), d0 = *(const LAS f32x4*)(DTh + s0), d1 = *(const LAS f32x4*)(DTh + s0 + 4);
                        float gv[8];
#pragma unroll
                        for (int j = 0; j < 4; ++j) { gv[j] = (s0 + j <= t) ? c0[j] * __expf(at - a0[j]) * d0[j] : 0.f; gv[4 + j] = (s0 + 4 + j <= t) ? c1[j] * __expf(at - a1[j]) * d1[j] : 0.f; }
                        u32x4 w; w.x = pk2(gv[0], gv[1]); w.y = pk2(gv[2], gv[3]); w.z = pk2(gv[4], gv[5]); w.w = pk2(gv[6], gv[7]); ga[ks] = __builtin_bit_cast(bf16x8, w); }
#pragma unroll
                    for (int pi = 0; pi < 4; ++pi) { f32x4 acc = {0.f, 0.f, 0.f, 0.f};
#pragma unroll
                        for (int ks = 0; ks < 2; ++ks) acc = __builtin_amdgcn_mfma_f32_16x16x32_bf16(ga[ks], *(const LAS bf16x8*)(XST + (64 * hl + 16 * pi + fr) * 72 + 32 * ks + 8 * fk), acc, 0, 0, 0);
#pragma unroll
                        for (int r = 0; r < 4; ++r) { const int tt = 16 * ti + 4 * fk + r, pp = 16 * pi + fr;
                            YD[(size_t)(m0 + tt) * 512 + 64 * h + pp] = (bf16_t)f2bf(acc[r] + dsk * bf2f(XST[(64 * hl + pp) * 72 + tt])); } }
                }
                {   float fac[2][8];
#pragma unroll
                    for (int ks = 0; ks < 2; ++ks) { const int s0 = 32 * ks + 8 * fk; const f32x4 a0 = *(const LAS f32x4*)(ACh + s0), a1 = *(const LAS f32x4*)(ACh + s0 + 4), d0 = *(const LAS f32x4*)(DTh + s0), d1 = *(const LAS f32x4*)(DTh + s0 + 4);
#pragma unroll
                        for (int j = 0; j < 4; ++j) { fac[ks][j] = d0[j] * __expf(a63 - a0[j]); fac[ks][4 + j] = d1[j] * __expf(a63 - a1[j]); } }
#pragma unroll
                    for (int pi2 = 0; pi2 < 2; ++pi2) { const int pi = 2 * hf + pi2; bf16x8 xa[2];
#pragma unroll
                        for (int ks = 0; ks < 2; ++ks) { const u32x4 xw = *(const LAS u32x4*)(XST + (64 * hl + 16 * pi + fr) * 72 + 32 * ks + 8 * fk);
                            u32x4 w; w.x = pk2(bflo(xw.x) * fac[ks][0], bfhi(xw.x) * fac[ks][1]); w.y = pk2(bflo(xw.y) * fac[ks][2], bfhi(xw.y) * fac[ks][3]); w.z = pk2(bflo(xw.z) * fac[ks][4], bfhi(xw.z) * fac[ks][5]); w.w = pk2(bflo(xw.w) * fac[ks][6], bfhi(xw.w) * fac[ks][7]);
                            xa[ks] = __builtin_bit_cast(bf16x8, w); }
#pragma unroll
                        for (int ni = 0; ni < 8; ++ni) { f32x4 acc = {0.f, 0.f, 0.f, 0.f};
#pragma unroll
                            for (int ks = 0; ks < 2; ++ks) acc = __builtin_amdgcn_mfma_f32_16x16x32_bf16(xa[ks], *(const LAS bf16x8*)(BT + (16 * ni + fr) * 72 + 32 * ks + 8 * fk), acc, 0, 0, 0);
#pragma unroll
                            for (int r = 0; r < 4; ++r) { const int pp = 16 * pi + 4 * fk + r, n = 16 * ni + fr; const int f = hl * 8192 + pp * 128 + n, wr = f >> 9, col = ssd_win_col(g, f & 511);
                                XBC[(size_t)(m0 + wr) * 1024 + col] = (bf16_t)f2bf(acc[r]); } }
                    }
                }
            }
            __syncthreads();
        }
    }
}

template <int VAR = 0> __device__ __forceinline__ void p3c_rwkv(const Ctx& F, int l) {
    constexpr int M9 = 9216, O_TW = 0, O_AL = 9216, O_SL = 18432, O_MAB = O_SL + 12 * M9  , O_LWF = O_SL + 10 * M9  , O_ICF = O_LWF + 17408, O_WL = O_MAB + 16640  , O_SCR = O_WL + 256, O_PAR = O_SCR + 4224  ;
    static_assert(O_ICF + 17408 <= O_MAB + 16640 && O_PAR + 2048 <= LDS_BYTES - 256, "rwkv lds map");
#define LB() ({ LAS unsigned char* p_ = F.lds; asm volatile("" : "+s"(p_)); p_; })
#define SLOT(i) ((LAS bf16_t*)(L + O_SL + (i) * M9))
#define TW ((LAS bf16_t*)(L + O_TW))
#define AL ((LAS bf16_t*)(L + O_AL))
#define AT SLOT(0)
#define ATt SLOT(1)
#define BTl SLOT(2)
#define KTl SLOT(3)
#define RT SLOT(4)
#define BHt SLOT(5)
#define KH SLOT(6)
#define VT SLOT(7)
#define MI SLOT(8)
#define MakT SLOT(9)
#define Rb SLOT(10)
#define Rk SLOT(11)
#define Attn SLOT(0)
#define KEt SLOT(1)
#define X1t SLOT(2)
#define X2t SLOT(3)
#define S8 SLOT(8)
#define S9 SLOT(9)
#define MAB ((LAS float*)(L + O_MAB))
#define LWf ((LAS float*)(L + O_LWF))
#define ICf ((LAS float*)(L + O_ICF))
#define WL ((LAS float*)(L + O_WL))
#define SCR ((LAS float*)(L + O_SCR))
#define PAR ((LAS float*)(L + O_PAR))
    const int tid = F.tid, lane = F.lane, wave = F.wave;
    for (int c = F.bid; c < NCHK; c += F.G) {
        const int m0 = 64 * c; const bool first = (c & 127) == 0;
        {
            LAS unsigned char* L = LB();
            const int t = tid >> 3, q0 = (tid & 7) * 8;
            const float* Ff = (const float*)(F.ws + WS_F); const float* HF = (const float*)(F.ws + WS_HF); const float* mu_w = INP(I_MUW) + l * 64; const float* mu_a = INP(I_MUA) + l * 64;
            float cw[8], pw[8], ca[8], pa[8];
            const float* cur = Ff + (size_t)(m0 + t) * 144; const float* prv = (t > 0) ? cur - 144 : HF + (size_t)(c - 1) * 128;
#pragma unroll
            for (int j = 0; j < 8; ++j) { cw[j] = cur[q0 + j]; ca[j] = cur[64 + q0 + j]; }
            if (t > 0) {
#pragma unroll
                for (int j = 0; j < 8; ++j) { pw[j] = prv[q0 + j]; pa[j] = prv[64 + q0 + j]; }
            } else if (!first) {
#pragma unroll
                for (int j = 0; j < 8; ++j) { pw[j] = prv[q0 + j]; pa[j] = prv[64 + q0 + j]; }
            } else {
#pragma unroll
                for (int j = 0; j < 8; ++j) { pw[j] = 0.f; pa[j] = 0.f; }
            }
            float ow[8], oa[8];
#pragma unroll
            for (int j = 0; j < 8; ++j) { ow[j] = tanhf(cw[j] + (pw[j] - cw[j]) * mu_w[q0 + j]); oa[j] = ca[j] + (pa[j] - ca[j]) * mu_a[q0 + j]; }
            u32x4 o; o.x = pk2(ow[0], ow[1]); o.y = pk2(ow[2], ow[3]); o.z = pk2(ow[4], ow[5]); o.w = pk2(ow[6], ow[7]); *(LAS u32x4*)(TW + t * 72 + q0) = o;
            o.x = pk2(oa[0], oa[1]); o.y = pk2(oa[2], oa[3]); o.z = pk2(oa[4], oa[5]); o.w = pk2(oa[6], oa[7]); *(LAS u32x4*)(AL + t * 72 + q0) = o;
        }
        u32x4 nlw, nla; float npar;
        auto head_fetch = [&](int h_, int tid_) { const int row = tid_ >> 3, c8 = tid_ & 7; const bf16_t* WLW = (const bf16_t*)(F.ws + WS_WLW); const bf16_t* WLA = (const bf16_t*)(F.ws + WS_WLA);
            nlw = *(const u32x4*)(WLW + (size_t)(h_ * 64 + row) * 64 + c8 * 8); nla = *(const u32x4*)(WLA + (size_t)(h_ * 64 + row) * 64 + c8 * 8);
            const int pi = tid_ >> 6, pc = tid_ & 63;
            const float* src = (pi < 3) ? INP(I_MURKV) + (size_t)l * 1536 + pi * 512 : (pi == 3) ? INP(I_KK) + l * 512 : (pi == 4) ? INP(I_KA) + l * 512 : (pi == 5) ? INP(I_RK) + l * 512 : (pi == 6) ? INP(I_W0) + l * 512 : INP(I_A0) + l * 512;
            npar = src[h_ * 64 + pc]; };
        head_fetch(0, F.tid);
        for (int h = 0; h < 8; ++h) {
            int tid = F.tid, lane = F.lane; asm volatile("" : "+v"(tid), "+v"(lane));
            const int t1 = tid >> 3, ch0 = (tid & 7) * 8, col1 = h * 64 + ch0;
            u32x4 rw, kw, vw, rp = {0u, 0u, 0u, 0u}, kp = rp, vp = rp;
            {   const bf16_t* Rg = (const bf16_t*)(F.ws + WS_R); const bf16_t* Kg = (const bf16_t*)(F.ws + WS_K); const bf16_t* Vg = (const bf16_t*)(F.ws + WS_V); const bf16_t* HR = (const bf16_t*)(F.ws + WS_HRKV);
                const size_t off = (size_t)(m0 + t1) * 512 + col1;
                rw = *(const u32x4*)(Rg + off); kw = *(const u32x4*)(Kg + off); vw = *(const u32x4*)(Vg + off);
                if (t1 > 0) { rp = *(const u32x4*)(Rg + off - 512); kp = *(const u32x4*)(Kg + off - 512); vp = *(const u32x4*)(Vg + off - 512); }
                else if (!first) { const size_t ho = (size_t)(c - 1) * 512 + col1; rp = *(const u32x4*)(HR + ho); kp = *(const u32x4*)(HR + (size_t)NCHK * 512 + ho); vp = *(const u32x4*)(HR + (size_t)2 * NCHK * 512 + ho); } }
            {   LAS unsigned char* L = LB(); const int row = tid >> 3, c8 = tid & 7;
                *(LAS u32x4*)(S8 + row * 72 + c8 * 8) = nlw; *(LAS u32x4*)(S9 + row * 72 + c8 * 8) = nla; PAR[(tid >> 6) * 64 + (tid & 63)] = npar; }
            if (h < 7) head_fetch(h + 1, tid);
            __syncthreads();
            if (!(VAR & 16)) {   LAS unsigned char* L = LB(); const int which = wave >> 2, ci = wave & 3, ch = ci * 16 + (lane & 15), g4 = lane >> 4;
                const float bias = PAR[(6 + which) * 64 + ch]; float carry = 0.f;
#pragma unroll
                for (int ti = 0; ti < 4; ++ti) {
                    const f32x4 acc = mma_tile<64>((which ? AL : TW) + ti * 16 * 72, 72, (which ? S9 : S8) + ci * 16 * 72, 72, lane);
                    if (which == 0) {
                        float a[4];
#pragma unroll
                        for (int r = 0; r < 4; ++r) a[r] = -DECAY_SCALE * sigmoidf_(acc[r] + bias);
                        a[1] += a[0]; a[2] += a[1]; a[3] += a[2];
                        float tot = a[3]; const float u1 = __shfl_up(tot, 16); if (g4 >= 1) tot += u1; const float u2 = __shfl_up(tot, 32); if (g4 >= 2) tot += u2;
                        const float base = carry + tot - a[3];
#pragma unroll
                        for (int r = 0; r < 4; ++r) LWf[(ti * 16 + 4 * g4 + r) * 68 + ch] = base + a[r];
                        carry += __shfl(tot, 48 + (lane & 15));
                    } else {
#pragma unroll
                        for (int r = 0; r < 4; ++r) ICf[(ti * 16 + 4 * g4 + r) * 68 + ch] = sigmoidf_(acc[r] + bias);
                    }
                }
                if (which == 0 && g4 == 0) WL[ch] = __expf(carry);
            }
            __syncthreads();
            float bonv[8] = {0.f, 0.f, 0.f, 0.f, 0.f, 0.f, 0.f, 0.f};
            if (!(VAR & 2)) {   LAS unsigned char* L = LB(); const int t = t1;
                const unsigned rwa[4] = {rw.x, rw.y, rw.z, rw.w}, kwa[4] = {kw.x, kw.y, kw.z, kw.w}, vwa[4] = {vw.x, vw.y, vw.z, vw.w};
                const unsigned rpa[4] = {rp.x, rp.y, rp.z, rp.w}, kpa[4] = {kp.x, kp.y, kp.z, kp.w}, vpa[4] = {vp.x, vp.y, vp.z, vp.w};
                float rs[8], ks[8], vs[8], kkv[8], k2[8], ic[8]; float ss = 0.f, bs = 0.f;
                float pr_[6][8], lwt[8], lwp[8], l63[8];
#pragma unroll
                for (int q = 0; q < 6; ++q) { const f32x4 a = *(const LAS f32x4*)(PAR + q * 64 + ch0), b = *(const LAS f32x4*)(PAR + q * 64 + ch0 + 4);
                    pr_[q][0] = a[0]; pr_[q][1] = a[1]; pr_[q][2] = a[2]; pr_[q][3] = a[3]; pr_[q][4] = b[0]; pr_[q][5] = b[1]; pr_[q][6] = b[2]; pr_[q][7] = b[3]; }
                {   const f32x4 a = *(const LAS f32x4*)(ICf + t * 68 + ch0), b = *(const LAS f32x4*)(ICf + t * 68 + ch0 + 4); ic[0] = a[0]; ic[1] = a[1]; ic[2] = a[2]; ic[3] = a[3]; ic[4] = b[0]; ic[5] = b[1]; ic[6] = b[2]; ic[7] = b[3];
                    const f32x4 c0 = *(const LAS f32x4*)(LWf + t * 68 + ch0), c1 = *(const LAS f32x4*)(LWf + t * 68 + ch0 + 4); lwt[0] = c0[0]; lwt[1] = c0[1]; lwt[2] = c0[2]; lwt[3] = c0[3]; lwt[4] = c1[0]; lwt[5] = c1[1]; lwt[6] = c1[2]; lwt[7] = c1[3];
                    const int tp = (t > 0) ? t - 1 : 0; const f32x4 d0 = *(const LAS f32x4*)(LWf + tp * 68 + ch0), d1 = *(const LAS f32x4*)(LWf + tp * 68 + ch0 + 4); const float pm_ = (t > 0) ? 1.f : 0.f;
                    lwp[0] = d0[0] * pm_; lwp[1] = d0[1] * pm_; lwp[2] = d0[2] * pm_; lwp[3] = d0[3] * pm_; lwp[4] = d1[0] * pm_; lwp[5] = d1[1] * pm_; lwp[6] = d1[2] * pm_; lwp[7] = d1[3] * pm_;
                    const f32x4 e0 = *(const LAS f32x4*)(LWf + 63 * 68 + ch0), e1 = *(const LAS f32x4*)(LWf + 63 * 68 + ch0 + 4); l63[0] = e0[0]; l63[1] = e0[1]; l63[2] = e0[2]; l63[3] = e0[3]; l63[4] = e1[0]; l63[5] = e1[1]; l63[6] = e1[2]; l63[7] = e1[3]; }
#pragma unroll
                for (int j = 0; j < 8; ++j) { const int q = j >> 1;
                    const float r_ = (j & 1) ? bfhi(rwa[q]) : bflo(rwa[q]), rq = (j & 1) ? bfhi(rpa[q]) : bflo(rpa[q]);
                    const float k_ = (j & 1) ? bfhi(kwa[q]) : bflo(kwa[q]), kq = (j & 1) ? bfhi(kpa[q]) : bflo(kpa[q]);
                    const float v_ = (j & 1) ? bfhi(vwa[q]) : bflo(vwa[q]), vq = (j & 1) ? bfhi(vpa[q]) : bflo(vpa[q]);
                    rs[j] = r_ + (rq - r_) * pr_[0][j]; ks[j] = k_ + (kq - k_) * pr_[1][j]; vs[j] = v_ + (vq - v_) * pr_[2][j];
                    kkv[j] = ks[j] * pr_[3][j]; ss += kkv[j] * kkv[j];
                    k2[j] = ks[j] * (1.f + (ic[j] - 1.f) * pr_[4][j]); bs += rs[j] * k2[j] * pr_[5][j]; }
                ss += __shfl_xor(ss, 1); ss += __shfl_xor(ss, 2); ss += __shfl_xor(ss, 4);
                bs += __shfl_xor(bs, 1); bs += __shfl_xor(bs, 2); bs += __shfl_xor(bs, 4);
                const float inv = __builtin_amdgcn_rsqf(fmaxf(ss, 1e-24f));
                float vAT[8], vB[8], vK[8], vR[8], vBH[8], vKH[8];
#pragma unroll
                for (int j = 0; j < 8; ++j) { const int ch = ch0 + j;
                    const float LWt = lwt[j], LWp = lwp[j], L63 = l63[j];
                    const float kk = kkv[j] * inv, a = -kk, b = kk * ic[j];
                    const float e1 = __expf(LWt), e2 = __expf(-LWt), e3 = __expf(LWp), e4 = __expf(L63 - LWt);
                    vAT[j] = a * e3; vB[j] = b * e2; vK[j] = k2[j] * e2; vR[j] = rs[j] * e1; vBH[j] = b * e4; vKH[j] = k2[j] * e4; bonv[j] = bs * vs[j];
                    (void)ch; }
                u32x4 o;
#define PK8(A_) (o[0] = pk2(A_[0], A_[1]), o[1] = pk2(A_[2], A_[3]), o[2] = pk2(A_[4], A_[5]), o[3] = pk2(A_[6], A_[7]), o)
                *(LAS u32x4*)(AT + t * 72 + ch0) = PK8(vAT); *(LAS u32x4*)(BTl + t * 72 + ch0) = PK8(vB); *(LAS u32x4*)(KTl + t * 72 + ch0) = PK8(vK);
                *(LAS u32x4*)(RT + t * 72 + ch0) = PK8(vR); *(LAS u32x4*)(KH + t * 72 + ch0) = PK8(vKH); *(LAS u32x4*)(BHt + t * 72 + ch0) = PK8(vBH); *(LAS u32x4*)(VT + t * 72 + ch0) = PK8(vs);
            }
            __syncthreads();
            { u32x4 o; *(u32x4*)((bf16_t*)(F.ws + WS_V) + (size_t)(m0 + t1) * 512 + col1) = PK8(bonv); }
            if (!(VAR & 8)) { LAS unsigned char* L = LB();
                auto run2 = [&](auto PT) { constexpr int p = decltype(PT)::value;
                    f32x4 acc[8];
#pragma unroll
                    for (int i = 0; i < 8; ++i) { const int idx = 8 * (wave & 1) + i, ti = idx >> 2, si = idx & 3;
                        acc[i] = mma_tile<64>(((p < 2) ? AT : RT) + ti * 16 * 72, 72, ((p & 1) ? KTl : BTl) + si * 16 * 72, 72, lane); }
#pragma unroll
                    for (int i = 0; i < 8; ++i) { const int idx = 8 * (wave & 1) + i, ti = idx >> 2, si = idx & 3;
#pragma unroll
                        for (int r = 0; r < 4; ++r) { const int t = ti * 16 + 4 * (lane >> 4) + r, s = si * 16 + (lane & 15);
                            if (p == 0) MAB[t * 65 + s] = (s < t) ? acc[i][r] : 0.f;
                            else if (p == 1) MakT[s * 72 + t] = (bf16_t)f2bf((s < t) ? acc[i][r] : 0.f);
                            else if (p == 2) Rb[t * 72 + s] = (bf16_t)f2bf((s <= t) ? acc[i][r] : 0.f);
                            else Rk[t * 72 + s] = (bf16_t)f2bf((s <= t) ? acc[i][r] : 0.f); } } };
                const int pw = wave >> 1;
                if (pw == 0) run2(IC<0>{}); else if (pw == 1) run2(IC<1>{}); else if (pw == 2) run2(IC<2>{}); else run2(IC<3>{}); }
            __syncthreads();
            if (!(VAR & 1)) {
            if (wave < 4 && lane < 16) { LAS unsigned char* L = LB(); const int b0 = 16 * wave; float x[16];
#pragma unroll
                for (int t = 0; t < 16; ++t) { float v = (t == lane) ? 1.f : 0.f;
#pragma unroll
                    for (int s = 0; s < 16; ++s) if (s < t) v += MAB[(b0 + t) * 65 + b0 + s] * x[s];
                    x[t] = v; }
#pragma unroll
                for (int t = 0; t < 16; ++t) MAB[(b0 + t) * 65 + b0 + lane] = x[t]; }
            __syncthreads();
            if (wave < 2) { LAS unsigned char* L = LB(); const int pr = wave, rb = pr ? 48 : 16, cb = pr ? 32 : 0, fr = lane & 15, fk = lane >> 4; f32x4 acc = {0.f, 0.f, 0.f, 0.f};
#pragma unroll
                for (int ks = 0; ks < 4; ++ks) acc = __builtin_amdgcn_mfma_f32_16x16x4f32(MAB[(rb + fr) * 65 + cb + 4 * ks + fk], MAB[(cb + 4 * ks + fk) * 65 + cb + fr], acc, 0, 0, 0);
#pragma unroll
                for (int r = 0; r < 4; ++r) SCR[(pr * 16 + 4 * fk + r) * 33 + fr] = acc[r]; }
            __syncthreads();
            if (wave < 2) { LAS unsigned char* L = LB(); const int pr = wave, rb = pr ? 48 : 16, cb = pr ? 32 : 0, fr = lane & 15, fk = lane >> 4; f32x4 acc = {0.f, 0.f, 0.f, 0.f};
#pragma unroll
                for (int ks = 0; ks < 4; ++ks) acc = __builtin_amdgcn_mfma_f32_16x16x4f32(MAB[(rb + fr) * 65 + rb + 4 * ks + fk], SCR[(pr * 16 + 4 * ks + fk) * 33 + fr], acc, 0, 0, 0);
#pragma unroll
                for (int r = 0; r < 4; ++r) MAB[(rb + 4 * fk + r) * 65 + cb + fr] = acc[r]; }
            __syncthreads();
            if (wave < 4) { LAS unsigned char* L = LB(); const int ti = wave >> 1, ci = wave & 1, fr = lane & 15, fk = lane >> 4; f32x4 acc = {0.f, 0.f, 0.f, 0.f};
#pragma unroll
                for (int ks = 0; ks < 8; ++ks) acc = __builtin_amdgcn_mfma_f32_16x16x4f32(MAB[(32 + 16 * ti + fr) * 65 + 4 * ks + fk], MAB[(4 * ks + fk) * 65 + 16 * ci + fr], acc, 0, 0, 0);
#pragma unroll
                for (int r = 0; r < 4; ++r) SCR[(16 * ti + 4 * fk + r) * 33 + 16 * ci + fr] = acc[r]; }
            __syncthreads();
            if (wave < 4) { LAS unsigned char* L = LB(); const int ti = wave >> 1, ci = wave & 1, fr = lane & 15, fk = lane >> 4; f32x4 acc = {0.f, 0.f, 0.f, 0.f};
#pragma unroll
                for (int ks = 0; ks < 8; ++ks) acc = __builtin_amdgcn_mfma_f32_16x16x4f32(MAB[(32 + 16 * ti + fr) * 65 + 32 + 4 * ks + fk], SCR[(4 * ks + fk) * 33 + 16 * ci + fr], acc, 0, 0, 0);
#pragma unroll
                for (int r = 0; r < 4; ++r) MAB[(32 + 16 * ti + 4 * fk + r) * 65 + 16 * ci + fr] = acc[r]; }
            __syncthreads();
            {   LAS unsigned char* L = LB(); const int t = tid >> 3, s0 = (tid & 7) * 8; float x[8];
#pragma unroll
                for (int j = 0; j < 8; ++j) x[j] = MAB[t * 65 + s0 + j];
                u32x4 o; *(LAS u32x4*)(MI + t * 72 + s0) = PK8(x); }
            __syncthreads();
            }
            if (!(VAR & 4)) { LAS unsigned char* L = LB();
#pragma unroll
            for (int i = 0; i < 4; ++i) { const int idx = 4 * wave + i, ti = (idx >> 2) & 3, ci = idx & 3; LAS bf16_t* osel = (wave >> 2) ? X2t : X1t;
                const f32x4 acc = (wave >> 2) ? mma_tile<64>(MI + ti * 16 * 72, 72, MakT + ci * 16 * 72, 72, lane) : mma_tile2<64, false, true>(MI, 72, ti * 16, AT, 72, ci * 16, lane);
#pragma unroll
                for (int r = 0; r < 4; ++r) { const int t = ti * 16 + 4 * (lane >> 4) + r, j = ci * 16 + (lane & 15); osel[j * 72 + t] = (bf16_t)f2bf(acc[r]); } } }
            __syncthreads();
            if (!(VAR & 4)) { LAS unsigned char* L = LB();
                auto run5 = [&](auto PT) { constexpr int p = decltype(PT)::value;
                    f32x4 acc[8];
#pragma unroll
                    for (int i = 0; i < 8; ++i) { const int idx = 8 * (wave & 1) + i, ti = idx >> 2, si = idx & 3;
                        if constexpr (p < 2) acc[i] = mma_tile<64>(Rb + ti * 16 * 72, 72, ((p == 0) ? X1t : X2t) + si * 16 * 72, 72, lane);
                        else acc[i] = mma_tile2<64, false, true>((p == 2) ? X1t : X2t, 72, ti * 16, BHt, 72, si * 16, lane);
#pragma unroll
                        for (int r = 0; r < 4; ++r) { const int rw = ti * 16 + 4 * (lane >> 4) + r, cl = si * 16 + (lane & 15);
                            acc[i][r] += (p == 0) ? bf2f(RT[rw * 72 + cl]) : (p == 1) ? bf2f(Rk[rw * 72 + cl]) : (p == 2) ? ((rw == cl) ? WL[rw] : 0.f) : bf2f(KH[rw * 72 + cl]); } }
#pragma unroll
                    for (int i = 0; i < 8; ++i) { const int idx = 8 * (wave & 1) + i, ti = idx >> 2, si = idx & 3;
#pragma unroll
                        for (int r = 0; r < 4; ++r) { const int rw = ti * 16 + 4 * (lane >> 4) + r, cl = si * 16 + (lane & 15);
                            if (p == 0) SLOT(8)[rw * 64 + pi16(cl)] = (bf16_t)f2bf(acc[i][r]);
                            else if (p == 1) Attn[rw * 72 + cl] = (bf16_t)f2bf(acc[i][r]);
                            else if (p == 2) SLOT(9)[cl * 64 + pi16(rw)] = (bf16_t)f2bf(acc[i][r]);
                            else KEt[cl * 72 + rw] = (bf16_t)f2bf(acc[i][r]); } } };
                const int pw = wave >> 1;
                if (pw == 0) run5(IC<0>{}); else if (pw == 1) run5(IC<1>{}); else if (pw == 2) run5(IC<2>{}); else run5(IC<3>{}); }
            __syncthreads();
            {   LAS unsigned char* L = LB();
                *(u32x4*)((bf16_t*)(F.ws + WS_QE) + (size_t)(c * 8 + h) * 4096 + tid * 8) = *(const LAS u32x4*)(SLOT(8) + tid * 8);
                *(u32x4*)((bf16_t*)(F.ws + WS_TT) + (size_t)(c * 8 + h) * 4096 + tid * 8) = *(const LAS u32x4*)(SLOT(9) + tid * 8); }
            LAS unsigned char* L = LB();
#pragma unroll
            for (int i = 0; i < 4; ++i) { const int idx = 4 * wave + i, which = wave >> 2, ti = (idx >> 2) & 3, ci = idx & 3;
                const f32x4 acc = which ? mma_tile2<64, true, false>(VT, 72, ti * 16, KEt, 72, ci * 16, lane) : mma_tile2<64, false, true>(Attn, 72, ti * 16, VT, 72, ci * 16, lane);
#pragma unroll
                for (int r = 0; r < 4; ++r) { const int rw = ti * 16 + 4 * (lane >> 4) + r, cl = ci * 16 + (lane & 15);
                    const int o = which ? rw * 64 + sg32(cl) : cl * 64 + sg32(rw);
                    (which ? SLOT(3) : SLOT(2))[o] = (bf16_t)f2bf(acc[r]); } }
            __syncthreads();
            {   const int row = tid >> 3, c8 = tid & 7;
                *(u32x4*)((bf16_t*)(F.ws + WS_K) + (size_t)(m0 + row) * 512 + h * 64 + c8 * 8) = *(const LAS u32x4*)(SLOT(2) + tid * 8);
                *(u32x4*)((bf16_t*)(F.ws + WS_R) + (size_t)(m0 + row) * 512 + h * 64 + c8 * 8) = *(const LAS u32x4*)(SLOT(3) + tid * 8); }
        }
        __syncthreads();
    }
#undef SLOT
#undef PK8
#undef LB
#undef TW
#undef AL
#undef AT
#undef ATt
#undef BTl
#undef KTl
#undef RT
#undef BHt
#undef KH
#undef VT
#undef MI
#undef MakT
#undef Rb
#undef Rk
#undef Attn
#undef KEt
#undef X1t
#undef X2t
#undef S8
#undef S9
#undef MAB
#undef LWf
#undef ICf
#undef WL
#undef SCR
#undef PAR
}

__device__ __forceinline__ bf16x8 cvt8(const f32x16& x, int s) {
    u32x4 w; w.x = pk2(x[8 * s + 0], x[8 * s + 1]); w.y = pk2(x[8 * s + 2], x[8 * s + 3]); w.z = pk2(x[8 * s + 4], x[8 * s + 5]); w.w = pk2(x[8 * s + 6], x[8 * s + 7]);
    return __builtin_bit_cast(bf16x8, w);
}
__device__ __forceinline__ f32x16 ld16bf(const bf16_t* p) {
    const u32x4 a = *(const u32x4*)p, b = *(const u32x4*)(p + 8); f32x16 r;
    r[0] = bflo(a.x); r[1] = bfhi(a.x); r[2] = bflo(a.y); r[3] = bfhi(a.y); r[4] = bflo(a.z); r[5] = bfhi(a.z); r[6] = bflo(a.w); r[7] = bfhi(a.w);
    r[8] = bflo(b.x); r[9] = bfhi(b.x); r[10] = bflo(b.y); r[11] = bfhi(b.y); r[12] = bflo(b.z); r[13] = bfhi(b.z); r[14] = bflo(b.w); r[15] = bfhi(b.w); return r;
}
__device__ __forceinline__ void st16bf(bf16_t* p, const f32x16& x) {
    u32x4 a, b; a.x = pk2(x[0], x[1]); a.y = pk2(x[2], x[3]); a.z = pk2(x[4], x[5]); a.w = pk2(x[6], x[7]); b.x = pk2(x[8], x[9]); b.y = pk2(x[10], x[11]); b.z = pk2(x[12], x[13]); b.w = pk2(x[14], x[15]);
    *(u32x4*)p = a; *(u32x4*)(p + 8) = b;
}
__device__ __forceinline__ float max3f(float a, float b, float c) { float r; asm("v_max3_f32 %0, %1, %2, %3" : "=v"(r) : "v"(a), "v"(b), "v"(c)); return r; }
__device__ __forceinline__ int ktile_off(int row, int ch) { return 3072 * (row >> 3) + 512 * (ch >> 2) + 64 * (row & 7) + 16 * ((ch & 3) ^ ((row >> 2) & 3)); }
constexpr int KTILE = 24576;
template <int VAR> __device__ __forceinline__ void attn_unit(const Ctx& F, int b, int c, int hp) {
    const int tid = F.tid, lane = F.lane, wave = F.wave, r32 = lane & 31, hi = lane >> 5, grp = wave >> 2, wq = wave & 3, head = 2 * hp + (wq >> 1);
    const bf16_t* Q = (const bf16_t*)(F.ws + WS_Q); const bf16_t* KV = (const bf16_t*)(F.ws + WS_KVB) + (size_t)b * SEQ * 192; bf16_t* OL = (bf16_t*)(F.ws + WS_OL);
    const size_t mq = (size_t)b * SEQ + 64 * c + 32 * (wq & 1) + r32;
    bf16x8 qr[12];
#pragma unroll
    for (int d0 = 0; d0 < 12; ++d0) qr[d0] = *(const bf16x8*)(Q + mq * 768 + head * 192 + 16 * d0 + 8 * hi);
    {
        const float* rp = (const float*)(F.ws + WS_ROPE) + mq * 64;
#pragma unroll
        for (int d0 = 8; d0 < 10; ++d0) { const int j0 = 16 * (d0 - 8) + 8 * hi;
            const f32x4 c0 = *(const f32x4*)(rp + j0), c1 = *(const f32x4*)(rp + j0 + 4), s0 = *(const f32x4*)(rp + 32 + j0), s1 = *(const f32x4*)(rp + 32 + j0 + 4);
            const u32x4 a = __builtin_bit_cast(u32x4, qr[d0]), bq = __builtin_bit_cast(u32x4, qr[d0 + 2]);
            const float x1[8] = {bflo(a.x), bfhi(a.x), bflo(a.y), bfhi(a.y), bflo(a.z), bfhi(a.z), bflo(a.w), bfhi(a.w)}, x2[8] = {bflo(bq.x), bfhi(bq.x), bflo(bq.y), bfhi(bq.y), bflo(bq.z), bfhi(bq.z), bflo(bq.w), bfhi(bq.w)};
            const float cs[8] = {c0[0], c0[1], c0[2], c0[3], c1[0], c1[1], c1[2], c1[3]}, sn[8] = {s0[0], s0[1], s0[2], s0[3], s1[0], s1[1], s1[2], s1[3]};
            float o1[8], o2[8];
#pragma unroll
            for (int e = 0; e < 8; ++e) { o1[e] = x1[e] * cs[e] - x2[e] * sn[e]; o2[e] = x1[e] * sn[e] + x2[e] * cs[e]; }
            u32x4 w1, w2; w1.x = pk2(o1[0], o1[1]); w1.y = pk2(o1[2], o1[3]); w1.z = pk2(o1[4], o1[5]); w1.w = pk2(o1[6], o1[7]); w2.x = pk2(o2[0], o2[1]); w2.y = pk2(o2[2], o2[3]); w2.z = pk2(o2[4], o2[5]); w2.w = pk2(o2[6], o2[7]);
            qr[d0] = __builtin_bit_cast(bf16x8, w1); qr[d0 + 2] = __builtin_bit_cast(bf16x8, w2); }
    }
    int poff[3]; int goff[3];
#pragma unroll
    for (int i = 0; i < 3; ++i) { const int idx = tid + 512 * i, row = idx / 24, col = idx % 24; poff[i] = ktile_off(row, col); goff[i] = row * 192 + col * 8; }
    const int nt = c + 1, ns = (VAR & 64) ? 0 : (nt + 1) >> 1;
    u32x4 st[6];
#pragma unroll
    for (int i = 0; i < 3; ++i) st[i] = *(const u32x4*)(KV + goff[i]);
    if (nt > 1) {
#pragma unroll
        for (int i = 0; i < 3; ++i) st[3 + i] = *(const u32x4*)(KV + (size_t)64 * 192 + goff[i]);
    }
#pragma unroll
    for (int i = 0; i < 3; ++i) { *(LAS u32x4*)(F.lds + poff[i]) = st[i]; if (nt > 1) *(LAS u32x4*)(F.lds + KTILE + poff[i]) = st[3 + i]; }
    __syncthreads();
    f32x16 o[4];
#pragma unroll
    for (int d = 0; d < 4; ++d)
#pragma unroll
        for (int r = 0; r < 16; ++r) o[d][r] = 0.f;
    float mrun = -1e30f, lrun = 0.f;
    const int kx_ = (r32 >> 2) & 3, kbase = 3072 * (r32 >> 3) + 64 * (r32 & 7), koffE = kbase + 16 * (hi ^ kx_), koffO = kbase + 16 * ((2 + hi) ^ kx_);
    const int tq_ = (lane & 15) >> 2, tp_ = lane & 3, tgl_ = (lane >> 4) & 1, trb = 64 * (4 * hi + tq_) + 8 * (tp_ & 1);
    const int tro0 = trb + 16 * ((2 * tgl_ + (tp_ >> 1)) ^ (hi & 3)), tro1 = trb + 16 * ((2 * tgl_ + (tp_ >> 1)) ^ ((2 + hi) & 3)) + 3072;
    for (int s = 0; s < ns; ++s) {
        const bool more = (s + 1 < ns), more2 = (2 * s + 3 < nt);
        if (more && !(VAR & 1)) {
#pragma unroll
            for (int i = 0; i < 3; ++i) st[i] = *(const u32x4*)(KV + (size_t)(2 * s + 2) * 64 * 192 + goff[i]);
            if (more2) {
#pragma unroll
                for (int i = 0; i < 3; ++i) st[3 + i] = *(const u32x4*)(KV + (size_t)(2 * s + 3) * 64 * 192 + goff[i]);
            }
        }
        if (2 * s + grp < nt) {
            const LAS unsigned char* buf = F.lds + ((s & 1) * 2 + grp) * KTILE;
            f32x16 p0, p1, q0, q1;
#pragma unroll
            for (int r = 0; r < 16; ++r) { p0[r] = 0.f; p1[r] = 0.f; q0[r] = 0.f; q1[r] = 0.f; }
            bf16x8 ka[3][2];
            if (VAR & 32) {
#pragma unroll
                for (int q = 0; q < 3; ++q) { ka[q][0] = qr[q]; ka[q][1] = qr[q + 3]; } }
#define KLD(slot, d0) do { if (VAR & 32) { asm volatile("" : "+v"(ka[slot][0]), "+v"(ka[slot][1])); break; } ka[slot][0] = *(const LAS bf16x8*)(buf + (((d0) & 1) ? koffO : koffE) + 512 * ((d0) >> 1)); ka[slot][1] = *(const LAS bf16x8*)(buf + (((d0) & 1) ? koffO : koffE) + 12288 + 512 * ((d0) >> 1)); } while (0)
            KLD(0, 0); KLD(1, 1); KLD(2, 2);
#pragma unroll
            for (int d0 = 0; d0 < 12; ++d0) {
                __builtin_amdgcn_sched_barrier(0);
                if (VAR & 16) { if (d0 & 1) { q0 = __builtin_amdgcn_mfma_f32_32x32x16_bf16(ka[d0 % 3][0], qr[d0], q0, 0, 0, 0); q1 = __builtin_amdgcn_mfma_f32_32x32x16_bf16(ka[d0 % 3][1], qr[d0], q1, 0, 0, 0); } else { p0 = __builtin_amdgcn_mfma_f32_32x32x16_bf16(ka[d0 % 3][0], qr[d0], p0, 0, 0, 0); p1 = __builtin_amdgcn_mfma_f32_32x32x16_bf16(ka[d0 % 3][1], qr[d0], p1, 0, 0, 0); } }
                else if (!(VAR & 4)) { p0 = __builtin_amdgcn_mfma_f32_32x32x16_bf16(ka[d0 % 3][0], qr[d0], p0, 0, 0, 0); p1 = __builtin_amdgcn_mfma_f32_32x32x16_bf16(ka[d0 % 3][1], qr[d0], p1, 0, 0, 0); } else { asm volatile("" :: "v"(ka[d0 % 3][0]), "v"(ka[d0 % 3][1])); }
                __builtin_amdgcn_sched_barrier(0);
                if (d0 + 3 < 12) KLD(d0 % 3, d0 + 3);
            }
            __builtin_amdgcn_sched_barrier(0);
            if (VAR & 16) {
#pragma unroll
                for (int r = 0; r < 16; ++r) { p0[r] += q0[r]; p1[r] += q1[r]; } }
#undef KLD
            v4i16_t vl[2][4], vh[2][4];
#pragma unroll
            for (int db = 0; db < 4; ++db) { vl[0][db] = __builtin_amdgcn_ds_read_tr16_b64_v4i16((LAS v4i16_t*)(buf + tro0 + 512 * db)); vh[0][db] = __builtin_amdgcn_ds_read_tr16_b64_v4i16((LAS v4i16_t*)(buf + tro1 + 512 * db)); }
            float mx = max3f(p0[0], p1[0], p0[1]), my = max3f(p1[1], p0[2], p1[2]);
#pragma unroll
            for (int r = 3; r < 15; r += 2) { mx = max3f(mx, p0[r], p1[r]); my = max3f(my, p0[r + 1], p1[r + 1]); }
            mx = max3f(mx, my, fmaxf(p0[15], p1[15]));
            mx = fmaxf(mx, __shfl_xor(mx, 32));
            if (!(VAR & 8) && __any(mx > mrun + 8.f)) {
                const float mnew = fmaxf(mrun, mx), alpha = __builtin_amdgcn_exp2f(mrun - mnew); mrun = mnew; lrun *= alpha;
#pragma unroll
                for (int d = 0; d < 4; ++d)
#pragma unroll
                    for (int r = 0; r < 16; ++r) o[d][r] *= alpha;
            }
            float ls = 0.f;
#pragma unroll
            for (int r = 0; r < 16; ++r) { if (!(VAR & 8)) { p0[r] = __builtin_amdgcn_exp2f(p0[r] - mrun); p1[r] = __builtin_amdgcn_exp2f(p1[r] - mrun); } ls += p0[r] + p1[r]; }
            lrun += ls;
#pragma unroll
            for (int ks = 0; ks < 4; ++ks) {
                if (ks + 1 < 4) {
#pragma unroll
                    for (int db = 0; db < 4; ++db) {
                        vl[(ks + 1) & 1][db] = __builtin_amdgcn_ds_read_tr16_b64_v4i16((LAS v4i16_t*)(buf + tro0 + 6144 * (ks + 1) + 512 * db)); vh[(ks + 1) & 1][db] = __builtin_amdgcn_ds_read_tr16_b64_v4i16((LAS v4i16_t*)(buf + tro1 + 6144 * (ks + 1) + 512 * db)); }
                }
                const bf16x8 pb = (ks < 2) ? cvt8(p0, ks & 1) : cvt8(p1, ks & 1);
#pragma unroll
                for (int db = 0; db < 4; ++db) { const v4i16_t lo = vl[ks & 1][db], hh = vh[ks & 1][db];
                    const bf16x8 va = {lo[0], lo[1], lo[2], lo[3], hh[0], hh[1], hh[2], hh[3]};
                    if (!(VAR & 2)) o[db] = __builtin_amdgcn_mfma_f32_32x32x16_bf16(va, pb, o[db], 0, 0, 0); else asm volatile("" :: "v"(va), "v"(pb)); }
            }
        }
        if (more && !(VAR & 1)) {
            LAS unsigned char* nb = F.lds + (((s + 1) & 1) * 2) * KTILE;
#pragma unroll
            for (int i = 0; i < 3; ++i) { *(LAS u32x4*)(nb + poff[i]) = st[i]; if (more2) *(LAS u32x4*)(nb + KTILE + poff[i]) = st[3 + i]; }
        }
        __syncthreads();
    }
    lrun += __shfl_xor(lrun, 32);
    LAS float* xb = (LAS float*)(F.lds + wq * (66 * 64 * 4));
    if (grp == 1) {
#pragma unroll
        for (int d = 0; d < 4; ++d)
#pragma unroll
            for (int r = 0; r < 16; ++r) xb[(d * 16 + r) * 64 + lane] = o[d][r];
        xb[64 * 64 + lane] = mrun; xb[65 * 64 + lane] = lrun;
    }
    __syncthreads();
    if (grp == 0) {
        const float m2 = xb[64 * 64 + lane], l2 = xb[65 * 64 + lane];
        const float mm = fmaxf(mrun, m2), a1 = __builtin_amdgcn_exp2f(mrun - mm), a2 = __builtin_amdgcn_exp2f(m2 - mm);
        const float inv = 1.f / (lrun * a1 + l2 * a2), f1 = a1 * inv, f2 = a2 * inv;
#pragma unroll
        for (int db = 0; db < 4; ++db)
#pragma unroll
            for (int g = 0; g < 4; ++g) { float v[4];
#pragma unroll
                for (int e = 0; e < 4; ++e) v[e] = o[db][4 * g + e] * f1 + xb[(db * 16 + 4 * g + e) * 64 + lane] * f2;
                u32x2 w; w.x = pk2(v[0], v[1]); w.y = pk2(v[2], v[3]);
                *(u32x2*)(OL + mq * 512 + head * 128 + 32 * db + 8 * g + 4 * hi) = w; }
    }
    __syncthreads();
}
struct RwSet { bf16x8 ta[2][4]; u32x4 d[4]; };
__device__ __forceinline__ void rw_load(RwSet& s, const bf16_t* TTg, const bf16_t* Rg, int cg_, int h, int i, int r32, int hi) {
    const bf16_t* TTw = TTg + (size_t)(cg_ * 8 + h) * 4096; const bf16_t* Dw = Rg + ((size_t)64 * cg_ + i) * 512 + h * 64;
#pragma unroll
    for (int a = 0; a < 2; ++a)
#pragma unroll
        for (int s2 = 0; s2 < 4; ++s2) s.ta[a][s2] = *(const bf16x8*)(TTw + (32 * a + r32) * 64 + 16 * s2 + 8 * hi);
    s.d[0] = *(const u32x4*)(Dw + 16 * hi); s.d[1] = *(const u32x4*)(Dw + 16 * hi + 8); s.d[2] = *(const u32x4*)(Dw + 32 + 16 * hi); s.d[3] = *(const u32x4*)(Dw + 32 + 16 * hi + 8);
}
__device__ __forceinline__ f32x16 up16(const u32x4 a, const u32x4 b) { f32x16 r;
    r[0] = bflo(a.x); r[1] = bfhi(a.x); r[2] = bflo(a.y); r[3] = bfhi(a.y); r[4] = bflo(a.z); r[5] = bfhi(a.z); r[6] = bflo(a.w); r[7] = bfhi(a.w);
    r[8] = bflo(b.x); r[9] = bfhi(b.x); r[10] = bflo(b.y); r[11] = bfhi(b.y); r[12] = bflo(b.z); r[13] = bfhi(b.z); r[14] = bflo(b.w); r[15] = bfhi(b.w); return r; }
__device__ __forceinline__ void rw_step(f32x16& X0, f32x16& X1, const RwSet& s, bf16_t* Rg, int cg_, int h, int i, int hi, bool live) {
    const bf16x8 bf[4] = {cvt8(X0, 0), cvt8(X0, 1), cvt8(X1, 0), cvt8(X1, 1)};
    if (live) { bf16_t* Dw = Rg + ((size_t)64 * cg_ + i) * 512 + h * 64;
        *(bf16x8*)(Dw + 16 * hi) = bf[0]; *(bf16x8*)(Dw + 16 * hi + 8) = bf[1]; *(bf16x8*)(Dw + 32 + 16 * hi) = bf[2]; *(bf16x8*)(Dw + 32 + 16 * hi + 8) = bf[3]; }
    f32x16 n0 = up16(s.d[0], s.d[1]), n1 = up16(s.d[2], s.d[3]);
#pragma unroll
    for (int s2 = 0; s2 < 4; ++s2) { n0 = __builtin_amdgcn_mfma_f32_32x32x16_bf16(s.ta[0][s2], bf[s2], n0, 0, 0, 0); n1 = __builtin_amdgcn_mfma_f32_32x32x16_bf16(s.ta[1][s2], bf[s2], n1, 0, 0, 0); }
    X0 = n0; X1 = n1;
}
__device__ __forceinline__ void rwkv_scan(const Ctx& F, int b, int h, int half) {
    const int lane = F.lane, r32 = lane & 31, hi = lane >> 5, i = 32 * half + r32;
    const bf16_t* TTg = (const bf16_t*)(F.ws + WS_TT); bf16_t* Rg = (bf16_t*)(F.ws + WS_R);
    f32x16 X0, X1;
#pragma unroll
    for (int r = 0; r < 16; ++r) { X0[r] = 0.f; X1[r] = 0.f; }
    RwSet sA, sB, sC; const int c0 = b * 128;
    rw_load(sA, TTg, Rg, c0 + 0, h, i, r32, hi); rw_load(sB, TTg, Rg, c0 + 1, h, i, r32, hi); rw_load(sC, TTg, Rg, c0 + 2, h, i, r32, hi);
    for (int c = 0; c < 129; c += 3) {
        rw_step(X0, X1, sA, Rg, c0 + c, h, i, hi, true);          rw_load(sA, TTg, Rg, c0 + min(c + 3, 127), h, i, r32, hi);
        rw_step(X0, X1, sB, Rg, c0 + c + 1, h, i, hi, true);      rw_load(sB, TTg, Rg, c0 + min(c + 4, 127), h, i, r32, hi);
        rw_step(X0, X1, sC, Rg, c0 + min(c + 2, 127), h, i, hi, c + 2 < 128); rw_load(sC, TTg, Rg, c0 + min(c + 5, 127), h, i, r32, hi);
    }
}
__device__ __forceinline__ void ssd_scan(const Ctx& F, int item) {
    const int b = item >> 4, h = (item >> 1) & 7, hp = item & 1, g = h >> 2, hl = h & 3;
    const int piece = hp * 512 + F.tid;
    const int f = hl * 8192 + piece * 8, row = f >> 9, col = ssd_win_col(g, f & 511);
    bf16_t* ST = (bf16_t*)(F.ws + WS_XBC); const float* CDEC = (const float*)(F.ws + WS_CDEC);
    float st[8];
#pragma unroll
    for (int j = 0; j < 8; ++j) st[j] = 0.f;
    for (int c8 = 0; c8 < 128; c8 += 8) {
        u32x4 v[8]; float cd[8];
#pragma unroll
        for (int u = 0; u < 8; ++u) { const int cg_ = b * 128 + c8 + u; v[u] = *(const u32x4*)(ST + ((size_t)64 * cg_ + row) * 1024 + col); cd[u] = CDEC[cg_ * 8 + h]; }
#pragma unroll
        for (int u = 0; u < 8; ++u) { const int cg_ = b * 128 + c8 + u;
            u32x4 o; o.x = pk2(st[0], st[1]); o.y = pk2(st[2], st[3]); o.z = pk2(st[4], st[5]); o.w = pk2(st[6], st[7]);
            *(u32x4*)(ST + ((size_t)64 * cg_ + row) * 1024 + col) = o;
            const float x[8] = {bflo(v[u].x), bfhi(v[u].x), bflo(v[u].y), bfhi(v[u].y), bflo(v[u].z), bfhi(v[u].z), bflo(v[u].w), bfhi(v[u].w)};
#pragma unroll
            for (int j = 0; j < 8; ++j) st[j] = st[j] * cd[u] + x[j]; }
    }
}
constexpr size_t CTL_QUEUE = 32768;
template <int VAR = 0> __device__ __forceinline__ void p4_mix(const Ctx& F, int qslot, int what = 3) {
    const int x = F.bid & 7, li = F.bid >> 3;
    if ((what & 2) && li < 8) { const int st = li * 8 + x;
        if (st < 32) { if (!(what & 8) && F.wave == 0) rwkv_scan(F, st >> 4, (st >> 1) & 7, st & 1); }
        else if (!(what & 4)) ssd_scan(F, st - 32); }
    if (what & 1) {
        unsigned* ctr = (unsigned*)(F.ws + WS_CTL + CTL_QUEUE) + (qslot * 8 + x) * 64;
        volatile LAS int* qw = (volatile LAS int*)(F.lds + LDS_BYTES - 128);
        for (;;) {
            if (F.tid == 0) *qw = (int)__hip_atomic_fetch_add(ctr, 1u, __ATOMIC_RELAXED, __HIP_MEMORY_SCOPE_AGENT);
            __syncthreads();
            const int k = *qw;
            __syncthreads();
            if (k >= 64) break;
            const int rb = 4 * k + (x >> 1), c = 127 - (rb >> 1), hp = rb & 1, b = x & 1;
            attn_unit<VAR>(F, b, c, hp);
        }
    }
}
template <int VAR = 0> __device__ __forceinline__ void p5_assemble(const Ctx& F, int l) {
    bf16_t* GT = (bf16_t*)(F.ws + WS_GATES);
    if (!(VAR & 1)) {   pg8::Gemm g{(const bf16_t*)(F.ws + WS_OL), (const bf16_t*)(F.ws + WS_WUV), NT, 512, 256, 512, 512, 256};     pg8::StaticOrder S; S.init(NT, 512, F.G, F.bid); EpiUV E{GT};
        pg8::gemm_phase<EpiUV, pg8::StaticOrder, true, true>(F.lds, F.wave, g, S, E); }
    __syncthreads();
    int lane = fresh_lane(); const int tid = F.wave * 64 + lane, wave = F.wave;
    const int gw = F.bid * NWAVES + F.wave, NGW = F.G * NWAVES;
    {   constexpr int O_CC = 0, O_YO = 33792;
        const bf16_t* Cbuf = (const bf16_t*)(F.ws + WS_CB); const float* ECUM = (const float*)(F.ws + WS_ECUM); const bf16_t* ST = (const bf16_t*)(F.ws + WS_XBC); const bf16_t* YD = (const bf16_t*)(F.ws + WS_YD);
        const float* snw = INP(I_SSDNW) + l * 512;
        for (int c = F.bid; c < ((VAR & 2) ? 0 : NCHK); c += F.G) {
            const size_t m0 = (size_t)64 * c; const int h = wave, g = h >> 2, hl = h & 3;
            bf16x8 pf[4][4];
#pragma unroll
            for (int pi = 0; pi < 4; ++pi)
#pragma unroll
                for (int ks = 0; ks < 4; ++ks) { const int f = hl * 8192 + (16 * pi + (lane & 15)) * 128 + 32 * ks + 8 * (lane >> 4), row = f >> 9, col = ssd_win_col(g, f & 511);
                    pf[pi][ks] = *(const bf16x8*)(ST + (m0 + row) * 1024 + col); }
            {   LAS bf16_t* CC = (LAS bf16_t*)(F.lds + O_CC);
#pragma unroll
                for (int i = 0; i < 4; ++i) { const int idx = tid + 512 * i, t = idx >> 5, c8 = idx & 31; *(LAS u32x4*)(CC + t * 264 + c8 * 8) = *(const u32x4*)(Cbuf + (m0 + t) * 256 + c8 * 8); } }
            __syncthreads();
            {   const LAS bf16_t* CC = (const LAS bf16_t*)(F.lds + O_CC) + g * 128; LAS bf16_t* YO = (LAS bf16_t*)(F.lds + O_YO);
#pragma unroll
                for (int ti = 0; ti < 4; ++ti) {
                    bf16x8 af[4];
#pragma unroll
                    for (int ks = 0; ks < 4; ++ks) af[ks] = *(const LAS bf16x8*)(CC + (16 * ti + (lane & 15)) * 264 + 32 * ks + 8 * (lane >> 4));
                    float ec[4];
#pragma unroll
                    for (int r = 0; r < 4; ++r) ec[r] = ECUM[(size_t)(c * 8 + h) * 64 + 16 * ti + 4 * (lane >> 4) + r];
#pragma unroll
                    for (int pi = 0; pi < 4; ++pi) { f32x4 acc = {0.f, 0.f, 0.f, 0.f};
#pragma unroll
                        for (int ks = 0; ks < 4; ++ks) acc = __builtin_amdgcn_mfma_f32_16x16x32_bf16(af[ks], pf[pi][ks], acc, 0, 0, 0);
#pragma unroll
                        for (int r = 0; r < 4; ++r) YO[(16 * ti + 4 * (lane >> 4) + r) * 520 + 64 * h + 16 * pi + (lane & 15)] = (bf16_t)f2bf(acc[r] * ec[r]); }
                }
            }
            __syncthreads();
            {   const LAS bf16_t* YO = (const LAS bf16_t*)(F.lds + O_YO);
                u32x4 ydv[8], zv[8];
#pragma unroll
                for (int rr = 0; rr < 8; ++rr) { const int t = 8 * wave + rr; ydv[rr] = *(const u32x4*)(YD + (m0 + t) * 512 + 8 * lane); zv[rr] = *(const u32x4*)(GT + (m0 + t) * 1536 + 512 + 8 * lane); }
                const f32x4 w0 = *(const f32x4*)(snw + 8 * lane), w1 = *(const f32x4*)(snw + 8 * lane + 4);
#pragma unroll
                for (int rr = 0; rr < 8; ++rr) { const int t = 8 * wave + rr; const u32x4 w = *(const LAS u32x4*)(YO + t * 520 + 8 * lane);
                    const unsigned wa[4] = {w.x, w.y, w.z, w.w}, ya[4] = {ydv[rr].x, ydv[rr].y, ydv[rr].z, ydv[rr].w}, za[4] = {zv[rr].x, zv[rr].y, zv[rr].z, zv[rr].w};
                    float v[8]; float q = 0.f;
#pragma unroll
                    for (int j = 0; j < 8; ++j) { const int k2 = j >> 1; const float yo = (j & 1) ? bfhi(wa[k2]) : bflo(wa[k2]), yd = (j & 1) ? bfhi(ya[k2]) : bflo(ya[k2]), zz = (j & 1) ? bfhi(za[k2]) : bflo(za[k2]);
                        v[j] = (yd + yo) * siluf_(zz); q += v[j] * v[j]; }
                    const float rs = __builtin_amdgcn_rsqf(wave_sum(q) * (1.f / 512.f) + EPS);
                    u32x4 o; o.x = pk2(v[0] * rs * w0[0], v[1] * rs * w0[1]); o.y = pk2(v[2] * rs * w0[2], v[3] * rs * w0[3]); o.z = pk2(v[4] * rs * w1[0], v[5] * rs * w1[1]); o.w = pk2(v[6] * rs * w1[2], v[7] * rs * w1[3]);
                    *(u32x4*)(GT + (m0 + t) * 1536 + 512 + 8 * lane) = o; } }
            __syncthreads();
        }
    }
    LAS float* SW = (LAS float*)(F.lds + F.wave * 16640);
    const bf16_t* Yt = (const bf16_t*)(F.ws + WS_K); const bf16_t* SF = (const bf16_t*)(F.ws + WS_R); const bf16_t* QEg = (const bf16_t*)(F.ws + WS_QE);
    const bf16_t* BON = (const bf16_t*)(F.ws + WS_V); const float* lw = INP(I_LNXW) + l * 512; const float* lb = INP(I_LNXB) + l * 512;
    for (int w = gw; w < ((VAR & 4) ? 0 : NCHK * 8); w += NGW) {
        asm volatile("" : "+v"(lane));
        const int cg_ = w >> 3, h = w & 7, r32 = lane & 31, hi = lane >> 5; const size_t m0 = (size_t)64 * cg_;
        const bf16_t* QEw = QEg + (size_t)(cg_ * 8 + h) * 4096;
        bf16x8 qa[2][4];
#pragma unroll
        for (int tb = 0; tb < 2; ++tb)
#pragma unroll
            for (int s2 = 0; s2 < 4; ++s2) qa[tb][s2] = *(const bf16x8*)(QEw + (32 * tb + r32) * 64 + 16 * s2 + 8 * hi);
#pragma unroll
        for (int ih = 0; ih < 2; ++ih) { const size_t ro = (m0 + 32 * ih + r32) * 512 + h * 64;
            const bf16x8 bf[4] = {*(const bf16x8*)(SF + ro + 16 * hi), *(const bf16x8*)(SF + ro + 16 * hi + 8), *(const bf16x8*)(SF + ro + 32 + 16 * hi), *(const bf16x8*)(SF + ro + 32 + 16 * hi + 8)};
#pragma unroll
            for (int tb = 0; tb < 2; ++tb) { f32x16 y = ld16bf(Yt + ro + 32 * tb + 16 * hi);
#pragma unroll
                for (int s2 = 0; s2 < 4; ++s2) y = __builtin_amdgcn_mfma_f32_32x32x16_bf16(qa[tb][s2], bf[s2], y, 0, 0, 0);
#pragma unroll
                for (int r = 0; r < 16; ++r) SW[(32 * tb + crow(r, hi)) * 65 + 32 * ih + r32] = y[r]; } }
        LDS_WAIT();
        {   float y[64]; float sm = 0.f;
#pragma unroll
            for (int i = 0; i < 64; ++i) { y[i] = SW[lane * 65 + i]; sm += y[i]; }
            const float mean = sm * (1.f / 64.f); float q = 0.f;
#pragma unroll
            for (int i = 0; i < 64; ++i) { y[i] -= mean; q += y[i] * y[i]; }
            const float rs = 1.f / sqrtf(q * (1.f / 64.f) + GN_EPS);
#pragma unroll
            for (int i = 0; i < 64; ++i) SW[lane * 65 + i] = y[i] * rs; }
        LDS_WAIT();
        u32x4 bwv[8], gvv[8];
#pragma unroll
        for (int it = 0; it < 8; ++it) { const int t = it * 8 + (lane >> 3), i0 = (lane & 7) * 8; const size_t row = m0 + t;
            bwv[it] = *(const u32x4*)(BON + row * 512 + h * 64 + i0); gvv[it] = *(const u32x4*)(GT + row * 1536 + 1024 + h * 64 + i0); }
#pragma unroll
        for (int it = 0; it < 8; ++it) { const int t = it * 8 + (lane >> 3), i0 = (lane & 7) * 8; const size_t row = m0 + t;
            const u32x4 bw = bwv[it]; u32x4* gp = (u32x4*)(GT + row * 1536 + 1024 + h * 64 + i0); const u32x4 gv = gvv[it];
            const float bo[8] = {bflo(bw.x), bfhi(bw.x), bflo(bw.y), bfhi(bw.y), bflo(bw.z), bfhi(bw.z), bflo(bw.w), bfhi(bw.w)};
            const float gg[8] = {bflo(gv.x), bfhi(gv.x), bflo(gv.y), bfhi(gv.y), bflo(gv.z), bfhi(gv.z), bflo(gv.w), bfhi(gv.w)};
            float ov[8];
#pragma unroll
            for (int j = 0; j < 8; ++j) ov[j] = (SW[t * 65 + i0 + j] * lw[h * 64 + i0 + j] + lb[h * 64 + i0 + j] + bo[j]) * siluf_(gg[j]);
            u32x4 o; o.x = pk2(ov[0], ov[1]); o.y = pk2(ov[2], ov[3]); o.z = pk2(ov[4], ov[5]); o.w = pk2(ov[6], ov[7]); *gp = o; }
        LDS_WAIT();
    }
}
__device__ __forceinline__ void p7_final(const Ctx& F) {
    const int gw = F.bid * NWAVES + F.wave, NGW = F.G * NWAVES; const float* fw = INP(I_FNW);
    for (int m = gw; m < NT; m += NGW) {
        f32x4* xr = (f32x4*)(F.out + (size_t)m * DM) + F.lane; f32x4 v[4]; float s = 0.f;
#pragma unroll
        for (int j = 0; j < 4; ++j) { v[j] = xr[64 * j]; s += v[j].x * v[j].x + v[j].y * v[j].y + v[j].z * v[j].z + v[j].w * v[j].w; }
        const float rstd = 1.f / sqrtf(wave_sum(s) * (1.f / DM) + EPS);
#pragma unroll
        for (int j = 0; j < 4; ++j) xr[64 * j] = v[j] * rstd * *(const f32x4*)(fw + 4 * F.lane + 256 * j);
    }
}

#define RLX_AGENT __ATOMIC_RELAXED, __HIP_MEMORY_SCOPE_AGENT
#define XB_TMO      128
#define XB_XCNT(j)  (256  + 64 * (j))
#define XB_XSUB(j)  (1280 + 64 * (j))
#define XB_XGEN(j)  (2304 + 64 * (j))
#define XB_TOP      3328
#define XB_TOPGEN   3392
#define XCD_BAR_WORDS 3456
#define XB_SPIN_CAP (1u << 18)

__device__ __forceinline__ unsigned xb_ld(unsigned* p)              { return __hip_atomic_load(p, __ATOMIC_RELAXED, __HIP_MEMORY_SCOPE_AGENT); }
__device__ __forceinline__ unsigned xb_add(unsigned* p, unsigned v) { return __hip_atomic_fetch_add(p, v, __ATOMIC_RELAXED, __HIP_MEMORY_SCOPE_AGENT); }
__device__ __forceinline__ unsigned xb_xcc_id() { return (unsigned)__builtin_amdgcn_s_getreg((3 << 11) | 20) & 0xFu; }
#define XB_SPIN(cond, bar) do { unsigned _sp = 0; while (cond) { __builtin_amdgcn_s_sleep(1); \
    if ((++_sp & 255u) == 0u) { if (xb_ld(&(bar)[XB_TMO])) break; if (_sp > XB_SPIN_CAP) { atomicAdd(&(bar)[XB_TMO], 1u); break; } } } } while (0)

struct XcdBarrier {
    unsigned* bar; unsigned x;
    volatile LAS unsigned* st;
};

__device__ __forceinline__ XcdBarrier xcd_barrier_post(unsigned* bar, volatile LAS unsigned* st) {
    XcdBarrier b; b.bar = bar; b.x = xb_xcc_id(); b.st = st;
    if (threadIdx.x == 0) (void)xb_add(&bar[XB_XCNT(b.x)], 1u);
    return b;
}
__device__ __forceinline__ void xcd_barrier_complete(unsigned* bar, unsigned x, unsigned& nloc, unsigned& nx) {
    const unsigned G = gridDim.x * gridDim.y * gridDim.z;
    unsigned sum, cnt, mine, sp = 0u;
    for (;;) {
        sum = 0u; cnt = 0u; mine = 0u;
#pragma unroll
        for (unsigned j = 0; j < 16; ++j) { const unsigned c = xb_ld(&bar[XB_XCNT(j)]); sum += c; cnt += (c > 0u) ? 1u : 0u; mine = (j == x) ? c : mine; }
        if (sum == G) break;
        __builtin_amdgcn_s_sleep(1);
        if ((++sp & 255u) == 0u) { if (xb_ld(&bar[XB_TMO])) break; if (sp > XB_SPIN_CAP) { atomicAdd(&bar[XB_TMO], 1u); break; } }
    }
    nloc = mine > 0u ? mine : 1u; nx = cnt > 0u ? cnt : 1u;
}

__device__ __forceinline__ void xcd_barrier(const XcdBarrier& b) {
    asm volatile("s_waitcnt vmcnt(0)" ::: "memory");
    __syncthreads();
    if (threadIdx.x == 0) {
        unsigned* bar = b.bar;
        __builtin_amdgcn_s_waitcnt(0);
        unsigned nloc = b.st[0], nx = b.st[1];
        if (nloc == 0u) { xcd_barrier_complete(bar, b.x, nloc, nx); b.st[0] = nloc; b.st[1] = nx; }
        const unsigned old = xb_add(&bar[XB_XSUB(b.x)], 1u);
        const unsigned gen = old / nloc;
        if (old + 1u == (gen + 1u) * nloc) {
            __builtin_amdgcn_fence(__ATOMIC_RELEASE, "agent");
            asm volatile("s_waitcnt vmcnt(0)" ::: "memory");
            const unsigned og = xb_add(&bar[XB_TOP], 1u);
            const unsigned tg = og / nx;
            if (og + 1u == (tg + 1u) * nx) xb_add(&bar[XB_TOPGEN], 1u);
            else XB_SPIN(xb_ld(&bar[XB_TOPGEN]) == tg, bar);
            __builtin_amdgcn_fence(__ATOMIC_ACQUIRE, "agent");
            xb_add(&bar[XB_XGEN(b.x)], 1u);
            asm volatile("s_waitcnt vmcnt(0)" ::: "memory");
        } else {
            XB_SPIN(xb_ld(&bar[XB_XGEN(b.x)]) == gen, bar);
            __builtin_amdgcn_fence(__ATOMIC_ACQUIRE, "agent");
            asm volatile("s_waitcnt vmcnt(0)" ::: "memory");
        }
    }
    __syncthreads();
}


#define LAYER(l) do { \
        const int pb = 1 + 8 * l; \
        if (IN(pb + 0)) { PHB(); prep_weights(F, l); if (l == 0) p0_rope(F); p1_norm(F, l); SEAM(pb + 0); } \
        if (IN(pb + 1)) { PHB(); \
            pg8::Gemm g{(const bf16_t*)(F.ws + WS_XN), (const bf16_t*)(F.ws + WS_WIN), NT, NIN, DM, DM, DM}; pg8::StaticOrder S; S.init(NT, NIN, F.G, F.bid); \
            EpiIn E{F.ws, l}; \
            pg8::gemm_phase<EpiIn, pg8::StaticOrder, true, true>(F.lds, F.wave, g, S, E); \
            SEAM(pb + 1); \
        } \
        if (IN(pb + 2)) { PHB(); \
            pg8::Gemm g{(const bf16_t*)(F.ws + WS_QLAT), (const bf16_t*)(F.ws + WS_WQ), NT, 768, 256, 256, 256}; pg8::StaticOrder S; S.init(NT, 768, F.G, F.bid); \
            EpiQ E{F.ws, l}; \
            pg8::gemm_phase<EpiQ, pg8::StaticOrder, true, true>(F.lds, F.wave, g, S, E); \
            p3a_extras(F, l); \
        } \
        if (IN(pb + 3)) { PHB(); p3b_ssd(F, l); __syncthreads(); } \
        if (IN(pb + 4)) { PHB(); p3c_rwkv(F, l); SEAM(pb + 4); } \
        if (IN(pb + 5)) { PHB(); p4_mix(F, l); SEAM(pb + 5); } \
        if (IN(pb + 6)) { PHB(); p5_assemble(F, l); SEAM(pb + 6); } \
        if (IN(pb + 7)) { PHB(); \
            pg8::Gemm g{(const bf16_t*)(F.ws + WS_GATES), (const bf16_t*)(F.ws + WS_WOUT), NT, DM, 1536, 1536, 1536}; pg8::StaticOrder S; S.init(NT, DM, F.G, F.bid); \
            EpiOut E{(l == 0) ? INP(I_X) : F.out, F.out, (const float*)(F.ws + WS_CTL + CTL_MOD) + (size_t)(l * 2) * 3072 + 2048}; \
            pg8::gemm_phase<EpiOut, pg8::StaticOrder, true, true>(F.lds, F.wave, g, S, E); \
            SEAM(pb + 7); \
        } \
    } while (0)
__global__ void __launch_bounds__(NTHR, 2) mk_fwd(Args args) {
    extern __shared__ __attribute__((aligned(16))) unsigned char lds_raw[];
    Ctx F; F.lds = (LAS unsigned char*)lds_raw; F.tid = threadIdx.x; F.lane = F.tid & 63; F.wave = __builtin_amdgcn_readfirstlane(F.tid >> 6);
    F.G = gridDim.x; F.bid = blockIdx.x; F.ws = args.ws; F.out = args.out; F.in = args.in;
    const int wave0 = F.wave;
    cg::grid_group grid = cg::this_grid();
    volatile LAS unsigned* xst = (volatile LAS unsigned*)(F.lds + LDS_BYTES - 256);
    if (threadIdx.x < 2) xst[threadIdx.x] = 0u;
    __syncthreads();
    const XcdBarrier xbar = xcd_barrier_post((unsigned*)(args.ws + WS_CTL) + 4096, xst);
#if MK_PER_PHASE
    const int lo = args.ph_lo, hi = args.ph_hi;
#else
    constexpr int lo = 0, hi = 18;
#endif
#ifndef MK_ONLY
#define MK_ONLY -1
#endif
#define IN(k) (lo <= (k) && (k) < hi && (MK_ONLY < 0 || MK_ONLY == ((k) == 0 ? 0 : (k) == 17 ? 17 : 1 + ((k) - 1) % 8)))
#if MK_PER_PHASE
#define SEAM(k) do { } while (0)
#else
#define SEAM(k) do { xcd_barrier(xbar); } while (0)
#endif
#define PHB() do { int b_ = blockIdx.x, g_ = gridDim.x, v_ = wave0; asm volatile("" : "+s"(b_), "+s"(g_), "+s"(v_)); F.bid = b_; F.G = g_; F.wave = v_; int t_ = v_ * 64 + (int)__builtin_amdgcn_mbcnt_hi(~0u, __builtin_amdgcn_mbcnt_lo(~0u, 0u)); asm volatile("; PHASE_MARK %0" : "+v"(t_)); F.tid = t_; F.lane = t_ & 63; unsigned wl_ = __builtin_amdgcn_readfirstlane((unsigned)(uintptr_t)args.ws), wh_ = __builtin_amdgcn_readfirstlane((unsigned)((uintptr_t)args.ws >> 32)), ol_ = __builtin_amdgcn_readfirstlane((unsigned)(uintptr_t)args.out), oh_ = __builtin_amdgcn_readfirstlane((unsigned)((uintptr_t)args.out >> 32)); asm volatile("" : "+s"(wl_), "+s"(wh_), "+s"(ol_), "+s"(oh_)); F.ws = (unsigned char*)(GAS unsigned char*)(((uintptr_t)wh_ << 32) | wl_); F.out = (float*)(GAS float*)(((uintptr_t)oh_ << 32) | ol_); } while (0)
    if (IN(0)) { PHB(); p0_mod(F); SEAM(0); }
    LAYER(0);
    LAYER(1);
    if (IN(17)) { PHB(); p7_final(F); }
#ifndef MK_RERUN
#define MK_RERUN 0
#endif
#define PHB2() do { int b_ = blockIdx.x, g_ = gridDim.x, v_ = wave0; asm volatile("" : "+s"(b_), "+s"(g_), "+s"(v_)); F.bid = b_; F.G = g_; F.wave = v_; int t_ = v_ * 64 + fresh_lane(); F.tid = t_; F.lane = t_ & 63; } while (0)
#if MK_RERUN
    { constexpr int l = 1;
    if (MK_RERUN & 1) { xcd_barrier(xbar); PHB2(); p1_norm(F, l); }
    if (MK_RERUN & 8192) { xcd_barrier(xbar); PHB2(); prep_weights(F, 1); }
    if (MK_RERUN & 2) { xcd_barrier(xbar); PHB2(); pg8::Gemm g{(const bf16_t*)(F.ws + WS_XN), (const bf16_t*)(F.ws + WS_WIN), NT, NIN, DM, DM, DM}; pg8::StaticOrder S; S.init(NT, NIN, F.G, F.bid); EpiIn E{F.ws, l}; pg8::gemm_phase<EpiIn, pg8::StaticOrder, true, true>(F.lds, F.wave, g, S, E); }
    if (MK_RERUN & 4) { xcd_barrier(xbar); PHB2(); pg8::Gemm g{(const bf16_t*)(F.ws + WS_QLAT), (const bf16_t*)(F.ws + WS_WQ), NT, 768, 256, 256, 256}; pg8::StaticOrder S; S.init(NT, 768, F.G, F.bid); EpiQ E{F.ws, l}; pg8::gemm_phase<EpiQ, pg8::StaticOrder, true, true>(F.lds, F.wave, g, S, E); p3a_extras(F, l); }
    if (MK_RERUN & 8) { xcd_barrier(xbar); PHB2(); p3b_ssd<MK_AVAR>(F, l); }
    if (MK_RERUN & 16) { xcd_barrier(xbar); PHB2(); p3c_rwkv<MK_AVAR>(F, l); }
    if (MK_RERUN & 32) { xcd_barrier(xbar); PHB2(); p4_mix(F, 2); }
#ifndef MK_AVAR
#define MK_AVAR 0
#endif
    if (MK_RERUN & 512) { xcd_barrier(xbar); PHB2(); p4_mix<MK_AVAR>(F, 2, 1); }
    if (MK_RERUN & 1024) { xcd_barrier(xbar); PHB2(); p4_mix(F, 2, 2); }
    if (MK_RERUN & 2048) { xcd_barrier(xbar); PHB2(); p4_mix(F, 2, 2 | 4); }
    if (MK_RERUN & 4096) { xcd_barrier(xbar); PHB2(); p4_mix(F, 2, 2 | 8); }
    if (MK_RERUN & 64) { xcd_barrier(xbar); PHB2(); p5_assemble<MK_AVAR>(F, l); }
    if (MK_RERUN & 128) { xcd_barrier(xbar); PHB2(); pg8::Gemm g{(const bf16_t*)(F.ws + WS_GATES), (const bf16_t*)(F.ws + WS_WOUT), NT, DM, 1536, 1536, 1536}; pg8::StaticOrder S; S.init(NT, DM, F.G, F.bid);
        EpiOut E{INP(I_X), (float*)(F.ws + WS_XBC), (const float*)(F.ws + WS_CTL + CTL_MOD) + (size_t)(l * 2) * 3072 + 2048}; pg8::gemm_phase<EpiOut, pg8::StaticOrder, true, true>(F.lds, F.wave, g, S, E); }
    }
#endif
#undef IN
#undef SEAM
}
constexpr int N_PHASES = 18;

extern "C" void kernel_launch(void* const* d_in, const int* in_sizes, int n_in, void* d_out, int out_size, void* d_ws, size_t ws_size, hipStream_t stream) {
    static int grid = 0;
    if (grid == 0) {
        if (n_in != 31 || out_size != NT * DM || ws_size < WS_END) { fprintf(stderr, "kernel_launch: unexpected shapes (n_in %d, out %d, ws %zu)\n", n_in, out_size, ws_size); grid = -1; return; }
        int dev = 0, cus = 0, per_cu = 0;
        hipGetDevice(&dev); hipDeviceGetAttribute(&cus, hipDeviceAttributeMultiprocessorCount, dev);
        if (hipFuncSetAttribute((const void*)mk_fwd, hipFuncAttributeMaxDynamicSharedMemorySize, LDS_BYTES) != hipSuccess) { fprintf(stderr, "kernel_launch: hipFuncSetAttribute failed\n"); grid = -1; return; }
        hipOccupancyMaxActiveBlocksPerMultiprocessor(&per_cu, (const void*)mk_fwd, NTHR, LDS_BYTES);
        (void)hipGetLastError();
        if (per_cu < 1) per_cu = 1;
        grid = cus;
        fprintf(stderr, "kernel_launch: cus %d, occupancy query %d block(s)/CU, grid %d\n", cus, per_cu, grid);
    }
    if (grid < 0) return;
    hipMemsetAsync((char*)d_ws + WS_CTL, 0, CTL_BYTES, stream);
    Args a{};
    for (int i = 0; i < 31; ++i) a.in[i] = (const float*)d_in[i];
    a.out = (float*)d_out; a.ws = (unsigned char*)d_ws;
#if MK_PER_PHASE
    for (int p = 0; p < N_PHASES; ++p) { a.ph_lo = p; a.ph_hi = p + 1; hipLaunchKernelGGL(mk_fwd, dim3(grid), dim3(NTHR), LDS_BYTES, stream, a); }
#else
    a.ph_lo = 0; a.ph_hi = N_PHASES;
    void* params[] = {&a};
    hipError_t e = hipLaunchCooperativeKernel((const void*)mk_fwd, dim3(grid), dim3(NTHR), params, LDS_BYTES, stream);
    if (e != hipSuccess) fprintf(stderr, "kernel_launch: cooperative launch failed: %s\n", hipGetErrorString(e));
#endif
}
```

```cpp
#include <hip/hip_runtime.h>
#include <hip/hip_cooperative_groups.h>
#include <cstdio>
#include <cstdint>
namespace cg = cooperative_groups;

#define LAS __attribute__((address_space(3)))
#define GAS __attribute__((address_space(1)))
typedef unsigned short bf16_t;
typedef short bf16x8 __attribute__((ext_vector_type(8)));
typedef float f32x4 __attribute__((ext_vector_type(4)));
typedef float f32x2 __attribute__((ext_vector_type(2)));
typedef float f32x16 __attribute__((ext_vector_type(16)));
typedef unsigned u32x4 __attribute__((ext_vector_type(4)));
typedef unsigned u32x2 __attribute__((ext_vector_type(2)));
typedef short v4i16_t __attribute__((ext_vector_type(4)));

#ifndef MK_PER_PHASE
#define MK_PER_PHASE 0
#endif

namespace pg8 {
constexpr int BM = 256, BK = 64, HALF = 128, HTB = HALF * BK * 2, STAGE_BYTES = 8 * HTB, NXCD = 8, WGM = 8;
__host__ __device__ __forceinline__ int lds_byte(int r, int c) { const int st = (r >> 4) * 2 + (c >> 5), rr = r & 15, cc = c & 31, ob = rr * 64 + cc * 2; return st * 1024 + (ob ^ (((ob >> 9) & 1) << 5)); }
__host__ __device__ __forceinline__ void stage_rc(int b, int& R, int& C) { const int st = b / 1024, sb = b % 1024, swz = sb ^ (((sb >> 9) & 1) << 5); R = (st >> 1) * 16 + swz / 64; C = (st & 1) * 32 + (swz % 64) / 2; }
__host__ __device__ __forceinline__ int perm32(int rho) { const int n = rho >> 4, i = rho & 15; return 8 * (i >> 2) + 4 * n + (i & 3); }
struct Unit { int pm, pn; };
struct Gemm { const bf16_t* A; const bf16_t* Bt; int M, N, K, lda, ldb; int kdiag = 0; };
struct StaticOrder {
    int nM, nN, nwg, G, c;
    __host__ __device__ void init(int M, int N, int G_, int c_) { nM = M / BM; nN = N / BM; nwg = nM * nN; G = G_; c = c_; }
    __host__ __device__ bool next(int i, Unit& u) const {
        const long L = (long)i * G + c; if (L >= nwg) return false;
        int wgid = (int)L; { const int q = nwg / NXCD, r = nwg % NXCD, xcd = wgid % NXCD, off = wgid / NXCD; wgid = (xcd < r ? xcd * (q + 1) : r * (q + 1) + (xcd - r) * q) + off; }
        const int nig = WGM * nN, gid = wgid / nig, fm = gid * WGM, gsz = (nM - fm) < WGM ? (nM - fm) : WGM;
        u.pm = fm + ((wgid % nig) % gsz); u.pn = (wgid % nig) / gsz; return true;
    }
};
template <class Epi, class Sched, bool ALIGN_EPI, bool SP2>
__device__ __forceinline__ void gemm_phase(LAS unsigned char* lds, int wave_id, const Gemm g, const Sched& S, const Epi& E) {
    int lane = (int)__builtin_amdgcn_mbcnt_hi(~0u, __builtin_amdgcn_mbcnt_lo(~0u, 0u)); asm volatile("" : "+v"(lane));
    const int wid = wave_id, tid = wid * 64 + lane, wr = wid >> 2, wc = wid & 3, fr = lane & 15, fq = lane >> 4;
    const int K = g.K, nt = K / BK;
    unsigned voffA[2], voffB[2];
#pragma unroll
    for (int i = 0; i < 2; ++i) { int R, C; stage_rc(tid * 16 + i * 8192, R, C); const int Rb = (R & ~31) + perm32(R & 31);
        voffA[i] = (unsigned)(R * g.lda + C) * 2u; voffB[i] = (unsigned)(Rb * g.ldb + C) * 2u; }
    const size_t kstep = (size_t)(BK * 2);
    const size_t hstepA = (size_t)HALF * g.lda * 2, hstepB = (size_t)HALF * g.ldb * 2;
    const size_t tstepA = 2 * hstepA, tstepB = 2 * hstepB;
    const unsigned ldsw = (unsigned)wid * 1024u, lds0 = (unsigned)(uintptr_t)lds;
    const int aoff = lds_byte(wr * 64 + fr, fq * 8), boff = lds_byte(wc * 32 + fr, fq * 8);
#define PG8_SA(b, h) (((b) * 2 + (h)) * HTB)
#define PG8_SB(b, h) ((4 + (b) * 2 + (h)) * HTB)
#define PG8_STAGE(bufoff, gbase, voff) do { _Pragma("unroll") for (int _i = 0; _i < 2; ++_i) { unsigned keep_; \
        asm volatile("s_mov_b32 %0, m0\n\ts_mov_b32 m0, %3\n\ts_nop 0\n\tglobal_load_lds_dwordx4 %1, %2\n\ts_mov_b32 m0, %0" : "=&s"(keep_) : "v"((voff)[_i]), "s"((const char*)(gbase)), "s"(lds0 + (unsigned)(bufoff) + ldsw + (unsigned)(_i * 8192)) : "memory"); } } while (0)
#define PG8_LDA(dst, b, h) do { _Pragma("unroll") for (int m = 0; m < 4; ++m) _Pragma("unroll") for (int k = 0; k < 2; ++k) dst[m][k] = *(const LAS bf16x8*)(lds + PG8_SA(b, h) + aoff + m * 2048 + k * 1024); } while (0)
#define PG8_LDB(dst, b, h) do { _Pragma("unroll") for (int n = 0; n < 2; ++n) _Pragma("unroll") for (int k = 0; k < 2; ++k) dst[n][k] = *(const LAS bf16x8*)(lds + PG8_SB(b, h) + boff + n * 2048 + k * 1024); } while (0)
#define PG8_MMA(ai, bj, At, Bt) do { __builtin_amdgcn_s_setprio(1); _Pragma("unroll") for (int m = 0; m < 4; ++m) _Pragma("unroll") for (int n = 0; n < 2; ++n) _Pragma("unroll") for (int k = 0; k < 2; ++k) \
        acc[ai][bj][m][n] = __builtin_amdgcn_mfma_f32_16x16x32_bf16(Bt[n][k], At[m][k], acc[ai][bj][m][n], 0, 0, 0); __builtin_amdgcn_s_setprio(0); } while (0)
#define PG8_WAIT_V(n) asm volatile("s_waitcnt vmcnt(" #n ")" ::: "memory")
#define PG8_WAIT_L(n) asm volatile("s_waitcnt lgkmcnt(" #n ")" ::: "memory")
#define PG8_BAR __builtin_amdgcn_s_barrier()
#define PG8_SCHED __builtin_amdgcn_sched_barrier(0)
    Unit cur, nxt; int ui = 0;
    if (!S.next(0, cur)) return;
    f32x4 acc[2][2][4][2];
#pragma unroll
    for (int a = 0; a < 2; ++a)
#pragma unroll
        for (int b = 0; b < 2; ++b)
#pragma unroll
            for (int m = 0; m < 4; ++m)
#pragma unroll
                for (int n = 0; n < 2; ++n) acc[a][b][m][n] = (f32x4){0.f, 0.f, 0.f, 0.f};
    bf16x8 At[4][2], B0[2][2], B1[2][2];
    const char* cA = (const char*)g.A + (size_t)cur.pm * tstepA + (size_t)cur.pn * g.kdiag * 2; const char* cB = (const char*)g.Bt + (size_t)cur.pn * tstepB + (size_t)cur.pn * g.kdiag * 2;
    if constexpr (SP2) {
        PG8_STAGE(PG8_SB(0, 0), cB, voffB); PG8_STAGE(PG8_SB(0, 1), cB + hstepB, voffB); PG8_STAGE(PG8_SA(0, 0), cA, voffA); PG8_STAGE(PG8_SA(0, 1), cA + hstepA, voffA);
        if (wr == 1) PG8_BAR;
        PG8_WAIT_V(2); PG8_BAR;
        PG8_STAGE(PG8_SB(1, 0), cB + kstep, voffB); PG8_STAGE(PG8_SA(1, 0), cA + kstep, voffA); PG8_STAGE(PG8_SB(1, 1), cB + hstepB + kstep, voffB);
        PG8_WAIT_V(6); PG8_BAR;
    } else {
        PG8_STAGE(PG8_SB(0, 0), cB, voffB); PG8_STAGE(PG8_SA(0, 0), cA, voffA); PG8_STAGE(PG8_SB(0, 1), cB + hstepB, voffB); PG8_STAGE(PG8_SA(0, 1), cA + hstepA, voffA);
        if (wr == 1) PG8_BAR;
        PG8_WAIT_V(4); PG8_BAR;
        PG8_STAGE(PG8_SB(1, 0), cB + kstep, voffB); PG8_STAGE(PG8_SA(1, 0), cA + kstep, voffA); PG8_STAGE(PG8_SB(1, 1), cB + hstepB + kstep, voffB);
        PG8_WAIT_V(6); PG8_BAR;
    }
    for (;;) {
        const bool has_next = S.next(ui + 1, nxt);
        const char* nA = has_next ? (const char*)g.A + (size_t)nxt.pm * tstepA + (size_t)nxt.pn * g.kdiag * 2 : cA; const char* nB = has_next ? (const char*)g.Bt + (size_t)nxt.pn * tstepB + (size_t)nxt.pn * g.kdiag * 2 : cB;
        for (int t = 0; t < nt; t += 2) {
            const bool last = (t == nt - 2);
            const char* a1 = cA + (size_t)(t + 1) * kstep;
            const char* a2 = last ? nA : cA + (size_t)(t + 2) * kstep; const char* b2 = last ? nB : cB + (size_t)(t + 2) * kstep;
            const char* a3 = a2 + kstep; const char* b3 = b2 + kstep;
            if constexpr (SP2) {
            PG8_LDB(B0, 0, 0); PG8_LDB(B1, 0, 1); PG8_SCHED; PG8_LDA(At, 0, 0); PG8_STAGE(PG8_SA(1, 1), a1 + hstepA, voffA);
            PG8_WAIT_V(8); PG8_WAIT_L(0); PG8_BAR; PG8_MMA(0, 0, At, B0); PG8_MMA(0, 1, At, B1); PG8_BAR; PG8_SCHED;
            PG8_LDA(At, 0, 1); PG8_STAGE(PG8_SB(0, 0), b2, voffB); PG8_STAGE(PG8_SB(0, 1), b2 + hstepB, voffB); PG8_STAGE(PG8_SA(0, 0), a2, voffA);
            PG8_WAIT_V(8); PG8_WAIT_L(0); PG8_BAR; PG8_MMA(1, 0, At, B0); PG8_MMA(1, 1, At, B1); PG8_BAR; PG8_SCHED;
            PG8_LDB(B0, 1, 0); PG8_LDB(B1, 1, 1); PG8_SCHED; PG8_LDA(At, 1, 0); PG8_STAGE(PG8_SA(0, 1), a2 + hstepA, voffA);
            PG8_WAIT_V(8); PG8_WAIT_L(0); PG8_BAR; PG8_MMA(0, 0, At, B0); PG8_MMA(0, 1, At, B1); PG8_BAR; PG8_SCHED;
            PG8_LDA(At, 1, 1); PG8_STAGE(PG8_SB(1, 0), b3, voffB); PG8_STAGE(PG8_SB(1, 1), b3 + hstepB, voffB); PG8_STAGE(PG8_SA(1, 0), a3, voffA);
            PG8_WAIT_V(8); PG8_WAIT_L(0); PG8_BAR; PG8_MMA(1, 0, At, B0); PG8_MMA(1, 1, At, B1); PG8_BAR; PG8_SCHED;
            } else {
            PG8_LDB(B0, 0, 0); PG8_SCHED; PG8_LDA(At, 0, 0); PG8_STAGE(PG8_SA(1, 1), a1 + hstepA, voffA);
            PG8_WAIT_L(8); PG8_BAR; PG8_WAIT_L(0); PG8_MMA(0, 0, At, B0); PG8_BAR; PG8_SCHED;
            PG8_LDB(B1, 0, 1); PG8_STAGE(PG8_SB(0, 0), b2, voffB);
            PG8_BAR; PG8_WAIT_L(0); PG8_MMA(0, 1, At, B1); PG8_BAR;
            PG8_LDA(At, 0, 1); PG8_STAGE(PG8_SA(0, 0), a2, voffA);
            PG8_BAR; PG8_WAIT_L(0); PG8_MMA(1, 0, At, B0); PG8_BAR; PG8_SCHED;
            PG8_STAGE(PG8_SB(0, 1), b2 + hstepB, voffB);
            PG8_WAIT_V(6); PG8_BAR; PG8_MMA(1, 1, At, B1); PG8_BAR;
            PG8_LDB(B0, 1, 0); PG8_SCHED; PG8_LDA(At, 1, 0); PG8_STAGE(PG8_SA(0, 1), a2 + hstepA, voffA);
            PG8_WAIT_L(8); PG8_BAR; PG8_WAIT_L(0); PG8_MMA(0, 0, At, B0); PG8_BAR; PG8_SCHED;
            PG8_LDB(B1, 1, 1); PG8_STAGE(PG8_SB(1, 0), b3, voffB);
            PG8_BAR; PG8_WAIT_L(0); PG8_MMA(0, 1, At, B1); PG8_BAR;
            PG8_LDA(At, 1, 1); PG8_STAGE(PG8_SA(1, 0), a3, voffA);
            PG8_BAR; PG8_WAIT_L(0); PG8_MMA(1, 0, At, B0); PG8_BAR; PG8_SCHED;
            PG8_STAGE(PG8_SB(1, 1), b3 + hstepB, voffB);
            PG8_WAIT_V(6); PG8_BAR; PG8_MMA(1, 1, At, B1); PG8_BAR;
            }
        }
        if constexpr (ALIGN_EPI) { if (wr == 0) PG8_BAR; }
        if constexpr (!Epi::AFTER_DRAIN) E(acc, cur, wr, wc, fr, fq);
        if (!has_next) break;
#pragma unroll
        for (int a = 0; a < 2; ++a)
#pragma unroll
            for (int b = 0; b < 2; ++b)
#pragma unroll
                for (int m = 0; m < 4; ++m)
#pragma unroll
                    for (int n = 0; n < 2; ++n) acc[a][b][m][n] = (f32x4){0.f, 0.f, 0.f, 0.f};
        cur = nxt; cA = nA; cB = nB; ++ui;
        if constexpr (ALIGN_EPI) { if (wr == 1) PG8_BAR; }
    }
    PG8_WAIT_V(0);
    if constexpr (!ALIGN_EPI) { if (wr == 0) PG8_BAR; }
    PG8_BAR;
    if constexpr (Epi::AFTER_DRAIN) E.fused(acc, cur, wr, wc, lds, wid);
#undef PG8_SA
#undef PG8_SB
#undef PG8_STAGE
#undef PG8_LDA
#undef PG8_LDB
#undef PG8_MMA
#undef PG8_WAIT_V
#undef PG8_WAIT_L
#undef PG8_BAR
#undef PG8_SCHED
}
}

constexpr int NT = 16384, SEQ = 8192, DM = 1024, DIN = 4680, NIN = 4864, NCHK = 256, NWAVES = 8, NTHR = 512;
constexpr float EPS = 1e-6f, GN_EPS = 64e-5f, DECAY_SCALE = 0.606531f;
constexpr float QSCALE = 0.07216878364870322f * 1.4426950408889634f;
constexpr size_t MiB = 1u << 20;
constexpr size_t WS_CTL = 0, CTL_BYTES = 1 * MiB;
constexpr size_t CTL_MOD = 65536;
constexpr size_t CTL_SSQ = 131072;
constexpr size_t CTL_RSLOT = 393216;
constexpr size_t CTL_RCNT = 917504;
constexpr size_t WS_WIN = 1 * MiB;
constexpr size_t WS_CB = WS_WIN, WS_ECUM = WS_WIN + 8 * MiB, WS_CDEC = WS_ECUM + 512 * 1024;
constexpr size_t WS_WQ = 10 * MiB + 512 * 1024;
constexpr size_t WS_WUV = 11 * MiB;
constexpr size_t WS_WLW = 11 * MiB + 512 * 1024;
constexpr size_t WS_WLA = WS_WLW + 65536;
constexpr size_t WS_WOUT = 12 * MiB;
constexpr size_t WS_XN = 15 * MiB;
constexpr size_t WS_TT = WS_XN, WS_QE = WS_XN + 16 * MiB;
constexpr size_t WS_QLAT = 47 * MiB, WS_KVL = 55 * MiB;
constexpr size_t WS_OL = WS_QLAT;
constexpr size_t WS_GATES = 63 * MiB;
constexpr size_t WS_XBC = 111 * MiB;
constexpr size_t WS_R = 143 * MiB, WS_K = 159 * MiB, WS_V = 175 * MiB;
constexpr size_t WS_F = 191 * MiB;
constexpr size_t WS_Q = 200 * MiB;
constexpr size_t WS_KVB = 224 * MiB;
constexpr size_t WS_YD = 230 * MiB;
constexpr size_t WS_ROPE = 246 * MiB;
constexpr size_t WS_HX = 250 * MiB;
constexpr size_t WS_HRKV = WS_HX + 1536 * 1024;
constexpr size_t WS_HF = WS_HRKV + 768 * 1024;
constexpr size_t WS_END = 253 * MiB;
constexpr int LDS_BYTES = 152 * 1024;

#define LDS_WAIT() asm volatile("s_waitcnt lgkmcnt(0)" ::: "memory")
typedef __bf16 bf16x2_hw __attribute__((ext_vector_type(2)));
__device__ __forceinline__ unsigned pk2(float lo, float hi) { const f32x2 v = {lo, hi}; return __builtin_bit_cast(unsigned, __builtin_convertvector(v, bf16x2_hw)); }
__device__ __forceinline__ unsigned f2bf(float f) { return pk2(f, 0.f) & 0xffffu; }
__device__ __forceinline__ float bf2f(unsigned short b) { return __builtin_bit_cast(float, (unsigned)b << 16); }
__device__ __forceinline__ float bflo(unsigned w) { return __builtin_bit_cast(float, w << 16); }
__device__ __forceinline__ float bfhi(unsigned w) { return __builtin_bit_cast(float, w & 0xffff0000u); }
__device__ __forceinline__ float wave_sum(float v) {
#pragma unroll
    for (int o = 1; o < 64; o <<= 1) v += __shfl_xor(v, o);
    return v;
}
__device__ __forceinline__ float sigmoidf_(float x) { return __builtin_amdgcn_rcpf(1.f + __expf(-x)); }
__device__ __forceinline__ float siluf_(float x) { return x * __builtin_amdgcn_rcpf(1.f + __expf(-x)); }
__device__ __forceinline__ int pi16(int n) { const int x = n & 15; return (n & ~15) | ((x >= 4 && x < 8) ? x + 4 : (x >= 8 && x < 12) ? x - 4 : x); }
__device__ __forceinline__ int sg32(int x) { return (x & ~31) | (16 * ((x >> 2) & 1) + 4 * ((x & 31) >> 3) + (x & 3)); }
__device__ __forceinline__ int crow(int r, int hi) { return (r & 3) + 8 * (r >> 2) + 4 * hi; }

template <int K> __device__ __forceinline__ f32x4 mma_tile(const LAS bf16_t* A, int lda, const LAS bf16_t* Bt, int ldb, int lane) {
    f32x4 acc = {0.f, 0.f, 0.f, 0.f};
    const LAS bf16_t* ap = A + (lane & 15) * lda + (lane >> 4) * 8;
    const LAS bf16_t* bp = Bt + (lane & 15) * ldb + (lane >> 4) * 8;
#pragma unroll
    for (int k = 0; k < K; k += 32) {
        const bf16x8 a = *(const LAS bf16x8*)(ap + k), b = *(const LAS bf16x8*)(bp + k);
        acc = __builtin_amdgcn_mfma_f32_16x16x32_bf16(a, b, acc, 0, 0, 0);
    }
    return acc;
}

template <int V> struct IC { static constexpr int value = V; };
template <bool KX> __device__ __forceinline__ bf16x8 frag16(const LAS bf16_t* M, int ld, int x0, int k0, int lane) {
    if constexpr (!KX) return *(const LAS bf16x8*)(M + (x0 + (lane & 15)) * ld + k0 + 8 * (lane >> 4));
    else { const LAS bf16_t* p = M + (k0 + 8 * (lane >> 4) + ((lane & 15) >> 2)) * ld + x0 + 4 * (lane & 3);
        const v4i16_t lo = __builtin_amdgcn_ds_read_tr16_b64_v4i16((LAS v4i16_t*)p), hi = __builtin_amdgcn_ds_read_tr16_b64_v4i16((LAS v4i16_t*)(p + 4 * ld));
        return (bf16x8){lo[0], lo[1], lo[2], lo[3], hi[0], hi[1], hi[2], hi[3]}; }
}
template <int K, bool AKX, bool BKX> __device__ __forceinline__ f32x4 mma_tile2(const LAS bf16_t* A, int lda, int m0, const LAS bf16_t* B, int ldb, int n0, int lane) {
    f32x4 acc = {0.f, 0.f, 0.f, 0.f};
#pragma unroll
    for (int k = 0; k < K; k += 32) acc = __builtin_amdgcn_mfma_f32_16x16x32_bf16(frag16<AKX>(A, lda, m0, k, lane), frag16<BKX>(B, ldb, n0, k, lane), acc, 0, 0, 0);
    return acc;
}
struct Args {
    const float* in[31]; float* out; unsigned char* ws; int ph_lo, ph_hi;
};
struct Ctx {
    LAS unsigned char* lds; int tid, lane, wave, G, bid;
    unsigned char* ws; float* out;
    const float* const* in;
};
__device__ __forceinline__ const float* ldin(const float* const* in, int i) { asm volatile("" : "+s"(i)); return (const float*)(const GAS float*)in[i]; }
#define INP(i) ldin(F.in, i)
__device__ __forceinline__ int fresh_lane() { int l_ = (int)__builtin_amdgcn_mbcnt_hi(~0u, __builtin_amdgcn_mbcnt_lo(~0u, 0u)); asm volatile("" : "+v"(l_)); return l_; }
enum { I_X = 0, I_C, I_POS, I_ADAW, I_ADAB, I_NORMW, I_WIN, I_QNW, I_WUQ, I_KVNW, I_WUKV, I_CONVW, I_CONVB, I_DTB, I_ALOG, I_DSKIP, I_SSDNW,
       I_MURKV, I_MUW, I_MUA, I_W0, I_WLB, I_A0, I_ALB, I_KK, I_KA, I_RK, I_LNXW, I_LNXB, I_WOUT, I_FNW };

__device__ __forceinline__ int win_src_col(int n) {
    if (n < 448) return n;
    if (n < 512) return -1;
    if (n < 1024) return 448 + (n - 512);
    if (n < 1536) return 960 + (n - 1024);
    if (n < 2560) return 1472 + (n - 1536);
    if (n < 3072) return 2504 + (n - 2560);
    if (n < 3584) return 3016 + (n - 3072);
    if (n < 4096) return 3528 + (n - 3584);
    if (n < 4608) return 4168 + (n - 4096);
    if (n < 4672) return 4040 + (n - 4608);
    if (n < 4736) return 4104 + (n - 4672);
    if (n < 4744) return 2496 + (n - 4736);
    return -1;
}
template <class Src4> __device__ __forceinline__ void transpose_item(const Src4& src4, bf16_t* WT, int ldw, LAS float* scr, int kb, int nb, int lane) {
    const int k0 = 64 * kb, n0 = 64 * nb;
#pragma unroll 8
    for (int i = 0; i < 16; ++i) { const int kk = 4 * i + (lane >> 4), nn = 4 * (lane & 15); const f32x4 v = src4(k0 + kk, n0 + nn);
        LAS float* d = scr + kk * 65 + nn; d[0] = v[0]; d[1] = v[1]; d[2] = v[2]; d[3] = v[3]; }
    LDS_WAIT();
    const int c = lane & 7;
#pragma unroll
    for (int j = 0; j < 8; ++j) { const int n = (lane >> 3) + 8 * j; const LAS float* sp = scr + (8 * c) * 65 + n;
        u32x4 o; o.x = pk2(sp[0 * 65], sp[1 * 65]); o.y = pk2(sp[2 * 65], sp[3 * 65]); o.z = pk2(sp[4 * 65], sp[5 * 65]); o.w = pk2(sp[6 * 65], sp[7 * 65]);
        *(u32x4*)(WT + (size_t)(n0 + n) * ldw + k0 + 8 * c) = o; }
    LDS_WAIT();
}
__device__ __forceinline__ void prep_weights(const Ctx& F, int l) {
    LAS float* scr = (LAS float*)(F.lds + F.wave * 16640);
    const int gw = F.bid * NWAVES + F.wave, NGW = F.G * NWAVES;
    const float* w_in = INP(I_WIN) + (size_t)l * DM * DIN;
    const float* w_out = INP(I_WOUT) + (size_t)l * 1536 * 1024;
    const float* wlb = INP(I_WLB) + (size_t)l * 64 * 512;
    const float* alb = INP(I_ALB) + (size_t)l * 64 * 512;
    bf16_t* WIN = (bf16_t*)(F.ws + WS_WIN); bf16_t* WOUT = (bf16_t*)(F.ws + WS_WOUT); bf16_t* WLW = (bf16_t*)(F.ws + WS_WLW); bf16_t* WLA = (bf16_t*)(F.ws + WS_WLA);
    constexpr int I_IN = 16 * (NIN / 64), I_OUT = 24 * 16, I_LW = 8, I_LA = 8, NITEMS = I_IN + I_OUT + I_LW + I_LA;
    for (int it = gw; it < NITEMS; it += NGW) {
        int r = it;
        if (r < I_IN) { const int kb = r / (NIN / 64), nb = r % (NIN / 64);
            transpose_item([&](int k, int n) { const int sc = win_src_col(n); return sc >= 0 ? *(const f32x4*)(w_in + (size_t)k * DIN + sc) : (f32x4){0.f, 0.f, 0.f, 0.f}; }, WIN, 1024, scr, kb, nb, F.lane); continue; }
        r -= I_IN;
        if (r < I_OUT) { const int kb = r / 16, nb = r % 16;
            transpose_item([&](int k, int n) { return *(const f32x4*)(w_out + (size_t)k * 1024 + n); }, WOUT, 1536, scr, kb, nb, F.lane); continue; }
        r -= I_OUT;
        if (r < I_LW) { transpose_item([&](int k, int n) { return *(const f32x4*)(wlb + k * 512 + n); }, WLW, 64, scr, 0, r, F.lane); continue; }
        r -= I_LW;
        transpose_item([&](int k, int n) { return *(const f32x4*)(alb + k * 512 + n); }, WLA, 64, scr, 0, r, F.lane);
    }
    const float* wuq = INP(I_WUQ) + (size_t)l * 256 * 768; const float* wukv = INP(I_WUKV) + (size_t)l * 128 * 1024; const float* qnw = INP(I_QNW) + l * 256;
    bf16_t* WQ = (bf16_t*)(F.ws + WS_WQ); bf16_t* WUV = (bf16_t*)(F.ws + WS_WUV);
    const int gt = F.bid * NTHR + F.tid, NGT = F.G * NTHR;
    for (int e = gt; e < 768 * 256; e += NGT) {
        const int n = e >> 8, k = e & 255, h = n / 192, idx = n % 192; float v;
        if (idx < 128) {
            const f32x4* a = (const f32x4*)(wuq + (size_t)k * 768 + h * 192); const f32x4* b = (const f32x4*)(wukv + (size_t)idx * 1024 + h * 256);
            float s = 0.f;
#pragma unroll 8
            for (int d = 0; d < 32; ++d) { const f32x4 x = a[d], y = b[d]; s += x.x * y.x + x.y * y.y + x.z * y.z + x.w * y.w; }
            v = s;
        } else v = wuq[(size_t)k * 768 + n];
        WQ[e] = (bf16_t)f2bf(v * qnw[k]);
    }
    for (int e = gt; e < 512 * 512; e += NGT) {
        const int n = e >> 9, k = e & 511, h = n >> 7, d = n & 127, h2 = k >> 7, c = k & 127;
        WUV[e] = (h == h2) ? (bf16_t)f2bf(wukv[(size_t)c * 1024 + h * 256 + 128 + d]) : (bf16_t)0;
    }
}
__device__ __forceinline__ void p0_mod(const Ctx& F) {
    const int gw = F.bid * NWAVES + F.wave, NGW = F.G * NWAVES;
    float* MOD = (float*)(F.ws + WS_CTL + CTL_MOD);
    for (int it = gw; it < 2 * 12 * 32; it += NGW) {
        const int l = it / 384, r = it % 384, cb = r / 32, ks = r % 32;
        const float* aw = INP(I_ADAW) + (size_t)l * DM * 3072 + (size_t)(ks * 32) * 3072 + cb * 256 + F.lane * 4;
        const float* cc = INP(I_C);
        f32x4 a0 = {0.f, 0.f, 0.f, 0.f}, a1 = a0;
#pragma unroll 8
        for (int k = 0; k < 32; ++k) { const f32x4 w = *(const f32x4*)(aw + (size_t)k * 3072); const float s0 = siluf_(cc[ks * 32 + k]), s1 = siluf_(cc[DM + ks * 32 + k]); a0 += w * s0; a1 += w * s1; }
        if (ks == 0) { const f32x4 bb = *(const f32x4*)(INP(I_ADAB) + l * 3072 + cb * 256 + F.lane * 4); a0 += bb; a1 += bb; }
        float* m0 = MOD + (size_t)(l * 2 + 0) * 3072 + cb * 256 + F.lane * 4; float* m1 = m0 + 3072;
#pragma unroll
        for (int j = 0; j < 4; ++j) { atomicAdd(m0 + j, a0[j]); atomicAdd(m1 + j, a1[j]); }
    }
}
__device__ __forceinline__ void p0_rope(const Ctx& F) {
    float* ROPE = (float*)(F.ws + WS_ROPE); const int* pos = (const int*)INP(I_POS);
    for (int e = F.bid * NTHR + F.tid; e < NT * 32; e += F.G * NTHR) {
        const int m = e >> 5, i = e & 31;
        const float invf = powf(10000.f, -(float)i / 32.f); const float ang = (float)pos[m] * invf;
        const double a = (double)ang; const double kq = __builtin_rint(a * 0.15915494309189535); const float rr = (float)(a - kq * 6.283185307179586);
        ROPE[(size_t)m * 64 + i] = cosf(rr); ROPE[(size_t)m * 64 + 32 + i] = sinf(rr);
    }
}
__device__ __forceinline__ void p1_norm(const Ctx& F, int l) {
    const float* xin = (l == 0) ? INP(I_X) : F.out;
    const float* nw = INP(I_NORMW) + l * DM; const float* MOD = (const float*)(F.ws + WS_CTL + CTL_MOD);
    bf16_t* XN = (bf16_t*)(F.ws + WS_XN);
    const int gw = F.bid * NWAVES + F.wave, NGW = F.G * NWAVES;
    for (int m = gw; m < NT; m += NGW) {
        const int b = m >> 13; const float* md = MOD + (size_t)(l * 2 + b) * 3072;
        const f32x4* xr = (const f32x4*)(xin + (size_t)m * DM) + F.lane;
        f32x4 v[4]; float s = 0.f;
#pragma unroll
        for (int j = 0; j < 4; ++j) { v[j] = xr[64 * j]; s += v[j].x * v[j].x + v[j].y * v[j].y + v[j].z * v[j].z + v[j].w * v[j].w; }
        const float rstd = 1.f / sqrtf(wave_sum(s) * (1.f / DM) + EPS);
        unsigned long long* o8 = (unsigned long long*)(XN + (size_t)m * DM) + F.lane;
#pragma unroll
        for (int j = 0; j < 4; ++j) { const int c0 = 4 * F.lane + 256 * j;
            const f32x4 w = *(const f32x4*)(nw + c0), sh = *(const f32x4*)(md + c0), sc = *(const f32x4*)(md + 1024 + c0);
            const f32x4 y = v[j] * rstd * w * (sc + 1.f) + sh;
            o8[64 * j] = (unsigned long long)pk2(y.x, y.y) | ((unsigned long long)pk2(y.z, y.w) << 32); }
    }
}
__device__ __forceinline__ u32x4 pack8(f32x4 a, f32x4 b) { u32x4 w; w.x = pk2(a[0], a[1]); w.y = pk2(a[2], a[3]); w.z = pk2(b[0], b[1]); w.w = pk2(b[2], b[3]); return w; }
struct EpiIn {
    static constexpr bool AFTER_DRAIN = false;
    unsigned char* ws; int l;
    __device__ __forceinline__ void operator()(const f32x4 (&acc)[2][2][4][2], const pg8::Unit& u, int wr, int wc, int fr, int fq) const {
        { int ln_ = (int)__builtin_amdgcn_mbcnt_hi(~0u, __builtin_amdgcn_mbcnt_lo(~0u, 0u)); asm volatile("" : "+v"(ln_)); fr = ln_ & 15; fq = ln_ >> 4; }
        const int pn = u.pn; size_t bo; int ld, c0;
        if (pn == 0) { bo = WS_QLAT; ld = 256; c0 = 0; } else if (pn == 1) { bo = WS_KVL; ld = 256; c0 = 0; }
        else if (pn < 4) { bo = WS_GATES; ld = 1536; c0 = (pn - 2) * 256; } else if (pn < 6) { bo = WS_GATES; ld = 1536; c0 = 512 + (pn - 4) * 256; }
        else if (pn < 10) { bo = WS_XBC; ld = 1024; c0 = (pn - 6) * 256; } else if (pn < 12) { bo = WS_R; ld = 512; c0 = (pn - 10) * 256; }
        else if (pn < 14) { bo = WS_K; ld = 512; c0 = (pn - 12) * 256; } else if (pn < 16) { bo = WS_V; ld = 512; c0 = (pn - 14) * 256; }
        else if (pn < 18) { bo = WS_GATES; ld = 1536; c0 = 1024 + (pn - 16) * 256; } else { bo = WS_F; ld = 144; c0 = 0; }
        bf16_t* base = (bf16_t*)(ws + bo); float* F = (float*)(ws + WS_F);
        float* ssq_q = (float*)(ws + WS_CTL + CTL_SSQ) + (size_t)(l * 2) * NT; float* ssq_kv = ssq_q + NT;
        const int row0 = u.pm * 256 + wr * 64 + fr, col0 = wc * 32 + 8 * fq;
        if (pn < 18) {
#pragma unroll
            for (int ai = 0; ai < 2; ++ai)
#pragma unroll
                for (int m = 0; m < 4; ++m) { const int row = row0 + ai * 128 + m * 16; bf16_t* rp = base + (size_t)row * ld + c0 + col0;
#pragma unroll
                    for (int bj = 0; bj < 2; ++bj) *(u32x4*)(rp + bj * 128) = pack8(acc[ai][bj][m][0], acc[ai][bj][m][1]);
                    if (m == 3 && pn >= 6 && pn < 16) {
                        const int chunk = row >> 6;
                        if (pn < 10) { if (fr >= 13) { bf16_t* hp = (bf16_t*)(ws + WS_HX) + (size_t)(chunk * 3 + (fr - 13)) * 1024 + c0 + col0;
#pragma unroll
                                for (int bj = 0; bj < 2; ++bj) *(u32x4*)(hp + bj * 128) = pack8(acc[ai][bj][m][0], acc[ai][bj][m][1]); } }
                        else if (fr == 15) { bf16_t* hp = (bf16_t*)(ws + WS_HRKV) + (size_t)((pn - 10) >> 1) * NCHK * 512 + (size_t)chunk * 512 + c0 + col0;
#pragma unroll
                            for (int bj = 0; bj < 2; ++bj) *(u32x4*)(hp + bj * 128) = pack8(acc[ai][bj][m][0], acc[ai][bj][m][1]); } }
                    if (pn < 2) { float s = 0.f;
#pragma unroll
                        for (int bj = 0; bj < 2; ++bj) if (pn == 0 || bj == 0) {
#pragma unroll
                            for (int n = 0; n < 2; ++n) { const f32x4 x = acc[ai][bj][m][n]; s += x[0] * x[0] + x[1] * x[1] + x[2] * x[2] + x[3] * x[3]; } }
                        s += __shfl_xor(s, 16); s += __shfl_xor(s, 32);
                        if (fq == 0) atomicAdd((pn == 0 ? ssq_q : ssq_kv) + row, s); } }
        } else {
#pragma unroll
            for (int ai = 0; ai < 2; ++ai)
#pragma unroll
                for (int m = 0; m < 4; ++m) { const int row = row0 + ai * 128 + m * 16;
#pragma unroll
                    for (int bj = 0; bj < 2; ++bj) { const int c = bj * 128 + col0; if (c < 136) { float* fp = F + (size_t)row * 144 + c; *(f32x4*)fp = acc[ai][bj][m][0]; *(f32x4*)(fp + 4) = acc[ai][bj][m][1]; } }
                    if (m == 3 && fr == 15) { float* hf = (float*)(ws + WS_HF) + (size_t)(row >> 6) * 128 + col0; *(f32x4*)hf = acc[ai][0][m][0]; *(f32x4*)(hf + 4) = acc[ai][0][m][1]; } }
        }
    }
};
struct EpiQ {
    static constexpr bool AFTER_DRAIN = false;
    unsigned char* ws; int l;
    __device__ __forceinline__ void operator()(const f32x4 (&acc)[2][2][4][2], const pg8::Unit& u, int wr, int wc, int fr, int fq) const {
        { int ln_ = (int)__builtin_amdgcn_mbcnt_hi(~0u, __builtin_amdgcn_mbcnt_lo(~0u, 0u)); asm volatile("" : "+v"(ln_)); fr = ln_ & 15; fq = ln_ >> 4; }
        bf16_t* Q = (bf16_t*)(ws + WS_Q); const float* ssq = (const float*)(ws + WS_CTL + CTL_SSQ) + (size_t)(l * 2) * NT;
        const int row0 = u.pm * 256 + wr * 64 + fr, c0 = u.pn * 256 + wc * 32 + 8 * fq;
#pragma unroll
        for (int ai = 0; ai < 2; ++ai)
#pragma unroll
            for (int m = 0; m < 4; ++m) { const int row = row0 + ai * 128 + m * 16; const float sc = QSCALE / sqrtf(ssq[row] * (1.f / 256.f) + EPS); bf16_t* qp = Q + (size_t)row * 768 + c0;
#pragma unroll
                for (int bj = 0; bj < 2; ++bj) *(u32x4*)(qp + bj * 128) = pack8(acc[ai][bj][m][0] * sc, acc[ai][bj][m][1] * sc); }
    }
};
struct EpiUV {
    static constexpr bool AFTER_DRAIN = false;
    bf16_t* gates;
    __device__ __forceinline__ void operator()(const f32x4 (&acc)[2][2][4][2], const pg8::Unit& u, int wr, int wc, int fr, int fq) const {
        { int ln_ = (int)__builtin_amdgcn_mbcnt_hi(~0u, __builtin_amdgcn_mbcnt_lo(~0u, 0u)); asm volatile("" : "+v"(ln_)); fr = ln_ & 15; fq = ln_ >> 4; }
        const int row0 = u.pm * 256 + wr * 64 + fr;
#pragma unroll
        for (int ai = 0; ai < 2; ++ai)
#pragma unroll
            for (int m = 0; m < 4; ++m) { asm volatile("" ::: "memory"); const int row = row0 + ai * 128 + m * 16;
#pragma unroll
                for (int bj = 0; bj < 2; ++bj) { const int c = u.pn * 256 + bj * 128 + wc * 32 + 8 * fq; u32x4* gp = (u32x4*)(gates + (size_t)row * 1536 + c); const u32x4 gw = *gp;
                    f32x4 v0 = acc[ai][bj][m][0], v1 = acc[ai][bj][m][1];
                    v0[0] *= siluf_(bflo(gw.x)); v0[1] *= siluf_(bfhi(gw.x)); v0[2] *= siluf_(bflo(gw.y)); v0[3] *= siluf_(bfhi(gw.y));
                    v1[0] *= siluf_(bflo(gw.z)); v1[1] *= siluf_(bfhi(gw.z)); v1[2] *= siluf_(bflo(gw.w)); v1[3] *= siluf_(bfhi(gw.w));
                    *gp = pack8(v0, v1); } }
    }
};
struct EpiOutNorm {
    static constexpr bool AFTER_DRAIN = true;
    const float* xin; float* xout; const float* gate; unsigned char* ws; const float* nw; const float* mod1; int mode; int use;
    __device__ __forceinline__ void fused(f32x4 (&acc)[2][2][4][2], const pg8::Unit& u, int wr, int wc, LAS unsigned char* lds, int wid) const {
        const int lane = fresh_lane(), fr = lane & 15, fq = lane >> 4;
        const int row0 = u.pm * 256 + wr * 64 + fr; const int bsel = (u.pm * 256) >> 13;
        LAS float* P = (LAS float*)lds;
        LAS float* S = (LAS float*)(lds + 4096);
        LAS unsigned* flag = (LAS unsigned*)(lds + 5120);
#pragma unroll
        for (int ai = 0; ai < 2; ++ai)
#pragma unroll
            for (int m = 0; m < 4; ++m) { const int row = row0 + ai * 128 + m * 16; float sq = 0.f;
#pragma unroll
                for (int bj = 0; bj < 2; ++bj) { const int c = u.pn * 256 + bj * 128 + wc * 32 + 8 * fq; const float* gp = gate + (size_t)bsel * 3072 + c; const size_t off = (size_t)row * DM + c;
                    const f32x4 g0 = *(const f32x4*)gp, g1 = *(const f32x4*)(gp + 4), x0 = *(const f32x4*)(xin + off), x1 = *(const f32x4*)(xin + off + 4);
                    const f32x4 v0 = x0 + g0 * acc[ai][bj][m][0], v1 = x1 + g1 * acc[ai][bj][m][1]; acc[ai][bj][m][0] = v0; acc[ai][bj][m][1] = v1;
                    sq += v0[0] * v0[0] + v0[1] * v0[1] + v0[2] * v0[2] + v0[3] * v0[3] + v1[0] * v1[0] + v1[1] * v1[1] + v1[2] * v1[2] + v1[3] * v1[3]; }
                sq += __shfl_xor(sq, 16); sq += __shfl_xor(sq, 32);
                if (fq == 0) P[(ai * 128 + wr * 64 + m * 16 + fr) * 4 + wc] = sq;
                asm volatile("" ::: "memory"); }
        asm volatile("s_waitcnt lgkmcnt(0)" ::: "memory"); __builtin_amdgcn_s_barrier(); asm volatile("" ::: "memory");
        float* slots = (float*)(ws + WS_CTL + CTL_RSLOT) + (size_t)use * NT * 4; unsigned* cnt = (unsigned*)(ws + WS_CTL + CTL_RCNT) + (use * 64 + u.pm) * 64;
        const int prow = wid * 32 + (lane & 31);
        if (lane < 32) { const f32x4 pp = *(const LAS f32x4*)(P + prow * 4); const float t = (pp[0] + pp[1]) + (pp[2] + pp[3]);
            __hip_atomic_store(slots + ((size_t)(u.pm * 256 + prow) * 4 + u.pn), t, __ATOMIC_RELAXED, __HIP_MEMORY_SCOPE_AGENT); }
        asm volatile("s_waitcnt vmcnt(0)" ::: "memory");
        if (lane == 0) __hip_atomic_fetch_add(cnt, 1u, __ATOMIC_RELAXED, __HIP_MEMORY_SCOPE_AGENT);
        if (wid == 0) { unsigned spins = 0;
            for (;;) { if ((unsigned)__builtin_amdgcn_readfirstlane(__hip_atomic_load(cnt, __ATOMIC_RELAXED, __HIP_MEMORY_SCOPE_AGENT)) >= 32u) break;
                if (++spins > (1u << 22)) break;
                __builtin_amdgcn_s_sleep(2); }
            __builtin_amdgcn_fence(__ATOMIC_ACQUIRE, "agent");
            if (lane == 0) flag[0] = 1u; }
        asm volatile("s_waitcnt vmcnt(0) lgkmcnt(0)" ::: "memory"); __builtin_amdgcn_s_barrier(); asm volatile("" ::: "memory");
        if (lane < 32) { const float* sl = slots + (size_t)(u.pm * 256 + prow) * 4; float q = 0.f;
#pragma unroll
            for (int t = 0; t < 4; ++t) q += __hip_atomic_load(sl + t, __ATOMIC_RELAXED, __HIP_MEMORY_SCOPE_AGENT);
            S[prow] = __builtin_amdgcn_rsqf(q * (1.f / DM) + EPS); }
        asm volatile("s_waitcnt vmcnt(0) lgkmcnt(0)" ::: "memory"); __builtin_amdgcn_s_barrier(); asm volatile("" ::: "memory");
        const float* shf = mod1 + (size_t)bsel * 3072; bf16_t* XN = (bf16_t*)(ws + WS_XN);
#pragma unroll
        for (int ai = 0; ai < 2; ++ai)
#pragma unroll
            for (int m = 0; m < 4; ++m) { const int rl = ai * 128 + wr * 64 + m * 16 + fr, row = u.pm * 256 + rl; const float rs = S[rl];
#pragma unroll
                for (int bj = 0; bj < 2; ++bj) { const int c = u.pn * 256 + bj * 128 + wc * 32 + 8 * fq; const size_t off = (size_t)row * DM + c;
                    const f32x4 v0 = acc[ai][bj][m][0], v1 = acc[ai][bj][m][1], w0 = *(const f32x4*)(nw + c), w1 = *(const f32x4*)(nw + c + 4);
                    if (mode == 0) { *(f32x4*)(xout + off) = v0; *(f32x4*)(xout + off + 4) = v1;
                        const f32x4 sh0 = *(const f32x4*)(shf + c), sh1 = *(const f32x4*)(shf + c + 4), sc0 = *(const f32x4*)(shf + 1024 + c), sc1 = *(const f32x4*)(shf + 1024 + c + 4);
                        *(u32x4*)(XN + off) = pack8(v0 * rs * w0 * (sc0 + 1.f) + sh0, v1 * rs * w1 * (sc1 + 1.f) + sh1); }
                    else { *(f32x4*)(xout + off) = v0 * rs * w0; *(f32x4*)(xout + off + 4) = v1 * rs * w1; } }
                asm volatile("" ::: "memory"); }
    }
};
struct EpiOut {
    static constexpr bool AFTER_DRAIN = false;
    const float* xin; float* xout; const float* gate;
    __device__ __forceinline__ void operator()(const f32x4 (&acc)[2][2][4][2], const pg8::Unit& u, int wr, int wc, int fr, int fq) const {
        { int ln_ = (int)__builtin_amdgcn_mbcnt_hi(~0u, __builtin_amdgcn_mbcnt_lo(~0u, 0u)); asm volatile("" : "+v"(ln_)); fr = ln_ & 15; fq = ln_ >> 4; }
        const int row0 = u.pm * 256 + wr * 64 + fr;
#pragma unroll
        for (int bj = 0; bj < 2; ++bj) { const int c = u.pn * 256 + bj * 128 + wc * 32 + 8 * fq;
#pragma unroll
            for (int ai = 0; ai < 2; ++ai)
#pragma unroll
                for (int m = 0; m < 4; ++m) { const int row = row0 + ai * 128 + m * 16; const float* gp = gate + (size_t)(row >> 13) * 3072 + c;
                    const f32x4 g0 = *(const f32x4*)gp, g1 = *(const f32x4*)(gp + 4);
                    const size_t off = (size_t)row * DM + c; const f32x4 x0 = *(const f32x4*)(xin + off), x1 = *(const f32x4*)(xin + off + 4);
                    *(f32x4*)(xout + off) = x0 + g0 * acc[ai][bj][m][0]; *(f32x4*)(xout + off + 4) = x1 + g1 * acc[ai][bj][m][1]; } }
    }
};

__device__ __forceinline__ void p3a_extras(const Ctx& F, int l) {
    const int tid_ = F.wave * 64 + fresh_lane();
    const int gt = F.bid * NTHR + tid_, NGT = F.G * NTHR;
    const bf16_t* KVL = (const bf16_t*)(F.ws + WS_KVL); bf16_t* KVB = (bf16_t*)(F.ws + WS_KVB);
    const float* ssq = (const float*)(F.ws + WS_CTL + CTL_SSQ) + (size_t)(l * 2 + 1) * NT; const float* kvnw = INP(I_KVNW) + l * 128;
    const float* ROPE = (const float*)(F.ws + WS_ROPE);
    for (int e = gt; e < NT * 24; e += NGT) {
        const int m = e / 24, g = e % 24;
        if (g < 16) {
            const u32x4 w = *(const u32x4*)(KVL + (size_t)m * 256 + 8 * g); const float rs = 1.f / sqrtf(ssq[m] * (1.f / 128.f) + EPS);
            const f32x4 n0 = *(const f32x4*)(kvnw + 8 * g), n1 = *(const f32x4*)(kvnw + 8 * g + 4);
            u32x4 o; o.x = pk2(bflo(w.x) * rs * n0[0], bfhi(w.x) * rs * n0[1]); o.y = pk2(bflo(w.y) * rs * n0[2], bfhi(w.y) * rs * n0[3]);
            o.z = pk2(bflo(w.z) * rs * n1[0], bfhi(w.z) * rs * n1[1]); o.w = pk2(bflo(w.w) * rs * n1[2], bfhi(w.w) * rs * n1[3]);
            *(u32x4*)(KVB + (size_t)m * 192 + 8 * g) = o;
        } else {
            const int i0 = 4 * (g - 16);
            const u32x2 a = *(const u32x2*)(KVL + (size_t)m * 256 + 128 + i0), b = *(const u32x2*)(KVL + (size_t)m * 256 + 160 + i0);
            const f32x4 cs = *(const f32x4*)(ROPE + (size_t)m * 64 + i0), sn = *(const f32x4*)(ROPE + (size_t)m * 64 + 32 + i0);
            const f32x4 x1 = {bflo(a.x), bfhi(a.x), bflo(a.y), bfhi(a.y)}, x2 = {bflo(b.x), bfhi(b.x), bflo(b.y), bfhi(b.y)};
            const f32x4 o1 = x1 * cs - x2 * sn, o2 = x1 * sn + x2 * cs;
            u32x2 w1, w2; w1.x = pk2(o1[0], o1[1]); w1.y = pk2(o1[2], o1[3]); w2.x = pk2(o2[0], o2[1]); w2.y = pk2(o2[2], o2[3]);
            *(u32x2*)(KVB + (size_t)m * 192 + 128 + i0) = w1; *(u32x2*)(KVB + (size_t)m * 192 + 160 + i0) = w2;
        }
    }
}

__device__ __forceinline__ int ssd_win_col(int g, int o) { return o < 256 ? 256 * g + o : o < 384 ? 512 + 128 * g + (o - 256) : 768 + 128 * g + (o - 384); }
template <int VAR = 0> __device__ __forceinline__ void p3b_ssd(const Ctx& F, int l) {
    constexpr int SC_C = 0, SC_B = 17408, SC_BT = 34816, SC_XST = 53248, SC_CB = 90112, SC_G = 106752, SC_XSD = 115968, SC_DT = 125184, SC_AC = 127232, SC_YS = 129280  , SC_STS = 137472  ;
    static_assert(SC_STS + 16384 <= LDS_BYTES - 256, "ssd lds map");
    LAS bf16_t* Cg = (LAS bf16_t*)(F.lds + SC_C); LAS bf16_t* Bg = (LAS bf16_t*)(F.lds + SC_B); LAS bf16_t* BT = (LAS bf16_t*)(F.lds + SC_BT);
    LAS bf16_t* XST = (LAS bf16_t*)(F.lds + SC_XST); LAS float* CB = (LAS float*)(F.lds + SC_CB); LAS bf16_t* Gh = (LAS bf16_t*)(F.lds + SC_G);
    LAS bf16_t* YS = (LAS bf16_t*)(F.lds + SC_YS); LAS bf16_t* STS = (LAS bf16_t*)(F.lds + SC_STS);
    LAS bf16_t* XSD = (LAS bf16_t*)(F.lds + SC_XSD); LAS float* DT = (LAS float*)(F.lds + SC_DT); LAS float* AC = (LAS float*)(F.lds + SC_AC);
    bf16_t* XBC = (bf16_t*)(F.ws + WS_XBC); const bf16_t* HX = (const bf16_t*)(F.ws + WS_HX); const float* Ff = (const float*)(F.ws + WS_F);
    bf16_t* Cbuf = (bf16_t*)(F.ws + WS_CB); float* ECUM = (float*)(F.ws + WS_ECUM); float* CDEC = (float*)(F.ws + WS_CDEC); bf16_t* YD = (bf16_t*)(F.ws + WS_YD);
    const float* convw = INP(I_CONVW) + (size_t)l * 4 * 1024; const float* convb = INP(I_CONVB) + l * 1024;
    const float* dtb = INP(I_DTB) + l * 8; const float* alog = INP(I_ALOG) + l * 8; const float* dskip = INP(I_DSKIP) + l * 8;
    const int tid = F.tid, lane = F.lane, wave = F.wave;
    for (int c = F.bid; c < NCHK; c += F.G) {
        const int m0 = 64 * c; const bool first = (c & 127) == 0;
        {
            const int t = lane;
            { const int h = wave;
                const float raw = Ff[(size_t)(m0 + t) * 144 + 128 + h] + dtb[h];
                const float dt = raw > 20.f ? raw : log1pf(expf(raw));
                float v = dt * (-expf(alog[h]));
#pragma unroll
                for (int o = 1; o < 64; o <<= 1) { const float y = __shfl_up(v, o); if (lane >= o) v += y; }
                DT[h * 64 + t] = dt; AC[h * 64 + t] = v;
                const float ev = expf(v); ECUM[(size_t)(c * 8 + h) * 64 + t] = ev; if (t == 63) CDEC[c * 8 + h] = ev;
            }
        }
        for (int g = 0; g < 2; ++g) {
            if (!(VAR & 1)) {
                const int cgp = tid & 63, rg = tid >> 6, col = ssd_win_col(g, 8 * cgp), t0 = 8 * rg;
                u32x4 xr[11];
#pragma unroll
                for (int i = 0; i < 11; ++i) { const int t = t0 - 3 + i;
                    if (t >= 0) xr[i] = *(const u32x4*)(XBC + (size_t)(m0 + t) * 1024 + col);
                    else if (!first) xr[i] = *(const u32x4*)(HX + (size_t)((c - 1) * 3 + i) * 1024 + col);
                    else xr[i] = (u32x4){0u, 0u, 0u, 0u}; }
                float wv[4][8], bv8[8];
#pragma unroll
                for (int j = 0; j < 4; ++j) { const f32x4 a = *(const f32x4*)(convw + j * 1024 + col), b2 = *(const f32x4*)(convw + j * 1024 + col + 4);
                    wv[j][0] = a[0]; wv[j][1] = a[1]; wv[j][2] = a[2]; wv[j][3] = a[3]; wv[j][4] = b2[0]; wv[j][5] = b2[1]; wv[j][6] = b2[2]; wv[j][7] = b2[3]; }
                { const f32x4 a = *(const f32x4*)(convb + col), b2 = *(const f32x4*)(convb + col + 4); bv8[0] = a[0]; bv8[1] = a[1]; bv8[2] = a[2]; bv8[3] = a[3]; bv8[4] = b2[0]; bv8[5] = b2[1]; bv8[6] = b2[2]; bv8[7] = b2[3]; }
                float y[8][8];
#pragma unroll
                for (int e = 0; e < 8; ++e) {
                    const unsigned x0[4] = {xr[e].x, xr[e].y, xr[e].z, xr[e].w}, x1[4] = {xr[e + 1].x, xr[e + 1].y, xr[e + 1].z, xr[e + 1].w}, x2[4] = {xr[e + 2].x, xr[e + 2].y, xr[e + 2].z, xr[e + 2].w}, x3[4] = {xr[e + 3].x, xr[e + 3].y, xr[e + 3].z, xr[e + 3].w};
#pragma unroll
                    for (int k = 0; k < 8; ++k) { const int q = k >> 1;
                        const float a0 = (k & 1) ? bfhi(x0[q]) : bflo(x0[q]), a1 = (k & 1) ? bfhi(x1[q]) : bflo(x1[q]), a2 = (k & 1) ? bfhi(x2[q]) : bflo(x2[q]), a3 = (k & 1) ? bfhi(x3[q]) : bflo(x3[q]);
                        y[e][k] = siluf_(wv[0][k] * a0 + wv[1][k] * a1 + wv[2][k] * a2 + wv[3][k] * a3 + bv8[k]); } }
                if (cgp >= 32) { LAS bf16_t* nat = (cgp < 48) ? Bg + 8 * (cgp - 32) : Cg + 8 * (cgp - 48);
#pragma unroll
                    for (int e = 0; e < 8; ++e) { u32x4 o; o.x = pk2(y[e][0], y[e][1]); o.y = pk2(y[e][2], y[e][3]); o.z = pk2(y[e][4], y[e][5]); o.w = pk2(y[e][6], y[e][7]); *(LAS u32x4*)(nat + (t0 + e) * 136) = o; } }
                if (cgp < 48) { LAS bf16_t* trn = (cgp < 32) ? XST + (8 * cgp) * 72 : BT + (8 * (cgp - 32)) * 72;
#pragma unroll
                    for (int k = 0; k < 8; ++k) { u32x4 o; o.x = pk2(y[0][k], y[1][k]); o.y = pk2(y[2][k], y[3][k]); o.z = pk2(y[4][k], y[5][k]); o.w = pk2(y[6][k], y[7][k]); *(LAS u32x4*)(trn + k * 72 + t0) = o; } }
            }
            __syncthreads();
#pragma unroll
            for (int i = 0; i < 2; ++i) { const int idx = tid + 512 * i, t = idx >> 4, c8 = idx & 15;
                *(u32x4*)(Cbuf + (size_t)(m0 + t) * 256 + g * 128 + c8 * 8) = *(const LAS u32x4*)(Cg + t * 136 + c8 * 8); }
#pragma unroll
            for (int i = 0; i < 2; ++i) { const int idx = 2 * wave + i, ti = idx >> 2, si = idx & 3;
                const f32x4 acc = mma_tile<128>(Cg + ti * 16 * 136, 136, Bg + si * 16 * 136, 136, lane);
#pragma unroll
                for (int r = 0; r < 4; ++r) CB[(ti * 16 + 4 * (lane >> 4) + r) * 68 + si * 16 + (lane & 15)] = acc[r]; }
            __syncthreads();
            if (!(VAR & 2)) {
                const int hl = wave >> 1, hf = wave & 1, h = 4 * g + hl, fr = lane & 15, fk = lane >> 4;
                const LAS float* ACh = AC + h * 64; const LAS float* DTh = DT + h * 64; const float a63 = ACh[63], dsk = dskip[h];
#pragma unroll
                for (int ti2 = 0; ti2 < 2; ++ti2) { const int ti = 2 * hf + ti2, t = 16 * ti + fr; const float at = ACh[t];
                    bf16x8 ga[2];
#pragma unroll
                    for (int ks = 0; ks < 2; ++ks) { const int s0 = 32 * ks + 8 * fk;
                        const f32x4 c0 = *(const LAS f32x4*)(CB + t * 68 + s0), c1 = *(const LAS f32x4*)(CB + t * 68 + s0 + 4), a0 = *(const LAS f32x4*)(ACh + s0), a1 = *(const LAS f32x4*)(ACh + s0 + 4), d0 = *(const LAS f32x4*)(DTh + s0), d1 = *(const LAS f32x4*)(DTh + s0 + 4);
                        float gv[8];
#pragma unroll
                        for (int j = 0; j < 4; ++j) { gv[j] = (s0 + j <= t) ? c0[j] * __expf(at - a0[j]) * d0[j] : 0.f; gv[4 + j] = (s0 + 4 + j <= t) ? c1[j] * __expf(at - a1[j]) * d1[j] : 0.f; }
                        u32x4 w; w.x = pk2(gv[0], gv[1]); w.y = pk2(gv[2], gv[3]); w.z = pk2(gv[4], gv[5]); w.w = pk2(gv[6], gv[7]); ga[ks] = __builtin_bit_cast(bf16x8, w); }
#pragma unroll
                    for (int pi = 0; pi < 4; ++pi) { f32x4 acc = {0.f, 0.f, 0.f, 0.f};
#pragma unroll
                        for (int ks = 0; ks < 2; ++ks) acc = __builtin_amdgcn_mfma_f32_16x16x32_bf16(ga[ks], *(const LAS bf16x8*)(XST + (64 * hl + 16 * pi + fr) * 72 + 32 * ks + 8 * fk), acc, 0, 0, 0);
#pragma unroll
                        for (int r = 0; r < 4; ++r) { const int tt = 16 * ti + 4 * fk + r, pp = 16 * pi + fr;
                            YD[(size_t)(m0 + tt) * 512 + 64 * h + pp] = (bf16_t)f2bf(acc[r] + dsk * bf2f(XST[(64 * hl + pp) * 72 + tt])); } }
                }
                {   float fac[2][8];
#pragma unroll
                    for (int ks = 0; ks < 2; ++ks) { const int s0 = 32 * ks + 8 * fk; const f32x4 a0 = *(const LAS f32x4*)(ACh + s0), a1 = *(const LAS f32x4*)(ACh + s0 + 4), d0 = *(const LAS f32x4*)(DTh + s0), d1 = *(const LAS f32x4*)(DTh + s0 + 4);
#pragma unroll
                        for (int j = 0; j < 4; ++j) { fac[ks][j] = d0[j] * __expf(a63 - a0[j]); fac[ks][4 + j] = d1[j] * __expf(a63 - a1[j]); } }
#pragma unroll
                    for (int pi2 = 0; pi2 < 2; ++pi2) { const int pi = 2 * hf + pi2; bf16x8 xa[2];
#pragma unroll
                        for (int ks = 0; ks < 2; ++ks) { const u32x4 xw = *(const LAS u32x4*)(XST + (64 * hl + 16 * pi + fr) * 72 + 32 * ks + 8 * fk);
                            u32x4 w; w.x = pk2(bflo(xw.x) * fac[ks][0], bfhi(xw.x) * fac[ks][1]); w.y = pk2(bflo(xw.y) * fac[ks][2], bfhi(xw.y) * fac[ks][3]); w.z = pk2(bflo(xw.z) * fac[ks][4], bfhi(xw.z) * fac[ks][5]); w.w = pk2(bflo(xw.w) * fac[ks][6], bfhi(xw.w) * fac[ks][7]);
                            xa[ks] = __builtin_bit_cast(bf16x8, w); }
#pragma unroll
                        for (int ni = 0; ni < 8; ++ni) { f32x4 acc = {0.f, 0.f, 0.f, 0.f};
#pragma unroll
                            for (int ks = 0; ks < 2; ++ks) acc = __builtin_amdgcn_mfma_f32_16x16x32_bf16(xa[ks], *(const LAS bf16x8*)(BT + (16 * ni + fr) * 72 + 32 * ks + 8 * fk), acc, 0, 0, 0);
#pragma unroll
                            for (int r = 0; r < 4; ++r) { const int pp = 16 * pi + 4 * fk + r, n = 16 * ni + fr; const int f = hl * 8192 + pp * 128 + n, wr = f >> 9, col = ssd_win_col(g, f & 511);
                                XBC[(size_t)(m0 + wr) * 1024 + col] = (bf16_t)f2bf(acc[r]); } }
                    }
                }
            }
            __syncthreads();
        }
    }
}

template <int VAR = 0> __device__ __forceinline__ void p3c_rwkv(const Ctx& F, int l) {
    constexpr int M9 = 9216, O_TW = 0, O_AL = 9216, O_SL = 18432, O_MAB = O_SL + 12 * M9  , O_LWF = O_SL + 10 * M9  , O_ICF = O_LWF + 17408, O_WL = O_MAB + 16640  , O_SCR = O_WL + 256, O_PAR = O_SCR + 4224  ;
    static_assert(O_ICF + 17408 <= O_MAB + 16640 && O_PAR + 2048 <= LDS_BYTES - 256, "rwkv lds map");
#define LB() ({ LAS unsigned char* p_ = F.lds; asm volatile("" : "+s"(p_)); p_; })
#define SLOT(i) ((LAS bf16_t*)(L + O_SL + (i) * M9))
#define TW ((LAS bf16_t*)(L + O_TW))
#define AL ((LAS bf16_t*)(L + O_AL))
#define AT SLOT(0)
#define ATt SLOT(1)
#define BTl SLOT(2)
#define KTl SLOT(3)
#define RT SLOT(4)
#define BHt SLOT(5)
#define KH SLOT(6)
#define VT SLOT(7)
#define MI SLOT(8)
#define MakT SLOT(9)
#define Rb SLOT(10)
#define Rk SLOT(11)
#define Attn SLOT(0)
#define KEt SLOT(1)
#define X1t SLOT(2)
#define X2t SLOT(3)
#define S8 SLOT(8)
#define S9 SLOT(9)
#define MAB ((LAS float*)(L + O_MAB))
#define LWf ((LAS float*)(L + O_LWF))
#define ICf ((LAS float*)(L + O_ICF))
#define WL ((LAS float*)(L + O_WL))
#define SCR ((LAS float*)(L + O_SCR))
#define PAR ((LAS float*)(L + O_PAR))
    const int tid = F.tid, lane = F.lane, wave = F.wave;
    for (int c = F.bid; c < NCHK; c += F.G) {
        const int m0 = 64 * c; const bool first = (c & 127) == 0;
        {
            LAS unsigned char* L = LB();
            const int t = tid >> 3, q0 = (tid & 7) * 8;
            const float* Ff = (const float*)(F.ws + WS_F); const float* HF = (const float*)(F.ws + WS_HF); const float* mu_w = INP(I_MUW) + l * 64; const float* mu_a = INP(I_MUA) + l * 64;
            float cw[8], pw[8], ca[8], pa[8];
            const float* cur = Ff + (size_t)(m0 + t) * 144; const float* prv = (t > 0) ? cur - 144 : HF + (size_t)(c - 1) * 128;
#pragma unroll
            for (int j = 0; j < 8; ++j) { cw[j] = cur[q0 + j]; ca[j] = cur[64 + q0 + j]; }
            if (t > 0) {
#pragma unroll
                for (int j = 0; j < 8; ++j) { pw[j] = prv[q0 + j]; pa[j] = prv[64 + q0 + j]; }
            } else if (!first) {
#pragma unroll
                for (int j = 0; j < 8; ++j) { pw[j] = prv[q0 + j]; pa[j] = prv[64 + q0 + j]; }
            } else {
#pragma unroll
                for (int j = 0; j < 8; ++j) { pw[j] = 0.f; pa[j] = 0.f; }
            }
            float ow[8], oa[8];
#pragma unroll
            for (int j = 0; j < 8; ++j) { ow[j] = tanhf(cw[j] + (pw[j] - cw[j]) * mu_w[q0 + j]); oa[j] = ca[j] + (pa[j] - ca[j]) * mu_a[q0 + j]; }
            u32x4 o; o.x = pk2(ow[0], ow[1]); o.y = pk2(ow[2], ow[3]); o.z = pk2(ow[4], ow[5]); o.w = pk2(ow[6], ow[7]); *(LAS u32x4*)(TW + t * 72 + q0) = o;
            o.x = pk2(oa[0], oa[1]); o.y = pk2(oa[2], oa[3]); o.z = pk2(oa[4], oa[5]); o.w = pk2(oa[6], oa[7]); *(LAS u32x4*)(AL + t * 72 + q0) = o;
        }
        u32x4 nlw, nla; float npar;
        auto head_fetch = [&](int h_, int tid_) { const int row = tid_ >> 3, c8 = tid_ & 7; const bf16_t* WLW = (const bf16_t*)(F.ws + WS_WLW); const bf16_t* WLA = (const bf16_t*)(F.ws + WS_WLA);
            nlw = *(const u32x4*)(WLW + (size_t)(h_ * 64 + row) * 64 + c8 * 8); nla = *(const u32x4*)(WLA + (size_t)(h_ * 64 + row) * 64 + c8 * 8);
            const int pi = tid_ >> 6, pc = tid_ & 63;
            const float* src = (pi < 3) ? INP(I_MURKV) + (size_t)l * 1536 + pi * 512 : (pi == 3) ? INP(I_KK) + l * 512 : (pi == 4) ? INP(I_KA) + l * 512 : (pi == 5) ? INP(I_RK) + l * 512 : (pi == 6) ? INP(I_W0) + l * 512 : INP(I_A0) + l * 512;
            npar = src[h_ * 64 + pc]; };
        head_fetch(0, F.tid);
        for (int h = 0; h < 8; ++h) {
            int tid = F.tid, lane = F.lane; asm volatile("" : "+v"(tid), "+v"(lane));
            const int t1 = tid >> 3, ch0 = (tid & 7) * 8, col1 = h * 64 + ch0;
            u32x4 rw, kw, vw, rp = {0u, 0u, 0u, 0u}, kp = rp, vp = rp;
            {   const bf16_t* Rg = (const bf16_t*)(F.ws + WS_R); const bf16_t* Kg = (const bf16_t*)(F.ws + WS_K); const bf16_t* Vg = (const bf16_t*)(F.ws + WS_V); const bf16_t* HR = (const bf16_t*)(F.ws + WS_HRKV);
                const size_t off = (size_t)(m0 + t1) * 512 + col1;
                rw = *(const u32x4*)(Rg + off); kw = *(const u32x4*)(Kg + off); vw = *(const u32x4*)(Vg + off);
                if (t1 > 0) { rp = *(const u32x4*)(Rg + off - 512); kp = *(const u32x4*)(Kg + off - 512); vp = *(const u32x4*)(Vg + off - 512); }
                else if (!first) { const size_t ho = (size_t)(c - 1) * 512 + col1; rp = *(const u32x4*)(HR + ho); kp = *(const u32x4*)(HR + (size_t)NCHK * 512 + ho); vp = *(const u32x4*)(HR + (size_t)2 * NCHK * 512 + ho); } }
            {   LAS unsigned char* L = LB(); const int row = tid >> 3, c8 = tid & 7;
                *(LAS u32x4*)(S8 + row * 72 + c8 * 8) = nlw; *(LAS u32x4*)(S9 + row * 72 + c8 * 8) = nla; PAR[(tid >> 6) * 64 + (tid & 63)] = npar; }
            if (h < 7) head_fetch(h + 1, tid);
            __syncthreads();
            if (!(VAR & 16)) {   LAS unsigned char* L = LB(); const int which = wave >> 2, ci = wave & 3, ch = ci * 16 + (lane & 15), g4 = lane >> 4;
                const float bias = PAR[(6 + which) * 64 + ch]; float carry = 0.f;
#pragma unroll
                for (int ti = 0; ti < 4; ++ti) {
                    const f32x4 acc = mma_tile<64>((which ? AL : TW) + ti * 16 * 72, 72, (which ? S9 : S8) + ci * 16 * 72, 72, lane);
                    if (which == 0) {
                        float a[4];
#pragma unroll
                        for (int r = 0; r < 4; ++r) a[r] = -DECAY_SCALE * sigmoidf_(acc[r] + bias);
                        a[1] += a[0]; a[2] += a[1]; a[3] += a[2];
                        float tot = a[3]; const float u1 = __shfl_up(tot, 16); if (g4 >= 1) tot += u1; const float u2 = __shfl_up(tot, 32); if (g4 >= 2) tot += u2;
                        const float base = carry + tot - a[3];
#pragma unroll
                        for (int r = 0; r < 4; ++r) LWf[(ti * 16 + 4 * g4 + r) * 68 + ch] = base + a[r];
                        carry += __shfl(tot, 48 + (lane & 15));
                    } else {
#pragma unroll
                        for (int r = 0; r < 4; ++r) ICf[(ti * 16 + 4 * g4 + r) * 68 + ch] = sigmoidf_(acc[r] + bias);
                    }
                }
                if (which == 0 && g4 == 0) WL[ch] = __expf(carry);
            }
            __syncthreads();
            float bonv[8] = {0.f, 0.f, 0.f, 0.f, 0.f, 0.f, 0.f, 0.f};
            if (!(VAR & 2)) {   LAS unsigned char* L = LB(); const int t = t1;
                const unsigned rwa[4] = {rw.x, rw.y, rw.z, rw.w}, kwa[4] = {kw.x, kw.y, kw.z, kw.w}, vwa[4] = {vw.x, vw.y, vw.z, vw.w};
                const unsigned rpa[4] = {rp.x, rp.y, rp.z, rp.w}, kpa[4] = {kp.x, kp.y, kp.z, kp.w}, vpa[4] = {vp.x, vp.y, vp.z, vp.w};
                float rs[8], ks[8], vs[8], kkv[8], k2[8], ic[8]; float ss = 0.f, bs = 0.f;
                float pr_[6][8], lwt[8], lwp[8], l63[8];
#pragma unroll
                for (int q = 0; q < 6; ++q) { const f32x4 a = *(const LAS f32x4*)(PAR + q * 64 + ch0), b = *(const LAS f32x4*)(PAR + q * 64 + ch0 + 4);
                    pr_[q][0] = a[0]; pr_[q][1] = a[1]; pr_[q][2] = a[2]; pr_[q][3] = a[3]; pr_[q][4] = b[0]; pr_[q][5] = b[1]; pr_[q][6] = b[2]; pr_[q][7] = b[3]; }
                {   const f32x4 a = *(const LAS f32x4*)(ICf + t * 68 + ch0), b = *(const LAS f32x4*)(ICf + t * 68 + ch0 + 4); ic[0] = a[0]; ic[1] = a[1]; ic[2] = a[2]; ic[3] = a[3]; ic[4] = b[0]; ic[5] = b[1]; ic[6] = b[2]; ic[7] = b[3];
                    const f32x4 c0 = *(const LAS f32x4*)(LWf + t * 68 + ch0), c1 = *(const LAS f32x4*)(LWf + t * 68 + ch0 + 4); lwt[0] = c0[0]; lwt[1] = c0[1]; lwt[2] = c0[2]; lwt[3] = c0[3]; lwt[4] = c1[0]; lwt[5] = c1[1]; lwt[6] = c1[2]; lwt[7] = c1[3];
                    const int tp = (t > 0) ? t - 1 : 0; const f32x4 d0 = *(const LAS f32x4*)(LWf + tp * 68 + ch0), d1 = *(const LAS f32x4*)(LWf + tp * 68 + ch0 + 4); const float pm_ = (t > 0) ? 1.f : 0.f;
                    lwp[0] = d0[0] * pm_; lwp[1] = d0[1] * pm_; lwp[2] = d0[2] * pm_; lwp[3] = d0[3] * pm_; lwp[4] = d1[0] * pm_; lwp[5] = d1[1] * pm_; lwp[6] = d1[2] * pm_; lwp[7] = d1[3] * pm_;
                    const f32x4 e0 = *(const LAS f32x4*)(LWf + 63 * 68 + ch0), e1 = *(const LAS f32x4*)(LWf + 63 * 68 + ch0 + 4); l63[0] = e0[0]; l63[1] = e0[1]; l63[2] = e0[2]; l63[3] = e0[3]; l63[4] = e1[0]; l63[5] = e1[1]; l63[6] = e1[2]; l63[7] = e1[3]; }
#pragma unroll
                for (int j = 0; j < 8; ++j) { const int q = j >> 1;
                    const float r_ = (j & 1) ? bfhi(rwa[q]) : bflo(rwa[q]), rq = (j & 1) ? bfhi(rpa[q]) : bflo(rpa[q]);
                    const float k_ = (j & 1) ? bfhi(kwa[q]) : bflo(kwa[q]), kq = (j & 1) ? bfhi(kpa[q]) : bflo(kpa[q]);
                    const float v_ = (j & 1) ? bfhi(vwa[q]) : bflo(vwa[q]), vq = (j & 1) ? bfhi(vpa[q]) : bflo(vpa[q]);
                    rs[j] = r_ + (rq - r_) * pr_[0][j]; ks[j] = k_ + (kq - k_) * pr_[1][j]; vs[j] = v_ + (vq - v_) * pr_[2][j];
                    kkv[j] = ks[j] * pr_[3][j]; ss += kkv[j] * kkv[j];
                    k2[j] = ks[j] * (1.f + (ic[j] - 1.f) * pr_[4][j]); bs += rs[j] * k2[j] * pr_[5][j]; }
                ss += __shfl_xor(ss, 1); ss += __shfl_xor(ss, 2); ss += __shfl_xor(ss, 4);
                bs += __shfl_xor(bs, 1); bs += __shfl_xor(bs, 2); bs += __shfl_xor(bs, 4);
                const float inv = __builtin_amdgcn_rsqf(fmaxf(ss, 1e-24f));
                float vAT[8], vB[8], vK[8], vR[8], vBH[8], vKH[8];
#pragma unroll
                for (int j = 0; j < 8; ++j) { const int ch = ch0 + j;
                    const float LWt = lwt[j], LWp = lwp[j], L63 = l63[j];
                    const float kk = kkv[j] * inv, a = -kk, b = kk * ic[j];
                    const float e1 = __expf(LWt), e2 = __expf(-LWt), e3 = __expf(LWp), e4 = __expf(L63 - LWt);
                    vAT[j] = a * e3; vB[j] = b * e2; vK[j] = k2[j] * e2; vR[j] = rs[j] * e1; vBH[j] = b * e4; vKH[j] = k2[j] * e4; bonv[j] = bs * vs[j];
                    (void)ch; }
                u32x4 o;
#define PK8(A_) (o[0] = pk2(A_[0], A_[1]), o[1] = pk2(A_[2], A_[3]), o[2] = pk2(A_[4], A_[5]), o[3] = pk2(A_[6], A_[7]), o)
                *(LAS u32x4*)(AT + t * 72 + ch0) = PK8(vAT); *(LAS u32x4*)(BTl + t * 72 + ch0) = PK8(vB); *(LAS u32x4*)(KTl + t * 72 + ch0) = PK8(vK);
                *(LAS u32x4*)(RT + t * 72 + ch0) = PK8(vR); *(LAS u32x4*)(KH + t * 72 + ch0) = PK8(vKH); *(LAS u32x4*)(BHt + t * 72 + ch0) = PK8(vBH); *(LAS u32x4*)(VT + t * 72 + ch0) = PK8(vs);
            }
            __syncthreads();
            { u32x4 o; *(u32x4*)((bf16_t*)(F.ws + WS_V) + (size_t)(m0 + t1) * 512 + col1) = PK8(bonv); }
            if (!(VAR & 8)) { LAS unsigned char* L = LB();
                auto run2 = [&](auto PT) { constexpr int p = decltype(PT)::value;
                    f32x4 acc[8];
#pragma unroll
                    for (int i = 0; i < 8; ++i) { const int idx = 8 * (wave & 1) + i, ti = idx >> 2, si = idx & 3;
                        acc[i] = mma_tile<64>(((p < 2) ? AT : RT) + ti * 16 * 72, 72, ((p & 1) ? KTl : BTl) + si * 16 * 72, 72, lane); }
#pragma unroll
                    for (int i = 0; i < 8; ++i) { const int idx = 8 * (wave & 1) + i, ti = idx >> 2, si = idx & 3;
#pragma unroll
                        for (int r = 0; r < 4; ++r) { const int t = ti * 16 + 4 * (lane >> 4) + r, s = si * 16 + (lane & 15);
                            if (p == 0) MAB[t * 65 + s] = (s < t) ? acc[i][r] : 0.f;
                            else if (p == 1) MakT[s * 72 + t] = (bf16_t)f2bf((s < t) ? acc[i][r] : 0.f);
                            else if (p == 2) Rb[t * 72 + s] = (bf16_t)f2bf((s <= t) ? acc[i][r] : 0.f);
                            else Rk[t * 72 + s] = (bf16_t)f2bf((s <= t) ? acc[i][r] : 0.f); } } };
                const int pw = wave >> 1;
                if (pw == 0) run2(IC<0>{}); else if (pw == 1) run2(IC<1>{}); else if (pw == 2) run2(IC<2>{}); else run2(IC<3>{}); }
            __syncthreads();
            if (!(VAR & 1)) {
            if (wave < 4 && lane < 16) { LAS unsigned char* L = LB(); const int b0 = 16 * wave; float x[16];
#pragma unroll
                for (int t = 0; t < 16; ++t) { float v = (t == lane) ? 1.f : 0.f;
#pragma unroll
                    for (int s = 0; s < 16; ++s) if (s < t) v += MAB[(b0 + t) * 65 + b0 + s] * x[s];
                    x[t] = v; }
#pragma unroll
                for (int t = 0; t < 16; ++t) MAB[(b0 + t) * 65 + b0 + lane] = x[t]; }
            __syncthreads();
            if (wave < 2) { LAS unsigned char* L = LB(); const int pr = wave, rb = pr ? 48 : 16, cb = pr ? 32 : 0, fr = lane & 15, fk = lane >> 4; f32x4 acc = {0.f, 0.f, 0.f, 0.f};
#pragma unroll
                for (int ks = 0; ks < 4; ++ks) acc = __builtin_amdgcn_mfma_f32_16x16x4f32(MAB[(rb + fr) * 65 + cb + 4 * ks + fk], MAB[(cb + 4 * ks + fk) * 65 + cb + fr], acc, 0, 0, 0);
#pragma unroll
                for (int r = 0; r < 4; ++r) SCR[(pr * 16 + 4 * fk + r) * 33 + fr] = acc[r]; }
            __syncthreads();
            if (wave < 2) { LAS unsigned char* L = LB(); const int pr = wave, rb = pr ? 48 : 16, cb = pr ? 32 : 0, fr = lane & 15, fk = lane >> 4; f32x4 acc = {0.f, 0.f, 0.f, 0.f};
#pragma unroll
                for (int ks = 0; ks < 4; ++ks) acc = __builtin_amdgcn_mfma_f32_16x16x4f32(MAB[(rb + fr) * 65 + rb + 4 * ks + fk], SCR[(pr * 16 + 4 * ks + fk) * 33 + fr], acc, 0, 0, 0);
#pragma unroll
                for (int r = 0; r < 4; ++r) MAB[(rb + 4 * fk + r) * 65 + cb + fr] = acc[r]; }
            __syncthreads();
            if (wave < 4) { LAS unsigned char* L = LB(); const int ti = wave >> 1, ci = wave & 1, fr = lane & 15, fk = lane >> 4; f32x4 acc = {0.f, 0.f, 0.f, 0.f};
#pragma unroll
                for (int ks = 0; ks < 8; ++ks) acc = __builtin_amdgcn_mfma_f32_16x16x4f32(MAB[(32 + 16 * ti + fr) * 65 + 4 * ks + fk], MAB[(4 * ks + fk) * 65 + 16 * ci + fr], acc, 0, 0, 0);
#pragma unroll
                for (int r = 0; r < 4; ++r) SCR[(16 * ti + 4 * fk + r) * 33 + 16 * ci + fr] = acc[r]; }
            __syncthreads();
            if (wave < 4) { LAS unsigned char* L = LB(); const int ti = wave >> 1, ci = wave & 1, fr = lane & 15, fk = lane >> 4; f32x4 acc = {0.f, 0.f, 0.f, 0.f};
#pragma unroll
                for (int ks = 0; ks < 8; ++ks) acc = __builtin_amdgcn_mfma_f32_16x16x4f32(MAB[(32 + 16 * ti + fr) * 65 + 32 + 4 * ks + fk], SCR[(4 * ks + fk) * 33 + 16 * ci + fr], acc, 0, 0, 0);
#pragma unroll
                for (int r = 0; r < 4; ++r) MAB[(32 + 16 * ti + 4 * fk + r) * 65 + 16 * ci + fr] = acc[r]; }
            __syncthreads();
            {   LAS unsigned char* L = LB(); const int t = tid >> 3, s0 = (tid & 7) * 8; float x[8];
#pragma unroll
                for (int j = 0; j < 8; ++j) x[j] = MAB[t * 65 + s0 + j];
                u32x4 o; *(LAS u32x4*)(MI + t * 72 + s0) = PK8(x); }
            __syncthreads();
            }
            if (!(VAR & 4)) { LAS unsigned char* L = LB();
#pragma unroll
            for (int i = 0; i < 4; ++i) { const int idx = 4 * wave + i, ti = (idx >> 2) & 3, ci = idx & 3; LAS bf16_t* osel = (wave >> 2) ? X2t : X1t;
                const f32x4 acc = (wave >> 2) ? mma_tile<64>(MI + ti * 16 * 72, 72, MakT + ci * 16 * 72, 72, lane) : mma_tile2<64, false, true>(MI, 72, ti * 16, AT, 72, ci * 16, lane);
#pragma unroll
                for (int r = 0; r < 4; ++r) { const int t = ti * 16 + 4 * (lane >> 4) + r, j = ci * 16 + (lane & 15); osel[j * 72 + t] = (bf16_t)f2bf(acc[r]); } } }
            __syncthreads();
            if (!(VAR & 4)) { LAS unsigned char* L = LB();
                auto run5 = [&](auto PT) { constexpr int p = decltype(PT)::value;
                    f32x4 acc[8];
#pragma unroll
                    for (int i = 0; i < 8; ++i) { const int idx = 8 * (wave & 1) + i, ti = idx >> 2, si = idx & 3;
                        if constexpr (p < 2) acc[i] = mma_tile<64>(Rb + ti * 16 * 72, 72, ((p == 0) ? X1t : X2t) + si * 16 * 72, 72, lane);
                        else acc[i] = mma_tile2<64, false, true>((p == 2) ? X1t : X2t, 72, ti * 16, BHt, 72, si * 16, lane);
#pragma unroll
                        for (int r = 0; r < 4; ++r) { const int rw = ti * 16 + 4 * (lane >> 4) + r, cl = si * 16 + (lane & 15);
                            acc[i][r] += (p == 0) ? bf2f(RT[rw * 72 + cl]) : (p == 1) ? bf2f(Rk[rw * 72 + cl]) : (p == 2) ? ((rw == cl) ? WL[rw] : 0.f) : bf2f(KH[rw * 72 + cl]); } }
#pragma unroll
                    for (int i = 0; i < 8; ++i) { const int idx = 8 * (wave & 1) + i, ti = idx >> 2, si = idx & 3;
#pragma unroll
                        for (int r = 0; r < 4; ++r) { const int rw = ti * 16 + 4 * (lane >> 4) + r, cl = si * 16 + (lane & 15);
                            if (p == 0) SLOT(8)[rw * 64 + pi16(cl)] = (bf16_t)f2bf(acc[i][r]);
                            else if (p == 1) Attn[rw * 72 + cl] = (bf16_t)f2bf(acc[i][r]);
                            else if (p == 2) SLOT(9)[cl * 64 + pi16(rw)] = (bf16_t)f2bf(acc[i][r]);
                            else KEt[cl * 72 + rw] = (bf16_t)f2bf(acc[i][r]); } } };
                const int pw = wave >> 1;
                if (pw == 0) run5(IC<0>{}); else if (pw == 1) run5(IC<1>{}); else if (pw == 2) run5(IC<2>{}); else run5(IC<3>{}); }
            __syncthreads();
            {   LAS unsigned char* L = LB();
                *(u32x4*)((bf16_t*)(F.ws + WS_QE) + (size_t)(c * 8 + h) * 4096 + tid * 8) = *(const LAS u32x4*)(SLOT(8) + tid * 8);
                *(u32x4*)((bf16_t*)(F.ws + WS_TT) + (size_t)(c * 8 + h) * 4096 + tid * 8) = *(const LAS u32x4*)(SLOT(9) + tid * 8); }
            LAS unsigned char* L = LB();
#pragma unroll
            for (int i = 0; i < 4; ++i) { const int idx = 4 * wave + i, which = wave >> 2, ti = (idx >> 2) & 3, ci = idx & 3;
                const f32x4 acc = which ? mma_tile2<64, true, false>(VT, 72, ti * 16, KEt, 72, ci * 16, lane) : mma_tile2<64, false, true>(Attn, 72, ti * 16, VT, 72, ci * 16, lane);
#pragma unroll
                for (int r = 0; r < 4; ++r) { const int rw = ti * 16 + 4 * (lane >> 4) + r, cl = ci * 16 + (lane & 15);
                    const int o = which ? rw * 64 + sg32(cl) : cl * 64 + sg32(rw);
                    (which ? SLOT(3) : SLOT(2))[o] = (bf16_t)f2bf(acc[r]); } }
            __syncthreads();
            {   const int row = tid >> 3, c8 = tid & 7;
                *(u32x4*)((bf16_t*)(F.ws + WS_K) + (size_t)(m0 + row) * 512 + h * 64 + c8 * 8) = *(const LAS u32x4*)(SLOT(2) + tid * 8);
                *(u32x4*)((bf16_t*)(F.ws + WS_R) + (size_t)(m0 + row) * 512 + h * 64 + c8 * 8) = *(const LAS u32x4*)(SLOT(3) + tid * 8); }
        }
        __syncthreads();
    }
#undef SLOT
#undef PK8
#undef LB
#undef TW
#undef AL
#undef AT
#undef ATt
#undef BTl
#undef KTl
#undef RT
#undef BHt
#undef KH
#undef VT
#undef MI
#undef MakT
#undef Rb
#undef Rk
#undef Attn
#undef KEt
#undef X1t
#undef X2t
#undef S8
#undef S9
#undef MAB
#undef LWf
#undef ICf
#undef WL
#undef SCR
#undef PAR
}

__device__ __forceinline__ bf16x8 cvt8(const f32x16& x, int s) {
    u32x4 w; w.x = pk2(x[8 * s + 0], x[8 * s + 1]); w.y = pk2(x[8 * s + 2], x[8 * s + 3]); w.z = pk2(x[8 * s + 4], x[8 * s + 5]); w.w = pk2(x[8 * s + 6], x[8 * s + 7]);
    return __builtin_bit_cast(bf16x8, w);
}
__device__ __forceinline__ f32x16 ld16bf(const bf16_t* p) {
    const u32x4 a = *(const u32x4*)p, b = *(const u32x4*)(p + 8); f32x16 r;
    r[0] = bflo(a.x); r[1] = bfhi(a.x); r[2] = bflo(a.y); r[3] = bfhi(a.y); r[4] = bflo(a.z); r[5] = bfhi(a.z); r[6] = bflo(a.w); r[7] = bfhi(a.w);
    r[8] = bflo(b.x); r[9] = bfhi(b.x); r[10] = bflo(b.y); r[11] = bfhi(b.y); r[12] = bflo(b.z); r[13] = bfhi(b.z); r[14] = bflo(b.w); r[15] = bfhi(b.w); return r;
}
__device__ __forceinline__ void st16bf(bf16_t* p, const f32x16& x) {
    u32x4 a, b; a.x = pk2(x[0], x[1]); a.y = pk2(x[2], x[3]); a.z = pk2(x[4], x[5]); a.w = pk2(x[6], x[7]); b.x = pk2(x[8], x[9]); b.y = pk2(x[10], x[11]); b.z = pk2(x[12], x[13]); b.w = pk2(x[14], x[15]);
    *(u32x4*)p = a; *(u32x4*)(p + 8) = b;
}
__device__ __forceinline__ float max3f(float a, float b, float c) { float r; asm("v_max3_f32 %0, %1, %2, %3" : "=v"(r) : "v"(a), "v"(b), "v"(c)); return r; }
__device__ __forceinline__ int ktile_off(int row, int ch) { return 3072 * (row >> 3) + 512 * (ch >> 2) + 64 * (row & 7) + 16 * ((ch & 3) ^ ((row >> 2) & 3)); }
constexpr int KTILE = 24576;
template <int VAR> __device__ __forceinline__ void attn_unit(const Ctx& F, int b, int c, int hp) {
    const int tid = F.tid, lane = F.lane, wave = F.wave, r32 = lane & 31, hi = lane >> 5, grp = wave >> 2, wq = wave & 3, head = 2 * hp + (wq >> 1);
    const bf16_t* Q = (const bf16_t*)(F.ws + WS_Q); const bf16_t* KV = (const bf16_t*)(F.ws + WS_KVB) + (size_t)b * SEQ * 192; bf16_t* OL = (bf16_t*)(F.ws + WS_OL);
    const size_t mq = (size_t)b * SEQ + 64 * c + 32 * (wq & 1) + r32;
    bf16x8 qr[12];
#pragma unroll
    for (int d0 = 0; d0 < 12; ++d0) qr[d0] = *(const bf16x8*)(Q + mq * 768 + head * 192 + 16 * d0 + 8 * hi);
    {
        const float* rp = (const float*)(F.ws + WS_ROPE) + mq * 64;
#pragma unroll
        for (int d0 = 8; d0 < 10; ++d0) { const int j0 = 16 * (d0 - 8) + 8 * hi;
            const f32x4 c0 = *(const f32x4*)(rp + j0), c1 = *(const f32x4*)(rp + j0 + 4), s0 = *(const f32x4*)(rp + 32 + j0), s1 = *(const f32x4*)(rp + 32 + j0 + 4);
            const u32x4 a = __builtin_bit_cast(u32x4, qr[d0]), bq = __builtin_bit_cast(u32x4, qr[d0 + 2]);
            const float x1[8] = {bflo(a.x), bfhi(a.x), bflo(a.y), bfhi(a.y), bflo(a.z), bfhi(a.z), bflo(a.w), bfhi(a.w)}, x2[8] = {bflo(bq.x), bfhi(bq.x), bflo(bq.y), bfhi(bq.y), bflo(bq.z), bfhi(bq.z), bflo(bq.w), bfhi(bq.w)};
            const float cs[8] = {c0[0], c0[1], c0[2], c0[3], c1[0], c1[1], c1[2], c1[3]}, sn[8] = {s0[0], s0[1], s0[2], s0[3], s1[0], s1[1], s1[2], s1[3]};
            float o1[8], o2[8];
#pragma unroll
            for (int e = 0; e < 8; ++e) { o1[e] = x1[e] * cs[e] - x2[e] * sn[e]; o2[e] = x1[e] * sn[e] + x2[e] * cs[e]; }
            u32x4 w1, w2; w1.x = pk2(o1[0], o1[1]); w1.y = pk2(o1[2], o1[3]); w1.z = pk2(o1[4], o1[5]); w1.w = pk2(o1[6], o1[7]); w2.x = pk2(o2[0], o2[1]); w2.y = pk2(o2[2], o2[3]); w2.z = pk2(o2[4], o2[5]); w2.w = pk2(o2[6], o2[7]);
            qr[d0] = __builtin_bit_cast(bf16x8, w1); qr[d0 + 2] = __builtin_bit_cast(bf16x8, w2); }
    }
    int poff[3]; int goff[3];
#pragma unroll
    for (int i = 0; i < 3; ++i) { const int idx = tid + 512 * i, row = idx / 24, col = idx % 24; poff[i] = ktile_off(row, col); goff[i] = row * 192 + col * 8; }
    const int nt = c + 1, ns = (VAR & 64) ? 0 : (nt + 1) >> 1;
    u32x4 st[6];
#pragma unroll
    for (int i = 0; i < 3; ++i) st[i] = *(const u32x4*)(KV + goff[i]);
    if (nt > 1) {
#pragma unroll
        for (int i = 0; i < 3; ++i) st[3 + i] = *(const u32x4*)(KV + (size_t)64 * 192 + goff[i]);
    }
#pragma unroll
    for (int i = 0; i < 3; ++i) { *(LAS u32x4*)(F.lds + poff[i]) = st[i]; if (nt > 1) *(LAS u32x4*)(F.lds + KTILE + poff[i]) = st[3 + i]; }
    __syncthreads();
    f32x16 o[4];
#pragma unroll
    for (int d = 0; d < 4; ++d)
#pragma unroll
        for (int r = 0; r < 16; ++r) o[d][r] = 0.f;
    float mrun = -1e30f, lrun = 0.f;
    const int kx_ = (r32 >> 2) & 3, kbase = 3072 * (r32 >> 3) + 64 * (r32 & 7), koffE = kbase + 16 * (hi ^ kx_), koffO = kbase + 16 * ((2 + hi) ^ kx_);
    const int tq_ = (lane & 15) >> 2, tp_ = lane & 3, tgl_ = (lane >> 4) & 1, trb = 64 * (4 * hi + tq_) + 8 * (tp_ & 1);
    const int tro0 = trb + 16 * ((2 * tgl_ + (tp_ >> 1)) ^ (hi & 3)), tro1 = trb + 16 * ((2 * tgl_ + (tp_ >> 1)) ^ ((2 + hi) & 3)) + 3072;
    for (int s = 0; s < ns; ++s) {
        const bool more = (s + 1 < ns), more2 = (2 * s + 3 < nt);
        if (more && !(VAR & 1)) {
#pragma unroll
            for (int i = 0; i < 3; ++i) st[i] = *(const u32x4*)(KV + (size_t)(2 * s + 2) * 64 * 192 + goff[i]);
            if (more2) {
#pragma unroll
                for (int i = 0; i < 3; ++i) st[3 + i] = *(const u32x4*)(KV + (size_t)(2 * s + 3) * 64 * 192 + goff[i]);
            }
        }
        if (2 * s + grp < nt) {
            const LAS unsigned char* buf = F.lds + ((s & 1) * 2 + grp) * KTILE;
            f32x16 p0, p1, q0, q1;
#pragma unroll
            for (int r = 0; r < 16; ++r) { p0[r] = 0.f; p1[r] = 0.f; q0[r] = 0.f; q1[r] = 0.f; }
            bf16x8 ka[3][2];
            if (VAR & 32) {
#pragma unroll
                for (int q = 0; q < 3; ++q) { ka[q][0] = qr[q]; ka[q][1] = qr[q + 3]; } }
#define KLD(slot, d0) do { if (VAR & 32) { asm volatile("" : "+v"(ka[slot][0]), "+v"(ka[slot][1])); break; } ka[slot][0] = *(const LAS bf16x8*)(buf + (((d0) & 1) ? koffO : koffE) + 512 * ((d0) >> 1)); ka[slot][1] = *(const LAS bf16x8*)(buf + (((d0) & 1) ? koffO : koffE) + 12288 + 512 * ((d0) >> 1)); } while (0)
            KLD(0, 0); KLD(1, 1); KLD(2, 2);
#pragma unroll
            for (int d0 = 0; d0 < 12; ++d0) {
                __builtin_amdgcn_sched_barrier(0);
                if (VAR & 16) { if (d0 & 1) { q0 = __builtin_amdgcn_mfma_f32_32x32x16_bf16(ka[d0 % 3][0], qr[d0], q0, 0, 0, 0); q1 = __builtin_amdgcn_mfma_f32_32x32x16_bf16(ka[d0 % 3][1], qr[d0], q1, 0, 0, 0); } else { p0 = __builtin_amdgcn_mfma_f32_32x32x16_bf16(ka[d0 % 3][0], qr[d0], p0, 0, 0, 0); p1 = __builtin_amdgcn_mfma_f32_32x32x16_bf16(ka[d0 % 3][1], qr[d0], p1, 0, 0, 0); } }
                else if (!(VAR & 4)) { p0 = __builtin_amdgcn_mfma_f32_32x32x16_bf16(ka[d0 % 3][0], qr[d0], p0, 0, 0, 0); p1 = __builtin_amdgcn_mfma_f32_32x32x16_bf16(ka[d0 % 3][1], qr[d0], p1, 0, 0, 0); } else { asm volatile("" :: "v"(ka[d0 % 3][0]), "v"(ka[d0 % 3][1])); }
                __builtin_amdgcn_sched_barrier(0);
                if (d0 + 3 < 12) KLD(d0 % 3, d0 + 3);
            }
            __builtin_amdgcn_sched_barrier(0);
            if (VAR & 16) {
#pragma unroll
                for (int r = 0; r < 16; ++r) { p0[r] += q0[r]; p1[r] += q1[r]; } }
#undef KLD
            v4i16_t vl[2][4], vh[2][4];
#pragma unroll
            for (int db = 0; db < 4; ++db) { vl[0][db] = __builtin_amdgcn_ds_read_tr16_b64_v4i16((LAS v4i16_t*)(buf + tro0 + 512 * db)); vh[0][db] = __builtin_amdgcn_ds_read_tr16_b64_v4i16((LAS v4i16_t*)(buf + tro1 + 512 * db)); }
            float mx = max3f(p0[0], p1[0], p0[1]), my = max3f(p1[1], p0[2], p1[2]);
#pragma unroll
            for (int r = 3; r < 15; r += 2) { mx = max3f(mx, p0[r], p1[r]); my = max3f(my, p0[r + 1], p1[r + 1]); }
            mx = max3f(mx, my, fmaxf(p0[15], p1[15]));
            mx = fmaxf(mx, __shfl_xor(mx, 32));
            if (!(VAR & 8) && __any(mx > mrun + 8.f)) {
                const float mnew = fmaxf(mrun, mx), alpha = __builtin_amdgcn_exp2f(mrun - mnew); mrun = mnew; lrun *= alpha;
#pragma unroll
                for (int d = 0; d < 4; ++d)
#pragma unroll
                    for (int r = 0; r < 16; ++r) o[d][r] *= alpha;
            }
            float ls = 0.f;
#pragma unroll
            for (int r = 0; r < 16; ++r) { if (!(VAR & 8)) { p0[r] = __builtin_amdgcn_exp2f(p0[r] - mrun); p1[r] = __builtin_amdgcn_exp2f(p1[r] - mrun); } ls += p0[r] + p1[r]; }
            lrun += ls;
#pragma unroll
            for (int ks = 0; ks < 4; ++ks) {
                if (ks + 1 < 4) {
#pragma unroll
                    for (int db = 0; db < 4; ++db) {
                        vl[(ks + 1) & 1][db] = __builtin_amdgcn_ds_read_tr16_b64_v4i16((LAS v4i16_t*)(buf + tro0 + 6144 * (ks + 1) + 512 * db)); vh[(ks + 1) & 1][db] = __builtin_amdgcn_ds_read_tr16_b64_v4i16((LAS v4i16_t*)(buf + tro1 + 6144 * (ks + 1) + 512 * db)); }
                }
                const bf16x8 pb = (ks < 2) ? cvt8(p0, ks & 1) : cvt8(p1, ks & 1);
#pragma unroll
                for (int db = 0; db < 4; ++db) { const v4i16_t lo = vl[ks & 1][db], hh = vh[ks & 1][db];
                    const bf16x8 va = {lo[0], lo[1], lo[2], lo[3], hh[0], hh[1], hh[2], hh[3]};
                    if (!(VAR & 2)) o[db] = __builtin_amdgcn_mfma_f32_32x32x16_bf16(va, pb, o[db], 0, 0, 0); else asm volatile("" :: "v"(va), "v"(pb)); }
            }
        }
        if (more && !(VAR & 1)) {
            LAS unsigned char* nb = F.lds + (((s + 1) & 1) * 2) * KTILE;
#pragma unroll
            for (int i = 0; i < 3; ++i) { *(LAS u32x4*)(nb + poff[i]) = st[i]; if (more2) *(LAS u32x4*)(nb + KTILE + poff[i]) = st[3 + i]; }
        }
        __syncthreads();
    }
    lrun += __shfl_xor(lrun, 32);
    LAS float* xb = (LAS float*)(F.lds + wq * (66 * 64 * 4));
    if (grp == 1) {
#pragma unroll
        for (int d = 0; d < 4; ++d)
#pragma unroll
            for (int r = 0; r < 16; ++r) xb[(d * 16 + r) * 64 + lane] = o[d][r];
        xb[64 * 64 + lane] = mrun; xb[65 * 64 + lane] = lrun;
    }
    __syncthreads();
    if (grp == 0) {
        const float m2 = xb[64 * 64 + lane], l2 = xb[65 * 64 + lane];
        const float mm = fmaxf(mrun, m2), a1 = __builtin_amdgcn_exp2f(mrun - mm), a2 = __builtin_amdgcn_exp2f(m2 - mm);
        const float inv = 1.f / (lrun * a1 + l2 * a2), f1 = a1 * inv, f2 = a2 * inv;
#pragma unroll
        for (int db = 0; db < 4; ++db)
#pragma unroll
            for (int g = 0; g < 4; ++g) { float v[4];
#pragma unroll
                for (int e = 0; e < 4; ++e) v[e] = o[db][4 * g + e] * f1 + xb[(db * 16 + 4 * g + e) * 64 + lane] * f2;
                u32x2 w; w.x = pk2(v[0], v[1]); w.y = pk2(v[2], v[3]);
                *(u32x2*)(OL + mq * 512 + head * 128 + 32 * db + 8 * g + 4 * hi) = w; }
    }
    __syncthreads();
}
struct RwSet { bf16x8 ta[2][4]; u32x4 d[4]; };
__device__ __forceinline__ void rw_load(RwSet& s, const bf16_t* TTg, const bf16_t* Rg, int cg_, int h, int i, int r32, int hi) {
    const bf16_t* TTw = TTg + (size_t)(cg_ * 8 + h) * 4096; const bf16_t* Dw = Rg + ((size_t)64 * cg_ + i) * 512 + h * 64;
#pragma unroll
    for (int a = 0; a < 2; ++a)
#pragma unroll
        for (int s2 = 0; s2 < 4; ++s2) s.ta[a][s2] = *(const bf16x8*)(TTw + (32 * a + r32) * 64 + 16 * s2 + 8 * hi);
    s.d[0] = *(const u32x4*)(Dw + 16 * hi); s.d[1] = *(const u32x4*)(Dw + 16 * hi + 8); s.d[2] = *(const u32x4*)(Dw + 32 + 16 * hi); s.d[3] = *(const u32x4*)(Dw + 32 + 16 * hi + 8);
}
__device__ __forceinline__ f32x16 up16(const u32x4 a, const u32x4 b) { f32x16 r;
    r[0] = bflo(a.x); r[1] = bfhi(a.x); r[2] = bflo(a.y); r[3] = bfhi(a.y); r[4] = bflo(a.z); r[5] = bfhi(a.z); r[6] = bflo(a.w); r[7] = bfhi(a.w);
    r[8] = bflo(b.x); r[9] = bfhi(b.x); r[10] = bflo(b.y); r[11] = bfhi(b.y); r[12] = bflo(b.z); r[13] = bfhi(b.z); r[14] = bflo(b.w); r[15] = bfhi(b.w); return r; }
__device__ __forceinline__ void rw_step(f32x16& X0, f32x16& X1, const RwSet& s, bf16_t* Rg, int cg_, int h, int i, int hi, bool live) {
    const bf16x8 bf[4] = {cvt8(X0, 0), cvt8(X0, 1), cvt8(X1, 0), cvt8(X1, 1)};
    if (live) { bf16_t* Dw = Rg + ((size_t)64 * cg_ + i) * 512 + h * 64;
        *(bf16x8*)(Dw + 16 * hi) = bf[0]; *(bf16x8*)(Dw + 16 * hi + 8) = bf[1]; *(bf16x8*)(Dw + 32 + 16 * hi) = bf[2]; *(bf16x8*)(Dw + 32 + 16 * hi + 8) = bf[3]; }
    f32x16 n0 = up16(s.d[0], s.d[1]), n1 = up16(s.d[2], s.d[3]);
#pragma unroll
    for (int s2 = 0; s2 < 4; ++s2) { n0 = __builtin_amdgcn_mfma_f32_32x32x16_bf16(s.ta[0][s2], bf[s2], n0, 0, 0, 0); n1 = __builtin_amdgcn_mfma_f32_32x32x16_bf16(s.ta[1][s2], bf[s2], n1, 0, 0, 0); }
    X0 = n0; X1 = n1;
}
__device__ __forceinline__ void rwkv_scan(const Ctx& F, int b, int h, int half) {
    const int lane = F.lane, r32 = lane & 31, hi = lane >> 5, i = 32 * half + r32;
    const bf16_t* TTg = (const bf16_t*)(F.ws + WS_TT); bf16_t* Rg = (bf16_t*)(F.ws + WS_R);
    f32x16 X0, X1;
#pragma unroll
    for (int r = 0; r < 16; ++r) { X0[r] = 0.f; X1[r] = 0.f; }
    RwSet sA, sB, sC; const int c0 = b * 128;
    rw_load(sA, TTg, Rg, c0 + 0, h, i, r32, hi); rw_load(sB, TTg, Rg, c0 + 1, h, i, r32, hi); rw_load(sC, TTg, Rg, c0 + 2, h, i, r32, hi);
    for (int c = 0; c < 129; c += 3) {
        rw_step(X0, X1, sA, Rg, c0 + c, h, i, hi, true);          rw_load(sA, TTg, Rg, c0 + min(c + 3, 127), h, i, r32, hi);
        rw_step(X0, X1, sB, Rg, c0 + c + 1, h, i, hi, true);      rw_load(sB, TTg, Rg, c0 + min(c + 4, 127), h, i, r32, hi);
        rw_step(X0, X1, sC, Rg, c0 + min(c + 2, 127), h, i, hi, c + 2 < 128); rw_load(sC, TTg, Rg, c0 + min(c + 5, 127), h, i, r32, hi);
    }
}
__device__ __forceinline__ void ssd_scan(const Ctx& F, int item) {
    const int b = item >> 4, h = (item >> 1) & 7, hp = item & 1, g = h >> 2, hl = h & 3;
    const int piece = hp * 512 + F.tid;
    const int f = hl * 8192 + piece * 8, row = f >> 9, col = ssd_win_col(g, f & 511);
    bf16_t* ST = (bf16_t*)(F.ws + WS_XBC); const float* CDEC = (const float*)(F.ws + WS_CDEC);
    float st[8];
#pragma unroll
    for (int j = 0; j < 8; ++j) st[j] = 0.f;
    for (int c8 = 0; c8 < 128; c8 += 8) {
        u32x4 v[8]; float cd[8];
#pragma unroll
        for (int u = 0; u < 8; ++u) { const int cg_ = b * 128 + c8 + u; v[u] = *(const u32x4*)(ST + ((size_t)64 * cg_ + row) * 1024 + col); cd[u] = CDEC[cg_ * 8 + h]; }
#pragma unroll
        for (int u = 0; u < 8; ++u) { const int cg_ = b * 128 + c8 + u;
            u32x4 o; o.x = pk2(st[0], st[1]); o.y = pk2(st[2], st[3]); o.z = pk2(st[4], st[5]); o.w = pk2(st[6], st[7]);
            *(u32x4*)(ST + ((size_t)64 * cg_ + row) * 1024 + col) = o;
            const float x[8] = {bflo(v[u].x), bfhi(v[u].x), bflo(v[u].y), bfhi(v[u].y), bflo(v[u].z), bfhi(v[u].z), bflo(v[u].w), bfhi(v[u].w)};
#pragma unroll
            for (int j = 0; j < 8; ++j) st[j] = st[j] * cd[u] + x[j]; }
    }
}
constexpr size_t CTL_QUEUE = 32768;
template <int VAR = 0> __device__ __forceinline__ void p4_mix(const Ctx& F, int qslot, int what = 3) {
    const int x = F.bid & 7, li = F.bid >> 3;
    if ((what & 2) && li < 8) { const int st = li * 8 + x;
        if (st < 32) { if (!(what & 8) && F.wave == 0) rwkv_scan(F, st >> 4, (st >> 1) & 7, st & 1); }
        else if (!(what & 4)) ssd_scan(F, st - 32); }
    if (what & 1) {
        unsigned* ctr = (unsigned*)(F.ws + WS_CTL + CTL_QUEUE) + (qslot * 8 + x) * 64;
        volatile LAS int* qw = (volatile LAS int*)(F.lds + LDS_BYTES - 128);
        for (;;) {
            if (F.tid == 0) *qw = (int)__hip_atomic_fetch_add(ctr, 1u, __ATOMIC_RELAXED, __HIP_MEMORY_SCOPE_AGENT);
            __syncthreads();
            const int k = *qw;
            __syncthreads();
            if (k >= 64) break;
            const int rb = 4 * k + (x >> 1), c = 127 - (rb >> 1), hp = rb & 1, b = x & 1;
            attn_unit<VAR>(F, b, c, hp);
        }
    }
}
template <int VAR = 0> __device__ __forceinline__ void p5_assemble(const Ctx& F, int l) {
    bf16_t* GT = (bf16_t*)(F.ws + WS_GATES);
    if (!(VAR & 1)) {   pg8::Gemm g{(const bf16_t*)(F.ws + WS_OL), (const bf16_t*)(F.ws + WS_WUV), NT, 512, 256, 512, 512, 256};     pg8::StaticOrder S; S.init(NT, 512, F.G, F.bid); EpiUV E{GT};
        pg8::gemm_phase<EpiUV, pg8::StaticOrder, true, true>(F.lds, F.wave, g, S, E); }
    __syncthreads();
    int lane = fresh_lane(); const int tid = F.wave * 64 + lane, wave = F.wave;
    const int gw = F.bid * NWAVES + F.wave, NGW = F.G * NWAVES;
    {   constexpr int O_CC = 0, O_YO = 33792;
        const bf16_t* Cbuf = (const bf16_t*)(F.ws + WS_CB); const float* ECUM = (const float*)(F.ws + WS_ECUM); const bf16_t* ST = (const bf16_t*)(F.ws + WS_XBC); const bf16_t* YD = (const bf16_t*)(F.ws + WS_YD);
        const float* snw = INP(I_SSDNW) + l * 512;
        for (int c = F.bid; c < ((VAR & 2) ? 0 : NCHK); c += F.G) {
            const size_t m0 = (size_t)64 * c; const int h = wave, g = h >> 2, hl = h & 3;
            bf16x8 pf[4][4];
#pragma unroll
            for (int pi = 0; pi < 4; ++pi)
#pragma unroll
                for (int ks = 0; ks < 4; ++ks) { const int f = hl * 8192 + (16 * pi + (lane & 15)) * 128 + 32 * ks + 8 * (lane >> 4), row = f >> 9, col = ssd_win_col(g, f & 511);
                    pf[pi][ks] = *(const bf16x8*)(ST + (m0 + row) * 1024 + col); }
            {   LAS bf16_t* CC = (LAS bf16_t*)(F.lds + O_CC);
#pragma unroll
                for (int i = 0; i < 4; ++i) { const int idx = tid + 512 * i, t = idx >> 5, c8 = idx & 31; *(LAS u32x4*)(CC + t * 264 + c8 * 8) = *(const u32x4*)(Cbuf + (m0 + t) * 256 + c8 * 8); } }
            __syncthreads();
            {   const LAS bf16_t* CC = (const LAS bf16_t*)(F.lds + O_CC) + g * 128; LAS bf16_t* YO = (LAS bf16_t*)(F.lds + O_YO);
#pragma unroll
                for (int ti = 0; ti < 4; ++ti) {
                    bf16x8 af[4];
#pragma unroll
                    for (int ks = 0; ks < 4; ++ks) af[ks] = *(const LAS bf16x8*)(CC + (16 * ti + (lane & 15)) * 264 + 32 * ks + 8 * (lane >> 4));
                    float ec[4];
#pragma unroll
                    for (int r = 0; r < 4; ++r) ec[r] = ECUM[(size_t)(c * 8 + h) * 64 + 16 * ti + 4 * (lane >> 4) + r];
#pragma unroll
                    for (int pi = 0; pi < 4; ++pi) { f32x4 acc = {0.f, 0.f, 0.f, 0.f};
#pragma unroll
                        for (int ks = 0; ks < 4; ++ks) acc = __builtin_amdgcn_mfma_f32_16x16x32_bf16(af[ks], pf[pi][ks], acc, 0, 0, 0);
#pragma unroll
                        for (int r = 0; r < 4; ++r) YO[(16 * ti + 4 * (lane >> 4) + r) * 520 + 64 * h + 16 * pi + (lane & 15)] = (bf16_t)f2bf(acc[r] * ec[r]); }
                }
            }
            __syncthreads();
            {   const LAS bf16_t* YO = (const LAS bf16_t*)(F.lds + O_YO);
                u32x4 ydv[8], zv[8];
#pragma unroll
                for (int rr = 0; rr < 8; ++rr) { const int t = 8 * wave + rr; ydv[rr] = *(const u32x4*)(YD + (m0 + t) * 512 + 8 * lane); zv[rr] = *(const u32x4*)(GT + (m0 + t) * 1536 + 512 + 8 * lane); }
                const f32x4 w0 = *(const f32x4*)(snw + 8 * lane), w1 = *(const f32x4*)(snw + 8 * lane + 4);
#pragma unroll
                for (int rr = 0; rr < 8; ++rr) { const int t = 8 * wave + rr; const u32x4 w = *(const LAS u32x4*)(YO + t * 520 + 8 * lane);
                    const unsigned wa[4] = {w.x, w.y, w.z, w.w}, ya[4] = {ydv[rr].x, ydv[rr].y, ydv[rr].z, ydv[rr].w}, za[4] = {zv[rr].x, zv[rr].y, zv[rr].z, zv[rr].w};
                    float v[8]; float q = 0.f;
#pragma unroll
                    for (int j = 0; j < 8; ++j) { const int k2 = j >> 1; const float yo = (j & 1) ? bfhi(wa[k2]) : bflo(wa[k2]), yd = (j & 1) ? bfhi(ya[k2]) : bflo(ya[k2]), zz = (j & 1) ? bfhi(za[k2]) : bflo(za[k2]);
                        v[j] = (yd + yo) * siluf_(zz); q += v[j] * v[j]; }
                    const float rs = __builtin_amdgcn_rsqf(wave_sum(q) * (1.f / 512.f) + EPS);
                    u32x4 o; o.x = pk2(v[0] * rs * w0[0], v[1] * rs * w0[1]); o.y = pk2(v[2] * rs * w0[2], v[3] * rs * w0[3]); o.z = pk2(v[4] * rs * w1[0], v[5] * rs * w1[1]); o.w = pk2(v[6] * rs * w1[2], v[7] * rs * w1[3]);
                    *(u32x4*)(GT + (m0 + t) * 1536 + 512 + 8 * lane) = o; } }
            __syncthreads();
        }
    }
    LAS float* SW = (LAS float*)(F.lds + F.wave * 16640);
    const bf16_t* Yt = (const bf16_t*)(F.ws + WS_K); const bf16_t* SF = (const bf16_t*)(F.ws + WS_R); const bf16_t* QEg = (const bf16_t*)(F.ws + WS_QE);
    const bf16_t* BON = (const bf16_t*)(F.ws + WS_V); const float* lw = INP(I_LNXW) + l * 512; const float* lb = INP(I_LNXB) + l * 512;
    for (int w = gw; w < ((VAR & 4) ? 0 : NCHK * 8); w += NGW) {
        asm volatile("" : "+v"(lane));
        const int cg_ = w >> 3, h = w & 7, r32 = lane & 31, hi = lane >> 5; const size_t m0 = (size_t)64 * cg_;
        const bf16_t* QEw = QEg + (size_t)(cg_ * 8 + h) * 4096;
        bf16x8 qa[2][4];
#pragma unroll
        for (int tb = 0; tb < 2; ++tb)
#pragma unroll
            for (int s2 = 0; s2 < 4; ++s2) qa[tb][s2] = *(const bf16x8*)(QEw + (32 * tb + r32) * 64 + 16 * s2 + 8 * hi);
#pragma unroll
        for (int ih = 0; ih < 2; ++ih) { const size_t ro = (m0 + 32 * ih + r32) * 512 + h * 64;
            const bf16x8 bf[4] = {*(const bf16x8*)(SF + ro + 16 * hi), *(const bf16x8*)(SF + ro + 16 * hi + 8), *(const bf16x8*)(SF + ro + 32 + 16 * hi), *(const bf16x8*)(SF + ro + 32 + 16 * hi + 8)};
#pragma unroll
            for (int tb = 0; tb < 2; ++tb) { f32x16 y = ld16bf(Yt + ro + 32 * tb + 16 * hi);
#pragma unroll
                for (int s2 = 0; s2 < 4; ++s2) y = __builtin_amdgcn_mfma_f32_32x32x16_bf16(qa[tb][s2], bf[s2], y, 0, 0, 0);
#pragma unroll
                for (int r = 0; r < 16; ++r) SW[(32 * tb + crow(r, hi)) * 65 + 32 * ih + r32] = y[r]; } }
        LDS_WAIT();
        {   float y[64]; float sm = 0.f;
#pragma unroll
            for (int i = 0; i < 64; ++i) { y[i] = SW[lane * 65 + i]; sm += y[i]; }
            const float mean = sm * (1.f / 64.f); float q = 0.f;
#pragma unroll
            for (int i = 0; i < 64; ++i) { y[i] -= mean; q += y[i] * y[i]; }
            const float rs = 1.f / sqrtf(q * (1.f / 64.f) + GN_EPS);
#pragma unroll
            for (int i = 0; i < 64; ++i) SW[lane * 65 + i] = y[i] * rs; }
        LDS_WAIT();
        u32x4 bwv[8], gvv[8];
#pragma unroll
        for (int it = 0; it < 8; ++it) { const int t = it * 8 + (lane >> 3), i0 = (lane & 7) * 8; const size_t row = m0 + t;
            bwv[it] = *(const u32x4*)(BON + row * 512 + h * 64 + i0); gvv[it] = *(const u32x4*)(GT + row * 1536 + 1024 + h * 64 + i0); }
#pragma unroll
        for (int it = 0; it < 8; ++it) { const int t = it * 8 + (lane >> 3), i0 = (lane & 7) * 8; const size_t row = m0 + t;
            const u32x4 bw = bwv[it]; u32x4* gp = (u32x4*)(GT + row * 1536 + 1024 + h * 64 + i0); const u32x4 gv = gvv[it];
            const float bo[8] = {bflo(bw.x), bfhi(bw.x), bflo(bw.y), bfhi(bw.y), bflo(bw.z), bfhi(bw.z), bflo(bw.w), bfhi(bw.w)};
            const float gg[8] = {bflo(gv.x), bfhi(gv.x), bflo(gv.y), bfhi(gv.y), bflo(gv.z), bfhi(gv.z), bflo(gv.w), bfhi(gv.w)};
            float ov[8];
#pragma unroll
            for (int j = 0; j < 8; ++j) ov[j] = (SW[t * 65 + i0 + j] * lw[h * 64 + i0 + j] + lb[h * 64 + i0 + j] + bo[j]) * siluf_(gg[j]);
            u32x4 o; o.x = pk2(ov[0], ov[1]); o.y = pk2(ov[2], ov[3]); o.z = pk2(ov[4], ov[5]); o.w = pk2(ov[6], ov[7]); *gp = o; }
        LDS_WAIT();
    }
}
__device__ __forceinline__ void p7_final(const Ctx& F) {
    const int gw = F.bid * NWAVES + F.wave, NGW = F.G * NWAVES; const float* fw = INP(I_FNW);
    for (int m = gw; m < NT; m += NGW) {
        f32x4* xr = (f32x4*)(F.out + (size_t)m * DM) + F.lane; f32x4 v[4]; float s = 0.f;
#pragma unroll
        for (int j = 0; j < 4; ++j) { v[j] = xr[64 * j]; s += v[j].x * v[j].x + v[j].y * v[j].y + v[j].z * v[j].z + v[j].w * v[j].w; }
        const float rstd = 1.f / sqrtf(wave_sum(s) * (1.f / DM) + EPS);
#pragma unroll
        for (int j = 0; j < 4; ++j) xr[64 * j] = v[j] * rstd * *(const f32x4*)(fw + 4 * F.lane + 256 * j);
    }
}

#define RLX_AGENT __ATOMIC_RELAXED, __HIP_MEMORY_SCOPE_AGENT
#define XB_TMO      128
#define XB_XCNT(j)  (256  + 64 * (j))
#define XB_XSUB(j)  (1280 + 64 * (j))
#define XB_XGEN(j)  (2304 + 64 * (j))
#define XB_TOP      3328
#define XB_TOPGEN   3392
#define XCD_BAR_WORDS 3456
#define XB_SPIN_CAP (1u << 18)

__device__ __forceinline__ unsigned xb_ld(unsigned* p)              { return __hip_atomic_load(p, __ATOMIC_RELAXED, __HIP_MEMORY_SCOPE_AGENT); }
__device__ __forceinline__ unsigned xb_add(unsigned* p, unsigned v) { return __hip_atomic_fetch_add(p, v, __ATOMIC_RELAXED, __HIP_MEMORY_SCOPE_AGENT); }
__device__ __forceinline__ unsigned xb_xcc_id() { return (unsigned)__builtin_amdgcn_s_getreg((3 << 11) | 20) & 0xFu; }
#define XB_SPIN(cond, bar) do { unsigned _sp = 0; while (cond) { __builtin_amdgcn_s_sleep(1); \
    if ((++_sp & 255u) == 0u) { if (xb_ld(&(bar)[XB_TMO])) break; if (_sp > XB_SPIN_CAP) { atomicAdd(&(bar)[XB_TMO], 1u); break; } } } } while (0)

struct XcdBarrier {
    unsigned* bar; unsigned x;
    volatile LAS unsigned* st;
};

__device__ __forceinline__ XcdBarrier xcd_barrier_post(unsigned* bar, volatile LAS unsigned* st) {
    XcdBarrier b; b.bar = bar; b.x = xb_xcc_id(); b.st = st;
    if (threadIdx.x == 0) (void)xb_add(&bar[XB_XCNT(b.x)], 1u);
    return b;
}
__device__ __forceinline__ void xcd_barrier_complete(unsigned* bar, unsigned x, unsigned& nloc, unsigned& nx) {
    const unsigned G = gridDim.x * gridDim.y * gridDim.z;
    unsigned sum, cnt, mine, sp = 0u;
    for (;;) {
        sum = 0u; cnt = 0u; mine = 0u;
#pragma unroll
        for (unsigned j = 0; j < 16; ++j) { const unsigned c = xb_ld(&bar[XB_XCNT(j)]); sum += c; cnt += (c > 0u) ? 1u : 0u; mine = (j == x) ? c : mine; }
        if (sum == G) break;
        __builtin_amdgcn_s_sleep(1);
        if ((++sp & 255u) == 0u) { if (xb_ld(&bar[XB_TMO])) break; if (sp > XB_SPIN_CAP) { atomicAdd(&bar[XB_TMO], 1u); break; } }
    }
    nloc = mine > 0u ? mine : 1u; nx = cnt > 0u ? cnt : 1u;
}

__device__ __forceinline__ void xcd_barrier(const XcdBarrier& b) {
    asm volatile("s_waitcnt vmcnt(0)" ::: "memory");
    __syncthreads();
    if (threadIdx.x == 0) {
        unsigned* bar = b.bar;
        __builtin_amdgcn_s_waitcnt(0);
        unsigned nloc = b.st[0], nx = b.st[1];
        if (nloc == 0u) { xcd_barrier_complete(bar, b.x, nloc, nx); b.st[0] = nloc; b.st[1] = nx; }
        const unsigned old = xb_add(&bar[XB_XSUB(b.x)], 1u);
        const unsigned gen = old / nloc;
        if (old + 1u == (gen + 1u) * nloc) {
            __builtin_amdgcn_fence(__ATOMIC_RELEASE, "agent");
            asm volatile("s_waitcnt vmcnt(0)" ::: "memory");
            const unsigned og = xb_add(&bar[XB_TOP], 1u);
            const unsigned tg = og / nx;
            if (og + 1u == (tg + 1u) * nx) xb_add(&bar[XB_TOPGEN], 1u);
            else XB_SPIN(xb_ld(&bar[XB_TOPGEN]) == tg, bar);
            __builtin_amdgcn_fence(__ATOMIC_ACQUIRE, "agent");
            xb_add(&bar[XB_XGEN(b.x)], 1u);
            asm volatile("s_waitcnt vmcnt(0)" ::: "memory");
        } else {
            XB_SPIN(xb_ld(&bar[XB_XGEN(b.x)]) == gen, bar);
            __builtin_amdgcn_fence(__ATOMIC_ACQUIRE, "agent");
            asm volatile("s_waitcnt vmcnt(0)" ::: "memory");
        }
    }
    __syncthreads();
}


#define LAYER(l) do { \
        const int pb = 1 + 8 * l; \
        if (IN(pb + 0)) { PHB(); prep_weights(F, l); if (l == 0) { p0_rope(F); p1_norm(F, l); } SEAM(pb + 0); }     \
        if (IN(pb + 1)) { PHB(); \
            pg8::Gemm g{(const bf16_t*)(F.ws + WS_XN), (const bf16_t*)(F.ws + WS_WIN), NT, NIN, DM, DM, DM}; pg8::StaticOrder S; S.init(NT, NIN, F.G, F.bid); \
            EpiIn E{F.ws, l}; \
            pg8::gemm_phase<EpiIn, pg8::StaticOrder, true, true>(F.lds, F.wave, g, S, E); \
            SEAM(pb + 1); \
        } \
        if (IN(pb + 2)) { PHB(); \
            pg8::Gemm g{(const bf16_t*)(F.ws + WS_QLAT), (const bf16_t*)(F.ws + WS_WQ), NT, 768, 256, 256, 256}; pg8::StaticOrder S; S.init(NT, 768, F.G, F.bid); \
            EpiQ E{F.ws, l}; \
            pg8::gemm_phase<EpiQ, pg8::StaticOrder, true, true>(F.lds, F.wave, g, S, E); \
            p3a_extras(F, l); \
        } \
        if (IN(pb + 3)) { PHB(); p3b_ssd(F, l); __syncthreads(); } \
        if (IN(pb + 4)) { PHB(); p3c_rwkv(F, l); SEAM(pb + 4); } \
        if (IN(pb + 5)) { PHB(); p4_mix(F, l); SEAM(pb + 5); } \
        if (IN(pb + 6)) { PHB(); p5_assemble(F, l); SEAM(pb + 6); } \
        if (IN(pb + 7)) { PHB(); \
            pg8::Gemm g{(const bf16_t*)(F.ws + WS_GATES), (const bf16_t*)(F.ws + WS_WOUT), NT, DM, 1536, 1536, 1536}; pg8::StaticOrder S; S.init(NT, DM, F.G, F.bid); \
            EpiOutNorm E{(l == 0) ? INP(I_X) : F.out, F.out, (const float*)(F.ws + WS_CTL + CTL_MOD) + (size_t)(l * 2) * 3072 + 2048, F.ws, (l == 0) ? INP(I_NORMW) + DM : INP(I_FNW), (const float*)(F.ws + WS_CTL + CTL_MOD) + (size_t)2 * 3072, l, l}; \
            pg8::gemm_phase<EpiOutNorm, pg8::StaticOrder, false, true>(F.lds, F.wave, g, S, E); \
            if (l == 0) SEAM(pb + 7); \
        } \
    } while (0)
__global__ void __launch_bounds__(NTHR, 2) mk_fwd(Args args) {
    extern __shared__ __attribute__((aligned(16))) unsigned char lds_raw[];
    Ctx F; F.lds = (LAS unsigned char*)lds_raw; F.tid = threadIdx.x; F.lane = F.tid & 63; F.wave = __builtin_amdgcn_readfirstlane(F.tid >> 6);
    F.G = gridDim.x; F.bid = blockIdx.x; F.ws = args.ws; F.out = args.out; F.in = args.in;
    const int wave0 = F.wave;
    cg::grid_group grid = cg::this_grid();
    volatile LAS unsigned* xst = (volatile LAS unsigned*)(F.lds + LDS_BYTES - 256);
    if (threadIdx.x < 2) xst[threadIdx.x] = 0u;
    __syncthreads();
    const XcdBarrier xbar = xcd_barrier_post((unsigned*)(args.ws + WS_CTL) + 4096, xst);
#if MK_PER_PHASE
    const int lo = args.ph_lo, hi = args.ph_hi;
#else
    constexpr int lo = 0, hi = 18;
#endif
#ifndef MK_ONLY
#define MK_ONLY -1
#endif
#define IN(k) (lo <= (k) && (k) < hi && (MK_ONLY < 0 || MK_ONLY == ((k) == 0 ? 0 : (k) == 17 ? 17 : 1 + ((k) - 1) % 8)))
#if MK_PER_PHASE
#define SEAM(k) do { } while (0)
#else
#define SEAM(k) do { xcd_barrier(xbar); } while (0)
#endif
#define PHB() do { int b_ = blockIdx.x, g_ = gridDim.x, v_ = wave0; asm volatile("" : "+s"(b_), "+s"(g_), "+s"(v_)); F.bid = b_; F.G = g_; F.wave = v_; int t_ = v_ * 64 + (int)__builtin_amdgcn_mbcnt_hi(~0u, __builtin_amdgcn_mbcnt_lo(~0u, 0u)); asm volatile("; PHASE_MARK %0" : "+v"(t_)); F.tid = t_; F.lane = t_ & 63; unsigned wl_ = __builtin_amdgcn_readfirstlane((unsigned)(uintptr_t)args.ws), wh_ = __builtin_amdgcn_readfirstlane((unsigned)((uintptr_t)args.ws >> 32)), ol_ = __builtin_amdgcn_readfirstlane((unsigned)(uintptr_t)args.out), oh_ = __builtin_amdgcn_readfirstlane((unsigned)((uintptr_t)args.out >> 32)); asm volatile("" : "+s"(wl_), "+s"(wh_), "+s"(ol_), "+s"(oh_)); F.ws = (unsigned char*)(GAS unsigned char*)(((uintptr_t)wh_ << 32) | wl_); F.out = (float*)(GAS float*)(((uintptr_t)oh_ << 32) | ol_); } while (0)
    if (IN(0)) { PHB(); p0_mod(F); SEAM(0); }
    LAYER(0);
    LAYER(1);
#ifndef MK_RERUN
#define MK_RERUN 0
#endif
#define PHB2() do { int b_ = blockIdx.x, g_ = gridDim.x, v_ = wave0; asm volatile("" : "+s"(b_), "+s"(g_), "+s"(v_)); F.bid = b_; F.G = g_; F.wave = v_; int t_ = v_ * 64 + fresh_lane(); F.tid = t_; F.lane = t_ & 63; } while (0)
#if MK_RERUN
    { constexpr int l = 1;
    if (MK_RERUN & 1) { xcd_barrier(xbar); PHB2(); p1_norm(F, l); }
    if (MK_RERUN & 8192) { xcd_barrier(xbar); PHB2(); prep_weights(F, 1); }
    if (MK_RERUN & 2) { xcd_barrier(xbar); PHB2(); pg8::Gemm g{(const bf16_t*)(F.ws + WS_XN), (const bf16_t*)(F.ws + WS_WIN), NT, NIN, DM, DM, DM}; pg8::StaticOrder S; S.init(NT, NIN, F.G, F.bid); EpiIn E{F.ws, l}; pg8::gemm_phase<EpiIn, pg8::StaticOrder, true, true>(F.lds, F.wave, g, S, E); }
    if (MK_RERUN & 4) { xcd_barrier(xbar); PHB2(); pg8::Gemm g{(const bf16_t*)(F.ws + WS_QLAT), (const bf16_t*)(F.ws + WS_WQ), NT, 768, 256, 256, 256}; pg8::StaticOrder S; S.init(NT, 768, F.G, F.bid); EpiQ E{F.ws, l}; pg8::gemm_phase<EpiQ, pg8::StaticOrder, true, true>(F.lds, F.wave, g, S, E); p3a_extras(F, l); }
    if (MK_RERUN & 8) { xcd_barrier(xbar); PHB2(); p3b_ssd<MK_AVAR>(F, l); }
    if (MK_RERUN & 16) { xcd_barrier(xbar); PHB2(); p3c_rwkv<MK_AVAR>(F, l); }
    if (MK_RERUN & 32) { xcd_barrier(xbar); PHB2(); p4_mix(F, 2); }
#ifndef MK_AVAR
#define MK_AVAR 0
#endif
    if (MK_RERUN & 512) { xcd_barrier(xbar); PHB2(); p4_mix<MK_AVAR>(F, 2, 1); }
    if (MK_RERUN & 1024) { xcd_barrier(xbar); PHB2(); p4_mix(F, 2, 2); }
    if (MK_RERUN & 2048) { xcd_barrier(xbar); PHB2(); p4_mix(F, 2, 2 | 4); }
    if (MK_RERUN & 4096) { xcd_barrier(xbar); PHB2(); p4_mix(F, 2, 2 | 8); }
    if (MK_RERUN & 64) { xcd_barrier(xbar); PHB2(); p5_assemble<MK_AVAR>(F, l); }
    if (MK_RERUN & 128) { xcd_barrier(xbar); PHB2(); pg8::Gemm g{(const bf16_t*)(F.ws + WS_GATES), (const bf16_t*)(F.ws + WS_WOUT), NT, DM, 1536, 1536, 1536}; pg8::StaticOrder S; S.init(NT, DM, F.G, F.bid);
        EpiOut E{INP(I_X), (float*)(F.ws + WS_XBC), (const float*)(F.ws + WS_CTL + CTL_MOD) + (size_t)(l * 2) * 3072 + 2048}; pg8::gemm_phase<EpiOut, pg8::StaticOrder, true, true>(F.lds, F.wave, g, S, E); }
    }
#endif
#undef IN
#undef SEAM
}
constexpr int N_PHASES = 18;

extern "C" void kernel_launch(void* const* d_in, const int* in_sizes, int n_in, void* d_out, int out_size, void* d_ws, size_t ws_size, hipStream_t stream) {
    static int grid = 0;
    if (grid == 0) {
        if (n_in != 31 || out_size != NT * DM || ws_size < WS_END) { fprintf(stderr, "kernel_launch: unexpected shapes (n_in %d, out %d, ws %zu)\n", n_in, out_size, ws_size); grid = -1; return; }
        int dev = 0, cus = 0, per_cu = 0;
        hipGetDevice(&dev); hipDeviceGetAttribute(&cus, hipDeviceAttributeMultiprocessorCount, dev);
        if (hipFuncSetAttribute((const void*)mk_fwd, hipFuncAttributeMaxDynamicSharedMemorySize, LDS_BYTES) != hipSuccess) { fprintf(stderr, "kernel_launch: hipFuncSetAttribute failed\n"); grid = -1; return; }
        hipOccupancyMaxActiveBlocksPerMultiprocessor(&per_cu, (const void*)mk_fwd, NTHR, LDS_BYTES);
        (void)hipGetLastError();
        if (per_cu < 1) per_cu = 1;
        grid = cus;
        fprintf(stderr, "kernel_launch: cus %d, occupancy query %d block(s)/CU, grid %d\n", cus, per_cu, grid);
    }
    if (grid < 0) return;
    hipMemsetAsync((char*)d_ws + WS_CTL, 0, CTL_BYTES, stream);
    Args a{};
    for (int i = 0; i < 31; ++i) a.in[i] = (const float*)d_in[i];
    a.out = (float*)d_out; a.ws = (unsigned char*)d_ws;
#if MK_PER_PHASE
    for (int p = 0; p < N_PHASES; ++p) { a.ph_lo = p; a.ph_hi = p + 1; hipLaunchKernelGGL(mk_fwd, dim3(grid), dim3(NTHR), LDS_BYTES, stream, a); }
#else
    a.ph_lo = 0; a.ph_hi = N_PHASES;
    void* params[] = {&a};
    hipError_t e = hipLaunchCooperativeKernel((const void*)mk_fwd, dim3(grid), dim3(NTHR), params, LDS_BYTES, stream);
    if (e != hipSuccess) fprintf(stderr, "kernel_launch: cooperative launch failed: %s\n", hipGetErrorString(e));
#endif
}
```

```cpp
#include <hip/hip_runtime.h>
#include <hip/hip_cooperative_groups.h>
#include <cstdio>
#include <cstdint>
namespace cg = cooperative_groups;

#define LAS __attribute__((address_space(3)))
#define GAS __attribute__((address_space(1)))
typedef unsigned short bf16_t;
typedef short bf16x8 __attribute__((ext_vector_type(8)));
typedef float f32x4 __attribute__((ext_vector_type(4)));
typedef float f32x2 __attribute__((ext_vector_type(2)));
typedef float f32x16 __attribute__((ext_vector_type(16)));
typedef unsigned u32x4 __attribute__((ext_vector_type(4)));
typedef unsigned u32x2 __attribute__((ext_vector_type(2)));
typedef short v4i16_t __attribute__((ext_vector_type(4)));

#ifndef MK_PER_PHASE
#define MK_PER_PHASE 0
#endif

namespace pg8 {
constexpr int BM = 256, BK = 64, HALF = 128, HTB = HALF * BK * 2, STAGE_BYTES = 8 * HTB, NXCD = 8, WGM = 8;
__host__ __device__ __forceinline__ int lds_byte(int r, int c) { const int st = (r >> 4) * 2 + (c >> 5), rr = r & 15, cc = c & 31, ob = rr * 64 + cc * 2; return st * 1024 + (ob ^ (((ob >> 9) & 1) << 5)); }
__host__ __device__ __forceinline__ void stage_rc(int b, int& R, int& C) { const int st = b / 1024, sb = b % 1024, swz = sb ^ (((sb >> 9) & 1) << 5); R = (st >> 1) * 16 + swz / 64; C = (st & 1) * 32 + (swz % 64) / 2; }
__host__ __device__ __forceinline__ int perm32(int rho) { const int n = rho >> 4, i = rho & 15; return 8 * (i >> 2) + 4 * n + (i & 3); }
struct Unit { int pm, pn; };
struct Gemm { const bf16_t* A; const bf16_t* Bt; int M, N, K, lda, ldb; int kdiag = 0; };
struct StaticOrder {
    int nM, nN, nwg, G, c;
    __host__ __device__ void init(int M, int N, int G_, int c_) { nM = M / BM; nN = N / BM; nwg = nM * nN; G = G_; c = c_; }
    __host__ __device__ bool next(int i, Unit& u) const {
        const long L = (long)i * G + c; if (L >= nwg) return false;
        int wgid = (int)L; { const int q = nwg / NXCD, r = nwg % NXCD, xcd = wgid % NXCD, off = wgid / NXCD; wgid = (xcd < r ? xcd * (q + 1) : r * (q + 1) + (xcd - r) * q) + off; }
        const int nig = WGM * nN, gid = wgid / nig, fm = gid * WGM, gsz = (nM - fm) < WGM ? (nM - fm) : WGM;
        u.pm = fm + ((wgid % nig) % gsz); u.pn = (wgid % nig) / gsz; return true;
    }
};
template <class Epi, class Sched, bool ALIGN_EPI, bool SP2>
__device__ __forceinline__ void gemm_phase(LAS unsigned char* lds, int wave_id, const Gemm g, const Sched& S, const Epi& E) {
    int lane = (int)__builtin_amdgcn_mbcnt_hi(~0u, __builtin_amdgcn_mbcnt_lo(~0u, 0u)); asm volatile("" : "+v"(lane));
    const int wid = wave_id, tid = wid * 64 + lane, wr = wid >> 2, wc = wid & 3, fr = lane & 15, fq = lane >> 4;
    const int K = g.K, nt = K / BK;
    unsigned voffA[2], voffB[2];
#pragma unroll
    for (int i = 0; i < 2; ++i) { int R, C; stage_rc(tid * 16 + i * 8192, R, C); const int Rb = (R & ~31) + perm32(R & 31);
        voffA[i] = (unsigned)(R * g.lda + C) * 2u; voffB[i] = (unsigned)(Rb * g.ldb + C) * 2u; }
    const size_t kstep = (size_t)(BK * 2);
    const size_t hstepA = (size_t)HALF * g.lda * 2, hstepB = (size_t)HALF * g.ldb * 2;
    const size_t tstepA = 2 * hstepA, tstepB = 2 * hstepB;
    const unsigned ldsw = (unsigned)wid * 1024u, lds0 = (unsigned)(uintptr_t)lds;
    const int aoff = lds_byte(wr * 64 + fr, fq * 8), boff = lds_byte(wc * 32 + fr, fq * 8);
#define PG8_SA(b, h) (((b) * 2 + (h)) * HTB)
#define PG8_SB(b, h) ((4 + (b) * 2 + (h)) * HTB)
#define PG8_STAGE(bufoff, gbase, voff) do { _Pragma("unroll") for (int _i = 0; _i < 2; ++_i) { unsigned keep_; \
        asm volatile("s_mov_b32 %0, m0\n\ts_mov_b32 m0, %3\n\ts_nop 0\n\tglobal_load_lds_dwordx4 %1, %2\n\ts_mov_b32 m0, %0" : "=&s"(keep_) : "v"((voff)[_i]), "s"((const char*)(gbase)), "s"(lds0 + (unsigned)(bufoff) + ldsw + (unsigned)(_i * 8192)) : "memory"); } } while (0)
#define PG8_LDA(dst, b, h) do { _Pragma("unroll") for (int m = 0; m < 4; ++m) _Pragma("unroll") for (int k = 0; k < 2; ++k) dst[m][k] = *(const LAS bf16x8*)(lds + PG8_SA(b, h) + aoff + m * 2048 + k * 1024); } while (0)
#define PG8_LDB(dst, b, h) do { _Pragma("unroll") for (int n = 0; n < 2; ++n) _Pragma("unroll") for (int k = 0; k < 2; ++k) dst[n][k] = *(const LAS bf16x8*)(lds + PG8_SB(b, h) + boff + n * 2048 + k * 1024); } while (0)
#define PG8_MMA(ai, bj, At, Bt) do { __builtin_amdgcn_s_setprio(1); _Pragma("unroll") for (int m = 0; m < 4; ++m) _Pragma("unroll") for (int n = 0; n < 2; ++n) _Pragma("unroll") for (int k = 0; k < 2; ++k) \
        acc[ai][bj][m][n] = __builtin_amdgcn_mfma_f32_16x16x32_bf16(Bt[n][k], At[m][k], acc[ai][bj][m][n], 0, 0, 0); __builtin_amdgcn_s_setprio(0); } while (0)
#define PG8_WAIT_V(n) asm volatile("s_waitcnt vmcnt(" #n ")" ::: "memory")
#define PG8_WAIT_L(n) asm volatile("s_waitcnt lgkmcnt(" #n ")" ::: "memory")
#define PG8_BAR __builtin_amdgcn_s_barrier()
#define PG8_SCHED __builtin_amdgcn_sched_barrier(0)
    Unit cur, nxt; int ui = 0;
    if (!S.next(0, cur)) return;
    f32x4 acc[2][2][4][2];
#pragma unroll
    for (int a = 0; a < 2; ++a)
#pragma unroll
        for (int b = 0; b < 2; ++b)
#pragma unroll
            for (int m = 0; m < 4; ++m)
#pragma unroll
                for (int n = 0; n < 2; ++n) acc[a][b][m][n] = (f32x4){0.f, 0.f, 0.f, 0.f};
    bf16x8 At[4][2], B0[2][2], B1[2][2];
    const char* cA = (const char*)g.A + (size_t)cur.pm * tstepA + (size_t)cur.pn * g.kdiag * 2; const char* cB = (const char*)g.Bt + (size_t)cur.pn * tstepB + (size_t)cur.pn * g.kdiag * 2;
    if constexpr (SP2) {
        PG8_STAGE(PG8_SB(0, 0), cB, voffB); PG8_STAGE(PG8_SB(0, 1), cB + hstepB, voffB); PG8_STAGE(PG8_SA(0, 0), cA, voffA); PG8_STAGE(PG8_SA(0, 1), cA + hstepA, voffA);
        if (wr == 1) PG8_BAR;
        PG8_WAIT_V(2); PG8_BAR;
        PG8_STAGE(PG8_SB(1, 0), cB + kstep, voffB); PG8_STAGE(PG8_SA(1, 0), cA + kstep, voffA); PG8_STAGE(PG8_SB(1, 1), cB + hstepB + kstep, voffB);
        PG8_WAIT_V(6); PG8_BAR;
    } else {
        PG8_STAGE(PG8_SB(0, 0), cB, voffB); PG8_STAGE(PG8_SA(0, 0), cA, voffA); PG8_STAGE(PG8_SB(0, 1), cB + hstepB, voffB); PG8_STAGE(PG8_SA(0, 1), cA + hstepA, voffA);
        if (wr == 1) PG8_BAR;
        PG8_WAIT_V(4); PG8_BAR;
        PG8_STAGE(PG8_SB(1, 0), cB + kstep, voffB); PG8_STAGE(PG8_SA(1, 0), cA + kstep, voffA); PG8_STAGE(PG8_SB(1, 1), cB + hstepB + kstep, voffB);
        PG8_WAIT_V(6); PG8_BAR;
    }
    for (;;) {
        const bool has_next = S.next(ui + 1, nxt);
        const char* nA = has_next ? (const char*)g.A + (size_t)nxt.pm * tstepA + (size_t)nxt.pn * g.kdiag * 2 : cA; const char* nB = has_next ? (const char*)g.Bt + (size_t)nxt.pn * tstepB + (size_t)nxt.pn * g.kdiag * 2 : cB;
        for (int t = 0; t < nt; t += 2) {
            const bool last = (t == nt - 2);
            const char* a1 = cA + (size_t)(t + 1) * kstep;
            const char* a2 = last ? nA : cA + (size_t)(t + 2) * kstep; const char* b2 = last ? nB : cB + (size_t)(t + 2) * kstep;
            const char* a3 = a2 + kstep; const char* b3 = b2 + kstep;
            if constexpr (SP2) {
            PG8_LDB(B0, 0, 0); PG8_LDB(B1, 0, 1); PG8_SCHED; PG8_LDA(At, 0, 0); PG8_STAGE(PG8_SA(1, 1), a1 + hstepA, voffA);
            PG8_WAIT_V(8); PG8_WAIT_L(0); PG8_BAR; PG8_MMA(0, 0, At, B0); PG8_MMA(0, 1, At, B1); PG8_BAR; PG8_SCHED;
            PG8_LDA(At, 0, 1); PG8_STAGE(PG8_SB(0, 0), b2, voffB); PG8_STAGE(PG8_SB(0, 1), b2 + hstepB, voffB); PG8_STAGE(PG8_SA(0, 0), a2, voffA);
            PG8_WAIT_V(8); PG8_WAIT_L(0); PG8_BAR; PG8_MMA(1, 0, At, B0); PG8_MMA(1, 1, At, B1); PG8_BAR; PG8_SCHED;
            PG8_LDB(B0, 1, 0); PG8_LDB(B1, 1, 1); PG8_SCHED; PG8_LDA(At, 1, 0); PG8_STAGE(PG8_SA(0, 1), a2 + hstepA, voffA);
            PG8_WAIT_V(8); PG8_WAIT_L(0); PG8_BAR; PG8_MMA(0, 0, At, B0); PG8_MMA(0, 1, At, B1); PG8_BAR; PG8_SCHED;
            PG8_LDA(At, 1, 1); PG8_STAGE(PG8_SB(1, 0), b3, voffB); PG8_STAGE(PG8_SB(1, 1), b3 + hstepB, voffB); PG8_STAGE(PG8_SA(1, 0), a3, voffA);
            PG8_WAIT_V(8); PG8_WAIT_L(0); PG8_BAR; PG8_MMA(1, 0, At, B0); PG8_MMA(1, 1, At, B1); PG8_BAR; PG8_SCHED;
            } else {
            PG8_LDB(B0, 0, 0); PG8_SCHED; PG8_LDA(At, 0, 0); PG8_STAGE(PG8_SA(1, 1), a1 + hstepA, voffA);
            PG8_WAIT_L(8); PG8_BAR; PG8_WAIT_L(0); PG8_MMA(0, 0, At, B0); PG8_BAR; PG8_SCHED;
            PG8_LDB(B1, 0, 1); PG8_STAGE(PG8_SB(0, 0), b2, voffB);
            PG8_BAR; PG8_WAIT_L(0); PG8_MMA(0, 1, At, B1); PG8_BAR;
            PG8_LDA(At, 0, 1); PG8_STAGE(PG8_SA(0, 0), a2, voffA);
            PG8_BAR; PG8_WAIT_L(0); PG8_MMA(1, 0, At, B0); PG8_BAR; PG8_SCHED;
            PG8_STAGE(PG8_SB(0, 1), b2 + hstepB, voffB);
            PG8_WAIT_V(6); PG8_BAR; PG8_MMA(1, 1, At, B1); PG8_BAR;
            PG8_LDB(B0, 1, 0); PG8_SCHED; PG8_LDA(At, 1, 0); PG8_STAGE(PG8_SA(0, 1), a2 + hstepA, voffA);
            PG8_WAIT_L(8); PG8_BAR; PG8_WAIT_L(0); PG8_MMA(0, 0, At, B0); PG8_BAR; PG8_SCHED;
            PG8_LDB(B1, 1, 1); PG8_STAGE(PG8_SB(1, 0), b3, voffB);
            PG8_BAR; PG8_WAIT_L(0); PG8_MMA(0, 1, At, B1); PG8_BAR;
            PG8_LDA(At, 1, 1); PG8_STAGE(PG8_SA(1, 0), a3, voffA);
            PG8_BAR; PG8_WAIT_L(0); PG8_MMA(1, 0, At, B0); PG8_BAR; PG8_SCHED;
            PG8_STAGE(PG8_SB(1, 1), b3 + hstepB, voffB);
            PG8_WAIT_V(6); PG8_BAR; PG8_MMA(1, 1, At, B1); PG8_BAR;
            }
        }
        if constexpr (ALIGN_EPI) { if (wr == 0) PG8_BAR; }
        if constexpr (!Epi::AFTER_DRAIN) E(acc, cur, wr, wc, fr, fq);
        if (!has_next) break;
#pragma unroll
        for (int a = 0; a < 2; ++a)
#pragma unroll
            for (int b = 0; b < 2; ++b)
#pragma unroll
                for (int m = 0; m < 4; ++m)
#pragma unroll
                    for (int n = 0; n < 2; ++n) acc[a][b][m][n] = (f32x4){0.f, 0.f, 0.f, 0.f};
        cur = nxt; cA = nA; cB = nB; ++ui;
        if constexpr (ALIGN_EPI) { if (wr == 1) PG8_BAR; }
    }
    PG8_WAIT_V(0);
    if constexpr (!ALIGN_EPI) { if (wr == 0) PG8_BAR; }
    PG8_BAR;
    if constexpr (Epi::AFTER_DRAIN) E.fused(acc, cur, wr, wc, lds, wid);
#undef PG8_SA
#undef PG8_SB
#undef PG8_STAGE
#undef PG8_LDA
#undef PG8_LDB
#undef PG8_MMA
#undef PG8_WAIT_V
#undef PG8_WAIT_L
#undef PG8_BAR
#undef PG8_SCHED
}
}

constexpr int NT = 16384, SEQ = 8192, DM = 1024, DIN = 4680, NIN = 4864, NCHK = 256, NWAVES = 8, NTHR = 512;
constexpr float EPS = 1e-6f, GN_EPS = 64e-5f, DECAY_SCALE = 0.606531f;
constexpr float QSCALE = 0.07216878364870322f * 1.4426950408889634f;
constexpr size_t MiB = 1u << 20;
constexpr size_t WS_CTL = 0, CTL_BYTES = 1 * MiB;
constexpr size_t CTL_MOD = 65536;
constexpr size_t CTL_SSQ = 131072;
constexpr size_t CTL_RSLOT = 393216;
constexpr size_t CTL_RCNT = 917504;
constexpr size_t WS_WIN = 1 * MiB;
constexpr size_t WS_CB = WS_WIN, WS_ECUM = WS_WIN + 8 * MiB, WS_CDEC = WS_ECUM + 512 * 1024;
constexpr size_t WS_WQ = 10 * MiB + 512 * 1024;
constexpr size_t WS_WUV = 11 * MiB;
constexpr size_t WS_WLW = 11 * MiB + 512 * 1024;
constexpr size_t WS_WLA = WS_WLW + 65536;
constexpr size_t WS_WOUT = 12 * MiB;
constexpr size_t WS_XN = 15 * MiB;
constexpr size_t WS_TT = WS_XN, WS_QE = WS_XN + 16 * MiB;
constexpr size_t WS_QLAT = 47 * MiB, WS_KVL = 55 * MiB;
constexpr size_t WS_OL = WS_QLAT;
constexpr size_t WS_GATES = 63 * MiB;
constexpr size_t WS_XBC = 111 * MiB;
constexpr size_t WS_R = 143 * MiB, WS_K = 159 * MiB, WS_V = 175 * MiB;
constexpr size_t WS_F = 191 * MiB;
constexpr size_t WS_Q = 200 * MiB;
constexpr size_t WS_KVB = 224 * MiB;
constexpr size_t WS_YD = 230 * MiB;
constexpr size_t WS_ROPE = 246 * MiB;
constexpr size_t WS_HX = 250 * MiB;
constexpr size_t WS_HRKV = WS_HX + 1536 * 1024;
constexpr size_t WS_HF = WS_HRKV + 768 * 1024;
constexpr size_t WS_END = 253 * MiB;
constexpr int LDS_BYTES = 152 * 1024;

#define LDS_WAIT() asm volatile("s_waitcnt lgkmcnt(0)" ::: "memory")
typedef __bf16 bf16x2_hw __attribute__((ext_vector_type(2)));
__device__ __forceinline__ unsigned pk2(float lo, float hi) { const f32x2 v = {lo, hi}; return __builtin_bit_cast(unsigned, __builtin_convertvector(v, bf16x2_hw)); }
__device__ __forceinline__ unsigned f2bf(float f) { return pk2(f, 0.f) & 0xffffu; }
__device__ __forceinline__ float bf2f(unsigned short b) { return __builtin_bit_cast(float, (unsigned)b << 16); }
__device__ __forceinline__ float bflo(unsigned w) { return __builtin_bit_cast(float, w << 16); }
__device__ __forceinline__ float bfhi(unsigned w) { return __builtin_bit_cast(float, w & 0xffff0000u); }
__device__ __forceinline__ float wave_sum(float v) {
#pragma unroll
    for (int o = 1; o < 64; o <<= 1) v += __shfl_xor(v, o);
    return v;
}
__device__ __forceinline__ float sigmoidf_(float x) { return __builtin_amdgcn_rcpf(1.f + __expf(-x)); }
__device__ __forceinline__ float siluf_(float x) { return x * __builtin_amdgcn_rcpf(1.f + __expf(-x)); }
__device__ __forceinline__ int pi16(int n) { const int x = n & 15; return (n & ~15) | ((x >= 4 && x < 8) ? x + 4 : (x >= 8 && x < 12) ? x - 4 : x); }
__device__ __forceinline__ int sg32(int x) { return (x & ~31) | (16 * ((x >> 2) & 1) + 4 * ((x & 31) >> 3) + (x & 3)); }
__device__ __forceinline__ int crow(int r, int hi) { return (r & 3) + 8 * (r >> 2) + 4 * hi; }

template <int K> __device__ __forceinline__ f32x4 mma_tile(const LAS bf16_t* A, int lda, const LAS bf16_t* Bt, int ldb, int lane) {
    f32x4 acc = {0.f, 0.f, 0.f, 0.f};
    const LAS bf16_t* ap = A + (lane & 15) * lda + (lane >> 4) * 8;
    const LAS bf16_t* bp = Bt + (lane & 15) * ldb + (lane >> 4) * 8;
#pragma unroll
    for (int k = 0; k < K; k += 32) {
        const bf16x8 a = *(const LAS bf16x8*)(ap + k), b = *(const LAS bf16x8*)(bp + k);
        acc = __builtin_amdgcn_mfma_f32_16x16x32_bf16(a, b, acc, 0, 0, 0);
    }
    return acc;
}

template <int V> struct IC { static constexpr int value = V; };
template <bool KX> __device__ __forceinline__ bf16x8 frag16(const LAS bf16_t* M, int ld, int x0, int k0, int lane) {
    if constexpr (!KX) return *(const LAS bf16x8*)(M + (x0 + (lane & 15)) * ld + k0 + 8 * (lane >> 4));
    else { const LAS bf16_t* p = M + (k0 + 8 * (lane >> 4) + ((lane & 15) >> 2)) * ld + x0 + 4 * (lane & 3);
        const v4i16_t lo = __builtin_amdgcn_ds_read_tr16_b64_v4i16((LAS v4i16_t*)p), hi = __builtin_amdgcn_ds_read_tr16_b64_v4i16((LAS v4i16_t*)(p + 4 * ld));
        return (bf16x8){lo[0], lo[1], lo[2], lo[3], hi[0], hi[1], hi[2], hi[3]}; }
}
template <int K, bool AKX, bool BKX> __device__ __forceinline__ f32x4 mma_tile2(const LAS bf16_t* A, int lda, int m0, const LAS bf16_t* B, int ldb, int n0, int lane) {
    f32x4 acc = {0.f, 0.f, 0.f, 0.f};
#pragma unroll
    for (int k = 0; k < K; k += 32) acc = __builtin_amdgcn_mfma_f32_16x16x32_bf16(frag16<AKX>(A, lda, m0, k, lane), frag16<BKX>(B, ldb, n0, k, lane), acc, 0, 0, 0);
    return acc;
}
struct Args {
    const float* in[31]; float* out; unsigned char* ws; int ph_lo, ph_hi;
};
struct Ctx {
    LAS unsigned char* lds; int tid, lane, wave, G, bid;
    unsigned char* ws; float* out;
    const float* const* in;
};
__device__ __forceinline__ const float* ldin(const float* const* in, int i) { asm volatile("" : "+s"(i)); return (const float*)(const GAS float*)in[i]; }
#define INP(i) ldin(F.in, i)
__device__ __forceinline__ int fresh_lane() { int l_ = (int)__builtin_amdgcn_mbcnt_hi(~0u, __builtin_amdgcn_mbcnt_lo(~0u, 0u)); asm volatile("" : "+v"(l_)); return l_; }
enum { I_X = 0, I_C, I_POS, I_ADAW, I_ADAB, I_NORMW, I_WIN, I_QNW, I_WUQ, I_KVNW, I_WUKV, I_CONVW, I_CONVB, I_DTB, I_ALOG, I_DSKIP, I_SSDNW,
       I_MURKV, I_MUW, I_MUA, I_W0, I_WLB, I_A0, I_ALB, I_KK, I_KA, I_RK, I_LNXW, I_LNXB, I_WOUT, I_FNW };

__device__ __forceinline__ int win_src_col(int n) {
    if (n < 448) return n;
    if (n < 512) return -1;
    if (n < 1024) return 448 + (n - 512);
    if (n < 1536) return 960 + (n - 1024);
    if (n < 2560) return 1472 + (n - 1536);
    if (n < 3072) return 2504 + (n - 2560);
    if (n < 3584) return 3016 + (n - 3072);
    if (n < 4096) return 3528 + (n - 3584);
    if (n < 4608) return 4168 + (n - 4096);
    if (n < 4672) return 4040 + (n - 4608);
    if (n < 4736) return 4104 + (n - 4672);
    if (n < 4744) return 2496 + (n - 4736);
    return -1;
}
template <class Src4> __device__ __forceinline__ void transpose_item(const Src4& src4, bf16_t* WT, int ldw, LAS float* scr, int kb, int nb, int lane) {
    const int k0 = 64 * kb, n0 = 64 * nb;
#pragma unroll 8
    for (int i = 0; i < 16; ++i) { const int kk = 4 * i + (lane >> 4), nn = 4 * (lane & 15); const f32x4 v = src4(k0 + kk, n0 + nn);
        LAS float* d = scr + kk * 65 + nn; d[0] = v[0]; d[1] = v[1]; d[2] = v[2]; d[3] = v[3]; }
    LDS_WAIT();
    const int c = lane & 7;
#pragma unroll
    for (int j = 0; j < 8; ++j) { const int n = (lane >> 3) + 8 * j; const LAS float* sp = scr + (8 * c) * 65 + n;
        u32x4 o; o.x = pk2(sp[0 * 65], sp[1 * 65]); o.y = pk2(sp[2 * 65], sp[3 * 65]); o.z = pk2(sp[4 * 65], sp[5 * 65]); o.w = pk2(sp[6 * 65], sp[7 * 65]);
        *(u32x4*)(WT + (size_t)(n0 + n) * ldw + k0 + 8 * c) = o; }
    LDS_WAIT();
}
__device__ __forceinline__ void prep_weights(const Ctx& F, int l) {
    LAS float* scr = (LAS float*)(F.lds + F.wave * 16640);
    const int gw = F.bid * NWAVES + F.wave, NGW = F.G * NWAVES;
    const float* w_in = INP(I_WIN) + (size_t)l * DM * DIN;
    const float* w_out = INP(I_WOUT) + (size_t)l * 1536 * 1024;
    const float* wlb = INP(I_WLB) + (size_t)l * 64 * 512;
    const float* alb = INP(I_ALB) + (size_t)l * 64 * 512;
    bf16_t* WIN = (bf16_t*)(F.ws + WS_WIN); bf16_t* WOUT = (bf16_t*)(F.ws + WS_WOUT); bf16_t* WLW = (bf16_t*)(F.ws + WS_WLW); bf16_t* WLA = (bf16_t*)(F.ws + WS_WLA);
    constexpr int I_IN = 16 * (NIN / 64), I_OUT = 24 * 16, I_LW = 8, I_LA = 8, NITEMS = I_IN + I_OUT + I_LW + I_LA;
    for (int it = gw; it < NITEMS; it += NGW) {
        int r = it;
        if (r < I_IN) { const int kb = r / (NIN / 64), nb = r % (NIN / 64);
            transpose_item([&](int k, int n) { const int sc = win_src_col(n); return sc >= 0 ? *(const f32x4*)(w_in + (size_t)k * DIN + sc) : (f32x4){0.f, 0.f, 0.f, 0.f}; }, WIN, 1024, scr, kb, nb, F.lane); continue; }
        r -= I_IN;
        if (r < I_OUT) { const int kb = r / 16, nb = r % 16;
            transpose_item([&](int k, int n) { return *(const f32x4*)(w_out + (size_t)k * 1024 + n); }, WOUT, 1536, scr, kb, nb, F.lane); continue; }
        r -= I_OUT;
        if (r < I_LW) { transpose_item([&](int k, int n) { return *(const f32x4*)(wlb + k * 512 + n); }, WLW, 64, scr, 0, r, F.lane); continue; }
        r -= I_LW;
        transpose_item([&](int k, int n) { return *(const f32x4*)(alb + k * 512 + n); }, WLA, 64, scr, 0, r, F.lane);
    }
    const float* wuq = INP(I_WUQ) + (size_t)l * 256 * 768; const float* wukv = INP(I_WUKV) + (size_t)l * 128 * 1024; const float* qnw = INP(I_QNW) + l * 256;
    bf16_t* WQ = (bf16_t*)(F.ws + WS_WQ); bf16_t* WUV = (bf16_t*)(F.ws + WS_WUV);
    const int gt = F.bid * NTHR + F.tid, NGT = F.G * NTHR;
    for (int e = gt; e < 768 * 256; e += NGT) {
        const int n = e >> 8, k = e & 255, h = n / 192, idx = n % 192; float v;
        if (idx < 128) {
            const f32x4* a = (const f32x4*)(wuq + (size_t)k * 768 + h * 192); const f32x4* b = (const f32x4*)(wukv + (size_t)idx * 1024 + h * 256);
            float s = 0.f;
#pragma unroll 8
            for (int d = 0; d < 32; ++d) { const f32x4 x = a[d], y = b[d]; s += x.x * y.x + x.y * y.y + x.z * y.z + x.w * y.w; }
            v = s;
        } else v = wuq[(size_t)k * 768 + n];
        WQ[e] = (bf16_t)f2bf(v * qnw[k]);
    }
    for (int e = gt; e < 512 * 512; e += NGT) {
        const int n = e >> 9, k = e & 511, h = n >> 7, d = n & 127, h2 = k >> 7, c = k & 127;
        WUV[e] = (h == h2) ? (bf16_t)f2bf(wukv[(size_t)c * 1024 + h * 256 + 128 + d]) : (bf16_t)0;
    }
}
__device__ __forceinline__ void p0_mod(const Ctx& F) {
    const int gw = F.bid * NWAVES + F.wave, NGW = F.G * NWAVES;
    float* MOD = (float*)(F.ws + WS_CTL + CTL_MOD);
    for (int it = gw; it < 2 * 12 * 32; it += NGW) {
        const int l = it / 384, r = it % 384, cb = r / 32, ks = r % 32;
        const float* aw = INP(I_ADAW) + (size_t)l * DM * 3072 + (size_t)(ks * 32) * 3072 + cb * 256 + F.lane * 4;
        const float* cc = INP(I_C);
        f32x4 a0 = {0.f, 0.f, 0.f, 0.f}, a1 = a0;
#pragma unroll 8
        for (int k = 0; k < 32; ++k) { const f32x4 w = *(const f32x4*)(aw + (size_t)k * 3072); const float s0 = siluf_(cc[ks * 32 + k]), s1 = siluf_(cc[DM + ks * 32 + k]); a0 += w * s0; a1 += w * s1; }
        if (ks == 0) { const f32x4 bb = *(const f32x4*)(INP(I_ADAB) + l * 3072 + cb * 256 + F.lane * 4); a0 += bb; a1 += bb; }
        float* m0 = MOD + (size_t)(l * 2 + 0) * 3072 + cb * 256 + F.lane * 4; float* m1 = m0 + 3072;
#pragma unroll
        for (int j = 0; j < 4; ++j) { atomicAdd(m0 + j, a0[j]); atomicAdd(m1 + j, a1[j]); }
    }
}
__device__ __forceinline__ void p0_rope(const Ctx& F) {
    float* ROPE = (float*)(F.ws + WS_ROPE); const int* pos = (const int*)INP(I_POS);
    for (int e = F.bid * NTHR + F.tid; e < NT * 32; e += F.G * NTHR) {
        const int m = e >> 5, i = e & 31;
        const float invf = powf(10000.f, -(float)i / 32.f); const float ang = (float)pos[m] * invf;
        const double a = (double)ang; const double kq = __builtin_rint(a * 0.15915494309189535); const float rr = (float)(a - kq * 6.283185307179586);
        ROPE[(size_t)m * 64 + i] = cosf(rr); ROPE[(size_t)m * 64 + 32 + i] = sinf(rr);
    }
}
__device__ __forceinline__ void p1_norm(const Ctx& F, int l) {
    const float* xin = (l == 0) ? INP(I_X) : F.out;
    const float* nw = INP(I_NORMW) + l * DM; const float* MOD = (const float*)(F.ws + WS_CTL + CTL_MOD);
    bf16_t* XN = (bf16_t*)(F.ws + WS_XN);
    const int gw = F.bid * NWAVES + F.wave, NGW = F.G * NWAVES;
    for (int m = gw; m < NT; m += NGW) {
        const int b = m >> 13; const float* md = MOD + (size_t)(l * 2 + b) * 3072;
        const f32x4* xr = (const f32x4*)(xin + (size_t)m * DM) + F.lane;
        f32x4 v[4]; float s = 0.f;
#pragma unroll
        for (int j = 0; j < 4; ++j) { v[j] = xr[64 * j]; s += v[j].x * v[j].x + v[j].y * v[j].y + v[j].z * v[j].z + v[j].w * v[j].w; }
        const float rstd = 1.f / sqrtf(wave_sum(s) * (1.f / DM) + EPS);
        unsigned long long* o8 = (unsigned long long*)(XN + (size_t)m * DM) + F.lane;
#pragma unroll
        for (int j = 0; j < 4; ++j) { const int c0 = 4 * F.lane + 256 * j;
            const f32x4 w = *(const f32x4*)(nw + c0), sh = *(const f32x4*)(md + c0), sc = *(const f32x4*)(md + 1024 + c0);
            const f32x4 y = v[j] * rstd * w * (sc + 1.f) + sh;
            o8[64 * j] = (unsigned long long)pk2(y.x, y.y) | ((unsigned long long)pk2(y.z, y.w) << 32); }
    }
}
__device__ __forceinline__ u32x4 pack8(f32x4 a, f32x4 b) { u32x4 w; w.x = pk2(a[0], a[1]); w.y = pk2(a[2], a[3]); w.z = pk2(b[0], b[1]); w.w = pk2(b[2], b[3]); return w; }
struct EpiIn {
    static constexpr bool AFTER_DRAIN = false;
    unsigned char* ws; int l;
    __device__ __forceinline__ void operator()(const f32x4 (&acc)[2][2][4][2], const pg8::Unit& u, int wr, int wc, int fr, int fq) const {
        { int ln_ = (int)__builtin_amdgcn_mbcnt_hi(~0u, __builtin_amdgcn_mbcnt_lo(~0u, 0u)); asm volatile("" : "+v"(ln_)); fr = ln_ & 15; fq = ln_ >> 4; }
        const int pn = u.pn; size_t bo; int ld, c0;
        if (pn == 0) { bo = WS_QLAT; ld = 256; c0 = 0; } else if (pn == 1) { bo = WS_KVL; ld = 256; c0 = 0; }
        else if (pn < 4) { bo = WS_GATES; ld = 1536; c0 = (pn - 2) * 256; } else if (pn < 6) { bo = WS_GATES; ld = 1536; c0 = 512 + (pn - 4) * 256; }
        else if (pn < 10) { bo = WS_XBC; ld = 1024; c0 = (pn - 6) * 256; } else if (pn < 12) { bo = WS_R; ld = 512; c0 = (pn - 10) * 256; }
        else if (pn < 14) { bo = WS_K; ld = 512; c0 = (pn - 12) * 256; } else if (pn < 16) { bo = WS_V; ld = 512; c0 = (pn - 14) * 256; }
        else if (pn < 18) { bo = WS_GATES; ld = 1536; c0 = 1024 + (pn - 16) * 256; } else { bo = WS_F; ld = 144; c0 = 0; }
        bf16_t* base = (bf16_t*)(ws + bo); float* F = (float*)(ws + WS_F);
        float* ssq_q = (float*)(ws + WS_CTL + CTL_SSQ) + (size_t)(l * 2) * NT; float* ssq_kv = ssq_q + NT;
        const int row0 = u.pm * 256 + wr * 64 + fr, col0 = wc * 32 + 8 * fq;
        if (pn < 18) {
#pragma unroll
            for (int ai = 0; ai < 2; ++ai)
#pragma unroll
                for (int m = 0; m < 4; ++m) { const int row = row0 + ai * 128 + m * 16; bf16_t* rp = base + (size_t)row * ld + c0 + col0;
#pragma unroll
                    for (int bj = 0; bj < 2; ++bj) *(u32x4*)(rp + bj * 128) = pack8(acc[ai][bj][m][0], acc[ai][bj][m][1]);
                    if (m == 3 && pn >= 6 && pn < 16) {
                        const int chunk = row >> 6;
                        if (pn < 10) { if (fr >= 13) { bf16_t* hp = (bf16_t*)(ws + WS_HX) + (size_t)(chunk * 3 + (fr - 13)) * 1024 + c0 + col0;
#pragma unroll
                                for (int bj = 0; bj < 2; ++bj) *(u32x4*)(hp + bj * 128) = pack8(acc[ai][bj][m][0], acc[ai][bj][m][1]); } }
                        else if (fr == 15) { bf16_t* hp = (bf16_t*)(ws + WS_HRKV) + (size_t)((pn - 10) >> 1) * NCHK * 512 + (size_t)chunk * 512 + c0 + col0;
#pragma unroll
                            for (int bj = 0; bj < 2; ++bj) *(u32x4*)(hp + bj * 128) = pack8(acc[ai][bj][m][0], acc[ai][bj][m][1]); } }
                    if (pn < 2) { float s = 0.f;
#pragma unroll
                        for (int bj = 0; bj < 2; ++bj) if (pn == 0 || bj == 0) {
#pragma unroll
                            for (int n = 0; n < 2; ++n) { const f32x4 x = acc[ai][bj][m][n]; s += x[0] * x[0] + x[1] * x[1] + x[2] * x[2] + x[3] * x[3]; } }
                        s += __shfl_xor(s, 16); s += __shfl_xor(s, 32);
                        if (fq == 0) atomicAdd((pn == 0 ? ssq_q : ssq_kv) + row, s); } }
        } else {
#pragma unroll
            for (int ai = 0; ai < 2; ++ai)
#pragma unroll
                for (int m = 0; m < 4; ++m) { const int row = row0 + ai * 128 + m * 16;
#pragma unroll
                    for (int bj = 0; bj < 2; ++bj) { const int c = bj * 128 + col0; if (c < 136) { float* fp = F + (size_t)row * 144 + c; *(f32x4*)fp = acc[ai][bj][m][0]; *(f32x4*)(fp + 4) = acc[ai][bj][m][1]; } }
                    if (m == 3 && fr == 15) { float* hf = (float*)(ws + WS_HF) + (size_t)(row >> 6) * 128 + col0; *(f32x4*)hf = acc[ai][0][m][0]; *(f32x4*)(hf + 4) = acc[ai][0][m][1]; } }
        }
    }
};
struct EpiQ {
    static constexpr bool AFTER_DRAIN = false;
    unsigned char* ws; int l;
    __device__ __forceinline__ void operator()(const f32x4 (&acc)[2][2][4][2], const pg8::Unit& u, int wr, int wc, int fr, int fq) const {
        { int ln_ = (int)__builtin_amdgcn_mbcnt_hi(~0u, __builtin_amdgcn_mbcnt_lo(~0u, 0u)); asm volatile("" : "+v"(ln_)); fr = ln_ & 15; fq = ln_ >> 4; }
        bf16_t* Q = (bf16_t*)(ws + WS_Q); const float* ssq = (const float*)(ws + WS_CTL + CTL_SSQ) + (size_t)(l * 2) * NT;
        const int row0 = u.pm * 256 + wr * 64 + fr, c0 = u.pn * 256 + wc * 32 + 8 * fq;
#pragma unroll
        for (int ai = 0; ai < 2; ++ai)
#pragma unroll
            for (int m = 0; m < 4; ++m) { const int row = row0 + ai * 128 + m * 16; const float sc = QSCALE / sqrtf(ssq[row] * (1.f / 256.f) + EPS); bf16_t* qp = Q + (size_t)row * 768 + c0;
#pragma unroll
                for (int bj = 0; bj < 2; ++bj) *(u32x4*)(qp + bj * 128) = pack8(acc[ai][bj][m][0] * sc, acc[ai][bj][m][1] * sc); }
    }
};
struct EpiUV {
    static constexpr bool AFTER_DRAIN = false;
    bf16_t* gates;
    __device__ __forceinline__ void operator()(const f32x4 (&acc)[2][2][4][2], const pg8::Unit& u, int wr, int wc, int fr, int fq) const {
        { int ln_ = (int)__builtin_amdgcn_mbcnt_hi(~0u, __builtin_amdgcn_mbcnt_lo(~0u, 0u)); asm volatile("" : "+v"(ln_)); fr = ln_ & 15; fq = ln_ >> 4; }
        const int row0 = u.pm * 256 + wr * 64 + fr;
#pragma unroll
        for (int ai = 0; ai < 2; ++ai)
#pragma unroll
            for (int m = 0; m < 4; ++m) { asm volatile("" ::: "memory"); const int row = row0 + ai * 128 + m * 16;
#pragma unroll
                for (int bj = 0; bj < 2; ++bj) { const int c = u.pn * 256 + bj * 128 + wc * 32 + 8 * fq; u32x4* gp = (u32x4*)(gates + (size_t)row * 1536 + c); const u32x4 gw = *gp;
                    f32x4 v0 = acc[ai][bj][m][0], v1 = acc[ai][bj][m][1];
                    v0[0] *= siluf_(bflo(gw.x)); v0[1] *= siluf_(bfhi(gw.x)); v0[2] *= siluf_(bflo(gw.y)); v0[3] *= siluf_(bfhi(gw.y));
                    v1[0] *= siluf_(bflo(gw.z)); v1[1] *= siluf_(bfhi(gw.z)); v1[2] *= siluf_(bflo(gw.w)); v1[3] *= siluf_(bfhi(gw.w));
                    *gp = pack8(v0, v1); } }
    }
};
struct EpiOutNorm {
    static constexpr bool AFTER_DRAIN = true;
    const float* xin; float* xout; const float* gate; unsigned char* ws; const float* nw; const float* mod1; int mode; int use;
    __device__ __forceinline__ void fused(f32x4 (&acc)[2][2][4][2], const pg8::Unit& u, int wr, int wc, LAS unsigned char* lds, int wid) const {
        const int lane = fresh_lane(), fr = lane & 15, fq = lane >> 4;
        const int row0 = u.pm * 256 + wr * 64 + fr; const int bsel = (u.pm * 256) >> 13;
        LAS float* P = (LAS float*)lds;
        LAS float* S = (LAS float*)(lds + 4096);
        LAS unsigned* flag = (LAS unsigned*)(lds + 5120);
#pragma unroll
        for (int ai = 0; ai < 2; ++ai)
#pragma unroll
            for (int m = 0; m < 4; ++m) { const int row = row0 + ai * 128 + m * 16; float sq = 0.f;
#pragma unroll
                for (int bj = 0; bj < 2; ++bj) { const int c = u.pn * 256 + bj * 128 + wc * 32 + 8 * fq; const float* gp = gate + (size_t)bsel * 3072 + c; const size_t off = (size_t)row * DM + c;
                    const f32x4 g0 = *(const f32x4*)gp, g1 = *(const f32x4*)(gp + 4), x0 = *(const f32x4*)(xin + off), x1 = *(const f32x4*)(xin + off + 4);
                    const f32x4 v0 = x0 + g0 * acc[ai][bj][m][0], v1 = x1 + g1 * acc[ai][bj][m][1]; acc[ai][bj][m][0] = v0; acc[ai][bj][m][1] = v1;
                    sq += v0[0] * v0[0] + v0[1] * v0[1] + v0[2] * v0[2] + v0[3] * v0[3] + v1[0] * v1[0] + v1[1] * v1[1] + v1[2] * v1[2] + v1[3] * v1[3]; }
                sq += __shfl_xor(sq, 16); sq += __shfl_xor(sq, 32);
                if (fq == 0) P[(ai * 128 + wr * 64 + m * 16 + fr) * 4 + wc] = sq;
                asm volatile("" ::: "memory"); }
        asm volatile("s_waitcnt lgkmcnt(0)" ::: "memory"); __builtin_amdgcn_s_barrier(); asm volatile("" ::: "memory");
        float* slots = (float*)(ws + WS_CTL + CTL_RSLOT) + (size_t)use * NT * 4; unsigned* cnt = (unsigned*)(ws + WS_CTL + CTL_RCNT) + (use * 64 + u.pm) * 64;
        const int prow = wid * 32 + (lane & 31);
        if (lane < 32) { const f32x4 pp = *(const LAS f32x4*)(P + prow * 4); const float t = (pp[0] + pp[1]) + (pp[2] + pp[3]);
            __hip_atomic_store(slots + ((size_t)(u.pm * 256 + prow) * 4 + u.pn), t, __ATOMIC_RELAXED, __HIP_MEMORY_SCOPE_AGENT); }
        asm volatile("s_waitcnt vmcnt(0)" ::: "memory");
        if (lane == 0) __hip_atomic_fetch_add(cnt, 1u, __ATOMIC_RELAXED, __HIP_MEMORY_SCOPE_AGENT);
        if (wid == 0) { unsigned spins = 0;
            for (;;) { if ((unsigned)__builtin_amdgcn_readfirstlane(__hip_atomic_load(cnt, __ATOMIC_RELAXED, __HIP_MEMORY_SCOPE_AGENT)) >= 32u) break;
                if (++spins > (1u << 22)) break;
                __builtin_amdgcn_s_sleep(2); }
            __builtin_amdgcn_fence(__ATOMIC_ACQUIRE, "agent");
            if (lane == 0) flag[0] = 1u; }
        asm volatile("s_waitcnt vmcnt(0) lgkmcnt(0)" ::: "memory"); __builtin_amdgcn_s_barrier(); asm volatile("" ::: "memory");
        if (lane < 32) { const float* sl = slots + (size_t)(u.pm * 256 + prow) * 4; float q = 0.f;
#pragma unroll
            for (int t = 0; t < 4; ++t) q += __hip_atomic_load(sl + t, __ATOMIC_RELAXED, __HIP_MEMORY_SCOPE_AGENT);
            S[prow] = __builtin_amdgcn_rsqf(q * (1.f / DM) + EPS); }
        asm volatile("s_waitcnt vmcnt(0) lgkmcnt(0)" ::: "memory"); __builtin_amdgcn_s_barrier(); asm volatile("" ::: "memory");
        const float* shf = mod1 + (size_t)bsel * 3072; bf16_t* XN = (bf16_t*)(ws + WS_XN);
#pragma unroll
        for (int ai = 0; ai < 2; ++ai)
#pragma unroll
            for (int m = 0; m < 4; ++m) { const int rl = ai * 128 + wr * 64 + m * 16 + fr, row = u.pm * 256 + rl; const float rs = S[rl];
#pragma unroll
                for (int bj = 0; bj < 2; ++bj) { const int c = u.pn * 256 + bj * 128 + wc * 32 + 8 * fq; const size_t off = (size_t)row * DM + c;
                    const f32x4 v0 = acc[ai][bj][m][0], v1 = acc[ai][bj][m][1], w0 = *(const f32x4*)(nw + c), w1 = *(const f32x4*)(nw + c + 4);
                    if (mode == 0) { *(f32x4*)(xout + off) = v0; *(f32x4*)(xout + off + 4) = v1;
                        const f32x4 sh0 = *(const f32x4*)(shf + c), sh1 = *(const f32x4*)(shf + c + 4), sc0 = *(const f32x4*)(shf + 1024 + c), sc1 = *(const f32x4*)(shf + 1024 + c + 4);
                        *(u32x4*)(XN + off) = pack8(v0 * rs * w0 * (sc0 + 1.f) + sh0, v1 * rs * w1 * (sc1 + 1.f) + sh1); }
                    else { *(f32x4*)(xout + off) = v0 * rs * w0; *(f32x4*)(xout + off + 4) = v1 * rs * w1; } }
                asm volatile("" ::: "memory"); }
    }
};
struct EpiOut {
    static constexpr bool AFTER_DRAIN = false;
    const float* xin; float* xout; const float* gate;
    __device__ __forceinline__ void operator()(const f32x4 (&acc)[2][2][4][2], const pg8::Unit& u, int wr, int wc, int fr, int fq) const {
        { int ln_ = (int)__builtin_amdgcn_mbcnt_hi(~0u, __builtin_amdgcn_mbcnt_lo(~0u, 0u)); asm volatile("" : "+v"(ln_)); fr = ln_ & 15; fq = ln_ >> 4; }
        const int row0 = u.pm * 256 + wr * 64 + fr;
#pragma unroll
        for (int bj = 0; bj < 2; ++bj) { const int c = u.pn * 256 + bj * 128 + wc * 32 + 8 * fq;
#pragma unroll
            for (int ai = 0; ai < 2; ++ai)
#pragma unroll
                for (int m = 0; m < 4; ++m) { const int row = row0 + ai * 128 + m * 16; const float* gp = gate + (size_t)(row >> 13) * 3072 + c;
                    const f32x4 g0 = *(const f32x4*)gp, g1 = *(const f32x4*)(gp + 4);
                    const size_t off = (size_t)row * DM + c; const f32x4 x0 = *(const f32x4*)(xin + off), x1 = *(const f32x4*)(xin + off + 4);
                    *(f32x4*)(xout + off) = x0 + g0 * acc[ai][bj][m][0]; *(f32x4*)(xout + off + 4) = x1 + g1 * acc[ai][bj][m][1]; } }
    }
};

__device__ __forceinline__ void p3a_extras(const Ctx& F, int l) {
    const int tid_ = F.wave * 64 + fresh_lane();
    const int gt = F.bid * NTHR + tid_, NGT = F.G * NTHR;
    const bf16_t* KVL = (const bf16_t*)(F.ws + WS_KVL); bf16_t* KVB = (bf16_t*)(F.ws + WS_KVB);
    const float* ssq = (const float*)(F.ws + WS_CTL + CTL_SSQ) + (size_t)(l * 2 + 1) * NT; const float* kvnw = INP(I_KVNW) + l * 128;
    const float* ROPE = (const float*)(F.ws + WS_ROPE);
    for (int e = gt; e < NT * 24; e += NGT) {
        const int m = e / 24, g = e % 24;
        if (g < 16) {
            const u32x4 w = *(const u32x4*)(KVL + (size_t)m * 256 + 8 * g); const float rs = 1.f / sqrtf(ssq[m] * (1.f / 128.f) + EPS);
            const f32x4 n0 = *(const f32x4*)(kvnw + 8 * g), n1 = *(const f32x4*)(kvnw + 8 * g + 4);
            u32x4 o; o.x = pk2(bflo(w.x) * rs * n0[0], bfhi(w.x) * rs * n0[1]); o.y = pk2(bflo(w.y) * rs * n0[2], bfhi(w.y) * rs * n0[3]);
            o.z = pk2(bflo(w.z) * rs * n1[0], bfhi(w.z) * rs * n1[1]); o.w = pk2(bflo(w.w) * rs * n1[2], bfhi(w.w) * rs * n1[3]);
            *(u32x4*)(KVB + (size_t)m * 192 + 8 * g) = o;
        } else {
            const int i0 = 4 * (g - 16);
            const u32x2 a = *(const u32x2*)(KVL + (size_t)m * 256 + 128 + i0), b = *(const u32x2*)(KVL + (size_t)m * 256 + 160 + i0);
            const f32x4 cs = *(const f32x4*)(ROPE + (size_t)m * 64 + i0), sn = *(const f32x4*)(ROPE + (size_t)m * 64 + 32 + i0);
            const f32x4 x1 = {bflo(a.x), bfhi(a.x), bflo(a.y), bfhi(a.y)}, x2 = {bflo(b.x), bfhi(b.x), bflo(b.y), bfhi(b.y)};
            const f32x4 o1 = x1 * cs - x2 * sn, o2 = x1 * sn + x2 * cs;
            u32x2 w1, w2; w1.x = pk2(o1[0], o1[1]); w1.y = pk2(o1[2], o1[3]); w2.x = pk2(o2[0], o2[1]); w2.y = pk2(o2[2], o2[3]);
            *(u32x2*)(KVB + (size_t)m * 192 + 128 + i0) = w1; *(u32x2*)(KVB + (size_t)m * 192 + 160 + i0) = w2;
        }
    }
}

__device__ __forceinline__ int ssd_win_col(int g, int o) { return o < 256 ? 256 * g + o : o < 384 ? 512 + 128 * g + (o - 256) : 768 + 128 * g + (o - 384); }
template <int VAR = 0> __device__ __forceinline__ void p3b_ssd(const Ctx& F, int l) {
    constexpr int SC_C = 0, SC_B = 17408, SC_BT = 34816, SC_XST = 53248, SC_CB = 90112, SC_G = 106752, SC_XSD = 115968, SC_DT = 125184, SC_AC = 127232, SC_YS = 129280  , SC_STS = 137472  ;
    static_assert(SC_STS + 16384 <= LDS_BYTES - 256, "ssd lds map");
    LAS bf16_t* Cg = (LAS bf16_t*)(F.lds + SC_C); LAS bf16_t* Bg = (LAS bf16_t*)(F.lds + SC_B); LAS bf16_t* BT = (LAS bf16_t*)(F.lds + SC_BT);
    LAS bf16_t* XST = (LAS bf16_t*)(F.lds + SC_XST); LAS float* CB = (LAS float*)(F.lds + SC_CB); LAS bf16_t* Gh = (LAS bf16_t*)(F.lds + SC_G);
    LAS bf16_t* YS = (LAS bf16_t*)(F.lds + SC_YS); LAS bf16_t* STS = (LAS bf16_t*)(F.lds + SC_STS);
    LAS bf16_t* XSD = (LAS bf16_t*)(F.lds + SC_XSD); LAS float* DT = (LAS float*)(F.lds + SC_DT); LAS float* AC = (LAS float*)(F.lds + SC_AC);
    bf16_t* XBC = (bf16_t*)(F.ws + WS_XBC); const bf16_t* HX = (const bf16_t*)(F.ws + WS_HX); const float* Ff = (const float*)(F.ws + WS_F);
    bf16_t* Cbuf = (bf16_t*)(F.ws + WS_CB); float* ECUM = (float*)(F.ws + WS_ECUM); float* CDEC = (float*)(F.ws + WS_CDEC); bf16_t* YD = (bf16_t*)(F.ws + WS_YD);
    const float* convw = INP(I_CONVW) + (size_t)l * 4 * 1024; const float* convb = INP(I_CONVB) + l * 1024;
    const float* dtb = INP(I_DTB) + l * 8; const float* alog = INP(I_ALOG) + l * 8; const float* dskip = INP(I_DSKIP) + l * 8;
    const int tid = F.tid, lane = F.lane, wave = F.wave;
    for (int c = F.bid; c < NCHK; c += F.G) {
        const int m0 = 64 * c; const bool first = (c & 127) == 0;
        {
            const int t = lane;
            { const int h = wave;
                const float raw = Ff[(size_t)(m0 + t) * 144 + 128 + h] + dtb[h];
                const float dt = raw > 20.f ? raw : log1pf(expf(raw));
                float v = dt * (-expf(alog[h]));
#pragma unroll
                for (int o = 1; o < 64; o <<= 1) { const float y = __shfl_up(v, o); if (lane >= o) v += y; }
                DT[h * 64 + t] = dt; AC[h * 64 + t] = v;
                const float ev = expf(v); ECUM[(size_t)(c * 8 + h) * 64 + t] = ev; if (t == 63) CDEC[c * 8 + h] = ev;
            }
        }
        for (int g = 0; g < 2; ++g) {
            if (!(VAR & 1)) {
                const int cgp = tid & 63, rg = tid >> 6, col = ssd_win_col(g, 8 * cgp), t0 = 8 * rg;
                u32x4 xr[11];
#pragma unroll
                for (int i = 0; i < 11; ++i) { const int t = t0 - 3 + i;
                    if (t >= 0) xr[i] = *(const u32x4*)(XBC + (size_t)(m0 + t) * 1024 + col);
                    else if (!first) xr[i] = *(const u32x4*)(HX + (size_t)((c - 1) * 3 + i) * 1024 + col);
                    else xr[i] = (u32x4){0u, 0u, 0u, 0u}; }
                float wv[4][8], bv8[8];
#pragma unroll
                for (int j = 0; j < 4; ++j) { const f32x4 a = *(const f32x4*)(convw + j * 1024 + col), b2 = *(const f32x4*)(convw + j * 1024 + col + 4);
                    wv[j][0] = a[0]; wv[j][1] = a[1]; wv[j][2] = a[2]; wv[j][3] = a[3]; wv[j][4] = b2[0]; wv[j][5] = b2[1]; wv[j][6] = b2[2]; wv[j][7] = b2[3]; }
                { const f32x4 a = *(const f32x4*)(convb + col), b2 = *(const f32x4*)(convb + col + 4); bv8[0] = a[0]; bv8[1] = a[1]; bv8[2] = a[2]; bv8[3] = a[3]; bv8[4] = b2[0]; bv8[5] = b2[1]; bv8[6] = b2[2]; bv8[7] = b2[3]; }
                float y[8][8];
#pragma unroll
                for (int e = 0; e < 8; ++e) {
                    const unsigned x0[4] = {xr[e].x, xr[e].y, xr[e].z, xr[e].w}, x1[4] = {xr[e + 1].x, xr[e + 1].y, xr[e + 1].z, xr[e + 1].w}, x2[4] = {xr[e + 2].x, xr[e + 2].y, xr[e + 2].z, xr[e + 2].w}, x3[4] = {xr[e + 3].x, xr[e + 3].y, xr[e + 3].z, xr[e + 3].w};
#pragma unroll
                    for (int k = 0; k < 8; ++k) { const int q = k >> 1;
                        const float a0 = (k & 1) ? bfhi(x0[q]) : bflo(x0[q]), a1 = (k & 1) ? bfhi(x1[q]) : bflo(x1[q]), a2 = (k & 1) ? bfhi(x2[q]) : bflo(x2[q]), a3 = (k & 1) ? bfhi(x3[q]) : bflo(x3[q]);
                        y[e][k] = siluf_(wv[0][k] * a0 + wv[1][k] * a1 + wv[2][k] * a2 + wv[3][k] * a3 + bv8[k]); } }
                if (cgp >= 32) { LAS bf16_t* nat = (cgp < 48) ? Bg + 8 * (cgp - 32) : Cg + 8 * (cgp - 48);
#pragma unroll
                    for (int e = 0; e < 8; ++e) { u32x4 o; o.x = pk2(y[e][0], y[e][1]); o.y = pk2(y[e][2], y[e][3]); o.z = pk2(y[e][4], y[e][5]); o.w = pk2(y[e][6], y[e][7]); *(LAS u32x4*)(nat + (t0 + e) * 136) = o; } }
                if (cgp < 48) { LAS bf16_t* trn = (cgp < 32) ? XST + (8 * cgp) * 72 : BT + (8 * (cgp - 32)) * 72;
#pragma unroll
                    for (int k = 0; k < 8; ++k) { u32x4 o; o.x = pk2(y[0][k], y[1][k]); o.y = pk2(y[2][k], y[3][k]); o.z = pk2(y[4][k], y[5][k]); o.w = pk2(y[6][k], y[7][k]); *(LAS u32x4*)(trn + k * 72 + t0) = o; } }
            }
            __syncthreads();
#pragma unroll
            for (int i = 0; i < 2; ++i) { const int idx = tid + 512 * i, t = idx >> 4, c8 = idx & 15;
                *(u32x4*)(Cbuf + (size_t)(m0 + t) * 256 + g * 128 + c8 * 8) = *(const LAS u32x4*)(Cg + t * 136 + c8 * 8); }
#pragma unroll
            for (int i = 0; i < 2; ++i) { const int idx = 2 * wave + i, ti = idx >> 2, si = idx & 3;
                const f32x4 acc = mma_tile<128>(Cg + ti * 16 * 136, 136, Bg + si * 16 * 136, 136, lane);
#pragma unroll
                for (int r = 0; r < 4; ++r) CB[(ti * 16 + 4 * (lane >> 4) + r) * 68 + si * 16 + (lane & 15)] = acc[r]; }
            __syncthreads();
            if (!(VAR & 2)) {
                const int hl = wave >> 1, hf = wave & 1, h = 4 * g + hl, fr = lane & 15, fk = lane >> 4;
                const LAS float* ACh = AC + h * 64; const LAS float* DTh = DT + h * 64; const float a63 = ACh[63], dsk = dskip[h];
#pragma unroll
                for (int ti2 = 0; ti2 < 2; ++ti2) { const int ti = 2 * hf + ti2, t = 16 * ti + fr; const float at = ACh[t];
                    bf16x8 ga[2];
#pragma unroll
                    for (int ks = 0; ks < 2; ++ks) { const int s0 = 32 * ks + 8 * fk;
                        const f32x4 c0 = *(const LAS f32x4*)(CB + t * 68 + s0), c1 = *(const LAS f32x4*)(CB + t * 68 + s0 + 4), a0 = *(const LAS f32x4*)(ACh + s0), a1 = *(const LAS f32x4*)(ACh + s0 + 4), d0 = *(const LAS f32x4*)(DTh + s0), d1 = *(const LAS f32x4*)(DTh + s0 + 4);
                        float gv[8];
#pragma unroll
                        for (int j = 0; j < 4; ++j) { gv[j] = (s0 + j <= t) ? c0[j] * __expf(at - a0[j]) * d0[j] : 0.f; gv[4 + j] = (s0 + 4 + j <= t) ? c1[j] * __expf(at - a1[j]) * d1[j] : 0.f; }
                        u32x4 w; w.x = pk2(gv[0], gv[1]); w.y = pk2(gv[2], gv[3]); w.z = pk2(gv[4], gv[5]); w.w = pk2(gv[6], gv[7]); ga[ks] = __builtin_bit_cast(bf16x8, w); }
#pragma unroll
                    for (int pi = 0; pi < 4; ++pi) { f32x4 acc = {0.f, 0.f, 0.f, 0.f};
#pragma unroll
                        for (int ks = 0; ks < 2; ++ks) acc = __builtin_amdgcn_mfma_f32_16x16x32_bf16(ga[ks], *(const LAS bf16x8*)(XST + (64 * hl + 16 * pi + fr) * 72 + 32 * ks + 8 * fk), acc, 0, 0, 0);
#pragma unroll
                        for (int r = 0; r < 4; ++r) { const int tt = 16 * ti + 4 * fk + r, pp = 16 * pi + fr;
                            YD[(size_t)(m0 + tt) * 512 + 64 * h + pp] = (bf16_t)f2bf(acc[r] + dsk * bf2f(XST[(64 * hl + pp) * 72 + tt])); } }
                }
                {   float fac[2][8];
#pragma unroll
                    for (int ks = 0; ks < 2; ++ks) { const int s0 = 32 * ks + 8 * fk; const f32x4 a0 = *(const LAS f32x4*)(ACh + s0), a1 = *(const LAS f32x4*)(ACh + s0 + 4), d0 = *(const LAS f32x4*)(DTh + s0), d1 = *(const LAS f32x4*)(DTh + s0 + 4);
#pragma unroll
                        for (int j = 0; j < 4; ++j) { fac[ks][j] = d0[j] * __expf(a63 - a0[j]); fac[ks][4 + j] = d1[j] * __expf(a63 - a1[j]); } }
#pragma unroll
                    for (int pi2 = 0; pi2 < 2; ++pi2) { const int pi = 2 * hf + pi2; bf16x8 xa[2];
#pragma unroll
                        for (int ks = 0; ks < 2; ++ks) { const u32x4 xw = *(const LAS u32x4*)(XST + (64 * hl + 16 * pi + fr) * 72 + 32 * ks + 8 * fk);
                            u32x4 w; w.x = pk2(bflo(xw.x) * fac[ks][0], bfhi(xw.x) * fac[ks][1]); w.y = pk2(bflo(xw.y) * fac[ks][2], bfhi(xw.y) * fac[ks][3]); w.z = pk2(bflo(xw.z) * fac[ks][4], bfhi(xw.z) * fac[ks][5]); w.w = pk2(bflo(xw.w) * fac[ks][6], bfhi(xw.w) * fac[ks][7]);
                            xa[ks] = __builtin_bit_cast(bf16x8, w); }
#pragma unroll
                        for (int ni = 0; ni < 8; ++ni) { f32x4 acc = {0.f, 0.f, 0.f, 0.f};
#pragma unroll
                            for (int ks = 0; ks < 2; ++ks) acc = __builtin_amdgcn_mfma_f32_16x16x32_bf16(xa[ks], *(const LAS bf16x8*)(BT + (16 * ni + fr) * 72 + 32 * ks + 8 * fk), acc, 0, 0, 0);
#pragma unroll
                            for (int r = 0; r < 4; ++r) { const int pp = 16 * pi + 4 * fk + r, n = 16 * ni + fr; const int f = hl * 8192 + pp * 128 + n, wr = f >> 9, col = ssd_win_col(g, f & 511);
                                XBC[(size_t)(m0 + wr) * 1024 + col] = (bf16_t)f2bf(acc[r]); } }
                    }
                }
            }
            __syncthreads();
        }
    }
}

template <int VAR = 0> __device__ __forceinline__ void p3c_rwkv(const Ctx& F, int l) {
    constexpr int M9 = 9216, O_TW = 0, O_AL = 9216, O_SL = 18432, O_MAB = O_SL + 12 * M9  , O_LWF = O_SL + 10 * M9  , O_ICF = O_LWF + 17408, O_WL = O_MAB + 16640  , O_SCR = O_WL + 256, O_PAR = O_SCR + 4224  ;
    static_assert(O_ICF + 17408 <= O_MAB + 16640 && O_PAR + 2048 <= LDS_BYTES - 256, "rwkv lds map");
#define LB() ({ LAS unsigned char* p_ = F.lds; asm volatile("" : "+s"(p_)); p_; })
#define SLOT(i) ((LAS bf16_t*)(L + O_SL + (i) * M9))
#define TW ((LAS bf16_t*)(L + O_TW))
#define AL ((LAS bf16_t*)(L + O_AL))
#define AT SLOT(0)
#define ATt SLOT(1)
#define BTl SLOT(2)
#define KTl SLOT(3)
#define RT SLOT(4)
#define BHt SLOT(5)
#define KH SLOT(6)
#define VT SLOT(7)
#define MI SLOT(8)
#define MakT SLOT(9)
#define Rb SLOT(10)
#define Rk SLOT(11)
#define Attn SLOT(0)
#define KEt SLOT(1)
#define X1t SLOT(2)
#define X2t SLOT(3)
#define S8 SLOT(8)
#define S9 SLOT(9)
#define MAB ((LAS float*)(L + O_MAB))
#define LWf ((LAS float*)(L + O_LWF))
#define ICf ((LAS float*)(L + O_ICF))
#define WL ((LAS float*)(L + O_WL))
#define SCR ((LAS float*)(L + O_SCR))
#define PAR ((LAS float*)(L + O_PAR))
    const int tid = F.tid, lane = F.lane, wave = F.wave;
    for (int c = F.bid; c < NCHK; c += F.G) {
        const int m0 = 64 * c; const bool first = (c & 127) == 0;
        {
            LAS unsigned char* L = LB();
            const int t = tid >> 3, q0 = (tid & 7) * 8;
            const float* Ff = (const float*)(F.ws + WS_F); const float* HF = (const float*)(F.ws + WS_HF); const float* mu_w = INP(I_MUW) + l * 64; const float* mu_a = INP(I_MUA) + l * 64;
            float cw[8], pw[8], ca[8], pa[8];
            const float* cur = Ff + (size_t)(m0 + t) * 144; const float* prv = (t > 0) ? cur - 144 : HF + (size_t)(c - 1) * 128;
#pragma unroll
            for (int j = 0; j < 8; ++j) { cw[j] = cur[q0 + j]; ca[j] = cur[64 + q0 + j]; }
            if (t > 0) {
#pragma unroll
                for (int j = 0; j < 8; ++j) { pw[j] = prv[q0 + j]; pa[j] = prv[64 + q0 + j]; }
            } else if (!first) {
#pragma unroll
                for (int j = 0; j < 8; ++j) { pw[j] = prv[q0 + j]; pa[j] = prv[64 + q0 + j]; }
            } else {
#pragma unroll
                for (int j = 0; j < 8; ++j) { pw[j] = 0.f; pa[j] = 0.f; }
            }
            float ow[8], oa[8];
#pragma unroll
            for (int j = 0; j < 8; ++j) { ow[j] = tanhf(cw[j] + (pw[j] - cw[j]) * mu_w[q0 + j]); oa[j] = ca[j] + (pa[j] - ca[j]) * mu_a[q0 + j]; }
            u32x4 o; o.x = pk2(ow[0], ow[1]); o.y = pk2(ow[2], ow[3]); o.z = pk2(ow[4], ow[5]); o.w = pk2(ow[6], ow[7]); *(LAS u32x4*)(TW + t * 72 + q0) = o;
            o.x = pk2(oa[0], oa[1]); o.y = pk2(oa[2], oa[3]); o.z = pk2(oa[4], oa[5]); o.w = pk2(oa[6], oa[7]); *(LAS u32x4*)(AL + t * 72 + q0) = o;
        }
        u32x4 nlw, nla; float npar;
        auto head_fetch = [&](int h_, int tid_) { const int row = tid_ >> 3, c8 = tid_ & 7; const bf16_t* WLW = (const bf16_t*)(F.ws + WS_WLW); const bf16_t* WLA = (const bf16_t*)(F.ws + WS_WLA);
            nlw = *(const u32x4*)(WLW + (size_t)(h_ * 64 + row) * 64 + c8 * 8); nla = *(const u32x4*)(WLA + (size_t)(h_ * 64 + row) * 64 + c8 * 8);
            const int pi = tid_ >> 6, pc = tid_ & 63;
            const float* src = (pi < 3) ? INP(I_MURKV) + (size_t)l * 1536 + pi * 512 : (pi == 3) ? INP(I_KK) + l * 512 : (pi == 4) ? INP(I_KA) + l * 512 : (pi == 5) ? INP(I_RK) + l * 512 : (pi == 6) ? INP(I_W0) + l * 512 : INP(I_A0) + l * 512;
            npar = src[h_ * 64 + pc]; };
        head_fetch(0, F.tid);
        for (int h = 0; h < 8; ++h) {
            int tid = F.tid, lane = F.lane; asm volatile("" : "+v"(tid), "+v"(lane));
            const int t1 = tid >> 3, ch0 = (tid & 7) * 8, col1 = h * 64 + ch0;
            u32x4 rw, kw, vw, rp = {0u, 0u, 0u, 0u}, kp = rp, vp = rp;
            {   const bf16_t* Rg = (const bf16_t*)(F.ws + WS_R); const bf16_t* Kg = (const bf16_t*)(F.ws + WS_K); const bf16_t* Vg = (const bf16_t*)(F.ws + WS_V); const bf16_t* HR = (const bf16_t*)(F.ws + WS_HRKV);
                const size_t off = (size_t)(m0 + t1) * 512 + col1;
                rw = *(const u32x4*)(Rg + off); kw = *(const u32x4*)(Kg + off); vw = *(const u32x4*)(Vg + off);
                if (t1 > 0) { rp = *(const u32x4*)(Rg + off - 512); kp = *(const u32x4*)(Kg + off - 512); vp = *(const u32x4*)(Vg + off - 512); }
                else if (!first) { const size_t ho = (size_t)(c - 1) * 512 + col1; rp = *(const u32x4*)(HR + ho); kp = *(const u32x4*)(HR + (size_t)NCHK * 512 + ho); vp = *(const u32x4*)(HR + (size_t)2 * NCHK * 512 + ho); } }
            {   LAS unsigned char* L = LB(); const int row = tid >> 3, c8 = tid & 7;
                *(LAS u32x4*)(S8 + row * 72 + c8 * 8) = nlw; *(LAS u32x4*)(S9 + row * 72 + c8 * 8) = nla; PAR[(tid >> 6) * 64 + (tid & 63)] = npar; }
            if (h < 7) head_fetch(h + 1, tid);
            __syncthreads();
            if (!(VAR & 16)) {   LAS unsigned char* L = LB(); const int which = wave >> 2, ci = wave & 3, ch = ci * 16 + (lane & 15), g4 = lane >> 4;
                const float bias = PAR[(6 + which) * 64 + ch]; float carry = 0.f;
#pragma unroll
                for (int ti = 0; ti < 4; ++ti) {
                    const f32x4 acc = mma_tile<64>((which ? AL : TW) + ti * 16 * 72, 72, (which ? S9 : S8) + ci * 16 * 72, 72, lane);
                    if (which == 0) {
                        float a[4];
#pragma unroll
                        for (int r = 0; r < 4; ++r) a[r] = -DECAY_SCALE * sigmoidf_(acc[r] + bias);
                        a[1] += a[0]; a[2] += a[1]; a[3] += a[2];
                        float tot = a[3]; const float u1 = __shfl_up(tot, 16); if (g4 >= 1) tot += u1; const float u2 = __shfl_up(tot, 32); if (g4 >= 2) tot += u2;
                        const float base = carry + tot - a[3];
#pragma unroll
                        for (int r = 0; r < 4; ++r) LWf[(ti * 16 + 4 * g4 + r) * 68 + ch] = base + a[r];
                        carry += __shfl(tot, 48 + (lane & 15));
                    } else {
#pragma unroll
                        for (int r = 0; r < 4; ++r) ICf[(ti * 16 + 4 * g4 + r) * 68 + ch] = sigmoidf_(acc[r] + bias);
                    }
                }
                if (which == 0 && g4 == 0) WL[ch] = __expf(carry);
            }
            __syncthreads();
            float bonv[8] = {0.f, 0.f, 0.f, 0.f, 0.f, 0.f, 0.f, 0.f};
            if (!(VAR & 2)) {   LAS unsigned char* L = LB(); const int t = t1;
                const unsigned rwa[4] = {rw.x, rw.y, rw.z, rw.w}, kwa[4] = {kw.x, kw.y, kw.z, kw.w}, vwa[4] = {vw.x, vw.y, vw.z, vw.w};
                const unsigned rpa[4] = {rp.x, rp.y, rp.z, rp.w}, kpa[4] = {kp.x, kp.y, kp.z, kp.w}, vpa[4] = {vp.x, vp.y, vp.z, vp.w};
                float rs[8], ks[8], vs[8], kkv[8], k2[8], ic[8]; float ss = 0.f, bs = 0.f;
                float pr_[6][8], lwt[8], lwp[8], l63[8];
#pragma unroll
                for (int q = 0; q < 6; ++q) { const f32x4 a = *(const LAS f32x4*)(PAR + q * 64 + ch0), b = *(const LAS f32x4*)(PAR + q * 64 + ch0 + 4);
                    pr_[q][0] = a[0]; pr_[q][1] = a[1]; pr_[q][2] = a[2]; pr_[q][3] = a[3]; pr_[q][4] = b[0]; pr_[q][5] = b[1]; pr_[q][6] = b[2]; pr_[q][7] = b[3]; }
                {   const f32x4 a = *(const LAS f32x4*)(ICf + t * 68 + ch0), b = *(const LAS f32x4*)(ICf + t * 68 + ch0 + 4); ic[0] = a[0]; ic[1] = a[1]; ic[2] = a[2]; ic[3] = a[3]; ic[4] = b[0]; ic[5] = b[1]; ic[6] = b[2]; ic[7] = b[3];
                    const f32x4 c0 = *(const LAS f32x4*)(LWf + t * 68 + ch0), c1 = *(const LAS f32x4*)(LWf + t * 68 + ch0 + 4); lwt[0] = c0[0]; lwt[1] = c0[1]; lwt[2] = c0[2]; lwt[3] = c0[3]; lwt[4] = c1[0]; lwt[5] = c1[1]; lwt[6] = c1[2]; lwt[7] = c1[3];
                    const int tp = (t > 0) ? t - 1 : 0; const f32x4 d0 = *(const LAS f32x4*)(LWf + tp * 68 + ch0), d1 = *(const LAS f32x4*)(LWf + tp * 68 + ch0 + 4); const float pm_ = (t > 0) ? 1.f : 0.f;
                    lwp[0] = d0[0] * pm_; lwp[1] = d0[1] * pm_; lwp[2] = d0[2] * pm_; lwp[3] = d0[3] * pm_; lwp[4] = d1[0] * pm_; lwp[5] = d1[1] * pm_; lwp[6] = d1[2] * pm_; lwp[7] = d1[3] * pm_;
                    const f32x4 e0 = *(const LAS f32x4*)(LWf + 63 * 68 + ch0), e1 = *(const LAS f32x4*)(LWf + 63 * 68 + ch0 + 4); l63[0] = e0[0]; l63[1] = e0[1]; l63[2] = e0[2]; l63[3] = e0[3]; l63[4] = e1[0]; l63[5] = e1[1]; l63[6] = e1[2]; l63[7] = e1[3]; }
#pragma unroll
                for (int j = 0; j < 8; ++j) { const int q = j >> 1;
                    const float r_ = (j & 1) ? bfhi(rwa[q]) : bflo(rwa[q]), rq = (j & 1) ? bfhi(rpa[q]) : bflo(rpa[q]);
                    const float k_ = (j & 1) ? bfhi(kwa[q]) : bflo(kwa[q]), kq = (j & 1) ? bfhi(kpa[q]) : bflo(kpa[q]);
                    const float v_ = (j & 1) ? bfhi(vwa[q]) : bflo(vwa[q]), vq = (j & 1) ? bfhi(vpa[q]) : bflo(vpa[q]);
                    rs[j] = r_ + (rq - r_) * pr_[0][j]; ks[j] = k_ + (kq - k_) * pr_[1][j]; vs[j] = v_ + (vq - v_) * pr_[2][j];
                    kkv[j] = ks[j] * pr_[3][j]; ss += kkv[j] * kkv[j];
                    k2[j] = ks[j] * (1.f + (ic[j] - 1.f) * pr_[4][j]); bs += rs[j] * k2[j] * pr_[5][j]; }
                ss += __shfl_xor(ss, 1); ss += __shfl_xor(ss, 2); ss += __shfl_xor(ss, 4);
                bs += __shfl_xor(bs, 1); bs += __shfl_xor(bs, 2); bs += __shfl_xor(bs, 4);
                const float inv = __builtin_amdgcn_rsqf(fmaxf(ss, 1e-24f));
                float vAT[8], vB[8], vK[8], vR[8], vBH[8], vKH[8];
#pragma unroll
                for (int j = 0; j < 8; ++j) { const int ch = ch0 + j;
                    const float LWt = lwt[j], LWp = lwp[j], L63 = l63[j];
                    const float kk = kkv[j] * inv, a = -kk, b = kk * ic[j];
                    const float e1 = __expf(LWt), e2 = __expf(-LWt), e3 = __expf(LWp), e4 = __expf(L63 - LWt);
                    vAT[j] = a * e3; vB[j] = b * e2; vK[j] = k2[j] * e2; vR[j] = rs[j] * e1; vBH[j] = b * e4; vKH[j] = k2[j] * e4; bonv[j] = bs * vs[j];
                    (void)ch; }
                u32x4 o;
#define PK8(A_) (o[0] = pk2(A_[0], A_[1]), o[1] = pk2(A_[2], A_[3]), o[2] = pk2(A_[4], A_[5]), o[3] = pk2(A_[6], A_[7]), o)
                *(LAS u32x4*)(AT + t * 72 + ch0) = PK8(vAT); *(LAS u32x4*)(BTl + t * 72 + ch0) = PK8(vB); *(LAS u32x4*)(KTl + t * 72 + ch0) = PK8(vK);
                *(LAS u32x4*)(RT + t * 72 + ch0) = PK8(vR); *(LAS u32x4*)(KH + t * 72 + ch0) = PK8(vKH); *(LAS u32x4*)(BHt + t * 72 + ch0) = PK8(vBH); *(LAS u32x4*)(VT + t * 72 + ch0) = PK8(vs);
            }
            __syncthreads();
            { u32x4 o; *(u32x4*)((bf16_t*)(F.ws + WS_V) + (size_t)(m0 + t1) * 512 + col1) = PK8(bonv); }
            if (!(VAR & 8)) { LAS unsigned char* L = LB();
                auto run2 = [&](auto PT) { constexpr int p = decltype(PT)::value;
                    f32x4 acc[8];
#pragma unroll
                    for (int i = 0; i < 8; ++i) { const int idx = 8 * (wave & 1) + i, ti = idx >> 2, si = idx & 3;
                        acc[i] = mma_tile<64>(((p < 2) ? AT : RT) + ti * 16 * 72, 72, ((p & 1) ? KTl : BTl) + si * 16 * 72, 72, lane); }
#pragma unroll
                    for (int i = 0; i < 8; ++i) { const int idx = 8 * (wave & 1) + i, ti = idx >> 2, si = idx & 3;
#pragma unroll
                        for (int r = 0; r < 4; ++r) { const int t = ti * 16 + 4 * (lane >> 4) + r, s = si * 16 + (lane & 15);
                            if (p == 0) MAB[t * 65 + s] = (s < t) ? acc[i][r] : 0.f;
                            else if (p == 1) MakT[s * 72 + t] = (bf16_t)f2bf((s < t) ? acc[i][r] : 0.f);
                            else if (p == 2) Rb[t * 72 + s] = (bf16_t)f2bf((s <= t) ? acc[i][r] : 0.f);
                            else Rk[t * 72 + s] = (bf16_t)f2bf((s <= t) ? acc[i][r] : 0.f); } } };
                const int pw = wave >> 1;
                if (pw == 0) run2(IC<0>{}); else if (pw == 1) run2(IC<1>{}); else if (pw == 2) run2(IC<2>{}); else run2(IC<3>{}); }
            __syncthreads();
            if (!(VAR & 1)) {
            if (wave < 4 && lane < 16) { LAS unsigned char* L = LB(); const int b0 = 16 * wave; float x[16];
#pragma unroll
                for (int t = 0; t < 16; ++t) { float v = (t == lane) ? 1.f : 0.f;
#pragma unroll
                    for (int s = 0; s < 16; ++s) if (s < t) v += MAB[(b0 + t) * 65 + b0 + s] * x[s];
                    x[t] = v; }
#pragma unroll
                for (int t = 0; t < 16; ++t) MAB[(b0 + t) * 65 + b0 + lane] = x[t]; }
            __syncthreads();
            if (wave < 2) { LAS unsigned char* L = LB(); const int pr = wave, rb = pr ? 48 : 16, cb = pr ? 32 : 0, fr = lane & 15, fk = lane >> 4; f32x4 acc = {0.f, 0.f, 0.f, 0.f};
#pragma unroll
                for (int ks = 0; ks < 4; ++ks) acc = __builtin_amdgcn_mfma_f32_16x16x4f32(MAB[(rb + fr) * 65 + cb + 4 * ks + fk], MAB[(cb + 4 * ks + fk) * 65 + cb + fr], acc, 0, 0, 0);
#pragma unroll
                for (int r = 0; r < 4; ++r) SCR[(pr * 16 + 4 * fk + r) * 33 + fr] = acc[r]; }
            __syncthreads();
            if (wave < 2) { LAS unsigned char* L = LB(); const int pr = wave, rb = pr ? 48 : 16, cb = pr ? 32 : 0, fr = lane & 15, fk = lane >> 4; f32x4 acc = {0.f, 0.f, 0.f, 0.f};
#pragma unroll
                for (int ks = 0; ks < 4; ++ks) acc = __builtin_amdgcn_mfma_f32_16x16x4f32(MAB[(rb + fr) * 65 + rb + 4 * ks + fk], SCR[(pr * 16 + 4 * ks + fk) * 33 + fr], acc, 0, 0, 0);
#pragma unroll
                for (int r = 0; r < 4; ++r) MAB[(rb + 4 * fk + r) * 65 + cb + fr] = acc[r]; }
            __syncthreads();
            if (wave < 4) { LAS unsigned char* L = LB(); const int ti = wave >> 1, ci = wave & 1, fr = lane & 15, fk = lane >> 4; f32x4 acc = {0.f, 0.f, 0.f, 0.f};
#pragma unroll
                for (int ks = 0; ks < 8; ++ks) acc = __builtin_amdgcn_mfma_f32_16x16x4f32(MAB[(32 + 16 * ti + fr) * 65 + 4 * ks + fk], MAB[(4 * ks + fk) * 65 + 16 * ci + fr], acc, 0, 0, 0);
#pragma unroll
                for (int r = 0; r < 4; ++r) SCR[(16 * ti + 4 * fk + r) * 33 + 16 * ci + fr] = acc[r]; }
            __syncthreads();
            if (wave < 4) { LAS unsigned char* L = LB(); const int ti = wave >> 1, ci = wave & 1, fr = lane & 15, fk = lane >> 4; f32x4 acc = {0.f, 0.f, 0.f, 0.f};
#pragma unroll
                for (int ks = 0; ks < 8; ++ks) acc = __builtin_amdgcn_mfma_f32_16x16x4f32(MAB[(32 + 16 * ti + fr) * 65 + 32 + 4 * ks + fk], SCR[(4 * ks + fk) * 33 + 16 * ci + fr], acc, 0, 0, 0);
#pragma unroll
                for (int r = 0; r < 4; ++r) MAB[(32 + 16 * ti + 4 * fk + r) * 65 + 16 * ci + fr] = acc[r]; }
            __syncthreads();
            {   LAS unsigned char* L = LB(); const int t = tid >> 3, s0 = (tid & 7) * 8; float x[8];
#pragma unroll
                for (int j = 0; j < 8; ++j) x[j] = MAB[t * 65 + s0 + j];
                u32x4 o; *(LAS u32x4*)(MI + t * 72 + s0) = PK8(x); }
            __syncthreads();
            }
            if (!(VAR & 4)) { LAS unsigned char* L = LB();
#pragma unroll
            for (int i = 0; i < 4; ++i) { const int idx = 4 * wave + i, ti = (idx >> 2) & 3, ci = idx & 3; LAS bf16_t* osel = (wave >> 2) ? X2t : X1t;
                const f32x4 acc = (wave >> 2) ? mma_tile<64>(MI + ti * 16 * 72, 72, MakT + ci * 16 * 72, 72, lane) : mma_tile2<64, false, true>(MI, 72, ti * 16, AT, 72, ci * 16, lane);
#pragma unroll
                for (int r = 0; r < 4; ++r) { const int t = ti * 16 + 4 * (lane >> 4) + r, j = ci * 16 + (lane & 15); osel[j * 72 + t] = (bf16_t)f2bf(acc[r]); } } }
            __syncthreads();
            if (!(VAR & 4)) { LAS unsigned char* L = LB();
                auto run5 = [&](auto PT) { constexpr int p = decltype(PT)::value;
                    f32x4 acc[8];
#pragma unroll
                    for (int i = 0; i < 8; ++i) { const int idx = 8 * (wave & 1) + i, ti = idx >> 2, si = idx & 3;
                        if constexpr (p < 2) acc[i] = mma_tile<64>(Rb + ti * 16 * 72, 72, ((p == 0) ? X1t : X2t) + si * 16 * 72, 72, lane);
                        else acc[i] = mma_tile2<64, false, true>((p == 2) ? X1t : X2t, 72, ti * 16, BHt, 72, si * 16, lane);
#pragma unroll
                        for (int r = 0; r < 4; ++r) { const int rw = ti * 16 + 4 * (lane >> 4) + r, cl = si * 16 + (lane & 15);
                            acc[i][r] += (p == 0) ? bf2f(RT[rw * 72 + cl]) : (p == 1) ? bf2f(Rk[rw * 72 + cl]) : (p == 2) ? ((rw == cl) ? WL[rw] : 0.f) : bf2f(KH[rw * 72 + cl]); } }
#pragma unroll
                    for (int i = 0; i < 8; ++i) { const int idx = 8 * (wave & 1) + i, ti = idx >> 2, si = idx & 3;
#pragma unroll
                        for (int r = 0; r < 4; ++r) { const int rw = ti * 16 + 4 * (lane >> 4) + r, cl = si * 16 + (lane & 15);
                            if (p == 0) SLOT(8)[rw * 64 + pi16(cl)] = (bf16_t)f2bf(acc[i][r]);
                            else if (p == 1) Attn[rw * 72 + cl] = (bf16_t)f2bf(acc[i][r]);
                            else if (p == 2) SLOT(9)[cl * 64 + pi16(rw)] = (bf16_t)f2bf(acc[i][r]);
                            else KEt[cl * 72 + rw] = (bf16_t)f2bf(acc[i][r]); } } };
                const int pw = wave >> 1;
                if (pw == 0) run5(IC<0>{}); else if (pw == 1) run5(IC<1>{}); else if (pw == 2) run5(IC<2>{}); else run5(IC<3>{}); }
            __syncthreads();
            {   LAS unsigned char* L = LB();
                *(u32x4*)((bf16_t*)(F.ws + WS_QE) + (size_t)(c * 8 + h) * 4096 + tid * 8) = *(const LAS u32x4*)(SLOT(8) + tid * 8);
                *(u32x4*)((bf16_t*)(F.ws + WS_TT) + (size_t)(c * 8 + h) * 4096 + tid * 8) = *(const LAS u32x4*)(SLOT(9) + tid * 8); }
            LAS unsigned char* L = LB();
#pragma unroll
            for (int i = 0; i < 4; ++i) { const int idx = 4 * wave + i, which = wave >> 2, ti = (idx >> 2) & 3, ci = idx & 3;
                const f32x4 acc = which ? mma_tile2<64, true, false>(VT, 72, ti * 16, KEt, 72, ci * 16, lane) : mma_tile2<64, false, true>(Attn, 72, ti * 16, VT, 72, ci * 16, lane);
#pragma unroll
                for (int r = 0; r < 4; ++r) { const int rw = ti * 16 + 4 * (lane >> 4) + r, cl = ci * 16 + (lane & 15);
                    const int o = which ? rw * 64 + sg32(cl) : cl * 64 + sg32(rw);
                    (which ? SLOT(3) : SLOT(2))[o] = (bf16_t)f2bf(acc[r]); } }
            __syncthreads();
            {   const int row = tid >> 3, c8 = tid & 7;
                *(u32x4*)((bf16_t*)(F.ws + WS_K) + (size_t)(m0 + row) * 512 + h * 64 + c8 * 8) = *(const LAS u32x4*)(SLOT(2) + tid * 8);
                *(u32x4*)((bf16_t*)(F.ws + WS_R) + (size_t)(m0 + row) * 512 + h * 64 + c8 * 8) = *(const LAS u32x4*)(SLOT(3) + tid * 8); }
        }
        __syncthreads();
    }
#undef SLOT
#undef PK8
#undef LB
#undef TW
#undef AL
#undef AT
#undef ATt
#undef BTl
#undef KTl
#undef RT
#undef BHt
#undef KH
#undef VT
#undef MI
#undef MakT
#undef Rb
#undef Rk
#undef Attn
#undef KEt
#undef X1t
#undef X2t
#undef S8
#undef S9
#undef MAB
#undef LWf
#undef ICf
#undef WL
#undef SCR
#undef PAR
}

__device__ __forceinline__ bf16x8 cvt8(const f32x16& x, int s) {
    u32x4 w; w.x = pk2(x[8 * s + 0], x[8 * s + 1]); w.y = pk2(x[8 * s + 2], x[8 * s + 3]); w.z = pk2(x[8 * s + 4], x[8 * s + 5]); w.w = pk2(x[8 * s + 6], x[8 * s + 7]);
    return __builtin_bit_cast(bf16x8, w);
}
__device__ __forceinline__ f32x16 ld16bf(const bf16_t* p) {
    const u32x4 a = *(const u32x4*)p, b = *(const u32x4*)(p + 8); f32x16 r;
    r[0] = bflo(a.x); r[1] = bfhi(a.x); r[2] = bflo(a.y); r[3] = bfhi(a.y); r[4] = bflo(a.z); r[5] = bfhi(a.z); r[6] = bflo(a.w); r[7] = bfhi(a.w);
    r[8] = bflo(b.x); r[9] = bfhi(b.x); r[10] = bflo(b.y); r[11] = bfhi(b.y); r[12] = bflo(b.z); r[13] = bfhi(b.z); r[14] = bflo(b.w); r[15] = bfhi(b.w); return r;
}
__device__ __forceinline__ void st16bf(bf16_t* p, const f32x16& x) {
    u32x4 a, b; a.x = pk2(x[0], x[1]); a.y = pk2(x[2], x[3]); a.z = pk2(x[4], x[5]); a.w = pk2(x[6], x[7]); b.x = pk2(x[8], x[9]); b.y = pk2(x[10], x[11]); b.z = pk2(x[12], x[13]); b.w = pk2(x[14], x[15]);
    *(u32x4*)p = a; *(u32x4*)(p + 8) = b;
}
__device__ __forceinline__ float max3f(float a, float b, float c) { float r; asm("v_max3_f32 %0, %1, %2, %3" : "=v"(r) : "v"(a), "v"(b), "v"(c)); return r; }
__device__ __forceinline__ int ktile_off(int row, int ch) { return 3072 * (row >> 3) + 512 * (ch >> 2) + 64 * (row & 7) + 16 * ((ch & 3) ^ ((row >> 2) & 3)); }
constexpr int KTILE = 24576;
template <int VAR> __device__ __forceinline__ void attn_unit(const Ctx& F, int b, int c, int hp) {
    const int tid = F.tid, lane = F.lane, wave = F.wave, r32 = lane & 31, hi = lane >> 5, grp = wave >> 2, wq = wave & 3, head = 2 * hp + (wq >> 1);
    const bf16_t* Q = (const bf16_t*)(F.ws + WS_Q); const bf16_t* KV = (const bf16_t*)(F.ws + WS_KVB) + (size_t)b * SEQ * 192; bf16_t* OL = (bf16_t*)(F.ws + WS_OL);
    const size_t mq = (size_t)b * SEQ + 64 * c + 32 * (wq & 1) + r32;
    bf16x8 qr[12];
#pragma unroll
    for (int d0 = 0; d0 < 12; ++d0) qr[d0] = *(const bf16x8*)(Q + mq * 768 + head * 192 + 16 * d0 + 8 * hi);
    {
        const float* rp = (const float*)(F.ws + WS_ROPE) + mq * 64;
#pragma unroll
        for (int d0 = 8; d0 < 10; ++d0) { const int j0 = 16 * (d0 - 8) + 8 * hi;
            const f32x4 c0 = *(const f32x4*)(rp + j0), c1 = *(const f32x4*)(rp + j0 + 4), s0 = *(const f32x4*)(rp + 32 + j0), s1 = *(const f32x4*)(rp + 32 + j0 + 4);
            const u32x4 a = __builtin_bit_cast(u32x4, qr[d0]), bq = __builtin_bit_cast(u32x4, qr[d0 + 2]);
            const float x1[8] = {bflo(a.x), bfhi(a.x), bflo(a.y), bfhi(a.y), bflo(a.z), bfhi(a.z), bflo(a.w), bfhi(a.w)}, x2[8] = {bflo(bq.x), bfhi(bq.x), bflo(bq.y), bfhi(bq.y), bflo(bq.z), bfhi(bq.z), bflo(bq.w), bfhi(bq.w)};
            const float cs[8] = {c0[0], c0[1], c0[2], c0[3], c1[0], c1[1], c1[2], c1[3]}, sn[8] = {s0[0], s0[1], s0[2], s0[3], s1[0], s1[1], s1[2], s1[3]};
            float o1[8], o2[8];
#pragma unroll
            for (int e = 0; e < 8; ++e) { o1[e] = x1[e] * cs[e] - x2[e] * sn[e]; o2[e] = x1[e] * sn[e] + x2[e] * cs[e]; }
            u32x4 w1, w2; w1.x = pk2(o1[0], o1[1]); w1.y = pk2(o1[2], o1[3]); w1.z = pk2(o1[4], o1[5]); w1.w = pk2(o1[6], o1[7]); w2.x = pk2(o2[0], o2[1]); w2.y = pk2(o2[2], o2[3]); w2.z = pk2(o2[4], o2[5]); w2.w = pk2(o2[6], o2[7]);
            qr[d0] = __builtin_bit_cast(bf16x8, w1); qr[d0 + 2] = __builtin_bit_cast(bf16x8, w2); }
    }
    int goff[6];
#pragma unroll
    for (int i = 0; i < 6; ++i) { const int j = 6 * wave + i, q = j % 24, pbyte = 1024 * q + 16 * lane, sub = pbyte >> 9, rg = sub / 6, cgp = sub % 6, r7 = (pbyte >> 6) & 7, slot = (pbyte >> 4) & 3;
        const int row = 8 * rg + r7, ch = 4 * cgp + (slot ^ ((row >> 2) & 3)); goff[i] = (row * 192 + ch * 8) * 2 + (j / 24) * 64 * 192 * 2; }
    const int nt = c + 1, ns = (VAR & 64) ? 0 : (nt + 1) >> 1;
    const unsigned ldsb = (unsigned)(uintptr_t)F.lds;
#define ATT_STAGE(s_, par_) do { if ((6 * wave) / 24 == 0 || 2 * (s_) + 1 < nt) { const char* src_ = (const char*)KV + (size_t)(2 * (s_)) * 64 * 192 * 2; \
        _Pragma("unroll") for (int i = 0; i < 6; ++i) { const int j_ = 6 * wave + i; \
            __builtin_amdgcn_global_load_lds((const unsigned*)(src_ + goff[i]), (LAS unsigned*)(F.lds + ((par_) * 2 + j_ / 24) * KTILE + (j_ % 24) * 1024), 16, 0, 0); } } } while (0)
    (void)ldsb;
    ATT_STAGE(0, 0);
    __syncthreads();
    f32x16 o[4];
#pragma unroll
    for (int d = 0; d < 4; ++d)
#pragma unroll
        for (int r = 0; r < 16; ++r) o[d][r] = 0.f;
    float mrun = -1e30f, lrun = 0.f;
    const int kx_ = (r32 >> 2) & 3, kbase = 3072 * (r32 >> 3) + 64 * (r32 & 7), koffE = kbase + 16 * (hi ^ kx_), koffO = kbase + 16 * ((2 + hi) ^ kx_);
    const int tq_ = (lane & 15) >> 2, tp_ = lane & 3, tgl_ = (lane >> 4) & 1, trb = 64 * (4 * hi + tq_) + 8 * (tp_ & 1);
    const int tro0 = trb + 16 * ((2 * tgl_ + (tp_ >> 1)) ^ (hi & 3)), tro1 = trb + 16 * ((2 * tgl_ + (tp_ >> 1)) ^ ((2 + hi) & 3)) + 3072;
    for (int s = 0; s < ns; ++s) {
        const bool more = (s + 1 < ns), more2 = (2 * s + 3 < nt);
        if (more && !(VAR & 1)) ATT_STAGE(s + 1, (s + 1) & 1);
        (void)more2;
        if (2 * s + grp < nt) {
            const LAS unsigned char* buf = F.lds + ((s & 1) * 2 + grp) * KTILE;
            f32x16 p0, p1, q0, q1;
#pragma unroll
            for (int r = 0; r < 16; ++r) { p0[r] = 0.f; p1[r] = 0.f; q0[r] = 0.f; q1[r] = 0.f; }
            bf16x8 ka[3][2];
            if (VAR & 32) {
#pragma unroll
                for (int q = 0; q < 3; ++q) { ka[q][0] = qr[q]; ka[q][1] = qr[q + 3]; } }
#define KLD(slot, d0) do { if (VAR & 32) { asm volatile("" : "+v"(ka[slot][0]), "+v"(ka[slot][1])); break; } ka[slot][0] = *(const LAS bf16x8*)(buf + (((d0) & 1) ? koffO : koffE) + 512 * ((d0) >> 1)); ka[slot][1] = *(const LAS bf16x8*)(buf + (((d0) & 1) ? koffO : koffE) + 12288 + 512 * ((d0) >> 1)); } while (0)
            KLD(0, 0); KLD(1, 1); KLD(2, 2);
#pragma unroll
            for (int d0 = 0; d0 < 12; ++d0) {
                __builtin_amdgcn_sched_barrier(0);
                if (VAR & 16) { if (d0 & 1) { q0 = __builtin_amdgcn_mfma_f32_32x32x16_bf16(ka[d0 % 3][0], qr[d0], q0, 0, 0, 0); q1 = __builtin_amdgcn_mfma_f32_32x32x16_bf16(ka[d0 % 3][1], qr[d0], q1, 0, 0, 0); } else { p0 = __builtin_amdgcn_mfma_f32_32x32x16_bf16(ka[d0 % 3][0], qr[d0], p0, 0, 0, 0); p1 = __builtin_amdgcn_mfma_f32_32x32x16_bf16(ka[d0 % 3][1], qr[d0], p1, 0, 0, 0); } }
                else if (!(VAR & 4)) { p0 = __builtin_amdgcn_mfma_f32_32x32x16_bf16(ka[d0 % 3][0], qr[d0], p0, 0, 0, 0); p1 = __builtin_amdgcn_mfma_f32_32x32x16_bf16(ka[d0 % 3][1], qr[d0], p1, 0, 0, 0); } else { asm volatile("" :: "v"(ka[d0 % 3][0]), "v"(ka[d0 % 3][1])); }
                __builtin_amdgcn_sched_barrier(0);
                if (d0 + 3 < 12) KLD(d0 % 3, d0 + 3);
            }
            __builtin_amdgcn_sched_barrier(0);
            if (VAR & 16) {
#pragma unroll
                for (int r = 0; r < 16; ++r) { p0[r] += q0[r]; p1[r] += q1[r]; } }
#undef KLD
            v4i16_t vl[2][4], vh[2][4];
#pragma unroll
            for (int db = 0; db < 4; ++db) { vl[0][db] = __builtin_amdgcn_ds_read_tr16_b64_v4i16((LAS v4i16_t*)(buf + tro0 + 512 * db)); vh[0][db] = __builtin_amdgcn_ds_read_tr16_b64_v4i16((LAS v4i16_t*)(buf + tro1 + 512 * db)); }
            float mx = max3f(p0[0], p1[0], p0[1]), my = max3f(p1[1], p0[2], p1[2]);
#pragma unroll
            for (int r = 3; r < 15; r += 2) { mx = max3f(mx, p0[r], p1[r]); my = max3f(my, p0[r + 1], p1[r + 1]); }
            mx = max3f(mx, my, fmaxf(p0[15], p1[15]));
            mx = fmaxf(mx, __shfl_xor(mx, 32));
            if (!(VAR & 8) && __any(mx > mrun + 8.f)) {
                const float mnew = fmaxf(mrun, mx), alpha = __builtin_amdgcn_exp2f(mrun - mnew); mrun = mnew; lrun *= alpha;
#pragma unroll
                for (int d = 0; d < 4; ++d)
#pragma unroll
                    for (int r = 0; r < 16; ++r) o[d][r] *= alpha;
            }
            float ls = 0.f;
#pragma unroll
            for (int r = 0; r < 16; ++r) { if (!(VAR & 8)) { p0[r] = __builtin_amdgcn_exp2f(p0[r] - mrun); p1[r] = __builtin_amdgcn_exp2f(p1[r] - mrun); } ls += p0[r] + p1[r]; }
            lrun += ls;
#pragma unroll
            for (int ks = 0; ks < 4; ++ks) {
                if (ks + 1 < 4) {
#pragma unroll
                    for (int db = 0; db < 4; ++db) {
                        vl[(ks + 1) & 1][db] = __builtin_amdgcn_ds_read_tr16_b64_v4i16((LAS v4i16_t*)(buf + tro0 + 6144 * (ks + 1) + 512 * db)); vh[(ks + 1) & 1][db] = __builtin_amdgcn_ds_read_tr16_b64_v4i16((LAS v4i16_t*)(buf + tro1 + 6144 * (ks + 1) + 512 * db)); }
                }
                const bf16x8 pb = (ks < 2) ? cvt8(p0, ks & 1) : cvt8(p1, ks & 1);
#pragma unroll
                for (int db = 0; db < 4; ++db) { const v4i16_t lo = vl[ks & 1][db], hh = vh[ks & 1][db];
                    const bf16x8 va = {lo[0], lo[1], lo[2], lo[3], hh[0], hh[1], hh[2], hh[3]};
                    if (!(VAR & 2)) o[db] = __builtin_amdgcn_mfma_f32_32x32x16_bf16(va, pb, o[db], 0, 0, 0); else asm volatile("" :: "v"(va), "v"(pb)); }
            }
        }
        __syncthreads();
    }
#undef ATT_STAGE
    lrun += __shfl_xor(lrun, 32);
    LAS float* xb = (LAS float*)(F.lds + wq * (66 * 64 * 4));
    if (grp == 1) {
#pragma unroll
        for (int d = 0; d < 4; ++d)
#pragma unroll
            for (int r = 0; r < 16; ++r) xb[(d * 16 + r) * 64 + lane] = o[d][r];
        xb[64 * 64 + lane] = mrun; xb[65 * 64 + lane] = lrun;
    }
    __syncthreads();
    if (grp == 0) {
        const float m2 = xb[64 * 64 + lane], l2 = xb[65 * 64 + lane];
        const float mm = fmaxf(mrun, m2), a1 = __builtin_amdgcn_exp2f(mrun - mm), a2 = __builtin_amdgcn_exp2f(m2 - mm);
        const float inv = 1.f / (lrun * a1 + l2 * a2), f1 = a1 * inv, f2 = a2 * inv;
#pragma unroll
        for (int db = 0; db < 4; ++db)
#pragma unroll
            for (int g = 0; g < 4; ++g) { float v[4];
#pragma unroll
                for (int e = 0; e < 4; ++e) v[e] = o[db][4 * g + e] * f1 + xb[(db * 16 + 4 * g + e) * 64 + lane] * f2;
                u32x2 w; w.x = pk2(v[0], v[1]); w.y = pk2(v[2], v[3]);
                *(u32x2*)(OL + mq * 512 + head * 128 + 32 * db + 8 * g + 4 * hi) = w; }
    }
    __syncthreads();
}
struct RwSet { bf16x8 ta[2][4]; u32x4 d[4]; };
__device__ __forceinline__ void rw_load(RwSet& s, const bf16_t* TTg, const bf16_t* Rg, int cg_, int h, int i, int r32, int hi) {
    const bf16_t* TTw = TTg + (size_t)(cg_ * 8 + h) * 4096; const bf16_t* Dw = Rg + ((size_t)64 * cg_ + i) * 512 + h * 64;
#pragma unroll
    for (int a = 0; a < 2; ++a)
#pragma unroll
        for (int s2 = 0; s2 < 4; ++s2) s.ta[a][s2] = *(const bf16x8*)(TTw + (32 * a + r32) * 64 + 16 * s2 + 8 * hi);
    s.d[0] = *(const u32x4*)(Dw + 16 * hi); s.d[1] = *(const u32x4*)(Dw + 16 * hi + 8); s.d[2] = *(const u32x4*)(Dw + 32 + 16 * hi); s.d[3] = *(const u32x4*)(Dw + 32 + 16 * hi + 8);
}
__device__ __forceinline__ f32x16 up16(const u32x4 a, const u32x4 b) { f32x16 r;
    r[0] = bflo(a.x); r[1] = bfhi(a.x); r[2] = bflo(a.y); r[3] = bfhi(a.y); r[4] = bflo(a.z); r[5] = bfhi(a.z); r[6] = bflo(a.w); r[7] = bfhi(a.w);
    r[8] = bflo(b.x); r[9] = bfhi(b.x); r[10] = bflo(b.y); r[11] = bfhi(b.y); r[12] = bflo(b.z); r[13] = bfhi(b.z); r[14] = bflo(b.w); r[15] = bfhi(b.w); return r; }
__device__ __forceinline__ void rw_step(f32x16& X0, f32x16& X1, const RwSet& s, bf16_t* Rg, int cg_, int h, int i, int hi, bool live) {
    const bf16x8 bf[4] = {cvt8(X0, 0), cvt8(X0, 1), cvt8(X1, 0), cvt8(X1, 1)};
    if (live) { bf16_t* Dw = Rg + ((size_t)64 * cg_ + i) * 512 + h * 64;
        *(bf16x8*)(Dw + 16 * hi) = bf[0]; *(bf16x8*)(Dw + 16 * hi + 8) = bf[1]; *(bf16x8*)(Dw + 32 + 16 * hi) = bf[2]; *(bf16x8*)(Dw + 32 + 16 * hi + 8) = bf[3]; }
    f32x16 n0 = up16(s.d[0], s.d[1]), n1 = up16(s.d[2], s.d[3]);
#pragma unroll
    for (int s2 = 0; s2 < 4; ++s2) { n0 = __builtin_amdgcn_mfma_f32_32x32x16_bf16(s.ta[0][s2], bf[s2], n0, 0, 0, 0); n1 = __builtin_amdgcn_mfma_f32_32x32x16_bf16(s.ta[1][s2], bf[s2], n1, 0, 0, 0); }
    X0 = n0; X1 = n1;
}
__device__ __forceinline__ void rwkv_scan(const Ctx& F, int b, int h, int half) {
    const int lane = F.lane, r32 = lane & 31, hi = lane >> 5, i = 32 * half + r32;
    const bf16_t* TTg = (const bf16_t*)(F.ws + WS_TT); bf16_t* Rg = (bf16_t*)(F.ws + WS_R);
    f32x16 X0, X1;
#pragma unroll
    for (int r = 0; r < 16; ++r) { X0[r] = 0.f; X1[r] = 0.f; }
    RwSet sA, sB, sC; const int c0 = b * 128;
    rw_load(sA, TTg, Rg, c0 + 0, h, i, r32, hi); rw_load(sB, TTg, Rg, c0 + 1, h, i, r32, hi); rw_load(sC, TTg, Rg, c0 + 2, h, i, r32, hi);
    for (int c = 0; c < 129; c += 3) {
        rw_step(X0, X1, sA, Rg, c0 + c, h, i, hi, true);          rw_load(sA, TTg, Rg, c0 + min(c + 3, 127), h, i, r32, hi);
        rw_step(X0, X1, sB, Rg, c0 + c + 1, h, i, hi, true);      rw_load(sB, TTg, Rg, c0 + min(c + 4, 127), h, i, r32, hi);
        rw_step(X0, X1, sC, Rg, c0 + min(c + 2, 127), h, i, hi, c + 2 < 128); rw_load(sC, TTg, Rg, c0 + min(c + 5, 127), h, i, r32, hi);
    }
}
__device__ __forceinline__ void ssd_scan(const Ctx& F, int item) {
    const int b = item >> 4, h = (item >> 1) & 7, hp = item & 1, g = h >> 2, hl = h & 3;
    const int piece = hp * 512 + F.tid;
    const int f = hl * 8192 + piece * 8, row = f >> 9, col = ssd_win_col(g, f & 511);
    bf16_t* ST = (bf16_t*)(F.ws + WS_XBC); const float* CDEC = (const float*)(F.ws + WS_CDEC);
    float st[8];
#pragma unroll
    for (int j = 0; j < 8; ++j) st[j] = 0.f;
    for (int c8 = 0; c8 < 128; c8 += 8) {
        u32x4 v[8]; float cd[8];
#pragma unroll
        for (int u = 0; u < 8; ++u) { const int cg_ = b * 128 + c8 + u; v[u] = *(const u32x4*)(ST + ((size_t)64 * cg_ + row) * 1024 + col); cd[u] = CDEC[cg_ * 8 + h]; }
#pragma unroll
        for (int u = 0; u < 8; ++u) { const int cg_ = b * 128 + c8 + u;
            u32x4 o; o.x = pk2(st[0], st[1]); o.y = pk2(st[2], st[3]); o.z = pk2(st[4], st[5]); o.w = pk2(st[6], st[7]);
            *(u32x4*)(ST + ((size_t)64 * cg_ + row) * 1024 + col) = o;
            const float x[8] = {bflo(v[u].x), bfhi(v[u].x), bflo(v[u].y), bfhi(v[u].y), bflo(v[u].z), bfhi(v[u].z), bflo(v[u].w), bfhi(v[u].w)};
#pragma unroll
            for (int j = 0; j < 8; ++j) st[j] = st[j] * cd[u] + x[j]; }
    }
}
constexpr size_t CTL_QUEUE = 32768;
template <int VAR = 0> __device__ __forceinline__ void p4_mix(const Ctx& F, int qslot, int what = 3) {
    const int x = F.bid & 7, li = F.bid >> 3;
    if ((what & 2) && li < 8) { const int st = li * 8 + x;
        if (st < 32) { if (!(what & 8) && F.wave == 0) rwkv_scan(F, st >> 4, (st >> 1) & 7, st & 1); }
        else if (!(what & 4)) ssd_scan(F, st - 32); }
    if (what & 1) {
        unsigned* ctr = (unsigned*)(F.ws + WS_CTL + CTL_QUEUE) + (qslot * 8 + x) * 64;
        volatile LAS int* qw = (volatile LAS int*)(F.lds + LDS_BYTES - 128);
        for (;;) {
            if (F.tid == 0) *qw = (int)__hip_atomic_fetch_add(ctr, 1u, __ATOMIC_RELAXED, __HIP_MEMORY_SCOPE_AGENT);
            __syncthreads();
            const int k = *qw;
            __syncthreads();
            if (k >= 64) break;
            const int rb = 4 * k + (x >> 1), c = 127 - (rb >> 1), hp = rb & 1, b = x & 1;
            attn_unit<VAR>(F, b, c, hp);
        }
    }
}
template <int VAR = 0> __device__ __forceinline__ void p5_assemble(const Ctx& F, int l) {
    bf16_t* GT = (bf16_t*)(F.ws + WS_GATES);
    if (!(VAR & 1)) {   pg8::Gemm g{(const bf16_t*)(F.ws + WS_OL), (const bf16_t*)(F.ws + WS_WUV), NT, 512, 256, 512, 512, 256};     pg8::StaticOrder S; S.init(NT, 512, F.G, F.bid); EpiUV E{GT};
        pg8::gemm_phase<EpiUV, pg8::StaticOrder, true, true>(F.lds, F.wave, g, S, E); }
    __syncthreads();
    int lane = fresh_lane(); const int tid = F.wave * 64 + lane, wave = F.wave;
    const int gw = F.bid * NWAVES + F.wave, NGW = F.G * NWAVES;
    {   constexpr int O_CC = 0, O_YO = 33792;
        const bf16_t* Cbuf = (const bf16_t*)(F.ws + WS_CB); const float* ECUM = (const float*)(F.ws + WS_ECUM); const bf16_t* ST = (const bf16_t*)(F.ws + WS_XBC); const bf16_t* YD = (const bf16_t*)(F.ws + WS_YD);
        const float* snw = INP(I_SSDNW) + l * 512;
        for (int c = F.bid; c < ((VAR & 2) ? 0 : NCHK); c += F.G) {
            const size_t m0 = (size_t)64 * c; const int h = wave, g = h >> 2, hl = h & 3;
            bf16x8 pf[4][4];
#pragma unroll
            for (int pi = 0; pi < 4; ++pi)
#pragma unroll
                for (int ks = 0; ks < 4; ++ks) { const int f = hl * 8192 + (16 * pi + (lane & 15)) * 128 + 32 * ks + 8 * (lane >> 4), row = f >> 9, col = ssd_win_col(g, f & 511);
                    pf[pi][ks] = *(const bf16x8*)(ST + (m0 + row) * 1024 + col); }
            {   LAS bf16_t* CC = (LAS bf16_t*)(F.lds + O_CC);
#pragma unroll
                for (int i = 0; i < 4; ++i) { const int idx = tid + 512 * i, t = idx >> 5, c8 = idx & 31; *(LAS u32x4*)(CC + t * 264 + c8 * 8) = *(const u32x4*)(Cbuf + (m0 + t) * 256 + c8 * 8); } }
            __syncthreads();
            {   const LAS bf16_t* CC = (const LAS bf16_t*)(F.lds + O_CC) + g * 128; LAS bf16_t* YO = (LAS bf16_t*)(F.lds + O_YO);
#pragma unroll
                for (int ti = 0; ti < 4; ++ti) {
                    bf16x8 af[4];
#pragma unroll
                    for (int ks = 0; ks < 4; ++ks) af[ks] = *(const LAS bf16x8*)(CC + (16 * ti + (lane & 15)) * 264 + 32 * ks + 8 * (lane >> 4));
                    float ec[4];
#pragma unroll
                    for (int r = 0; r < 4; ++r) ec[r] = ECUM[(size_t)(c * 8 + h) * 64 + 16 * ti + 4 * (lane >> 4) + r];
#pragma unroll
                    for (int pi = 0; pi < 4; ++pi) { f32x4 acc = {0.f, 0.f, 0.f, 0.f};
#pragma unroll
                        for (int ks = 0; ks < 4; ++ks) acc = __builtin_amdgcn_mfma_f32_16x16x32_bf16(af[ks], pf[pi][ks], acc, 0, 0, 0);
#pragma unroll
                        for (int r = 0; r < 4; ++r) YO[(16 * ti + 4 * (lane >> 4) + r) * 520 + 64 * h + 16 * pi + (lane & 15)] = (bf16_t)f2bf(acc[r] * ec[r]); }
                }
            }
            __syncthreads();
            {   const LAS bf16_t* YO = (const LAS bf16_t*)(F.lds + O_YO);
                u32x4 ydv[8], zv[8];
#pragma unroll
                for (int rr = 0; rr < 8; ++rr) { const int t = 8 * wave + rr; ydv[rr] = *(const u32x4*)(YD + (m0 + t) * 512 + 8 * lane); zv[rr] = *(const u32x4*)(GT + (m0 + t) * 1536 + 512 + 8 * lane); }
                const f32x4 w0 = *(const f32x4*)(snw + 8 * lane), w1 = *(const f32x4*)(snw + 8 * lane + 4);
#pragma unroll
                for (int rr = 0; rr < 8; ++rr) { const int t = 8 * wave + rr; const u32x4 w = *(const LAS u32x4*)(YO + t * 520 + 8 * lane);
                    const unsigned wa[4] = {w.x, w.y, w.z, w.w}, ya[4] = {ydv[rr].x, ydv[rr].y, ydv[rr].z, ydv[rr].w}, za[4] = {zv[rr].x, zv[rr].y, zv[rr].z, zv[rr].w};
                    float v[8]; float q = 0.f;
#pragma unroll
                    for (int j = 0; j < 8; ++j) { const int k2 = j >> 1; const float yo = (j & 1) ? bfhi(wa[k2]) : bflo(wa[k2]), yd = (j & 1) ? bfhi(ya[k2]) : bflo(ya[k2]), zz = (j & 1) ? bfhi(za[k2]) : bflo(za[k2]);
                        v[j] = (yd + yo) * siluf_(zz); q += v[j] * v[j]; }
                    const float rs = __builtin_amdgcn_rsqf(wave_sum(q) * (1.f / 512.f) + EPS);
                    u32x4 o; o.x = pk2(v[0] * rs * w0[0], v[1] * rs * w0[1]); o.y = pk2(v[2] * rs * w0[2], v[3] * rs * w0[3]); o.z = pk2(v[4] * rs * w1[0], v[5] * rs * w1[1]); o.w = pk2(v[6] * rs * w1[2], v[7] * rs * w1[3]);
                    *(u32x4*)(GT + (m0 + t) * 1536 + 512 + 8 * lane) = o; } }
            __syncthreads();
        }
    }
    LAS float* SW = (LAS float*)(F.lds + F.wave * 16640);
    const bf16_t* Yt = (const bf16_t*)(F.ws + WS_K); const bf16_t* SF = (const bf16_t*)(F.ws + WS_R); const bf16_t* QEg = (const bf16_t*)(F.ws + WS_QE);
    const bf16_t* BON = (const bf16_t*)(F.ws + WS_V); const float* lw = INP(I_LNXW) + l * 512; const float* lb = INP(I_LNXB) + l * 512;
    for (int w = gw; w < ((VAR & 4) ? 0 : NCHK * 8); w += NGW) {
        asm volatile("" : "+v"(lane));
        const int cg_ = w >> 3, h = w & 7, r32 = lane & 31, hi = lane >> 5; const size_t m0 = (size_t)64 * cg_;
        const bf16_t* QEw = QEg + (size_t)(cg_ * 8 + h) * 4096;
        bf16x8 qa[2][4];
#pragma unroll
        for (int tb = 0; tb < 2; ++tb)
#pragma unroll
            for (int s2 = 0; s2 < 4; ++s2) qa[tb][s2] = *(const bf16x8*)(QEw + (32 * tb + r32) * 64 + 16 * s2 + 8 * hi);
#pragma unroll
        for (int ih = 0; ih < 2; ++ih) { const size_t ro = (m0 + 32 * ih + r32) * 512 + h * 64;
            const bf16x8 bf[4] = {*(const bf16x8*)(SF + ro + 16 * hi), *(const bf16x8*)(SF + ro + 16 * hi + 8), *(const bf16x8*)(SF + ro + 32 + 16 * hi), *(const bf16x8*)(SF + ro + 32 + 16 * hi + 8)};
#pragma unroll
            for (int tb = 0; tb < 2; ++tb) { f32x16 y = ld16bf(Yt + ro + 32 * tb + 16 * hi);
#pragma unroll
                for (int s2 = 0; s2 < 4; ++s2) y = __builtin_amdgcn_mfma_f32_32x32x16_bf16(qa[tb][s2], bf[s2], y, 0, 0, 0);
#pragma unroll
                for (int r = 0; r < 16; ++r) SW[(32 * tb + crow(r, hi)) * 65 + 32 * ih + r32] = y[r]; } }
        LDS_WAIT();
        {   float y[64]; float sm = 0.f;
#pragma unroll
            for (int i = 0; i < 64; ++i) { y[i] = SW[lane * 65 + i]; sm += y[i]; }
            const float mean = sm * (1.f / 64.f); float q = 0.f;
#pragma unroll
            for (int i = 0; i < 64; ++i) { y[i] -= mean; q += y[i] * y[i]; }
            const float rs = 1.f / sqrtf(q * (1.f / 64.f) + GN_EPS);
#pragma unroll
            for (int i = 0; i < 64; ++i) SW[lane * 65 + i] = y[i] * rs; }
        LDS_WAIT();
        u32x4 bwv[8], gvv[8];
#pragma unroll
        for (int it = 0; it < 8; ++it) { const int t = it * 8 + (lane >> 3), i0 = (lane & 7) * 8; const size_t row = m0 + t;
            bwv[it] = *(const u32x4*)(BON + row * 512 + h * 64 + i0); gvv[it] = *(const u32x4*)(GT + row * 1536 + 1024 + h * 64 + i0); }
#pragma unroll
        for (int it = 0; it < 8; ++it) { const int t = it * 8 + (lane >> 3), i0 = (lane & 7) * 8; const size_t row = m0 + t;
            const u32x4 bw = bwv[it]; u32x4* gp = (u32x4*)(GT + row * 1536 + 1024 + h * 64 + i0); const u32x4 gv = gvv[it];
            const float bo[8] = {bflo(bw.x), bfhi(bw.x), bflo(bw.y), bfhi(bw.y), bflo(bw.z), bfhi(bw.z), bflo(bw.w), bfhi(bw.w)};
            const float gg[8] = {bflo(gv.x), bfhi(gv.x), bflo(gv.y), bfhi(gv.y), bflo(gv.z), bfhi(gv.z), bflo(gv.w), bfhi(gv.w)};
            float ov[8];
#pragma unroll
            for (int j = 0; j < 8; ++j) ov[j] = (SW[t * 65 + i0 + j] * lw[h * 64 + i0 + j] + lb[h * 64 + i0 + j] + bo[j]) * siluf_(gg[j]);
            u32x4 o; o.x = pk2(ov[0], ov[1]); o.y = pk2(ov[2], ov[3]); o.z = pk2(ov[4], ov[5]); o.w = pk2(ov[6], ov[7]); *gp = o; }
        LDS_WAIT();
    }
}
__device__ __forceinline__ void p7_final(const Ctx& F) {
    const int gw = F.bid * NWAVES + F.wave, NGW = F.G * NWAVES; const float* fw = INP(I_FNW);
    for (int m = gw; m < NT; m += NGW) {
        f32x4* xr = (f32x4*)(F.out + (size_t)m * DM) + F.lane; f32x4 v[4]; float s = 0.f;
#pragma unroll
        for (int j = 0; j < 4; ++j) { v[j] = xr[64 * j]; s += v[j].x * v[j].x + v[j].y * v[j].y + v[j].z * v[j].z + v[j].w * v[j].w; }
        const float rstd = 1.f / sqrtf(wave_sum(s) * (1.f / DM) + EPS);
#pragma unroll
        for (int j = 0; j < 4; ++j) xr[64 * j] = v[j] * rstd * *(const f32x4*)(fw + 4 * F.lane + 256 * j);
    }
}

#define RLX_AGENT __ATOMIC_RELAXED, __HIP_MEMORY_SCOPE_AGENT
#define XB_TMO      128
#define XB_XCNT(j)  (256  + 64 * (j))
#define XB_XSUB(j)  (1280 + 64 * (j))
#define XB_XGEN(j)  (2304 + 64 * (j))
#define XB_TOP      3328
#define XB_TOPGEN   3392
#define XCD_BAR_WORDS 3456
#define XB_SPIN_CAP (1u << 18)

__device__ __forceinline__ unsigned xb_ld(unsigned* p)              { return __hip_atomic_load(p, __ATOMIC_RELAXED, __HIP_MEMORY_SCOPE_AGENT); }
__device__ __forceinline__ unsigned xb_add(unsigned* p, unsigned v) { return __hip_atomic_fetch_add(p, v, __ATOMIC_RELAXED, __HIP_MEMORY_SCOPE_AGENT); }
__device__ __forceinline__ unsigned xb_xcc_id() { return (unsigned)__builtin_amdgcn_s_getreg((3 << 11) | 20) & 0xFu; }
#define XB_SPIN(cond, bar) do { unsigned _sp = 0; while (cond) { __builtin_amdgcn_s_sleep(1); \
    if ((++_sp & 255u) == 0u) { if (xb_ld(&(bar)[XB_TMO])) break; if (_sp > XB_SPIN_CAP) { atomicAdd(&(bar)[XB_TMO], 1u); break; } } } } while (0)

struct XcdBarrier {
    unsigned* bar; unsigned x;
    volatile LAS unsigned* st;
};

__device__ __forceinline__ XcdBarrier xcd_barrier_post(unsigned* bar, volatile LAS unsigned* st) {
    XcdBarrier b; b.bar = bar; b.x = xb_xcc_id(); b.st = st;
    if (threadIdx.x == 0) (void)xb_add(&bar[XB_XCNT(b.x)], 1u);
    return b;
}
__device__ __forceinline__ void xcd_barrier_complete(unsigned* bar, unsigned x, unsigned& nloc, unsigned& nx) {
    const unsigned G = gridDim.x * gridDim.y * gridDim.z;
    unsigned sum, cnt, mine, sp = 0u;
    for (;;) {
        sum = 0u; cnt = 0u; mine = 0u;
#pragma unroll
        for (unsigned j = 0; j < 16; ++j) { const unsigned c = xb_ld(&bar[XB_XCNT(j)]); sum += c; cnt += (c > 0u) ? 1u : 0u; mine = (j == x) ? c : mine; }
        if (sum == G) break;
        __builtin_amdgcn_s_sleep(1);
        if ((++sp & 255u) == 0u) { if (xb_ld(&bar[XB_TMO])) break; if (sp > XB_SPIN_CAP) { atomicAdd(&bar[XB_TMO], 1u); break; } }
    }
    nloc = mine > 0u ? mine : 1u; nx = cnt > 0u ? cnt : 1u;
}

__device__ __forceinline__ void xcd_barrier(const XcdBarrier& b) {
    asm volatile("s_waitcnt vmcnt(0)" ::: "memory");
    __syncthreads();
    if (threadIdx.x == 0) {
        unsigned* bar = b.bar;
        __builtin_amdgcn_s_waitcnt(0);
        unsigned nloc = b.st[0], nx = b.st[1];
        if (nloc == 0u) { xcd_barrier_complete(bar, b.x, nloc, nx); b.st[0] = nloc; b.st[1] = nx; }
        const unsigned old = xb_add(&bar[XB_XSUB(b.x)], 1u);
        const unsigned gen = old / nloc;
        if (old + 1u == (gen + 1u) * nloc) {
            __builtin_amdgcn_fence(__ATOMIC_RELEASE, "agent");
            asm volatile("s_waitcnt vmcnt(0)" ::: "memory");
            const unsigned og = xb_add(&bar[XB_TOP], 1u);
            const unsigned tg = og / nx;
            if (og + 1u == (tg + 1u) * nx) xb_add(&bar[XB_TOPGEN], 1u);
            else XB_SPIN(xb_ld(&bar[XB_TOPGEN]) == tg, bar);
            __builtin_amdgcn_fence(__ATOMIC_ACQUIRE, "agent");
            xb_add(&bar[XB_XGEN(b.x)], 1u);
            asm volatile("s_waitcnt vmcnt(0)" ::: "memory");
        } else {
            XB_SPIN(xb_ld(&bar[XB_XGEN(b.x)]) == gen, bar);
            __builtin_amdgcn_fence(__ATOMIC_ACQUIRE, "agent");
            asm volatile("s_waitcnt vmcnt(0)" ::: "memory");
        }
    }
    __syncthreads();
}


#define LAYER(l) do { \
        const int pb = 1 + 8 * l; \
        if (IN(pb + 0)) { PHB(); prep_weights(F, l); if (l == 0) { p0_rope(F); p1_norm(F, l); } SEAM(pb + 0); }     \
        if (IN(pb + 1)) { PHB(); \
            pg8::Gemm g{(const bf16_t*)(F.ws + WS_XN), (const bf16_t*)(F.ws + WS_WIN), NT, NIN, DM, DM, DM}; pg8::StaticOrder S; S.init(NT, NIN, F.G, F.bid); \
            EpiIn E{F.ws, l}; \
            pg8::gemm_phase<EpiIn, pg8::StaticOrder, true, true>(F.lds, F.wave, g, S, E); \
            SEAM(pb + 1); \
        } \
        if (IN(pb + 2)) { PHB(); \
            pg8::Gemm g{(const bf16_t*)(F.ws + WS_QLAT), (const bf16_t*)(F.ws + WS_WQ), NT, 768, 256, 256, 256}; pg8::StaticOrder S; S.init(NT, 768, F.G, F.bid); \
            EpiQ E{F.ws, l}; \
            pg8::gemm_phase<EpiQ, pg8::StaticOrder, true, true>(F.lds, F.wave, g, S, E); \
            p3a_extras(F, l); \
        } \
        if (IN(pb + 3)) { PHB(); p3b_ssd(F, l); __syncthreads(); } \
        if (IN(pb + 4)) { PHB(); p3c_rwkv(F, l); SEAM(pb + 4); } \
        if (IN(pb + 5)) { PHB(); p4_mix(F, l); SEAM(pb + 5); } \
        if (IN(pb + 6)) { PHB(); p5_assemble(F, l); SEAM(pb + 6); } \
        if (IN(pb + 7)) { PHB(); \
            pg8::Gemm g{(const bf16_t*)(F.ws + WS_GATES), (const bf16_t*)(F.ws + WS_WOUT), NT, DM, 1536, 1536, 1536}; pg8::StaticOrder S; S.init(NT, DM, F.G, F.bid); \
            EpiOutNorm E{(l == 0) ? INP(I_X) : F.out, F.out, (const float*)(F.ws + WS_CTL + CTL_MOD) + (size_t)(l * 2) * 3072 + 2048, F.ws, (l == 0) ? INP(I_NORMW) + DM : INP(I_FNW), (const float*)(F.ws + WS_CTL + CTL_MOD) + (size_t)2 * 3072, l, l}; \
            pg8::gemm_phase<EpiOutNorm, pg8::StaticOrder, false, true>(F.lds, F.wave, g, S, E); \
            if (l == 0) SEAM(pb + 7); \
        } \
    } while (0)
__global__ void __launch_bounds__(NTHR, 2) mk_fwd(Args args) {
    extern __shared__ __attribute__((aligned(16))) unsigned char lds_raw[];
    Ctx F; F.lds = (LAS unsigned char*)lds_raw; F.tid = threadIdx.x; F.lane = F.tid & 63; F.wave = __builtin_amdgcn_readfirstlane(F.tid >> 6);
    F.G = gridDim.x; F.bid = blockIdx.x; F.ws = args.ws; F.out = args.out; F.in = args.in;
    const int wave0 = F.wave;
    cg::grid_group grid = cg::this_grid();
    volatile LAS unsigned* xst = (volatile LAS unsigned*)(F.lds + LDS_BYTES - 256);
    if (threadIdx.x < 2) xst[threadIdx.x] = 0u;
    __syncthreads();
    const XcdBarrier xbar = xcd_barrier_post((unsigned*)(args.ws + WS_CTL) + 4096, xst);
#if MK_PER_PHASE
    const int lo = args.ph_lo, hi = args.ph_hi;
#else
    constexpr int lo = 0, hi = 18;
#endif
#ifndef MK_ONLY
#define MK_ONLY -1
#endif
#define IN(k) (lo <= (k) && (k) < hi && (MK_ONLY < 0 || MK_ONLY == ((k) == 0 ? 0 : (k) == 17 ? 17 : 1 + ((k) - 1) % 8)))
#if MK_PER_PHASE
#define SEAM(k) do { } while (0)
#else
#define SEAM(k) do { xcd_barrier(xbar); } while (0)
#endif
#define PHB() do { int b_ = blockIdx.x, g_ = gridDim.x, v_ = wave0; asm volatile("" : "+s"(b_), "+s"(g_), "+s"(v_)); F.bid = b_; F.G = g_; F.wave = v_; int t_ = v_ * 64 + (int)__builtin_amdgcn_mbcnt_hi(~0u, __builtin_amdgcn_mbcnt_lo(~0u, 0u)); asm volatile("; PHASE_MARK %0" : "+v"(t_)); F.tid = t_; F.lane = t_ & 63; unsigned wl_ = __builtin_amdgcn_readfirstlane((unsigned)(uintptr_t)args.ws), wh_ = __builtin_amdgcn_readfirstlane((unsigned)((uintptr_t)args.ws >> 32)), ol_ = __builtin_amdgcn_readfirstlane((unsigned)(uintptr_t)args.out), oh_ = __builtin_amdgcn_readfirstlane((unsigned)((uintptr_t)args.out >> 32)); asm volatile("" : "+s"(wl_), "+s"(wh_), "+s"(ol_), "+s"(oh_)); F.ws = (unsigned char*)(GAS unsigned char*)(((uintptr_t)wh_ << 32) | wl_); F.out = (float*)(GAS float*)(((uintptr_t)oh_ << 32) | ol_); } while (0)
    if (IN(0)) { PHB(); p0_mod(F); SEAM(0); }
    LAYER(0);
    LAYER(1);
#ifndef MK_RERUN
#define MK_RERUN 0
#endif
#define PHB2() do { int b_ = blockIdx.x, g_ = gridDim.x, v_ = wave0; asm volatile("" : "+s"(b_), "+s"(g_), "+s"(v_)); F.bid = b_; F.G = g_; F.wave = v_; int t_ = v_ * 64 + fresh_lane(); F.tid = t_; F.lane = t_ & 63; } while (0)
#if MK_RERUN
    { constexpr int l = 1;
    if (MK_RERUN & 1) { xcd_barrier(xbar); PHB2(); p1_norm(F, l); }
    if (MK_RERUN & 8192) { xcd_barrier(xbar); PHB2(); prep_weights(F, 1); }
    if (MK_RERUN & 2) { xcd_barrier(xbar); PHB2(); pg8::Gemm g{(const bf16_t*)(F.ws + WS_XN), (const bf16_t*)(F.ws + WS_WIN), NT, NIN, DM, DM, DM}; pg8::StaticOrder S; S.init(NT, NIN, F.G, F.bid); EpiIn E{F.ws, l}; pg8::gemm_phase<EpiIn, pg8::StaticOrder, true, true>(F.lds, F.wave, g, S, E); }
    if (MK_RERUN & 4) { xcd_barrier(xbar); PHB2(); pg8::Gemm g{(const bf16_t*)(F.ws + WS_QLAT), (const bf16_t*)(F.ws + WS_WQ), NT, 768, 256, 256, 256}; pg8::StaticOrder S; S.init(NT, 768, F.G, F.bid); EpiQ E{F.ws, l}; pg8::gemm_phase<EpiQ, pg8::StaticOrder, true, true>(F.lds, F.wave, g, S, E); p3a_extras(F, l); }
    if (MK_RERUN & 8) { xcd_barrier(xbar); PHB2(); p3b_ssd<MK_AVAR>(F, l); }
    if (MK_RERUN & 16) { xcd_barrier(xbar); PHB2(); p3c_rwkv<MK_AVAR>(F, l); }
    if (MK_RERUN & 32) { xcd_barrier(xbar); PHB2(); p4_mix(F, 2); }
#ifndef MK_AVAR
#define MK_AVAR 0
#endif
    if (MK_RERUN & 512) { xcd_barrier(xbar); PHB2(); p4_mix<MK_AVAR>(F, 2, 1); }
    if (MK_RERUN & 1024) { xcd_barrier(xbar); PHB2(); p4_mix(F, 2, 2); }
    if (MK_RERUN & 2048) { xcd_barrier(xbar); PHB2(); p4_mix(F, 2, 2 | 4); }
    if (MK_RERUN & 4096) { xcd_barrier(xbar); PHB2(); p4_mix(F, 2, 2 | 8); }
    if (MK_RERUN & 64) { xcd_barrier(xbar); PHB2(); p5_assemble<MK_AVAR>(F, l); }
    if (MK_RERUN & 128) { xcd_barrier(xbar); PHB2(); pg8::Gemm g{(const bf16_t*)(F.ws + WS_GATES), (const bf16_t*)(F.ws + WS_WOUT), NT, DM, 1536, 1536, 1536}; pg8::StaticOrder S; S.init(NT, DM, F.G, F.bid);
        EpiOut E{INP(I_X), (float*)(F.ws + WS_XBC), (const float*)(F.ws + WS_CTL + CTL_MOD) + (size_t)(l * 2) * 3072 + 2048}; pg8::gemm_phase<EpiOut, pg8::StaticOrder, true, true>(F.lds, F.wave, g, S, E); }
    }
#endif
#undef IN
#undef SEAM
}
constexpr int N_PHASES = 18;

extern "C" void kernel_launch(void* const* d_in, const int* in_sizes, int n_in, void* d_out, int out_size, void* d_ws, size_t ws_size, hipStream_t stream) {
    static int grid = 0;
    if (grid == 0) {
        if (n_in != 31 || out_size != NT * DM || ws_size < WS_END) { fprintf(stderr, "kernel_launch: unexpected shapes (n_in %d, out %d, ws %zu)\n", n_in, out_size, ws_size); grid = -1; return; }
        int dev = 0, cus = 0, per_cu = 0;
        hipGetDevice(&dev); hipDeviceGetAttribute(&cus, hipDeviceAttributeMultiprocessorCount, dev);
        if (hipFuncSetAttribute((const void*)mk_fwd, hipFuncAttributeMaxDynamicSharedMemorySize, LDS_BYTES) != hipSuccess) { fprintf(stderr, "kernel_launch: hipFuncSetAttribute failed\n"); grid = -1; return; }
        hipOccupancyMaxActiveBlocksPerMultiprocessor(&per_cu, (const void*)mk_fwd, NTHR, LDS_BYTES);
        (void)hipGetLastError();
        if (per_cu < 1) per_cu = 1;
        grid = cus;
        fprintf(stderr, "kernel_launch: cus %d, occupancy query %d block(s)/CU, grid %d\n", cus, per_cu, grid);
    }
    if (grid < 0) return;
    hipMemsetAsync((char*)d_ws + WS_CTL, 0, CTL_BYTES, stream);
    Args a{};
    for (int i = 0; i < 31; ++i) a.in[i] = (const float*)d_in[i];
    a.out = (float*)d_out; a.ws = (unsigned char*)d_ws;
#if MK_PER_PHASE
    for (int p = 0; p < N_PHASES; ++p) { a.ph_lo = p; a.ph_hi = p + 1; hipLaunchKernelGGL(mk_fwd, dim3(grid), dim3(NTHR), LDS_BYTES, stream, a); }
#else
    a.ph_lo = 0; a.ph_hi = N_PHASES;
    void* params[] = {&a};
    hipError_t e = hipLaunchCooperativeKernel((const void*)mk_fwd, dim3(grid), dim3(NTHR), params, LDS_BYTES, stream);
    if (e != hipSuccess) fprintf(stderr, "kernel_launch: cooperative launch failed: %s\n", hipGetErrorString(e));
#endif
}
```

```cpp
#include <hip/hip_runtime.h>
#include <hip/hip_cooperative_groups.h>
#include <cstdio>
#include <cstdint>
namespace cg = cooperative_groups;

#define LAS __attribute__((address_space(3)))
#define GAS __attribute__((address_space(1)))
typedef unsigned short bf16_t;
typedef short bf16x8 __attribute__((ext_vector_type(8)));
typedef float f32x4 __attribute__((ext_vector_type(4)));
typedef float f32x2 __attribute__((ext_vector_type(2)));
typedef float f32x16 __attribute__((ext_vector_type(16)));
typedef unsigned u32x4 __attribute__((ext_vector_type(4)));
typedef unsigned u32x2 __attribute__((ext_vector_type(2)));
typedef short v4i16_t __attribute__((ext_vector_type(4)));

#ifndef MK_PER_PHASE
#define MK_PER_PHASE 0
#endif

namespace pg8 {
constexpr int BM = 256, BK = 64, HALF = 128, HTB = HALF * BK * 2, STAGE_BYTES = 8 * HTB, NXCD = 8, WGM = 8;
__host__ __device__ __forceinline__ int lds_byte(int r, int c) { const int st = (r >> 4) * 2 + (c >> 5), rr = r & 15, cc = c & 31, ob = rr * 64 + cc * 2; return st * 1024 + (ob ^ (((ob >> 9) & 1) << 5)); }
__host__ __device__ __forceinline__ void stage_rc(int b, int& R, int& C) { const int st = b / 1024, sb = b % 1024, swz = sb ^ (((sb >> 9) & 1) << 5); R = (st >> 1) * 16 + swz / 64; C = (st & 1) * 32 + (swz % 64) / 2; }
__host__ __device__ __forceinline__ int perm32(int rho) { const int n = rho >> 4, i = rho & 15; return 8 * (i >> 2) + 4 * n + (i & 3); }
struct Unit { int pm, pn; };
struct Gemm { const bf16_t* A; const bf16_t* Bt; int M, N, K, lda, ldb; int kdiag = 0; };
struct StaticOrder {
    int nM, nN, nwg, G, c;
    __host__ __device__ void init(int M, int N, int G_, int c_) { nM = M / BM; nN = N / BM; nwg = nM * nN; G = G_; c = c_; }
    __host__ __device__ bool next(int i, Unit& u) const {
        const long L = (long)i * G + c; if (L >= nwg) return false;
        int wgid = (int)L; { const int q = nwg / NXCD, r = nwg % NXCD, xcd = wgid % NXCD, off = wgid / NXCD; wgid = (xcd < r ? xcd * (q + 1) : r * (q + 1) + (xcd - r) * q) + off; }
        const int nig = WGM * nN, gid = wgid / nig, fm = gid * WGM, gsz = (nM - fm) < WGM ? (nM - fm) : WGM;
        u.pm = fm + ((wgid % nig) % gsz); u.pn = (wgid % nig) / gsz; return true;
    }
};
template <class Epi, class Sched, bool ALIGN_EPI, bool SP2>
__device__ __forceinline__ void gemm_phase(LAS unsigned char* lds, int wave_id, const Gemm g, const Sched& S, const Epi& E) {
    int lane = (int)__builtin_amdgcn_mbcnt_hi(~0u, __builtin_amdgcn_mbcnt_lo(~0u, 0u)); asm volatile("" : "+v"(lane));
    const int wid = wave_id, tid = wid * 64 + lane, wr = wid >> 2, wc = wid & 3, fr = lane & 15, fq = lane >> 4;
    const int K = g.K, nt = K / BK;
    unsigned voffA[2], voffB[2];
#pragma unroll
    for (int i = 0; i < 2; ++i) { int R, C; stage_rc(tid * 16 + i * 8192, R, C); const int Rb = (R & ~31) + perm32(R & 31);
        voffA[i] = (unsigned)(R * g.lda + C) * 2u; voffB[i] = (unsigned)(Rb * g.ldb + C) * 2u; }
    const size_t kstep = (size_t)(BK * 2);
    const size_t hstepA = (size_t)HALF * g.lda * 2, hstepB = (size_t)HALF * g.ldb * 2;
    const size_t tstepA = 2 * hstepA, tstepB = 2 * hstepB;
    const unsigned ldsw = (unsigned)wid * 1024u, lds0 = (unsigned)(uintptr_t)lds;
    const int aoff = lds_byte(wr * 64 + fr, fq * 8), boff = lds_byte(wc * 32 + fr, fq * 8);
#define PG8_SA(b, h) (((b) * 2 + (h)) * HTB)
#define PG8_SB(b, h) ((4 + (b) * 2 + (h)) * HTB)
#define PG8_STAGE(bufoff, gbase, voff) do { _Pragma("unroll") for (int _i = 0; _i < 2; ++_i) { unsigned keep_; \
        asm volatile("s_mov_b32 %0, m0\n\ts_mov_b32 m0, %3\n\ts_nop 0\n\tglobal_load_lds_dwordx4 %1, %2\n\ts_mov_b32 m0, %0" : "=&s"(keep_) : "v"((voff)[_i]), "s"((const char*)(gbase)), "s"(lds0 + (unsigned)(bufoff) + ldsw + (unsigned)(_i * 8192)) : "memory"); } } while (0)
#define PG8_LDA(dst, b, h) do { _Pragma("unroll") for (int m = 0; m < 4; ++m) _Pragma("unroll") for (int k = 0; k < 2; ++k) dst[m][k] = *(const LAS bf16x8*)(lds + PG8_SA(b, h) + aoff + m * 2048 + k * 1024); } while (0)
#define PG8_LDB(dst, b, h) do { _Pragma("unroll") for (int n = 0; n < 2; ++n) _Pragma("unroll") for (int k = 0; k < 2; ++k) dst[n][k] = *(const LAS bf16x8*)(lds + PG8_SB(b, h) + boff + n * 2048 + k * 1024); } while (0)
#define PG8_MMA(ai, bj, At, Bt) do { __builtin_amdgcn_s_setprio(1); _Pragma("unroll") for (int m = 0; m < 4; ++m) _Pragma("unroll") for (int n = 0; n < 2; ++n) _Pragma("unroll") for (int k = 0; k < 2; ++k) \
        acc[ai][bj][m][n] = __builtin_amdgcn_mfma_f32_16x16x32_bf16(Bt[n][k], At[m][k], acc[ai][bj][m][n], 0, 0, 0); __builtin_amdgcn_s_setprio(0); } while (0)
#define PG8_WAIT_V(n) asm volatile("s_waitcnt vmcnt(" #n ")" ::: "memory")
#define PG8_WAIT_L(n) asm volatile("s_waitcnt lgkmcnt(" #n ")" ::: "memory")
#define PG8_BAR __builtin_amdgcn_s_barrier()
#define PG8_SCHED __builtin_amdgcn_sched_barrier(0)
    Unit cur, nxt; int ui = 0;
    if (!S.next(0, cur)) return;
    f32x4 acc[2][2][4][2];
#pragma unroll
    for (int a = 0; a < 2; ++a)
#pragma unroll
        for (int b = 0; b < 2; ++b)
#pragma unroll
            for (int m = 0; m < 4; ++m)
#pragma unroll
                for (int n = 0; n < 2; ++n) acc[a][b][m][n] = (f32x4){0.f, 0.f, 0.f, 0.f};
    bf16x8 At[4][2], B0[2][2], B1[2][2];
    const char* cA = (const char*)g.A + (size_t)cur.pm * tstepA + (size_t)cur.pn * g.kdiag * 2; const char* cB = (const char*)g.Bt + (size_t)cur.pn * tstepB + (size_t)cur.pn * g.kdiag * 2;
    if constexpr (SP2) {
        PG8_STAGE(PG8_SB(0, 0), cB, voffB); PG8_STAGE(PG8_SB(0, 1), cB + hstepB, voffB); PG8_STAGE(PG8_SA(0, 0), cA, voffA); PG8_STAGE(PG8_SA(0, 1), cA + hstepA, voffA);
        if (wr == 1) PG8_BAR;
        PG8_WAIT_V(2); PG8_BAR;
        PG8_STAGE(PG8_SB(1, 0), cB + kstep, voffB); PG8_STAGE(PG8_SA(1, 0), cA + kstep, voffA); PG8_STAGE(PG8_SB(1, 1), cB + hstepB + kstep, voffB);
        PG8_WAIT_V(6); PG8_BAR;
    } else {
        PG8_STAGE(PG8_SB(0, 0), cB, voffB); PG8_STAGE(PG8_SA(0, 0), cA, voffA); PG8_STAGE(PG8_SB(0, 1), cB + hstepB, voffB); PG8_STAGE(PG8_SA(0, 1), cA + hstepA, voffA);
        if (wr == 1) PG8_BAR;
        PG8_WAIT_V(4); PG8_BAR;
        PG8_STAGE(PG8_SB(1, 0), cB + kstep, voffB); PG8_STAGE(PG8_SA(1, 0), cA + kstep, voffA); PG8_STAGE(PG8_SB(1, 1), cB + hstepB + kstep, voffB);
        PG8_WAIT_V(6); PG8_BAR;
    }
    for (;;) {
        const bool has_next = S.next(ui + 1, nxt);
        const char* nA = has_next ? (const char*)g.A + (size_t)nxt.pm * tstepA + (size_t)nxt.pn * g.kdiag * 2 : cA; const char* nB = has_next ? (const char*)g.Bt + (size_t)nxt.pn * tstepB + (size_t)nxt.pn * g.kdiag * 2 : cB;
        for (int t = 0; t < nt; t += 2) {
            const bool last = (t == nt - 2);
            const char* a1 = cA + (size_t)(t + 1) * kstep;
            const char* a2 = last ? nA : cA + (size_t)(t + 2) * kstep; const char* b2 = last ? nB : cB + (size_t)(t + 2) * kstep;
            const char* a3 = a2 + kstep; const char* b3 = b2 + kstep;
            if constexpr (SP2) {
            PG8_LDB(B0, 0, 0); PG8_LDB(B1, 0, 1); PG8_SCHED; PG8_LDA(At, 0, 0); PG8_STAGE(PG8_SA(1, 1), a1 + hstepA, voffA);
            PG8_WAIT_V(8); PG8_WAIT_L(0); PG8_BAR; PG8_MMA(0, 0, At, B0); PG8_MMA(0, 1, At, B1); PG8_BAR; PG8_SCHED;
            PG8_LDA(At, 0, 1); PG8_STAGE(PG8_SB(0, 0), b2, voffB); PG8_STAGE(PG8_SB(0, 1), b2 + hstepB, voffB); PG8_STAGE(PG8_SA(0, 0), a2, voffA);
            PG8_WAIT_V(8); PG8_WAIT_L(0); PG8_BAR; PG8_MMA(1, 0, At, B0); PG8_MMA(1, 1, At, B1); PG8_BAR; PG8_SCHED;
            PG8_LDB(B0, 1, 0); PG8_LDB(B1, 1, 1); PG8_SCHED; PG8_LDA(At, 1, 0); PG8_STAGE(PG8_SA(0, 1), a2 + hstepA, voffA);
            PG8_WAIT_V(8); PG8_WAIT_L(0); PG8_BAR; PG8_MMA(0, 0, At, B0); PG8_MMA(0, 1, At, B1); PG8_BAR; PG8_SCHED;
            PG8_LDA(At, 1, 1); PG8_STAGE(PG8_SB(1, 0), b3, voffB); PG8_STAGE(PG8_SB(1, 1), b3 + hstepB, voffB); PG8_STAGE(PG8_SA(1, 0), a3, voffA);
            PG8_WAIT_V(8); PG8_WAIT_L(0); PG8_BAR; PG8_MMA(1, 0, At, B0); PG8_MMA(1, 1, At, B1); PG8_BAR; PG8_SCHED;
            } else {
            PG8_LDB(B0, 0, 0); PG8_SCHED; PG8_LDA(At, 0, 0); PG8_STAGE(PG8_SA(1, 1), a1 + hstepA, voffA);
            PG8_WAIT_L(8); PG8_BAR; PG8_WAIT_L(0); PG8_MMA(0, 0, At, B0); PG8_BAR; PG8_SCHED;
            PG8_LDB(B1, 0, 1); PG8_STAGE(PG8_SB(0, 0), b2, voffB);
            PG8_BAR; PG8_WAIT_L(0); PG8_MMA(0, 1, At, B1); PG8_BAR;
            PG8_LDA(At, 0, 1); PG8_STAGE(PG8_SA(0, 0), a2, voffA);
            PG8_BAR; PG8_WAIT_L(0); PG8_MMA(1, 0, At, B0); PG8_BAR; PG8_SCHED;
            PG8_STAGE(PG8_SB(0, 1), b2 + hstepB, voffB);
            PG8_WAIT_V(6); PG8_BAR; PG8_MMA(1, 1, At, B1); PG8_BAR;
            PG8_LDB(B0, 1, 0); PG8_SCHED; PG8_LDA(At, 1, 0); PG8_STAGE(PG8_SA(0, 1), a2 + hstepA, voffA);
            PG8_WAIT_L(8); PG8_BAR; PG8_WAIT_L(0); PG8_MMA(0, 0, At, B0); PG8_BAR; PG8_SCHED;
            PG8_LDB(B1, 1, 1); PG8_STAGE(PG8_SB(1, 0), b3, voffB);
            PG8_BAR; PG8_WAIT_L(0); PG8_MMA(0, 1, At, B1); PG8_BAR;
            PG8_LDA(At, 1, 1); PG8_STAGE(PG8_SA(1, 0), a3, voffA);
            PG8_BAR; PG8_WAIT_L(0); PG8_MMA(1, 0, At, B0); PG8_BAR; PG8_SCHED;
            PG8_STAGE(PG8_SB(1, 1), b3 + hstepB, voffB);
            PG8_WAIT_V(6); PG8_BAR; PG8_MMA(1, 1, At, B1); PG8_BAR;
            }
        }
        if constexpr (ALIGN_EPI) { if (wr == 0) PG8_BAR; }
        if constexpr (!Epi::AFTER_DRAIN) E(acc, cur, wr, wc, fr, fq);
        if (!has_next) break;
#pragma unroll
        for (int a = 0; a < 2; ++a)
#pragma unroll
            for (int b = 0; b < 2; ++b)
#pragma unroll
                for (int m = 0; m < 4; ++m)
#pragma unroll
                    for (int n = 0; n < 2; ++n) acc[a][b][m][n] = (f32x4){0.f, 0.f, 0.f, 0.f};
        cur = nxt; cA = nA; cB = nB; ++ui;
        if constexpr (ALIGN_EPI) { if (wr == 1) PG8_BAR; }
    }
    PG8_WAIT_V(0);
    if constexpr (!ALIGN_EPI) { if (wr == 0) PG8_BAR; }
    PG8_BAR;
    if constexpr (Epi::AFTER_DRAIN) E.fused(acc, cur, wr, wc, lds, wid);
#undef PG8_SA
#undef PG8_SB
#undef PG8_STAGE
#undef PG8_LDA
#undef PG8_LDB
#undef PG8_MMA
#undef PG8_WAIT_V
#undef PG8_WAIT_L
#undef PG8_BAR
#undef PG8_SCHED
}
}

constexpr int NT = 16384, SEQ = 8192, DM = 1024, DIN = 4680, NIN = 4864, NCHK = 256, NWAVES = 8, NTHR = 512;
constexpr float EPS = 1e-6f, GN_EPS = 64e-5f, DECAY_SCALE = 0.606531f;
constexpr float QSCALE = 0.07216878364870322f * 1.4426950408889634f;
constexpr size_t MiB = 1u << 20;
constexpr size_t WS_CTL = 0, CTL_BYTES = 1 * MiB;
constexpr size_t CTL_MOD = 65536;
constexpr size_t CTL_SSQ = 131072;
constexpr size_t CTL_RSLOT = 393216;
constexpr size_t CTL_RCNT = 917504;
constexpr size_t WS_WIN = 1 * MiB;
constexpr size_t WS_CB = WS_WIN, WS_ECUM = WS_WIN + 8 * MiB, WS_CDEC = WS_ECUM + 512 * 1024;
constexpr size_t WS_WQ = 10 * MiB + 512 * 1024;
constexpr size_t WS_WUV = 11 * MiB;
constexpr size_t WS_WLW = 11 * MiB + 512 * 1024;
constexpr size_t WS_WLA = WS_WLW + 65536;
constexpr size_t WS_WOUT = 12 * MiB;
constexpr size_t WS_XN = 15 * MiB;
constexpr size_t WS_TT = WS_XN, WS_QE = WS_XN + 16 * MiB;
constexpr size_t WS_QLAT = 47 * MiB, WS_KVL = 55 * MiB;
constexpr size_t WS_OL = WS_QLAT;
constexpr size_t WS_GATES = 63 * MiB;
constexpr size_t WS_XBC = 111 * MiB;
constexpr size_t WS_R = 143 * MiB, WS_K = 159 * MiB, WS_V = 175 * MiB;
constexpr size_t WS_F = 191 * MiB;
constexpr size_t WS_Q = 200 * MiB;
constexpr size_t WS_KVB = 224 * MiB;
constexpr size_t WS_YD = 230 * MiB;
constexpr size_t WS_ROPE = 246 * MiB;
constexpr size_t WS_HX = 250 * MiB;
constexpr size_t WS_HRKV = WS_HX + 1536 * 1024;
constexpr size_t WS_HF = WS_HRKV + 768 * 1024;
constexpr size_t WS_END = 253 * MiB;
constexpr int LDS_BYTES = 152 * 1024;

#define LDS_WAIT() asm volatile("s_waitcnt lgkmcnt(0)" ::: "memory")
typedef __bf16 bf16x2_hw __attribute__((ext_vector_type(2)));
__device__ __forceinline__ unsigned pk2(float lo, float hi) { const f32x2 v = {lo, hi}; return __builtin_bit_cast(unsigned, __builtin_convertvector(v, bf16x2_hw)); }
__device__ __forceinline__ unsigned f2bf(float f) { return pk2(f, 0.f) & 0xffffu; }
__device__ __forceinline__ float bf2f(unsigned short b) { return __builtin_bit_cast(float, (unsigned)b << 16); }
__device__ __forceinline__ float bflo(unsigned w) { return __builtin_bit_cast(float, w << 16); }
__device__ __forceinline__ float bfhi(unsigned w) { return __builtin_bit_cast(float, w & 0xffff0000u); }
__device__ __forceinline__ float wave_sum(float v) {
#pragma unroll
    for (int o = 1; o < 64; o <<= 1) v += __shfl_xor(v, o);
    return v;
}
__device__ __forceinline__ float sigmoidf_(float x) { return __builtin_amdgcn_rcpf(1.f + __expf(-x)); }
__device__ __forceinline__ float siluf_(float x) { return x * __builtin_amdgcn_rcpf(1.f + __expf(-x)); }
__device__ __forceinline__ int pi16(int n) { const int x = n & 15; return (n & ~15) | ((x >= 4 && x < 8) ? x + 4 : (x >= 8 && x < 12) ? x - 4 : x); }
__device__ __forceinline__ int sg32(int x) { return (x & ~31) | (16 * ((x >> 2) & 1) + 4 * ((x & 31) >> 3) + (x & 3)); }
__device__ __forceinline__ int crow(int r, int hi) { return (r & 3) + 8 * (r >> 2) + 4 * hi; }

template <int K> __device__ __forceinline__ f32x4 mma_tile(const LAS bf16_t* A, int lda, const LAS bf16_t* Bt, int ldb, int lane) {
    f32x4 acc = {0.f, 0.f, 0.f, 0.f};
    const LAS bf16_t* ap = A + (lane & 15) * lda + (lane >> 4) * 8;
    const LAS bf16_t* bp = Bt + (lane & 15) * ldb + (lane >> 4) * 8;
#pragma unroll
    for (int k = 0; k < K; k += 32) {
        const bf16x8 a = *(const LAS bf16x8*)(ap + k), b = *(const LAS bf16x8*)(bp + k);
        acc = __builtin_amdgcn_mfma_f32_16x16x32_bf16(a, b, acc, 0, 0, 0);
    }
    return acc;
}

template <int V> struct IC { static constexpr int value = V; };
template <bool KX> __device__ __forceinline__ bf16x8 frag16(const LAS bf16_t* M, int ld, int x0, int k0, int lane) {
    if constexpr (!KX) return *(const LAS bf16x8*)(M + (x0 + (lane & 15)) * ld + k0 + 8 * (lane >> 4));
    else { const LAS bf16_t* p = M + (k0 + 8 * (lane >> 4) + ((lane & 15) >> 2)) * ld + x0 + 4 * (lane & 3);
        const v4i16_t lo = __builtin_amdgcn_ds_read_tr16_b64_v4i16((LAS v4i16_t*)p), hi = __builtin_amdgcn_ds_read_tr16_b64_v4i16((LAS v4i16_t*)(p + 4 * ld));
        return (bf16x8){lo[0], lo[1], lo[2], lo[3], hi[0], hi[1], hi[2], hi[3]}; }
}
template <int K, bool AKX, bool BKX> __device__ __forceinline__ f32x4 mma_tile2(const LAS bf16_t* A, int lda, int m0, const LAS bf16_t* B, int ldb, int n0, int lane) {
    f32x4 acc = {0.f, 0.f, 0.f, 0.f};
#pragma unroll
    for (int k = 0; k < K; k += 32) acc = __builtin_amdgcn_mfma_f32_16x16x32_bf16(frag16<AKX>(A, lda, m0, k, lane), frag16<BKX>(B, ldb, n0, k, lane), acc, 0, 0, 0);
    return acc;
}
struct Args {
    const float* in[31]; float* out; unsigned char* ws; int ph_lo, ph_hi;
};
struct Ctx {
    LAS unsigned char* lds; int tid, lane, wave, G, bid;
    unsigned char* ws; float* out;
    const float* const* in;
};
__device__ __forceinline__ const float* ldin(const float* const* in, int i) { asm volatile("" : "+s"(i)); return (const float*)(const GAS float*)in[i]; }
#define INP(i) ldin(F.in, i)
__device__ __forceinline__ int fresh_lane() { int l_ = (int)__builtin_amdgcn_mbcnt_hi(~0u, __builtin_amdgcn_mbcnt_lo(~0u, 0u)); asm volatile("" : "+v"(l_)); return l_; }
enum { I_X = 0, I_C, I_POS, I_ADAW, I_ADAB, I_NORMW, I_WIN, I_QNW, I_WUQ, I_KVNW, I_WUKV, I_CONVW, I_CONVB, I_DTB, I_ALOG, I_DSKIP, I_SSDNW,
       I_MURKV, I_MUW, I_MUA, I_W0, I_WLB, I_A0, I_ALB, I_KK, I_KA, I_RK, I_LNXW, I_LNXB, I_WOUT, I_FNW };

__device__ __forceinline__ int win_src_col(int n) {
    if (n < 448) return n;
    if (n < 512) return -1;
    if (n < 1024) return 448 + (n - 512);
    if (n < 1536) return 960 + (n - 1024);
    if (n < 2560) return 1472 + (n - 1536);
    if (n < 3072) return 2504 + (n - 2560);
    if (n < 3584) return 3016 + (n - 3072);
    if (n < 4096) return 3528 + (n - 3584);
    if (n < 4608) return 4168 + (n - 4096);
    if (n < 4672) return 4040 + (n - 4608);
    if (n < 4736) return 4104 + (n - 4672);
    if (n < 4744) return 2496 + (n - 4736);
    return -1;
}
template <class Src4> __device__ __forceinline__ void transpose_item(const Src4& src4, bf16_t* WT, int ldw, LAS float* scr, int kb, int nb, int lane) {
    const int k0 = 64 * kb, n0 = 64 * nb;
#pragma unroll 8
    for (int i = 0; i < 16; ++i) { const int kk = 4 * i + (lane >> 4), nn = 4 * (lane & 15); const f32x4 v = src4(k0 + kk, n0 + nn);
        LAS float* d = scr + kk * 65 + nn; d[0] = v[0]; d[1] = v[1]; d[2] = v[2]; d[3] = v[3]; }
    LDS_WAIT();
    const int c = lane & 7;
#pragma unroll
    for (int j = 0; j < 8; ++j) { const int n = (lane >> 3) + 8 * j; const LAS float* sp = scr + (8 * c) * 65 + n;
        u32x4 o; o.x = pk2(sp[0 * 65], sp[1 * 65]); o.y = pk2(sp[2 * 65], sp[3 * 65]); o.z = pk2(sp[4 * 65], sp[5 * 65]); o.w = pk2(sp[6 * 65], sp[7 * 65]);
        *(u32x4*)(WT + (size_t)(n0 + n) * ldw + k0 + 8 * c) = o; }
    LDS_WAIT();
}
__device__ __forceinline__ void prep_weights(const Ctx& F, int l) {
    LAS float* scr = (LAS float*)(F.lds + F.wave * 16640);
    const int gw = F.bid * NWAVES + F.wave, NGW = F.G * NWAVES;
    const float* w_in = INP(I_WIN) + (size_t)l * DM * DIN;
    const float* w_out = INP(I_WOUT) + (size_t)l * 1536 * 1024;
    const float* wlb = INP(I_WLB) + (size_t)l * 64 * 512;
    const float* alb = INP(I_ALB) + (size_t)l * 64 * 512;
    bf16_t* WIN = (bf16_t*)(F.ws + WS_WIN); bf16_t* WOUT = (bf16_t*)(F.ws + WS_WOUT); bf16_t* WLW = (bf16_t*)(F.ws + WS_WLW); bf16_t* WLA = (bf16_t*)(F.ws + WS_WLA);
    constexpr int I_IN = 16 * (NIN / 64), I_OUT = 24 * 16, I_LW = 8, I_LA = 8, NITEMS = I_IN + I_OUT + I_LW + I_LA;
    for (int it = gw; it < NITEMS; it += NGW) {
        int r = it;
        if (r < I_IN) { const int kb = r / (NIN / 64), nb = r % (NIN / 64);
            transpose_item([&](int k, int n) { const int sc = win_src_col(n); return sc >= 0 ? *(const f32x4*)(w_in + (size_t)k * DIN + sc) : (f32x4){0.f, 0.f, 0.f, 0.f}; }, WIN, 1024, scr, kb, nb, F.lane); continue; }
        r -= I_IN;
        if (r < I_OUT) { const int kb = r / 16, nb = r % 16;
            transpose_item([&](int k, int n) { return *(const f32x4*)(w_out + (size_t)k * 1024 + n); }, WOUT, 1536, scr, kb, nb, F.lane); continue; }
        r -= I_OUT;
        if (r < I_LW) { transpose_item([&](int k, int n) { return *(const f32x4*)(wlb + k * 512 + n); }, WLW, 64, scr, 0, r, F.lane); continue; }
        r -= I_LW;
        transpose_item([&](int k, int n) { return *(const f32x4*)(alb + k * 512 + n); }, WLA, 64, scr, 0, r, F.lane);
    }
    const float* wuq = INP(I_WUQ) + (size_t)l * 256 * 768; const float* wukv = INP(I_WUKV) + (size_t)l * 128 * 1024; const float* qnw = INP(I_QNW) + l * 256;
    bf16_t* WQ = (bf16_t*)(F.ws + WS_WQ); bf16_t* WUV = (bf16_t*)(F.ws + WS_WUV);
    const int gt = F.bid * NTHR + F.tid, NGT = F.G * NTHR;
    for (int e = gt; e < 768 * 256; e += NGT) {
        const int n = e >> 8, k = e & 255, h = n / 192, idx = n % 192; float v;
        if (idx < 128) {
            const f32x4* a = (const f32x4*)(wuq + (size_t)k * 768 + h * 192); const f32x4* b = (const f32x4*)(wukv + (size_t)idx * 1024 + h * 256);
            float s = 0.f;
#pragma unroll 8
            for (int d = 0; d < 32; ++d) { const f32x4 x = a[d], y = b[d]; s += x.x * y.x + x.y * y.y + x.z * y.z + x.w * y.w; }
            v = s;
        } else v = wuq[(size_t)k * 768 + n];
        WQ[e] = (bf16_t)f2bf(v * qnw[k]);
    }
    for (int e = gt; e < 512 * 512; e += NGT) {
        const int n = e >> 9, k = e & 511, h = n >> 7, d = n & 127, h2 = k >> 7, c = k & 127;
        WUV[e] = (h == h2) ? (bf16_t)f2bf(wukv[(size_t)c * 1024 + h * 256 + 128 + d]) : (bf16_t)0;
    }
}
__device__ __forceinline__ void p0_mod(const Ctx& F) {
    const int gw = F.bid * NWAVES + F.wave, NGW = F.G * NWAVES;
    float* MOD = (float*)(F.ws + WS_CTL + CTL_MOD);
    for (int it = gw; it < 2 * 12 * 32; it += NGW) {
        const int l = it / 384, r = it % 384, cb = r / 32, ks = r % 32;
        const float* aw = INP(I_ADAW) + (size_t)l * DM * 3072 + (size_t)(ks * 32) * 3072 + cb * 256 + F.lane * 4;
        const float* cc = INP(I_C);
        f32x4 a0 = {0.f, 0.f, 0.f, 0.f}, a1 = a0;
#pragma unroll 8
        for (int k = 0; k < 32; ++k) { const f32x4 w = *(const f32x4*)(aw + (size_t)k * 3072); const float s0 = siluf_(cc[ks * 32 + k]), s1 = siluf_(cc[DM + ks * 32 + k]); a0 += w * s0; a1 += w * s1; }
        if (ks == 0) { const f32x4 bb = *(const f32x4*)(INP(I_ADAB) + l * 3072 + cb * 256 + F.lane * 4); a0 += bb; a1 += bb; }
        float* m0 = MOD + (size_t)(l * 2 + 0) * 3072 + cb * 256 + F.lane * 4; float* m1 = m0 + 3072;
#pragma unroll
        for (int j = 0; j < 4; ++j) { atomicAdd(m0 + j, a0[j]); atomicAdd(m1 + j, a1[j]); }
    }
}
__device__ __forceinline__ void p0_rope(const Ctx& F) {
    float* ROPE = (float*)(F.ws + WS_ROPE); const int* pos = (const int*)INP(I_POS);
    for (int e = F.bid * NTHR + F.tid; e < NT * 32; e += F.G * NTHR) {
        const int m = e >> 5, i = e & 31;
        const float invf = powf(10000.f, -(float)i / 32.f); const float ang = (float)pos[m] * invf;
        const double a = (double)ang; const double kq = __builtin_rint(a * 0.15915494309189535); const float rr = (float)(a - kq * 6.283185307179586);
        ROPE[(size_t)m * 64 + i] = cosf(rr); ROPE[(size_t)m * 64 + 32 + i] = sinf(rr);
    }
}
__device__ __forceinline__ void p1_norm(const Ctx& F, int l) {
    const float* xin = (l == 0) ? INP(I_X) : F.out;
    const float* nw = INP(I_NORMW) + l * DM; const float* MOD = (const float*)(F.ws + WS_CTL + CTL_MOD);
    bf16_t* XN = (bf16_t*)(F.ws + WS_XN);
    const int gw = F.bid * NWAVES + F.wave, NGW = F.G * NWAVES;
    for (int m = gw; m < NT; m += NGW) {
        const int b = m >> 13; const float* md = MOD + (size_t)(l * 2 + b) * 3072;
        const f32x4* xr = (const f32x4*)(xin + (size_t)m * DM) + F.lane;
        f32x4 v[4]; float s = 0.f;
#pragma unroll
        for (int j = 0; j < 4; ++j) { v[j] = xr[64 * j]; s += v[j].x * v[j].x + v[j].y * v[j].y + v[j].z * v[j].z + v[j].w * v[j].w; }
        const float rstd = 1.f / sqrtf(wave_sum(s) * (1.f / DM) + EPS);
        unsigned long long* o8 = (unsigned long long*)(XN + (size_t)m * DM) + F.lane;
#pragma unroll
        for (int j = 0; j < 4; ++j) { const int c0 = 4 * F.lane + 256 * j;
            const f32x4 w = *(const f32x4*)(nw + c0), sh = *(const f32x4*)(md + c0), sc = *(const f32x4*)(md + 1024 + c0);
            const f32x4 y = v[j] * rstd * w * (sc + 1.f) + sh;
            o8[64 * j] = (unsigned long long)pk2(y.x, y.y) | ((unsigned long long)pk2(y.z, y.w) << 32); }
    }
}
__device__ __forceinline__ u32x4 pack8(f32x4 a, f32x4 b) { u32x4 w; w.x = pk2(a[0], a[1]); w.y = pk2(a[2], a[3]); w.z = pk2(b[0], b[1]); w.w = pk2(b[2], b[3]); return w; }
struct EpiIn {
    static constexpr bool AFTER_DRAIN = false;
    unsigned char* ws; int l;
    __device__ __forceinline__ void operator()(const f32x4 (&acc)[2][2][4][2], const pg8::Unit& u, int wr, int wc, int fr, int fq) const {
        { int ln_ = (int)__builtin_amdgcn_mbcnt_hi(~0u, __builtin_amdgcn_mbcnt_lo(~0u, 0u)); asm volatile("" : "+v"(ln_)); fr = ln_ & 15; fq = ln_ >> 4; }
        const int pn = u.pn; size_t bo; int ld, c0;
        if (pn == 0) { bo = WS_QLAT; ld = 256; c0 = 0; } else if (pn == 1) { bo = WS_KVL; ld = 256; c0 = 0; }
        else if (pn < 4) { bo = WS_GATES; ld = 1536; c0 = (pn - 2) * 256; } else if (pn < 6) { bo = WS_GATES; ld = 1536; c0 = 512 + (pn - 4) * 256; }
        else if (pn < 10) { bo = WS_XBC; ld = 1024; c0 = (pn - 6) * 256; } else if (pn < 12) { bo = WS_R; ld = 512; c0 = (pn - 10) * 256; }
        else if (pn < 14) { bo = WS_K; ld = 512; c0 = (pn - 12) * 256; } else if (pn < 16) { bo = WS_V; ld = 512; c0 = (pn - 14) * 256; }
        else if (pn < 18) { bo = WS_GATES; ld = 1536; c0 = 1024 + (pn - 16) * 256; } else { bo = WS_F; ld = 144; c0 = 0; }
        bf16_t* base = (bf16_t*)(ws + bo); float* F = (float*)(ws + WS_F);
        float* ssq_q = (float*)(ws + WS_CTL + CTL_SSQ) + (size_t)(l * 2) * NT; float* ssq_kv = ssq_q + NT;
        const int row0 = u.pm * 256 + wr * 64 + fr, col0 = wc * 32 + 8 * fq;
        if (pn < 18) {
#pragma unroll
            for (int ai = 0; ai < 2; ++ai)
#pragma unroll
                for (int m = 0; m < 4; ++m) { const int row = row0 + ai * 128 + m * 16; bf16_t* rp = base + (size_t)row * ld + c0 + col0;
#pragma unroll
                    for (int bj = 0; bj < 2; ++bj) *(u32x4*)(rp + bj * 128) = pack8(acc[ai][bj][m][0], acc[ai][bj][m][1]);
                    if (m == 3 && pn >= 6 && pn < 16) {
                        const int chunk = row >> 6;
                        if (pn < 10) { if (fr >= 13) { bf16_t* hp = (bf16_t*)(ws + WS_HX) + (size_t)(chunk * 3 + (fr - 13)) * 1024 + c0 + col0;
#pragma unroll
                                for (int bj = 0; bj < 2; ++bj) *(u32x4*)(hp + bj * 128) = pack8(acc[ai][bj][m][0], acc[ai][bj][m][1]); } }
                        else if (fr == 15) { bf16_t* hp = (bf16_t*)(ws + WS_HRKV) + (size_t)((pn - 10) >> 1) * NCHK * 512 + (size_t)chunk * 512 + c0 + col0;
#pragma unroll
                            for (int bj = 0; bj < 2; ++bj) *(u32x4*)(hp + bj * 128) = pack8(acc[ai][bj][m][0], acc[ai][bj][m][1]); } }
                    if (pn < 2) { float s = 0.f;
#pragma unroll
                        for (int bj = 0; bj < 2; ++bj) if (pn == 0 || bj == 0) {
#pragma unroll
                            for (int n = 0; n < 2; ++n) { const f32x4 x = acc[ai][bj][m][n]; s += x[0] * x[0] + x[1] * x[1] + x[2] * x[2] + x[3] * x[3]; } }
                        s += __shfl_xor(s, 16); s += __shfl_xor(s, 32);
                        if (fq == 0) atomicAdd((pn == 0 ? ssq_q : ssq_kv) + row, s); } }
        } else {
#pragma unroll
            for (int ai = 0; ai < 2; ++ai)
#pragma unroll
                for (int m = 0; m < 4; ++m) { const int row = row0 + ai * 128 + m * 16;
#pragma unroll
                    for (int bj = 0; bj < 2; ++bj) { const int c = bj * 128 + col0; if (c < 136) { float* fp = F + (size_t)row * 144 + c; *(f32x4*)fp = acc[ai][bj][m][0]; *(f32x4*)(fp + 4) = acc[ai][bj][m][1]; } }
                    if (m == 3 && fr == 15) { float* hf = (float*)(ws + WS_HF) + (size_t)(row >> 6) * 128 + col0; *(f32x4*)hf = acc[ai][0][m][0]; *(f32x4*)(hf + 4) = acc[ai][0][m][1]; } }
        }
    }
};
struct EpiQ {
    static constexpr bool AFTER_DRAIN = false;
    unsigned char* ws; int l;
    __device__ __forceinline__ void operator()(const f32x4 (&acc)[2][2][4][2], const pg8::Unit& u, int wr, int wc, int fr, int fq) const {
        { int ln_ = (int)__builtin_amdgcn_mbcnt_hi(~0u, __builtin_amdgcn_mbcnt_lo(~0u, 0u)); asm volatile("" : "+v"(ln_)); fr = ln_ & 15; fq = ln_ >> 4; }
        bf16_t* Q = (bf16_t*)(ws + WS_Q); const float* ssq = (const float*)(ws + WS_CTL + CTL_SSQ) + (size_t)(l * 2) * NT;
        const int row0 = u.pm * 256 + wr * 64 + fr, c0 = u.pn * 256 + wc * 32 + 8 * fq;
#pragma unroll
        for (int ai = 0; ai < 2; ++ai)
#pragma unroll
            for (int m = 0; m < 4; ++m) { const int row = row0 + ai * 128 + m * 16; const float sc = QSCALE / sqrtf(ssq[row] * (1.f / 256.f) + EPS); bf16_t* qp = Q + (size_t)row * 768 + c0;
#pragma unroll
                for (int bj = 0; bj < 2; ++bj) *(u32x4*)(qp + bj * 128) = pack8(acc[ai][bj][m][0] * sc, acc[ai][bj][m][1] * sc); }
    }
};
struct EpiUV {
    static constexpr bool AFTER_DRAIN = false;
    bf16_t* gates;
    __device__ __forceinline__ void operator()(const f32x4 (&acc)[2][2][4][2], const pg8::Unit& u, int wr, int wc, int fr, int fq) const {
        { int ln_ = (int)__builtin_amdgcn_mbcnt_hi(~0u, __builtin_amdgcn_mbcnt_lo(~0u, 0u)); asm volatile("" : "+v"(ln_)); fr = ln_ & 15; fq = ln_ >> 4; }
        const int row0 = u.pm * 256 + wr * 64 + fr;
#pragma unroll
        for (int ai = 0; ai < 2; ++ai)
#pragma unroll
            for (int m = 0; m < 4; ++m) { asm volatile("" ::: "memory"); const int row = row0 + ai * 128 + m * 16;
#pragma unroll
                for (int bj = 0; bj < 2; ++bj) { const int c = u.pn * 256 + bj * 128 + wc * 32 + 8 * fq; u32x4* gp = (u32x4*)(gates + (size_t)row * 1536 + c); const u32x4 gw = *gp;
                    f32x4 v0 = acc[ai][bj][m][0], v1 = acc[ai][bj][m][1];
                    v0[0] *= siluf_(bflo(gw.x)); v0[1] *= siluf_(bfhi(gw.x)); v0[2] *= siluf_(bflo(gw.y)); v0[3] *= siluf_(bfhi(gw.y));
                    v1[0] *= siluf_(bflo(gw.z)); v1[1] *= siluf_(bfhi(gw.z)); v1[2] *= siluf_(bflo(gw.w)); v1[3] *= siluf_(bfhi(gw.w));
                    *gp = pack8(v0, v1); } }
    }
};
struct EpiOutNorm {
    static constexpr bool AFTER_DRAIN = true;
    const float* xin; float* xout; const float* gate; unsigned char* ws; const float* nw; const float* mod1; int mode; int use;
    __device__ __forceinline__ void fused(f32x4 (&acc)[2][2][4][2], const pg8::Unit& u, int wr, int wc, LAS unsigned char* lds, int wid) const {
        const int lane = fresh_lane(), fr = lane & 15, fq = lane >> 4;
        const int row0 = u.pm * 256 + wr * 64 + fr; const int bsel = (u.pm * 256) >> 13;
        LAS float* P = (LAS float*)lds;
        LAS float* S = (LAS float*)(lds + 4096);
        LAS unsigned* flag = (LAS unsigned*)(lds + 5120);
#pragma unroll
        for (int ai = 0; ai < 2; ++ai)
#pragma unroll
            for (int m = 0; m < 4; ++m) { const int row = row0 + ai * 128 + m * 16; float sq = 0.f;
#pragma unroll
                for (int bj = 0; bj < 2; ++bj) { const int c = u.pn * 256 + bj * 128 + wc * 32 + 8 * fq; const float* gp = gate + (size_t)bsel * 3072 + c; const size_t off = (size_t)row * DM + c;
                    const f32x4 g0 = *(const f32x4*)gp, g1 = *(const f32x4*)(gp + 4), x0 = *(const f32x4*)(xin + off), x1 = *(const f32x4*)(xin + off + 4);
                    const f32x4 v0 = x0 + g0 * acc[ai][bj][m][0], v1 = x1 + g1 * acc[ai][bj][m][1]; acc[ai][bj][m][0] = v0; acc[ai][bj][m][1] = v1;
                    sq += v0[0] * v0[0] + v0[1] * v0[1] + v0[2] * v0[2] + v0[3] * v0[3] + v1[0] * v1[0] + v1[1] * v1[1] + v1[2] * v1[2] + v1[3] * v1[3]; }
                sq += __shfl_xor(sq, 16); sq += __shfl_xor(sq, 32);
                if (fq == 0) P[(ai * 128 + wr * 64 + m * 16 + fr) * 4 + wc] = sq;
                asm volatile("" ::: "memory"); }
        asm volatile("s_waitcnt lgkmcnt(0)" ::: "memory"); __builtin_amdgcn_s_barrier(); asm volatile("" ::: "memory");
        float* slots = (float*)(ws + WS_CTL + CTL_RSLOT) + (size_t)use * NT * 4; unsigned* cnt = (unsigned*)(ws + WS_CTL + CTL_RCNT) + (use * 64 + u.pm) * 64;
        const int prow = wid * 32 + (lane & 31);
        if (lane < 32) { const f32x4 pp = *(const LAS f32x4*)(P + prow * 4); const float t = (pp[0] + pp[1]) + (pp[2] + pp[3]);
            __hip_atomic_store(slots + ((size_t)(u.pm * 256 + prow) * 4 + u.pn), t, __ATOMIC_RELAXED, __HIP_MEMORY_SCOPE_AGENT); }
        asm volatile("s_waitcnt vmcnt(0)" ::: "memory");
        if (lane == 0) __hip_atomic_fetch_add(cnt, 1u, __ATOMIC_RELAXED, __HIP_MEMORY_SCOPE_AGENT);
        if (wid == 0) { unsigned spins = 0;
            for (;;) { if ((unsigned)__builtin_amdgcn_readfirstlane(__hip_atomic_load(cnt, __ATOMIC_RELAXED, __HIP_MEMORY_SCOPE_AGENT)) >= 32u) break;
                if (++spins > (1u << 22)) break;
                __builtin_amdgcn_s_sleep(2); }
            __builtin_amdgcn_fence(__ATOMIC_ACQUIRE, "agent");
            if (lane == 0) flag[0] = 1u; }
        asm volatile("s_waitcnt vmcnt(0) lgkmcnt(0)" ::: "memory"); __builtin_amdgcn_s_barrier(); asm volatile("" ::: "memory");
        if (lane < 32) { const float* sl = slots + (size_t)(u.pm * 256 + prow) * 4; float q = 0.f;
#pragma unroll
            for (int t = 0; t < 4; ++t) q += __hip_atomic_load(sl + t, __ATOMIC_RELAXED, __HIP_MEMORY_SCOPE_AGENT);
            S[prow] = __builtin_amdgcn_rsqf(q * (1.f / DM) + EPS); }
        asm volatile("s_waitcnt vmcnt(0) lgkmcnt(0)" ::: "memory"); __builtin_amdgcn_s_barrier(); asm volatile("" ::: "memory");
        const float* shf = mod1 + (size_t)bsel * 3072; bf16_t* XN = (bf16_t*)(ws + WS_XN);
#pragma unroll
        for (int ai = 0; ai < 2; ++ai)
#pragma unroll
            for (int m = 0; m < 4; ++m) { const int rl = ai * 128 + wr * 64 + m * 16 + fr, row = u.pm * 256 + rl; const float rs = S[rl];
#pragma unroll
                for (int bj = 0; bj < 2; ++bj) { const int c = u.pn * 256 + bj * 128 + wc * 32 + 8 * fq; const size_t off = (size_t)row * DM + c;
                    const f32x4 v0 = acc[ai][bj][m][0], v1 = acc[ai][bj][m][1], w0 = *(const f32x4*)(nw + c), w1 = *(const f32x4*)(nw + c + 4);
                    if (mode == 0) { *(f32x4*)(xout + off) = v0; *(f32x4*)(xout + off + 4) = v1;
                        const f32x4 sh0 = *(const f32x4*)(shf + c), sh1 = *(const f32x4*)(shf + c + 4), sc0 = *(const f32x4*)(shf + 1024 + c), sc1 = *(const f32x4*)(shf + 1024 + c + 4);
                        *(u32x4*)(XN + off) = pack8(v0 * rs * w0 * (sc0 + 1.f) + sh0, v1 * rs * w1 * (sc1 + 1.f) + sh1); }
                    else { *(f32x4*)(xout + off) = v0 * rs * w0; *(f32x4*)(xout + off + 4) = v1 * rs * w1; } }
                asm volatile("" ::: "memory"); }
    }
};
struct EpiOut {
    static constexpr bool AFTER_DRAIN = false;
    const float* xin; float* xout; const float* gate;
    __device__ __forceinline__ void operator()(const f32x4 (&acc)[2][2][4][2], const pg8::Unit& u, int wr, int wc, int fr, int fq) const {
        { int ln_ = (int)__builtin_amdgcn_mbcnt_hi(~0u, __builtin_amdgcn_mbcnt_lo(~0u, 0u)); asm volatile("" : "+v"(ln_)); fr = ln_ & 15; fq = ln_ >> 4; }
        const int row0 = u.pm * 256 + wr * 64 + fr;
#pragma unroll
        for (int bj = 0; bj < 2; ++bj) { const int c = u.pn * 256 + bj * 128 + wc * 32 + 8 * fq;
#pragma unroll
            for (int ai = 0; ai < 2; ++ai)
#pragma unroll
                for (int m = 0; m < 4; ++m) { const int row = row0 + ai * 128 + m * 16; const float* gp = gate + (size_t)(row >> 13) * 3072 + c;
                    const f32x4 g0 = *(const f32x4*)gp, g1 = *(const f32x4*)(gp + 4);
                    const size_t off = (size_t)row * DM + c; const f32x4 x0 = *(const f32x4*)(xin + off), x1 = *(const f32x4*)(xin + off + 4);
                    *(f32x4*)(xout + off) = x0 + g0 * acc[ai][bj][m][0]; *(f32x4*)(xout + off + 4) = x1 + g1 * acc[ai][bj][m][1]; } }
    }
};

__device__ __forceinline__ void p3a_extras(const Ctx& F, int l) {
    const int tid_ = F.wave * 64 + fresh_lane();
    const int gt = F.bid * NTHR + tid_, NGT = F.G * NTHR;
    const bf16_t* KVL = (const bf16_t*)(F.ws + WS_KVL); bf16_t* KVB = (bf16_t*)(F.ws + WS_KVB);
    const float* ssq = (const float*)(F.ws + WS_CTL + CTL_SSQ) + (size_t)(l * 2 + 1) * NT; const float* kvnw = INP(I_KVNW) + l * 128;
    const float* ROPE = (const float*)(F.ws + WS_ROPE);
    for (int e = gt; e < NT * 24; e += NGT) {
        const int m = e / 24, g = e % 24;
        if (g < 16) {
            const u32x4 w = *(const u32x4*)(KVL + (size_t)m * 256 + 8 * g); const float rs = 1.f / sqrtf(ssq[m] * (1.f / 128.f) + EPS);
            const f32x4 n0 = *(const f32x4*)(kvnw + 8 * g), n1 = *(const f32x4*)(kvnw + 8 * g + 4);
            u32x4 o; o.x = pk2(bflo(w.x) * rs * n0[0], bfhi(w.x) * rs * n0[1]); o.y = pk2(bflo(w.y) * rs * n0[2], bfhi(w.y) * rs * n0[3]);
            o.z = pk2(bflo(w.z) * rs * n1[0], bfhi(w.z) * rs * n1[1]); o.w = pk2(bflo(w.w) * rs * n1[2], bfhi(w.w) * rs * n1[3]);
            *(u32x4*)(KVB + (size_t)m * 192 + 8 * g) = o;
        } else {
            const int i0 = 4 * (g - 16);
            const u32x2 a = *(const u32x2*)(KVL + (size_t)m * 256 + 128 + i0), b = *(const u32x2*)(KVL + (size_t)m * 256 + 160 + i0);
            const f32x4 cs = *(const f32x4*)(ROPE + (size_t)m * 64 + i0), sn = *(const f32x4*)(ROPE + (size_t)m * 64 + 32 + i0);
            const f32x4 x1 = {bflo(a.x), bfhi(a.x), bflo(a.y), bfhi(a.y)}, x2 = {bflo(b.x), bfhi(b.x), bflo(b.y), bfhi(b.y)};
            const f32x4 o1 = x1 * cs - x2 * sn, o2 = x1 * sn + x2 * cs;
            u32x2 w1, w2; w1.x = pk2(o1[0], o1[1]); w1.y = pk2(o1[2], o1[3]); w2.x = pk2(o2[0], o2[1]); w2.y = pk2(o2[2], o2[3]);
            *(u32x2*)(KVB + (size_t)m * 192 + 128 + i0) = w1; *(u32x2*)(KVB + (size_t)m * 192 + 160 + i0) = w2;
        }
    }
}

__device__ __forceinline__ int ssd_win_col(int g, int o) { return o < 256 ? 256 * g + o : o < 384 ? 512 + 128 * g + (o - 256) : 768 + 128 * g + (o - 384); }
template <int VAR = 0> __device__ __forceinline__ void p3b_ssd(const Ctx& F, int l) {
    constexpr int SC_C = 0, SC_B = 17408, SC_BT = 34816, SC_XST = 53248, SC_CB = 90112, SC_G = 106752, SC_XSD = 115968, SC_DT = 125184, SC_AC = 127232, SC_YS = 129280  , SC_STS = 137472  ;
    static_assert(SC_STS + 16384 <= LDS_BYTES - 256, "ssd lds map");
    LAS bf16_t* Cg = (LAS bf16_t*)(F.lds + SC_C); LAS bf16_t* Bg = (LAS bf16_t*)(F.lds + SC_B); LAS bf16_t* BT = (LAS bf16_t*)(F.lds + SC_BT);
    LAS bf16_t* XST = (LAS bf16_t*)(F.lds + SC_XST); LAS float* CB = (LAS float*)(F.lds + SC_CB); LAS bf16_t* Gh = (LAS bf16_t*)(F.lds + SC_G);
    LAS bf16_t* YS = (LAS bf16_t*)(F.lds + SC_YS); LAS bf16_t* STS = (LAS bf16_t*)(F.lds + SC_STS);
    LAS bf16_t* XSD = (LAS bf16_t*)(F.lds + SC_XSD); LAS float* DT = (LAS float*)(F.lds + SC_DT); LAS float* AC = (LAS float*)(F.lds + SC_AC);
    bf16_t* XBC = (bf16_t*)(F.ws + WS_XBC); const bf16_t* HX = (const bf16_t*)(F.ws + WS_HX); const float* Ff = (const float*)(F.ws + WS_F);
    bf16_t* Cbuf = (bf16_t*)(F.ws + WS_CB); float* ECUM = (float*)(F.ws + WS_ECUM); float* CDEC = (float*)(F.ws + WS_CDEC); bf16_t* YD = (bf16_t*)(F.ws + WS_YD);
    const float* convw = INP(I_CONVW) + (size_t)l * 4 * 1024; const float* convb = INP(I_CONVB) + l * 1024;
    const float* dtb = INP(I_DTB) + l * 8; const float* alog = INP(I_ALOG) + l * 8; const float* dskip = INP(I_DSKIP) + l * 8;
    const int tid = F.tid, lane = F.lane, wave = F.wave;
    for (int c = F.bid; c < NCHK; c += F.G) {
        const int m0 = 64 * c; const bool first = (c & 127) == 0;
        {
            const int t = lane;
            { const int h = wave;
                const float raw = Ff[(size_t)(m0 + t) * 144 + 128 + h] + dtb[h];
                const float dt = raw > 20.f ? raw : log1pf(expf(raw));
                float v = dt * (-expf(alog[h]));
#pragma unroll
                for (int o = 1; o < 64; o <<= 1) { const float y = __shfl_up(v, o); if (lane >= o) v += y; }
                DT[h * 64 + t] = dt; AC[h * 64 + t] = v;
                const float ev = expf(v); ECUM[(size_t)(c * 8 + h) * 64 + t] = ev; if (t == 63) CDEC[c * 8 + h] = ev;
            }
        }
        for (int g = 0; g < 2; ++g) {
            if (!(VAR & 1)) {
                const int cgp = tid & 63, rg = tid >> 6, col = ssd_win_col(g, 8 * cgp), t0 = 8 * rg;
                u32x4 xr[11];
#pragma unroll
                for (int i = 0; i < 11; ++i) { const int t = t0 - 3 + i;
                    if (t >= 0) xr[i] = *(const u32x4*)(XBC + (size_t)(m0 + t) * 1024 + col);
                    else if (!first) xr[i] = *(const u32x4*)(HX + (size_t)((c - 1) * 3 + i) * 1024 + col);
                    else xr[i] = (u32x4){0u, 0u, 0u, 0u}; }
                float wv[4][8], bv8[8];
#pragma unroll
                for (int j = 0; j < 4; ++j) { const f32x4 a = *(const f32x4*)(convw + j * 1024 + col), b2 = *(const f32x4*)(convw + j * 1024 + col + 4);
                    wv[j][0] = a[0]; wv[j][1] = a[1]; wv[j][2] = a[2]; wv[j][3] = a[3]; wv[j][4] = b2[0]; wv[j][5] = b2[1]; wv[j][6] = b2[2]; wv[j][7] = b2[3]; }
                { const f32x4 a = *(const f32x4*)(convb + col), b2 = *(const f32x4*)(convb + col + 4); bv8[0] = a[0]; bv8[1] = a[1]; bv8[2] = a[2]; bv8[3] = a[3]; bv8[4] = b2[0]; bv8[5] = b2[1]; bv8[6] = b2[2]; bv8[7] = b2[3]; }
                float y[8][8];
#pragma unroll
                for (int e = 0; e < 8; ++e) {
                    const unsigned x0[4] = {xr[e].x, xr[e].y, xr[e].z, xr[e].w}, x1[4] = {xr[e + 1].x, xr[e + 1].y, xr[e + 1].z, xr[e + 1].w}, x2[4] = {xr[e + 2].x, xr[e + 2].y, xr[e + 2].z, xr[e + 2].w}, x3[4] = {xr[e + 3].x, xr[e + 3].y, xr[e + 3].z, xr[e + 3].w};
#pragma unroll
                    for (int k = 0; k < 8; ++k) { const int q = k >> 1;
                        const float a0 = (k & 1) ? bfhi(x0[q]) : bflo(x0[q]), a1 = (k & 1) ? bfhi(x1[q]) : bflo(x1[q]), a2 = (k & 1) ? bfhi(x2[q]) : bflo(x2[q]), a3 = (k & 1) ? bfhi(x3[q]) : bflo(x3[q]);
                        y[e][k] = siluf_(wv[0][k] * a0 + wv[1][k] * a1 + wv[2][k] * a2 + wv[3][k] * a3 + bv8[k]); } }
                if (cgp >= 32) { LAS bf16_t* nat = (cgp < 48) ? Bg + 8 * (cgp - 32) : Cg + 8 * (cgp - 48);
#pragma unroll
                    for (int e = 0; e < 8; ++e) { u32x4 o; o.x = pk2(y[e][0], y[e][1]); o.y = pk2(y[e][2], y[e][3]); o.z = pk2(y[e][4], y[e][5]); o.w = pk2(y[e][6], y[e][7]); *(LAS u32x4*)(nat + (t0 + e) * 136) = o; } }
                if (cgp < 48) { LAS bf16_t* trn = (cgp < 32) ? XST + (8 * cgp) * 72 : BT + (8 * (cgp - 32)) * 72;
#pragma unroll
                    for (int k = 0; k < 8; ++k) { u32x4 o; o.x = pk2(y[0][k], y[1][k]); o.y = pk2(y[2][k], y[3][k]); o.z = pk2(y[4][k], y[5][k]); o.w = pk2(y[6][k], y[7][k]); *(LAS u32x4*)(trn + k * 72 + t0) = o; } }
            }
            __syncthreads();
#pragma unroll
            for (int i = 0; i < 2; ++i) { const int idx = tid + 512 * i, t = idx >> 4, c8 = idx & 15;
                *(u32x4*)(Cbuf + (size_t)(m0 + t) * 256 + g * 128 + c8 * 8) = *(const LAS u32x4*)(Cg + t * 136 + c8 * 8); }
#pragma unroll
            for (int i = 0; i < 2; ++i) { const int idx = 2 * wave + i, ti = idx >> 2, si = idx & 3;
                const f32x4 acc = mma_tile<128>(Cg + ti * 16 * 136, 136, Bg + si * 16 * 136, 136, lane);
#pragma unroll
                for (int r = 0; r < 4; ++r) CB[(ti * 16 + 4 * (lane >> 4) + r) * 68 + si * 16 + (lane & 15)] = acc[r]; }
            __syncthreads();
            if (!(VAR & 2)) {
                const int hl = wave >> 1, hf = wave & 1, h = 4 * g + hl, fr = lane & 15, fk = lane >> 4;
                const LAS float* ACh = AC + h * 64; const LAS float* DTh = DT + h * 64; const float a63 = ACh[63], dsk = dskip[h];
#pragma unroll
                for (int ti2 = 0; ti2 < 2; ++ti2) { const int ti = 2 * hf + ti2, t = 16 * ti + fr; const float at = ACh[t];
                    bf16x8 ga[2];
#pragma unroll
                    for (int ks = 0; ks < 2; ++ks) { const int s0 = 32 * ks + 8 * fk;
                        const f32x4 c0 = *(const LAS f32x4*)(CB + t * 68 + s0), c1 = *(const LAS f32x4*)(CB + t * 68 + s0 + 4), a0 = *(const LAS f32x4*)(ACh + s0), a1 = *(const LAS f32x4*)(ACh + s0 + 4), d0 = *(const LAS f32x4*)(DTh + s0), d1 = *(const LAS f32x4*)(DTh + s0 + 4);
                        float gv[8];
#pragma unroll
                        for (int j = 0; j < 4; ++j) { gv[j] = (s0 + j <= t) ? c0[j] * __expf(at - a0[j]) * d0[j] : 0.f; gv[4 + j] = (s0 + 4 + j <= t) ? c1[j] * __expf(at - a1[j]) * d1[j] : 0.f; }
                        u32x4 w; w.x = pk2(gv[0], gv[1]); w.y = pk2(gv[2], gv[3]); w.z = pk2(gv[4], gv[5]); w.w = pk2(gv[6], gv[7]); ga[ks] = __builtin_bit_cast(bf16x8, w); }
#pragma unroll
                    for (int pi = 0; pi < 4; ++pi) { f32x4 acc = {0.f, 0.f, 0.f, 0.f};
#pragma unroll
                        for (int ks = 0; ks < 2; ++ks) acc = __builtin_amdgcn_mfma_f32_16x16x32_bf16(ga[ks], *(const LAS bf16x8*)(XST + (64 * hl + 16 * pi + fr) * 72 + 32 * ks + 8 * fk), acc, 0, 0, 0);
#pragma unroll
                        for (int r = 0; r < 4; ++r) { const int tt = 16 * ti + 4 * fk + r, pp = 16 * pi + fr;
                            YD[(size_t)(m0 + tt) * 512 + 64 * h + pp] = (bf16_t)f2bf(acc[r] + dsk * bf2f(XST[(64 * hl + pp) * 72 + tt])); } }
                }
                {   float fac[2][8];
#pragma unroll
                    for (int ks = 0; ks < 2; ++ks) { const int s0 = 32 * ks + 8 * fk; const f32x4 a0 = *(const LAS f32x4*)(ACh + s0), a1 = *(const LAS f32x4*)(ACh + s0 + 4), d0 = *(const LAS f32x4*)(DTh + s0), d1 = *(const LAS f32x4*)(DTh + s0 + 4);
#pragma unroll
                        for (int j = 0; j < 4; ++j) { fac[ks][j] = d0[j] * __expf(a63 - a0[j]); fac[ks][4 + j] = d1[j] * __expf(a63 - a1[j]); } }
#pragma unroll
                    for (int pi2 = 0; pi2 < 2; ++pi2) { const int pi = 2 * hf + pi2; bf16x8 xa[2];
#pragma unroll
                        for (int ks = 0; ks < 2; ++ks) { const u32x4 xw = *(const LAS u32x4*)(XST + (64 * hl + 16 * pi + fr) * 72 + 32 * ks + 8 * fk);
                            u32x4 w; w.x = pk2(bflo(xw.x) * fac[ks][0], bfhi(xw.x) * fac[ks][1]); w.y = pk2(bflo(xw.y) * fac[ks][2], bfhi(xw.y) * fac[ks][3]); w.z = pk2(bflo(xw.z) * fac[ks][4], bfhi(xw.z) * fac[ks][5]); w.w = pk2(bflo(xw.w) * fac[ks][6], bfhi(xw.w) * fac[ks][7]);
                            xa[ks] = __builtin_bit_cast(bf16x8, w); }
#pragma unroll
                        for (int ni = 0; ni < 8; ++ni) { f32x4 acc = {0.f, 0.f, 0.f, 0.f};
#pragma unroll
                            for (int ks = 0; ks < 2; ++ks) acc = __builtin_amdgcn_mfma_f32_16x16x32_bf16(xa[ks], *(const LAS bf16x8*)(BT + (16 * ni + fr) * 72 + 32 * ks + 8 * fk), acc, 0, 0, 0);
#pragma unroll
                            for (int r = 0; r < 4; ++r) { const int pp = 16 * pi + 4 * fk + r, n = 16 * ni + fr; const int f = hl * 8192 + pp * 128 + n, wr = f >> 9, col = ssd_win_col(g, f & 511);
                                XBC[(size_t)(m0 + wr) * 1024 + col] = (bf16_t)f2bf(acc[r]); } }
                    }
                }
            }
            __syncthreads();
        }
    }
}

template <int VAR = 0> __device__ __forceinline__ void p3c_rwkv(const Ctx& F, int l) {
    constexpr int M9 = 9216, O_TW = 0, O_AL = 9216, O_SL = 18432, O_MAB = O_SL + 12 * M9  , O_LWF = O_SL + 10 * M9  , O_ICF = O_LWF + 17408, O_WL = O_MAB + 16640  , O_SCR = O_WL + 256, O_PAR = O_SCR + 4224  ;
    static_assert(O_ICF + 17408 <= O_MAB + 16640 && O_PAR + 2048 <= LDS_BYTES - 256, "rwkv lds map");
#define LB() ({ LAS unsigned char* p_ = F.lds; asm volatile("" : "+s"(p_)); p_; })
#define SLOT(i) ((LAS bf16_t*)(L + O_SL + (i) * M9))
#define TW ((LAS bf16_t*)(L + O_TW))
#define AL ((LAS bf16_t*)(L + O_AL))
#define AT SLOT(0)
#define ATt SLOT(1)
#define BTl SLOT(2)
#define KTl SLOT(3)
#define RT SLOT(4)
#define BHt SLOT(5)
#define KH SLOT(6)
#define VT SLOT(7)
#define MI SLOT(8)
#define MakT SLOT(9)
#define Rb SLOT(10)
#define Rk SLOT(11)
#define Attn SLOT(0)
#define KEt SLOT(1)
#define X1t SLOT(2)
#define X2t SLOT(3)
#define S8 SLOT(8)
#define S9 SLOT(9)
#define MAB ((LAS float*)(L + O_MAB))
#define LWf ((LAS float*)(L + O_LWF))
#define ICf ((LAS float*)(L + O_ICF))
#define WL ((LAS float*)(L + O_WL))
#define SCR ((LAS float*)(L + O_SCR))
#define PAR ((LAS float*)(L + O_PAR))
    const int tid = F.tid, lane = F.lane, wave = F.wave;
    for (int c = F.bid; c < NCHK; c += F.G) {
        const int m0 = 64 * c; const bool first = (c & 127) == 0;
        {
            LAS unsigned char* L = LB();
            const int t = tid >> 3, q0 = (tid & 7) * 8;
            const float* Ff = (const float*)(F.ws + WS_F); const float* HF = (const float*)(F.ws + WS_HF); const float* mu_w = INP(I_MUW) + l * 64; const float* mu_a = INP(I_MUA) + l * 64;
            float cw[8], pw[8], ca[8], pa[8];
            const float* cur = Ff + (size_t)(m0 + t) * 144; const float* prv = (t > 0) ? cur - 144 : HF + (size_t)(c - 1) * 128;
#pragma unroll
            for (int j = 0; j < 8; ++j) { cw[j] = cur[q0 + j]; ca[j] = cur[64 + q0 + j]; }
            if (t > 0) {
#pragma unroll
                for (int j = 0; j < 8; ++j) { pw[j] = prv[q0 + j]; pa[j] = prv[64 + q0 + j]; }
            } else if (!first) {
#pragma unroll
                for (int j = 0; j < 8; ++j) { pw[j] = prv[q0 + j]; pa[j] = prv[64 + q0 + j]; }
            } else {
#pragma unroll
                for (int j = 0; j < 8; ++j) { pw[j] = 0.f; pa[j] = 0.f; }
            }
            float ow[8], oa[8];
#pragma unroll
            for (int j = 0; j < 8; ++j) { ow[j] = tanhf(cw[j] + (pw[j] - cw[j]) * mu_w[q0 + j]); oa[j] = ca[j] + (pa[j] - ca[j]) * mu_a[q0 + j]; }
            u32x4 o; o.x = pk2(ow[0], ow[1]); o.y = pk2(ow[2], ow[3]); o.z = pk2(ow[4], ow[5]); o.w = pk2(ow[6], ow[7]); *(LAS u32x4*)(TW + t * 72 + q0) = o;
            o.x = pk2(oa[0], oa[1]); o.y = pk2(oa[2], oa[3]); o.z = pk2(oa[4], oa[5]); o.w = pk2(oa[6], oa[7]); *(LAS u32x4*)(AL + t * 72 + q0) = o;
        }
        u32x4 nlw, nla; float npar;
        auto head_fetch = [&](int h_, int tid_) { const int row = tid_ >> 3, c8 = tid_ & 7; const bf16_t* WLW = (const bf16_t*)(F.ws + WS_WLW); const bf16_t* WLA = (const bf16_t*)(F.ws + WS_WLA);
            nlw = *(const u32x4*)(WLW + (size_t)(h_ * 64 + row) * 64 + c8 * 8); nla = *(const u32x4*)(WLA + (size_t)(h_ * 64 + row) * 64 + c8 * 8);
            const int pi = tid_ >> 6, pc = tid_ & 63;
            const float* src = (pi < 3) ? INP(I_MURKV) + (size_t)l * 1536 + pi * 512 : (pi == 3) ? INP(I_KK) + l * 512 : (pi == 4) ? INP(I_KA) + l * 512 : (pi == 5) ? INP(I_RK) + l * 512 : (pi == 6) ? INP(I_W0) + l * 512 : INP(I_A0) + l * 512;
            npar = src[h_ * 64 + pc]; };
        head_fetch(0, F.tid);
        for (int h = 0; h < 8; ++h) {
            int tid = F.tid, lane = F.lane; asm volatile("" : "+v"(tid), "+v"(lane));
            const int t1 = tid >> 3, ch0 = (tid & 7) * 8, col1 = h * 64 + ch0;
            u32x4 rw, kw, vw, rp = {0u, 0u, 0u, 0u}, kp = rp, vp = rp;
            {   const bf16_t* Rg = (const bf16_t*)(F.ws + WS_R); const bf16_t* Kg = (const bf16_t*)(F.ws + WS_K); const bf16_t* Vg = (const bf16_t*)(F.ws + WS_V); const bf16_t* HR = (const bf16_t*)(F.ws + WS_HRKV);
                const size_t off = (size_t)(m0 + t1) * 512 + col1;
                rw = *(const u32x4*)(Rg + off); kw = *(const u32x4*)(Kg + off); vw = *(const u32x4*)(Vg + off);
                if (t1 > 0) { rp = *(const u32x4*)(Rg + off - 512); kp = *(const u32x4*)(Kg + off - 512); vp = *(const u32x4*)(Vg + off - 512); }
                else if (!first) { const size_t ho = (size_t)(c - 1) * 512 + col1; rp = *(const u32x4*)(HR + ho); kp = *(const u32x4*)(HR + (size_t)NCHK * 512 + ho); vp = *(const u32x4*)(HR + (size_t)2 * NCHK * 512 + ho); } }
            {   LAS unsigned char* L = LB(); const int row = tid >> 3, c8 = tid & 7;
                *(LAS u32x4*)(S8 + row * 72 + c8 * 8) = nlw; *(LAS u32x4*)(S9 + row * 72 + c8 * 8) = nla; PAR[(tid >> 6) * 64 + (tid & 63)] = npar; }
            if (h < 7) head_fetch(h + 1, tid);
            __syncthreads();
            if (!(VAR & 16)) {   LAS unsigned char* L = LB(); const int which = wave >> 2, ci = wave & 3, ch = ci * 16 + (lane & 15), g4 = lane >> 4;
                const float bias = PAR[(6 + which) * 64 + ch]; float carry = 0.f;
#pragma unroll
                for (int ti = 0; ti < 4; ++ti) {
                    const f32x4 acc = mma_tile<64>((which ? AL : TW) + ti * 16 * 72, 72, (which ? S9 : S8) + ci * 16 * 72, 72, lane);
                    if (which == 0) {
                        float a[4];
#pragma unroll
                        for (int r = 0; r < 4; ++r) a[r] = -DECAY_SCALE * sigmoidf_(acc[r] + bias);
                        a[1] += a[0]; a[2] += a[1]; a[3] += a[2];
                        float tot = a[3]; const float u1 = __shfl_up(tot, 16); if (g4 >= 1) tot += u1; const float u2 = __shfl_up(tot, 32); if (g4 >= 2) tot += u2;
                        const float base = carry + tot - a[3];
#pragma unroll
                        for (int r = 0; r < 4; ++r) LWf[(ti * 16 + 4 * g4 + r) * 68 + ch] = base + a[r];
                        carry += __shfl(tot, 48 + (lane & 15));
                    } else {
#pragma unroll
                        for (int r = 0; r < 4; ++r) ICf[(ti * 16 + 4 * g4 + r) * 68 + ch] = sigmoidf_(acc[r] + bias);
                    }
                }
                if (which == 0 && g4 == 0) WL[ch] = __expf(carry);
            }
            __syncthreads();
            float bonv[8] = {0.f, 0.f, 0.f, 0.f, 0.f, 0.f, 0.f, 0.f};
            if (!(VAR & 2)) {   LAS unsigned char* L = LB(); const int t = t1;
                const unsigned rwa[4] = {rw.x, rw.y, rw.z, rw.w}, kwa[4] = {kw.x, kw.y, kw.z, kw.w}, vwa[4] = {vw.x, vw.y, vw.z, vw.w};
                const unsigned rpa[4] = {rp.x, rp.y, rp.z, rp.w}, kpa[4] = {kp.x, kp.y, kp.z, kp.w}, vpa[4] = {vp.x, vp.y, vp.z, vp.w};
                float rs[8], ks[8], vs[8], kkv[8], k2[8], ic[8]; float ss = 0.f, bs = 0.f;
                float pr_[6][8], lwt[8], lwp[8], l63[8];
#pragma unroll
                for (int q = 0; q < 6; ++q) { const f32x4 a = *(const LAS f32x4*)(PAR + q * 64 + ch0), b = *(const LAS f32x4*)(PAR + q * 64 + ch0 + 4);
                    pr_[q][0] = a[0]; pr_[q][1] = a[1]; pr_[q][2] = a[2]; pr_[q][3] = a[3]; pr_[q][4] = b[0]; pr_[q][5] = b[1]; pr_[q][6] = b[2]; pr_[q][7] = b[3]; }
                {   const f32x4 a = *(const LAS f32x4*)(ICf + t * 68 + ch0), b = *(const LAS f32x4*)(ICf + t * 68 + ch0 + 4); ic[0] = a[0]; ic[1] = a[1]; ic[2] = a[2]; ic[3] = a[3]; ic[4] = b[0]; ic[5] = b[1]; ic[6] = b[2]; ic[7] = b[3];
                    const f32x4 c0 = *(const LAS f32x4*)(LWf + t * 68 + ch0), c1 = *(const LAS f32x4*)(LWf + t * 68 + ch0 + 4); lwt[0] = c0[0]; lwt[1] = c0[1]; lwt[2] = c0[2]; lwt[3] = c0[3]; lwt[4] = c1[0]; lwt[5] = c1[1]; lwt[6] = c1[2]; lwt[7] = c1[3];
                    const int tp = (t > 0) ? t - 1 : 0; const f32x4 d0 = *(const LAS f32x4*)(LWf + tp * 68 + ch0), d1 = *(const LAS f32x4*)(LWf + tp * 68 + ch0 + 4); const float pm_ = (t > 0) ? 1.f : 0.f;
                    lwp[0] = d0[0] * pm_; lwp[1] = d0[1] * pm_; lwp[2] = d0[2] * pm_; lwp[3] = d0[3] * pm_; lwp[4] = d1[0] * pm_; lwp[5] = d1[1] * pm_; lwp[6] = d1[2] * pm_; lwp[7] = d1[3] * pm_;
                    const f32x4 e0 = *(const LAS f32x4*)(LWf + 63 * 68 + ch0), e1 = *(const LAS f32x4*)(LWf + 63 * 68 + ch0 + 4); l63[0] = e0[0]; l63[1] = e0[1]; l63[2] = e0[2]; l63[3] = e0[3]; l63[4] = e1[0]; l63[5] = e1[1]; l63[6] = e1[2]; l63[7] = e1[3]; }
#pragma unroll
                for (int j = 0; j < 8; ++j) { const int q = j >> 1;
                    const float r_ = (j & 1) ? bfhi(rwa[q]) : bflo(rwa[q]), rq = (j & 1) ? bfhi(rpa[q]) : bflo(rpa[q]);
                    const float k_ = (j & 1) ? bfhi(kwa[q]) : bflo(kwa[q]), kq = (j & 1) ? bfhi(kpa[q]) : bflo(kpa[q]);
                    const float v_ = (j & 1) ? bfhi(vwa[q]) : bflo(vwa[q]), vq = (j & 1) ? bfhi(vpa[q]) : bflo(vpa[q]);
                    rs[j] = r_ + (rq - r_) * pr_[0][j]; ks[j] = k_ + (kq - k_) * pr_[1][j]; vs[j] = v_ + (vq - v_) * pr_[2][j];
                    kkv[j] = ks[j] * pr_[3][j]; ss += kkv[j] * kkv[j];
                    k2[j] = ks[j] * (1.f + (ic[j] - 1.f) * pr_[4][j]); bs += rs[j] * k2[j] * pr_[5][j]; }
                ss += __shfl_xor(ss, 1); ss += __shfl_xor(ss, 2); ss += __shfl_xor(ss, 4);
                bs += __shfl_xor(bs, 1); bs += __shfl_xor(bs, 2); bs += __shfl_xor(bs, 4);
                const float inv = __builtin_amdgcn_rsqf(fmaxf(ss, 1e-24f));
                float vAT[8], vB[8], vK[8], vR[8], vBH[8], vKH[8];
#pragma unroll
                for (int j = 0; j < 8; ++j) { const int ch = ch0 + j;
                    const float LWt = lwt[j], LWp = lwp[j], L63 = l63[j];
                    const float kk = kkv[j] * inv, a = -kk, b = kk * ic[j];
                    const float e1 = __expf(LWt), e2 = __expf(-LWt), e3 = __expf(LWp), e4 = __expf(L63 - LWt);
                    vAT[j] = a * e3; vB[j] = b * e2; vK[j] = k2[j] * e2; vR[j] = rs[j] * e1; vBH[j] = b * e4; vKH[j] = k2[j] * e4; bonv[j] = bs * vs[j];
                    (void)ch; }
                u32x4 o;
#define PK8(A_) (o[0] = pk2(A_[0], A_[1]), o[1] = pk2(A_[2], A_[3]), o[2] = pk2(A_[4], A_[5]), o[3] = pk2(A_[6], A_[7]), o)
                *(LAS u32x4*)(AT + t * 72 + ch0) = PK8(vAT); *(LAS u32x4*)(BTl + t * 72 + ch0) = PK8(vB); *(LAS u32x4*)(KTl + t * 72 + ch0) = PK8(vK);
                *(LAS u32x4*)(RT + t * 72 + ch0) = PK8(vR); *(LAS u32x4*)(KH + t * 72 + ch0) = PK8(vKH); *(LAS u32x4*)(BHt + t * 72 + ch0) = PK8(vBH); *(LAS u32x4*)(VT + t * 72 + ch0) = PK8(vs);
            }
            __syncthreads();
            { u32x4 o; *(u32x4*)((bf16_t*)(F.ws + WS_V) + (size_t)(m0 + t1) * 512 + col1) = PK8(bonv); }
            if (!(VAR & 8)) { LAS unsigned char* L = LB();
                auto run2 = [&](auto PT) { constexpr int p = decltype(PT)::value;
                    f32x4 acc[8];
#pragma unroll
                    for (int i = 0; i < 8; ++i) { const int idx = 8 * (wave & 1) + i, ti = idx >> 2, si = idx & 3;
                        acc[i] = mma_tile<64>(((p < 2) ? AT : RT) + ti * 16 * 72, 72, ((p & 1) ? KTl : BTl) + si * 16 * 72, 72, lane); }
#pragma unroll
                    for (int i = 0; i < 8; ++i) { const int idx = 8 * (wave & 1) + i, ti = idx >> 2, si = idx & 3;
#pragma unroll
                        for (int r = 0; r < 4; ++r) { const int t = ti * 16 + 4 * (lane >> 4) + r, s = si * 16 + (lane & 15);
                            if (p == 0) MAB[t * 65 + s] = (s < t) ? acc[i][r] : 0.f;
                            else if (p == 1) MakT[s * 72 + t] = (bf16_t)f2bf((s < t) ? acc[i][r] : 0.f);
                            else if (p == 2) Rb[t * 72 + s] = (bf16_t)f2bf((s <= t) ? acc[i][r] : 0.f);
                            else Rk[t * 72 + s] = (bf16_t)f2bf((s <= t) ? acc[i][r] : 0.f); } } };
                const int pw = wave >> 1;
                if (pw == 0) run2(IC<0>{}); else if (pw == 1) run2(IC<1>{}); else if (pw == 2) run2(IC<2>{}); else run2(IC<3>{}); }
            __syncthreads();
            if (!(VAR & 1)) {
            if (wave < 4 && lane < 16) { LAS unsigned char* L = LB(); const int b0 = 16 * wave; float x[16];
#pragma unroll
                for (int t = 0; t < 16; ++t) { float v = (t == lane) ? 1.f : 0.f;
#pragma unroll
                    for (int s = 0; s < 16; ++s) if (s < t) v += MAB[(b0 + t) * 65 + b0 + s] * x[s];
                    x[t] = v; }
#pragma unroll
                for (int t = 0; t < 16; ++t) MAB[(b0 + t) * 65 + b0 + lane] = x[t]; }
            __syncthreads();
            if (wave < 2) { LAS unsigned char* L = LB(); const int pr = wave, rb = pr ? 48 : 16, cb = pr ? 32 : 0, fr = lane & 15, fk = lane >> 4; f32x4 acc = {0.f, 0.f, 0.f, 0.f};
#pragma unroll
                for (int ks = 0; ks < 4; ++ks) acc = __builtin_amdgcn_mfma_f32_16x16x4f32(MAB[(rb + fr) * 65 + cb + 4 * ks + fk], MAB[(cb + 4 * ks + fk) * 65 + cb + fr], acc, 0, 0, 0);
#pragma unroll
                for (int r = 0; r < 4; ++r) SCR[(pr * 16 + 4 * fk + r) * 33 + fr] = acc[r]; }
            __syncthreads();
            if (wave < 2) { LAS unsigned char* L = LB(); const int pr = wave, rb = pr ? 48 : 16, cb = pr ? 32 : 0, fr = lane & 15, fk = lane >> 4; f32x4 acc = {0.f, 0.f, 0.f, 0.f};
#pragma unroll
                for (int ks = 0; ks < 4; ++ks) acc = __builtin_amdgcn_mfma_f32_16x16x4f32(MAB[(rb + fr) * 65 + rb + 4 * ks + fk], SCR[(pr * 16 + 4 * ks + fk) * 33 + fr], acc, 0, 0, 0);
#pragma unroll
                for (int r = 0; r < 4; ++r) MAB[(rb + 4 * fk + r) * 65 + cb + fr] = acc[r]; }
            __syncthreads();
            if (wave < 4) { LAS unsigned char* L = LB(); const int ti = wave >> 1, ci = wave & 1, fr = lane & 15, fk = lane >> 4; f32x4 acc = {0.f, 0.f, 0.f, 0.f};
#pragma unroll
                for (int ks = 0; ks < 8; ++ks) acc = __builtin_amdgcn_mfma_f32_16x16x4f32(MAB[(32 + 16 * ti + fr) * 65 + 4 * ks + fk], MAB[(4 * ks + fk) * 65 + 16 * ci + fr], acc, 0, 0, 0);
#pragma unroll
                for (int r = 0; r < 4; ++r) SCR[(16 * ti + 4 * fk + r) * 33 + 16 * ci + fr] = acc[r]; }
            __syncthreads();
            if (wave < 4) { LAS unsigned char* L = LB(); const int ti = wave >> 1, ci = wave & 1, fr = lane & 15, fk = lane >> 4; f32x4 acc = {0.f, 0.f, 0.f, 0.f};
#pragma unroll
                for (int ks = 0; ks < 8; ++ks) acc = __builtin_amdgcn_mfma_f32_16x16x4f32(MAB[(32 + 16 * ti + fr) * 65 + 32 + 4 * ks + fk], SCR[(4 * ks + fk) * 33 + 16 * ci + fr], acc, 0, 0, 0);
#pragma unroll
                for (int r = 0; r < 4; ++r) MAB[(32 + 16 * ti + 4 * fk + r) * 65 + 16 * ci + fr] = acc[r]; }
            __syncthreads();
            {   LAS unsigned char* L = LB(); const int t = tid >> 3, s0 = (tid & 7) * 8; float x[8];
#pragma unroll
                for (int j = 0; j < 8; ++j) x[j] = MAB[t * 65 + s0 + j];
                u32x4 o; *(LAS u32x4*)(MI + t * 72 + s0) = PK8(x); }
            __syncthreads();
            }
            if (!(VAR & 4)) { LAS unsigned char* L = LB();
#pragma unroll
            for (int i = 0; i < 4; ++i) { const int idx = 4 * wave + i, ti = (idx >> 2) & 3, ci = idx & 3; LAS bf16_t* osel = (wave >> 2) ? X2t : X1t;
                const f32x4 acc = (wave >> 2) ? mma_tile<64>(MI + ti * 16 * 72, 72, MakT + ci * 16 * 72, 72, lane) : mma_tile2<64, false, true>(MI, 72, ti * 16, AT, 72, ci * 16, lane);
#pragma unroll
                for (int r = 0; r < 4; ++r) { const int t = ti * 16 + 4 * (lane >> 4) + r, j = ci * 16 + (lane & 15); osel[j * 72 + t] = (bf16_t)f2bf(acc[r]); } } }
            __syncthreads();
            if (!(VAR & 4)) { LAS unsigned char* L = LB();
                auto run5 = [&](auto PT) { constexpr int p = decltype(PT)::value;
                    f32x4 acc[8];
#pragma unroll
                    for (int i = 0; i < 8; ++i) { const int idx = 8 * (wave & 1) + i, ti = idx >> 2, si = idx & 3;
                        if constexpr (p < 2) acc[i] = mma_tile<64>(Rb + ti * 16 * 72, 72, ((p == 0) ? X1t : X2t) + si * 16 * 72, 72, lane);
                        else acc[i] = mma_tile2<64, false, true>((p == 2) ? X1t : X2t, 72, ti * 16, BHt, 72, si * 16, lane);
#pragma unroll
                        for (int r = 0; r < 4; ++r) { const int rw = ti * 16 + 4 * (lane >> 4) + r, cl = si * 16 + (lane & 15);
                            acc[i][r] += (p == 0) ? bf2f(RT[rw * 72 + cl]) : (p == 1) ? bf2f(Rk[rw * 72 + cl]) : (p == 2) ? ((rw == cl) ? WL[rw] : 0.f) : bf2f(KH[rw * 72 + cl]); } }
#pragma unroll
                    for (int i = 0; i < 8; ++i) { const int idx = 8 * (wave & 1) + i, ti = idx >> 2, si = idx & 3;
#pragma unroll
                        for (int r = 0; r < 4; ++r) { const int rw = ti * 16 + 4 * (lane >> 4) + r, cl = si * 16 + (lane & 15);
                            if (p == 0) SLOT(8)[rw * 64 + pi16(cl)] = (bf16_t)f2bf(acc[i][r]);
                            else if (p == 1) Attn[rw * 72 + cl] = (bf16_t)f2bf(acc[i][r]);
                            else if (p == 2) SLOT(9)[cl * 64 + pi16(rw)] = (bf16_t)f2bf(acc[i][r]);
                            else KEt[cl * 72 + rw] = (bf16_t)f2bf(acc[i][r]); } } };
                const int pw = wave >> 1;
                if (pw == 0) run5(IC<0>{}); else if (pw == 1) run5(IC<1>{}); else if (pw == 2) run5(IC<2>{}); else run5(IC<3>{}); }
            __syncthreads();
            {   LAS unsigned char* L = LB();
                *(u32x4*)((bf16_t*)(F.ws + WS_QE) + (size_t)(c * 8 + h) * 4096 + tid * 8) = *(const LAS u32x4*)(SLOT(8) + tid * 8);
                *(u32x4*)((bf16_t*)(F.ws + WS_TT) + (size_t)(c * 8 + h) * 4096 + tid * 8) = *(const LAS u32x4*)(SLOT(9) + tid * 8); }
            LAS unsigned char* L = LB();
#pragma unroll
            for (int i = 0; i < 4; ++i) { const int idx = 4 * wave + i, which = wave >> 2, ti = (idx >> 2) & 3, ci = idx & 3;
                const f32x4 acc = which ? mma_tile2<64, true, false>(VT, 72, ti * 16, KEt, 72, ci * 16, lane) : mma_tile2<64, false, true>(Attn, 72, ti * 16, VT, 72, ci * 16, lane);
#pragma unroll
                for (int r = 0; r < 4; ++r) { const int rw = ti * 16 + 4 * (lane >> 4) + r, cl = ci * 16 + (lane & 15);
                    const int o = which ? rw * 64 + sg32(cl) : cl * 64 + sg32(rw);
                    (which ? SLOT(3) : SLOT(2))[o] = (bf16_t)f2bf(acc[r]); } }
            __syncthreads();
            {   const int row = tid >> 3, c8 = tid & 7;
                *(u32x4*)((bf16_t*)(F.ws + WS_K) + (size_t)(m0 + row) * 512 + h * 64 + c8 * 8) = *(const LAS u32x4*)(SLOT(2) + tid * 8);
                *(u32x4*)((bf16_t*)(F.ws + WS_R) + (size_t)(m0 + row) * 512 + h * 64 + c8 * 8) = *(const LAS u32x4*)(SLOT(3) + tid * 8); }
        }
        __syncthreads();
    }
#undef SLOT
#undef PK8
#undef LB
#undef TW
#undef AL
#undef AT
#undef ATt
#undef BTl
#undef KTl
#undef RT
#undef BHt
#undef KH
#undef VT
#undef MI
#undef MakT
#undef Rb
#undef Rk
#undef Attn
#undef KEt
#undef X1t
#undef X2t
#undef S8
#undef S9
#undef MAB
#undef LWf
#undef ICf
#undef WL
#undef SCR
#undef PAR
}

__device__ __forceinline__ bf16x8 cvt8(const f32x16& x, int s) {
    u32x4 w; w.x = pk2(x[8 * s + 0], x[8 * s + 1]); w.y = pk2(x[8 * s + 2], x[8 * s + 3]); w.z = pk2(x[8 * s + 4], x[8 * s + 5]); w.w = pk2(x[8 * s + 6], x[8 * s + 7]);
    return __builtin_bit_cast(bf16x8, w);
}
__device__ __forceinline__ f32x16 ld16bf(const bf16_t* p) {
    const u32x4 a = *(const u32x4*)p, b = *(const u32x4*)(p + 8); f32x16 r;
    r[0] = bflo(a.x); r[1] = bfhi(a.x); r[2] = bflo(a.y); r[3] = bfhi(a.y); r[4] = bflo(a.z); r[5] = bfhi(a.z); r[6] = bflo(a.w); r[7] = bfhi(a.w);
    r[8] = bflo(b.x); r[9] = bfhi(b.x); r[10] = bflo(b.y); r[11] = bfhi(b.y); r[12] = bflo(b.z); r[13] = bfhi(b.z); r[14] = bflo(b.w); r[15] = bfhi(b.w); return r;
}
__device__ __forceinline__ void st16bf(bf16_t* p, const f32x16& x) {
    u32x4 a, b; a.x = pk2(x[0], x[1]); a.y = pk2(x[2], x[3]); a.z = pk2(x[4], x[5]); a.w = pk2(x[6], x[7]); b.x = pk2(x[8], x[9]); b.y = pk2(x[10], x[11]); b.z = pk2(x[12], x[13]); b.w = pk2(x[14], x[15]);
    *(u32x4*)p = a; *(u32x4*)(p + 8) = b;
}
__device__ __forceinline__ float max3f(float a, float b, float c) { float r; asm("v_max3_f32 %0, %1, %2, %3" : "=v"(r) : "v"(a), "v"(b), "v"(c)); return r; }
__device__ __forceinline__ int ktile_off(int row, int ch) { return 3072 * (row >> 3) + 512 * (ch >> 2) + 64 * (row & 7) + 16 * ((ch & 3) ^ ((row >> 2) & 3)); }
constexpr int KTILE = 24576;
template <int VAR> __device__ __forceinline__ void attn_unit(const Ctx& F, int b, int c, int hp) {
    const int tid = F.tid, lane = F.lane, wave = F.wave, r32 = lane & 31, hi = lane >> 5, grp = wave >> 2, wq = wave & 3, head = 2 * hp + (wq >> 1);
    const bf16_t* Q = (const bf16_t*)(F.ws + WS_Q); const bf16_t* KV = (const bf16_t*)(F.ws + WS_KVB) + (size_t)b * SEQ * 192; bf16_t* OL = (bf16_t*)(F.ws + WS_OL);
    const size_t mq = (size_t)b * SEQ + 64 * c + 32 * (wq & 1) + r32;
    bf16x8 qr[12];
#pragma unroll
    for (int d0 = 0; d0 < 12; ++d0) qr[d0] = *(const bf16x8*)(Q + mq * 768 + head * 192 + 16 * d0 + 8 * hi);
    {
        const float* rp = (const float*)(F.ws + WS_ROPE) + mq * 64;
#pragma unroll
        for (int d0 = 8; d0 < 10; ++d0) { const int j0 = 16 * (d0 - 8) + 8 * hi;
            const f32x4 c0 = *(const f32x4*)(rp + j0), c1 = *(const f32x4*)(rp + j0 + 4), s0 = *(const f32x4*)(rp + 32 + j0), s1 = *(const f32x4*)(rp + 32 + j0 + 4);
            const u32x4 a = __builtin_bit_cast(u32x4, qr[d0]), bq = __builtin_bit_cast(u32x4, qr[d0 + 2]);
            const float x1[8] = {bflo(a.x), bfhi(a.x), bflo(a.y), bfhi(a.y), bflo(a.z), bfhi(a.z), bflo(a.w), bfhi(a.w)}, x2[8] = {bflo(bq.x), bfhi(bq.x), bflo(bq.y), bfhi(bq.y), bflo(bq.z), bfhi(bq.z), bflo(bq.w), bfhi(bq.w)};
            const float cs[8] = {c0[0], c0[1], c0[2], c0[3], c1[0], c1[1], c1[2], c1[3]}, sn[8] = {s0[0], s0[1], s0[2], s0[3], s1[0], s1[1], s1[2], s1[3]};
            float o1[8], o2[8];
#pragma unroll
            for (int e = 0; e < 8; ++e) { o1[e] = x1[e] * cs[e] - x2[e] * sn[e]; o2[e] = x1[e] * sn[e] + x2[e] * cs[e]; }
            u32x4 w1, w2; w1.x = pk2(o1[0], o1[1]); w1.y = pk2(o1[2], o1[3]); w1.z = pk2(o1[4], o1[5]); w1.w = pk2(o1[6], o1[7]); w2.x = pk2(o2[0], o2[1]); w2.y = pk2(o2[2], o2[3]); w2.z = pk2(o2[4], o2[5]); w2.w = pk2(o2[6], o2[7]);
            qr[d0] = __builtin_bit_cast(bf16x8, w1); qr[d0 + 2] = __builtin_bit_cast(bf16x8, w2); }
    }
    int goff[6];
#pragma unroll
    for (int i = 0; i < 6; ++i) { const int j = 6 * wave + i, q = j % 24, pbyte = 1024 * q + 16 * lane, sub = pbyte >> 9, rg = sub / 6, cgp = sub % 6, r7 = (pbyte >> 6) & 7, slot = (pbyte >> 4) & 3;
        const int row = 8 * rg + r7, ch = 4 * cgp + (slot ^ ((row >> 2) & 3)); goff[i] = (row * 192 + ch * 8) * 2 + (j / 24) * 64 * 192 * 2; }
    const int nt = c + 1, ns = (VAR & 64) ? 0 : (nt + 1) >> 1;
    const unsigned ldsb = (unsigned)(uintptr_t)F.lds;
#define ATT_STAGE(s_, par_) do { if ((6 * wave) / 24 == 0 || 2 * (s_) + 1 < nt) { const char* src_ = (const char*)KV + (size_t)(2 * (s_)) * 64 * 192 * 2; \
        _Pragma("unroll") for (int i = 0; i < 6; ++i) { const int j_ = 6 * wave + i; unsigned keep_; \
            asm volatile("s_mov_b32 %0, m0\n\ts_mov_b32 m0, %3\n\ts_nop 0\n\tglobal_load_lds_dwordx4 %1, %2\n\ts_mov_b32 m0, %0" : "=&s"(keep_) : "v"(goff[i]), "s"(src_), "s"(ldsb + (unsigned)(((par_) * 2 + j_ / 24) * KTILE + (j_ % 24) * 1024)) : "memory"); } } } while (0)
    (void)ldsb;
    ATT_STAGE(0, 0);
    asm volatile("s_waitcnt vmcnt(0)" ::: "memory");
    __syncthreads();
    f32x16 o[4];
#pragma unroll
    for (int d = 0; d < 4; ++d)
#pragma unroll
        for (int r = 0; r < 16; ++r) o[d][r] = 0.f;
    float mrun = -1e30f, lrun = 0.f;
    const int kx_ = (r32 >> 2) & 3, kbase = 3072 * (r32 >> 3) + 64 * (r32 & 7), koffE = kbase + 16 * (hi ^ kx_), koffO = kbase + 16 * ((2 + hi) ^ kx_);
    const int tq_ = (lane & 15) >> 2, tp_ = lane & 3, tgl_ = (lane >> 4) & 1, trb = 64 * (4 * hi + tq_) + 8 * (tp_ & 1);
    const int tro0 = trb + 16 * ((2 * tgl_ + (tp_ >> 1)) ^ (hi & 3)), tro1 = trb + 16 * ((2 * tgl_ + (tp_ >> 1)) ^ ((2 + hi) & 3)) + 3072;
    for (int s = 0; s < ns; ++s) {
        const bool more = (s + 1 < ns), more2 = (2 * s + 3 < nt);
        if (more && !(VAR & 1)) ATT_STAGE(s + 1, (s + 1) & 1);
        (void)more2;
        if (2 * s + grp < nt) {
            const LAS unsigned char* buf = F.lds + ((s & 1) * 2 + grp) * KTILE;
            f32x16 p0, p1, q0, q1;
#pragma unroll
            for (int r = 0; r < 16; ++r) { p0[r] = 0.f; p1[r] = 0.f; q0[r] = 0.f; q1[r] = 0.f; }
            bf16x8 ka[3][2];
            if (VAR & 32) {
#pragma unroll
                for (int q = 0; q < 3; ++q) { ka[q][0] = qr[q]; ka[q][1] = qr[q + 3]; } }
#define KLD(slot, d0) do { if (VAR & 32) { asm volatile("" : "+v"(ka[slot][0]), "+v"(ka[slot][1])); break; } ka[slot][0] = *(const LAS bf16x8*)(buf + (((d0) & 1) ? koffO : koffE) + 512 * ((d0) >> 1)); ka[slot][1] = *(const LAS bf16x8*)(buf + (((d0) & 1) ? koffO : koffE) + 12288 + 512 * ((d0) >> 1)); } while (0)
            KLD(0, 0); KLD(1, 1); KLD(2, 2);
#pragma unroll
            for (int d0 = 0; d0 < 12; ++d0) {
                __builtin_amdgcn_sched_barrier(0);
                if (VAR & 16) { if (d0 & 1) { q0 = __builtin_amdgcn_mfma_f32_32x32x16_bf16(ka[d0 % 3][0], qr[d0], q0, 0, 0, 0); q1 = __builtin_amdgcn_mfma_f32_32x32x16_bf16(ka[d0 % 3][1], qr[d0], q1, 0, 0, 0); } else { p0 = __builtin_amdgcn_mfma_f32_32x32x16_bf16(ka[d0 % 3][0], qr[d0], p0, 0, 0, 0); p1 = __builtin_amdgcn_mfma_f32_32x32x16_bf16(ka[d0 % 3][1], qr[d0], p1, 0, 0, 0); } }
                else if (!(VAR & 4)) { p0 = __builtin_amdgcn_mfma_f32_32x32x16_bf16(ka[d0 % 3][0], qr[d0], p0, 0, 0, 0); p1 = __builtin_amdgcn_mfma_f32_32x32x16_bf16(ka[d0 % 3][1], qr[d0], p1, 0, 0, 0); } else { asm volatile("" :: "v"(ka[d0 % 3][0]), "v"(ka[d0 % 3][1])); }
                __builtin_amdgcn_sched_barrier(0);
                if (d0 + 3 < 12) KLD(d0 % 3, d0 + 3);
            }
            __builtin_amdgcn_sched_barrier(0);
            if (VAR & 16) {
#pragma unroll
                for (int r = 0; r < 16; ++r) { p0[r] += q0[r]; p1[r] += q1[r]; } }
#undef KLD
            v4i16_t vl[2][4], vh[2][4];
#pragma unroll
            for (int db = 0; db < 4; ++db) { vl[0][db] = __builtin_amdgcn_ds_read_tr16_b64_v4i16((LAS v4i16_t*)(buf + tro0 + 512 * db)); vh[0][db] = __builtin_amdgcn_ds_read_tr16_b64_v4i16((LAS v4i16_t*)(buf + tro1 + 512 * db)); }
            float mx = max3f(p0[0], p1[0], p0[1]), my = max3f(p1[1], p0[2], p1[2]);
#pragma unroll
            for (int r = 3; r < 15; r += 2) { mx = max3f(mx, p0[r], p1[r]); my = max3f(my, p0[r + 1], p1[r + 1]); }
            mx = max3f(mx, my, fmaxf(p0[15], p1[15]));
            mx = fmaxf(mx, __shfl_xor(mx, 32));
            if (!(VAR & 8) && __any(mx > mrun + 8.f)) {
                const float mnew = fmaxf(mrun, mx), alpha = __builtin_amdgcn_exp2f(mrun - mnew); mrun = mnew; lrun *= alpha;
#pragma unroll
                for (int d = 0; d < 4; ++d)
#pragma unroll
                    for (int r = 0; r < 16; ++r) o[d][r] *= alpha;
            }
            float ls = 0.f;
#pragma unroll
            for (int r = 0; r < 16; ++r) { if (!(VAR & 8)) { p0[r] = __builtin_amdgcn_exp2f(p0[r] - mrun); p1[r] = __builtin_amdgcn_exp2f(p1[r] - mrun); } ls += p0[r] + p1[r]; }
            lrun += ls;
#pragma unroll
            for (int ks = 0; ks < 4; ++ks) {
                if (ks + 1 < 4) {
#pragma unroll
                    for (int db = 0; db < 4; ++db) {
                        vl[(ks + 1) & 1][db] = __builtin_amdgcn_ds_read_tr16_b64_v4i16((LAS v4i16_t*)(buf + tro0 + 6144 * (ks + 1) + 512 * db)); vh[(ks + 1) & 1][db] = __builtin_amdgcn_ds_read_tr16_b64_v4i16((LAS v4i16_t*)(buf + tro1 + 6144 * (ks + 1) + 512 * db)); }
                }
                const bf16x8 pb = (ks < 2) ? cvt8(p0, ks & 1) : cvt8(p1, ks & 1);
#pragma unroll
                for (int db = 0; db < 4; ++db) { const v4i16_t lo = vl[ks & 1][db], hh = vh[ks & 1][db];
                    const bf16x8 va = {lo[0], lo[1], lo[2], lo[3], hh[0], hh[1], hh[2], hh[3]};
                    if (!(VAR & 2)) o[db] = __builtin_amdgcn_mfma_f32_32x32x16_bf16(va, pb, o[db], 0, 0, 0); else asm volatile("" :: "v"(va), "v"(pb)); }
            }
        }
        asm volatile("s_waitcnt vmcnt(0)" ::: "memory");
        __syncthreads();
    }
#undef ATT_STAGE
    lrun += __shfl_xor(lrun, 32);
    LAS float* xb = (LAS float*)(F.lds + wq * (66 * 64 * 4));
    if (grp == 1) {
#pragma unroll
        for (int d = 0; d < 4; ++d)
#pragma unroll
            for (int r = 0; r < 16; ++r) xb[(d * 16 + r) * 64 + lane] = o[d][r];
        xb[64 * 64 + lane] = mrun; xb[65 * 64 + lane] = lrun;
    }
    __syncthreads();
    if (grp == 0) {
        const float m2 = xb[64 * 64 + lane], l2 = xb[65 * 64 + lane];
        const float mm = fmaxf(mrun, m2), a1 = __builtin_amdgcn_exp2f(mrun - mm), a2 = __builtin_amdgcn_exp2f(m2 - mm);
        const float inv = 1.f / (lrun * a1 + l2 * a2), f1 = a1 * inv, f2 = a2 * inv;
#pragma unroll
        for (int db = 0; db < 4; ++db)
#pragma unroll
            for (int g = 0; g < 4; ++g) { float v[4];
#pragma unroll
                for (int e = 0; e < 4; ++e) v[e] = o[db][4 * g + e] * f1 + xb[(db * 16 + 4 * g + e) * 64 + lane] * f2;
                u32x2 w; w.x = pk2(v[0], v[1]); w.y = pk2(v[2], v[3]);
                *(u32x2*)(OL + mq * 512 + head * 128 + 32 * db + 8 * g + 4 * hi) = w; }
    }
    __syncthreads();
}
struct RwSet { bf16x8 ta[2][4]; u32x4 d[4]; };
__device__ __forceinline__ void rw_load(RwSet& s, const bf16_t* TTg, const bf16_t* Rg, int cg_, int h, int i, int r32, int hi) {
    const bf16_t* TTw = TTg + (size_t)(cg_ * 8 + h) * 4096; const bf16_t* Dw = Rg + ((size_t)64 * cg_ + i) * 512 + h * 64;
#pragma unroll
    for (int a = 0; a < 2; ++a)
#pragma unroll
        for (int s2 = 0; s2 < 4; ++s2) s.ta[a][s2] = *(const bf16x8*)(TTw + (32 * a + r32) * 64 + 16 * s2 + 8 * hi);
    s.d[0] = *(const u32x4*)(Dw + 16 * hi); s.d[1] = *(const u32x4*)(Dw + 16 * hi + 8); s.d[2] = *(const u32x4*)(Dw + 32 + 16 * hi); s.d[3] = *(const u32x4*)(Dw + 32 + 16 * hi + 8);
}
__device__ __forceinline__ f32x16 up16(const u32x4 a, const u32x4 b) { f32x16 r;
    r[0] = bflo(a.x); r[1] = bfhi(a.x); r[2] = bflo(a.y); r[3] = bfhi(a.y); r[4] = bflo(a.z); r[5] = bfhi(a.z); r[6] = bflo(a.w); r[7] = bfhi(a.w);
    r[8] = bflo(b.x); r[9] = bfhi(b.x); r[10] = bflo(b.y); r[11] = bfhi(b.y); r[12] = bflo(b.z); r[13] = bfhi(b.z); r[14] = bflo(b.w); r[15] = bfhi(b.w); return r; }
__device__ __forceinline__ void rw_step(f32x16& X0, f32x16& X1, const RwSet& s, bf16_t* Rg, int cg_, int h, int i, int hi, bool live) {
    const bf16x8 bf[4] = {cvt8(X0, 0), cvt8(X0, 1), cvt8(X1, 0), cvt8(X1, 1)};
    if (live) { bf16_t* Dw = Rg + ((size_t)64 * cg_ + i) * 512 + h * 64;
        *(bf16x8*)(Dw + 16 * hi) = bf[0]; *(bf16x8*)(Dw + 16 * hi + 8) = bf[1]; *(bf16x8*)(Dw + 32 + 16 * hi) = bf[2]; *(bf16x8*)(Dw + 32 + 16 * hi + 8) = bf[3]; }
    f32x16 n0 = up16(s.d[0], s.d[1]), n1 = up16(s.d[2], s.d[3]);
#pragma unroll
    for (int s2 = 0; s2 < 4; ++s2) { n0 = __builtin_amdgcn_mfma_f32_32x32x16_bf16(s.ta[0][s2], bf[s2], n0, 0, 0, 0); n1 = __builtin_amdgcn_mfma_f32_32x32x16_bf16(s.ta[1][s2], bf[s2], n1, 0, 0, 0); }
    X0 = n0; X1 = n1;
}
__device__ __forceinline__ void rwkv_scan(const Ctx& F, int b, int h, int half) {
    const int lane = F.lane, r32 = lane & 31, hi = lane >> 5, i = 32 * half + r32;
    const bf16_t* TTg = (const bf16_t*)(F.ws + WS_TT); bf16_t* Rg = (bf16_t*)(F.ws + WS_R);
    f32x16 X0, X1;
#pragma unroll
    for (int r = 0; r < 16; ++r) { X0[r] = 0.f; X1[r] = 0.f; }
    RwSet sA, sB, sC; const int c0 = b * 128;
    rw_load(sA, TTg, Rg, c0 + 0, h, i, r32, hi); rw_load(sB, TTg, Rg, c0 + 1, h, i, r32, hi); rw_load(sC, TTg, Rg, c0 + 2, h, i, r32, hi);
    for (int c = 0; c < 129; c += 3) {
        rw_step(X0, X1, sA, Rg, c0 + c, h, i, hi, true);          rw_load(sA, TTg, Rg, c0 + min(c + 3, 127), h, i, r32, hi);
        rw_step(X0, X1, sB, Rg, c0 + c + 1, h, i, hi, true);      rw_load(sB, TTg, Rg, c0 + min(c + 4, 127), h, i, r32, hi);
        rw_step(X0, X1, sC, Rg, c0 + min(c + 2, 127), h, i, hi, c + 2 < 128); rw_load(sC, TTg, Rg, c0 + min(c + 5, 127), h, i, r32, hi);
    }
}
__device__ __forceinline__ void ssd_scan(const Ctx& F, int item) {
    const int b = item >> 4, h = (item >> 1) & 7, hp = item & 1, g = h >> 2, hl = h & 3;
    const int piece = hp * 512 + F.tid;
    const int f = hl * 8192 + piece * 8, row = f >> 9, col = ssd_win_col(g, f & 511);
    bf16_t* ST = (bf16_t*)(F.ws + WS_XBC); const float* CDEC = (const float*)(F.ws + WS_CDEC);
    float st[8];
#pragma unroll
    for (int j = 0; j < 8; ++j) st[j] = 0.f;
    for (int c8 = 0; c8 < 128; c8 += 8) {
        u32x4 v[8]; float cd[8];
#pragma unroll
        for (int u = 0; u < 8; ++u) { const int cg_ = b * 128 + c8 + u; v[u] = *(const u32x4*)(ST + ((size_t)64 * cg_ + row) * 1024 + col); cd[u] = CDEC[cg_ * 8 + h]; }
#pragma unroll
        for (int u = 0; u < 8; ++u) { const int cg_ = b * 128 + c8 + u;
            u32x4 o; o.x = pk2(st[0], st[1]); o.y = pk2(st[2], st[3]); o.z = pk2(st[4], st[5]); o.w = pk2(st[6], st[7]);
            *(u32x4*)(ST + ((size_t)64 * cg_ + row) * 1024 + col) = o;
            const float x[8] = {bflo(v[u].x), bfhi(v[u].x), bflo(v[u].y), bfhi(v[u].y), bflo(v[u].z), bfhi(v[u].z), bflo(v[u].w), bfhi(v[u].w)};
#pragma unroll
            for (int j = 0; j < 8; ++j) st[j] = st[j] * cd[u] + x[j]; }
    }
}
constexpr size_t CTL_QUEUE = 32768;
template <int VAR = 0> __device__ __forceinline__ void p4_mix(const Ctx& F, int qslot, int what = 3) {
    const int x = F.bid & 7, li = F.bid >> 3;
    if ((what & 2) && li < 8) { const int st = li * 8 + x;
        if (st < 32) { if (!(what & 8) && F.wave == 0) rwkv_scan(F, st >> 4, (st >> 1) & 7, st & 1); }
        else if (!(what & 4)) ssd_scan(F, st - 32); }
    if (what & 1) {
        unsigned* ctr = (unsigned*)(F.ws + WS_CTL + CTL_QUEUE) + (qslot * 8 + x) * 64;
        volatile LAS int* qw = (volatile LAS int*)(F.lds + LDS_BYTES - 128);
        for (;;) {
            if (F.tid == 0) *qw = (int)__hip_atomic_fetch_add(ctr, 1u, __ATOMIC_RELAXED, __HIP_MEMORY_SCOPE_AGENT);
            __syncthreads();
            const int k = *qw;
            __syncthreads();
            if (k >= 64) break;
            const int rb = 4 * k + (x >> 1), c = 127 - (rb >> 1), hp = rb & 1, b = x & 1;
            attn_unit<VAR>(F, b, c, hp);
        }
    }
}
template <int VAR = 0> __device__ __forceinline__ void p5_assemble(const Ctx& F, int l) {
    bf16_t* GT = (bf16_t*)(F.ws + WS_GATES);
    if (!(VAR & 1)) {   pg8::Gemm g{(const bf16_t*)(F.ws + WS_OL), (const bf16_t*)(F.ws + WS_WUV), NT, 512, 256, 512, 512, 256};     pg8::StaticOrder S; S.init(NT, 512, F.G, F.bid); EpiUV E{GT};
        pg8::gemm_phase<EpiUV, pg8::StaticOrder, true, true>(F.lds, F.wave, g, S, E); }
    __syncthreads();
    int lane = fresh_lane(); const int tid = F.wave * 64 + lane, wave = F.wave;
    const int gw = F.bid * NWAVES + F.wave, NGW = F.G * NWAVES;
    {   constexpr int O_CC = 0, O_YO = 33792;
        const bf16_t* Cbuf = (const bf16_t*)(F.ws + WS_CB); const float* ECUM = (const float*)(F.ws + WS_ECUM); const bf16_t* ST = (const bf16_t*)(F.ws + WS_XBC); const bf16_t* YD = (const bf16_t*)(F.ws + WS_YD);
        const float* snw = INP(I_SSDNW) + l * 512;
        for (int c = F.bid; c < ((VAR & 2) ? 0 : NCHK); c += F.G) {
            const size_t m0 = (size_t)64 * c; const int h = wave, g = h >> 2, hl = h & 3;
            bf16x8 pf[4][4];
#pragma unroll
            for (int pi = 0; pi < 4; ++pi)
#pragma unroll
                for (int ks = 0; ks < 4; ++ks) { const int f = hl * 8192 + (16 * pi + (lane & 15)) * 128 + 32 * ks + 8 * (lane >> 4), row = f >> 9, col = ssd_win_col(g, f & 511);
                    pf[pi][ks] = *(const bf16x8*)(ST + (m0 + row) * 1024 + col); }
            {   LAS bf16_t* CC = (LAS bf16_t*)(F.lds + O_CC);
#pragma unroll
                for (int i = 0; i < 4; ++i) { const int idx = tid + 512 * i, t = idx >> 5, c8 = idx & 31; *(LAS u32x4*)(CC + t * 264 + c8 * 8) = *(const u32x4*)(Cbuf + (m0 + t) * 256 + c8 * 8); } }
            __syncthreads();
            {   const LAS bf16_t* CC = (const LAS bf16_t*)(F.lds + O_CC) + g * 128; LAS bf16_t* YO = (LAS bf16_t*)(F.lds + O_YO);
#pragma unroll
                for (int ti = 0; ti < 4; ++ti) {
                    bf16x8 af[4];
#pragma unroll
                    for (int ks = 0; ks < 4; ++ks) af[ks] = *(const LAS bf16x8*)(CC + (16 * ti + (lane & 15)) * 264 + 32 * ks + 8 * (lane >> 4));
                    float ec[4];
#pragma unroll
                    for (int r = 0; r < 4; ++r) ec[r] = ECUM[(size_t)(c * 8 + h) * 64 + 16 * ti + 4 * (lane >> 4) + r];
#pragma unroll
                    for (int pi = 0; pi < 4; ++pi) { f32x4 acc = {0.f, 0.f, 0.f, 0.f};
#pragma unroll
                        for (int ks = 0; ks < 4; ++ks) acc = __builtin_amdgcn_mfma_f32_16x16x32_bf16(af[ks], pf[pi][ks], acc, 0, 0, 0);
#pragma unroll
                        for (int r = 0; r < 4; ++r) YO[(16 * ti + 4 * (lane >> 4) + r) * 520 + 64 * h + 16 * pi + (lane & 15)] = (bf16_t)f2bf(acc[r] * ec[r]); }
                }
            }
            __syncthreads();
            {   const LAS bf16_t* YO = (const LAS bf16_t*)(F.lds + O_YO);
                u32x4 ydv[8], zv[8];
#pragma unroll
                for (int rr = 0; rr < 8; ++rr) { const int t = 8 * wave + rr; ydv[rr] = *(const u32x4*)(YD + (m0 + t) * 512 + 8 * lane); zv[rr] = *(const u32x4*)(GT + (m0 + t) * 1536 + 512 + 8 * lane); }
                const f32x4 w0 = *(const f32x4*)(snw + 8 * lane), w1 = *(const f32x4*)(snw + 8 * lane + 4);
#pragma unroll
                for (int rr = 0; rr < 8; ++rr) { const int t = 8 * wave + rr; const u32x4 w = *(const LAS u32x4*)(YO + t * 520 + 8 * lane);
                    const unsigned wa[4] = {w.x, w.y, w.z, w.w}, ya[4] = {ydv[rr].x, ydv[rr].y, ydv[rr].z, ydv[rr].w}, za[4] = {zv[rr].x, zv[rr].y, zv[rr].z, zv[rr].w};
                    float v[8]; float q = 0.f;
#pragma unroll
                    for (int j = 0; j < 8; ++j) { const int k2 = j >> 1; const float yo = (j & 1) ? bfhi(wa[k2]) : bflo(wa[k2]), yd = (j & 1) ? bfhi(ya[k2]) : bflo(ya[k2]), zz = (j & 1) ? bfhi(za[k2]) : bflo(za[k2]);
                        v[j] = (yd + yo) * siluf_(zz); q += v[j] * v[j]; }
                    const float rs = __builtin_amdgcn_rsqf(wave_sum(q) * (1.f / 512.f) + EPS);
                    u32x4 o; o.x = pk2(v[0] * rs * w0[0], v[1] * rs * w0[1]); o.y = pk2(v[2] * rs * w0[2], v[3] * rs * w0[3]); o.z = pk2(v[4] * rs * w1[0], v[5] * rs * w1[1]); o.w = pk2(v[6] * rs * w1[2], v[7] * rs * w1[3]);
                    *(u32x4*)(GT + (m0 + t) * 1536 + 512 + 8 * lane) = o; } }
            __syncthreads();
        }
    }
    LAS float* SW = (LAS float*)(F.lds + F.wave * 16640);
    const bf16_t* Yt = (const bf16_t*)(F.ws + WS_K); const bf16_t* SF = (const bf16_t*)(F.ws + WS_R); const bf16_t* QEg = (const bf16_t*)(F.ws + WS_QE);
    const bf16_t* BON = (const bf16_t*)(F.ws + WS_V); const float* lw = INP(I_LNXW) + l * 512; const float* lb = INP(I_LNXB) + l * 512;
    for (int w = gw; w < ((VAR & 4) ? 0 : NCHK * 8); w += NGW) {
        asm volatile("" : "+v"(lane));
        const int cg_ = w >> 3, h = w & 7, r32 = lane & 31, hi = lane >> 5; const size_t m0 = (size_t)64 * cg_;
        const bf16_t* QEw = QEg + (size_t)(cg_ * 8 + h) * 4096;
        bf16x8 qa[2][4];
#pragma unroll
        for (int tb = 0; tb < 2; ++tb)
#pragma unroll
            for (int s2 = 0; s2 < 4; ++s2) qa[tb][s2] = *(const bf16x8*)(QEw + (32 * tb + r32) * 64 + 16 * s2 + 8 * hi);
#pragma unroll
        for (int ih = 0; ih < 2; ++ih) { const size_t ro = (m0 + 32 * ih + r32) * 512 + h * 64;
            const bf16x8 bf[4] = {*(const bf16x8*)(SF + ro + 16 * hi), *(const bf16x8*)(SF + ro + 16 * hi + 8), *(const bf16x8*)(SF + ro + 32 + 16 * hi), *(const bf16x8*)(SF + ro + 32 + 16 * hi + 8)};
#pragma unroll
            for (int tb = 0; tb < 2; ++tb) { f32x16 y = ld16bf(Yt + ro + 32 * tb + 16 * hi);
#pragma unroll
                for (int s2 = 0; s2 < 4; ++s2) y = __builtin_amdgcn_mfma_f32_32x32x16_bf16(qa[tb][s2], bf[s2], y, 0, 0, 0);
#pragma unroll
                for (int r = 0; r < 16; ++r) SW[(32 * tb + crow(r, hi)) * 65 + 32 * ih + r32] = y[r]; } }
        LDS_WAIT();
        {   float y[64]; float sm = 0.f;
#pragma unroll
            for (int i = 0; i < 64; ++i) { y[i] = SW[lane * 65 + i]; sm += y[i]; }
            const float mean = sm * (1.f / 64.f); float q = 0.f;
#pragma unroll
            for (int i = 0; i < 64; ++i) { y[i] -= mean; q += y[i] * y[i]; }
            const float rs = 1.f / sqrtf(q * (1.f / 64.f) + GN_EPS);
#pragma unroll
            for (int i = 0; i < 64; ++i) SW[lane * 65 + i] = y[i] * rs; }
        LDS_WAIT();
        u32x4 bwv[8], gvv[8];
#pragma unroll
        for (int it = 0; it < 8; ++it) { const int t = it * 8 + (lane >> 3), i0 = (lane & 7) * 8; const size_t row = m0 + t;
            bwv[it] = *(const u32x4*)(BON + row * 512 + h * 64 + i0); gvv[it] = *(const u32x4*)(GT + row * 1536 + 1024 + h * 64 + i0); }
#pragma unroll
        for (int it = 0; it < 8; ++it) { const int t = it * 8 + (lane >> 3), i0 = (lane & 7) * 8; const size_t row = m0 + t;
            const u32x4 bw = bwv[it]; u32x4* gp = (u32x4*)(GT + row * 1536 + 1024 + h * 64 + i0); const u32x4 gv = gvv[it];
            const float bo[8] = {bflo(bw.x), bfhi(bw.x), bflo(bw.y), bfhi(bw.y), bflo(bw.z), bfhi(bw.z), bflo(bw.w), bfhi(bw.w)};
            const float gg[8] = {bflo(gv.x), bfhi(gv.x), bflo(gv.y), bfhi(gv.y), bflo(gv.z), bfhi(gv.z), bflo(gv.w), bfhi(gv.w)};
            float ov[8];
#pragma unroll
            for (int j = 0; j < 8; ++j) ov[j] = (SW[t * 65 + i0 + j] * lw[h * 64 + i0 + j] + lb[h * 64 + i0 + j] + bo[j]) * siluf_(gg[j]);
            u32x4 o; o.x = pk2(ov[0], ov[1]); o.y = pk2(ov[2], ov[3]); o.z = pk2(ov[4], ov[5]); o.w = pk2(ov[6], ov[7]); *gp = o; }
        LDS_WAIT();
    }
}
__device__ __forceinline__ void p7_final(const Ctx& F) {
    const int gw = F.bid * NWAVES + F.wave, NGW = F.G * NWAVES; const float* fw = INP(I_FNW);
    for (int m = gw; m < NT; m += NGW) {
        f32x4* xr = (f32x4*)(F.out + (size_t)m * DM) + F.lane; f32x4 v[4]; float s = 0.f;
#pragma unroll
        for (int j = 0; j < 4; ++j) { v[j] = xr[64 * j]; s += v[j].x * v[j].x + v[j].y * v[j].y + v[j].z * v[j].z + v[j].w * v[j].w; }
        const float rstd = 1.f / sqrtf(wave_sum(s) * (1.f / DM) + EPS);
#pragma unroll
        for (int j = 0; j < 4; ++j) xr[64 * j] = v[j] * rstd * *(const f32x4*)(fw + 4 * F.lane + 256 * j);
    }
}

#define RLX_AGENT __ATOMIC_RELAXED, __HIP_MEMORY_SCOPE_AGENT
#define XB_TMO      128
#define XB_XCNT(j)  (256  + 64 * (j))
#define XB_XSUB(j)  (1280 + 64 * (j))
#define XB_XGEN(j)  (2304 + 64 * (j))
#define XB_TOP      3328
#define XB_TOPGEN   3392
#define XCD_BAR_WORDS 3456
#define XB_SPIN_CAP (1u << 18)

__device__ __forceinline__ unsigned xb_ld(unsigned* p)              { return __hip_atomic_load(p, __ATOMIC_RELAXED, __HIP_MEMORY_SCOPE_AGENT); }
__device__ __forceinline__ unsigned xb_add(unsigned* p, unsigned v) { return __hip_atomic_fetch_add(p, v, __ATOMIC_RELAXED, __HIP_MEMORY_SCOPE_AGENT); }
__device__ __forceinline__ unsigned xb_xcc_id() { return (unsigned)__builtin_amdgcn_s_getreg((3 << 11) | 20) & 0xFu; }
#define XB_SPIN(cond, bar) do { unsigned _sp = 0; while (cond) { __builtin_amdgcn_s_sleep(1); \
    if ((++_sp & 255u) == 0u) { if (xb_ld(&(bar)[XB_TMO])) break; if (_sp > XB_SPIN_CAP) { atomicAdd(&(bar)[XB_TMO], 1u); break; } } } } while (0)

struct XcdBarrier {
    unsigned* bar; unsigned x;
    volatile LAS unsigned* st;
};

__device__ __forceinline__ XcdBarrier xcd_barrier_post(unsigned* bar, volatile LAS unsigned* st) {
    XcdBarrier b; b.bar = bar; b.x = xb_xcc_id(); b.st = st;
    if (threadIdx.x == 0) (void)xb_add(&bar[XB_XCNT(b.x)], 1u);
    return b;
}
__device__ __forceinline__ void xcd_barrier_complete(unsigned* bar, unsigned x, unsigned& nloc, unsigned& nx) {
    const unsigned G = gridDim.x * gridDim.y * gridDim.z;
    unsigned sum, cnt, mine, sp = 0u;
    for (;;) {
        sum = 0u; cnt = 0u; mine = 0u;
#pragma unroll
        for (unsigned j = 0; j < 16; ++j) { const unsigned c = xb_ld(&bar[XB_XCNT(j)]); sum += c; cnt += (c > 0u) ? 1u : 0u; mine = (j == x) ? c : mine; }
        if (sum == G) break;
        __builtin_amdgcn_s_sleep(1);
        if ((++sp & 255u) == 0u) { if (xb_ld(&bar[XB_TMO])) break; if (sp > XB_SPIN_CAP) { atomicAdd(&bar[XB_TMO], 1u); break; } }
    }
    nloc = mine > 0u ? mine : 1u; nx = cnt > 0u ? cnt : 1u;
}

__device__ __forceinline__ void xcd_barrier(const XcdBarrier& b) {
    asm volatile("s_waitcnt vmcnt(0)" ::: "memory");
    __syncthreads();
    if (threadIdx.x == 0) {
        unsigned* bar = b.bar;
        __builtin_amdgcn_s_waitcnt(0);
        unsigned nloc = b.st[0], nx = b.st[1];
        if (nloc == 0u) { xcd_barrier_complete(bar, b.x, nloc, nx); b.st[0] = nloc; b.st[1] = nx; }
        const unsigned old = xb_add(&bar[XB_XSUB(b.x)], 1u);
        const unsigned gen = old / nloc;
        if (old + 1u == (gen + 1u) * nloc) {
            __builtin_amdgcn_fence(__ATOMIC_RELEASE, "agent");
            asm volatile("s_waitcnt vmcnt(0)" ::: "memory");
            const unsigned og = xb_add(&bar[XB_TOP], 1u);
            const unsigned tg = og / nx;
            if (og + 1u == (tg + 1u) * nx) xb_add(&bar[XB_TOPGEN], 1u);
            else XB_SPIN(xb_ld(&bar[XB_TOPGEN]) == tg, bar);
            __builtin_amdgcn_fence(__ATOMIC_ACQUIRE, "agent");
            xb_add(&bar[XB_XGEN(b.x)], 1u);
            asm volatile("s_waitcnt vmcnt(0)" ::: "memory");
        } else {
            XB_SPIN(xb_ld(&bar[XB_XGEN(b.x)]) == gen, bar);
            __builtin_amdgcn_fence(__ATOMIC_ACQUIRE, "agent");
            asm volatile("s_waitcnt vmcnt(0)" ::: "memory");
        }
    }
    __syncthreads();
}


#define LAYER(l) do { \
        const int pb = 1 + 8 * l; \
        if (IN(pb + 0)) { PHB(); prep_weights(F, l); if (l == 0) { p0_rope(F); p1_norm(F, l); } SEAM(pb + 0); }     \
        if (IN(pb + 1)) { PHB(); \
            pg8::Gemm g{(const bf16_t*)(F.ws + WS_XN), (const bf16_t*)(F.ws + WS_WIN), NT, NIN, DM, DM, DM}; pg8::StaticOrder S; S.init(NT, NIN, F.G, F.bid); \
            EpiIn E{F.ws, l}; \
            pg8::gemm_phase<EpiIn, pg8::StaticOrder, true, true>(F.lds, F.wave, g, S, E); \
            SEAM(pb + 1); \
        } \
        if (IN(pb + 2)) { PHB(); \
            pg8::Gemm g{(const bf16_t*)(F.ws + WS_QLAT), (const bf16_t*)(F.ws + WS_WQ), NT, 768, 256, 256, 256}; pg8::StaticOrder S; S.init(NT, 768, F.G, F.bid); \
            EpiQ E{F.ws, l}; \
            pg8::gemm_phase<EpiQ, pg8::StaticOrder, true, true>(F.lds, F.wave, g, S, E); \
            p3a_extras(F, l); \
        } \
        if (IN(pb + 3)) { PHB(); p3b_ssd(F, l); __syncthreads(); } \
        if (IN(pb + 4)) { PHB(); p3c_rwkv(F, l); SEAM(pb + 4); } \
        if (IN(pb + 5)) { PHB(); p4_mix(F, l); SEAM(pb + 5); } \
        if (IN(pb + 6)) { PHB(); p5_assemble(F, l); SEAM(pb + 6); } \
        if (IN(pb + 7)) { PHB(); \
            pg8::Gemm g{(const bf16_t*)(F.ws + WS_GATES), (const bf16_t*)(F.ws + WS_WOUT), NT, DM, 1536, 1536, 1536}; pg8::StaticOrder S; S.init(NT, DM, F.G, F.bid); \
            EpiOutNorm E{(l == 0) ? INP(I_X) : F.out, F.out, (const float*)(F.ws + WS_CTL + CTL_MOD) + (size_t)(l * 2) * 3072 + 2048, F.ws, (l == 0) ? INP(I_NORMW) + DM : INP(I_FNW), (const float*)(F.ws + WS_CTL + CTL_MOD) + (size_t)2 * 3072, l, l}; \
            pg8::gemm_phase<EpiOutNorm, pg8::StaticOrder, false, true>(F.lds, F.wave, g, S, E); \
            if (l == 0) SEAM(pb + 7); \
        } \
    } while (0)
__global__ void __launch_bounds__(NTHR, 2) mk_fwd(Args args) {
    extern __shared__ __attribute__((aligned(16))) unsigned char lds_raw[];
    Ctx F; F.lds = (LAS unsigned char*)lds_raw; F.tid = threadIdx.x; F.lane = F.tid & 63; F.wave = __builtin_amdgcn_readfirstlane(F.tid >> 6);
    F.G = gridDim.x; F.bid = blockIdx.x; F.ws = args.ws; F.out = args.out; F.in = args.in;
    const int wave0 = F.wave;
    cg::grid_group grid = cg::this_grid();
    volatile LAS unsigned* xst = (volatile LAS unsigned*)(F.lds + LDS_BYTES - 256);
    if (threadIdx.x < 2) xst[threadIdx.x] = 0u;
    __syncthreads();
    const XcdBarrier xbar = xcd_barrier_post((unsigned*)(args.ws + WS_CTL) + 4096, xst);
#if MK_PER_PHASE
    const int lo = args.ph_lo, hi = args.ph_hi;
#else
    constexpr int lo = 0, hi = 18;
#endif
#ifndef MK_ONLY
#define MK_ONLY -1
#endif
#define IN(k) (lo <= (k) && (k) < hi && (MK_ONLY < 0 || MK_ONLY == ((k) == 0 ? 0 : (k) == 17 ? 17 : 1 + ((k) - 1) % 8)))
#if MK_PER_PHASE
#define SEAM(k) do { } while (0)
#else
#define SEAM(k) do { xcd_barrier(xbar); } while (0)
#endif
#define PHB() do { int b_ = blockIdx.x, g_ = gridDim.x, v_ = wave0; asm volatile("" : "+s"(b_), "+s"(g_), "+s"(v_)); F.bid = b_; F.G = g_; F.wave = v_; int t_ = v_ * 64 + (int)__builtin_amdgcn_mbcnt_hi(~0u, __builtin_amdgcn_mbcnt_lo(~0u, 0u)); asm volatile("; PHASE_MARK %0" : "+v"(t_)); F.tid = t_; F.lane = t_ & 63; unsigned wl_ = __builtin_amdgcn_readfirstlane((unsigned)(uintptr_t)args.ws), wh_ = __builtin_amdgcn_readfirstlane((unsigned)((uintptr_t)args.ws >> 32)), ol_ = __builtin_amdgcn_readfirstlane((unsigned)(uintptr_t)args.out), oh_ = __builtin_amdgcn_readfirstlane((unsigned)((uintptr_t)args.out >> 32)); asm volatile("" : "+s"(wl_), "+s"(wh_), "+s"(ol_), "+s"(oh_)); F.ws = (unsigned char*)(GAS unsigned char*)(((uintptr_t)wh_ << 32) | wl_); F.out = (float*)(GAS float*)(((uintptr_t)oh_ << 32) | ol_); } while (0)
    if (IN(0)) { PHB(); p0_mod(F); SEAM(0); }
    LAYER(0);
    LAYER(1);
#ifndef MK_RERUN
#define MK_RERUN 0
#endif
#define PHB2() do { int b_ = blockIdx.x, g_ = gridDim.x, v_ = wave0; asm volatile("" : "+s"(b_), "+s"(g_), "+s"(v_)); F.bid = b_; F.G = g_; F.wave = v_; int t_ = v_ * 64 + fresh_lane(); F.tid = t_; F.lane = t_ & 63; } while (0)
#if MK_RERUN
    { constexpr int l = 1;
    if (MK_RERUN & 1) { xcd_barrier(xbar); PHB2(); p1_norm(F, l); }
    if (MK_RERUN & 8192) { xcd_barrier(xbar); PHB2(); prep_weights(F, 1); }
    if (MK_RERUN & 2) { xcd_barrier(xbar); PHB2(); pg8::Gemm g{(const bf16_t*)(F.ws + WS_XN), (const bf16_t*)(F.ws + WS_WIN), NT, NIN, DM, DM, DM}; pg8::StaticOrder S; S.init(NT, NIN, F.G, F.bid); EpiIn E{F.ws, l}; pg8::gemm_phase<EpiIn, pg8::StaticOrder, true, true>(F.lds, F.wave, g, S, E); }
    if (MK_RERUN & 4) { xcd_barrier(xbar); PHB2(); pg8::Gemm g{(const bf16_t*)(F.ws + WS_QLAT), (const bf16_t*)(F.ws + WS_WQ), NT, 768, 256, 256, 256}; pg8::StaticOrder S; S.init(NT, 768, F.G, F.bid); EpiQ E{F.ws, l}; pg8::gemm_phase<EpiQ, pg8::StaticOrder, true, true>(F.lds, F.wave, g, S, E); p3a_extras(F, l); }
    if (MK_RERUN & 8) { xcd_barrier(xbar); PHB2(); p3b_ssd<MK_AVAR>(F, l); }
    if (MK_RERUN & 16) { xcd_barrier(xbar); PHB2(); p3c_rwkv<MK_AVAR>(F, l); }
    if (MK_RERUN & 32) { xcd_barrier(xbar); PHB2(); p4_mix(F, 2); }
#ifndef MK_AVAR
#define MK_AVAR 0
#endif
    if (MK_RERUN & 512) { xcd_barrier(xbar); PHB2(); p4_mix<MK_AVAR>(F, 2, 1); }
    if (MK_RERUN & 1024) { xcd_barrier(xbar); PHB2(); p4_mix(F, 2, 2); }
    if (MK_RERUN & 2048) { xcd_barrier(xbar); PHB2(); p4_mix(F, 2, 2 | 4); }
    if (MK_RERUN & 4096) { xcd_barrier(xbar); PHB2(); p4_mix(F, 2, 2 | 8); }
    if (MK_RERUN & 64) { xcd_barrier(xbar); PHB2(); p5_assemble<MK_AVAR>(F, l); }
    if (MK_RERUN & 128) { xcd_barrier(xbar); PHB2(); pg8::Gemm g{(const bf16_t*)(F.ws + WS_GATES), (const bf16_t*)(F.ws + WS_WOUT), NT, DM, 1536, 1536, 1536}; pg8::StaticOrder S; S.init(NT, DM, F.G, F.bid);
        EpiOut E{INP(I_X), (float*)(F.ws + WS_XBC), (const float*)(F.ws + WS_CTL + CTL_MOD) + (size_t)(l * 2) * 3072 + 2048}; pg8::gemm_phase<EpiOut, pg8::StaticOrder, true, true>(F.lds, F.wave, g, S, E); }
    }
#endif
#undef IN
#undef SEAM
}
constexpr int N_PHASES = 18;

extern "C" void kernel_launch(void* const* d_in, const int* in_sizes, int n_in, void* d_out, int out_size, void* d_ws, size_t ws_size, hipStream_t stream) {
    static int grid = 0;
    if (grid == 0) {
        if (n_in != 31 || out_size != NT * DM || ws_size < WS_END) { fprintf(stderr, "kernel_launch: unexpected shapes (n_in %d, out %d, ws %zu)\n", n_in, out_size, ws_size); grid = -1; return; }
        int dev = 0, cus = 0, per_cu = 0;
        hipGetDevice(&dev); hipDeviceGetAttribute(&cus, hipDeviceAttributeMultiprocessorCount, dev);
        if (hipFuncSetAttribute((const void*)mk_fwd, hipFuncAttributeMaxDynamicSharedMemorySize, LDS_BYTES) != hipSuccess) { fprintf(stderr, "kernel_launch: hipFuncSetAttribute failed\n"); grid = -1; return; }
        hipOccupancyMaxActiveBlocksPerMultiprocessor(&per_cu, (const void*)mk_fwd, NTHR, LDS_BYTES);
        (void)hipGetLastError();
        if (per_cu < 1) per_cu = 1;
        grid = cus;
        fprintf(stderr, "kernel_launch: cus %d, occupancy query %d block(s)/CU, grid %d\n", cus, per_cu, grid);
    }
    if (grid < 0) return;
    hipMemsetAsync((char*)d_ws + WS_CTL, 0, CTL_BYTES, stream);
    Args a{};
    for (int i = 0; i < 31; ++i) a.in[i] = (const float*)d_in[i];
    a.out = (float*)d_out; a.ws = (unsigned char*)d_ws;
#if MK_PER_PHASE
    for (int p = 0; p < N_PHASES; ++p) { a.ph_lo = p; a.ph_hi = p + 1; hipLaunchKernelGGL(mk_fwd, dim3(grid), dim3(NTHR), LDS_BYTES, stream, a); }
#else
    a.ph_lo = 0; a.ph_hi = N_PHASES;
    void* params[] = {&a};
    hipError_t e = hipLaunchCooperativeKernel((const void*)mk_fwd, dim3(grid), dim3(NTHR), params, LDS_BYTES, stream);
    if (e != hipSuccess) fprintf(stderr, "kernel_launch: cooperative launch failed: %s\n", hipGetErrorString(e));
#endif
}
```

```cpp
#include <hip/hip_runtime.h>
#include <hip/hip_cooperative_groups.h>
#include <cstdio>
#include <cstdint>
namespace cg = cooperative_groups;

#define LAS __attribute__((address_space(3)))
#define GAS __attribute__((address_space(1)))
typedef unsigned short bf16_t;
typedef short bf16x8 __attribute__((ext_vector_type(8)));
typedef float f32x4 __attribute__((ext_vector_type(4)));
typedef float f32x2 __attribute__((ext_vector_type(2)));
typedef float f32x16 __attribute__((ext_vector_type(16)));
typedef unsigned u32x4 __attribute__((ext_vector_type(4)));
typedef unsigned u32x2 __attribute__((ext_vector_type(2)));
typedef short v4i16_t __attribute__((ext_vector_type(4)));

#ifndef MK_PER_PHASE
#define MK_PER_PHASE 0
#endif

namespace pg8 {
constexpr int BM = 256, BK = 64, HALF = 128, HTB = HALF * BK * 2, STAGE_BYTES = 8 * HTB, NXCD = 8, WGM = 8;
__host__ __device__ __forceinline__ int lds_byte(int r, int c) { const int st = (r >> 4) * 2 + (c >> 5), rr = r & 15, cc = c & 31, ob = rr * 64 + cc * 2; return st * 1024 + (ob ^ (((ob >> 9) & 1) << 5)); }
__host__ __device__ __forceinline__ void stage_rc(int b, int& R, int& C) { const int st = b / 1024, sb = b % 1024, swz = sb ^ (((sb >> 9) & 1) << 5); R = (st >> 1) * 16 + swz / 64; C = (st & 1) * 32 + (swz % 64) / 2; }
__host__ __device__ __forceinline__ int perm32(int rho) { const int n = rho >> 4, i = rho & 15; return 8 * (i >> 2) + 4 * n + (i & 3); }
struct Unit { int pm, pn; };
struct Gemm { const bf16_t* A; const bf16_t* Bt; int M, N, K, lda, ldb; int kdiag = 0; };
struct StaticOrder {
    int nM, nN, nwg, G, c;
    __host__ __device__ void init(int M, int N, int G_, int c_) { nM = M / BM; nN = N / BM; nwg = nM * nN; G = G_; c = c_; }
    __host__ __device__ bool next(int i, Unit& u) const {
        const long L = (long)i * G + c; if (L >= nwg) return false;
        int wgid = (int)L; { const int q = nwg / NXCD, r = nwg % NXCD, xcd = wgid % NXCD, off = wgid / NXCD; wgid = (xcd < r ? xcd * (q + 1) : r * (q + 1) + (xcd - r) * q) + off; }
        const int nig = WGM * nN, gid = wgid / nig, fm = gid * WGM, gsz = (nM - fm) < WGM ? (nM - fm) : WGM;
        u.pm = fm + ((wgid % nig) % gsz); u.pn = (wgid % nig) / gsz; return true;
    }
};
template <class Epi, class Sched, bool ALIGN_EPI, bool SP2>
__device__ __forceinline__ void gemm_phase(LAS unsigned char* lds, int wave_id, const Gemm g, const Sched& S, const Epi& E) {
    int lane = (int)__builtin_amdgcn_mbcnt_hi(~0u, __builtin_amdgcn_mbcnt_lo(~0u, 0u)); asm volatile("" : "+v"(lane));
    const int wid = wave_id, tid = wid * 64 + lane, wr = wid >> 2, wc = wid & 3, fr = lane & 15, fq = lane >> 4;
    const int K = g.K, nt = K / BK;
    unsigned voffA[2], voffB[2];
#pragma unroll
    for (int i = 0; i < 2; ++i) { int R, C; stage_rc(tid * 16 + i * 8192, R, C); const int Rb = (R & ~31) + perm32(R & 31);
        voffA[i] = (unsigned)(R * g.lda + C) * 2u; voffB[i] = (unsigned)(Rb * g.ldb + C) * 2u; }
    const size_t kstep = (size_t)(BK * 2);
    const size_t hstepA = (size_t)HALF * g.lda * 2, hstepB = (size_t)HALF * g.ldb * 2;
    const size_t tstepA = 2 * hstepA, tstepB = 2 * hstepB;
    const unsigned ldsw = (unsigned)wid * 1024u, lds0 = (unsigned)(uintptr_t)lds;
    const int aoff = lds_byte(wr * 64 + fr, fq * 8), boff = lds_byte(wc * 32 + fr, fq * 8);
#define PG8_SA(b, h) (((b) * 2 + (h)) * HTB)
#define PG8_SB(b, h) ((4 + (b) * 2 + (h)) * HTB)
#define PG8_STAGE(bufoff, gbase, voff) do { _Pragma("unroll") for (int _i = 0; _i < 2; ++_i) { unsigned keep_; \
        asm volatile("s_mov_b32 %0, m0\n\ts_mov_b32 m0, %3\n\ts_nop 0\n\tglobal_load_lds_dwordx4 %1, %2\n\ts_mov_b32 m0, %0" : "=&s"(keep_) : "v"((voff)[_i]), "s"((const char*)(gbase)), "s"(lds0 + (unsigned)(bufoff) + ldsw + (unsigned)(_i * 8192)) : "memory"); } } while (0)
#define PG8_LDA(dst, b, h) do { _Pragma("unroll") for (int m = 0; m < 4; ++m) _Pragma("unroll") for (int k = 0; k < 2; ++k) dst[m][k] = *(const LAS bf16x8*)(lds + PG8_SA(b, h) + aoff + m * 2048 + k * 1024); } while (0)
#define PG8_LDB(dst, b, h) do { _Pragma("unroll") for (int n = 0; n < 2; ++n) _Pragma("unroll") for (int k = 0; k < 2; ++k) dst[n][k] = *(const LAS bf16x8*)(lds + PG8_SB(b, h) + boff + n * 2048 + k * 1024); } while (0)
#define PG8_MMA(ai, bj, At, Bt) do { __builtin_amdgcn_s_setprio(1); _Pragma("unroll") for (int m = 0; m < 4; ++m) _Pragma("unroll") for (int n = 0; n < 2; ++n) _Pragma("unroll") for (int k = 0; k < 2; ++k) \
        acc[ai][bj][m][n] = __builtin_amdgcn_mfma_f32_16x16x32_bf16(Bt[n][k], At[m][k], acc[ai][bj][m][n], 0, 0, 0); __builtin_amdgcn_s_setprio(0); } while (0)
#define PG8_WAIT_V(n) asm volatile("s_waitcnt vmcnt(" #n ")" ::: "memory")
#define PG8_WAIT_L(n) asm volatile("s_waitcnt lgkmcnt(" #n ")" ::: "memory")
#define PG8_BAR __builtin_amdgcn_s_barrier()
#define PG8_SCHED __builtin_amdgcn_sched_barrier(0)
    Unit cur, nxt; int ui = 0;
    if (!S.next(0, cur)) return;
    f32x4 acc[2][2][4][2];
#pragma unroll
    for (int a = 0; a < 2; ++a)
#pragma unroll
        for (int b = 0; b < 2; ++b)
#pragma unroll
            for (int m = 0; m < 4; ++m)
#pragma unroll
                for (int n = 0; n < 2; ++n) acc[a][b][m][n] = (f32x4){0.f, 0.f, 0.f, 0.f};
    bf16x8 At[4][2], B0[2][2], B1[2][2];
    const char* cA = (const char*)g.A + (size_t)cur.pm * tstepA + (size_t)cur.pn * g.kdiag * 2; const char* cB = (const char*)g.Bt + (size_t)cur.pn * tstepB + (size_t)cur.pn * g.kdiag * 2;
    if constexpr (SP2) {
        PG8_STAGE(PG8_SB(0, 0), cB, voffB); PG8_STAGE(PG8_SB(0, 1), cB + hstepB, voffB); PG8_STAGE(PG8_SA(0, 0), cA, voffA); PG8_STAGE(PG8_SA(0, 1), cA + hstepA, voffA);
        if (wr == 1) PG8_BAR;
        PG8_WAIT_V(2); PG8_BAR;
        PG8_STAGE(PG8_SB(1, 0), cB + kstep, voffB); PG8_STAGE(PG8_SA(1, 0), cA + kstep, voffA); PG8_STAGE(PG8_SB(1, 1), cB + hstepB + kstep, voffB);
        PG8_WAIT_V(6); PG8_BAR;
    } else {
        PG8_STAGE(PG8_SB(0, 0), cB, voffB); PG8_STAGE(PG8_SA(0, 0), cA, voffA); PG8_STAGE(PG8_SB(0, 1), cB + hstepB, voffB); PG8_STAGE(PG8_SA(0, 1), cA + hstepA, voffA);
        if (wr == 1) PG8_BAR;
        PG8_WAIT_V(4); PG8_BAR;
        PG8_STAGE(PG8_SB(1, 0), cB + kstep, voffB); PG8_STAGE(PG8_SA(1, 0), cA + kstep, voffA); PG8_STAGE(PG8_SB(1, 1), cB + hstepB + kstep, voffB);
        PG8_WAIT_V(6); PG8_BAR;
    }
    for (;;) {
        const bool has_next = S.next(ui + 1, nxt);
        const char* nA = has_next ? (const char*)g.A + (size_t)nxt.pm * tstepA + (size_t)nxt.pn * g.kdiag * 2 : cA; const char* nB = has_next ? (const char*)g.Bt + (size_t)nxt.pn * tstepB + (size_t)nxt.pn * g.kdiag * 2 : cB;
        for (int t = 0; t < nt; t += 2) {
            const bool last = (t == nt - 2);
            const char* a1 = cA + (size_t)(t + 1) * kstep;
            const char* a2 = last ? nA : cA + (size_t)(t + 2) * kstep; const char* b2 = last ? nB : cB + (size_t)(t + 2) * kstep;
            const char* a3 = a2 + kstep; const char* b3 = b2 + kstep;
            if constexpr (SP2) {
            PG8_LDB(B0, 0, 0); PG8_LDB(B1, 0, 1); PG8_SCHED; PG8_LDA(At, 0, 0); PG8_STAGE(PG8_SA(1, 1), a1 + hstepA, voffA);
            PG8_WAIT_V(8); PG8_WAIT_L(0); PG8_BAR; PG8_MMA(0, 0, At, B0); PG8_MMA(0, 1, At, B1); PG8_BAR; PG8_SCHED;
            PG8_LDA(At, 0, 1); PG8_STAGE(PG8_SB(0, 0), b2, voffB); PG8_STAGE(PG8_SB(0, 1), b2 + hstepB, voffB); PG8_STAGE(PG8_SA(0, 0), a2, voffA);
            PG8_WAIT_V(8); PG8_WAIT_L(0); PG8_BAR; PG8_MMA(1, 0, At, B0); PG8_MMA(1, 1, At, B1); PG8_BAR; PG8_SCHED;
            PG8_LDB(B0, 1, 0); PG8_LDB(B1, 1, 1); PG8_SCHED; PG8_LDA(At, 1, 0); PG8_STAGE(PG8_SA(0, 1), a2 + hstepA, voffA);
            PG8_WAIT_V(8); PG8_WAIT_L(0); PG8_BAR; PG8_MMA(0, 0, At, B0); PG8_MMA(0, 1, At, B1); PG8_BAR; PG8_SCHED;
            PG8_LDA(At, 1, 1); PG8_STAGE(PG8_SB(1, 0), b3, voffB); PG8_STAGE(PG8_SB(1, 1), b3 + hstepB, voffB); PG8_STAGE(PG8_SA(1, 0), a3, voffA);
            PG8_WAIT_V(8); PG8_WAIT_L(0); PG8_BAR; PG8_MMA(1, 0, At, B0); PG8_MMA(1, 1, At, B1); PG8_BAR; PG8_SCHED;
            } else {
            PG8_LDB(B0, 0, 0); PG8_SCHED; PG8_LDA(At, 0, 0); PG8_STAGE(PG8_SA(1, 1), a1 + hstepA, voffA);
            PG8_WAIT_L(8); PG8_BAR; PG8_WAIT_L(0); PG8_MMA(0, 0, At, B0); PG8_BAR; PG8_SCHED;
            PG8_LDB(B1, 0, 1); PG8_STAGE(PG8_SB(0, 0), b2, voffB);
            PG8_BAR; PG8_WAIT_L(0); PG8_MMA(0, 1, At, B1); PG8_BAR;
            PG8_LDA(At, 0, 1); PG8_STAGE(PG8_SA(0, 0), a2, voffA);
            PG8_BAR; PG8_WAIT_L(0); PG8_MMA(1, 0, At, B0); PG8_BAR; PG8_SCHED;
            PG8_STAGE(PG8_SB(0, 1), b2 + hstepB, voffB);
            PG8_WAIT_V(6); PG8_BAR; PG8_MMA(1, 1, At, B1); PG8_BAR;
            PG8_LDB(B0, 1, 0); PG8_SCHED; PG8_LDA(At, 1, 0); PG8_STAGE(PG8_SA(0, 1), a2 + hstepA, voffA);
            PG8_WAIT_L(8); PG8_BAR; PG8_WAIT_L(0); PG8_MMA(0, 0, At, B0); PG8_BAR; PG8_SCHED;
            PG8_LDB(B1, 1, 1); PG8_STAGE(PG8_SB(1, 0), b3, voffB);
            PG8_BAR; PG8_WAIT_L(0); PG8_MMA(0, 1, At, B1); PG8_BAR;
            PG8_LDA(At, 1, 1); PG8_STAGE(PG8_SA(1, 0), a3, voffA);
            PG8_BAR; PG8_WAIT_L(0); PG8_MMA(1, 0, At, B0); PG8_BAR; PG8_SCHED;
            PG8_STAGE(PG8_SB(1, 1), b3 + hstepB, voffB);
            PG8_WAIT_V(6); PG8_BAR; PG8_MMA(1, 1, At, B1); PG8_BAR;
            }
        }
        if constexpr (ALIGN_EPI) { if (wr == 0) PG8_BAR; }
        if constexpr (!Epi::AFTER_DRAIN) E(acc, cur, wr, wc, fr, fq);
        if (!has_next) break;
#pragma unroll
        for (int a = 0; a < 2; ++a)
#pragma unroll
            for (int b = 0; b < 2; ++b)
#pragma unroll
                for (int m = 0; m < 4; ++m)
#pragma unroll
                    for (int n = 0; n < 2; ++n) acc[a][b][m][n] = (f32x4){0.f, 0.f, 0.f, 0.f};
        cur = nxt; cA = nA; cB = nB; ++ui;
        if constexpr (ALIGN_EPI) { if (wr == 1) PG8_BAR; }
    }
    PG8_WAIT_V(0);
    if constexpr (!ALIGN_EPI) { if (wr == 0) PG8_BAR; }
    PG8_BAR;
    if constexpr (Epi::AFTER_DRAIN) E.fused(acc, cur, wr, wc, lds, wid);
#undef PG8_SA
#undef PG8_SB
#undef PG8_STAGE
#undef PG8_LDA
#undef PG8_LDB
#undef PG8_MMA
#undef PG8_WAIT_V
#undef PG8_WAIT_L
#undef PG8_BAR
#undef PG8_SCHED
}
}

constexpr int NT = 16384, SEQ = 8192, DM = 1024, DIN = 4680, NIN = 4864, NCHK = 256, NWAVES = 8, NTHR = 512;
constexpr float EPS = 1e-6f, GN_EPS = 64e-5f, DECAY_SCALE = 0.606531f;
constexpr float QSCALE = 0.07216878364870322f * 1.4426950408889634f;
constexpr size_t MiB = 1u << 20;
constexpr size_t WS_CTL = 0, CTL_BYTES = 1 * MiB;
constexpr size_t CTL_MOD = 65536;
constexpr size_t CTL_SSQ = 131072;
constexpr size_t CTL_RSLOT = 393216;
constexpr size_t CTL_RCNT = 917504;
constexpr size_t WS_WIN = 1 * MiB;
constexpr size_t WS_CB = WS_WIN, WS_ECUM = WS_WIN + 8 * MiB, WS_CDEC = WS_ECUM + 512 * 1024;
constexpr size_t WS_WQ = 10 * MiB + 512 * 1024;
constexpr size_t WS_WUV = 11 * MiB;
constexpr size_t WS_WLW = 11 * MiB + 512 * 1024;
constexpr size_t WS_WLA = WS_WLW + 65536;
constexpr size_t WS_WOUT = 12 * MiB;
constexpr size_t WS_XN = 15 * MiB;
constexpr size_t WS_TT = WS_XN, WS_QE = WS_XN + 16 * MiB;
constexpr size_t WS_QLAT = 47 * MiB, WS_KVL = 55 * MiB;
constexpr size_t WS_OL = WS_QLAT;
constexpr size_t WS_GATES = 63 * MiB;
constexpr size_t WS_XBC = 111 * MiB;
constexpr size_t WS_R = 143 * MiB, WS_K = 159 * MiB, WS_V = 175 * MiB;
constexpr size_t WS_F = 191 * MiB;
constexpr size_t WS_Q = 200 * MiB;
constexpr size_t WS_KVB = 224 * MiB;
constexpr size_t WS_YD = 230 * MiB;
constexpr size_t WS_ROPE = 246 * MiB;
constexpr size_t WS_HX = 250 * MiB;
constexpr size_t WS_HRKV = WS_HX + 1536 * 1024;
constexpr size_t WS_HF = WS_HRKV + 768 * 1024;
constexpr size_t WS_END = 253 * MiB;
constexpr size_t WS_WOUT1 = 253 * MiB;
constexpr int LDS_BYTES = 152 * 1024;

#define LDS_WAIT() asm volatile("s_waitcnt lgkmcnt(0)" ::: "memory")
typedef __bf16 bf16x2_hw __attribute__((ext_vector_type(2)));
__device__ __forceinline__ unsigned pk2(float lo, float hi) { const f32x2 v = {lo, hi}; return __builtin_bit_cast(unsigned, __builtin_convertvector(v, bf16x2_hw)); }
__device__ __forceinline__ unsigned f2bf(float f) { return pk2(f, 0.f) & 0xffffu; }
__device__ __forceinline__ float bf2f(unsigned short b) { return __builtin_bit_cast(float, (unsigned)b << 16); }
__device__ __forceinline__ float bflo(unsigned w) { return __builtin_bit_cast(float, w << 16); }
__device__ __forceinline__ float bfhi(unsigned w) { return __builtin_bit_cast(float, w & 0xffff0000u); }
__device__ __forceinline__ float wave_sum(float v) {
#pragma unroll
    for (int o = 1; o < 64; o <<= 1) v += __shfl_xor(v, o);
    return v;
}
__device__ __forceinline__ float sigmoidf_(float x) { return __builtin_amdgcn_rcpf(1.f + __expf(-x)); }
__device__ __forceinline__ float siluf_(float x) { return x * __builtin_amdgcn_rcpf(1.f + __expf(-x)); }
__device__ __forceinline__ int pi16(int n) { const int x = n & 15; return (n & ~15) | ((x >= 4 && x < 8) ? x + 4 : (x >= 8 && x < 12) ? x - 4 : x); }
__device__ __forceinline__ int sg32(int x) { return (x & ~31) | (16 * ((x >> 2) & 1) + 4 * ((x & 31) >> 3) + (x & 3)); }
__device__ __forceinline__ int crow(int r, int hi) { return (r & 3) + 8 * (r >> 2) + 4 * hi; }

template <int K> __device__ __forceinline__ f32x4 mma_tile(const LAS bf16_t* A, int lda, const LAS bf16_t* Bt, int ldb, int lane) {
    f32x4 acc = {0.f, 0.f, 0.f, 0.f};
    const LAS bf16_t* ap = A + (lane & 15) * lda + (lane >> 4) * 8;
    const LAS bf16_t* bp = Bt + (lane & 15) * ldb + (lane >> 4) * 8;
#pragma unroll
    for (int k = 0; k < K; k += 32) {
        const bf16x8 a = *(const LAS bf16x8*)(ap + k), b = *(const LAS bf16x8*)(bp + k);
        acc = __builtin_amdgcn_mfma_f32_16x16x32_bf16(a, b, acc, 0, 0, 0);
    }
    return acc;
}

template <int V> struct IC { static constexpr int value = V; };
template <bool KX> __device__ __forceinline__ bf16x8 frag16(const LAS bf16_t* M, int ld, int x0, int k0, int lane) {
    if constexpr (!KX) return *(const LAS bf16x8*)(M + (x0 + (lane & 15)) * ld + k0 + 8 * (lane >> 4));
    else { const LAS bf16_t* p = M + (k0 + 8 * (lane >> 4) + ((lane & 15) >> 2)) * ld + x0 + 4 * (lane & 3);
        const v4i16_t lo = __builtin_amdgcn_ds_read_tr16_b64_v4i16((LAS v4i16_t*)p), hi = __builtin_amdgcn_ds_read_tr16_b64_v4i16((LAS v4i16_t*)(p + 4 * ld));
        return (bf16x8){lo[0], lo[1], lo[2], lo[3], hi[0], hi[1], hi[2], hi[3]}; }
}
template <int K, bool AKX, bool BKX> __device__ __forceinline__ f32x4 mma_tile2(const LAS bf16_t* A, int lda, int m0, const LAS bf16_t* B, int ldb, int n0, int lane) {
    f32x4 acc = {0.f, 0.f, 0.f, 0.f};
#pragma unroll
    for (int k = 0; k < K; k += 32) acc = __builtin_amdgcn_mfma_f32_16x16x32_bf16(frag16<AKX>(A, lda, m0, k, lane), frag16<BKX>(B, ldb, n0, k, lane), acc, 0, 0, 0);
    return acc;
}
struct Args {
    const float* in[31]; float* out; unsigned char* ws; int ph_lo, ph_hi;
};
struct Ctx {
    LAS unsigned char* lds; int tid, lane, wave, G, bid;
    unsigned char* ws; float* out;
    const float* const* in;
};
__device__ __forceinline__ const float* ldin(const float* const* in, int i) { asm volatile("" : "+s"(i)); return (const float*)(const GAS float*)in[i]; }
#define INP(i) ldin(F.in, i)
__device__ __forceinline__ int fresh_lane() { int l_ = (int)__builtin_amdgcn_mbcnt_hi(~0u, __builtin_amdgcn_mbcnt_lo(~0u, 0u)); asm volatile("" : "+v"(l_)); return l_; }
enum { I_X = 0, I_C, I_POS, I_ADAW, I_ADAB, I_NORMW, I_WIN, I_QNW, I_WUQ, I_KVNW, I_WUKV, I_CONVW, I_CONVB, I_DTB, I_ALOG, I_DSKIP, I_SSDNW,
       I_MURKV, I_MUW, I_MUA, I_W0, I_WLB, I_A0, I_ALB, I_KK, I_KA, I_RK, I_LNXW, I_LNXB, I_WOUT, I_FNW };

__device__ __forceinline__ int win_src_col(int n) {
    if (n < 448) return n;
    if (n < 512) return -1;
    if (n < 1024) return 448 + (n - 512);
    if (n < 1536) return 960 + (n - 1024);
    if (n < 2560) return 1472 + (n - 1536);
    if (n < 3072) return 2504 + (n - 2560);
    if (n < 3584) return 3016 + (n - 3072);
    if (n < 4096) return 3528 + (n - 3584);
    if (n < 4608) return 4168 + (n - 4096);
    if (n < 4672) return 4040 + (n - 4608);
    if (n < 4736) return 4104 + (n - 4672);
    if (n < 4744) return 2496 + (n - 4736);
    return -1;
}
template <class Src4> __device__ __forceinline__ void transpose_item(const Src4& src4, bf16_t* WT, int ldw, LAS float* scr, int kb, int nb, int lane) {
    const int k0 = 64 * kb, n0 = 64 * nb;
#pragma unroll
    for (int i = 0; i < 16; ++i) { const int kk = 4 * i + (lane >> 4), nn = 4 * (lane & 15); const f32x4 v = src4(k0 + kk, n0 + nn);
        LAS float* d = scr + kk * 65 + nn; d[0] = v[0]; d[1] = v[1]; d[2] = v[2]; d[3] = v[3]; }
    LDS_WAIT();
    const int c = lane & 7;
#pragma unroll
    for (int j = 0; j < 8; ++j) { const int n = (lane >> 3) + 8 * j; const LAS float* sp = scr + (8 * c) * 65 + n;
        u32x4 o; o.x = pk2(sp[0 * 65], sp[1 * 65]); o.y = pk2(sp[2 * 65], sp[3 * 65]); o.z = pk2(sp[4 * 65], sp[5 * 65]); o.w = pk2(sp[6 * 65], sp[7 * 65]);
        *(u32x4*)(WT + (size_t)(n0 + n) * ldw + k0 + 8 * c) = o; }
    LDS_WAIT();
}
__device__ __forceinline__ void prep_weights(const Ctx& F, int l) {
    LAS float* scr = (LAS float*)(F.lds + F.wave * 16640);
    const int gw = F.bid * NWAVES + F.wave, NGW = F.G * NWAVES;
    const float* w_in = INP(I_WIN) + (size_t)l * DM * DIN;
    const float* w_out = INP(I_WOUT) + (size_t)l * 1536 * 1024;
    const float* wlb = INP(I_WLB) + (size_t)l * 64 * 512;
    const float* alb = INP(I_ALB) + (size_t)l * 64 * 512;
    bf16_t* WIN = (bf16_t*)(F.ws + WS_WIN); bf16_t* WOUT = (bf16_t*)(F.ws + (l == 0 ? WS_WOUT : WS_WOUT1)); bf16_t* WLW = (bf16_t*)(F.ws + WS_WLW); bf16_t* WLA = (bf16_t*)(F.ws + WS_WLA);
    constexpr int I_IN = 16 * (NIN / 64), I_OUT = 24 * 16, I_LW = 8, I_LA = 8, NITEMS = I_IN + I_OUT + I_LW + I_LA;
    for (int it = F.wave * F.G + F.bid; it < NITEMS; it += NGW) {
        int r = it;
        if (r < I_IN) { const int kb = r / (NIN / 64), nb = r % (NIN / 64);
            transpose_item([&](int k, int n) { const int sc = win_src_col(n); return sc >= 0 ? *(const f32x4*)(w_in + (size_t)k * DIN + sc) : (f32x4){0.f, 0.f, 0.f, 0.f}; }, WIN, 1024, scr, kb, nb, F.lane); continue; }
        r -= I_IN;
        if (r < I_OUT) { const int kb = r / 16, nb = r % 16;
            transpose_item([&](int k, int n) { return *(const f32x4*)(w_out + (size_t)k * 1024 + n); }, WOUT, 1536, scr, kb, nb, F.lane); continue; }
        r -= I_OUT;
        if (r < I_LW) { transpose_item([&](int k, int n) { return *(const f32x4*)(wlb + k * 512 + n); }, WLW, 64, scr, 0, r, F.lane); continue; }
        r -= I_LW;
        transpose_item([&](int k, int n) { return *(const f32x4*)(alb + k * 512 + n); }, WLA, 64, scr, 0, r, F.lane);
    }
    const float* wuq = INP(I_WUQ) + (size_t)l * 256 * 768; const float* wukv = INP(I_WUKV) + (size_t)l * 128 * 1024; const float* qnw = INP(I_QNW) + l * 256;
    bf16_t* WQ = (bf16_t*)(F.ws + WS_WQ); bf16_t* WUV = (bf16_t*)(F.ws + WS_WUV);
    const int gt = F.bid * NTHR + F.tid, NGT = F.G * NTHR;
    for (int t = F.wave * F.G + F.bid; t < 512; t += NGW) {
        const int h = t >> 7, kb = (t >> 3) & 15, ib = t & 7, row = F.lane & 15, dg = F.lane >> 4;
        const float* ap = wuq + (size_t)(16 * kb + row) * 768 + h * 192 + 4 * dg; const float* bp = wukv + (size_t)(16 * ib + row) * 1024 + h * 256 + 4 * dg;
        f32x4 av[8], bv[8];
#pragma unroll
        for (int j = 0; j < 8; ++j) { av[j] = *(const f32x4*)(ap + 16 * j); bv[j] = *(const f32x4*)(bp + 16 * j); }
        f32x4 acc = {0.f, 0.f, 0.f, 0.f};
#pragma unroll
        for (int j = 0; j < 8; ++j)
#pragma unroll
            for (int q = 0; q < 4; ++q) acc = __builtin_amdgcn_mfma_f32_16x16x4f32(av[j][q], bv[j][q], acc, 0, 0, 0);
        const int k0 = 16 * kb + 4 * dg; const f32x4 qn = *(const f32x4*)(qnw + k0);
        u32x2 o; o.x = pk2(acc[0] * qn[0], acc[1] * qn[1]); o.y = pk2(acc[2] * qn[2], acc[3] * qn[3]);
        *(u32x2*)(WQ + (size_t)(h * 192 + 16 * ib + row) * 256 + k0) = o;
    }
    for (int e = gt; e < 4 * 64 * 256; e += NGT) {
        const int k = e & 255, n = (e >> 14) * 192 + 128 + ((e >> 8) & 63);
        WQ[(size_t)n * 256 + k] = (bf16_t)f2bf(wuq[(size_t)k * 768 + n] * qnw[k]);
    }
    for (int e = gt; e < 512 * 512; e += NGT) {
        const int n = e >> 9, k = e & 511, h = n >> 7, d = n & 127, h2 = k >> 7, c = k & 127;
        WUV[e] = (h == h2) ? (bf16_t)f2bf(wukv[(size_t)c * 1024 + h * 256 + 128 + d]) : (bf16_t)0;
    }
}
__device__ __forceinline__ void p0_mod(const Ctx& F) {
    const int gw = F.bid * NWAVES + F.wave, NGW = F.G * NWAVES;
    float* MOD = (float*)(F.ws + WS_CTL + CTL_MOD);
    (void)gw; (void)NGW;
    for (int it = F.wave * F.G + F.bid; it < 2 * 12 * 32; it += NWAVES * F.G) {
        const int l = it / 384, r = it % 384, cb = r / 32, ks = r % 32;
        const float* aw = INP(I_ADAW) + (size_t)l * DM * 3072 + (size_t)(ks * 32) * 3072 + cb * 256 + F.lane * 4;
        const float* cc = INP(I_C);
        f32x4 a0 = {0.f, 0.f, 0.f, 0.f}, a1 = a0;
#pragma unroll
        for (int k = 0; k < 32; ++k) { const f32x4 w = *(const f32x4*)(aw + (size_t)k * 3072); const float s0 = siluf_(cc[ks * 32 + k]), s1 = siluf_(cc[DM + ks * 32 + k]); a0 += w * s0; a1 += w * s1; }
        if (ks == 0) { const f32x4 bb = *(const f32x4*)(INP(I_ADAB) + l * 3072 + cb * 256 + F.lane * 4); a0 += bb; a1 += bb; }
        float* m0 = MOD + (size_t)(l * 2 + 0) * 3072 + cb * 256 + F.lane * 4; float* m1 = m0 + 3072;
#pragma unroll
        for (int j = 0; j < 4; ++j) { atomicAdd(m0 + j, a0[j]); atomicAdd(m1 + j, a1[j]); }
    }
}
__device__ __forceinline__ void p0_zero_ctl(const Ctx& F) {
    const int gt = F.bid * NTHR + F.tid, NGT = F.G * NTHR; const u32x4 z = {0u, 0u, 0u, 0u};
    for (int e = gt; e < (int)((CTL_RSLOT - CTL_SSQ) / 16); e += NGT) *(u32x4*)(F.ws + WS_CTL + CTL_SSQ + (size_t)e * 16) = z;
    for (int e = gt; e < (2 * 64 * 256) / 16; e += NGT) *(u32x4*)(F.ws + WS_CTL + CTL_RCNT + (size_t)e * 16) = z;
}
__device__ __forceinline__ void p0_rope(const Ctx& F) {
    float* ROPE = (float*)(F.ws + WS_ROPE); const int* pos = (const int*)INP(I_POS);
    for (int e = F.bid * NTHR + F.tid; e < NT * 32; e += F.G * NTHR) {
        const int m = e >> 5, i = e & 31;
        const float invf = powf(10000.f, -(float)i / 32.f); const float ang = (float)pos[m] * invf;
        const double a = (double)ang; const double kq = __builtin_rint(a * 0.15915494309189535); const float rr = (float)(a - kq * 6.283185307179586);
        ROPE[(size_t)m * 64 + i] = cosf(rr); ROPE[(size_t)m * 64 + 32 + i] = sinf(rr);
    }
}
__device__ __forceinline__ void p1_norm(const Ctx& F, int l) {
    const float* xin = (l == 0) ? INP(I_X) : F.out;
    const float* nw = INP(I_NORMW) + l * DM; const float* MOD = (const float*)(F.ws + WS_CTL + CTL_MOD);
    bf16_t* XN = (bf16_t*)(F.ws + WS_XN);
    const int gw = F.bid * NWAVES + F.wave, NGW = F.G * NWAVES;
    for (int m = gw; m < NT; m += NGW) {
        const int b = m >> 13; const float* md = MOD + (size_t)(l * 2 + b) * 3072;
        const f32x4* xr = (const f32x4*)(xin + (size_t)m * DM) + F.lane;
        f32x4 v[4]; float s = 0.f;
#pragma unroll
        for (int j = 0; j < 4; ++j) { v[j] = __builtin_nontemporal_load(xr + 64 * j); s += v[j].x * v[j].x + v[j].y * v[j].y + v[j].z * v[j].z + v[j].w * v[j].w; }
        const float rstd = 1.f / sqrtf(wave_sum(s) * (1.f / DM) + EPS);
        unsigned long long* o8 = (unsigned long long*)(XN + (size_t)m * DM) + F.lane;
#pragma unroll
        for (int j = 0; j < 4; ++j) { const int c0 = 4 * F.lane + 256 * j;
            const f32x4 w = *(const f32x4*)(nw + c0), sh = *(const f32x4*)(md + c0), sc = *(const f32x4*)(md + 1024 + c0);
            const f32x4 y = v[j] * rstd * w * (sc + 1.f) + sh;
            o8[64 * j] = (unsigned long long)pk2(y.x, y.y) | ((unsigned long long)pk2(y.z, y.w) << 32); }
    }
}
__device__ __forceinline__ u32x4 pack8(f32x4 a, f32x4 b) { u32x4 w; w.x = pk2(a[0], a[1]); w.y = pk2(a[2], a[3]); w.z = pk2(b[0], b[1]); w.w = pk2(b[2], b[3]); return w; }
struct EpiIn {
    static constexpr bool AFTER_DRAIN = false;
    unsigned char* ws; int l;
    __device__ __forceinline__ void operator()(const f32x4 (&acc)[2][2][4][2], const pg8::Unit& u, int wr, int wc, int fr, int fq) const {
        { int ln_ = (int)__builtin_amdgcn_mbcnt_hi(~0u, __builtin_amdgcn_mbcnt_lo(~0u, 0u)); asm volatile("" : "+v"(ln_)); fr = ln_ & 15; fq = ln_ >> 4; }
        const int pn = u.pn; size_t bo; int ld, c0;
        if (pn == 0) { bo = WS_QLAT; ld = 256; c0 = 0; } else if (pn == 1) { bo = WS_KVL; ld = 256; c0 = 0; }
        else if (pn < 4) { bo = WS_GATES; ld = 1536; c0 = (pn - 2) * 256; } else if (pn < 6) { bo = WS_GATES; ld = 1536; c0 = 512 + (pn - 4) * 256; }
        else if (pn < 10) { bo = WS_XBC; ld = 1024; c0 = (pn - 6) * 256; } else if (pn < 12) { bo = WS_R; ld = 512; c0 = (pn - 10) * 256; }
        else if (pn < 14) { bo = WS_K; ld = 512; c0 = (pn - 12) * 256; } else if (pn < 16) { bo = WS_V; ld = 512; c0 = (pn - 14) * 256; }
        else if (pn < 18) { bo = WS_GATES; ld = 1536; c0 = 1024 + (pn - 16) * 256; } else { bo = WS_F; ld = 144; c0 = 0; }
        bf16_t* base = (bf16_t*)(ws + bo); float* F = (float*)(ws + WS_F);
        float* ssq_q = (float*)(ws + WS_CTL + CTL_SSQ) + (size_t)(l * 2) * NT; float* ssq_kv = ssq_q + NT;
        const int row0 = u.pm * 256 + wr * 64 + fr, col0 = wc * 32 + 8 * fq;
        if (pn < 18) {
#pragma unroll
            for (int ai = 0; ai < 2; ++ai)
#pragma unroll
                for (int m = 0; m < 4; ++m) { const int row = row0 + ai * 128 + m * 16; bf16_t* rp = base + (size_t)row * ld + c0 + col0;
#pragma unroll
                    for (int bj = 0; bj < 2; ++bj) *(u32x4*)(rp + bj * 128) = pack8(acc[ai][bj][m][0], acc[ai][bj][m][1]);
                    if (m == 3 && pn >= 6 && pn < 16) {
                        const int chunk = row >> 6;
                        if (pn < 10) { if (fr >= 13) { bf16_t* hp = (bf16_t*)(ws + WS_HX) + (size_t)(chunk * 3 + (fr - 13)) * 1024 + c0 + col0;
#pragma unroll
                                for (int bj = 0; bj < 2; ++bj) *(u32x4*)(hp + bj * 128) = pack8(acc[ai][bj][m][0], acc[ai][bj][m][1]); } }
                        else if (fr == 15) { bf16_t* hp = (bf16_t*)(ws + WS_HRKV) + (size_t)((pn - 10) >> 1) * NCHK * 512 + (size_t)chunk * 512 + c0 + col0;
#pragma unroll
                            for (int bj = 0; bj < 2; ++bj) *(u32x4*)(hp + bj * 128) = pack8(acc[ai][bj][m][0], acc[ai][bj][m][1]); } }
                    if (pn < 2) { float s = 0.f;
#pragma unroll
                        for (int bj = 0; bj < 2; ++bj) if (pn == 0 || bj == 0) {
#pragma unroll
                            for (int n = 0; n < 2; ++n) { const f32x4 x = acc[ai][bj][m][n]; s += x[0] * x[0] + x[1] * x[1] + x[2] * x[2] + x[3] * x[3]; } }
                        s += __shfl_xor(s, 16); s += __shfl_xor(s, 32);
                        if (fq == 0) atomicAdd((pn == 0 ? ssq_q : ssq_kv) + row, s); } }
        } else {
#pragma unroll
            for (int ai = 0; ai < 2; ++ai)
#pragma unroll
                for (int m = 0; m < 4; ++m) { const int row = row0 + ai * 128 + m * 16;
#pragma unroll
                    for (int bj = 0; bj < 2; ++bj) { const int c = bj * 128 + col0; if (c < 136) { float* fp = F + (size_t)row * 144 + c; *(f32x4*)fp = acc[ai][bj][m][0]; *(f32x4*)(fp + 4) = acc[ai][bj][m][1]; } }
                    if (m == 3 && fr == 15) { float* hf = (float*)(ws + WS_HF) + (size_t)(row >> 6) * 128 + col0; *(f32x4*)hf = acc[ai][0][m][0]; *(f32x4*)(hf + 4) = acc[ai][0][m][1]; } }
        }
    }
};
struct EpiQ {
    static constexpr bool AFTER_DRAIN = false;
    unsigned char* ws; int l;
    __device__ __forceinline__ void operator()(const f32x4 (&acc)[2][2][4][2], const pg8::Unit& u, int wr, int wc, int fr, int fq) const {
        { int ln_ = (int)__builtin_amdgcn_mbcnt_hi(~0u, __builtin_amdgcn_mbcnt_lo(~0u, 0u)); asm volatile("" : "+v"(ln_)); fr = ln_ & 15; fq = ln_ >> 4; }
        bf16_t* Q = (bf16_t*)(ws + WS_Q); const float* ssq = (const float*)(ws + WS_CTL + CTL_SSQ) + (size_t)(l * 2) * NT;
        const int row0 = u.pm * 256 + wr * 64 + fr, c0 = u.pn * 256 + wc * 32 + 8 * fq;
#pragma unroll
        for (int ai = 0; ai < 2; ++ai)
#pragma unroll
            for (int m = 0; m < 4; ++m) { const int row = row0 + ai * 128 + m * 16; const float sc = QSCALE / sqrtf(ssq[row] * (1.f / 256.f) + EPS); bf16_t* qp = Q + (size_t)row * 768 + c0;
#pragma unroll
                for (int bj = 0; bj < 2; ++bj) *(u32x4*)(qp + bj * 128) = pack8(acc[ai][bj][m][0] * sc, acc[ai][bj][m][1] * sc); }
    }
};
struct EpiUV {
    static constexpr bool AFTER_DRAIN = false;
    bf16_t* gates;
    __device__ __forceinline__ void operator()(const f32x4 (&acc)[2][2][4][2], const pg8::Unit& u, int wr, int wc, int fr, int fq) const {
        { int ln_ = (int)__builtin_amdgcn_mbcnt_hi(~0u, __builtin_amdgcn_mbcnt_lo(~0u, 0u)); asm volatile("" : "+v"(ln_)); fr = ln_ & 15; fq = ln_ >> 4; }
        const int row0 = u.pm * 256 + wr * 64 + fr;
#pragma unroll
        for (int ai = 0; ai < 2; ++ai) {
            u32x4 gwv[4][2];
#pragma unroll
            for (int m = 0; m < 4; ++m)
#pragma unroll
                for (int bj = 0; bj < 2; ++bj) gwv[m][bj] = *(const u32x4*)(gates + (size_t)(row0 + ai * 128 + m * 16) * 1536 + u.pn * 256 + bj * 128 + wc * 32 + 8 * fq);
#pragma unroll
            for (int m = 0; m < 4; ++m) { const int row = row0 + ai * 128 + m * 16;
#pragma unroll
                for (int bj = 0; bj < 2; ++bj) { const int c = u.pn * 256 + bj * 128 + wc * 32 + 8 * fq; u32x4* gp = (u32x4*)(gates + (size_t)row * 1536 + c); const u32x4 gw = gwv[m][bj];
                    f32x4 v0 = acc[ai][bj][m][0], v1 = acc[ai][bj][m][1];
                    v0[0] *= siluf_(bflo(gw.x)); v0[1] *= siluf_(bfhi(gw.x)); v0[2] *= siluf_(bflo(gw.y)); v0[3] *= siluf_(bfhi(gw.y));
                    v1[0] *= siluf_(bflo(gw.z)); v1[1] *= siluf_(bfhi(gw.z)); v1[2] *= siluf_(bflo(gw.w)); v1[3] *= siluf_(bfhi(gw.w));
                    *gp = pack8(v0, v1); } }
            asm volatile("" ::: "memory"); }
    }
};
struct EpiOutNorm {
    static constexpr bool AFTER_DRAIN = true;
    const float* xin; float* xout; const float* gate; unsigned char* ws; const float* nw; const float* mod1; int mode; int use;
    __device__ __forceinline__ void fused(f32x4 (&acc)[2][2][4][2], const pg8::Unit& u, int wr, int wc, LAS unsigned char* lds, int wid) const {
        const int lane = fresh_lane(), fr = lane & 15, fq = lane >> 4;
        const int row0 = u.pm * 256 + wr * 64 + fr; const int bsel = (u.pm * 256) >> 13;
        LAS float* P = (LAS float*)lds;
        LAS float* S = (LAS float*)(lds + 4096);
        LAS unsigned* flag = (LAS unsigned*)(lds + 5120);
        f32x4 gt_[2][2];
#pragma unroll
        for (int bj = 0; bj < 2; ++bj) { const float* gp = gate + (size_t)bsel * 3072 + u.pn * 256 + bj * 128 + wc * 32 + 8 * fq; gt_[bj][0] = *(const f32x4*)gp; gt_[bj][1] = *(const f32x4*)(gp + 4); }
#pragma unroll
        for (int ai = 0; ai < 2; ++ai) {
            f32x4 xr_[4][2][2];
#pragma unroll
            for (int m = 0; m < 4; ++m)
#pragma unroll
                for (int bj = 0; bj < 2; ++bj) { const size_t off = (size_t)(row0 + ai * 128 + m * 16) * DM + u.pn * 256 + bj * 128 + wc * 32 + 8 * fq;
                    xr_[m][bj][0] = __builtin_nontemporal_load((const f32x4*)(xin + off)); xr_[m][bj][1] = __builtin_nontemporal_load((const f32x4*)(xin + off + 4)); }
#pragma unroll
            for (int m = 0; m < 4; ++m) { float sq = 0.f;
#pragma unroll
                for (int bj = 0; bj < 2; ++bj) {
                    const f32x4 v0 = xr_[m][bj][0] + gt_[bj][0] * acc[ai][bj][m][0], v1 = xr_[m][bj][1] + gt_[bj][1] * acc[ai][bj][m][1]; acc[ai][bj][m][0] = v0; acc[ai][bj][m][1] = v1;
                    sq += v0[0] * v0[0] + v0[1] * v0[1] + v0[2] * v0[2] + v0[3] * v0[3] + v1[0] * v1[0] + v1[1] * v1[1] + v1[2] * v1[2] + v1[3] * v1[3]; }
                sq += __shfl_xor(sq, 16); sq += __shfl_xor(sq, 32);
                if (fq == 0) P[(ai * 128 + wr * 64 + m * 16 + fr) * 4 + wc] = sq; }
            asm volatile("" ::: "memory"); }
        asm volatile("s_waitcnt lgkmcnt(0)" ::: "memory"); __builtin_amdgcn_s_barrier(); asm volatile("" ::: "memory");
        float* slots = (float*)(ws + WS_CTL + CTL_RSLOT) + (size_t)use * NT * 4; unsigned* cnt = (unsigned*)(ws + WS_CTL + CTL_RCNT) + (use * 64 + u.pm) * 64;
        const int prow = wid * 32 + (lane & 31);
        if (lane < 32) { const f32x4 pp = *(const LAS f32x4*)(P + prow * 4); const float t = (pp[0] + pp[1]) + (pp[2] + pp[3]);
            __hip_atomic_store(slots + ((size_t)(u.pm * 256 + prow) * 4 + u.pn), t, __ATOMIC_RELAXED, __HIP_MEMORY_SCOPE_AGENT); }
        asm volatile("s_waitcnt vmcnt(0)" ::: "memory");
        if (lane == 0) __hip_atomic_fetch_add(cnt, 1u, __ATOMIC_RELAXED, __HIP_MEMORY_SCOPE_AGENT);
        if (wid == 0) { unsigned spins = 0;
            for (;;) { if ((unsigned)__builtin_amdgcn_readfirstlane(__hip_atomic_load(cnt, __ATOMIC_RELAXED, __HIP_MEMORY_SCOPE_AGENT)) >= 32u) break;
                if (++spins > (1u << 22)) break;
                __builtin_amdgcn_s_sleep(2); }
            __builtin_amdgcn_fence(__ATOMIC_ACQUIRE, "agent");
            if (lane == 0) flag[0] = 1u; }
        asm volatile("s_waitcnt vmcnt(0) lgkmcnt(0)" ::: "memory"); __builtin_amdgcn_s_barrier(); asm volatile("" ::: "memory");
        if (lane < 32) { const float* sl = slots + (size_t)(u.pm * 256 + prow) * 4; float q = 0.f;
#pragma unroll
            for (int t = 0; t < 4; ++t) q += __hip_atomic_load(sl + t, __ATOMIC_RELAXED, __HIP_MEMORY_SCOPE_AGENT);
            S[prow] = __builtin_amdgcn_rsqf(q * (1.f / DM) + EPS); }
        asm volatile("s_waitcnt vmcnt(0) lgkmcnt(0)" ::: "memory"); __builtin_amdgcn_s_barrier(); asm volatile("" ::: "memory");
        const float* shf = mod1 + (size_t)bsel * 3072; bf16_t* XN = (bf16_t*)(ws + WS_XN);
        f32x4 w_[2][2], sh_[2][2], sc_[2][2];
#pragma unroll
        for (int bj = 0; bj < 2; ++bj) { const int c = u.pn * 256 + bj * 128 + wc * 32 + 8 * fq; w_[bj][0] = *(const f32x4*)(nw + c); w_[bj][1] = *(const f32x4*)(nw + c + 4);
            if (mode == 0) { sh_[bj][0] = *(const f32x4*)(shf + c); sh_[bj][1] = *(const f32x4*)(shf + c + 4); sc_[bj][0] = *(const f32x4*)(shf + 1024 + c) + 1.f; sc_[bj][1] = *(const f32x4*)(shf + 1024 + c + 4) + 1.f; }
            else { sh_[bj][0] = sh_[bj][1] = sc_[bj][0] = sc_[bj][1] = (f32x4){0.f, 0.f, 0.f, 0.f}; } }
#pragma unroll
        for (int ai = 0; ai < 2; ++ai)
#pragma unroll
            for (int m = 0; m < 4; ++m) { const int rl = ai * 128 + wr * 64 + m * 16 + fr, row = u.pm * 256 + rl; const float rs = S[rl];
#pragma unroll
                for (int bj = 0; bj < 2; ++bj) { const int c = u.pn * 256 + bj * 128 + wc * 32 + 8 * fq; const size_t off = (size_t)row * DM + c;
                    const f32x4 v0 = acc[ai][bj][m][0], v1 = acc[ai][bj][m][1];
                    if (mode == 0) { *(f32x4*)(xout + off) = v0; *(f32x4*)(xout + off + 4) = v1;
                        *(u32x4*)(XN + off) = pack8(v0 * rs * w_[bj][0] * sc_[bj][0] + sh_[bj][0], v1 * rs * w_[bj][1] * sc_[bj][1] + sh_[bj][1]); }
                    else { *(f32x4*)(xout + off) = v0 * rs * w_[bj][0]; *(f32x4*)(xout + off + 4) = v1 * rs * w_[bj][1]; } } }
    }
};
struct EpiOut {
    static constexpr bool AFTER_DRAIN = false;
    const float* xin; float* xout; const float* gate;
    __device__ __forceinline__ void operator()(const f32x4 (&acc)[2][2][4][2], const pg8::Unit& u, int wr, int wc, int fr, int fq) const {
        { int ln_ = (int)__builtin_amdgcn_mbcnt_hi(~0u, __builtin_amdgcn_mbcnt_lo(~0u, 0u)); asm volatile("" : "+v"(ln_)); fr = ln_ & 15; fq = ln_ >> 4; }
        const int row0 = u.pm * 256 + wr * 64 + fr;
#pragma unroll
        for (int bj = 0; bj < 2; ++bj) { const int c = u.pn * 256 + bj * 128 + wc * 32 + 8 * fq;
#pragma unroll
            for (int ai = 0; ai < 2; ++ai)
#pragma unroll
                for (int m = 0; m < 4; ++m) { const int row = row0 + ai * 128 + m * 16; const float* gp = gate + (size_t)(row >> 13) * 3072 + c;
                    const f32x4 g0 = *(const f32x4*)gp, g1 = *(const f32x4*)(gp + 4);
                    const size_t off = (size_t)row * DM + c; const f32x4 x0 = *(const f32x4*)(xin + off), x1 = *(const f32x4*)(xin + off + 4);
                    *(f32x4*)(xout + off) = x0 + g0 * acc[ai][bj][m][0]; *(f32x4*)(xout + off + 4) = x1 + g1 * acc[ai][bj][m][1]; } }
    }
};

__device__ __forceinline__ void p3a_extras(const Ctx& F, int l) {
    const int tid_ = F.wave * 64 + fresh_lane();
    const int gt = F.bid * NTHR + tid_, NGT = F.G * NTHR;
    const bf16_t* KVL = (const bf16_t*)(F.ws + WS_KVL); bf16_t* KVB = (bf16_t*)(F.ws + WS_KVB);
    const float* ssq = (const float*)(F.ws + WS_CTL + CTL_SSQ) + (size_t)(l * 2 + 1) * NT; const float* kvnw = INP(I_KVNW) + l * 128;
    const float* ROPE = (const float*)(F.ws + WS_ROPE);
    for (int e0 = gt; e0 < NT * 24; e0 += 3 * NGT) {
        u32x4 w[3]; u32x2 ra[3], rb[3]; f32x4 cs[3], sn[3]; float sq[3];
#pragma unroll
        for (int i = 0; i < 3; ++i) { const int e = e0 + i * NGT; w[i] = (u32x4){0u, 0u, 0u, 0u}; ra[i] = (u32x2){0u, 0u}; rb[i] = ra[i]; cs[i] = (f32x4){0.f, 0.f, 0.f, 0.f}; sn[i] = cs[i]; sq[i] = 0.f;
            if (e < NT * 24) { const int m = e / 24, g = e % 24;
                if (g < 16) { w[i] = *(const u32x4*)(KVL + (size_t)m * 256 + 8 * g); sq[i] = ssq[m]; }
                else { const int i0 = 4 * (g - 16); ra[i] = *(const u32x2*)(KVL + (size_t)m * 256 + 128 + i0); rb[i] = *(const u32x2*)(KVL + (size_t)m * 256 + 160 + i0);
                    cs[i] = *(const f32x4*)(ROPE + (size_t)m * 64 + i0); sn[i] = *(const f32x4*)(ROPE + (size_t)m * 64 + 32 + i0); } } }
#pragma unroll
        for (int i = 0; i < 3; ++i) { const int e = e0 + i * NGT;
            if (e < NT * 24) { const int m = e / 24, g = e % 24;
                if (g < 16) { const float rs = 1.f / sqrtf(sq[i] * (1.f / 128.f) + EPS);
                    const f32x4 n0 = *(const f32x4*)(kvnw + 8 * g), n1 = *(const f32x4*)(kvnw + 8 * g + 4);
                    u32x4 o; o.x = pk2(bflo(w[i].x) * rs * n0[0], bfhi(w[i].x) * rs * n0[1]); o.y = pk2(bflo(w[i].y) * rs * n0[2], bfhi(w[i].y) * rs * n0[3]);
                    o.z = pk2(bflo(w[i].z) * rs * n1[0], bfhi(w[i].z) * rs * n1[1]); o.w = pk2(bflo(w[i].w) * rs * n1[2], bfhi(w[i].w) * rs * n1[3]);
                    *(u32x4*)(KVB + (size_t)m * 192 + 8 * g) = o;
                } else { const int i0 = 4 * (g - 16); const u32x2 a_ = ra[i], b_ = rb[i];
                    const f32x4 x1 = {bflo(a_.x), bfhi(a_.x), bflo(a_.y), bfhi(a_.y)}, x2 = {bflo(b_.x), bfhi(b_.x), bflo(b_.y), bfhi(b_.y)};
                    const f32x4 o1 = x1 * cs[i] - x2 * sn[i], o2 = x1 * sn[i] + x2 * cs[i];
                    u32x2 w1, w2; w1.x = pk2(o1[0], o1[1]); w1.y = pk2(o1[2], o1[3]); w2.x = pk2(o2[0], o2[1]); w2.y = pk2(o2[2], o2[3]);
                    *(u32x2*)(KVB + (size_t)m * 192 + 128 + i0) = w1; *(u32x2*)(KVB + (size_t)m * 192 + 160 + i0) = w2; } } }
    }
}

__device__ __forceinline__ int ssd_win_col(int g, int o) { return o < 256 ? 256 * g + o : o < 384 ? 512 + 128 * g + (o - 256) : 768 + 128 * g + (o - 384); }
template <int VAR = 0> __device__ __forceinline__ void p3b_ssd(const Ctx& F, int l) {
    constexpr int SC_C = 0, SC_B = 17408, SC_BT = 34816, SC_XST = 53248, SC_CB = 90112, SC_G = 106752, SC_XSD = 115968, SC_DT = 125184, SC_AC = 127232, SC_YS = 129280  , SC_STS = 137472  ;
    static_assert(SC_STS + 16384 <= LDS_BYTES - 256, "ssd lds map");
    LAS bf16_t* Cg = (LAS bf16_t*)(F.lds + SC_C); LAS bf16_t* Bg = (LAS bf16_t*)(F.lds + SC_B); LAS bf16_t* BT = (LAS bf16_t*)(F.lds + SC_BT);
    LAS bf16_t* XST = (LAS bf16_t*)(F.lds + SC_XST); LAS float* CB = (LAS float*)(F.lds + SC_CB); LAS bf16_t* Gh = (LAS bf16_t*)(F.lds + SC_G);
    LAS bf16_t* YS = (LAS bf16_t*)(F.lds + SC_YS); LAS bf16_t* STS = (LAS bf16_t*)(F.lds + SC_STS);
    LAS bf16_t* XSD = (LAS bf16_t*)(F.lds + SC_XSD); LAS float* DT = (LAS float*)(F.lds + SC_DT); LAS float* AC = (LAS float*)(F.lds + SC_AC);
    bf16_t* XBC = (bf16_t*)(F.ws + WS_XBC); const bf16_t* HX = (const bf16_t*)(F.ws + WS_HX); const float* Ff = (const float*)(F.ws + WS_F);
    bf16_t* Cbuf = (bf16_t*)(F.ws + WS_CB); float* ECUM = (float*)(F.ws + WS_ECUM); float* CDEC = (float*)(F.ws + WS_CDEC); bf16_t* YD = (bf16_t*)(F.ws + WS_YD);
    const float* convw = INP(I_CONVW) + (size_t)l * 4 * 1024; const float* convb = INP(I_CONVB) + l * 1024;
    const float* dtb = INP(I_DTB) + l * 8; const float* alog = INP(I_ALOG) + l * 8; const float* dskip = INP(I_DSKIP) + l * 8;
    const int tid = F.tid, lane = F.lane, wave = F.wave;
    for (int c = F.bid; c < NCHK; c += F.G) {
        const int m0 = 64 * c; const bool first = (c & 127) == 0;
        u32x4 nxr[11];
        auto conv_fetch = [&](int g_, int tid_) { const int cgp = tid_ & 63, rg = tid_ >> 6, col = ssd_win_col(g_, 8 * cgp), t0 = 8 * rg;
#pragma unroll
            for (int i = 0; i < 11; ++i) { const int t = t0 - 3 + i;
                if (t >= 0) nxr[i] = *(const u32x4*)(XBC + (size_t)(m0 + t) * 1024 + col);
                else if (!first) nxr[i] = *(const u32x4*)(HX + (size_t)((c - 1) * 3 + i) * 1024 + col);
                else nxr[i] = (u32x4){0u, 0u, 0u, 0u}; }
            };
        conv_fetch(0, tid);
        {
            const int t = lane;
            { const int h = wave;
                const float raw = Ff[(size_t)(m0 + t) * 144 + 128 + h] + dtb[h];
                const float dt = raw > 20.f ? raw : log1pf(expf(raw));
                float v = dt * (-expf(alog[h]));
#pragma unroll
                for (int o = 1; o < 64; o <<= 1) { const float y = __shfl_up(v, o); if (lane >= o) v += y; }
                DT[h * 64 + t] = dt; AC[h * 64 + t] = v;
                const float ev = expf(v); ECUM[(size_t)(c * 8 + h) * 64 + t] = ev; if (t == 63) CDEC[c * 8 + h] = ev;
            }
        }
        for (int g = 0; g < 2; ++g) {
            if (!(VAR & 1)) {
                const int cgp = tid & 63, rg = tid >> 6, col = ssd_win_col(g, 8 * cgp), t0 = 8 * rg;
                u32x4 xr[11];
#pragma unroll
                for (int i = 0; i < 11; ++i) xr[i] = nxr[i];
                float wv[4][8], bv8[8];
#pragma unroll
                for (int j = 0; j < 4; ++j) { const f32x4 a = *(const f32x4*)(convw + j * 1024 + col), b2 = *(const f32x4*)(convw + j * 1024 + col + 4);
                    wv[j][0] = a[0]; wv[j][1] = a[1]; wv[j][2] = a[2]; wv[j][3] = a[3]; wv[j][4] = b2[0]; wv[j][5] = b2[1]; wv[j][6] = b2[2]; wv[j][7] = b2[3]; }
                { const f32x4 a = *(const f32x4*)(convb + col), b2 = *(const f32x4*)(convb + col + 4); bv8[0] = a[0]; bv8[1] = a[1]; bv8[2] = a[2]; bv8[3] = a[3]; bv8[4] = b2[0]; bv8[5] = b2[1]; bv8[6] = b2[2]; bv8[7] = b2[3]; }
                float y[8][8];
#pragma unroll
                for (int e = 0; e < 8; ++e) {
                    const unsigned x0[4] = {xr[e].x, xr[e].y, xr[e].z, xr[e].w}, x1[4] = {xr[e + 1].x, xr[e + 1].y, xr[e + 1].z, xr[e + 1].w}, x2[4] = {xr[e + 2].x, xr[e + 2].y, xr[e + 2].z, xr[e + 2].w}, x3[4] = {xr[e + 3].x, xr[e + 3].y, xr[e + 3].z, xr[e + 3].w};
#pragma unroll
                    for (int k = 0; k < 8; ++k) { const int q = k >> 1;
                        const float a0 = (k & 1) ? bfhi(x0[q]) : bflo(x0[q]), a1 = (k & 1) ? bfhi(x1[q]) : bflo(x1[q]), a2 = (k & 1) ? bfhi(x2[q]) : bflo(x2[q]), a3 = (k & 1) ? bfhi(x3[q]) : bflo(x3[q]);
                        y[e][k] = siluf_(wv[0][k] * a0 + wv[1][k] * a1 + wv[2][k] * a2 + wv[3][k] * a3 + bv8[k]); } }
                if (cgp >= 32) { LAS bf16_t* nat = (cgp < 48) ? Bg + 8 * (cgp - 32) : Cg + 8 * (cgp - 48);
#pragma unroll
                    for (int e = 0; e < 8; ++e) { u32x4 o; o.x = pk2(y[e][0], y[e][1]); o.y = pk2(y[e][2], y[e][3]); o.z = pk2(y[e][4], y[e][5]); o.w = pk2(y[e][6], y[e][7]); *(LAS u32x4*)(nat + (t0 + e) * 136) = o; } }
                if (cgp < 48) { LAS bf16_t* trn = (cgp < 32) ? XST + (8 * cgp) * 72 : BT + (8 * (cgp - 32)) * 72;
#pragma unroll
                    for (int k = 0; k < 8; ++k) { u32x4 o; o.x = pk2(y[0][k], y[1][k]); o.y = pk2(y[2][k], y[3][k]); o.z = pk2(y[4][k], y[5][k]); o.w = pk2(y[6][k], y[7][k]); *(LAS u32x4*)(trn + k * 72 + t0) = o; } }
            }
            __syncthreads();
            if (g == 0) conv_fetch(1, tid);
#pragma unroll
            for (int i = 0; i < 2; ++i) { const int idx = tid + 512 * i, t = idx >> 4, c8 = idx & 15;
                *(u32x4*)(Cbuf + (size_t)(m0 + t) * 256 + g * 128 + c8 * 8) = *(const LAS u32x4*)(Cg + t * 136 + c8 * 8); }
#pragma unroll
            for (int i = 0; i < 2; ++i) { const int idx = 2 * wave + i, ti = idx >> 2, si = idx & 3;
                const f32x4 acc = mma_tile<128>(Cg + ti * 16 * 136, 136, Bg + si * 16 * 136, 136, lane);
#pragma unroll
                for (int r = 0; r < 4; ++r) CB[(ti * 16 + 4 * (lane >> 4) + r) * 68 + si * 16 + (lane & 15)] = acc[r]; }
            __syncthreads();
            if (!(VAR & 2)) {
                const int hl = wave >> 1, hf = wave & 1, h = 4 * g + hl, fr = lane & 15, fk = lane >> 4;
                const LAS float* ACh = AC + h * 64; const LAS float* DTh = DT + h * 64; const float a63 = ACh[63], dsk = dskip[h];
#pragma unroll
                for (int ti2 = 0; ti2 < 2; ++ti2) { const int ti = 2 * hf + ti2, t = 16 * ti + fr; const float at = ACh[t];
                    bf16x8 ga[2];
#pragma unroll
                    for (int ks = 0; ks < 2; ++ks) { const int s0 = 32 * ks + 8 * fk;
                        const f32x4 c0 = *(const LAS f32x4*)(CB + t * 68 + s0), c1 = *(const LAS f32x4*)(CB + t * 68 + s0 + 4), a0 = *(const LAS f32x4*)(ACh + s0), a1 = *(const LAS f32x4*)(ACh + s0 + 4), d0 = *(const LAS f32x4*)(DTh + s0), d1 = *(const LAS f32x4*)(DTh + s0 + 4);
                        float gv[8];
#pragma unroll
                        for (int j = 0; j < 4; ++j) { gv[j] = (s0 + j <= t) ? c0[j] * __expf(at - a0[j]) * d0[j] : 0.f; gv[4 + j] = (s0 + 4 + j <= t) ? c1[j] * __expf(at - a1[j]) * d1[j] : 0.f; }
                        u32x4 w; w.x = pk2(gv[0], gv[1]); w.y = pk2(gv[2], gv[3]); w.z = pk2(gv[4], gv[5]); w.w = pk2(gv[6], gv[7]); ga[ks] = __builtin_bit_cast(bf16x8, w); }
#pragma unroll
                    for (int pi = 0; pi < 4; ++pi) { f32x4 acc = {0.f, 0.f, 0.f, 0.f};
#pragma unroll
                        for (int ks = 0; ks < 2; ++ks) acc = __builtin_amdgcn_mfma_f32_16x16x32_bf16(*(const LAS bf16x8*)(XST + (64 * hl + 16 * pi + fr) * 72 + 32 * ks + 8 * fk), ga[ks], acc, 0, 0, 0);
                        float yv[4];
#pragma unroll
                        for (int r = 0; r < 4; ++r) yv[r] = acc[r] + dsk * bf2f(XST[(64 * hl + 16 * pi + 4 * fk + r) * 72 + t]);
                        u32x2 o; o.x = pk2(yv[0], yv[1]); o.y = pk2(yv[2], yv[3]);
                        *(u32x2*)(YD + (size_t)(m0 + t) * 512 + 64 * h + 16 * pi + 4 * fk) = o; }
                }
                {   float fac[2][8];
#pragma unroll
                    for (int ks = 0; ks < 2; ++ks) { const int s0 = 32 * ks + 8 * fk; const f32x4 a0 = *(const LAS f32x4*)(ACh + s0), a1 = *(const LAS f32x4*)(ACh + s0 + 4), d0 = *(const LAS f32x4*)(DTh + s0), d1 = *(const LAS f32x4*)(DTh + s0 + 4);
#pragma unroll
                        for (int j = 0; j < 4; ++j) { fac[ks][j] = d0[j] * __expf(a63 - a0[j]); fac[ks][4 + j] = d1[j] * __expf(a63 - a1[j]); } }
#pragma unroll
                    for (int pi2 = 0; pi2 < 2; ++pi2) { const int pi = 2 * hf + pi2; bf16x8 xa[2];
#pragma unroll
                        for (int ks = 0; ks < 2; ++ks) { const u32x4 xw = *(const LAS u32x4*)(XST + (64 * hl + 16 * pi + fr) * 72 + 32 * ks + 8 * fk);
                            u32x4 w; w.x = pk2(bflo(xw.x) * fac[ks][0], bfhi(xw.x) * fac[ks][1]); w.y = pk2(bflo(xw.y) * fac[ks][2], bfhi(xw.y) * fac[ks][3]); w.z = pk2(bflo(xw.z) * fac[ks][4], bfhi(xw.z) * fac[ks][5]); w.w = pk2(bflo(xw.w) * fac[ks][6], bfhi(xw.w) * fac[ks][7]);
                            xa[ks] = __builtin_bit_cast(bf16x8, w); }
#pragma unroll
                        for (int ni = 0; ni < 8; ++ni) { f32x4 acc = {0.f, 0.f, 0.f, 0.f};
#pragma unroll
                            for (int ks = 0; ks < 2; ++ks) acc = __builtin_amdgcn_mfma_f32_16x16x32_bf16(*(const LAS bf16x8*)(BT + (16 * ni + fr) * 72 + 32 * ks + 8 * fk), xa[ks], acc, 0, 0, 0);
                            const int f = hl * 8192 + (((pi * 4 + (ni >> 1)) * 64 + (2 * (ni & 1) + (fk >> 1)) * 16 + fr) << 3) + 4 * (fk & 1), wr = f >> 9, col = ssd_win_col(g, f & 511);
                            u32x2 o; o.x = pk2(acc[0], acc[1]); o.y = pk2(acc[2], acc[3]);
                            *(u32x2*)(XBC + (size_t)(m0 + wr) * 1024 + col) = o; }
                    }
                }
            }
            __syncthreads();
        }
    }
}

template <int VAR = 0> __device__ __forceinline__ void p3c_rwkv(const Ctx& F, int l) {
    constexpr int M9 = 9216, O_TW = 0, O_AL = 9216, O_SL = 18432, O_MAB = O_SL + 12 * M9  , O_LWF = O_SL + 10 * M9  , O_ICF = O_LWF + 17408, O_WL = O_MAB + 16640  , O_SCR = O_WL + 256, O_PAR = O_SCR + 4224  ;
    static_assert(O_ICF + 17408 <= O_MAB + 16640 && O_PAR + 2048 <= LDS_BYTES - 256, "rwkv lds map");
#define LB() ({ LAS unsigned char* p_ = F.lds; asm volatile("" : "+s"(p_)); p_; })
#define SLOT(i) ((LAS bf16_t*)(L + O_SL + (i) * M9))
#define TW ((LAS bf16_t*)(L + O_TW))
#define AL ((LAS bf16_t*)(L + O_AL))
#define AT SLOT(0)
#define ATt SLOT(1)
#define BTl SLOT(2)
#define KTl SLOT(3)
#define RT SLOT(4)
#define BHt SLOT(5)
#define KH SLOT(6)
#define VT SLOT(7)
#define MI SLOT(8)
#define MakT SLOT(9)
#define Rb SLOT(10)
#define Rk SLOT(11)
#define Attn SLOT(0)
#define KEt SLOT(1)
#define X1t SLOT(2)
#define X2t SLOT(3)
#define S8 SLOT(8)
#define S9 SLOT(9)
#define MAB ((LAS float*)(L + O_MAB))
#define LWf ((LAS float*)(L + O_LWF))
#define ICf ((LAS float*)(L + O_ICF))
#define WL ((LAS float*)(L + O_WL))
#define SCR ((LAS float*)(L + O_SCR))
#define PAR ((LAS float*)(L + O_PAR))
    const int tid = F.tid, lane = F.lane, wave = F.wave;
    for (int c = F.bid; c < NCHK; c += F.G) {
        const int m0 = 64 * c; const bool first = (c & 127) == 0;
        u32x4 nlw, nla; float npar;
        auto head_fetch = [&](int h_, int tid_) { const int row = tid_ >> 3, c8 = tid_ & 7; const bf16_t* WLW = (const bf16_t*)(F.ws + WS_WLW); const bf16_t* WLA = (const bf16_t*)(F.ws + WS_WLA);
            nlw = *(const u32x4*)(WLW + (size_t)(h_ * 64 + row) * 64 + c8 * 8); nla = *(const u32x4*)(WLA + (size_t)(h_ * 64 + row) * 64 + c8 * 8);
            const int pi = tid_ >> 6, pc = tid_ & 63;
            const float* src = (pi < 3) ? INP(I_MURKV) + (size_t)l * 1536 + pi * 512 : (pi == 3) ? INP(I_KK) + l * 512 : (pi == 4) ? INP(I_KA) + l * 512 : (pi == 5) ? INP(I_RK) + l * 512 : (pi == 6) ? INP(I_W0) + l * 512 : INP(I_A0) + l * 512;
            npar = src[h_ * 64 + pc]; };
        head_fetch(0, F.tid);
        u32x4 nrw, nkw, nvw, nrp, nkp, nvp;
        auto rkv_fetch = [&](int h_, int tid_) { const int t1 = tid_ >> 3, col1 = h_ * 64 + (tid_ & 7) * 8;
            const bf16_t* Rg = (const bf16_t*)(F.ws + WS_R); const bf16_t* Kg = (const bf16_t*)(F.ws + WS_K); const bf16_t* Vg = (const bf16_t*)(F.ws + WS_V); const bf16_t* HR = (const bf16_t*)(F.ws + WS_HRKV);
            const size_t off = (size_t)(m0 + t1) * 512 + col1;
            nrw = *(const u32x4*)(Rg + off); nkw = *(const u32x4*)(Kg + off); nvw = *(const u32x4*)(Vg + off); nrp = (u32x4){0u, 0u, 0u, 0u}; nkp = nrp; nvp = nrp;
            if (t1 > 0) { nrp = *(const u32x4*)(Rg + off - 512); nkp = *(const u32x4*)(Kg + off - 512); nvp = *(const u32x4*)(Vg + off - 512); }
            else if (!first) { const size_t ho = (size_t)(c - 1) * 512 + col1; nrp = *(const u32x4*)(HR + ho); nkp = *(const u32x4*)(HR + (size_t)NCHK * 512 + ho); nvp = *(const u32x4*)(HR + (size_t)2 * NCHK * 512 + ho); } };
        rkv_fetch(0, F.tid);
        {
            LAS unsigned char* L = LB();
            const int t = tid >> 3, q0 = (tid & 7) * 8;
            const float* Ff = (const float*)(F.ws + WS_F); const float* HF = (const float*)(F.ws + WS_HF); const float* mu_w = INP(I_MUW) + l * 64; const float* mu_a = INP(I_MUA) + l * 64;
            float cw[8], pw[8], ca[8], pa[8];
            const float* cur = Ff + (size_t)(m0 + t) * 144; const float* prv = (t > 0) ? cur - 144 : HF + (size_t)(c - 1) * 128;
#pragma unroll
            for (int j = 0; j < 8; ++j) { cw[j] = cur[q0 + j]; ca[j] = cur[64 + q0 + j]; }
            if (t > 0) {
#pragma unroll
                for (int j = 0; j < 8; ++j) { pw[j] = prv[q0 + j]; pa[j] = prv[64 + q0 + j]; }
            } else if (!first) {
#pragma unroll
                for (int j = 0; j < 8; ++j) { pw[j] = prv[q0 + j]; pa[j] = prv[64 + q0 + j]; }
            } else {
#pragma unroll
                for (int j = 0; j < 8; ++j) { pw[j] = 0.f; pa[j] = 0.f; }
            }
            float ow[8], oa[8];
#pragma unroll
            for (int j = 0; j < 8; ++j) { ow[j] = tanhf(cw[j] + (pw[j] - cw[j]) * mu_w[q0 + j]); oa[j] = ca[j] + (pa[j] - ca[j]) * mu_a[q0 + j]; }
            u32x4 o; o.x = pk2(ow[0], ow[1]); o.y = pk2(ow[2], ow[3]); o.z = pk2(ow[4], ow[5]); o.w = pk2(ow[6], ow[7]); *(LAS u32x4*)(TW + t * 72 + q0) = o;
            o.x = pk2(oa[0], oa[1]); o.y = pk2(oa[2], oa[3]); o.z = pk2(oa[4], oa[5]); o.w = pk2(oa[6], oa[7]); *(LAS u32x4*)(AL + t * 72 + q0) = o;
        }
        for (int h = 0; h < 8; ++h) {
            int tid = F.tid, lane = F.lane; asm volatile("" : "+v"(tid), "+v"(lane));
            const int t1 = tid >> 3, ch0 = (tid & 7) * 8, col1 = h * 64 + ch0;
            const u32x4 rw = nrw, kw = nkw, vw = nvw, rp = nrp, kp = nkp, vp = nvp;
            if (h < 7) rkv_fetch(h + 1, tid);
            {   LAS unsigned char* L = LB(); const int row = tid >> 3, c8 = tid & 7;
                *(LAS u32x4*)(S8 + row * 72 + c8 * 8) = nlw; *(LAS u32x4*)(S9 + row * 72 + c8 * 8) = nla; PAR[(tid >> 6) * 64 + (tid & 63)] = npar; }
            if (h < 7) head_fetch(h + 1, tid);
            __syncthreads();
            if (!(VAR & 16)) {   LAS unsigned char* L = LB(); const int which = wave >> 2, ci = wave & 3, ch = ci * 16 + (lane & 15), g4 = lane >> 4;
                const float bias = PAR[(6 + which) * 64 + ch]; float carry = 0.f;
                if (which == 0) {
                    float a[4][4], tot[4], u[4];
#pragma unroll
                    for (int ti = 0; ti < 4; ++ti) { const f32x4 acc = mma_tile<64>(TW + ti * 16 * 72, 72, S8 + ci * 16 * 72, 72, lane);
#pragma unroll
                        for (int r = 0; r < 4; ++r) a[ti][r] = -DECAY_SCALE * sigmoidf_(acc[r] + bias);
                        a[ti][1] += a[ti][0]; a[ti][2] += a[ti][1]; a[ti][3] += a[ti][2]; tot[ti] = a[ti][3]; }
#pragma unroll
                    for (int ti = 0; ti < 4; ++ti) u[ti] = __shfl_up(tot[ti], 16);
#pragma unroll
                    for (int ti = 0; ti < 4; ++ti) if (g4 >= 1) tot[ti] += u[ti];
#pragma unroll
                    for (int ti = 0; ti < 4; ++ti) u[ti] = __shfl_up(tot[ti], 32);
#pragma unroll
                    for (int ti = 0; ti < 4; ++ti) if (g4 >= 2) tot[ti] += u[ti];
#pragma unroll
                    for (int ti = 0; ti < 4; ++ti) u[ti] = __shfl(tot[ti], 48 + (lane & 15));
#pragma unroll
                    for (int ti = 0; ti < 4; ++ti) { const float base = carry + tot[ti] - a[ti][3];
#pragma unroll
                        for (int r = 0; r < 4; ++r) LWf[(ti * 16 + 4 * g4 + r) * 68 + ch] = __expf(base + a[ti][r]);
                        carry += u[ti]; }
                } else {
#pragma unroll
                    for (int ti = 0; ti < 4; ++ti) { const f32x4 acc = mma_tile<64>(AL + ti * 16 * 72, 72, S9 + ci * 16 * 72, 72, lane);
#pragma unroll
                        for (int r = 0; r < 4; ++r) ICf[(ti * 16 + 4 * g4 + r) * 68 + ch] = sigmoidf_(acc[r] + bias); }
                }
                if (which == 0 && g4 == 0) WL[ch] = __expf(carry);
            }
            __syncthreads();
            float bonv[8] = {0.f, 0.f, 0.f, 0.f, 0.f, 0.f, 0.f, 0.f};
            if (!(VAR & 2)) {   LAS unsigned char* L = LB(); const int t = t1;
                const unsigned rwa[4] = {rw.x, rw.y, rw.z, rw.w}, kwa[4] = {kw.x, kw.y, kw.z, kw.w}, vwa[4] = {vw.x, vw.y, vw.z, vw.w};
                const unsigned rpa[4] = {rp.x, rp.y, rp.z, rp.w}, kpa[4] = {kp.x, kp.y, kp.z, kp.w}, vpa[4] = {vp.x, vp.y, vp.z, vp.w};
                float rs[8], ks[8], vs[8], kkv[8], k2[8], ic[8]; float ss = 0.f, bs = 0.f;
                float pr_[6][8], lwt[8], lwp[8], l63[8];
#pragma unroll
                for (int q = 0; q < 6; ++q) { const f32x4 a = *(const LAS f32x4*)(PAR + q * 64 + ch0), b = *(const LAS f32x4*)(PAR + q * 64 + ch0 + 4);
                    pr_[q][0] = a[0]; pr_[q][1] = a[1]; pr_[q][2] = a[2]; pr_[q][3] = a[3]; pr_[q][4] = b[0]; pr_[q][5] = b[1]; pr_[q][6] = b[2]; pr_[q][7] = b[3]; }
                {   const f32x4 a = *(const LAS f32x4*)(ICf + t * 68 + ch0), b = *(const LAS f32x4*)(ICf + t * 68 + ch0 + 4); ic[0] = a[0]; ic[1] = a[1]; ic[2] = a[2]; ic[3] = a[3]; ic[4] = b[0]; ic[5] = b[1]; ic[6] = b[2]; ic[7] = b[3];
                    const f32x4 c0 = *(const LAS f32x4*)(LWf + t * 68 + ch0), c1 = *(const LAS f32x4*)(LWf + t * 68 + ch0 + 4); lwt[0] = c0[0]; lwt[1] = c0[1]; lwt[2] = c0[2]; lwt[3] = c0[3]; lwt[4] = c1[0]; lwt[5] = c1[1]; lwt[6] = c1[2]; lwt[7] = c1[3];
                    const int tp = (t > 0) ? t - 1 : 0; const f32x4 d0 = *(const LAS f32x4*)(LWf + tp * 68 + ch0), d1 = *(const LAS f32x4*)(LWf + tp * 68 + ch0 + 4); const float pm_ = (t > 0) ? 1.f : 0.f, pa_ = 1.f - pm_;
                    lwp[0] = d0[0] * pm_ + pa_; lwp[1] = d0[1] * pm_ + pa_; lwp[2] = d0[2] * pm_ + pa_; lwp[3] = d0[3] * pm_ + pa_; lwp[4] = d1[0] * pm_ + pa_; lwp[5] = d1[1] * pm_ + pa_; lwp[6] = d1[2] * pm_ + pa_; lwp[7] = d1[3] * pm_ + pa_;
                    const f32x4 e0 = *(const LAS f32x4*)(LWf + 63 * 68 + ch0), e1 = *(const LAS f32x4*)(LWf + 63 * 68 + ch0 + 4); l63[0] = e0[0]; l63[1] = e0[1]; l63[2] = e0[2]; l63[3] = e0[3]; l63[4] = e1[0]; l63[5] = e1[1]; l63[6] = e1[2]; l63[7] = e1[3]; }
#pragma unroll
                for (int j = 0; j < 8; ++j) { const int q = j >> 1;
                    const float r_ = (j & 1) ? bfhi(rwa[q]) : bflo(rwa[q]), rq = (j & 1) ? bfhi(rpa[q]) : bflo(rpa[q]);
                    const float k_ = (j & 1) ? bfhi(kwa[q]) : bflo(kwa[q]), kq = (j & 1) ? bfhi(kpa[q]) : bflo(kpa[q]);
                    const float v_ = (j & 1) ? bfhi(vwa[q]) : bflo(vwa[q]), vq = (j & 1) ? bfhi(vpa[q]) : bflo(vpa[q]);
                    rs[j] = r_ + (rq - r_) * pr_[0][j]; ks[j] = k_ + (kq - k_) * pr_[1][j]; vs[j] = v_ + (vq - v_) * pr_[2][j];
                    kkv[j] = ks[j] * pr_[3][j]; ss += kkv[j] * kkv[j];
                    k2[j] = ks[j] * (1.f + (ic[j] - 1.f) * pr_[4][j]); bs += rs[j] * k2[j] * pr_[5][j]; }
                ss += __shfl_xor(ss, 1); ss += __shfl_xor(ss, 2); ss += __shfl_xor(ss, 4);
                bs += __shfl_xor(bs, 1); bs += __shfl_xor(bs, 2); bs += __shfl_xor(bs, 4);
                const float inv = __builtin_amdgcn_rsqf(fmaxf(ss, 1e-24f));
                float vAT[8], vB[8], vK[8], vR[8], vBH[8], vKH[8];
#pragma unroll
                for (int j = 0; j < 8; ++j) { const int ch = ch0 + j;
                    const float LWt = lwt[j], LWp = lwp[j], L63 = l63[j];
                    const float kk = kkv[j] * inv, a = -kk, b = kk * ic[j];
                    const float e1 = LWt, e2 = __builtin_amdgcn_rcpf(LWt), e3 = LWp, e4 = L63 * e2;
                    vAT[j] = a * e3; vB[j] = b * e2; vK[j] = k2[j] * e2; vR[j] = rs[j] * e1; vBH[j] = b * e4; vKH[j] = k2[j] * e4; bonv[j] = bs * vs[j];
                    (void)ch; }
                u32x4 o;
#define PK8(A_) (o[0] = pk2(A_[0], A_[1]), o[1] = pk2(A_[2], A_[3]), o[2] = pk2(A_[4], A_[5]), o[3] = pk2(A_[6], A_[7]), o)
                *(LAS u32x4*)(AT + t * 72 + ch0) = PK8(vAT); *(LAS u32x4*)(BTl + t * 72 + ch0) = PK8(vB); *(LAS u32x4*)(KTl + t * 72 + ch0) = PK8(vK);
                *(LAS u32x4*)(RT + t * 72 + ch0) = PK8(vR); *(LAS u32x4*)(KH + t * 72 + ch0) = PK8(vKH); *(LAS u32x4*)(BHt + t * 72 + ch0) = PK8(vBH); *(LAS u32x4*)(VT + t * 72 + ch0) = PK8(vs);
            }
            __syncthreads();
            { u32x4 o; *(u32x4*)((bf16_t*)(F.ws + WS_V) + (size_t)(m0 + t1) * 512 + col1) = PK8(bonv); }
            if (!(VAR & 8)) { LAS unsigned char* L = LB();
                auto run2 = [&](auto PT) { constexpr int p = decltype(PT)::value;
                    f32x4 acc[8];
#pragma unroll
                    for (int i = 0; i < 8; ++i) { const int idx = 8 * (wave & 1) + i, ti = idx >> 2, si = idx & 3;
                        if constexpr (p < 2) acc[i] = mma_tile<64>(AT + ti * 16 * 72, 72, ((p & 1) ? KTl : BTl) + si * 16 * 72, 72, lane);
                        else acc[i] = mma_tile<64>(((p & 1) ? KTl : BTl) + si * 16 * 72, 72, RT + ti * 16 * 72, 72, lane); }
#pragma unroll
                    for (int i = 0; i < 8; ++i) { const int idx = 8 * (wave & 1) + i, ti = idx >> 2, si = idx & 3, q4 = 4 * (lane >> 4), l15 = lane & 15;
                        if (p == 0) {
#pragma unroll
                            for (int r = 0; r < 4; ++r) { const int t = ti * 16 + q4 + r, s_ = si * 16 + l15; MAB[t * 65 + s_] = (s_ < t) ? acc[i][r] : 0.f; } }
                        else if (p == 1) { const int s_ = si * 16 + l15, t0 = ti * 16 + q4; u32x2 o;
                            o.x = pk2((s_ < t0) ? acc[i][0] : 0.f, (s_ < t0 + 1) ? acc[i][1] : 0.f); o.y = pk2((s_ < t0 + 2) ? acc[i][2] : 0.f, (s_ < t0 + 3) ? acc[i][3] : 0.f);
                            *(LAS u32x2*)(MakT + s_ * 72 + t0) = o; }
                        else { const int t = ti * 16 + l15, s0 = si * 16 + q4; u32x2 o;
                            o.x = pk2((s0 <= t) ? acc[i][0] : 0.f, (s0 + 1 <= t) ? acc[i][1] : 0.f); o.y = pk2((s0 + 2 <= t) ? acc[i][2] : 0.f, (s0 + 3 <= t) ? acc[i][3] : 0.f);
                            *(LAS u32x2*)(((p == 2) ? Rb : Rk) + t * 72 + s0) = o; } } };
                const int pw = wave >> 1;
                if (pw == 0) run2(IC<0>{}); else if (pw == 1) run2(IC<1>{}); else if (pw == 2) run2(IC<2>{}); else run2(IC<3>{}); }
            __syncthreads();
            if (!(VAR & 1)) {
            if (wave < 4 && lane < 16) { LAS unsigned char* L = LB(); const int b0 = 16 * wave; float x[16];
#pragma unroll
                for (int t = 0; t < 16; ++t) { float v = (t == lane) ? 1.f : 0.f;
#pragma unroll
                    for (int s = 0; s < 16; ++s) if (s < t) v += MAB[(b0 + t) * 65 + b0 + s] * x[s];
                    x[t] = v; }
#pragma unroll
                for (int t = 0; t < 16; ++t) MAB[(b0 + t) * 65 + b0 + lane] = x[t]; }
            __syncthreads();
            if (wave < 2) { LAS unsigned char* L = LB(); const int pr = wave, rb = pr ? 48 : 16, cb = pr ? 32 : 0, fr = lane & 15, fk = lane >> 4; f32x4 acc = {0.f, 0.f, 0.f, 0.f};
#pragma unroll
                for (int ks = 0; ks < 4; ++ks) acc = __builtin_amdgcn_mfma_f32_16x16x4f32(MAB[(rb + fr) * 65 + cb + 4 * ks + fk], MAB[(cb + 4 * ks + fk) * 65 + cb + fr], acc, 0, 0, 0);
#pragma unroll
                for (int r = 0; r < 4; ++r) SCR[(pr * 16 + 4 * fk + r) * 33 + fr] = acc[r]; }
            __syncthreads();
            if (wave < 2) { LAS unsigned char* L = LB(); const int pr = wave, rb = pr ? 48 : 16, cb = pr ? 32 : 0, fr = lane & 15, fk = lane >> 4; f32x4 acc = {0.f, 0.f, 0.f, 0.f};
#pragma unroll
                for (int ks = 0; ks < 4; ++ks) acc = __builtin_amdgcn_mfma_f32_16x16x4f32(MAB[(rb + fr) * 65 + rb + 4 * ks + fk], SCR[(pr * 16 + 4 * ks + fk) * 33 + fr], acc, 0, 0, 0);
#pragma unroll
                for (int r = 0; r < 4; ++r) MAB[(rb + 4 * fk + r) * 65 + cb + fr] = acc[r]; }
            __syncthreads();
            if (wave < 4) { LAS unsigned char* L = LB(); const int ti = wave >> 1, ci = wave & 1, fr = lane & 15, fk = lane >> 4; f32x4 acc = {0.f, 0.f, 0.f, 0.f};
#pragma unroll
                for (int ks = 0; ks < 8; ++ks) acc = __builtin_amdgcn_mfma_f32_16x16x4f32(MAB[(32 + 16 * ti + fr) * 65 + 4 * ks + fk], MAB[(4 * ks + fk) * 65 + 16 * ci + fr], acc, 0, 0, 0);
#pragma unroll
                for (int r = 0; r < 4; ++r) SCR[(16 * ti + 4 * fk + r) * 33 + 16 * ci + fr] = acc[r]; }
            __syncthreads();
            if (wave < 4) { LAS unsigned char* L = LB(); const int ti = wave >> 1, ci = wave & 1, fr = lane & 15, fk = lane >> 4; f32x4 acc = {0.f, 0.f, 0.f, 0.f};
#pragma unroll
                for (int ks = 0; ks < 8; ++ks) acc = __builtin_amdgcn_mfma_f32_16x16x4f32(MAB[(32 + 16 * ti + fr) * 65 + 32 + 4 * ks + fk], SCR[(4 * ks + fk) * 33 + 16 * ci + fr], acc, 0, 0, 0);
#pragma unroll
                for (int r = 0; r < 4; ++r) MAB[(32 + 16 * ti + 4 * fk + r) * 65 + 16 * ci + fr] = acc[r]; }
            __syncthreads();
            {   LAS unsigned char* L = LB(); const int t = tid >> 3, s0 = (tid & 7) * 8; float x[8];
#pragma unroll
                for (int j = 0; j < 8; ++j) x[j] = MAB[t * 65 + s0 + j];
                u32x4 o; *(LAS u32x4*)(MI + t * 72 + s0) = PK8(x); }
            __syncthreads();
            }
            if (!(VAR & 4)) { LAS unsigned char* L = LB();
#pragma unroll
            for (int i = 0; i < 4; ++i) { const int idx = 4 * wave + i, ti = (idx >> 2) & 3, ci = idx & 3; LAS bf16_t* osel = (wave >> 2) ? X2t : X1t;
                const f32x4 acc = (wave >> 2) ? mma_tile<64>(MI + ti * 16 * 72, 72, MakT + ci * 16 * 72, 72, lane) : mma_tile2<64, false, true>(MI, 72, ti * 16, AT, 72, ci * 16, lane);
                u32x2 o; o.x = pk2(acc[0], acc[1]); o.y = pk2(acc[2], acc[3]);
                *(LAS u32x2*)(osel + (ci * 16 + (lane & 15)) * 72 + ti * 16 + 4 * (lane >> 4)) = o; } }
            __syncthreads();
            if (!(VAR & 4) && !(VAR & 32)) { LAS unsigned char* L = LB();
                auto run5 = [&](auto PT) { constexpr int p = decltype(PT)::value;
                    f32x4 acc[8];
#pragma unroll
                    for (int i = 0; i < 8; ++i) { const int idx = 8 * (wave & 1) + i, ti = idx >> 2, si = idx & 3, q4 = 4 * (lane >> 4), l15 = lane & 15;
                        if constexpr (p < 2) { acc[i] = mma_tile<64>(((p == 0) ? X1t : X2t) + si * 16 * 72, 72, Rb + ti * 16 * 72, 72, lane);
                            const u32x2 ad = *(const LAS u32x2*)(((p == 0) ? RT : Rk) + (ti * 16 + l15) * 72 + si * 16 + q4);
                            acc[i][0] += bflo(ad.x); acc[i][1] += bfhi(ad.x); acc[i][2] += bflo(ad.y); acc[i][3] += bfhi(ad.y); }
                        else if constexpr (p == 2) { acc[i] = mma_tile2<64, false, true>(X1t, 72, ti * 16, BHt, 72, si * 16, lane);
#pragma unroll
                            for (int r = 0; r < 4; ++r) { const int rw = ti * 16 + q4 + r; acc[i][r] += (rw == si * 16 + l15) ? WL[rw] : 0.f; } }
                        else { acc[i] = mma_tile2<64, true, false>(BHt, 72, si * 16, X2t, 72, ti * 16, lane);
                            const u32x2 ad = *(const LAS u32x2*)(KH + (ti * 16 + l15) * 72 + si * 16 + q4);
                            acc[i][0] += bflo(ad.x); acc[i][1] += bfhi(ad.x); acc[i][2] += bflo(ad.y); acc[i][3] += bfhi(ad.y); } }
#pragma unroll
                    for (int i = 0; i < 8; ++i) { const int idx = 8 * (wave & 1) + i, ti = idx >> 2, si = idx & 3, q4 = 4 * (lane >> 4), l15 = lane & 15;
                        u32x2 o; o.x = pk2(acc[i][0], acc[i][1]); o.y = pk2(acc[i][2], acc[i][3]);
                        if (p == 0) { const int R = ti * 16 + l15, C0 = pi16(si * 16 + q4);
                            *(LAS u32x2*)(SLOT(8) + ((((R >> 5) * 4 + (C0 >> 4)) * 64 + ((C0 >> 3) & 1) * 32 + (R & 31)) << 3) + (C0 & 7)) = o; }
                        else if (p == 1) *(LAS u32x2*)(Attn + (ti * 16 + l15) * 72 + si * 16 + q4) = o;
                        else if (p == 2) { const int R = si * 16 + l15, C0 = pi16(ti * 16 + q4);
                            *(LAS u32x2*)(SLOT(9) + ((((R >> 5) * 4 + (C0 >> 4)) * 64 + ((C0 >> 3) & 1) * 32 + (R & 31)) << 3) + (C0 & 7)) = o; }
                        else *(LAS u32x2*)(KEt + (ti * 16 + l15) * 72 + si * 16 + q4) = o; } };
                const int pw = wave >> 1;
                if (pw == 0) run5(IC<0>{}); else if (pw == 1) run5(IC<1>{}); else if (pw == 2) run5(IC<2>{}); else run5(IC<3>{}); }
            __syncthreads();
            {   LAS unsigned char* L = LB();
                *(u32x4*)((bf16_t*)(F.ws + WS_QE) + (size_t)(c * 8 + h) * 4096 + tid * 8) = *(const LAS u32x4*)(SLOT(8) + tid * 8);
                *(u32x4*)((bf16_t*)(F.ws + WS_TT) + (size_t)(c * 8 + h) * 4096 + tid * 8) = *(const LAS u32x4*)(SLOT(9) + tid * 8); }
            LAS unsigned char* L = LB();
            if (!(VAR & 64))
#pragma unroll
            for (int i = 0; i < 4; ++i) { const int idx = 4 * wave + i, which = wave >> 2, ti = (idx >> 2) & 3, ci = idx & 3, q4 = 4 * (lane >> 4), l15 = lane & 15;
                const f32x4 acc = which ? mma_tile2<64, true, true>(KEt, 72, ci * 16, VT, 72, ti * 16, lane) : mma_tile2<64, false, true>(Attn, 72, ti * 16, VT, 72, ci * 16, lane);
                u32x2 o; o.x = pk2(acc[0], acc[1]); o.y = pk2(acc[2], acc[3]);
                const int i_ = (which ? ti : ci) * 16 + l15, x0 = sg32((which ? ci : ti) * 16 + q4), k_ = 2 * (x0 >> 5) + ((x0 >> 3) & 1), hi_ = (x0 >> 4) & 1, r32_ = i_ & 31;
                *(LAS u32x2*)((which ? SLOT(3) : SLOT(2)) + (32 * (i_ >> 5) + 8 * k_ + 4 * hi_ + (r32_ >> 3)) * 64 + (r32_ & 7) * 8 + (x0 & 7)) = o; }
            __syncthreads();
            {   const int row = tid >> 3, c8 = tid & 7;
                *(u32x4*)((bf16_t*)(F.ws + WS_K) + (size_t)(m0 + row) * 512 + h * 64 + c8 * 8) = *(const LAS u32x4*)(SLOT(2) + tid * 8);
                *(u32x4*)((bf16_t*)(F.ws + WS_R) + (size_t)(m0 + row) * 512 + h * 64 + c8 * 8) = *(const LAS u32x4*)(SLOT(3) + tid * 8); }
        }
        __syncthreads();
    }
#undef SLOT
#undef PK8
#undef LB
#undef TW
#undef AL
#undef AT
#undef ATt
#undef BTl
#undef KTl
#undef RT
#undef BHt
#undef KH
#undef VT
#undef MI
#undef MakT
#undef Rb
#undef Rk
#undef Attn
#undef KEt
#undef X1t
#undef X2t
#undef S8
#undef S9
#undef MAB
#undef LWf
#undef ICf
#undef WL
#undef SCR
#undef PAR
}

__device__ __forceinline__ bf16x8 cvt8(const f32x16& x, int s) {
    u32x4 w; w.x = pk2(x[8 * s + 0], x[8 * s + 1]); w.y = pk2(x[8 * s + 2], x[8 * s + 3]); w.z = pk2(x[8 * s + 4], x[8 * s + 5]); w.w = pk2(x[8 * s + 6], x[8 * s + 7]);
    return __builtin_bit_cast(bf16x8, w);
}
__device__ __forceinline__ f32x16 ld16bf(const bf16_t* p) {
    const u32x4 a = *(const u32x4*)p, b = *(const u32x4*)(p + 8); f32x16 r;
    r[0] = bflo(a.x); r[1] = bfhi(a.x); r[2] = bflo(a.y); r[3] = bfhi(a.y); r[4] = bflo(a.z); r[5] = bfhi(a.z); r[6] = bflo(a.w); r[7] = bfhi(a.w);
    r[8] = bflo(b.x); r[9] = bfhi(b.x); r[10] = bflo(b.y); r[11] = bfhi(b.y); r[12] = bflo(b.z); r[13] = bfhi(b.z); r[14] = bflo(b.w); r[15] = bfhi(b.w); return r;
}
__device__ __forceinline__ void st16bf(bf16_t* p, const f32x16& x) {
    u32x4 a, b; a.x = pk2(x[0], x[1]); a.y = pk2(x[2], x[3]); a.z = pk2(x[4], x[5]); a.w = pk2(x[6], x[7]); b.x = pk2(x[8], x[9]); b.y = pk2(x[10], x[11]); b.z = pk2(x[12], x[13]); b.w = pk2(x[14], x[15]);
    *(u32x4*)p = a; *(u32x4*)(p + 8) = b;
}
__device__ __forceinline__ float max3f(float a, float b, float c) { float r; asm("v_max3_f32 %0, %1, %2, %3" : "=v"(r) : "v"(a), "v"(b), "v"(c)); return r; }
__device__ __forceinline__ int ktile_off(int row, int ch) { return 3072 * (row >> 3) + 512 * (ch >> 2) + 64 * (row & 7) + 16 * ((ch & 3) ^ ((row >> 2) & 3)); }
constexpr int KTILE = 24576;
template <int VAR> __device__ __forceinline__ void attn_unit(const Ctx& F, int b, int c, int hp, unsigned* qctr, int qbase, volatile LAS int* qw) {
    const int tid = F.tid, lane = F.lane, wave = F.wave, r32 = lane & 31, hi = lane >> 5, grp = wave >> 2, wq = wave & 3, head = 2 * hp + (wq >> 1);
    const bf16_t* Q = (const bf16_t*)(F.ws + WS_Q); const bf16_t* KV = (const bf16_t*)(F.ws + WS_KVB) + (size_t)b * SEQ * 192; bf16_t* OL = (bf16_t*)(F.ws + WS_OL);
    const size_t mq = (size_t)b * SEQ + 64 * c + 32 * (wq & 1) + r32;
    bf16x8 qr[12];
#pragma unroll
    for (int d0 = 0; d0 < 12; ++d0) qr[d0] = *(const bf16x8*)(Q + mq * 768 + head * 192 + 16 * d0 + 8 * hi);
    {
        const float* rp = (const float*)(F.ws + WS_ROPE) + mq * 64;
#pragma unroll
        for (int d0 = 8; d0 < 10; ++d0) { const int j0 = 16 * (d0 - 8) + 8 * hi;
            const f32x4 c0 = *(const f32x4*)(rp + j0), c1 = *(const f32x4*)(rp + j0 + 4), s0 = *(const f32x4*)(rp + 32 + j0), s1 = *(const f32x4*)(rp + 32 + j0 + 4);
            const u32x4 a = __builtin_bit_cast(u32x4, qr[d0]), bq = __builtin_bit_cast(u32x4, qr[d0 + 2]);
            const float x1[8] = {bflo(a.x), bfhi(a.x), bflo(a.y), bfhi(a.y), bflo(a.z), bfhi(a.z), bflo(a.w), bfhi(a.w)}, x2[8] = {bflo(bq.x), bfhi(bq.x), bflo(bq.y), bfhi(bq.y), bflo(bq.z), bfhi(bq.z), bflo(bq.w), bfhi(bq.w)};
            const float cs[8] = {c0[0], c0[1], c0[2], c0[3], c1[0], c1[1], c1[2], c1[3]}, sn[8] = {s0[0], s0[1], s0[2], s0[3], s1[0], s1[1], s1[2], s1[3]};
            float o1[8], o2[8];
#pragma unroll
            for (int e = 0; e < 8; ++e) { o1[e] = x1[e] * cs[e] - x2[e] * sn[e]; o2[e] = x1[e] * sn[e] + x2[e] * cs[e]; }
            u32x4 w1, w2; w1.x = pk2(o1[0], o1[1]); w1.y = pk2(o1[2], o1[3]); w1.z = pk2(o1[4], o1[5]); w1.w = pk2(o1[6], o1[7]); w2.x = pk2(o2[0], o2[1]); w2.y = pk2(o2[2], o2[3]); w2.z = pk2(o2[4], o2[5]); w2.w = pk2(o2[6], o2[7]);
            qr[d0] = __builtin_bit_cast(bf16x8, w1); qr[d0 + 2] = __builtin_bit_cast(bf16x8, w2); }
    }
    int goff[6];
#pragma unroll
    for (int i = 0; i < 6; ++i) { const int j = 6 * wave + i, q = j % 24, pbyte = 1024 * q + 16 * lane, sub = pbyte >> 9, rg = sub / 6, cgp = sub % 6, r7 = (pbyte >> 6) & 7, slot = (pbyte >> 4) & 3;
        const int row = 8 * rg + r7, ch = 4 * cgp + (slot ^ ((row >> 2) & 3)); goff[i] = (row * 192 + ch * 8) * 2 + (j / 24) * 64 * 192 * 2; }
    const int nt = c + 1, ns = (VAR & 64) ? 0 : (nt + 1) >> 1;
    const unsigned ldsb = (unsigned)(uintptr_t)F.lds;
#define ATT_STAGE(s_, par_) do { if ((6 * wave) / 24 == 0 || 2 * (s_) + 1 < nt) { const char* src_ = (const char*)KV + (size_t)(2 * (s_)) * 64 * 192 * 2; \
        _Pragma("unroll") for (int i = 0; i < 6; ++i) { const int j_ = 6 * wave + i; unsigned keep_; \
            asm volatile("s_mov_b32 %0, m0\n\ts_mov_b32 m0, %3\n\ts_nop 0\n\tglobal_load_lds_dwordx4 %1, %2\n\ts_mov_b32 m0, %0" : "=&s"(keep_) : "v"(goff[i]), "s"(src_), "s"(ldsb + (unsigned)(((par_) * 2 + j_ / 24) * KTILE + (j_ % 24) * 1024)) : "memory"); } } } while (0)
    (void)ldsb;
    ATT_STAGE(0, 0);
    asm volatile("s_waitcnt vmcnt(0)" ::: "memory");
    __syncthreads();
    f32x16 o[4];
#pragma unroll
    for (int d = 0; d < 4; ++d)
#pragma unroll
        for (int r = 0; r < 16; ++r) o[d][r] = 0.f;
    float mrun = -1e30f, lrun = 0.f;
    const int kx_ = (r32 >> 2) & 3, kbase = 3072 * (r32 >> 3) + 64 * (r32 & 7), koffE = kbase + 16 * (hi ^ kx_), koffO = kbase + 16 * ((2 + hi) ^ kx_);
    const int tq_ = (lane & 15) >> 2, tp_ = lane & 3, tgl_ = (lane >> 4) & 1, trb = 64 * (4 * hi + tq_) + 8 * (tp_ & 1);
    const int tro0 = trb + 16 * ((2 * tgl_ + (tp_ >> 1)) ^ (hi & 3)), tro1 = trb + 16 * ((2 * tgl_ + (tp_ >> 1)) ^ ((2 + hi) & 3)) + 3072;
    asm volatile(".p2align 8");
    for (int s = 0; s < ns; ++s) {
        const bool more = (s + 1 < ns), more2 = (2 * s + 3 < nt);
        if (more && !(VAR & 1)) ATT_STAGE(s + 1, (s + 1) & 1);
        (void)more2;
        if (2 * s + grp < nt) {
            const LAS unsigned char* buf = F.lds + ((s & 1) * 2 + grp) * KTILE;
            f32x16 p0, p1, q0, q1;
            const float mb = (mrun < -1e29f) ? 0.f : mrun;
#pragma unroll
            for (int r = 0; r < 16; ++r) { p0[r] = -mb; p1[r] = -mb; q0[r] = 0.f; q1[r] = 0.f; }
            bf16x8 ka[3][2];
            if (VAR & 32) {
#pragma unroll
                for (int q = 0; q < 3; ++q) { ka[q][0] = qr[q]; ka[q][1] = qr[q + 3]; } }
#define KLD(slot, d0) do { if (VAR & 32) { asm volatile("" : "+v"(ka[slot][0]), "+v"(ka[slot][1])); break; } ka[slot][0] = *(const LAS bf16x8*)(buf + (((d0) & 1) ? koffO : koffE) + 512 * ((d0) >> 1)); ka[slot][1] = *(const LAS bf16x8*)(buf + (((d0) & 1) ? koffO : koffE) + 12288 + 512 * ((d0) >> 1)); } while (0)
            KLD(0, 0); KLD(1, 1); KLD(2, 2);
#pragma unroll
            for (int d0 = 0; d0 < 12; ++d0) {
                __builtin_amdgcn_sched_barrier(0);
                if (VAR & 16) { if (d0 & 1) { q0 = __builtin_amdgcn_mfma_f32_32x32x16_bf16(ka[d0 % 3][0], qr[d0], q0, 0, 0, 0); q1 = __builtin_amdgcn_mfma_f32_32x32x16_bf16(ka[d0 % 3][1], qr[d0], q1, 0, 0, 0); } else { p0 = __builtin_amdgcn_mfma_f32_32x32x16_bf16(ka[d0 % 3][0], qr[d0], p0, 0, 0, 0); p1 = __builtin_amdgcn_mfma_f32_32x32x16_bf16(ka[d0 % 3][1], qr[d0], p1, 0, 0, 0); } }
                else if (!(VAR & 4)) { p0 = __builtin_amdgcn_mfma_f32_32x32x16_bf16(ka[d0 % 3][0], qr[d0], p0, 0, 0, 0); p1 = __builtin_amdgcn_mfma_f32_32x32x16_bf16(ka[d0 % 3][1], qr[d0], p1, 0, 0, 0); } else { asm volatile("" :: "v"(ka[d0 % 3][0]), "v"(ka[d0 % 3][1])); }
                __builtin_amdgcn_sched_barrier(0);
                if (d0 + 3 < 12) KLD(d0 % 3, d0 + 3);
            }
            __builtin_amdgcn_sched_barrier(0);
            if (VAR & 16) {
#pragma unroll
                for (int r = 0; r < 16; ++r) { p0[r] += q0[r]; p1[r] += q1[r]; } }
#undef KLD
            v4i16_t vl[2][4], vh[2][4];
#pragma unroll
            for (int db = 0; db < 4; ++db) { vl[0][db] = __builtin_amdgcn_ds_read_tr16_b64_v4i16((LAS v4i16_t*)(buf + tro0 + 512 * db)); vh[0][db] = __builtin_amdgcn_ds_read_tr16_b64_v4i16((LAS v4i16_t*)(buf + tro1 + 512 * db)); }
            float mx = max3f(p0[0], p1[0], p0[1]), my = max3f(p1[1], p0[2], p1[2]);
#pragma unroll
            for (int r = 3; r < 15; r += 2) { mx = max3f(mx, p0[r], p1[r]); my = max3f(my, p0[r + 1], p1[r + 1]); }
            mx = max3f(mx, my, fmaxf(p0[15], p1[15]));
            mx = fmaxf(mx, __shfl_xor(mx, 32));
            if (!(VAR & 8) && __any(mx + mb > mrun + 8.f)) {
                const float mnew = fmaxf(mrun, mx + mb), alpha = __builtin_amdgcn_exp2f(mrun - mnew), dsh = mb - mnew; mrun = mnew; lrun *= alpha;
#pragma unroll
                for (int d = 0; d < 4; ++d)
#pragma unroll
                    for (int r = 0; r < 16; ++r) o[d][r] *= alpha;
#pragma unroll
                for (int r = 0; r < 16; ++r) { p0[r] += dsh; p1[r] += dsh; }
            }
            float ls = 0.f;
#pragma unroll
            for (int r = 0; r < 16; ++r) { if (!(VAR & 8)) { p0[r] = __builtin_amdgcn_exp2f(p0[r]); p1[r] = __builtin_amdgcn_exp2f(p1[r]); } ls += p0[r] + p1[r]; }
            lrun += ls;
#pragma unroll
            for (int ks = 0; ks < 4; ++ks) {
                if (ks + 1 < 4) {
#pragma unroll
                    for (int db = 0; db < 4; ++db) {
                        vl[(ks + 1) & 1][db] = __builtin_amdgcn_ds_read_tr16_b64_v4i16((LAS v4i16_t*)(buf + tro0 + 6144 * (ks + 1) + 512 * db)); vh[(ks + 1) & 1][db] = __builtin_amdgcn_ds_read_tr16_b64_v4i16((LAS v4i16_t*)(buf + tro1 + 6144 * (ks + 1) + 512 * db)); }
                }
                const bf16x8 pb = (ks < 2) ? cvt8(p0, ks & 1) : cvt8(p1, ks & 1);
#pragma unroll
                for (int db = 0; db < 4; ++db) { const v4i16_t lo = vl[ks & 1][db], hh = vh[ks & 1][db];
                    const bf16x8 va = {lo[0], lo[1], lo[2], lo[3], hh[0], hh[1], hh[2], hh[3]};
                    if (!(VAR & 2)) o[db] = __builtin_amdgcn_mfma_f32_32x32x16_bf16(va, pb, o[db], 0, 0, 0); else asm volatile("" :: "v"(va), "v"(pb)); }
            }
        }
        asm volatile("s_waitcnt vmcnt(0)" ::: "memory");
        __syncthreads();
    }
#undef ATT_STAGE
    int knext = 0;
    if (F.tid == 0) knext = qbase + (int)__hip_atomic_fetch_add(qctr, 1u, __ATOMIC_RELAXED, __HIP_MEMORY_SCOPE_AGENT);
    lrun += __shfl_xor(lrun, 32);
    LAS float* xb = (LAS float*)(F.lds + wq * (66 * 64 * 4));
    if (grp == 1) {
#pragma unroll
        for (int d = 0; d < 4; ++d)
#pragma unroll
            for (int r = 0; r < 16; ++r) xb[(d * 16 + r) * 64 + lane] = o[d][r];
        xb[64 * 64 + lane] = mrun; xb[65 * 64 + lane] = lrun;
    }
    __syncthreads();
    if (grp == 0) {
        const float m2 = xb[64 * 64 + lane], l2 = xb[65 * 64 + lane];
        const float mm = fmaxf(mrun, m2), a1 = __builtin_amdgcn_exp2f(mrun - mm), a2 = __builtin_amdgcn_exp2f(m2 - mm);
        const float inv = 1.f / (lrun * a1 + l2 * a2), f1 = a1 * inv, f2 = a2 * inv;
#pragma unroll
        for (int db = 0; db < 4; ++db)
#pragma unroll
            for (int gp = 0; gp < 2; ++gp) { u32x2 w[2];
#pragma unroll
                for (int q = 0; q < 2; ++q) { const int g = 2 * gp + q; float v[4];
#pragma unroll
                    for (int e = 0; e < 4; ++e) v[e] = o[db][4 * g + e] * f1 + xb[(db * 16 + 4 * g + e) * 64 + lane] * f2;
                    w[q].x = pk2(v[0], v[1]); w[q].y = pk2(v[2], v[3]); }
                const auto sx = __builtin_amdgcn_permlane32_swap(w[0].x, w[1].x, false, false), sy = __builtin_amdgcn_permlane32_swap(w[0].y, w[1].y, false, false);
                u32x4 o4; o4.x = sx[0]; o4.y = sy[0]; o4.z = sx[1]; o4.w = sy[1];
                *(u32x4*)(OL + mq * 512 + head * 128 + 32 * db + 8 * (2 * gp + hi)) = o4; }
    }
    if (F.tid == 0) *qw = knext;
    __syncthreads();
}
struct RwSet { bf16x8 ta[2][4]; u32x4 d[4]; };
__device__ __forceinline__ void rw_load(RwSet& s, const bf16_t* TTg, const bf16_t* Rg, int cg_, int h, int i, int r32, int hi) {
    const bf16_t* TTw = TTg + (size_t)(cg_ * 8 + h) * 4096; const bf16_t* Dw = Rg + ((size_t)64 * cg_ + (i & 32) + 4 * hi + (r32 >> 3)) * 512 + h * 64 + (r32 & 7) * 8;
#pragma unroll
    for (int a = 0; a < 2; ++a)
#pragma unroll
        for (int s2 = 0; s2 < 4; ++s2) s.ta[a][s2] = *(const bf16x8*)(TTw + ((a * 4 + s2) * 64 + hi * 32 + r32) * 8);
#pragma unroll
    for (int k = 0; k < 4; ++k) s.d[k] = *(const u32x4*)(Dw + (size_t)(8 * k) * 512);
}
__device__ __forceinline__ f32x16 up16(const u32x4 a, const u32x4 b) { f32x16 r;
    r[0] = bflo(a.x); r[1] = bfhi(a.x); r[2] = bflo(a.y); r[3] = bfhi(a.y); r[4] = bflo(a.z); r[5] = bfhi(a.z); r[6] = bflo(a.w); r[7] = bfhi(a.w);
    r[8] = bflo(b.x); r[9] = bfhi(b.x); r[10] = bflo(b.y); r[11] = bfhi(b.y); r[12] = bflo(b.z); r[13] = bfhi(b.z); r[14] = bflo(b.w); r[15] = bfhi(b.w); return r; }
__device__ __forceinline__ void rw_step(f32x16& X0, f32x16& X1, const RwSet& s, bf16_t* Rg, int cg_, int h, int i, int hi, bool live) {
    const bf16x8 bf[4] = {cvt8(X0, 0), cvt8(X0, 1), cvt8(X1, 0), cvt8(X1, 1)};
    if (live) { const int r32 = i & 31; bf16_t* Dw = Rg + ((size_t)64 * cg_ + (i & 32) + 4 * hi + (r32 >> 3)) * 512 + h * 64 + (r32 & 7) * 8;
#pragma unroll
        for (int k = 0; k < 4; ++k) *(bf16x8*)(Dw + (size_t)(8 * k) * 512) = bf[k]; }
    f32x16 n0 = up16(s.d[0], s.d[1]), n1 = up16(s.d[2], s.d[3]);
#pragma unroll
    for (int s2 = 0; s2 < 4; ++s2) { n0 = __builtin_amdgcn_mfma_f32_32x32x16_bf16(s.ta[0][s2], bf[s2], n0, 0, 0, 0); n1 = __builtin_amdgcn_mfma_f32_32x32x16_bf16(s.ta[1][s2], bf[s2], n1, 0, 0, 0); }
    X0 = n0; X1 = n1;
}
__device__ __forceinline__ void rwkv_scan(const Ctx& F, int b, int h, int half) {
    const int lane = F.lane, r32 = lane & 31, hi = lane >> 5, i = 32 * half + r32;
    const bf16_t* TTg = (const bf16_t*)(F.ws + WS_TT); bf16_t* Rg = (bf16_t*)(F.ws + WS_R);
    f32x16 X0, X1;
#pragma unroll
    for (int r = 0; r < 16; ++r) { X0[r] = 0.f; X1[r] = 0.f; }
    RwSet sA, sB, sC; const int c0 = b * 128;
    rw_load(sA, TTg, Rg, c0 + 0, h, i, r32, hi); rw_load(sB, TTg, Rg, c0 + 1, h, i, r32, hi); rw_load(sC, TTg, Rg, c0 + 2, h, i, r32, hi);
    for (int c = 0; c < 129; c += 3) {
        rw_step(X0, X1, sA, Rg, c0 + c, h, i, hi, true);          rw_load(sA, TTg, Rg, c0 + min(c + 3, 127), h, i, r32, hi);
        rw_step(X0, X1, sB, Rg, c0 + c + 1, h, i, hi, true);      rw_load(sB, TTg, Rg, c0 + min(c + 4, 127), h, i, r32, hi);
        rw_step(X0, X1, sC, Rg, c0 + min(c + 2, 127), h, i, hi, c + 2 < 128); rw_load(sC, TTg, Rg, c0 + min(c + 5, 127), h, i, r32, hi);
    }
}
__device__ __forceinline__ void ssd_scan(const Ctx& F, int item) {
    const int b = item >> 4, h = (item >> 1) & 7, hp = item & 1, g = h >> 2, hl = h & 3;
    const int piece = hp * 512 + F.tid;
    const int f = hl * 8192 + piece * 8, row = f >> 9, col = ssd_win_col(g, f & 511);
    bf16_t* ST = (bf16_t*)(F.ws + WS_XBC); const float* CDEC = (const float*)(F.ws + WS_CDEC);
    float st[8];
#pragma unroll
    for (int j = 0; j < 8; ++j) st[j] = 0.f;
    u32x4 vn[8]; float cdn[8];
#pragma unroll
    for (int u = 0; u < 8; ++u) { const int cg_ = b * 128 + u; vn[u] = *(const u32x4*)(ST + ((size_t)64 * cg_ + row) * 1024 + col); cdn[u] = CDEC[cg_ * 8 + h]; }
    for (int c8 = 0; c8 < 128; c8 += 8) {
        u32x4 v[8]; float cd[8];
#pragma unroll
        for (int u = 0; u < 8; ++u) { v[u] = vn[u]; cd[u] = cdn[u]; }
        if (c8 + 8 < 128) {
#pragma unroll
            for (int u = 0; u < 8; ++u) { const int cg_ = b * 128 + c8 + 8 + u; vn[u] = *(const u32x4*)(ST + ((size_t)64 * cg_ + row) * 1024 + col); cdn[u] = CDEC[cg_ * 8 + h]; } }
#pragma unroll
        for (int u = 0; u < 8; ++u) { const int cg_ = b * 128 + c8 + u;
            u32x4 o; o.x = pk2(st[0], st[1]); o.y = pk2(st[2], st[3]); o.z = pk2(st[4], st[5]); o.w = pk2(st[6], st[7]);
            *(u32x4*)(ST + ((size_t)64 * cg_ + row) * 1024 + col) = o;
            const float x[8] = {bflo(v[u].x), bfhi(v[u].x), bflo(v[u].y), bfhi(v[u].y), bflo(v[u].z), bfhi(v[u].z), bflo(v[u].w), bfhi(v[u].w)};
#pragma unroll
            for (int j = 0; j < 8; ++j) st[j] = st[j] * cd[u] + x[j]; }
    }
}
constexpr size_t CTL_QUEUE = 32768;
template <int VAR = 0> __device__ __forceinline__ void p4_mix(const Ctx& F, int qslot, int what = 3) {
    const int x = F.bid & 7, li = F.bid >> 3;
    if ((what & 2) && li < 6) { const int st = li * 8 + x;
        if (st < 16) { if (!(what & 8) && F.wave < 2) rwkv_scan(F, st >> 3, st & 7, F.wave); }
        else if (!(what & 4)) ssd_scan(F, st - 16); }
    if (what & 1) {
        unsigned* ctr = (unsigned*)(F.ws + WS_CTL + CTL_QUEUE) + (qslot * 8 + x) * 64;
        volatile LAS int* qw = (volatile LAS int*)(F.lds + LDS_BYTES - 128);
        const int nscan = (what & 2) ? 6 : 0, nstat = max((F.G >> 3) - nscan, 0); bool stat = (li >= nscan);
        int k;
        if (stat) k = li - nscan;
        else {
            if (F.tid == 0) *qw = nstat + (int)__hip_atomic_fetch_add(ctr, 1u, __ATOMIC_RELAXED, __HIP_MEMORY_SCOPE_AGENT);
            __syncthreads();
            k = *qw;
            __syncthreads();
        }
        while (k < 64) {
            const int rb = 4 * k + (x >> 1), c = 127 - (rb >> 1), hp = rb & 1, b = x & 1;
            attn_unit<VAR>(F, b, c, hp, ctr, nstat, qw);
            k = *qw;
        }
    }
}
template <int VAR = 0> __device__ __forceinline__ void p5_assemble(const Ctx& F, int l) {
    bf16_t* GT = (bf16_t*)(F.ws + WS_GATES);
    if (!(VAR & 1)) {   pg8::Gemm g{(const bf16_t*)(F.ws + WS_OL), (const bf16_t*)(F.ws + WS_WUV), NT, 512, 256, 512, 512, 256};     pg8::StaticOrder S; S.init(NT, 512, F.G, F.bid); EpiUV E{GT};
        pg8::gemm_phase<EpiUV, pg8::StaticOrder, true, true>(F.lds, F.wave, g, S, E); }
    __syncthreads();
    int lane = fresh_lane(); const int tid = F.wave * 64 + lane, wave = F.wave;
    const int gw = F.bid * NWAVES + F.wave, NGW = F.G * NWAVES;
    {   constexpr int O_CC = 0, O_YO = 33792;
        const bf16_t* Cbuf = (const bf16_t*)(F.ws + WS_CB); const float* ECUM = (const float*)(F.ws + WS_ECUM); const bf16_t* ST = (const bf16_t*)(F.ws + WS_XBC); const bf16_t* YD = (const bf16_t*)(F.ws + WS_YD);
        const float* snw = INP(I_SSDNW) + l * 512;
        for (int c = F.bid; c < ((VAR & 2) ? 0 : NCHK); c += F.G) {
            const size_t m0 = (size_t)64 * c; const int h = wave, g = h >> 2, hl = h & 3;
            bf16x8 pf[4][4];
#pragma unroll
            for (int pi = 0; pi < 4; ++pi)
#pragma unroll
                for (int ks = 0; ks < 4; ++ks) { const int f = hl * 8192 + (((pi * 4 + ks) * 64 + lane) << 3), row = f >> 9, col = ssd_win_col(g, f & 511);
                    pf[pi][ks] = *(const bf16x8*)(ST + (m0 + row) * 1024 + col); }
            {   LAS bf16_t* CC = (LAS bf16_t*)(F.lds + O_CC);
#pragma unroll
                for (int i = 0; i < 4; ++i) { const int idx = tid + 512 * i, t = idx >> 5, c8 = idx & 31; *(LAS u32x4*)(CC + t * 264 + c8 * 8) = *(const u32x4*)(Cbuf + (m0 + t) * 256 + c8 * 8); } }
            __syncthreads();
            {   const LAS bf16_t* CC = (const LAS bf16_t*)(F.lds + O_CC) + g * 128; LAS bf16_t* YO = (LAS bf16_t*)(F.lds + O_YO);
                float ecv[4];
#pragma unroll
                for (int ti = 0; ti < 4; ++ti) ecv[ti] = ECUM[(size_t)(c * 8 + h) * 64 + 16 * ti + (lane & 15)];
#pragma unroll
                for (int ti = 0; ti < 4; ++ti) {
                    bf16x8 af[4];
#pragma unroll
                    for (int ks = 0; ks < 4; ++ks) af[ks] = *(const LAS bf16x8*)(CC + (16 * ti + (lane & 15)) * 264 + 32 * ks + 8 * (lane >> 4));
                    const float ec = ecv[ti];
#pragma unroll
                    for (int pi = 0; pi < 4; ++pi) { f32x4 acc = {0.f, 0.f, 0.f, 0.f};
#pragma unroll
                        for (int ks = 0; ks < 4; ++ks) acc = __builtin_amdgcn_mfma_f32_16x16x32_bf16(pf[pi][ks], af[ks], acc, 0, 0, 0);
                        u32x2 o; o.x = pk2(acc[0] * ec, acc[1] * ec); o.y = pk2(acc[2] * ec, acc[3] * ec);
                        *(LAS u32x2*)(YO + (16 * ti + (lane & 15)) * 520 + 64 * h + 16 * pi + 4 * (lane >> 4)) = o; }
                }
            }
            __syncthreads();
            {   const LAS bf16_t* YO = (const LAS bf16_t*)(F.lds + O_YO);
                u32x4 ydv[8], zv[8];
#pragma unroll
                for (int rr = 0; rr < 8; ++rr) { const int t = 8 * wave + rr; ydv[rr] = *(const u32x4*)(YD + (m0 + t) * 512 + 8 * lane); zv[rr] = *(const u32x4*)(GT + (m0 + t) * 1536 + 512 + 8 * lane); }
                const f32x4 w0 = *(const f32x4*)(snw + 8 * lane), w1 = *(const f32x4*)(snw + 8 * lane + 4);
#pragma unroll
                for (int rr = 0; rr < 8; ++rr) { const int t = 8 * wave + rr; const u32x4 w = *(const LAS u32x4*)(YO + t * 520 + 8 * lane);
                    const unsigned wa[4] = {w.x, w.y, w.z, w.w}, ya[4] = {ydv[rr].x, ydv[rr].y, ydv[rr].z, ydv[rr].w}, za[4] = {zv[rr].x, zv[rr].y, zv[rr].z, zv[rr].w};
                    float v[8]; float q = 0.f;
#pragma unroll
                    for (int j = 0; j < 8; ++j) { const int k2 = j >> 1; const float yo = (j & 1) ? bfhi(wa[k2]) : bflo(wa[k2]), yd = (j & 1) ? bfhi(ya[k2]) : bflo(ya[k2]), zz = (j & 1) ? bfhi(za[k2]) : bflo(za[k2]);
                        v[j] = (yd + yo) * siluf_(zz); q += v[j] * v[j]; }
                    const float rs = __builtin_amdgcn_rsqf(wave_sum(q) * (1.f / 512.f) + EPS);
                    u32x4 o; o.x = pk2(v[0] * rs * w0[0], v[1] * rs * w0[1]); o.y = pk2(v[2] * rs * w0[2], v[3] * rs * w0[3]); o.z = pk2(v[4] * rs * w1[0], v[5] * rs * w1[1]); o.w = pk2(v[6] * rs * w1[2], v[7] * rs * w1[3]);
                    *(u32x4*)(GT + (m0 + t) * 1536 + 512 + 8 * lane) = o; } }
            __syncthreads();
        }
    }
    LAS float* SW = (LAS float*)(F.lds + F.wave * 16640);
    const bf16_t* Yt = (const bf16_t*)(F.ws + WS_K); const bf16_t* SF = (const bf16_t*)(F.ws + WS_R); const bf16_t* QEg = (const bf16_t*)(F.ws + WS_QE);
    const bf16_t* BON = (const bf16_t*)(F.ws + WS_V); const float* lw = INP(I_LNXW) + l * 512; const float* lb = INP(I_LNXB) + l * 512;
    for (int w = gw; w < ((VAR & 4) ? 0 : NCHK * 8); w += NGW) {
        asm volatile("" : "+v"(lane));
        const int cg_ = w >> 3, h = w & 7, r32 = lane & 31, hi = lane >> 5; const size_t m0 = (size_t)64 * cg_;
        const bf16_t* QEw = QEg + (size_t)(cg_ * 8 + h) * 4096;
        bf16x8 qa[2][4];
#pragma unroll
        for (int tb = 0; tb < 2; ++tb)
#pragma unroll
            for (int s2 = 0; s2 < 4; ++s2) qa[tb][s2] = *(const bf16x8*)(QEw + ((tb * 4 + s2) * 64 + hi * 32 + r32) * 8);
        const f32x4 lwa = *(const f32x4*)(lw + h * 64 + (lane & 7) * 8), lwb = *(const f32x4*)(lw + h * 64 + (lane & 7) * 8 + 4), lba = *(const f32x4*)(lb + h * 64 + (lane & 7) * 8), lbb = *(const f32x4*)(lb + h * 64 + (lane & 7) * 8 + 4);
        bf16x8 bfA[2][4]; u32x4 ytA[2][2][2];
#pragma unroll
        for (int ih = 0; ih < 2; ++ih) { const size_t ro = (m0 + 32 * ih + 4 * hi + (r32 >> 3)) * 512 + h * 64 + (r32 & 7) * 8;
#pragma unroll
            for (int k = 0; k < 4; ++k) bfA[ih][k] = *(const bf16x8*)(SF + ro + (size_t)(8 * k) * 512);
#pragma unroll
            for (int tb = 0; tb < 2; ++tb) { ytA[ih][tb][0] = *(const u32x4*)(Yt + ro + (size_t)(16 * tb) * 512); ytA[ih][tb][1] = *(const u32x4*)(Yt + ro + (size_t)(16 * tb + 8) * 512); } }
#pragma unroll
        for (int ih = 0; ih < 2; ++ih)
#pragma unroll
            for (int tb = 0; tb < 2; ++tb) { f32x16 y = up16(ytA[ih][tb][0], ytA[ih][tb][1]);
#pragma unroll
                for (int s2 = 0; s2 < 4; ++s2) y = __builtin_amdgcn_mfma_f32_32x32x16_bf16(qa[tb][s2], bfA[ih][s2], y, 0, 0, 0);
#pragma unroll
                for (int r = 0; r < 16; ++r) SW[(32 * tb + crow(r, hi)) * 65 + 32 * ih + r32] = y[r]; }
        LDS_WAIT();
        {   float y[64]; float sm = 0.f;
#pragma unroll
            for (int i = 0; i < 64; ++i) { y[i] = SW[lane * 65 + i]; sm += y[i]; }
            const float mean = sm * (1.f / 64.f); float q = 0.f;
#pragma unroll
            for (int i = 0; i < 64; ++i) { y[i] -= mean; q += y[i] * y[i]; }
            const float rs = 1.f / sqrtf(q * (1.f / 64.f) + GN_EPS);
#pragma unroll
            for (int i = 0; i < 64; ++i) SW[lane * 65 + i] = y[i] * rs; }
        LDS_WAIT();
        u32x4 bwv[8], gvv[8];
#pragma unroll
        for (int it = 0; it < 8; ++it) { const int t = it * 8 + (lane >> 3), i0 = (lane & 7) * 8; const size_t row = m0 + t;
            bwv[it] = *(const u32x4*)(BON + row * 512 + h * 64 + i0); gvv[it] = *(const u32x4*)(GT + row * 1536 + 1024 + h * 64 + i0); }
#pragma unroll
        for (int it = 0; it < 8; ++it) { const int t = it * 8 + (lane >> 3), i0 = (lane & 7) * 8; const size_t row = m0 + t;
            const u32x4 bw = bwv[it]; u32x4* gp = (u32x4*)(GT + row * 1536 + 1024 + h * 64 + i0); const u32x4 gv = gvv[it];
            const float bo[8] = {bflo(bw.x), bfhi(bw.x), bflo(bw.y), bfhi(bw.y), bflo(bw.z), bfhi(bw.z), bflo(bw.w), bfhi(bw.w)};
            const float gg[8] = {bflo(gv.x), bfhi(gv.x), bflo(gv.y), bfhi(gv.y), bflo(gv.z), bfhi(gv.z), bflo(gv.w), bfhi(gv.w)};
            float ov[8];
#pragma unroll
            for (int j = 0; j < 8; ++j) ov[j] = (SW[t * 65 + i0 + j] * ((j < 4) ? lwa[j & 3] : lwb[j & 3]) + ((j < 4) ? lba[j & 3] : lbb[j & 3]) + bo[j]) * siluf_(gg[j]);
            u32x4 o; o.x = pk2(ov[0], ov[1]); o.y = pk2(ov[2], ov[3]); o.z = pk2(ov[4], ov[5]); o.w = pk2(ov[6], ov[7]); *gp = o; }
        LDS_WAIT();
    }
}
__device__ __forceinline__ void p7_final(const Ctx& F) {
    const int gw = F.bid * NWAVES + F.wave, NGW = F.G * NWAVES; const float* fw = INP(I_FNW);
    for (int m = gw; m < NT; m += NGW) {
        f32x4* xr = (f32x4*)(F.out + (size_t)m * DM) + F.lane; f32x4 v[4]; float s = 0.f;
#pragma unroll
        for (int j = 0; j < 4; ++j) { v[j] = xr[64 * j]; s += v[j].x * v[j].x + v[j].y * v[j].y + v[j].z * v[j].z + v[j].w * v[j].w; }
        const float rstd = 1.f / sqrtf(wave_sum(s) * (1.f / DM) + EPS);
#pragma unroll
        for (int j = 0; j < 4; ++j) xr[64 * j] = v[j] * rstd * *(const f32x4*)(fw + 4 * F.lane + 256 * j);
    }
}

#define RLX_AGENT __ATOMIC_RELAXED, __HIP_MEMORY_SCOPE_AGENT
#define XB_TMO      128
#define XB_XCNT(j)  (256  + 64 * (j))
#define XB_XSUB(j)  (1280 + 64 * (j))
#define XB_XGEN(j)  (2304 + 64 * (j))
#define XB_TOP      3328
#define XB_TOPGEN   3392
#define XCD_BAR_WORDS 3456
#define XB_SPIN_CAP (1u << 18)

__device__ __forceinline__ unsigned xb_ld(unsigned* p)              { return __hip_atomic_load(p, __ATOMIC_RELAXED, __HIP_MEMORY_SCOPE_AGENT); }
__device__ __forceinline__ unsigned xb_add(unsigned* p, unsigned v) { return __hip_atomic_fetch_add(p, v, __ATOMIC_RELAXED, __HIP_MEMORY_SCOPE_AGENT); }
__device__ __forceinline__ unsigned xb_xcc_id() { return (unsigned)__builtin_amdgcn_s_getreg((3 << 11) | 20) & 0xFu; }
#define XB_SPIN(cond, bar) do { unsigned _sp = 0; while (cond) { __builtin_amdgcn_s_sleep(1); \
    if ((++_sp & 255u) == 0u) { if (xb_ld(&(bar)[XB_TMO])) break; if (_sp > XB_SPIN_CAP) { atomicAdd(&(bar)[XB_TMO], 1u); break; } } } } while (0)

struct XcdBarrier {
    unsigned* bar; unsigned x;
    volatile LAS unsigned* st;
};

__device__ __forceinline__ XcdBarrier xcd_barrier_post(unsigned* bar, volatile LAS unsigned* st) {
    XcdBarrier b; b.bar = bar; b.x = xb_xcc_id(); b.st = st;
    if (threadIdx.x == 0) (void)xb_add(&bar[XB_XCNT(b.x)], 1u);
    return b;
}
__device__ __forceinline__ void xcd_barrier_complete(unsigned* bar, unsigned x, unsigned& nloc, unsigned& nx) {
    const unsigned G = gridDim.x * gridDim.y * gridDim.z;
    unsigned sum, cnt, mine, sp = 0u;
    for (;;) {
        sum = 0u; cnt = 0u; mine = 0u;
#pragma unroll
        for (unsigned j = 0; j < 16; ++j) { const unsigned c = xb_ld(&bar[XB_XCNT(j)]); sum += c; cnt += (c > 0u) ? 1u : 0u; mine = (j == x) ? c : mine; }
        if (sum == G) break;
        __builtin_amdgcn_s_sleep(1);
        if ((++sp & 255u) == 0u) { if (xb_ld(&bar[XB_TMO])) break; if (sp > XB_SPIN_CAP) { atomicAdd(&bar[XB_TMO], 1u); break; } }
    }
    nloc = mine > 0u ? mine : 1u; nx = cnt > 0u ? cnt : 1u;
}

__device__ __forceinline__ void xcd_barrier(const XcdBarrier& b) {
    asm volatile("s_waitcnt vmcnt(0)" ::: "memory");
    __syncthreads();
    if (threadIdx.x == 0) {
        unsigned* bar = b.bar;
        __builtin_amdgcn_s_waitcnt(0);
        unsigned nloc = b.st[0], nx = b.st[1];
        if (nloc == 0u) { xcd_barrier_complete(bar, b.x, nloc, nx); b.st[0] = nloc; b.st[1] = nx; }
        const unsigned old = xb_add(&bar[XB_XSUB(b.x)], 1u);
        const unsigned gen = old / nloc;
        if (old + 1u == (gen + 1u) * nloc) {
            __builtin_amdgcn_fence(__ATOMIC_RELEASE, "agent");
            asm volatile("s_waitcnt vmcnt(0)" ::: "memory");
            const unsigned og = xb_add(&bar[XB_TOP], 1u);
            const unsigned tg = og / nx;
            if (og + 1u == (tg + 1u) * nx) xb_add(&bar[XB_TOPGEN], 1u);
            else XB_SPIN(xb_ld(&bar[XB_TOPGEN]) == tg, bar);
            __builtin_amdgcn_fence(__ATOMIC_ACQUIRE, "agent");
            xb_add(&bar[XB_XGEN(b.x)], 1u);
            asm volatile("s_waitcnt vmcnt(0)" ::: "memory");
        } else {
            XB_SPIN(xb_ld(&bar[XB_XGEN(b.x)]) == gen, bar);
            __builtin_amdgcn_fence(__ATOMIC_ACQUIRE, "agent");
            asm volatile("s_waitcnt vmcnt(0)" ::: "memory");
        }
    }
    __syncthreads();
}


#define LAYER(l) do { \
        const int pb = 1 + 8 * l; \
        if (l == 0 && IN(pb + 0)) { PHB(); p1_norm(F, l); SEAM(pb + 0); }         \
        if (IN(pb + 1)) { PHB(); \
            pg8::Gemm g{(const bf16_t*)(F.ws + WS_XN), (const bf16_t*)(F.ws + WS_WIN), NT, NIN, DM, DM, DM}; pg8::StaticOrder S; S.init(NT, NIN, F.G, F.bid); \
            EpiIn E{F.ws, l}; \
            pg8::gemm_phase<EpiIn, pg8::StaticOrder, true, true>(F.lds, F.wave, g, S, E); \
            SEAM(pb + 1); \
        } \
        if (IN(pb + 2)) { PHB(); \
            pg8::Gemm g{(const bf16_t*)(F.ws + WS_QLAT), (const bf16_t*)(F.ws + WS_WQ), NT, 768, 256, 256, 256}; pg8::StaticOrder S; S.init(NT, 768, F.G, F.bid); \
            EpiQ E{F.ws, l}; \
            pg8::gemm_phase<EpiQ, pg8::StaticOrder, true, true>(F.lds, F.wave, g, S, E); \
            p3a_extras(F, l); \
        } \
        if (IN(pb + 3)) { PHB(); p3b_ssd(F, l); __syncthreads(); } \
        if (IN(pb + 4)) { PHB(); p3c_rwkv(F, l); SEAM(pb + 4); } \
        if (IN(pb + 5)) { PHB(); p4_mix(F, l); SEAM(pb + 5); } \
        if (IN(pb + 6)) { PHB(); p5_assemble(F, l); SEAM(pb + 6); } \
        if (IN(pb + 7)) { PHB(); \
            if (l == 0) { prep_weights(F, 1); __syncthreads(); }     \
            pg8::Gemm g{(const bf16_t*)(F.ws + WS_GATES), (const bf16_t*)(F.ws + (l == 0 ? WS_WOUT : WS_WOUT1)), NT, DM, 1536, 1536, 1536}; pg8::StaticOrder S; S.init(NT, DM, F.G, F.bid); \
            EpiOutNorm E{(l == 0) ? INP(I_X) : F.out, F.out, (const float*)(F.ws + WS_CTL + CTL_MOD) + (size_t)(l * 2) * 3072 + 2048, F.ws, (l == 0) ? INP(I_NORMW) + DM : INP(I_FNW), (const float*)(F.ws + WS_CTL + CTL_MOD) + (size_t)2 * 3072, l, l}; \
            pg8::gemm_phase<EpiOutNorm, pg8::StaticOrder, false, true>(F.lds, F.wave, g, S, E); \
            if (l == 0) SEAM(pb + 7); \
        } \
    } while (0)
__global__ void __launch_bounds__(NTHR, 2) mk_fwd(Args args) {
    extern __shared__ __attribute__((aligned(16))) unsigned char lds_raw[];
    Ctx F; F.lds = (LAS unsigned char*)lds_raw; F.tid = threadIdx.x; F.lane = F.tid & 63; F.wave = __builtin_amdgcn_readfirstlane(F.tid >> 6);
    F.G = gridDim.x; F.bid = blockIdx.x; F.ws = args.ws; F.out = args.out; F.in = args.in;
    const int wave0 = F.wave;
    cg::grid_group grid = cg::this_grid();
    volatile LAS unsigned* xst = (volatile LAS unsigned*)(F.lds + LDS_BYTES - 256);
    if (threadIdx.x < 2) xst[threadIdx.x] = 0u;
    __syncthreads();
    const XcdBarrier xbar = xcd_barrier_post((unsigned*)(args.ws + WS_CTL) + 4096, xst);
#if MK_PER_PHASE
    const int lo = args.ph_lo, hi = args.ph_hi;
#else
    constexpr int lo = 0, hi = 18;
#endif
#ifndef MK_ONLY
#define MK_ONLY -1
#endif
#define IN(k) (lo <= (k) && (k) < hi && (MK_ONLY < 0 || MK_ONLY == ((k) == 0 ? 0 : (k) == 17 ? 17 : 1 + ((k) - 1) % 8)))
#if MK_PER_PHASE
#define SEAM(k) do { } while (0)
#else
#define SEAM(k) do { xcd_barrier(xbar); } while (0)
#endif
#define PHB() do { int b_ = blockIdx.x, g_ = gridDim.x, v_ = wave0; asm volatile("" : "+s"(b_), "+s"(g_), "+s"(v_)); F.bid = b_; F.G = g_; F.wave = v_; int t_ = v_ * 64 + (int)__builtin_amdgcn_mbcnt_hi(~0u, __builtin_amdgcn_mbcnt_lo(~0u, 0u)); asm volatile("; PHASE_MARK %0" : "+v"(t_)); F.tid = t_; F.lane = t_ & 63; unsigned wl_ = __builtin_amdgcn_readfirstlane((unsigned)(uintptr_t)args.ws), wh_ = __builtin_amdgcn_readfirstlane((unsigned)((uintptr_t)args.ws >> 32)), ol_ = __builtin_amdgcn_readfirstlane((unsigned)(uintptr_t)args.out), oh_ = __builtin_amdgcn_readfirstlane((unsigned)((uintptr_t)args.out >> 32)); asm volatile("" : "+s"(wl_), "+s"(wh_), "+s"(ol_), "+s"(oh_)); F.ws = (unsigned char*)(GAS unsigned char*)(((uintptr_t)wh_ << 32) | wl_); F.out = (float*)(GAS float*)(((uintptr_t)oh_ << 32) | ol_); } while (0)
    if (IN(0)) { PHB(); p0_mod(F); p0_zero_ctl(F); prep_weights(F, 0); p0_rope(F); SEAM(0); }
    LAYER(0);
    LAYER(1);
#ifndef MK_RERUN
#define MK_RERUN 0
#endif
#define PHB2() do { int b_ = blockIdx.x, g_ = gridDim.x, v_ = wave0; asm volatile("" : "+s"(b_), "+s"(g_), "+s"(v_)); F.bid = b_; F.G = g_; F.wave = v_; int t_ = v_ * 64 + fresh_lane(); F.tid = t_; F.lane = t_ & 63; } while (0)
#if MK_RERUN
    { constexpr int l = 1;
    if (MK_RERUN & 1) { xcd_barrier(xbar); PHB2(); p1_norm(F, l); }
    if (MK_RERUN & 8192) { xcd_barrier(xbar); PHB2(); prep_weights(F, 1); }
    if (MK_RERUN & 2) { xcd_barrier(xbar); PHB2(); pg8::Gemm g{(const bf16_t*)(F.ws + WS_XN), (const bf16_t*)(F.ws + WS_WIN), NT, NIN, DM, DM, DM}; pg8::StaticOrder S; S.init(NT, NIN, F.G, F.bid); EpiIn E{F.ws, l}; pg8::gemm_phase<EpiIn, pg8::StaticOrder, true, true>(F.lds, F.wave, g, S, E); }
    if (MK_RERUN & 4) { xcd_barrier(xbar); PHB2(); pg8::Gemm g{(const bf16_t*)(F.ws + WS_QLAT), (const bf16_t*)(F.ws + WS_WQ), NT, 768, 256, 256, 256}; pg8::StaticOrder S; S.init(NT, 768, F.G, F.bid); EpiQ E{F.ws, l}; pg8::gemm_phase<EpiQ, pg8::StaticOrder, true, true>(F.lds, F.wave, g, S, E); p3a_extras(F, l); }
    if (MK_RERUN & 8) { xcd_barrier(xbar); PHB2(); p3b_ssd<MK_AVAR>(F, l); }
    if (MK_RERUN & 16) { xcd_barrier(xbar); PHB2(); p3c_rwkv<MK_AVAR>(F, l); }
    if (MK_RERUN & 32) { xcd_barrier(xbar); PHB2(); p4_mix(F, 2); }
#ifndef MK_AVAR
#define MK_AVAR 0
#endif
    if (MK_RERUN & 512) { xcd_barrier(xbar); PHB2(); p4_mix<MK_AVAR>(F, 2, 1); }
    if (MK_RERUN & 1024) { xcd_barrier(xbar); PHB2(); p4_mix(F, 2, 2); }
    if (MK_RERUN & 2048) { xcd_barrier(xbar); PHB2(); p4_mix(F, 2, 2 | 4); }
    if (MK_RERUN & 4096) { xcd_barrier(xbar); PHB2(); p4_mix(F, 2, 2 | 8); }
    if (MK_RERUN & 64) { xcd_barrier(xbar); PHB2(); p5_assemble<MK_AVAR>(F, l); }
    if (MK_RERUN & 128) { xcd_barrier(xbar); PHB2(); pg8::Gemm g{(const bf16_t*)(F.ws + WS_GATES), (const bf16_t*)(F.ws + WS_WOUT1), NT, DM, 1536, 1536, 1536}; pg8::StaticOrder S; S.init(NT, DM, F.G, F.bid);
        EpiOut E{INP(I_X), (float*)(F.ws + WS_XBC), (const float*)(F.ws + WS_CTL + CTL_MOD) + (size_t)(l * 2) * 3072 + 2048}; pg8::gemm_phase<EpiOut, pg8::StaticOrder, true, true>(F.lds, F.wave, g, S, E); }
    }
#endif
#undef IN
#undef SEAM
}
constexpr int N_PHASES = 18;

extern "C" void kernel_launch(void* const* d_in, const int* in_sizes, int n_in, void* d_out, int out_size, void* d_ws, size_t ws_size, hipStream_t stream) {
    static int grid = 0;
    if (grid == 0) {
        if (n_in != 31 || out_size != NT * DM || ws_size < WS_WOUT1 + 3 * MiB) { fprintf(stderr, "kernel_launch: unexpected shapes (n_in %d, out %d, ws %zu)\n", n_in, out_size, ws_size); grid = -1; return; }
        int dev = 0, cus = 0, per_cu = 0;
        hipGetDevice(&dev); hipDeviceGetAttribute(&cus, hipDeviceAttributeMultiprocessorCount, dev);
        if (hipFuncSetAttribute((const void*)mk_fwd, hipFuncAttributeMaxDynamicSharedMemorySize, LDS_BYTES) != hipSuccess) { fprintf(stderr, "kernel_launch: hipFuncSetAttribute failed\n"); grid = -1; return; }
        hipOccupancyMaxActiveBlocksPerMultiprocessor(&per_cu, (const void*)mk_fwd, NTHR, LDS_BYTES);
        (void)hipGetLastError();
        if (per_cu < 1) per_cu = 1;
        grid = cus;
        fprintf(stderr, "kernel_launch: cus %d, occupancy query %d block(s)/CU, grid %d\n", cus, per_cu, grid);
    }
    if (grid < 0) return;
    hipMemsetAsync((char*)d_ws + WS_CTL, 0, CTL_SSQ, stream);
    Args a{};
    for (int i = 0; i < 31; ++i) a.in[i] = (const float*)d_in[i];
    a.out = (float*)d_out; a.ws = (unsigned char*)d_ws;
#if MK_PER_PHASE
    for (int p = 0; p < N_PHASES; ++p) { a.ph_lo = p; a.ph_hi = p + 1; hipLaunchKernelGGL(mk_fwd, dim3(grid), dim3(NTHR), LDS_BYTES, stream, a); }
#else
    a.ph_lo = 0; a.ph_hi = N_PHASES;
    void* params[] = {&a};
    hipError_t e = hipLaunchCooperativeKernel((const void*)mk_fwd, dim3(grid), dim3(NTHR), params, LDS_BYTES, stream);
    if (e != hipSuccess) fprintf(stderr, "kernel_launch: cooperative launch failed: %s\n", hipGetErrorString(e));
#endif
}
```
